# Optimizing an MI355X kernel written in HIP

```python
import math
import jax, jax.numpy as jnp
from jax import lax
import numpy as np

D_MODEL = 1024
BATCH = 4
SEQ = 4096
DEPTH = 2

N_EVEN = (DEPTH + 1) // 2
N_ODD = DEPTH // 2
HEAD_DIM = 64
NORM_EPS = 1e-6

RWKV_HEADS = 8
RWKV_DIM = RWKV_HEADS * HEAD_DIM
DECAY_LORA = 64
ICLR_LORA = 64
GATE_LORA = 128
RWKV_GN_EPS = 64e-5
RWKV_COLS = 3 * RWKV_DIM + DECAY_LORA + ICLR_LORA + GATE_LORA
RWKV_SPLITS = (RWKV_DIM, 2 * RWKV_DIM, 3 * RWKV_DIM, 3 * RWKV_DIM + DECAY_LORA,
               3 * RWKV_DIM + DECAY_LORA + ICLR_LORA)

SSD_HEADS = 8
SSD_DIM = SSD_HEADS * HEAD_DIM
SSD_GROUPS = 2
SSD_STATE = 128
SSD_CONV = 4
SSD_CHUNK = 128
SSD_XBC = SSD_DIM + 2 * SSD_GROUPS * SSD_STATE
SSD_COLS = SSD_DIM + SSD_XBC + SSD_HEADS
IN0_COLS = RWKV_COLS + SSD_COLS
MIX0_DIM = RWKV_DIM + SSD_DIM

ATTN_Q_HEADS = 16
ATTN_KV_HEADS = 4
GQA_GROUP = ATTN_Q_HEADS // ATTN_KV_HEADS
Q_DIM = ATTN_Q_HEADS * HEAD_DIM
KV_DIM = ATTN_KV_HEADS * HEAD_DIM
QKV_COLS = Q_DIM + 2 * KV_DIM
WINDOW = 128
ROPE_THETA = 500000.0
ROPE_DIM = HEAD_DIM // 4

FFN_DENSE = 2816
N_EXPERTS = 8
TOP_K = 2
FFN_EXPERT = 1408

kernel_name = "hybrid_rwkv7_ssd_swa_moe_block"


def rmsnorm(x, g, eps=NORM_EPS):
    xf = x.astype(jnp.float32)
    y = xf * lax.rsqrt(jnp.mean(xf * xf, axis=-1, keepdims=True) + eps)
    return (y * g.astype(jnp.float32)).astype(x.dtype)


def token_shift(u):
    return jnp.pad(u[:, :-1], ((0, 0), (1, 0), (0, 0)))


def causal_depthwise_conv(u, w, b):
    c = u.shape[-1]
    y = lax.conv_general_dilated(u, w[:, None, :], window_strides=(1,),
                                 padding=[(SSD_CONV - 1, 0)],
                                 dimension_numbers=('NWC', 'WIO', 'NWC'),
                                 feature_group_count=c)
    return y + b


def rwkv7_scan(r, decay, k, v, a_vec, b_vec):
    out_dtype = v.dtype
    bsz, _, nh, n = r.shape

    def seq_major(t):
        return jnp.moveaxis(t.astype(jnp.float32), 1, 0)

    def step(s, inp):
        r_t, w_t, k_t, v_t, a_t, bb_t = inp
        sa = jnp.einsum('bhvk,bhk->bhv', s, a_t)
        s = s * w_t[:, :, None, :] + sa[..., :, None] * bb_t[..., None, :] + v_t[..., :, None] * k_t[..., None, :]
        return s, jnp.einsum('bhvk,bhk->bhv', s, r_t)

    s0 = jnp.zeros((bsz, nh, n, n), jnp.float32)
    _, y = lax.scan(step, s0, tuple(map(seq_major, (r, decay, k, v, a_vec, b_vec))))
    return jnp.moveaxis(y, 0, 1).astype(out_dtype)


def ssd_chunked(x, dt, a, bm, cm):
    bsz, seq, nh, p = x.shape
    g, n = bm.shape[2], bm.shape[3]
    hpg = nh // g
    nc, q = seq // SSD_CHUNK, SSD_CHUNK
    f32 = jnp.float32
    xc = x.astype(f32).reshape(bsz, nc, q, g, hpg, p)
    dtc = dt.reshape(bsz, nc, q, g, hpg)
    bc = bm.astype(f32).reshape(bsz, nc, q, g, n)
    cc = cm.astype(f32).reshape(bsz, nc, q, g, n)
    cum = jnp.cumsum(dtc * a.reshape(g, hpg), axis=2)
    seg = cum[:, :, :, None] - cum[:, :, None]
    causal = jnp.tril(jnp.ones((q, q), bool))[None, None, :, :, None, None]
    ldec = jnp.exp(jnp.where(causal, seg, -jnp.inf))
    cb = jnp.einsum('bclgn,bcsgn->bclsg', cc, bc)
    wts = cb[..., None] * ldec * dtc[:, :, None]
    y_diag = jnp.einsum('bclsgh,bcsghp->bclghp', wts, xc)
    to_end = jnp.exp(cum[:, :, -1:] - cum) * dtc
    states = jnp.einsum('bcsgn,bcsghp->bcghpn', bc, xc * to_end[..., None])
    chunk_decay = jnp.exp(cum[:, :, -1])

    def step(hs, inp):
        st, dec = inp
        return hs * dec[..., None, None] + st, hs

    h0 = jnp.zeros((bsz, g, hpg, p, n), f32)
    _, h_prev = lax.scan(step, h0, (jnp.moveaxis(states, 1, 0), jnp.moveaxis(chunk_decay, 1, 0)))
    h_prev = jnp.moveaxis(h_prev, 0, 1)
    y_off = jnp.einsum('bclgn,bcghpn->bclghp', cc, h_prev) * jnp.exp(cum)[..., None]
    return (y_diag + y_off).reshape(bsz, seq, nh, p)


def rwkv_ssd_mixer(h, w_in, mu_shift, w0, w_decay_up, a0, w_iclr_up, w_gate_up, k_k, k_a, r_k,
                   gn_w, gn_b, conv_w, conv_b, dt_bias, a_log, d_skip, ssd_norm, w_out):
    bsz, seq, _ = h.shape
    f32 = jnp.float32
    proj = h @ w_in
    pa, pb = proj[..., :RWKV_COLS], proj[..., RWKV_COLS:]

    pa = pa + (token_shift(pa) - pa) * mu_shift
    r, k, v, wl, al, gl = jnp.split(pa, RWKV_SPLITS, axis=-1)
    w_raw = (w0 + jnp.tanh(wl) @ w_decay_up).astype(f32)
    decay = jnp.exp(-jnp.exp(-jax.nn.softplus(-w_raw) - 0.5))
    iclr = jax.nn.sigmoid(a0 + al @ w_iclr_up)
    g_out = jax.nn.sigmoid(gl) @ w_gate_up

    def heads(t):
        return t.reshape(bsz, seq, RWKV_HEADS, HEAD_DIM)

    kk = heads(k * k_k).astype(f32)
    kk = kk * lax.rsqrt(jnp.sum(kk * kk, axis=-1, keepdims=True) + 1e-12)
    k = k * (1.0 + (iclr - 1.0) * k_a)
    r_h, k_h, v_h, a_h = heads(r), heads(k), heads(v), heads(iclr)
    y = rwkv7_scan(r_h, heads(decay), k_h, v_h, -kk, kk * a_h).astype(f32)
    mu = jnp.mean(y, axis=-1, keepdims=True)
    var = jnp.mean(jnp.square(y - mu), axis=-1, keepdims=True)
    y = (y - mu) * lax.rsqrt(var + RWKV_GN_EPS) * gn_w.reshape(RWKV_HEADS, HEAD_DIM) + gn_b.reshape(RWKV_HEADS, HEAD_DIM)
    bonus = jnp.sum((r_h * k_h * r_k).astype(f32), axis=-1, keepdims=True) * v_h
    ya = ((y + bonus).reshape(bsz, seq, RWKV_DIM) * g_out).astype(h.dtype)

    z, xbc, dt = jnp.split(pb, (SSD_DIM, SSD_DIM + SSD_XBC), axis=-1)
    xbc = jax.nn.silu(causal_depthwise_conv(xbc, conv_w, conv_b))
    xs, bm, cm = jnp.split(xbc, (SSD_DIM, SSD_DIM + SSD_GROUPS * SSD_STATE), axis=-1)
    dt = jax.nn.softplus((dt + dt_bias).astype(f32))
    a = -jnp.exp(a_log.astype(f32))
    xs_h = xs.reshape(bsz, seq, SSD_HEADS, HEAD_DIM)
    ys = ssd_chunked(xs_h, dt, a,
                     bm.reshape(bsz, seq, SSD_GROUPS, SSD_STATE),
                     cm.reshape(bsz, seq, SSD_GROUPS, SSD_STATE))
    ys = ys + d_skip[:, None] * xs_h
    ys = ys.reshape(bsz, seq, SSD_DIM) * jax.nn.silu(z)
    ys = rmsnorm(ys.reshape(bsz, seq, SSD_GROUPS, SSD_DIM // SSD_GROUPS),
                 ssd_norm.reshape(SSD_GROUPS, SSD_DIM // SSD_GROUPS)).reshape(bsz, seq, SSD_DIM)

    return jnp.concatenate([ya, ys.astype(h.dtype)], axis=-1) @ w_out


def partial_rope(t, cos, sin):
    rot, rest = t[..., :ROPE_DIM], t[..., ROPE_DIM:]
    x1, x2 = rot[..., :ROPE_DIM // 2], rot[..., ROPE_DIM // 2:]
    shape = cos.shape[:2] + (1,) * (t.ndim - 3) + (cos.shape[-1],)
    c, s = cos.reshape(shape), sin.reshape(shape)
    return jnp.concatenate([x1 * c - x2 * s, x2 * c + x1 * s, rest], axis=-1)


def swa_sink_attention(h, cos, sin, w_qkv, b_qkv, q_norm, k_norm, sinks, w_o, b_o):
    bsz, seq, _ = h.shape
    nb = seq // WINDOW
    qkv = h @ w_qkv + b_qkv
    q, k, v = jnp.split(qkv, (Q_DIM, Q_DIM + KV_DIM), axis=-1)
    q = q.reshape(bsz, seq, ATTN_KV_HEADS, GQA_GROUP, HEAD_DIM)
    k = k.reshape(bsz, seq, ATTN_KV_HEADS, HEAD_DIM)
    v = v.reshape(bsz, seq, ATTN_KV_HEADS, HEAD_DIM)
    q = partial_rope(rmsnorm(q, q_norm), cos, sin)
    k = partial_rope(rmsnorm(k, k_norm), cos, sin)
    qb = q.reshape(bsz, nb, WINDOW, ATTN_KV_HEADS, GQA_GROUP, HEAD_DIM)
    kb = k.reshape(bsz, nb, WINDOW, ATTN_KV_HEADS, HEAD_DIM)
    vb = v.reshape(bsz, nb, WINDOW, ATTN_KV_HEADS, HEAD_DIM)

    def with_prev_block(t):
        prev = jnp.pad(t[:, :-1], ((0, 0), (1, 0), (0, 0), (0, 0), (0, 0)))
        return jnp.concatenate([prev, t], axis=2)

    kw, vw = with_prev_block(kb), with_prev_block(vb)
    qi = jnp.arange(WINDOW)[:, None]
    kj = jnp.arange(2 * WINDOW)[None, :]
    diff = WINDOW + qi - kj
    band = (diff >= 0) & (diff < WINDOW)
    blk = jnp.arange(nb)[:, None, None]
    valid = band[None] & ((blk > 0) | (kj[None] >= WINDOW))
    scores = jnp.einsum('bnqkgd,bnskd->bkgnqs', qb, kw).astype(jnp.float32) * (HEAD_DIM ** -0.5)
    scores = jnp.where(valid[None, None, None], scores, -jnp.inf)
    sink = jnp.broadcast_to(sinks.astype(jnp.float32).reshape(1, ATTN_KV_HEADS, GQA_GROUP, 1, 1, 1),
                            scores.shape[:-1] + (1,))
    probs = jax.nn.softmax(jnp.concatenate([scores, sink], axis=-1), axis=-1)[..., :-1]
    out = jnp.einsum('bkgnqs,bnskd->bnqkgd', probs.astype(vw.dtype), vw)
    return out.reshape(bsz, seq, Q_DIM) @ w_o + b_o


def swiglu(h, w_gate, w_up, w_down):
    return (jax.nn.silu(h @ w_gate) * (h @ w_up)) @ w_down


def moe_swiglu(h, w_router, w_gate, w_up, w_down):
    bsz, seq, d = h.shape
    t = h.reshape(-1, d)
    logits = (t @ w_router).astype(jnp.float32)
    top_vals, top_idx = lax.top_k(logits, TOP_K)
    top_w = jax.nn.softmax(top_vals, axis=-1)
    combine = jnp.sum(jax.nn.one_hot(top_idx, N_EXPERTS, dtype=jnp.float32) * top_w[..., None], axis=1)
    combine = combine.astype(t.dtype)
    out = jnp.zeros_like(t)
    for e in range(N_EXPERTS):
        out = out + combine[:, e:e + 1] * swiglu(t, w_gate[e], w_up[e], w_down[e])
    return out.reshape(bsz, seq, d)


def setup_inputs(seed: int = 0) -> dict:
    key = jax.random.key(seed)
    keys = jax.random.split(key, 48)
    ctr = [0]
    f32 = jnp.float32

    def nxt():
        kk = keys[ctr[0]]
        ctr[0] += 1
        return kk

    def nrm(shape, scale):
        return jax.random.normal(nxt(), shape, f32) * scale

    def gain(shape):
        return 1.0 + nrm(shape, 0.02)

    ne, no = N_EVEN, N_ODD
    x = nrm((BATCH, SEQ, D_MODEL), 1.0)
    positions = jnp.broadcast_to(jnp.arange(SEQ, dtype=jnp.int32), (BATCH, SEQ))
    ev_norm_mix = gain((ne, D_MODEL))
    ev_w_in = nrm((ne, D_MODEL, IN0_COLS), D_MODEL ** -0.5)
    ev_mu_shift = jax.random.uniform(nxt(), (ne, RWKV_COLS), f32)
    ev_w0 = nrm((ne, RWKV_DIM), 0.5)
    ev_w_decay_up = nrm((ne, DECAY_LORA, RWKV_DIM), 0.5 * DECAY_LORA ** -0.5)
    ev_a0 = nrm((ne, RWKV_DIM), 0.1)
    ev_w_iclr_up = nrm((ne, ICLR_LORA, RWKV_DIM), ICLR_LORA ** -0.5)
    ev_w_gate_up = nrm((ne, GATE_LORA, RWKV_DIM), GATE_LORA ** -0.5)
    ev_k_k = 0.85 + nrm((ne, RWKV_DIM), 0.05)
    ev_k_a = 1.0 + nrm((ne, RWKV_DIM), 0.05)
    ev_r_k = nrm((ne, RWKV_HEADS, HEAD_DIM), 0.1)
    ev_gn_w = gain((ne, RWKV_DIM))
    ev_gn_b = nrm((ne, RWKV_DIM), 0.02)
    ev_conv_w = nrm((ne, SSD_CONV, SSD_XBC), SSD_CONV ** -0.5)
    ev_conv_b = nrm((ne, SSD_XBC), 0.02)
    dt_init = jnp.exp(jax.random.uniform(nxt(), (ne, SSD_HEADS), f32, math.log(1e-3), math.log(1e-1)))
    ev_dt_bias = dt_init + jnp.log(-jnp.expm1(-dt_init))
    ev_a_log = jnp.log(jax.random.uniform(nxt(), (ne, SSD_HEADS), f32, 1.0, 16.0))
    ev_d_skip = 1.0 + nrm((ne, SSD_HEADS), 0.1)
    ev_ssd_norm = gain((ne, SSD_DIM))
    ev_w_out = nrm((ne, MIX0_DIM, D_MODEL), MIX0_DIM ** -0.5)
    ev_norm_ffn = gain((ne, D_MODEL))
    ev_ffn_gate = nrm((ne, D_MODEL, FFN_DENSE), D_MODEL ** -0.5)
    ev_ffn_up = nrm((ne, D_MODEL, FFN_DENSE), D_MODEL ** -0.5)
    ev_ffn_down = nrm((ne, FFN_DENSE, D_MODEL), FFN_DENSE ** -0.5)
    od_norm_mix = gain((no, D_MODEL))
    od_w_qkv = nrm((no, D_MODEL, QKV_COLS), D_MODEL ** -0.5)
    od_b_qkv = nrm((no, QKV_COLS), 0.02)
    od_q_norm = gain((no, HEAD_DIM))
    od_k_norm = gain((no, HEAD_DIM))
    od_sinks = nrm((no, ATTN_Q_HEADS), 1.0)
    od_w_o = nrm((no, Q_DIM, D_MODEL), Q_DIM ** -0.5)
    od_b_o = nrm((no, D_MODEL), 0.02)
    od_norm_ffn = gain((no, D_MODEL))
    od_router = nrm((no, D_MODEL, N_EXPERTS), D_MODEL ** -0.5)
    od_exp_gate = nrm((no, N_EXPERTS, D_MODEL, FFN_EXPERT), D_MODEL ** -0.5)
    od_exp_up = nrm((no, N_EXPERTS, D_MODEL, FFN_EXPERT), D_MODEL ** -0.5)
    od_exp_down = nrm((no, N_EXPERTS, FFN_EXPERT, D_MODEL), FFN_EXPERT ** -0.5)
    return {
        "x": x, "positions": positions,
        "ev_norm_mix": ev_norm_mix, "ev_w_in": ev_w_in, "ev_mu_shift": ev_mu_shift, "ev_w0": ev_w0,
        "ev_w_decay_up": ev_w_decay_up, "ev_a0": ev_a0, "ev_w_iclr_up": ev_w_iclr_up,
        "ev_w_gate_up": ev_w_gate_up, "ev_k_k": ev_k_k, "ev_k_a": ev_k_a, "ev_r_k": ev_r_k,
        "ev_gn_w": ev_gn_w, "ev_gn_b": ev_gn_b, "ev_conv_w": ev_conv_w, "ev_conv_b": ev_conv_b,
        "ev_dt_bias": ev_dt_bias, "ev_a_log": ev_a_log, "ev_d_skip": ev_d_skip, "ev_ssd_norm": ev_ssd_norm,
        "ev_w_out": ev_w_out, "ev_norm_ffn": ev_norm_ffn, "ev_ffn_gate": ev_ffn_gate,
        "ev_ffn_up": ev_ffn_up, "ev_ffn_down": ev_ffn_down,
        "od_norm_mix": od_norm_mix, "od_w_qkv": od_w_qkv, "od_b_qkv": od_b_qkv, "od_q_norm": od_q_norm,
        "od_k_norm": od_k_norm, "od_sinks": od_sinks, "od_w_o": od_w_o, "od_b_o": od_b_o,
        "od_norm_ffn": od_norm_ffn, "od_router": od_router, "od_exp_gate": od_exp_gate,
        "od_exp_up": od_exp_up, "od_exp_down": od_exp_down,
    }


def reference(x, positions,
              ev_norm_mix, ev_w_in, ev_mu_shift, ev_w0, ev_w_decay_up, ev_a0, ev_w_iclr_up,
              ev_w_gate_up, ev_k_k, ev_k_a, ev_r_k, ev_gn_w, ev_gn_b, ev_conv_w, ev_conv_b,
              ev_dt_bias, ev_a_log, ev_d_skip, ev_ssd_norm, ev_w_out, ev_norm_ffn, ev_ffn_gate,
              ev_ffn_up, ev_ffn_down,
              od_norm_mix, od_w_qkv, od_b_qkv, od_q_norm, od_k_norm, od_sinks, od_w_o, od_b_o,
              od_norm_ffn, od_router, od_exp_gate, od_exp_up, od_exp_down):
    inv_freq = ROPE_THETA ** (-jnp.arange(0, ROPE_DIM, 2, dtype=jnp.float32) / ROPE_DIM)
    ang = positions.astype(jnp.float32)[..., None] * inv_freq
    cos, sin = jnp.cos(ang).astype(x.dtype), jnp.sin(ang).astype(x.dtype)
    h = x
    for layer in range(DEPTH):
        i = layer // 2
        if layer % 2 == 0:
            h = h + rwkv_ssd_mixer(rmsnorm(h, ev_norm_mix[i]), ev_w_in[i], ev_mu_shift[i], ev_w0[i],
                                   ev_w_decay_up[i], ev_a0[i], ev_w_iclr_up[i], ev_w_gate_up[i],
                                   ev_k_k[i], ev_k_a[i], ev_r_k[i], ev_gn_w[i], ev_gn_b[i],
                                   ev_conv_w[i], ev_conv_b[i], ev_dt_bias[i], ev_a_log[i],
                                   ev_d_skip[i], ev_ssd_norm[i], ev_w_out[i])
            h = h + swiglu(rmsnorm(h, ev_norm_ffn[i]), ev_ffn_gate[i], ev_ffn_up[i], ev_ffn_down[i])
        else:
            h = h + swa_sink_attention(rmsnorm(h, od_norm_mix[i]), cos, sin, od_w_qkv[i], od_b_qkv[i],
                                       od_q_norm[i], od_k_norm[i], od_sinks[i], od_w_o[i], od_b_o[i])
            h = h + moe_swiglu(rmsnorm(h, od_norm_ffn[i]), od_router[i], od_exp_gate[i],
                               od_exp_up[i], od_exp_down[i])
    return h
```

```cpp
#include <hip/hip_runtime.h>
#include <cstdio>
#include <cstdint>

#define LAS __attribute__((address_space(3)))
#define GAS __attribute__((address_space(1)))
typedef unsigned short bf16_t;
typedef short bf16x8 __attribute__((ext_vector_type(8)));
typedef float f32x4 __attribute__((ext_vector_type(4)));
typedef float f32x2 __attribute__((ext_vector_type(2)));
typedef float f32x16 __attribute__((ext_vector_type(16)));
typedef unsigned u32x4 __attribute__((ext_vector_type(4)));
typedef unsigned u32x2 __attribute__((ext_vector_type(2)));
typedef short s16x4 __attribute__((ext_vector_type(4)));

constexpr int BATCH = 4, SEQ = 4096, DM = 1024, MTOK = BATCH * SEQ;
constexpr int IN0 = 3336, NPROJ = 3328;
constexpr int FFN = 2816, FE = 1408, NEXP = 8;
constexpr int SROWS = 2 * MTOK + NEXP * 256;
constexpr float EPS = 1e-6f;

constexpr size_t MiB = 1u << 20;
constexpr size_t WS_CTL = 0, CTL_ZERO_BYTES = 64 * 1024;
constexpr size_t WS_DTSP = 1 * MiB;
constexpr size_t WS_KKR = 1 * MiB + 512 * 1024;
constexpr size_t WS_ROPE = 2 * MiB;
constexpr size_t WS_SS = 3 * MiB;
constexpr size_t WS_TOPE = 4 * MiB;
constexpr size_t WS_RANK = 4 * MiB + 128 * 1024;
constexpr size_t WS_TOPW = 4 * MiB + 256 * 1024;
constexpr size_t WS_POS = 4 * MiB + 384 * 1024;
constexpr size_t WS_RSTD4 = 4 * MiB + 512 * 1024;
constexpr size_t WS_RSTDS = 4 * MiB + 640 * 1024;
constexpr size_t WS_WDEC = 5 * MiB;
constexpr size_t WS_WICL = 5 * MiB + 64 * 1024;
constexpr size_t WS_WGAT = 5 * MiB + 128 * 1024;
constexpr size_t WS_EGU = 6 * MiB;
constexpr size_t WS_EDN = 50 * MiB;
constexpr size_t WS_WIN = 72 * MiB;
constexpr size_t WS_WOUT = WS_WIN + (size_t)NPROJ * DM * 2;
constexpr size_t WS_WGU = WS_WOUT + 2 * MiB;
constexpr size_t WS_WDN = WS_WGU + 11 * MiB;
constexpr size_t WS_WQKV = WS_WDN + (size_t)DM * FFN * 2;
constexpr size_t WS_WO = WS_WQKV + 3 * MiB;
constexpr size_t R0 = 102 * MiB;
static_assert(WS_WO + 2 * MiB <= R0, "weights");
constexpr size_t WS_XN = R0, WS_MIX = R0;
constexpr size_t WS_PROJ = R0 + 32 * MiB;
constexpr size_t WS_GOUT = R0 + 136 * MiB;
constexpr size_t WS_XNB = R0 + 104 * MiB;
constexpr size_t WS_HID = R0;
constexpr size_t WS_QKV = R0;
constexpr size_t WS_ATTO = R0 + 48 * MiB;
constexpr size_t WS_AS = 72 * MiB;
constexpr size_t WS_HS = 140 * MiB;
constexpr size_t WS_END = 254 * MiB;
static_assert(WS_AS + (size_t)SROWS * DM * 2 <= WS_HS && WS_HS + (size_t)SROWS * FE * 2 <= WS_END && WS_GOUT + 16 * MiB <= WS_END, "map");
constexpr size_t DO_XBCC = 0, DO_DECAY = 32 * MiB, DO_ICLR = 48 * MiB;
constexpr int CW_BAR = 4096, CW_CNT = 8192;

constexpr int LDS_BYTES = 147456, RING_BYTES = 131072, MISC_OFF = RING_BYTES + 320;

__device__ __forceinline__ unsigned f2bf(float f) { unsigned u = __builtin_bit_cast(unsigned, f); return (u + 0x7fffu + ((u >> 16) & 1u)) >> 16; }
__device__ __forceinline__ unsigned pk2(float lo, float hi) { return f2bf(lo) | (f2bf(hi) << 16); }
__device__ __forceinline__ float bflo(unsigned u) { return __builtin_bit_cast(float, u << 16); }
__device__ __forceinline__ float bfhi(unsigned u) { return __builtin_bit_cast(float, u & 0xffff0000u); }
__device__ __forceinline__ void unpack8(const u32x4 v, float* f) { f[0] = bflo(v.x); f[1] = bfhi(v.x); f[2] = bflo(v.y); f[3] = bfhi(v.y); f[4] = bflo(v.z); f[5] = bfhi(v.z); f[6] = bflo(v.w); f[7] = bfhi(v.w); }
__device__ __forceinline__ u32x4 pack8(const float* f) { u32x4 v; v.x = pk2(f[0], f[1]); v.y = pk2(f[2], f[3]); v.z = pk2(f[4], f[5]); v.w = pk2(f[6], f[7]); return v; }
__device__ __forceinline__ float sigmoidf_(float x) { return 1.0f / (1.0f + __expf(-x)); }
__device__ __forceinline__ float siluf_(float x) { return x / (1.0f + __expf(-x)); }
__device__ __forceinline__ float wave_sum(float v) {
#pragma unroll
    for (int o = 1; o < 64; o <<= 1) v += __shfl_xor(v, o);
    return v;
}
__device__ __forceinline__ float dpp_sum63(float x) {
    int v;
    v = __builtin_amdgcn_update_dpp(0, __builtin_bit_cast(int, x), 0xB1, 0xF, 0xF, false); x += __builtin_bit_cast(float, v);
    v = __builtin_amdgcn_update_dpp(0, __builtin_bit_cast(int, x), 0x4E, 0xF, 0xF, false); x += __builtin_bit_cast(float, v);
    v = __builtin_amdgcn_update_dpp(0, __builtin_bit_cast(int, x), 0x141, 0xF, 0xF, false); x += __builtin_bit_cast(float, v);
    v = __builtin_amdgcn_update_dpp(0, __builtin_bit_cast(int, x), 0x140, 0xF, 0xF, false); x += __builtin_bit_cast(float, v);
    v = __builtin_amdgcn_update_dpp(0, __builtin_bit_cast(int, x), 0x142, 0xA, 0xF, false); x += __builtin_bit_cast(float, v);
    v = __builtin_amdgcn_update_dpp(0, __builtin_bit_cast(int, x), 0x143, 0xC, 0xF, false); x += __builtin_bit_cast(float, v);
    return __builtin_bit_cast(float, __builtin_amdgcn_readlane(__builtin_bit_cast(int, x), 63));
}
__device__ __forceinline__ int crow(int r, int hi) { return (r & 3) + 8 * (r >> 2) + 4 * hi; }

namespace pg8 {
constexpr int BM = 256, BK = 64, HALF = 128, HTB = HALF * BK * 2, NXCD = 8, WGM = 8;
__host__ __device__ __forceinline__ int lds_byte(int r, int c) { const int st = (r >> 4) * 2 + (c >> 5), rr = r & 15, cc = c & 31, ob = rr * 64 + cc * 2; return st * 1024 + (ob ^ (((ob >> 9) & 1) << 5)); }
__host__ __device__ __forceinline__ void stage_rc(int b, int& R, int& C) { const int st = b / 1024, sb = b % 1024, swz = sb ^ (((sb >> 9) & 1) << 5); R = (st >> 1) * 16 + swz / 64; C = (st & 1) * 32 + (swz % 64) / 2; }
__host__ __device__ __forceinline__ int perm32(int rho) { const int n = rho >> 4, i = rho & 15; return 8 * (i >> 2) + 4 * n + (i & 3); }
struct Unit { int pm, pn; long bofs; };
struct Gemm { const bf16_t* A; const bf16_t* Bt; int M, N, K; };
struct StaticOrder {
    int nM, nN, nwg, G, c;
    __device__ void init(int M, int N, int G_, int c_) { nM = M / BM; nN = N / BM; nwg = nM * nN; G = G_; c = c_; }
    __device__ bool next(int i, Unit& u) const {
        const long L = (long)i * G + c; if (L >= nwg) return false;
        int wgid = (int)L; { const int q = nwg / NXCD, r = nwg % NXCD, xcd = wgid % NXCD, off = wgid / NXCD; wgid = (xcd < r ? xcd * (q + 1) : r * (q + 1) + (xcd - r) * q) + off; }
        const int nig = WGM * nN, gid = wgid / nig, fm = gid * WGM, gsz = (nM - fm) < WGM ? (nM - fm) : WGM;
        u.pm = fm + ((wgid % nig) % gsz); u.pn = (wgid % nig) / gsz; u.bofs = 0; return true;
    }
};
struct MoeOrder {
    int toff[NEXP + 1]; int nN, G, c; long estride;
    __device__ void init(const unsigned* cnt, int nN_, int G_, int c_, long estride_) {
        nN = nN_; G = G_; c = c_; estride = estride_; int t = 0;
#pragma unroll
        for (int e = 0; e < NEXP; ++e) { toff[e] = t; t += (int)((cnt[e] + 255u) >> 8); }
        toff[NEXP] = t;
    }
    __device__ bool next(int i, Unit& u) const {
        const long L = (long)i * G + c; if (L >= (long)toff[NEXP] * nN) return false;
        const int pm = (int)(L / nN); u.pm = pm; u.pn = (int)(L % nN); int e = 0;
#pragma unroll
        for (int j = 1; j < NEXP; ++j) e += (pm >= toff[j]) ? 1 : 0;
        u.bofs = (long)e * estride; return true;
    }
};

template <class Epi, class Sched>
__device__ __forceinline__ void gemm_phase(LAS unsigned char* lds, const Gemm g, const Sched& S, const Epi& E) {
    constexpr bool ALIGN_EPI = true;
    const int tid = threadIdx.x, wid = __builtin_amdgcn_readfirstlane(tid >> 6), lane = tid & 63, wr = wid >> 2, wc = wid & 3, fr = lane & 15, fq = lane >> 4;
    const int K = g.K, nt = K / BK;
    unsigned voffA[2], voffB[2];
#pragma unroll
    for (int i = 0; i < 2; ++i) { int R, C; stage_rc(tid * 16 + i * 8192, R, C); const int Rb = Epi::PERM ? ((R & ~31) + perm32(R & 31)) : R;
        voffA[i] = (unsigned)(R * K + C) * 2u; voffB[i] = (unsigned)(Rb * K + C) * 2u; }
    const size_t kstep = (size_t)(BK * 2);
    const size_t hstep = (size_t)HALF * K * 2;
    const size_t tstep = 2 * hstep;
    const unsigned ldsw = (unsigned)wid * 1024u;
    const int aoff = lds_byte(wr * 64 + fr, fq * 8), boff = lds_byte(wc * 32 + fr, fq * 8);
#define PG8_SA(b, h) (((b) * 2 + (h)) * HTB)
#define PG8_SB(b, h) ((4 + (b) * 2 + (h)) * HTB)
#define PG8_STAGE(bufoff, gbase, voff) do { _Pragma("unroll") for (int _i = 0; _i < 2; ++_i) \
        __builtin_amdgcn_global_load_lds((const unsigned*)((const char*)(gbase) + (voff)[_i]), (LAS unsigned*)(lds + (bufoff) + ldsw + _i * 8192), 16, 0, 0); } while (0)
#define PG8_LDA(dst, b, h) do { _Pragma("unroll") for (int m = 0; m < 4; ++m) _Pragma("unroll") for (int k = 0; k < 2; ++k) dst[m][k] = *(const LAS bf16x8*)(lds + PG8_SA(b, h) + aoff + m * 2048 + k * 1024); } while (0)
#define PG8_LDB(dst, b, h) do { _Pragma("unroll") for (int n = 0; n < 2; ++n) _Pragma("unroll") for (int k = 0; k < 2; ++k) dst[n][k] = *(const LAS bf16x8*)(lds + PG8_SB(b, h) + boff + n * 2048 + k * 1024); } while (0)
#define PG8_MMA(ai, bj, At, Bt) do { __builtin_amdgcn_s_setprio(1); _Pragma("unroll") for (int m = 0; m < 4; ++m) _Pragma("unroll") for (int n = 0; n < 2; ++n) _Pragma("unroll") for (int k = 0; k < 2; ++k) \
        acc[ai][bj][m][n] = __builtin_amdgcn_mfma_f32_16x16x32_bf16(Bt[n][k], At[m][k], acc[ai][bj][m][n], 0, 0, 0); __builtin_amdgcn_s_setprio(0); } while (0)
#define PG8_WAIT_V(n) asm volatile("s_waitcnt vmcnt(" #n ")" ::: "memory")
#define PG8_WAIT_L(n) asm volatile("s_waitcnt lgkmcnt(" #n ")" ::: "memory")
#define PG8_BAR __builtin_amdgcn_s_barrier()
#define PG8_SCHED __builtin_amdgcn_sched_barrier(0)
    Unit cur, nxt; int ui = 0;
    if (!S.next(0, cur)) return;
    f32x4 acc[2][2][4][2];
#pragma unroll
    for (int a = 0; a < 2; ++a)
#pragma unroll
        for (int b = 0; b < 2; ++b)
#pragma unroll
            for (int m = 0; m < 4; ++m)
#pragma unroll
                for (int n = 0; n < 2; ++n) acc[a][b][m][n] = (f32x4){0.f, 0.f, 0.f, 0.f};
    bf16x8 At[4][2], B0[2][2], B1[2][2];
    const char* cA = (const char*)g.A + (size_t)cur.pm * tstep; const char* cB = (const char*)g.Bt + cur.bofs + (size_t)cur.pn * tstep;
    PG8_STAGE(PG8_SB(0, 0), cB, voffB); PG8_STAGE(PG8_SB(0, 1), cB + hstep, voffB); PG8_STAGE(PG8_SA(0, 0), cA, voffA); PG8_STAGE(PG8_SA(0, 1), cA + hstep, voffA);
    if (wr == 1) PG8_BAR;
    PG8_WAIT_V(2); PG8_BAR;
    PG8_STAGE(PG8_SB(1, 0), cB + kstep, voffB); PG8_STAGE(PG8_SA(1, 0), cA + kstep, voffA); PG8_STAGE(PG8_SB(1, 1), cB + hstep + kstep, voffB);
    PG8_WAIT_V(6); PG8_BAR;
    for (;;) {
        const bool has_next = S.next(ui + 1, nxt);
        const char* nA = has_next ? (const char*)g.A + (size_t)nxt.pm * tstep : cA; const char* nB = has_next ? (const char*)g.Bt + nxt.bofs + (size_t)nxt.pn * tstep : cB;
        for (int t = 0; t < nt; t += 2) {
            const bool last = (t == nt - 2);
            const char* a1 = cA + (size_t)(t + 1) * kstep;
            const char* a2 = last ? nA : cA + (size_t)(t + 2) * kstep; const char* b2 = last ? nB : cB + (size_t)(t + 2) * kstep;
            const char* a3 = a2 + kstep; const char* b3 = b2 + kstep;
            PG8_LDB(B0, 0, 0); PG8_LDB(B1, 0, 1); PG8_SCHED; PG8_LDA(At, 0, 0); PG8_STAGE(PG8_SA(1, 1), a1 + hstep, voffA);
            PG8_WAIT_V(8); PG8_WAIT_L(0); PG8_BAR; PG8_MMA(0, 0, At, B0); PG8_MMA(0, 1, At, B1); PG8_BAR; PG8_SCHED;
            PG8_LDA(At, 0, 1); PG8_STAGE(PG8_SB(0, 0), b2, voffB); PG8_STAGE(PG8_SB(0, 1), b2 + hstep, voffB); PG8_STAGE(PG8_SA(0, 0), a2, voffA);
            PG8_WAIT_V(8); PG8_WAIT_L(0); PG8_BAR; PG8_MMA(1, 0, At, B0); PG8_MMA(1, 1, At, B1); PG8_BAR; PG8_SCHED;
            PG8_LDB(B0, 1, 0); PG8_LDB(B1, 1, 1); PG8_SCHED; PG8_LDA(At, 1, 0); PG8_STAGE(PG8_SA(0, 1), a2 + hstep, voffA);
            PG8_WAIT_V(8); PG8_WAIT_L(0); PG8_BAR; PG8_MMA(0, 0, At, B0); PG8_MMA(0, 1, At, B1); PG8_BAR; PG8_SCHED;
            PG8_LDA(At, 1, 1); PG8_STAGE(PG8_SB(1, 0), b3, voffB); PG8_STAGE(PG8_SB(1, 1), b3 + hstep, voffB); PG8_STAGE(PG8_SA(1, 0), a3, voffA);
            PG8_WAIT_V(8); PG8_WAIT_L(0); PG8_BAR; PG8_MMA(1, 0, At, B0); PG8_MMA(1, 1, At, B1); PG8_BAR; PG8_SCHED;
        }
        if constexpr (ALIGN_EPI) { if (wr == 0) PG8_BAR; }
        E(acc, cur, wr, wc, fr, fq);
        if (!has_next) break;
#pragma unroll
        for (int a = 0; a < 2; ++a)
#pragma unroll
            for (int b = 0; b < 2; ++b)
#pragma unroll
                for (int m = 0; m < 4; ++m)
#pragma unroll
                    for (int n = 0; n < 2; ++n) acc[a][b][m][n] = (f32x4){0.f, 0.f, 0.f, 0.f};
        cur = nxt; cA = nA; cB = nB; ++ui;
        if constexpr (ALIGN_EPI) { if (wr == 1) PG8_BAR; }
    }
    PG8_WAIT_V(0);
    if constexpr (!ALIGN_EPI) { if (wr == 0) PG8_BAR; }
    PG8_BAR;
#undef PG8_SA
#undef PG8_SB
#undef PG8_STAGE
#undef PG8_LDA
#undef PG8_LDB
#undef PG8_MMA
#undef PG8_WAIT_V
#undef PG8_WAIT_L
#undef PG8_BAR
#undef PG8_SCHED
}

struct EpiBf16 {
    static constexpr bool PERM = true;
    bf16_t* O; int ldc;
    __device__ __forceinline__ void operator()(const f32x4 (&acc)[2][2][4][2], const Unit& u, int wr, int wc, int fr, int fq) const {
        const int row0 = u.pm * BM + wr * 64 + fr, col0 = u.pn * BM + wc * 32 + 8 * fq;
#pragma unroll
        for (int ai = 0; ai < 2; ++ai)
#pragma unroll
            for (int m = 0; m < 4; ++m) { bf16_t* rowp = O + (size_t)(row0 + ai * HALF + m * 16) * ldc + col0;
#pragma unroll
                for (int bj = 0; bj < 2; ++bj) { const f32x4 v0 = acc[ai][bj][m][0], v1 = acc[ai][bj][m][1];
                    u32x4 w; w.x = pk2(v0[0], v0[1]); w.y = pk2(v0[2], v0[3]); w.z = pk2(v1[0], v1[1]); w.w = pk2(v1[2], v1[3]);
                    *(u32x4*)(rowp + bj * HALF) = w; } }
    }
};
struct EpiRes {
    static constexpr bool PERM = false;
    const float* base; float* out; bf16_t* xn; const float* gw; const float* bias; float* ss;
    __device__ __forceinline__ void operator()(const f32x4 (&acc)[2][2][4][2], const Unit& u, int wr, int wc, int fr, int fq) const {
        const int col0 = u.pn * BM + wc * 32 + 4 * fq;
        f32x4 gv[2][2], bv[2][2];
#pragma unroll
        for (int bj = 0; bj < 2; ++bj)
#pragma unroll
            for (int n = 0; n < 2; ++n) { gv[bj][n] = *(const f32x4*)(gw + col0 + bj * HALF + n * 16); bv[bj][n] = bias ? *(const f32x4*)(bias + col0 + bj * HALF + n * 16) : (f32x4){0.f, 0.f, 0.f, 0.f}; }
#pragma unroll
        for (int ai = 0; ai < 2; ++ai)
#pragma unroll
            for (int m = 0; m < 4; ++m) { const int row = u.pm * BM + ai * HALF + wr * 64 + m * 16 + fr; const size_t off = (size_t)row * DM + col0; float s = 0.f;
#pragma unroll
                for (int bj = 0; bj < 2; ++bj)
#pragma unroll
                    for (int n = 0; n < 2; ++n) { const f32x4 bs = *(const f32x4*)(base + off + bj * HALF + n * 16); const f32x4 o = bs + acc[ai][bj][m][n] + bv[bj][n];
                        *(f32x4*)(out + off + bj * HALF + n * 16) = o; s += (o[0] * o[0] + o[1] * o[1]) + (o[2] * o[2] + o[3] * o[3]);
                        const f32x4 x = o * gv[bj][n]; u32x2 w; w.x = pk2(x[0], x[1]); w.y = pk2(x[2], x[3]); *(u32x2*)(xn + off + bj * HALF + n * 16) = w; }
                s += __shfl_xor(s, 16); s += __shfl_xor(s, 32);
                if (fq == 0) ss[(size_t)row * 16 + u.pn * 4 + wc] = s; }
    }
};
__device__ __forceinline__ float rstd_from_ss(const float* ss, int row) {
    const f32x4* p = (const f32x4*)(ss + (size_t)row * 16); const f32x4 a = p[0], b = p[1], c = p[2], d = p[3];
    const float t = ((a[0] + a[1]) + (a[2] + a[3])) + ((b[0] + b[1]) + (b[2] + b[3])) + ((c[0] + c[1]) + (c[2] + c[3])) + ((d[0] + d[1]) + (d[2] + d[3]));
    return 1.0f / sqrtf(t * (1.0f / DM) + EPS);
}
struct EpiSwiglu {
    static constexpr bool PERM = true;
    bf16_t* O; int ldc; const float* ss; const float* rstd;
    __device__ __forceinline__ void operator()(const f32x4 (&acc)[2][2][4][2], const Unit& u, int wr, int wc, int fr, int fq) const {
        const int row0 = u.pm * BM + wr * 64 + fr, col0 = u.pn * HALF + wc * 32 + 8 * fq;
#pragma unroll
        for (int ai = 0; ai < 2; ++ai)
#pragma unroll
            for (int m = 0; m < 4; ++m) { const int row = row0 + ai * HALF + m * 16; const float rs = ss ? rstd_from_ss(ss, row) : rstd[row];
                float h[8];
#pragma unroll
                for (int n = 0; n < 2; ++n)
#pragma unroll
                    for (int i = 0; i < 4; ++i) { const float gg = acc[ai][0][m][n][i] * rs, uu = acc[ai][1][m][n][i] * rs; h[n * 4 + i] = siluf_(gg) * uu; }
                *(u32x4*)(O + (size_t)row * ldc + col0) = pack8(h); }
    }
};
struct EpiQkv {
    static constexpr bool PERM = true;
    bf16_t* O; const float* ss; const float* bias; const float* qn; const float* kn; const float* rope;
    __device__ __forceinline__ void operator()(const f32x4 (&acc)[2][2][4][2], const Unit& u, int wr, int wc, int fr, int fq) const {
        const int hd = u.pn * 4 + wc, row0 = u.pm * BM + wr * 64 + fr; const int kind = u.pn < 4 ? 0 : (u.pn == 4 ? 1 : 2);
        const float* nw = kind == 0 ? qn : kn;
        float bv[2][8], nv[2][8];
#pragma unroll
        for (int bj = 0; bj < 2; ++bj)
#pragma unroll
            for (int j = 0; j < 8; ++j) { bv[bj][j] = bias[hd * 64 + bj * 32 + fq * 8 + j]; nv[bj][j] = nw[bj * 32 + fq * 8 + j]; }
#pragma unroll
        for (int ai = 0; ai < 2; ++ai)
#pragma unroll
            for (int m = 0; m < 4; ++m) { const int row = row0 + ai * HALF + m * 16; const float rs = rstd_from_ss(ss, row);
                float v[2][8]; float s = 0.f;
#pragma unroll
                for (int bj = 0; bj < 2; ++bj)
#pragma unroll
                    for (int n = 0; n < 2; ++n)
#pragma unroll
                        for (int i = 0; i < 4; ++i) { const float x = acc[ai][bj][m][n][i] * rs + bv[bj][n * 4 + i]; v[bj][n * 4 + i] = x; s += x * x; }
                if (kind < 2) {
                    s += __shfl_xor(s, 16); s += __shfl_xor(s, 32);
                    const float r2 = 1.0f / sqrtf(s * (1.0f / 64.0f) + EPS);
#pragma unroll
                    for (int bj = 0; bj < 2; ++bj)
#pragma unroll
                        for (int j = 0; j < 8; ++j) v[bj][j] = v[bj][j] * r2 * nv[bj][j];
                    const f32x4* rp = (const f32x4*)(rope + (size_t)row * 16);
                    const f32x4 c0 = rp[0], c1 = rp[1], s0 = rp[2], s1 = rp[3];
#pragma unroll
                    for (int j = 0; j < 8; ++j) { const float other = __shfl_xor(v[0][j], 16); const float cc = j < 4 ? c0[j] : c1[j - 4], sn = j < 4 ? s0[j] : s1[j - 4];
                        const float mine = v[0][j]; const float rot = (fq == 0) ? (mine * cc - other * sn) : (mine * cc + other * sn);
                        v[0][j] = (fq < 2) ? rot : mine; }
                }
#pragma unroll
                for (int bj = 0; bj < 2; ++bj) *(u32x4*)(O + (size_t)row * 1536 + hd * 64 + bj * 32 + fq * 8) = pack8(v[bj]);
            }
    }
};
}

#define XB_TMO      128
#define XB_XCNT(j)  (256  + 64 * (j))
#define XB_XSUB(j)  (1280 + 64 * (j))
#define XB_XGEN(j)  (2304 + 64 * (j))
#define XB_TOP      3328
#define XB_TOPGEN   3392
#define XCD_BAR_WORDS 3456
#define XB_SPIN_CAP (1u << 20)
__device__ __forceinline__ unsigned xb_ld(unsigned* p)              { return __hip_atomic_load(p, __ATOMIC_RELAXED, __HIP_MEMORY_SCOPE_AGENT); }
__device__ __forceinline__ unsigned xb_add(unsigned* p, unsigned v) { return __hip_atomic_fetch_add(p, v, __ATOMIC_RELAXED, __HIP_MEMORY_SCOPE_AGENT); }
__device__ __forceinline__ unsigned xb_xcc_id() { return (unsigned)__builtin_amdgcn_s_getreg((3 << 11) | 20) & 0xFu; }
#define XB_SPIN(cond, bar) do { unsigned _sp = 0; while (cond) { __builtin_amdgcn_s_sleep(1); \
    if ((++_sp & 255u) == 0u) { if (xb_ld(&(bar)[XB_TMO])) break; if (_sp > XB_SPIN_CAP) { atomicAdd(&(bar)[XB_TMO], 1u); break; } } } } while (0)
struct XcdBarrier { unsigned* bar; unsigned x; volatile LAS unsigned* st; };
__device__ __forceinline__ XcdBarrier xcd_barrier_post(unsigned* bar, volatile LAS unsigned* st) {
    XcdBarrier b; b.bar = bar; b.x = xb_xcc_id(); b.st = st;
    if (threadIdx.x == 0) (void)xb_add(&bar[XB_XCNT(b.x)], 1u);
    return b;
}
__device__ __forceinline__ void xcd_barrier_complete(unsigned* bar, unsigned x, unsigned& nloc, unsigned& nx) {
    const unsigned G = gridDim.x * gridDim.y * gridDim.z;
    unsigned sum, cnt, mine, sp = 0u;
    for (;;) {
        sum = 0u; cnt = 0u; mine = 0u;
#pragma unroll
        for (unsigned j = 0; j < 16; ++j) { const unsigned c = xb_ld(&bar[XB_XCNT(j)]); sum += c; cnt += (c > 0u) ? 1u : 0u; mine = (j == x) ? c : mine; }
        if (sum == G) break;
        __builtin_amdgcn_s_sleep(1);
        if ((++sp & 255u) == 0u) { if (xb_ld(&bar[XB_TMO])) break; if (sp > XB_SPIN_CAP) { atomicAdd(&bar[XB_TMO], 1u); break; } }
    }
    nloc = mine > 0u ? mine : 1u; nx = cnt > 0u ? cnt : 1u;
}
__device__ __forceinline__ void xcd_barrier(const XcdBarrier& b) {
    asm volatile("s_waitcnt vmcnt(0)" ::: "memory");
    __syncthreads();
    if (threadIdx.x == 0) {
        unsigned* bar = b.bar;
        __builtin_amdgcn_s_waitcnt(0);
        unsigned nloc = b.st[0], nx = b.st[1];
        if (nloc == 0u) { xcd_barrier_complete(bar, b.x, nloc, nx); b.st[0] = nloc; b.st[1] = nx; }
        const unsigned old = xb_add(&bar[XB_XSUB(b.x)], 1u);
        const unsigned gen = old / nloc;
        if (old + 1u == (gen + 1u) * nloc) {
            __builtin_amdgcn_fence(__ATOMIC_RELEASE, "agent");
            asm volatile("s_waitcnt vmcnt(0)" ::: "memory");
            const unsigned og = xb_add(&bar[XB_TOP], 1u);
            const unsigned tg = og / nx;
            if (og + 1u == (tg + 1u) * nx) xb_add(&bar[XB_TOPGEN], 1u);
            else XB_SPIN(xb_ld(&bar[XB_TOPGEN]) == tg, bar);
            __builtin_amdgcn_fence(__ATOMIC_ACQUIRE, "agent");
            xb_add(&bar[XB_XGEN(b.x)], 1u);
            asm volatile("s_waitcnt vmcnt(0)" ::: "memory");
        } else {
            XB_SPIN(xb_ld(&bar[XB_XGEN(b.x)]) == gen, bar);
            __builtin_amdgcn_fence(__ATOMIC_ACQUIRE, "agent");
            asm volatile("s_waitcnt vmcnt(0)" ::: "memory");
        }
    }
    __syncthreads();
}

struct Args { const float* in[39]; const int* pos; float* out; unsigned char* ws; int ph_lo, ph_hi; };
enum InIdx { I_X = 0, I_NORM_MIX0 = 1, I_W_IN, I_MU, I_W0, I_WDEC, I_A0, I_WICL, I_WGAT, I_KK, I_KA, I_RK, I_GNW, I_GNB, I_CONVW, I_CONVB, I_DTB, I_ALOG, I_DSKIP, I_SSDN,
             I_WOUT, I_NORM_FFN0, I_FG, I_FU, I_FD, I_NORM_MIX1, I_WQKV, I_BQKV, I_QN, I_KN, I_SINK, I_WO, I_BO, I_NORM_FFN1, I_ROUTER, I_EG, I_EU, I_ED };

__device__ __forceinline__ void transpose_item(const float* W, int ld, int K, int k0, int n0, bf16_t* WT, int drow, LAS float* scr, int lane) {
#pragma unroll 8
    for (int i = 0; i < 32; ++i) { const int kk = 2 * i + (lane >> 5); scr[kk * 33 + (lane & 31)] = W[(size_t)(k0 + kk) * ld + n0 + (lane & 31)]; }
    asm volatile("s_waitcnt lgkmcnt(0)" ::: "memory");
    const int c = lane & 7;
#pragma unroll
    for (int j = 0; j < 4; ++j) { const int n = (lane >> 3) + 8 * j; const LAS float* s = scr + (8 * c) * 33 + n;
        u32x4 o; o.x = pk2(s[0 * 33], s[1 * 33]); o.y = pk2(s[2 * 33], s[3 * 33]); o.z = pk2(s[4 * 33], s[5 * 33]); o.w = pk2(s[6 * 33], s[7 * 33]);
        *(u32x4*)(WT + (size_t)(drow + n) * K + k0 + 8 * c) = o; }
    asm volatile("s_waitcnt lgkmcnt(0)" ::: "memory");
}
__device__ __forceinline__ int drow_of(int kind, int n0) {
    if (kind == 0) return n0;
    if (kind == 1) return 256 * (n0 >> 7) + (n0 & 127);
    if (kind == 2) return 256 * (n0 >> 7) + 128 + (n0 & 127);
    const int hd = n0 >> 6, bj = (n0 >> 5) & 1; return 256 * (hd >> 2) + 128 * bj + 32 * (hd & 3);
}
__device__ __forceinline__ bool transpose_matrix(int& it, const float* W, int ld, int K, int ncols, bf16_t* WT, int kind, LAS float* scr, int lane) {
    const int nnb = ncols / 32, items = (K / 64) * nnb;
    if (it < items) { const int kb = it / nnb, nb = it % nnb; transpose_item(W, ld, K, 64 * kb, 32 * nb, WT, drow_of(kind, 32 * nb), scr, lane); return true; }
    it -= items; return false;
}


#define XN ((bf16_t*)(ws + WS_XN))
#define MIX ((bf16_t*)(ws + WS_MIX))
#define PROJ ((bf16_t*)(ws + WS_PROJ))
#define GOUT ((bf16_t*)(ws + WS_GOUT))
#define XNB ((bf16_t*)(ws + WS_XNB))
#define HID ((bf16_t*)(ws + WS_HID))
#define QKV ((bf16_t*)(ws + WS_QKV))
#define ATTO ((bf16_t*)(ws + WS_ATTO))
#define AS ((bf16_t*)(ws + WS_AS))
#define HS ((bf16_t*)(ws + WS_HS))
#define XBCC ((bf16_t*)((unsigned char*)dout + DO_XBCC))
#define DECAY ((bf16_t*)((unsigned char*)dout + DO_DECAY))
#define ICLR ((bf16_t*)((unsigned char*)dout + DO_ICLR))
#define DTSP ((float*)(ws + WS_DTSP))
#define KKR ((float*)(ws + WS_KKR))
#define ROPE ((float*)(ws + WS_ROPE))
#define SS ((float*)(ws + WS_SS))
#define TOPE ((int*)(ws + WS_TOPE))
#define RANK ((int*)(ws + WS_RANK))
#define TOPW ((float*)(ws + WS_TOPW))
#define POS ((int*)(ws + WS_POS))
#define RSTD4 ((float*)(ws + WS_RSTD4))
#define RSTDS ((float*)(ws + WS_RSTDS))
#define WDEC ((bf16_t*)(ws + WS_WDEC))
#define WICL ((bf16_t*)(ws + WS_WICL))
#define WGAT ((bf16_t*)(ws + WS_WGAT))
#define EGU ((bf16_t*)(ws + WS_EGU))
#define EDN ((bf16_t*)(ws + WS_EDN))
#define WIN ((bf16_t*)(ws + WS_WIN))
#define WOUT ((bf16_t*)(ws + WS_WOUT))
#define WGU ((bf16_t*)(ws + WS_WGU))
#define WDN ((bf16_t*)(ws + WS_WDN))
#define WQKV ((bf16_t*)(ws + WS_WQKV))
#define WO ((bf16_t*)(ws + WS_WO))
__global__ void __launch_bounds__(512, 2) fwd_kernel(Args args) {
    extern __shared__ __attribute__((aligned(16))) unsigned char lds_raw[];
    LAS unsigned char* lds = (LAS unsigned char*)lds_raw;
    volatile LAS unsigned* MISC = (volatile LAS unsigned*)(lds + MISC_OFF);
    const int tid = threadIdx.x, lane = tid & 63, wave = __builtin_amdgcn_readfirstlane(tid >> 6);
    const int G = gridDim.x, bx = blockIdx.x;
    const int vcu = (G % 8 == 0) ? (bx % 8) * (G / 8) + bx / 8 : bx;
    unsigned char* ws = args.ws;
    unsigned* ctl = (unsigned*)(ws + WS_CTL);
    float* dout = args.out;
    for (int u = tid; u < (LDS_BYTES - RING_BYTES) / 4; u += 512) ((LAS unsigned*)(lds + RING_BYTES))[u] = 0u;
    __syncthreads();
    XcdBarrier bar = xcd_barrier_post(ctl + CW_BAR, MISC + 8);
    const int lo = args.ph_lo, hi = args.ph_hi;
#define IN(k) (lo <= (k) && (k) < hi)
#define SEAM(k) do { if (IN(k) && IN((k) + 1)) xcd_barrier(bar); } while (0)
    const int gw = vcu * 8 + wave, NGW = G * 8;

    unsigned* CNT = ctl + CW_CNT;

    if (IN(0)) {
        LAS float* scr = (LAS float*)(lds + wave * 16384);
        for (int it0 = gw; ; it0 += NGW) {
            int it = it0;
            if (transpose_matrix(it, args.in[I_W_IN], IN0, DM, NPROJ, WIN, 0, scr, lane)) continue;
            if (transpose_matrix(it, args.in[I_WOUT], DM, DM, DM, WOUT, 0, scr, lane)) continue;
            if (transpose_matrix(it, args.in[I_FG], FFN, DM, FFN, WGU, 1, scr, lane)) continue;
            if (transpose_matrix(it, args.in[I_FU], FFN, DM, FFN, WGU, 2, scr, lane)) continue;
            if (transpose_matrix(it, args.in[I_FD], DM, FFN, DM, WDN, 0, scr, lane)) continue;
            if (transpose_matrix(it, args.in[I_WQKV], 1536, DM, 1536, WQKV, 3, scr, lane)) continue;
            if (transpose_matrix(it, args.in[I_WO], DM, DM, DM, WO, 0, scr, lane)) continue;
            if (transpose_matrix(it, args.in[I_WDEC], 512, 64, 512, WDEC, 0, scr, lane)) continue;
            if (transpose_matrix(it, args.in[I_WICL], 512, 64, 512, WICL, 0, scr, lane)) continue;
            if (transpose_matrix(it, args.in[I_WGAT], 512, 128, 512, WGAT, 0, scr, lane)) continue;
            bool done = false;
            for (int e = 0; e < NEXP && !done; ++e) {
                if (transpose_matrix(it, args.in[I_EG] + (size_t)e * DM * FE, FE, DM, FE, EGU + (size_t)e * 2 * FE * DM, 1, scr, lane)) { done = true; break; }
                if (transpose_matrix(it, args.in[I_EU] + (size_t)e * DM * FE, FE, DM, FE, EGU + (size_t)e * 2 * FE * DM, 2, scr, lane)) { done = true; break; }
                if (transpose_matrix(it, args.in[I_ED] + (size_t)e * FE * DM, DM, FE, DM, EDN + (size_t)e * DM * FE, 0, scr, lane)) { done = true; break; }
            }
            if (!done) break;
        }
        __syncthreads();
        LAS float* w8 = (LAS float*)lds;
        for (int r = tid; r < DM; r += 512) { const float* p = args.in[I_W_IN] + (size_t)r * IN0 + NPROJ; *(LAS f32x4*)(w8 + r * 8) = *(const f32x4*)p; *(LAS f32x4*)(w8 + r * 8 + 4) = *(const f32x4*)(p + 4); }
        __syncthreads();
        const float* gm = args.in[I_NORM_MIX0];
        for (int m = gw; m < MTOK; m += NGW) {
            const f32x4* xr = (const f32x4*)(args.in[I_X] + (size_t)m * DM) + lane;
            f32x4 v[4]; float s = 0.f;
#pragma unroll
            for (int j = 0; j < 4; ++j) { v[j] = xr[64 * j]; s += (v[j][0] * v[j][0] + v[j][1] * v[j][1]) + (v[j][2] * v[j][2] + v[j][3] * v[j][3]); }
            const float rstd = 1.0f / sqrtf(wave_sum(s) * (1.0f / DM) + EPS);
            float d[8];
#pragma unroll
            for (int k = 0; k < 8; ++k) d[k] = 0.f;
            unsigned long long* o8 = (unsigned long long*)(XN + (size_t)m * DM) + lane;
#pragma unroll
            for (int j = 0; j < 4; ++j) { const f32x4 g4 = ((const f32x4*)gm)[64 * j + lane]; const f32x4 y = v[j] * rstd * g4;
                o8[64 * j] = (unsigned long long)pk2(y[0], y[1]) | ((unsigned long long)pk2(y[2], y[3]) << 32);
#pragma unroll
                for (int i = 0; i < 4; ++i) { const int c = 256 * j + 4 * lane + i; const f32x4 wa = *(const LAS f32x4*)(w8 + c * 8), wb = *(const LAS f32x4*)(w8 + c * 8 + 4);
                    d[0] += y[i] * wa[0]; d[1] += y[i] * wa[1]; d[2] += y[i] * wa[2]; d[3] += y[i] * wa[3]; d[4] += y[i] * wb[0]; d[5] += y[i] * wb[1]; d[6] += y[i] * wb[2]; d[7] += y[i] * wb[3]; } }
#pragma unroll
            for (int k = 0; k < 8; ++k) d[k] = wave_sum(d[k]);
            if (lane < 8) { float dv = d[0];
#pragma unroll
                for (int k = 1; k < 8; ++k) dv = (lane == k) ? d[k] : dv;
                const float z = dv + args.in[I_DTB][lane]; DTSP[(size_t)m * 8 + lane] = z > 20.f ? z : log1pf(__expf(z)); }
            if (lane >= 16 && lane < 24) { const int j = lane - 16; const double inv = exp(-(double)j * 0.125 * 13.122363377404328); const double ang = (double)args.pos[m] * inv;
                ROPE[(size_t)m * 16 + j] = (float)cos(ang); ROPE[(size_t)m * 16 + 8 + j] = (float)sin(ang); }
        }
        __syncthreads();
    }
    SEAM(0);

    if (IN(1)) {
        pg8::Gemm g{XN, WIN, MTOK, NPROJ, DM}; pg8::StaticOrder S; S.init(MTOK, NPROJ, G, bx);
        pg8::EpiBf16 E{PROJ, NPROJ};
        pg8::gemm_phase(lds, g, S, E);
    }
    SEAM(1);

    if (IN(2)) {
        const float* mu = args.in[I_MU];
        for (int unit = vcu; unit < MTOK / 64; unit += G) {
            const int m0 = unit * 64;
            LAS bf16_t* Aw = (LAS bf16_t*)lds; LAS bf16_t* Aa = (LAS bf16_t*)(lds + 9216); LAS bf16_t* Ag = (LAS bf16_t*)(lds + 18432);
            {
                const int tt = tid >> 3, cg = tid & 7, m = m0 + tt; const bool hasprev = (m & (SEQ - 1)) != 0;
                const bf16_t* pc = PROJ + (size_t)m * NPROJ + 1536 + 32 * cg;
#pragma unroll 1
                for (int q = 0; q < 4; ++q) {
                    float c[8], p[8]; unpack8(*(const u32x4*)(pc + 8 * q), c);
                    if (hasprev) unpack8(*(const u32x4*)(pc - NPROJ + 8 * q), p); else { for (int i = 0; i < 8; ++i) p[i] = 0.f; }
                    float o[8];
#pragma unroll
                    for (int i = 0; i < 8; ++i) { const int col = 32 * cg + 8 * q + i; const float x = c[i] + (p[i] - c[i]) * mu[1536 + col];
                        o[i] = cg < 2 ? tanhf(x) : (cg < 4 ? x : sigmoidf_(x)); }
                    const u32x4 w = pack8(o); const int col0 = 32 * cg + 8 * q;
                    if (cg < 2) *(LAS u32x4*)(Aw + tt * 72 + col0) = w; else if (cg < 4) *(LAS u32x4*)(Aa + tt * 72 + (col0 - 64)) = w; else *(LAS u32x4*)(Ag + tt * 136 + (col0 - 128)) = w;
                }
            }
            __syncthreads();
            {
                const int h = wave, r32 = lane & 31, hh = lane >> 5;
#pragma unroll 1
                for (int which = 0; which < 3; ++which) {
                    const LAS bf16_t* A = which == 0 ? Aw : (which == 1 ? Aa : Ag); const int pitch = which == 2 ? 136 : 72, KS = which == 2 ? 8 : 4;
                    const bf16_t* Wt = which == 0 ? WDEC : (which == 1 ? WICL : WGAT); const int wk = which == 2 ? 128 : 64;
                    f32x16 acc[2][2];
#pragma unroll
                    for (int a = 0; a < 2; ++a)
#pragma unroll
                        for (int b = 0; b < 2; ++b)
#pragma unroll
                            for (int r = 0; r < 16; ++r) acc[a][b][r] = 0.f;
                    for (int s = 0; s < KS; ++s) {
                        bf16x8 af[2], bfr[2];
#pragma unroll
                        for (int a = 0; a < 2; ++a) af[a] = *(const LAS bf16x8*)(A + (32 * a + r32) * pitch + 16 * s + 8 * hh);
#pragma unroll
                        for (int b = 0; b < 2; ++b) bfr[b] = *(const bf16x8*)(Wt + (size_t)(64 * h + 32 * b + r32) * wk + 16 * s + 8 * hh);
#pragma unroll
                        for (int a = 0; a < 2; ++a)
#pragma unroll
                            for (int b = 0; b < 2; ++b) acc[a][b] = __builtin_amdgcn_mfma_f32_32x32x16_bf16(af[a], bfr[b], acc[a][b], 0, 0, 0);
                    }
                    bf16_t* O = which == 0 ? DECAY : (which == 1 ? ICLR : GOUT);
#pragma unroll
                    for (int b = 0; b < 2; ++b) { const int c = 64 * h + 32 * b + r32; const float add = which == 0 ? args.in[I_W0][c] : (which == 1 ? args.in[I_A0][c] : 0.f);
#pragma unroll
                        for (int a = 0; a < 2; ++a)
#pragma unroll
                            for (int r = 0; r < 16; ++r) { const int m = m0 + 32 * a + crow(r, hh); float x = acc[a][b][r] + add;
                                if (which == 0) x = __expf(-0.6065306597126334f * sigmoidf_(x)); else if (which == 1) x = sigmoidf_(x);
                                O[(size_t)m * 512 + c] = (bf16_t)f2bf(x); } }
                }
            }
            {
                const int tt = tid >> 3, h = tid & 7, m = m0 + tt; const bool hasprev = (m & (SEQ - 1)) != 0;
                const bf16_t* pc = PROJ + (size_t)m * NPROJ + 512 + 64 * h; float s = 0.f;
#pragma unroll 2
                for (int q = 0; q < 8; ++q) { float c[8], p[8]; unpack8(*(const u32x4*)(pc + 8 * q), c);
                    if (hasprev) unpack8(*(const u32x4*)(pc - NPROJ + 8 * q), p); else { for (int i = 0; i < 8; ++i) p[i] = 0.f; }
#pragma unroll
                    for (int i = 0; i < 8; ++i) { const int col = 64 * h + 8 * q + i; const float x = (c[i] + (p[i] - c[i]) * mu[512 + col]) * args.in[I_KK][col]; s += x * x; } }
                KKR[(size_t)m * 8 + h] = 1.0f / sqrtf(s + 1e-12f);
            }
            {
                const int cgp = tid & 127, ts = tid >> 7, c0 = 8 * cgp; const float* cw = args.in[I_CONVW]; const float* cb = args.in[I_CONVB];
                float w[4][8], bb[8];
#pragma unroll
                for (int j = 0; j < 4; ++j)
#pragma unroll
                    for (int i = 0; i < 8; ++i) w[j][i] = cw[j * 1024 + c0 + i];
#pragma unroll
                for (int i = 0; i < 8; ++i) bb[i] = cb[c0 + i];
                float x0[8], x1[8], x2[8], x3[8];
                const int mstart = m0 + 16 * ts; const int tpos = mstart & (SEQ - 1);
                const bf16_t* src = PROJ + (size_t)mstart * NPROJ + 2304 + c0;
#pragma unroll
                for (int i = 0; i < 8; ++i) { x0[i] = 0.f; x1[i] = 0.f; x2[i] = 0.f; }
                if (tpos >= 3) unpack8(*(const u32x4*)(src - 3 * (size_t)NPROJ), x0);
                if (tpos >= 2) unpack8(*(const u32x4*)(src - 2 * (size_t)NPROJ), x1);
                if (tpos >= 1) unpack8(*(const u32x4*)(src - 1 * (size_t)NPROJ), x2);
                for (int t = 0; t < 16; ++t) {
                    unpack8(*(const u32x4*)(src + (size_t)t * NPROJ), x3);
                    float o[8];
#pragma unroll
                    for (int i = 0; i < 8; ++i) { const float y = bb[i] + w[0][i] * x0[i] + w[1][i] * x1[i] + w[2][i] * x2[i] + w[3][i] * x3[i]; o[i] = siluf_(y); x0[i] = x1[i]; x1[i] = x2[i]; x2[i] = x3[i]; }
                    *(u32x4*)(XBCC + (size_t)(mstart + t) * 1024 + c0) = pack8(o);
                }
            }
            __syncthreads();
        }
    }
    SEAM(2);

    if (IN(3)) {
        const int b = vcu >> 6, h = (vcu >> 3) & 7, rg = vcu & 7, row = 8 * rg + wave;
        LAS float* Rr = (LAS float*)lds; LAS float* Wd = Rr + 4096; LAS float* KX = Wd + 4096; LAS float* Aa = KX + 4096; LAS float* Bb = Aa + 4096; LAS float* Vv = Bb + 4096; LAS float* Yst = Vv + 4096;
        const float* mu = args.in[I_MU];
        const int tt = tid >> 3, cg = tid & 7, ch = 64 * h + 8 * cg;
        u32x4 raw[8]; float kkr;
        auto issue = [&](int s) {
            const int m = b * SEQ + s * 64 + tt; const bool hasprev = (s * 64 + tt) != 0;
            const bf16_t* pc = PROJ + (size_t)m * NPROJ + ch;
            raw[0] = *(const u32x4*)(pc); raw[1] = *(const u32x4*)(pc + 512); raw[2] = *(const u32x4*)(pc + 1024);
            if (hasprev) { raw[3] = *(const u32x4*)(pc - NPROJ); raw[4] = *(const u32x4*)(pc - NPROJ + 512); raw[5] = *(const u32x4*)(pc - NPROJ + 1024); }
            else { raw[3] = (u32x4){0, 0, 0, 0}; raw[4] = raw[3]; raw[5] = raw[3]; }
            raw[6] = *(const u32x4*)(DECAY + (size_t)m * 512 + ch); raw[7] = *(const u32x4*)(ICLR + (size_t)m * 512 + ch);
            kkr = KKR[(size_t)m * 8 + h];
        };
        auto commit = [&]() {
            float r[8], k[8], v[8], pr[8], pk[8], pv[8], dc[8], ic[8];
            unpack8(raw[0], r); unpack8(raw[1], k); unpack8(raw[2], v); unpack8(raw[3], pr); unpack8(raw[4], pk); unpack8(raw[5], pv); unpack8(raw[6], dc); unpack8(raw[7], ic);
            float o_r[8], o_w[8], o_kx[8], o_a[8], o_b[8], o_v[8];
#pragma unroll
            for (int i = 0; i < 8; ++i) { const int c = ch + i;
                const float rr = r[i] + (pr[i] - r[i]) * mu[c], kk0 = k[i] + (pk[i] - k[i]) * mu[512 + c], vv = v[i] + (pv[i] - v[i]) * mu[1024 + c];
                const float kn = kk0 * args.in[I_KK][c] * kkr;
                o_r[i] = rr; o_w[i] = dc[i]; o_kx[i] = kk0 * (1.0f + (ic[i] - 1.0f) * args.in[I_KA][c]); o_a[i] = -kn; o_b[i] = kn * ic[i]; o_v[i] = vv; }
            const int o = tt * 64 + 8 * cg;
            *(LAS f32x4*)(Rr + o) = (f32x4){o_r[0], o_r[1], o_r[2], o_r[3]}; *(LAS f32x4*)(Rr + o + 4) = (f32x4){o_r[4], o_r[5], o_r[6], o_r[7]};
            *(LAS f32x4*)(Wd + o) = (f32x4){o_w[0], o_w[1], o_w[2], o_w[3]}; *(LAS f32x4*)(Wd + o + 4) = (f32x4){o_w[4], o_w[5], o_w[6], o_w[7]};
            *(LAS f32x4*)(KX + o) = (f32x4){o_kx[0], o_kx[1], o_kx[2], o_kx[3]}; *(LAS f32x4*)(KX + o + 4) = (f32x4){o_kx[4], o_kx[5], o_kx[6], o_kx[7]};
            *(LAS f32x4*)(Aa + o) = (f32x4){o_a[0], o_a[1], o_a[2], o_a[3]}; *(LAS f32x4*)(Aa + o + 4) = (f32x4){o_a[4], o_a[5], o_a[6], o_a[7]};
            *(LAS f32x4*)(Bb + o) = (f32x4){o_b[0], o_b[1], o_b[2], o_b[3]}; *(LAS f32x4*)(Bb + o + 4) = (f32x4){o_b[4], o_b[5], o_b[6], o_b[7]};
            *(LAS f32x4*)(Vv + o) = (f32x4){o_v[0], o_v[1], o_v[2], o_v[3]}; *(LAS f32x4*)(Vv + o + 4) = (f32x4){o_v[4], o_v[5], o_v[6], o_v[7]};
        };
        issue(0); commit(); __syncthreads();
        float Sst = 0.f;
        for (int s = 0; s < SEQ / 64; ++s) {
            if (s + 1 < SEQ / 64) issue(s + 1);
#pragma unroll 4
            for (int t = 0; t < 64; ++t) {
                const float a = Aa[t * 64 + lane], w = Wd[t * 64 + lane], bb = Bb[t * 64 + lane], kx = KX[t * 64 + lane], r = Rr[t * 64 + lane], vv = Vv[t * 64 + row];
                const float sa = dpp_sum63(Sst * a);
                Sst = Sst * w + (sa * bb + vv * kx);
                const float y = dpp_sum63(Sst * r);
                if (lane == 0) Yst[t * 8 + wave] = y;
            }
            __syncthreads();
            { const int m = b * SEQ + s * 64 + (tid >> 3); MIX[(size_t)m * DM + 64 * h + 8 * rg + (tid & 7)] = (bf16_t)f2bf(Yst[tid]); }
            if (s + 1 < SEQ / 64) commit();
            __syncthreads();
        }
    }
    SEAM(3);

    if (IN(4)) {
        const int b = vcu >> 6, h = (vcu >> 3) & 7, pg = vcu & 7, g = h >> 2;
        LAS float* Bm = (LAS float*)lds; LAS float* Cm = Bm + 8192; LAS float* Xs = Cm + 8192; LAS float* DTs = Xs + 512; LAS float* DECs = DTs + 64; LAS float* Yst = DECs + 64;
        const float a_h = -__expf(args.in[I_ALOG][h]);
        const int tt = tid >> 3, cg = tid & 7;
        u32x4 raw[5]; float dtv;
        auto issue = [&](int s) {
            const int m = b * SEQ + s * 64 + tt; const bf16_t* pc = XBCC + (size_t)m * 1024;
            raw[0] = *(const u32x4*)(pc + 512 + 128 * g + 16 * cg); raw[1] = *(const u32x4*)(pc + 512 + 128 * g + 16 * cg + 8);
            raw[2] = *(const u32x4*)(pc + 768 + 128 * g + 16 * cg); raw[3] = *(const u32x4*)(pc + 768 + 128 * g + 16 * cg + 8);
            raw[4] = *(const u32x4*)(pc + 64 * h + 8 * pg); dtv = DTSP[(size_t)m * 8 + h];
        };
        auto commit = [&]() {
            float f[8];
            unpack8(raw[0], f); *(LAS f32x4*)(Bm + tt * 128 + 16 * cg) = (f32x4){f[0], f[1], f[2], f[3]}; *(LAS f32x4*)(Bm + tt * 128 + 16 * cg + 4) = (f32x4){f[4], f[5], f[6], f[7]};
            unpack8(raw[1], f); *(LAS f32x4*)(Bm + tt * 128 + 16 * cg + 8) = (f32x4){f[0], f[1], f[2], f[3]}; *(LAS f32x4*)(Bm + tt * 128 + 16 * cg + 12) = (f32x4){f[4], f[5], f[6], f[7]};
            unpack8(raw[2], f); *(LAS f32x4*)(Cm + tt * 128 + 16 * cg) = (f32x4){f[0], f[1], f[2], f[3]}; *(LAS f32x4*)(Cm + tt * 128 + 16 * cg + 4) = (f32x4){f[4], f[5], f[6], f[7]};
            unpack8(raw[3], f); *(LAS f32x4*)(Cm + tt * 128 + 16 * cg + 8) = (f32x4){f[0], f[1], f[2], f[3]}; *(LAS f32x4*)(Cm + tt * 128 + 16 * cg + 12) = (f32x4){f[4], f[5], f[6], f[7]};
            if (cg == 0) { unpack8(raw[4], f); *(LAS f32x4*)(Xs + tt * 8) = (f32x4){f[0], f[1], f[2], f[3]}; *(LAS f32x4*)(Xs + tt * 8 + 4) = (f32x4){f[4], f[5], f[6], f[7]}; DTs[tt] = dtv; DECs[tt] = __expf(dtv * a_h); }
        };
        issue(0); commit(); __syncthreads();
        float h0 = 0.f, h1 = 0.f;
        for (int s = 0; s < SEQ / 64; ++s) {
            if (s + 1 < SEQ / 64) issue(s + 1);
#pragma unroll 4
            for (int t = 0; t < 64; ++t) {
                const f32x2 bv = *(const LAS f32x2*)(Bm + t * 128 + 2 * lane), cv = *(const LAS f32x2*)(Cm + t * 128 + 2 * lane);
                const float dtx = DTs[t] * Xs[t * 8 + wave], dec = DECs[t];
                h0 = h0 * dec + dtx * bv[0]; h1 = h1 * dec + dtx * bv[1];
                const float y = dpp_sum63(h0 * cv[0] + h1 * cv[1]);
                if (lane == 0) Yst[t * 8 + wave] = y;
            }
            __syncthreads();
            { const int m = b * SEQ + s * 64 + (tid >> 3); MIX[(size_t)m * DM + 512 + 64 * h + 8 * pg + (tid & 7)] = (bf16_t)f2bf(Yst[tid]); }
            if (s + 1 < SEQ / 64) commit();
            __syncthreads();
        }
    }
    SEAM(4);

    if (IN(5)) {
        const float* mu = args.in[I_MU];
        for (int m = gw; m < MTOK; m += NGW) {
            const bool hasprev = (m & (SEQ - 1)) != 0; const int c0 = 8 * lane, h = lane >> 3;
            float y[8], r[8], k[8], v[8], p[8], ic[8], go[8];
            unpack8(*(const u32x4*)(MIX + (size_t)m * DM + c0), y);
            const bf16_t* pc = PROJ + (size_t)m * NPROJ + c0;
            unpack8(*(const u32x4*)(pc), r); unpack8(*(const u32x4*)(pc + 512), k); unpack8(*(const u32x4*)(pc + 1024), v);
            if (hasprev) {
                unpack8(*(const u32x4*)(pc - NPROJ), p);
#pragma unroll
                for (int i = 0; i < 8; ++i) r[i] += (p[i] - r[i]) * mu[c0 + i];
                unpack8(*(const u32x4*)(pc - NPROJ + 512), p);
#pragma unroll
                for (int i = 0; i < 8; ++i) k[i] += (p[i] - k[i]) * mu[512 + c0 + i];
                unpack8(*(const u32x4*)(pc - NPROJ + 1024), p);
#pragma unroll
                for (int i = 0; i < 8; ++i) v[i] += (p[i] - v[i]) * mu[1024 + c0 + i];
            } else {
#pragma unroll
                for (int i = 0; i < 8; ++i) { r[i] -= r[i] * mu[c0 + i]; k[i] -= k[i] * mu[512 + c0 + i]; v[i] -= v[i] * mu[1024 + c0 + i]; }
            }
            unpack8(*(const u32x4*)(ICLR + (size_t)m * 512 + c0), ic); unpack8(*(const u32x4*)(GOUT + (size_t)m * 512 + c0), go);
            float s1 = 0.f, bd = 0.f;
#pragma unroll
            for (int i = 0; i < 8; ++i) { s1 += y[i]; const float kx = k[i] * (1.0f + (ic[i] - 1.0f) * args.in[I_KA][c0 + i]); bd += r[i] * kx * args.in[I_RK][c0 + i]; }
            s1 += __shfl_xor(s1, 1); s1 += __shfl_xor(s1, 2); s1 += __shfl_xor(s1, 4);
            bd += __shfl_xor(bd, 1); bd += __shfl_xor(bd, 2); bd += __shfl_xor(bd, 4);
            const float mean = s1 * (1.0f / 64.0f); float s2 = 0.f;
#pragma unroll
            for (int i = 0; i < 8; ++i) { const float d = y[i] - mean; s2 += d * d; }
            s2 += __shfl_xor(s2, 1); s2 += __shfl_xor(s2, 2); s2 += __shfl_xor(s2, 4);
            const float rs = 1.0f / sqrtf(s2 * (1.0f / 64.0f) + 64e-5f);
            float o[8];
#pragma unroll
            for (int i = 0; i < 8; ++i) o[i] = ((y[i] - mean) * rs * args.in[I_GNW][c0 + i] + args.in[I_GNB][c0 + i] + bd * v[i]) * go[i];
            *(u32x4*)(MIX + (size_t)m * DM + c0) = pack8(o);
            float ys[8], xs[8], z[8];
            unpack8(*(const u32x4*)(MIX + (size_t)m * DM + 512 + c0), ys); unpack8(*(const u32x4*)(XBCC + (size_t)m * 1024 + c0), xs); unpack8(*(const u32x4*)(PROJ + (size_t)m * NPROJ + 1792 + c0), z);
            const float dsk = args.in[I_DSKIP][h]; float q = 0.f;
#pragma unroll
            for (int i = 0; i < 8; ++i) { ys[i] = (ys[i] + dsk * xs[i]) * siluf_(z[i]); q += ys[i] * ys[i]; }
            q += __shfl_xor(q, 1); q += __shfl_xor(q, 2); q += __shfl_xor(q, 4); q += __shfl_xor(q, 8); q += __shfl_xor(q, 16);
            const float rq = 1.0f / sqrtf(q * (1.0f / 256.0f) + EPS);
#pragma unroll
            for (int i = 0; i < 8; ++i) ys[i] = ys[i] * rq * args.in[I_SSDN][c0 + i];
            *(u32x4*)(MIX + (size_t)m * DM + 512 + c0) = pack8(ys);
        }
    }
    SEAM(5);

    if (IN(6)) {
        pg8::Gemm g{MIX, WOUT, MTOK, DM, DM}; pg8::StaticOrder S; S.init(MTOK, DM, G, bx);
        pg8::EpiRes E{args.in[I_X], dout, XNB, args.in[I_NORM_FFN0], nullptr, SS};
        pg8::gemm_phase(lds, g, S, E);
    }
    SEAM(6);
    if (IN(7)) {
        pg8::Gemm g{XNB, WGU, MTOK, 2 * FFN, DM}; pg8::StaticOrder S; S.init(MTOK, 2 * FFN, G, bx);
        pg8::EpiSwiglu E{HID, FFN, SS, nullptr};
        pg8::gemm_phase(lds, g, S, E);
    }
    SEAM(7);
    if (IN(8)) {
        pg8::Gemm g{HID, WDN, MTOK, DM, FFN}; pg8::StaticOrder S; S.init(MTOK, DM, G, bx);
        pg8::EpiRes E{dout, dout, XNB, args.in[I_NORM_MIX1], nullptr, SS};
        pg8::gemm_phase(lds, g, S, E);
    }
    SEAM(8);
    if (IN(9)) {
        pg8::Gemm g{XNB, WQKV, MTOK, 1536, DM}; pg8::StaticOrder S; S.init(MTOK, 1536, G, bx);
        pg8::EpiQkv E{QKV, SS, args.in[I_BQKV], args.in[I_QN], args.in[I_KN], ROPE};
        pg8::gemm_phase(lds, g, S, E);
    }
    SEAM(9);

    if (IN(10)) {
        LAS bf16_t* Kt = (LAS bf16_t*)lds; LAS bf16_t* Vt = (LAS bf16_t*)(lds + 36864);
        const int r32 = lane & 31, hh = lane >> 5;
        for (int unit = vcu; unit < BATCH * 4 * 32; unit += G) {
            const int blk = unit & 31, kvh = (unit >> 5) & 3, b = unit >> 7;
            {
                const int rowi = tid >> 1, half = tid & 1; const int tpos = (blk - 1) * 128 + rowi;
#pragma unroll
                for (int q = 0; q < 4; ++q) { u32x4 kv = (u32x4){0, 0, 0, 0}, vv = kv;
                    if (tpos >= 0) { const bf16_t* p = QKV + (size_t)(b * SEQ + tpos) * 1536 + 1024 + kvh * 64 + half * 32 + 8 * q; kv = *(const u32x4*)p; vv = *(const u32x4*)(p + 256); }
                    *(LAS u32x4*)(Kt + rowi * 72 + half * 32 + 8 * q) = kv; *(LAS u32x4*)(Vt + rowi * 72 + half * 32 + 8 * q) = vv; }
            }
            __syncthreads();
            const int gq = wave >> 1, qh = kvh * 4 + gq; const float sink = args.in[I_SINK][qh];
            for (int it = 0; it < 2; ++it) {
                const int qi = (wave & 1) * 64 + it * 32 + r32; const size_t mq = (size_t)b * SEQ + blk * 128 + qi;
                bf16x8 qr[4];
#pragma unroll
                for (int s = 0; s < 4; ++s) qr[s] = *(const bf16x8*)(QKV + mq * 1536 + qh * 64 + 16 * s + 8 * hh);
                const int a0 = (wave & 1) * 2 + it;
                f32x16 sc[5];
#pragma unroll
                for (int j = 0; j < 5; ++j) {
#pragma unroll
                    for (int r = 0; r < 16; ++r) sc[j][r] = 0.f;
#pragma unroll
                    for (int s = 0; s < 4; ++s) { const bf16x8 kf = *(const LAS bf16x8*)(Kt + (32 * (a0 + j) + r32) * 72 + 16 * s + 8 * hh); sc[j] = __builtin_amdgcn_mfma_f32_32x32x16_bf16(kf, qr[s], sc[j], 0, 0, 0); }
                }
                float mx = sink;
#pragma unroll
                for (int j = 0; j < 5; ++j)
#pragma unroll
                    for (int r = 0; r < 16; ++r) { const int kj = 32 * (a0 + j) + crow(r, hh); const bool valid = (kj > qi) && (kj <= qi + 128) && (blk > 0 || kj >= 128);
                        const float x = valid ? sc[j][r] * 0.125f : -1e30f; sc[j][r] = x; mx = fmaxf(mx, x); }
                mx = fmaxf(mx, __shfl_xor(mx, 32));
                float l = 0.f;
#pragma unroll
                for (int j = 0; j < 5; ++j)
#pragma unroll
                    for (int r = 0; r < 16; ++r) { const float p = __expf(sc[j][r] - mx); sc[j][r] = p; l += p; }
                l += __shfl_xor(l, 32); l += __expf(sink - mx);
                const float inv = 1.0f / l;
                f32x16 o[2];
#pragma unroll
                for (int dt = 0; dt < 2; ++dt)
#pragma unroll
                    for (int r = 0; r < 16; ++r) o[dt][r] = 0.f;
#pragma unroll
                for (int j = 0; j < 5; ++j)
#pragma unroll
                    for (int s2 = 0; s2 < 2; ++s2) {
                        u32x4 pw; pw.x = pk2(sc[j][8 * s2 + 0], sc[j][8 * s2 + 1]); pw.y = pk2(sc[j][8 * s2 + 2], sc[j][8 * s2 + 3]); pw.z = pk2(sc[j][8 * s2 + 4], sc[j][8 * s2 + 5]); pw.w = pk2(sc[j][8 * s2 + 6], sc[j][8 * s2 + 7]);
                        const bf16x8 pf = __builtin_bit_cast(bf16x8, pw);
                        const int key0 = 32 * (a0 + j) + 16 * s2 + 4 * hh + ((lane & 15) >> 2);
#pragma unroll
                        for (int dt = 0; dt < 2; ++dt) {
                            const LAS bf16_t* vp = Vt + key0 * 72 + 32 * dt + 16 * ((lane >> 4) & 1) + 4 * (lane & 3);
                            const s16x4 lo = __builtin_bit_cast(s16x4, __builtin_amdgcn_ds_read_tr16_b64_v4i16((LAS s16x4*)vp));
                            const s16x4 hi = __builtin_bit_cast(s16x4, __builtin_amdgcn_ds_read_tr16_b64_v4i16((LAS s16x4*)(vp + 8 * 72)));
                            const bf16x8 vf = (bf16x8){lo[0], lo[1], lo[2], lo[3], hi[0], hi[1], hi[2], hi[3]};
                            o[dt] = __builtin_amdgcn_mfma_f32_32x32x16_bf16(vf, pf, o[dt], 0, 0, 0);
                        }
                    }
                bf16_t* op = ATTO + mq * DM + qh * 64;
#pragma unroll
                for (int dt = 0; dt < 2; ++dt)
#pragma unroll
                    for (int rq = 0; rq < 4; ++rq) { u32x2 w; w.x = pk2(o[dt][4 * rq] * inv, o[dt][4 * rq + 1] * inv); w.y = pk2(o[dt][4 * rq + 2] * inv, o[dt][4 * rq + 3] * inv);
                        *(u32x2*)(op + 32 * dt + 8 * rq + 4 * hh) = w; }
            }
            __syncthreads();
        }
    }
    SEAM(10);

    if (IN(11)) {
        pg8::Gemm g{ATTO, WO, MTOK, DM, DM}; pg8::StaticOrder S; S.init(MTOK, DM, G, bx);
        pg8::EpiRes E{dout, dout, XNB, args.in[I_NORM_FFN1], args.in[I_BO], SS};
        pg8::gemm_phase(lds, g, S, E);
    }
    SEAM(11);

    if (IN(12)) {
        LAS float* w8 = (LAS float*)lds;
        for (int r = tid; r < DM; r += 512) { const float* p = args.in[I_ROUTER] + (size_t)r * 8; *(LAS f32x4*)(w8 + r * 8) = *(const f32x4*)p; *(LAS f32x4*)(w8 + r * 8 + 4) = *(const f32x4*)(p + 4); }
        __syncthreads();
        const float* gm = args.in[I_NORM_FFN1];
        for (int m = gw; m < MTOK; m += NGW) {
            const f32x4* xr = (const f32x4*)(dout + (size_t)m * DM) + lane;
            f32x4 v[4]; float s = 0.f;
#pragma unroll
            for (int j = 0; j < 4; ++j) { v[j] = xr[64 * j]; s += (v[j][0] * v[j][0] + v[j][1] * v[j][1]) + (v[j][2] * v[j][2] + v[j][3] * v[j][3]); }
            const float rstd = 1.0f / sqrtf(wave_sum(s) * (1.0f / DM) + EPS);
            float d[8];
#pragma unroll
            for (int k = 0; k < 8; ++k) d[k] = 0.f;
#pragma unroll
            for (int j = 0; j < 4; ++j) { const f32x4 g4 = ((const f32x4*)gm)[64 * j + lane]; const f32x4 y = v[j] * rstd * g4;
#pragma unroll
                for (int i = 0; i < 4; ++i) { const int c = 256 * j + 4 * lane + i; const f32x4 wa = *(const LAS f32x4*)(w8 + c * 8), wb = *(const LAS f32x4*)(w8 + c * 8 + 4);
                    d[0] += y[i] * wa[0]; d[1] += y[i] * wa[1]; d[2] += y[i] * wa[2]; d[3] += y[i] * wa[3]; d[4] += y[i] * wb[0]; d[5] += y[i] * wb[1]; d[6] += y[i] * wb[2]; d[7] += y[i] * wb[3]; } }
#pragma unroll
            for (int k = 0; k < 8; ++k) d[k] = wave_sum(d[k]);
            int e0 = 0; float v0 = d[0];
#pragma unroll
            for (int k = 1; k < 8; ++k) if (d[k] > v0) { v0 = d[k]; e0 = k; }
            int e1 = -1; float v1 = -3.0e38f;
#pragma unroll
            for (int k = 0; k < 8; ++k) if (k != e0 && d[k] > v1) { v1 = d[k]; e1 = k; }
            if (lane == 0) {
                const float w0 = 1.0f / (1.0f + __expf(v1 - v0));
                const unsigned r0 = atomicAdd(CNT + e0, 1u), r1 = atomicAdd(CNT + e1, 1u);
                TOPE[2 * m] = e0; TOPE[2 * m + 1] = e1; RANK[2 * m] = (int)r0; RANK[2 * m + 1] = (int)r1; TOPW[2 * m] = w0; TOPW[2 * m + 1] = 1.0f - w0; RSTD4[m] = rstd;
            }
        }
        __syncthreads();
    }
    SEAM(12);

    if (IN(13)) {
        int roff[NEXP]; { int t = 0;
#pragma unroll
            for (int e = 0; e < NEXP; ++e) { roff[e] = t; t += (int)((CNT[e] + 255u) >> 8) << 8; } }
        for (int j = gw; j < 2 * MTOK; j += NGW) {
            const int m = j >> 1, e = TOPE[j]; int ro = roff[0];
#pragma unroll
            for (int k = 1; k < NEXP; ++k) ro = (e == k) ? roff[k] : ro;
            const int pos = ro + RANK[j];
            const u32x4* src = (const u32x4*)(XNB + (size_t)m * DM) + lane; u32x4* dst = (u32x4*)(AS + (size_t)pos * DM) + lane;
            dst[0] = src[0]; dst[64] = src[64];
            if (lane == 0) { POS[j] = pos; RSTDS[pos] = RSTD4[m]; }
        }
    }
    SEAM(13);
    if (IN(14)) {
        pg8::Gemm g{AS, EGU, SROWS, 2 * FE, DM}; pg8::MoeOrder S; S.init(CNT, 2 * FE / 256, G, bx, (long)2 * FE * DM * 2);
        pg8::EpiSwiglu E{HS, FE, nullptr, RSTDS};
        pg8::gemm_phase(lds, g, S, E);
    }
    SEAM(14);
    if (IN(15)) {
        pg8::Gemm g{HS, EDN, SROWS, DM, FE}; pg8::MoeOrder S; S.init(CNT, DM / 256, G, bx, (long)DM * FE * 2);
        pg8::EpiBf16 E{AS, DM};
        pg8::gemm_phase(lds, g, S, E);
    }
    SEAM(15);
    if (IN(16)) {
        for (int m = gw; m < MTOK; m += NGW) {
            const int p0 = POS[2 * m], p1 = POS[2 * m + 1]; const float w0 = TOPW[2 * m], w1 = TOPW[2 * m + 1];
            const u32x4* y0 = (const u32x4*)(AS + (size_t)p0 * DM) + lane; const u32x4* y1 = (const u32x4*)(AS + (size_t)p1 * DM) + lane;
            f32x4* o = (f32x4*)(dout + (size_t)m * DM);
#pragma unroll
            for (int q = 0; q < 2; ++q) { float a[8], c[8]; unpack8(y0[64 * q], a); unpack8(y1[64 * q], c);
                f32x4 h0 = o[128 * q + 2 * lane], h1 = o[128 * q + 2 * lane + 1];
#pragma unroll
                for (int i = 0; i < 4; ++i) { h0[i] += w0 * a[i] + w1 * c[i]; h1[i] += w0 * a[4 + i] + w1 * c[4 + i]; }
                o[128 * q + 2 * lane] = h0; o[128 * q + 2 * lane + 1] = h1; }
        }
    }
#undef IN
#undef SEAM
}

#ifndef N_LAUNCH_SPLIT
#define N_LAUNCH_SPLIT 0
#endif
constexpr int NPHASE = 17;
extern "C" void kernel_launch(void* const* d_in, const int* in_sizes, int n_in, void* d_out, int out_size, void* d_ws, size_t ws_size, hipStream_t stream) {
    static int grid = 0;
    if (grid == 0) {
        if (n_in != 39 || out_size != MTOK * DM || ws_size < WS_END) { fprintf(stderr, "kernel_launch: unexpected shapes n_in %d out %d ws %zu\n", n_in, out_size, ws_size); grid = -1; return; }
        int dev = 0, cus = 0;
        if (hipGetDevice(&dev) != hipSuccess || hipDeviceGetAttribute(&cus, hipDeviceAttributeMultiprocessorCount, dev) != hipSuccess) { grid = -1; return; }
        if (hipFuncSetAttribute((const void*)fwd_kernel, hipFuncAttributeMaxDynamicSharedMemorySize, LDS_BYTES) != hipSuccess) { fprintf(stderr, "kernel_launch: hipFuncSetAttribute failed\n"); grid = -1; return; }
        int per_cu = 0; (void)hipOccupancyMaxActiveBlocksPerMultiprocessor(&per_cu, (const void*)fwd_kernel, 512, LDS_BYTES); (void)hipGetLastError();
        grid = 256; if (cus != 256 || per_cu < 1) fprintf(stderr, "kernel_launch: note: cus %d per_cu %d\n", cus, per_cu);
    }
    if (grid < 0) return;
    (void)hipMemsetAsync((char*)d_ws + WS_CTL, 0, CTL_ZERO_BYTES, stream);
    Args a{};
    a.in[0] = (const float*)d_in[0];
    for (int i = 2; i < 39; ++i) a.in[i - 1] = (const float*)d_in[i];
    a.pos = (const int*)d_in[1]; a.out = (float*)d_out; a.ws = (unsigned char*)d_ws;
#if N_LAUNCH_SPLIT
    for (int p = 0; p < NPHASE; ++p) { a.ph_lo = p; a.ph_hi = p + 1; hipLaunchKernelGGL(fwd_kernel, dim3(grid), dim3(512), LDS_BYTES, stream, a); }
#else
    a.ph_lo = 0; a.ph_hi = NPHASE;
    hipLaunchKernelGGL(fwd_kernel, dim3(grid), dim3(512), LDS_BYTES, stream, a);
#endif
}
```

```cpp
#include <hip/hip_runtime.h>
#include <cstdio>
#include <cstdint>

#define LAS __attribute__((address_space(3)))
#define GAS __attribute__((address_space(1)))
typedef unsigned short bf16_t;
typedef short bf16x8 __attribute__((ext_vector_type(8)));
typedef float f32x4 __attribute__((ext_vector_type(4)));
typedef float f32x2 __attribute__((ext_vector_type(2)));
typedef float f32x16 __attribute__((ext_vector_type(16)));
typedef unsigned u32x4 __attribute__((ext_vector_type(4)));
typedef unsigned u32x2 __attribute__((ext_vector_type(2)));
typedef short s16x4 __attribute__((ext_vector_type(4)));

constexpr int BATCH = 4, SEQ = 4096, DM = 1024, MTOK = BATCH * SEQ;
constexpr int IN0 = 3336, NPROJ = 3328;
constexpr int FFN = 2816, FE = 1408, NEXP = 8;
constexpr int SROWS = 2 * MTOK + NEXP * 256;
constexpr float EPS = 1e-6f;

constexpr size_t MiB = 1u << 20;
constexpr size_t WS_CTL = 0, CTL_ZERO_BYTES = 64 * 1024;
constexpr size_t WS_DTSP = 1 * MiB;
constexpr size_t WS_KKR = 1 * MiB + 512 * 1024;
constexpr size_t WS_ROPE = 2 * MiB;
constexpr size_t WS_SS = 3 * MiB;
constexpr size_t WS_TOPE = 4 * MiB;
constexpr size_t WS_RANK = 4 * MiB + 128 * 1024;
constexpr size_t WS_TOPW = 4 * MiB + 256 * 1024;
constexpr size_t WS_POS = 4 * MiB + 384 * 1024;
constexpr size_t WS_RSTD4 = 4 * MiB + 512 * 1024;
constexpr size_t WS_RSTDS = 4 * MiB + 640 * 1024;
constexpr size_t WS_WDEC = 5 * MiB;
constexpr size_t WS_WICL = 5 * MiB + 64 * 1024;
constexpr size_t WS_WGAT = 5 * MiB + 128 * 1024;
constexpr size_t WS_EGU = 6 * MiB;
constexpr size_t WS_EDN = 50 * MiB;
constexpr size_t WS_WIN = 72 * MiB;
constexpr size_t WS_WOUT = WS_WIN + (size_t)NPROJ * DM * 2;
constexpr size_t WS_WGU = WS_WOUT + 2 * MiB;
constexpr size_t WS_WDN = WS_WGU + 11 * MiB;
constexpr size_t WS_WQKV = WS_WDN + (size_t)DM * FFN * 2;
constexpr size_t WS_WO = WS_WQKV + 3 * MiB;
constexpr size_t R0 = 102 * MiB;
static_assert(WS_WO + 2 * MiB <= R0, "weights");
constexpr size_t WS_XN = R0, WS_MIX = R0;
constexpr size_t WS_PROJ = R0 + 32 * MiB;
constexpr size_t WS_GOUT = R0 + 136 * MiB;
constexpr size_t WS_XNB = R0 + 104 * MiB;
constexpr size_t WS_HID = R0;
constexpr size_t WS_QKV = R0;
constexpr size_t WS_ATTO = R0 + 48 * MiB;
constexpr size_t WS_AS = 72 * MiB;
constexpr size_t WS_HS = 140 * MiB;
constexpr size_t WS_END = 254 * MiB;
static_assert(WS_AS + (size_t)SROWS * DM * 2 <= WS_HS && WS_HS + (size_t)SROWS * FE * 2 <= WS_END && WS_GOUT + 16 * MiB <= WS_END, "map");
constexpr size_t DO_XBCC = 0, DO_DECAY = 32 * MiB, DO_ICLR = 48 * MiB;
constexpr int CW_BAR = 4096, CW_CNT = 8192;

constexpr int LDS_BYTES = 147456, RING_BYTES = 131072, MISC_OFF = LDS_BYTES - 128;

__device__ __forceinline__ unsigned f2bf(float f) { unsigned u = __builtin_bit_cast(unsigned, f); return (u + 0x7fffu + ((u >> 16) & 1u)) >> 16; }
typedef __bf16 bf16x2_t __attribute__((ext_vector_type(2)));
__device__ __forceinline__ unsigned pk2(float lo, float hi) { const f32x2 v = {lo, hi}; const bf16x2_t b = __builtin_convertvector(v, bf16x2_t); return __builtin_bit_cast(unsigned, b); }
__device__ __forceinline__ float bflo(unsigned u) { return __builtin_bit_cast(float, u << 16); }
__device__ __forceinline__ float bfhi(unsigned u) { return __builtin_bit_cast(float, u & 0xffff0000u); }
__device__ __forceinline__ void unpack8(const u32x4 v, float* f) { f[0] = bflo(v.x); f[1] = bfhi(v.x); f[2] = bflo(v.y); f[3] = bfhi(v.y); f[4] = bflo(v.z); f[5] = bfhi(v.z); f[6] = bflo(v.w); f[7] = bfhi(v.w); }
__device__ __forceinline__ u32x4 pack8(const float* f) { u32x4 v; v.x = pk2(f[0], f[1]); v.y = pk2(f[2], f[3]); v.z = pk2(f[4], f[5]); v.w = pk2(f[6], f[7]); return v; }
__device__ __forceinline__ float sigmoidf_(float x) { return 1.0f / (1.0f + __expf(-x)); }
__device__ __forceinline__ float siluf_(float x) { return x / (1.0f + __expf(-x)); }
__device__ __forceinline__ float wave_sum(float v) {
#pragma unroll
    for (int o = 1; o < 64; o <<= 1) v += __shfl_xor(v, o);
    return v;
}
__device__ __forceinline__ float dpp_sum63(float x) {
    int v;
    v = __builtin_amdgcn_update_dpp(0, __builtin_bit_cast(int, x), 0xB1, 0xF, 0xF, false); x += __builtin_bit_cast(float, v);
    v = __builtin_amdgcn_update_dpp(0, __builtin_bit_cast(int, x), 0x4E, 0xF, 0xF, false); x += __builtin_bit_cast(float, v);
    v = __builtin_amdgcn_update_dpp(0, __builtin_bit_cast(int, x), 0x141, 0xF, 0xF, false); x += __builtin_bit_cast(float, v);
    v = __builtin_amdgcn_update_dpp(0, __builtin_bit_cast(int, x), 0x140, 0xF, 0xF, false); x += __builtin_bit_cast(float, v);
    v = __builtin_amdgcn_update_dpp(0, __builtin_bit_cast(int, x), 0x142, 0xA, 0xF, false); x += __builtin_bit_cast(float, v);
    v = __builtin_amdgcn_update_dpp(0, __builtin_bit_cast(int, x), 0x143, 0xC, 0xF, false); x += __builtin_bit_cast(float, v);
    return __builtin_bit_cast(float, __builtin_amdgcn_readlane(__builtin_bit_cast(int, x), 63));
}
__device__ __forceinline__ int crow(int r, int hi) { return (r & 3) + 8 * (r >> 2) + 4 * hi; }
__device__ __forceinline__ constexpr int crc(int r) { return (r & 3) + 8 * (r >> 2); }

namespace pg8 {
constexpr int BM = 256, BK = 64, HALF = 128, HTB = HALF * BK * 2, NXCD = 8, WGM = 8;
__host__ __device__ __forceinline__ int lds_byte(int r, int c) { const int st = (r >> 4) * 2 + (c >> 5), rr = r & 15, cc = c & 31, ob = rr * 64 + cc * 2; return st * 1024 + (ob ^ (((ob >> 9) & 1) << 5)); }
__host__ __device__ __forceinline__ void stage_rc(int b, int& R, int& C) { const int st = b / 1024, sb = b % 1024, swz = sb ^ (((sb >> 9) & 1) << 5); R = (st >> 1) * 16 + swz / 64; C = (st & 1) * 32 + (swz % 64) / 2; }
__host__ __device__ __forceinline__ int perm32(int rho) { const int n = rho >> 4, i = rho & 15; return 8 * (i >> 2) + 4 * n + (i & 3); }
struct Unit { int pm, pn; long bofs; };
struct Gemm { const bf16_t* A; const bf16_t* Bt; int M, N, K; };
struct StaticOrder {
    int nM, nN, nwg, G, c;
    __device__ void init(int M, int N, int G_, int c_) { nM = M / BM; nN = N / BM; nwg = nM * nN; G = G_; c = c_; }
    __device__ bool next(int i, Unit& u) const {
        const long L = (long)i * G + c; if (L >= nwg) return false;
        int wgid = (int)L; { const int q = nwg / NXCD, r = nwg % NXCD, xcd = wgid % NXCD, off = wgid / NXCD; wgid = (xcd < r ? xcd * (q + 1) : r * (q + 1) + (xcd - r) * q) + off; }
        const int nig = WGM * nN, gid = wgid / nig, fm = gid * WGM, gsz = (nM - fm) < WGM ? (nM - fm) : WGM;
        u.pm = fm + ((wgid % nig) % gsz); u.pn = (wgid % nig) / gsz; u.bofs = 0; return true;
    }
};
struct MoeOrder {
    int toff[NEXP + 1]; int nN, G, c; long estride;
    __device__ void init(const unsigned* cnt, int nN_, int G_, int c_, long estride_) {
        nN = nN_; G = G_; c = c_; estride = estride_; int t = 0;
#pragma unroll
        for (int e = 0; e < NEXP; ++e) { toff[e] = t; t += (int)((cnt[e] + 255u) >> 8); }
        toff[NEXP] = t;
    }
    __device__ bool next(int i, Unit& u) const {
        const long L = (long)i * G + c; if (L >= (long)toff[NEXP] * nN) return false;
        const int pm = (int)(L / nN); u.pm = pm; u.pn = (int)(L % nN); int e = 0;
#pragma unroll
        for (int j = 1; j < NEXP; ++j) e += (pm >= toff[j]) ? 1 : 0;
        u.bofs = (long)e * estride; return true;
    }
};

template <class Epi, class Sched>
__device__ __forceinline__ void gemm_phase(LAS unsigned char* lds, const Gemm g, const Sched& S, const Epi& E) {
    constexpr bool ALIGN_EPI = true;
    const int tid = threadIdx.x, wid = __builtin_amdgcn_readfirstlane(tid >> 6), lane = tid & 63, wr = wid >> 2, wc = wid & 3, fr = lane & 15, fq = lane >> 4;
    const int K = g.K, nt = K / BK;
    unsigned voffA[2], voffB[2];
#pragma unroll
    for (int i = 0; i < 2; ++i) { int R, C; stage_rc(tid * 16 + i * 8192, R, C); const int Rb = Epi::PERM ? ((R & ~31) + perm32(R & 31)) : R;
        voffA[i] = (unsigned)(R * K + C) * 2u; voffB[i] = (unsigned)(Rb * K + C) * 2u; }
    const size_t kstep = (size_t)(BK * 2);
    const size_t hstep = (size_t)HALF * K * 2;
    const size_t tstep = 2 * hstep;
    const unsigned ldsw = (unsigned)wid * 1024u;
    const int aoff = lds_byte(wr * 64 + fr, fq * 8), boff = lds_byte(wc * 32 + fr, fq * 8);
#define PG8_SA(b, h) (((b) * 2 + (h)) * HTB)
#define PG8_SB(b, h) ((4 + (b) * 2 + (h)) * HTB)
#define PG8_STAGE(bufoff, gbase, voff) do { _Pragma("unroll") for (int _i = 0; _i < 2; ++_i) \
        __builtin_amdgcn_global_load_lds((const unsigned*)((const char*)(gbase) + (voff)[_i]), (LAS unsigned*)(lds + (bufoff) + ldsw + _i * 8192), 16, 0, 0); } while (0)
#define PG8_LDA(dst, b, h) do { _Pragma("unroll") for (int m = 0; m < 4; ++m) _Pragma("unroll") for (int k = 0; k < 2; ++k) dst[m][k] = *(const LAS bf16x8*)(lds + PG8_SA(b, h) + aoff + m * 2048 + k * 1024); } while (0)
#define PG8_LDB(dst, b, h) do { _Pragma("unroll") for (int n = 0; n < 2; ++n) _Pragma("unroll") for (int k = 0; k < 2; ++k) dst[n][k] = *(const LAS bf16x8*)(lds + PG8_SB(b, h) + boff + n * 2048 + k * 1024); } while (0)
#define PG8_MMA(ai, bj, At, Bt) do { __builtin_amdgcn_s_setprio(1); _Pragma("unroll") for (int m = 0; m < 4; ++m) _Pragma("unroll") for (int n = 0; n < 2; ++n) _Pragma("unroll") for (int k = 0; k < 2; ++k) \
        acc[ai][bj][m][n] = __builtin_amdgcn_mfma_f32_16x16x32_bf16(Bt[n][k], At[m][k], acc[ai][bj][m][n], 0, 0, 0); __builtin_amdgcn_s_setprio(0); } while (0)
#define PG8_WAIT_V(n) asm volatile("s_waitcnt vmcnt(" #n ")" ::: "memory")
#define PG8_WAIT_L(n) asm volatile("s_waitcnt lgkmcnt(" #n ")" ::: "memory")
#define PG8_BAR __builtin_amdgcn_s_barrier()
#define PG8_SCHED __builtin_amdgcn_sched_barrier(0)
    Unit cur, nxt; int ui = 0;
    if (!S.next(0, cur)) return;
    f32x4 acc[2][2][4][2];
#pragma unroll
    for (int a = 0; a < 2; ++a)
#pragma unroll
        for (int b = 0; b < 2; ++b)
#pragma unroll
            for (int m = 0; m < 4; ++m)
#pragma unroll
                for (int n = 0; n < 2; ++n) acc[a][b][m][n] = (f32x4){0.f, 0.f, 0.f, 0.f};
    bf16x8 At[4][2], B0[2][2], B1[2][2];
    const char* cA = (const char*)g.A + (size_t)cur.pm * tstep; const char* cB = (const char*)g.Bt + cur.bofs + (size_t)cur.pn * tstep;
    PG8_STAGE(PG8_SB(0, 0), cB, voffB); PG8_STAGE(PG8_SB(0, 1), cB + hstep, voffB); PG8_STAGE(PG8_SA(0, 0), cA, voffA); PG8_STAGE(PG8_SA(0, 1), cA + hstep, voffA);
    if (wr == 1) PG8_BAR;
    PG8_WAIT_V(2); PG8_BAR;
    PG8_STAGE(PG8_SB(1, 0), cB + kstep, voffB); PG8_STAGE(PG8_SA(1, 0), cA + kstep, voffA); PG8_STAGE(PG8_SB(1, 1), cB + hstep + kstep, voffB);
    PG8_WAIT_V(6); PG8_BAR;
    for (;;) {
        const bool has_next = S.next(ui + 1, nxt);
        const char* nA = has_next ? (const char*)g.A + (size_t)nxt.pm * tstep : cA; const char* nB = has_next ? (const char*)g.Bt + nxt.bofs + (size_t)nxt.pn * tstep : cB;
        for (int t = 0; t < nt; t += 2) {
            const bool last = (t == nt - 2);
            const char* a1 = cA + (size_t)(t + 1) * kstep;
            const char* a2 = last ? nA : cA + (size_t)(t + 2) * kstep; const char* b2 = last ? nB : cB + (size_t)(t + 2) * kstep;
            const char* a3 = a2 + kstep; const char* b3 = b2 + kstep;
            PG8_LDB(B0, 0, 0); PG8_LDB(B1, 0, 1); PG8_SCHED; PG8_LDA(At, 0, 0); PG8_STAGE(PG8_SA(1, 1), a1 + hstep, voffA);
            PG8_WAIT_V(8); PG8_WAIT_L(0); PG8_BAR; PG8_MMA(0, 0, At, B0); PG8_MMA(0, 1, At, B1); PG8_BAR; PG8_SCHED;
            PG8_LDA(At, 0, 1); PG8_STAGE(PG8_SB(0, 0), b2, voffB); PG8_STAGE(PG8_SB(0, 1), b2 + hstep, voffB); PG8_STAGE(PG8_SA(0, 0), a2, voffA);
            PG8_WAIT_V(8); PG8_WAIT_L(0); PG8_BAR; PG8_MMA(1, 0, At, B0); PG8_MMA(1, 1, At, B1); PG8_BAR; PG8_SCHED;
            PG8_LDB(B0, 1, 0); PG8_LDB(B1, 1, 1); PG8_SCHED; PG8_LDA(At, 1, 0); PG8_STAGE(PG8_SA(0, 1), a2 + hstep, voffA);
            PG8_WAIT_V(8); PG8_WAIT_L(0); PG8_BAR; PG8_MMA(0, 0, At, B0); PG8_MMA(0, 1, At, B1); PG8_BAR; PG8_SCHED;
            PG8_LDA(At, 1, 1); PG8_STAGE(PG8_SB(1, 0), b3, voffB); PG8_STAGE(PG8_SB(1, 1), b3 + hstep, voffB); PG8_STAGE(PG8_SA(1, 0), a3, voffA);
            PG8_WAIT_V(8); PG8_WAIT_L(0); PG8_BAR; PG8_MMA(1, 0, At, B0); PG8_MMA(1, 1, At, B1); PG8_BAR; PG8_SCHED;
        }
        if constexpr (ALIGN_EPI) { if (wr == 0) PG8_BAR; }
        E(acc, cur, wr, wc, fr, fq);
        if (!has_next) break;
#pragma unroll
        for (int a = 0; a < 2; ++a)
#pragma unroll
            for (int b = 0; b < 2; ++b)
#pragma unroll
                for (int m = 0; m < 4; ++m)
#pragma unroll
                    for (int n = 0; n < 2; ++n) acc[a][b][m][n] = (f32x4){0.f, 0.f, 0.f, 0.f};
        cur = nxt; cA = nA; cB = nB; ++ui;
        if constexpr (ALIGN_EPI) { if (wr == 1) PG8_BAR; }
    }
    PG8_WAIT_V(0);
    if constexpr (!ALIGN_EPI) { if (wr == 0) PG8_BAR; }
    PG8_BAR;
#undef PG8_SA
#undef PG8_SB
#undef PG8_STAGE
#undef PG8_LDA
#undef PG8_LDB
#undef PG8_MMA
#undef PG8_WAIT_V
#undef PG8_WAIT_L
#undef PG8_BAR
#undef PG8_SCHED
}

struct EpiBf16 {
    static constexpr bool PERM = true;
    bf16_t* O; int ldc;
    __device__ __forceinline__ void operator()(const f32x4 (&acc)[2][2][4][2], const Unit& u, int wr, int wc, int fr, int fq) const {
        const int row0 = u.pm * BM + wr * 64 + fr, col0 = u.pn * BM + wc * 32 + 8 * fq;
#pragma unroll
        for (int ai = 0; ai < 2; ++ai)
#pragma unroll
            for (int m = 0; m < 4; ++m) { bf16_t* rowp = O + (size_t)(row0 + ai * HALF + m * 16) * ldc + col0;
#pragma unroll
                for (int bj = 0; bj < 2; ++bj) { const f32x4 v0 = acc[ai][bj][m][0], v1 = acc[ai][bj][m][1];
                    u32x4 w; w.x = pk2(v0[0], v0[1]); w.y = pk2(v0[2], v0[3]); w.z = pk2(v1[0], v1[1]); w.w = pk2(v1[2], v1[3]);
                    *(u32x4*)(rowp + bj * HALF) = w; } }
    }
};
struct EpiRes {
    static constexpr bool PERM = false;
    const float* base; float* out; bf16_t* xn; const float* gw; const float* bias; float* ss;
    __device__ __forceinline__ void operator()(const f32x4 (&acc)[2][2][4][2], const Unit& u, int wr, int wc, int fr, int fq) const {
        const int col0 = u.pn * BM + wc * 32 + 4 * fq;
        f32x4 gv[2][2], bv[2][2];
#pragma unroll
        for (int bj = 0; bj < 2; ++bj)
#pragma unroll
            for (int n = 0; n < 2; ++n) { gv[bj][n] = *(const f32x4*)(gw + col0 + bj * HALF + n * 16); bv[bj][n] = bias ? *(const f32x4*)(bias + col0 + bj * HALF + n * 16) : (f32x4){0.f, 0.f, 0.f, 0.f}; }
#pragma unroll
        for (int ai = 0; ai < 2; ++ai)
#pragma unroll
            for (int m = 0; m < 4; ++m) { const int row = u.pm * BM + ai * HALF + wr * 64 + m * 16 + fr; const size_t off = (size_t)row * DM + col0; float s = 0.f;
#pragma unroll
                for (int bj = 0; bj < 2; ++bj)
#pragma unroll
                    for (int n = 0; n < 2; ++n) { const f32x4 bs = *(const f32x4*)(base + off + bj * HALF + n * 16); const f32x4 o = bs + acc[ai][bj][m][n] + bv[bj][n];
                        *(f32x4*)(out + off + bj * HALF + n * 16) = o; s += (o[0] * o[0] + o[1] * o[1]) + (o[2] * o[2] + o[3] * o[3]);
                        const f32x4 x = o * gv[bj][n]; u32x2 w; w.x = pk2(x[0], x[1]); w.y = pk2(x[2], x[3]); *(u32x2*)(xn + off + bj * HALF + n * 16) = w; }
                s += __shfl_xor(s, 16); s += __shfl_xor(s, 32);
                if (fq == 0) ss[(size_t)row * 16 + u.pn * 4 + wc] = s; }
    }
};
__device__ __forceinline__ float rstd_from_ss(const float* ss, int row) {
    const f32x4* p = (const f32x4*)(ss + (size_t)row * 16); const f32x4 a = p[0], b = p[1], c = p[2], d = p[3];
    const float t = ((a[0] + a[1]) + (a[2] + a[3])) + ((b[0] + b[1]) + (b[2] + b[3])) + ((c[0] + c[1]) + (c[2] + c[3])) + ((d[0] + d[1]) + (d[2] + d[3]));
    return 1.0f / sqrtf(t * (1.0f / DM) + EPS);
}
struct EpiSwiglu {
    static constexpr bool PERM = true;
    bf16_t* O; int ldc; const float* ss; const float* rstd;
    __device__ __forceinline__ void operator()(const f32x4 (&acc)[2][2][4][2], const Unit& u, int wr, int wc, int fr, int fq) const {
        const int row0 = u.pm * BM + wr * 64 + fr, col0 = u.pn * HALF + wc * 32 + 8 * fq;
#pragma unroll
        for (int ai = 0; ai < 2; ++ai)
#pragma unroll
            for (int m = 0; m < 4; ++m) { const int row = row0 + ai * HALF + m * 16; const float rs = ss ? rstd_from_ss(ss, row) : rstd[row];
                float h[8];
#pragma unroll
                for (int n = 0; n < 2; ++n)
#pragma unroll
                    for (int i = 0; i < 4; ++i) { const float gg = acc[ai][0][m][n][i] * rs, uu = acc[ai][1][m][n][i] * rs; h[n * 4 + i] = siluf_(gg) * uu; }
                *(u32x4*)(O + (size_t)row * ldc + col0) = pack8(h); }
    }
};
struct EpiQkv {
    static constexpr bool PERM = true;
    bf16_t* O; const float* ss; const float* bias; const float* qn; const float* kn; const float* rope;
    __device__ __forceinline__ void operator()(const f32x4 (&acc)[2][2][4][2], const Unit& u, int wr, int wc, int fr, int fq) const {
        const int hd = u.pn * 4 + wc, row0 = u.pm * BM + wr * 64 + fr; const int kind = u.pn < 4 ? 0 : (u.pn == 4 ? 1 : 2);
        const float* nw = kind == 0 ? qn : kn;
        float bv[2][8], nv[2][8];
#pragma unroll
        for (int bj = 0; bj < 2; ++bj)
#pragma unroll
            for (int j = 0; j < 8; ++j) { bv[bj][j] = bias[hd * 64 + bj * 32 + fq * 8 + j]; nv[bj][j] = nw[bj * 32 + fq * 8 + j]; }
#pragma unroll
        for (int ai = 0; ai < 2; ++ai)
#pragma unroll
            for (int m = 0; m < 4; ++m) { const int row = row0 + ai * HALF + m * 16; const float rs = rstd_from_ss(ss, row);
                float v[2][8]; float s = 0.f;
#pragma unroll
                for (int bj = 0; bj < 2; ++bj)
#pragma unroll
                    for (int n = 0; n < 2; ++n)
#pragma unroll
                        for (int i = 0; i < 4; ++i) { const float x = acc[ai][bj][m][n][i] * rs + bv[bj][n * 4 + i]; v[bj][n * 4 + i] = x; s += x * x; }
                if (kind < 2) {
                    s += __shfl_xor(s, 16); s += __shfl_xor(s, 32);
                    const float r2 = 1.0f / sqrtf(s * (1.0f / 64.0f) + EPS);
#pragma unroll
                    for (int bj = 0; bj < 2; ++bj)
#pragma unroll
                        for (int j = 0; j < 8; ++j) v[bj][j] = v[bj][j] * r2 * nv[bj][j];
                    const f32x4* rp = (const f32x4*)(rope + (size_t)row * 16);
                    const f32x4 c0 = rp[0], c1 = rp[1], s0 = rp[2], s1 = rp[3];
#pragma unroll
                    for (int j = 0; j < 8; ++j) { const float other = __shfl_xor(v[0][j], 16); const float cc = j < 4 ? c0[j] : c1[j - 4], sn = j < 4 ? s0[j] : s1[j - 4];
                        const float mine = v[0][j]; const float rot = (fq == 0) ? (mine * cc - other * sn) : (mine * cc + other * sn);
                        v[0][j] = (fq < 2) ? rot : mine; }
                }
#pragma unroll
                for (int bj = 0; bj < 2; ++bj) *(u32x4*)(O + (size_t)row * 1536 + hd * 64 + bj * 32 + fq * 8) = pack8(v[bj]);
            }
    }
};
}

#define XB_TMO      128
#define XB_XCNT(j)  (256  + 64 * (j))
#define XB_XSUB(j)  (1280 + 64 * (j))
#define XB_XGEN(j)  (2304 + 64 * (j))
#define XB_TOP      3328
#define XB_TOPGEN   3392
#define XCD_BAR_WORDS 3456
#define XB_SPIN_CAP (1u << 20)
__device__ __forceinline__ unsigned xb_ld(unsigned* p)              { return __hip_atomic_load(p, __ATOMIC_RELAXED, __HIP_MEMORY_SCOPE_AGENT); }
__device__ __forceinline__ unsigned xb_add(unsigned* p, unsigned v) { return __hip_atomic_fetch_add(p, v, __ATOMIC_RELAXED, __HIP_MEMORY_SCOPE_AGENT); }
__device__ __forceinline__ unsigned xb_xcc_id() { return (unsigned)__builtin_amdgcn_s_getreg((3 << 11) | 20) & 0xFu; }
#define XB_SPIN(cond, bar) do { unsigned _sp = 0; while (cond) { __builtin_amdgcn_s_sleep(1); \
    if ((++_sp & 255u) == 0u) { if (xb_ld(&(bar)[XB_TMO])) break; if (_sp > XB_SPIN_CAP) { atomicAdd(&(bar)[XB_TMO], 1u); break; } } } } while (0)
struct XcdBarrier { unsigned* bar; unsigned x; volatile LAS unsigned* st; };
__device__ __forceinline__ XcdBarrier xcd_barrier_post(unsigned* bar, volatile LAS unsigned* st) {
    XcdBarrier b; b.bar = bar; b.x = xb_xcc_id(); b.st = st;
    if (threadIdx.x == 0) (void)xb_add(&bar[XB_XCNT(b.x)], 1u);
    return b;
}
__device__ __forceinline__ void xcd_barrier_complete(unsigned* bar, unsigned x, unsigned& nloc, unsigned& nx) {
    const unsigned G = gridDim.x * gridDim.y * gridDim.z;
    unsigned sum, cnt, mine, sp = 0u;
    for (;;) {
        sum = 0u; cnt = 0u; mine = 0u;
#pragma unroll
        for (unsigned j = 0; j < 16; ++j) { const unsigned c = xb_ld(&bar[XB_XCNT(j)]); sum += c; cnt += (c > 0u) ? 1u : 0u; mine = (j == x) ? c : mine; }
        if (sum == G) break;
        __builtin_amdgcn_s_sleep(1);
        if ((++sp & 255u) == 0u) { if (xb_ld(&bar[XB_TMO])) break; if (sp > XB_SPIN_CAP) { atomicAdd(&bar[XB_TMO], 1u); break; } }
    }
    nloc = mine > 0u ? mine : 1u; nx = cnt > 0u ? cnt : 1u;
}
__device__ __forceinline__ void xcd_barrier(const XcdBarrier& b) {
    asm volatile("s_waitcnt vmcnt(0)" ::: "memory");
    __syncthreads();
    if (threadIdx.x == 0) {
        unsigned* bar = b.bar;
        __builtin_amdgcn_s_waitcnt(0);
        unsigned nloc = b.st[0], nx = b.st[1];
        if (nloc == 0u) { xcd_barrier_complete(bar, b.x, nloc, nx); b.st[0] = nloc; b.st[1] = nx; }
        const unsigned old = xb_add(&bar[XB_XSUB(b.x)], 1u);
        const unsigned gen = old / nloc;
        if (old + 1u == (gen + 1u) * nloc) {
            __builtin_amdgcn_fence(__ATOMIC_RELEASE, "agent");
            asm volatile("s_waitcnt vmcnt(0)" ::: "memory");
            const unsigned og = xb_add(&bar[XB_TOP], 1u);
            const unsigned tg = og / nx;
            if (og + 1u == (tg + 1u) * nx) xb_add(&bar[XB_TOPGEN], 1u);
            else XB_SPIN(xb_ld(&bar[XB_TOPGEN]) == tg, bar);
            __builtin_amdgcn_fence(__ATOMIC_ACQUIRE, "agent");
            xb_add(&bar[XB_XGEN(b.x)], 1u);
            asm volatile("s_waitcnt vmcnt(0)" ::: "memory");
        } else {
            XB_SPIN(xb_ld(&bar[XB_XGEN(b.x)]) == gen, bar);
            __builtin_amdgcn_fence(__ATOMIC_ACQUIRE, "agent");
            asm volatile("s_waitcnt vmcnt(0)" ::: "memory");
        }
    }
    __syncthreads();
}

struct Args { const float* in[39]; const int* pos; float* out; unsigned char* ws; int ph_lo, ph_hi; };
enum InIdx { I_X = 0, I_NORM_MIX0 = 1, I_W_IN, I_MU, I_W0, I_WDEC, I_A0, I_WICL, I_WGAT, I_KK, I_KA, I_RK, I_GNW, I_GNB, I_CONVW, I_CONVB, I_DTB, I_ALOG, I_DSKIP, I_SSDN,
             I_WOUT, I_NORM_FFN0, I_FG, I_FU, I_FD, I_NORM_MIX1, I_WQKV, I_BQKV, I_QN, I_KN, I_SINK, I_WO, I_BO, I_NORM_FFN1, I_ROUTER, I_EG, I_EU, I_ED };

__device__ __forceinline__ void transpose_item(const float* W, int ld, int K, int k0, int n0, bf16_t* WT, int drow, LAS float* scr, int lane) {
#pragma unroll 8
    for (int i = 0; i < 32; ++i) { const int kk = 2 * i + (lane >> 5); scr[kk * 33 + (lane & 31)] = W[(size_t)(k0 + kk) * ld + n0 + (lane & 31)]; }
    asm volatile("s_waitcnt lgkmcnt(0)" ::: "memory");
    const int c = lane & 7;
#pragma unroll
    for (int j = 0; j < 4; ++j) { const int n = (lane >> 3) + 8 * j; const LAS float* s = scr + (8 * c) * 33 + n;
        u32x4 o; o.x = pk2(s[0 * 33], s[1 * 33]); o.y = pk2(s[2 * 33], s[3 * 33]); o.z = pk2(s[4 * 33], s[5 * 33]); o.w = pk2(s[6 * 33], s[7 * 33]);
        *(u32x4*)(WT + (size_t)(drow + n) * K + k0 + 8 * c) = o; }
    asm volatile("s_waitcnt lgkmcnt(0)" ::: "memory");
}
__device__ __forceinline__ int drow_of(int kind, int n0) {
    if (kind == 0) return n0;
    if (kind == 1) return 256 * (n0 >> 7) + (n0 & 127);
    if (kind == 2) return 256 * (n0 >> 7) + 128 + (n0 & 127);
    const int hd = n0 >> 6, bj = (n0 >> 5) & 1; return 256 * (hd >> 2) + 128 * bj + 32 * (hd & 3);
}
__device__ __forceinline__ bool transpose_matrix(int& it, const float* W, int ld, int K, int ncols, bf16_t* WT, int kind, LAS float* scr, int lane) {
    const int nnb = ncols / 32, items = (K / 64) * nnb;
    if (it < items) { const int kb = it / nnb, nb = it % nnb; transpose_item(W, ld, K, 64 * kb, 32 * nb, WT, drow_of(kind, 32 * nb), scr, lane); return true; }
    it -= items; return false;
}

#ifndef DUPM
#define DUPM 0u
#endif

#define XN ((bf16_t*)(ws + WS_XN))
#define MIX ((bf16_t*)(ws + WS_MIX))
#define PROJ ((bf16_t*)(ws + WS_PROJ))
#define GOUT ((bf16_t*)(ws + WS_GOUT))
#define XNB ((bf16_t*)(ws + WS_XNB))
#define HID ((bf16_t*)(ws + WS_HID))
#define QKV ((bf16_t*)(ws + WS_QKV))
#define ATTO ((bf16_t*)(ws + WS_ATTO))
#define AS ((bf16_t*)(ws + WS_AS))
#define HS ((bf16_t*)(ws + WS_HS))
#define XBCC ((bf16_t*)(ws + WS_EGU))
#define DTSP ((float*)(ws + WS_DTSP))
#define KKR ((float*)(ws + WS_KKR))
#define ROPE ((float*)(ws + WS_ROPE))
#define SS ((float*)(ws + WS_SS))
#define TOPE ((int*)(ws + WS_TOPE))
#define RANK ((int*)(ws + WS_RANK))
#define TOPW ((float*)(ws + WS_TOPW))
#define POS ((int*)(ws + WS_POS))
#define RSTD4 ((float*)(ws + WS_RSTD4))
#define RSTDS ((float*)(ws + WS_RSTDS))
#define WDEC ((bf16_t*)(ws + WS_WDEC))
#define WICL ((bf16_t*)(ws + WS_WICL))
#define WGAT ((bf16_t*)(ws + WS_WGAT))
#define EGU ((bf16_t*)(ws + WS_EGU))
#define EDN ((bf16_t*)(ws + WS_EDN))
#define WIN ((bf16_t*)(ws + WS_WIN))
#define WOUT ((bf16_t*)(ws + WS_WOUT))
#define WGU ((bf16_t*)(ws + WS_WGU))
#define WDN ((bf16_t*)(ws + WS_WDN))
#define WQKV ((bf16_t*)(ws + WS_WQKV))
#define WO ((bf16_t*)(ws + WS_WO))
__global__ void __launch_bounds__(512, 2) fwd_kernel(Args args) {
    extern __shared__ __attribute__((aligned(16))) unsigned char lds_raw[];
    LAS unsigned char* lds = (LAS unsigned char*)lds_raw;
    volatile LAS unsigned* MISC = (volatile LAS unsigned*)(lds + MISC_OFF);
    const int tid = threadIdx.x, lane = tid & 63, wave = __builtin_amdgcn_readfirstlane(tid >> 6);
    const int G = gridDim.x, bx = blockIdx.x;
    const int vcu = (G % 8 == 0) ? (bx % 8) * (G / 8) + bx / 8 : bx;
    unsigned char* ws = args.ws;
    unsigned* ctl = (unsigned*)(ws + WS_CTL);
    float* dout = args.out;
    if (tid < 32) ((LAS unsigned*)(lds + MISC_OFF))[tid] = 0u;
    __syncthreads();
    XcdBarrier bar = xcd_barrier_post(ctl + CW_BAR, MISC + 8);
    const int lo = args.ph_lo, hi = args.ph_hi;
#define IN(k) (lo <= (k) && (k) < hi)
#if DUPM
#define PHASE(k) for (int rep_ = 0; rep_ <= (int)((DUPM >> (k)) & 1u); ++rep_) if (IN(k))
#define REPBAR if (rep_) xcd_barrier(bar);
#else
#define PHASE(k) if (IN(k))
#define REPBAR
#endif
#define SEAM(k) do { if (IN(k) && IN((k) + 1)) xcd_barrier(bar); } while (0)
    const int gw = vcu * 8 + wave, NGW = G * 8;

    unsigned* CNT = ctl + CW_CNT;

    PHASE(0) { REPBAR
        LAS float* scr = (LAS float*)(lds + wave * 16384);
        for (int it0 = gw; ; it0 += NGW) {
            int it = it0;
            if (transpose_matrix(it, args.in[I_W_IN], IN0, DM, NPROJ, WIN, 0, scr, lane)) continue;
            if (transpose_matrix(it, args.in[I_WOUT], DM, DM, DM, WOUT, 0, scr, lane)) continue;
            if (transpose_matrix(it, args.in[I_FG], FFN, DM, FFN, WGU, 1, scr, lane)) continue;
            if (transpose_matrix(it, args.in[I_FU], FFN, DM, FFN, WGU, 2, scr, lane)) continue;
            if (transpose_matrix(it, args.in[I_FD], DM, FFN, DM, WDN, 0, scr, lane)) continue;
            if (transpose_matrix(it, args.in[I_WQKV], 1536, DM, 1536, WQKV, 3, scr, lane)) continue;
            if (transpose_matrix(it, args.in[I_WO], DM, DM, DM, WO, 0, scr, lane)) continue;
            if (transpose_matrix(it, args.in[I_WDEC], 512, 64, 512, WDEC, 0, scr, lane)) continue;
            if (transpose_matrix(it, args.in[I_WICL], 512, 64, 512, WICL, 0, scr, lane)) continue;
            if (transpose_matrix(it, args.in[I_WGAT], 512, 128, 512, WGAT, 0, scr, lane)) continue;
            break;
        }
        __syncthreads();
        LAS float* w8 = (LAS float*)lds;
        for (int r = tid; r < DM; r += 512) { const float* p = args.in[I_W_IN] + (size_t)r * IN0 + NPROJ; *(LAS f32x4*)(w8 + r * 8) = *(const f32x4*)p; *(LAS f32x4*)(w8 + r * 8 + 4) = *(const f32x4*)(p + 4); }
        __syncthreads();
        const float* gm = args.in[I_NORM_MIX0];
        for (int m = gw; m < MTOK; m += NGW) {
            const f32x4* xr = (const f32x4*)(args.in[I_X] + (size_t)m * DM) + lane;
            f32x4 v[4]; float s = 0.f;
#pragma unroll
            for (int j = 0; j < 4; ++j) { v[j] = xr[64 * j]; s += (v[j][0] * v[j][0] + v[j][1] * v[j][1]) + (v[j][2] * v[j][2] + v[j][3] * v[j][3]); }
            const float rstd = 1.0f / sqrtf(wave_sum(s) * (1.0f / DM) + EPS);
            float d[8];
#pragma unroll
            for (int k = 0; k < 8; ++k) d[k] = 0.f;
            unsigned long long* o8 = (unsigned long long*)(XN + (size_t)m * DM) + lane;
#pragma unroll
            for (int j = 0; j < 4; ++j) { const f32x4 g4 = ((const f32x4*)gm)[64 * j + lane]; const f32x4 y = v[j] * rstd * g4;
                o8[64 * j] = (unsigned long long)pk2(y[0], y[1]) | ((unsigned long long)pk2(y[2], y[3]) << 32);
#pragma unroll
                for (int i = 0; i < 4; ++i) { const int c = 256 * j + 4 * lane + i; const f32x4 wa = *(const LAS f32x4*)(w8 + c * 8), wb = *(const LAS f32x4*)(w8 + c * 8 + 4);
                    d[0] += y[i] * wa[0]; d[1] += y[i] * wa[1]; d[2] += y[i] * wa[2]; d[3] += y[i] * wa[3]; d[4] += y[i] * wb[0]; d[5] += y[i] * wb[1]; d[6] += y[i] * wb[2]; d[7] += y[i] * wb[3]; } }
#pragma unroll
            for (int k = 0; k < 8; ++k) d[k] = wave_sum(d[k]);
            if (lane < 8) { float dv = d[0];
#pragma unroll
                for (int k = 1; k < 8; ++k) dv = (lane == k) ? d[k] : dv;
                const float z = dv + args.in[I_DTB][lane]; DTSP[(size_t)m * 8 + lane] = z > 20.f ? z : log1pf(__expf(z)); }
            if (lane >= 16 && lane < 24) { const int j = lane - 16; const double inv = exp(-(double)j * 0.125 * 13.122363377404328); const double ang = (double)args.pos[m] * inv;
                ROPE[(size_t)m * 16 + j] = (float)cos(ang); ROPE[(size_t)m * 16 + 8 + j] = (float)sin(ang); }
        }
        __syncthreads();
    }
    SEAM(0);

    PHASE(1) { REPBAR
        pg8::Gemm g{XN, WIN, MTOK, NPROJ, DM}; pg8::StaticOrder S; S.init(MTOK, NPROJ, G, bx);
        pg8::EpiBf16 E{PROJ, NPROJ};
        pg8::gemm_phase(lds, g, S, E);
    }
    SEAM(1);

    PHASE(2) { REPBAR
        const float* mu = args.in[I_MU];
        LAS bf16_t* Aw = (LAS bf16_t*)lds; LAS bf16_t* Aa = (LAS bf16_t*)(lds + 9216); LAS bf16_t* Ag = (LAS bf16_t*)(lds + 18432);
        LAS float* LW = (LAS float*)(lds + 35840); LAS float* IC = LW + 4096;
        LAS bf16_t* At = (LAS bf16_t*)(lds + 68864); LAS bf16_t* Kt = At + 4608; LAS bf16_t* Bt = Kt + 4608; LAS bf16_t* Rt = Bt + 4608; LAS bf16_t* Vt = Rt + 4608;
        LAS bf16_t* XX = At;
        LAS bf16_t* Lak = (LAS bf16_t*)(lds + 114944); LAS bf16_t* Mrk = Lak + 4608; LAS bf16_t* Mrb = Mrk + 4608;
        LAS float* TOT = (LAS float*)(lds + 142592); LAS float* GAMC = TOT + 512;
        const int r32 = lane & 31, hh = lane >> 5, mt = (wave >> 1) & 1, nt = wave & 1, grp = wave >> 2;
        const int trq = (lane & 15) >> 2, trc = 16 * ((lane >> 4) & 1) + 4 * (lane & 3);
#define TRF(M, P, s, blk) ({ const LAS bf16_t* p_ = (M) + (16 * (s) + 8 * hh + trq) * (P) + 32 * (blk) + trc; \
        const s16x4 lo_ = __builtin_bit_cast(s16x4, __builtin_amdgcn_ds_read_tr16_b64_v4i16((LAS s16x4*)p_)); \
        const s16x4 hi_ = __builtin_bit_cast(s16x4, __builtin_amdgcn_ds_read_tr16_b64_v4i16((LAS s16x4*)(p_ + 4 * (P)))); \
        (bf16x8){lo_[0], lo_[1], lo_[2], lo_[3], hi_[0], hi_[1], hi_[2], hi_[3]}; })
#define NATF(M, P, s, blk) (*(const LAS bf16x8*)((M) + (32 * (blk) + r32) * (P) + 16 * (s) + 8 * hh))
        for (int unit = vcu; unit < MTOK / 64; unit += G) {
            const int m0 = unit * 64;
            {
                const int tt = tid >> 3, cg = tid & 7, m = m0 + tt; const bool hasprev = (m & (SEQ - 1)) != 0;
                const bf16_t* pc = PROJ + (size_t)m * NPROJ + 1536 + 32 * cg;
#pragma unroll 1
                for (int q = 0; q < 4; ++q) {
                    float c[8], p[8]; unpack8(*(const u32x4*)(pc + 8 * q), c);
                    if (hasprev) unpack8(*(const u32x4*)(pc - NPROJ + 8 * q), p); else { for (int i = 0; i < 8; ++i) p[i] = 0.f; }
                    float o[8];
#pragma unroll
                    for (int i = 0; i < 8; ++i) { const int col = 32 * cg + 8 * q + i; const float x = c[i] + (p[i] - c[i]) * mu[1536 + col];
                        o[i] = cg < 2 ? tanhf(x) : (cg < 4 ? x : sigmoidf_(x)); }
                    const u32x4 w = pack8(o); const int col0 = 32 * cg + 8 * q;
                    if (cg < 2) *(LAS u32x4*)(Aw + tt * 72 + col0) = w; else if (cg < 4) *(LAS u32x4*)(Aa + tt * 72 + (col0 - 64)) = w; else *(LAS u32x4*)(Ag + tt * 136 + (col0 - 128)) = w;
                }
            }
            __syncthreads();
#pragma unroll 1
            for (int h = 0; h < 8; ++h) {
                unsigned char* cs = (unsigned char*)dout + (size_t)(unit * 8 + h) * 24576;
                if (grp == 0) {
                    f32x16 ad, ai;
#pragma unroll
                    for (int r = 0; r < 16; ++r) { ad[r] = 0.f; ai[r] = 0.f; }
#pragma unroll
                    for (int s = 0; s < 4; ++s) {
                        const bf16x8 bd = *(const bf16x8*)(WDEC + (size_t)(64 * h + 32 * nt + r32) * 64 + 16 * s + 8 * hh), bi = *(const bf16x8*)(WICL + (size_t)(64 * h + 32 * nt + r32) * 64 + 16 * s + 8 * hh);
                        ad = __builtin_amdgcn_mfma_f32_32x32x16_bf16(NATF(Aw, 72, s, mt), bd, ad, 0, 0, 0);
                        ai = __builtin_amdgcn_mfma_f32_32x32x16_bf16(NATF(Aa, 72, s, mt), bi, ai, 0, 0, 0);
                    }
                    const int c = 32 * nt + r32; const float w0c = args.in[I_W0][64 * h + c], a0c = args.in[I_A0][64 * h + c];
                    LAS float* lwb = LW + (32 * mt + 4 * hh) * 64 + c;
#pragma unroll
                    for (int r = 0; r < 16; ++r) { lwb[crc(r) * 64] = -0.6065306597126334f * sigmoidf_(ad[r] + w0c); lwb[4096 + crc(r) * 64] = sigmoidf_(ai[r] + a0c); }
                } else {
                    f32x16 ag;
#pragma unroll
                    for (int r = 0; r < 16; ++r) ag[r] = 0.f;
#pragma unroll
                    for (int s = 0; s < 8; ++s) {
                        const bf16x8 bg = *(const bf16x8*)(WGAT + (size_t)(64 * h + 32 * nt + r32) * 128 + 16 * s + 8 * hh);
                        ag = __builtin_amdgcn_mfma_f32_32x32x16_bf16(NATF(Ag, 136, s, mt), bg, ag, 0, 0, 0);
                    }
                    bf16_t* gob = GOUT + (size_t)(m0 + 32 * mt + 4 * hh) * 512 + 64 * h + 32 * nt + r32;
#pragma unroll
                    for (int r = 0; r < 16; ++r) gob[crc(r) * 512] = (bf16_t)f2bf(ag[r]);
                }
                __syncthreads();
                {
                    const int c = lane, gc = 64 * h + c, t0 = 8 * wave;
                    const float mur = mu[gc], muk = mu[512 + gc], muv = mu[1024 + gc], kkc = args.in[I_KK][gc], kac = args.in[I_KA][gc], rkc = args.in[I_RK][gc];
                    const bf16_t* pp = PROJ + (size_t)(m0 + t0) * NPROJ + gc;
                    float pr = 0.f, pk = 0.f, pv = 0.f;
                    if (((m0 + t0) & (SEQ - 1)) != 0) { pr = bflo(pp[-NPROJ]); pk = bflo(pp[-NPROJ + 512]); pv = bflo(pp[-NPROJ + 1024]); }
                    float rr[8], kx[8], vv[8], an[8], bn[8], lw[8], cl[8]; float run = 0.f;
#pragma unroll
                    for (int i = 0; i < 8; ++i) {
                        const float r0 = bflo(pp[(size_t)i * NPROJ]), k0 = bflo(pp[(size_t)i * NPROJ + 512]), v0 = bflo(pp[(size_t)i * NPROJ + 1024]);
                        rr[i] = r0 + (pr - r0) * mur; const float kl = k0 + (pk - k0) * muk; vv[i] = v0 + (pv - v0) * muv; pr = r0; pk = k0; pv = v0;
                        const float ic = IC[(t0 + i) * 64 + c]; lw[i] = LW[(t0 + i) * 64 + c]; run += lw[i]; cl[i] = run;
                        const float xk = kl * kkc; const float ssq = dpp_sum63(xk * xk); const float kn = xk * (1.0f / sqrtf(ssq + 1e-12f));
                        an[i] = -kn; bn[i] = kn * ic; kx[i] = kl * (1.0f + (ic - 1.0f) * kac);
                        const float bon = dpp_sum63(rr[i] * kx[i] * rkc);
                        if (lane == 0) KKR[(size_t)(m0 + t0 + i) * 8 + h] = bon;
                    }
                    TOT[wave * 64 + c] = run;
                    __syncthreads();
                    float off = 0.f, totc = 0.f;
#pragma unroll
                    for (int w2 = 0; w2 < 8; ++w2) { const float tv = TOT[w2 * 64 + c]; totc += tv; off += (w2 < wave) ? tv : 0.f; }
                    if (wave == 0) GAMC[c] = __expf(totc);
#pragma unroll
                    for (int i = 0; i < 8; ++i) { const float cum = off + cl[i]; const float en = __expf(-cum), ep = __expf(cum), em = __expf(cum - lw[i]); const int o = (t0 + i) * 72 + c;
                        At[o] = (bf16_t)f2bf(an[i] * em); Kt[o] = (bf16_t)f2bf(kx[i] * en); Bt[o] = (bf16_t)f2bf(bn[i] * en); Rt[o] = (bf16_t)f2bf(rr[i] * ep); Vt[o] = (bf16_t)f2bf(vv[i]); }
                }
                __syncthreads();
                {
                    f32x16 pb, pk2_;
#pragma unroll
                    for (int r = 0; r < 16; ++r) { pb[r] = 0.f; pk2_[r] = 0.f; }
#pragma unroll
                    for (int s = 0; s < 4; ++s) {
                        if (grp == 0) { pb = __builtin_amdgcn_mfma_f32_32x32x16_bf16(NATF(Bt, 72, s, mt), NATF(At, 72, s, nt), pb, 0, 0, 0);
                                        pk2_ = __builtin_amdgcn_mfma_f32_32x32x16_bf16(NATF(At, 72, s, mt), NATF(Kt, 72, s, nt), pk2_, 0, 0, 0); }
                        else { const bf16x8 a = NATF(Rt, 72, s, mt);
                               pb = __builtin_amdgcn_mfma_f32_32x32x16_bf16(a, NATF(Bt, 72, s, nt), pb, 0, 0, 0);
                               pk2_ = __builtin_amdgcn_mfma_f32_32x32x16_bf16(a, NATF(Kt, 72, s, nt), pk2_, 0, 0, 0); }
                    }
                    const int sc = 32 * nt + r32, tb = 32 * mt + 4 * hh;
                    if (grp == 0) { LAS float* ltb = LW + tb * 64 + sc; LAS bf16_t* lkb = Lak + tb * 72 + sc;
#pragma unroll
                        for (int r = 0; r < 16; ++r) { const int t = tb + crc(r); ltb[crc(r) * 64] = (t < sc) ? pb[r] : 0.f;
                            lkb[crc(r) * 72] = (bf16_t)f2bf(sc < t ? pk2_[r] : 0.f); }
                    } else { LAS bf16_t* mbb = Mrb + tb * 72 + sc; LAS bf16_t* mkb = Mrk + tb * 72 + sc;
#pragma unroll
                        for (int r = 0; r < 16; ++r) { const bool keep = sc <= tb + crc(r); mbb[crc(r) * 72] = (bf16_t)f2bf(keep ? pb[r] : 0.f); mkb[crc(r) * 72] = (bf16_t)f2bf(keep ? pk2_[r] : 0.f); } }
                }
                __syncthreads();
                f32x16 accA, accB;
#pragma unroll
                for (int r = 0; r < 16; ++r) { accA[r] = 0.f; accB[r] = 0.f; }
                {
                    const LAS bf16_t* Aop = grp == 0 ? Lak : Mrk;
#pragma unroll
                    for (int s = 0; s < 4; ++s) { const bf16x8 vb = TRF(Vt, 72, s, nt);
                        if (grp == 0) { accA = __builtin_amdgcn_mfma_f32_32x32x16_bf16(NATF(Aop, 72, s, mt), vb, accA, 0, 0, 0); accB = __builtin_amdgcn_mfma_f32_32x32x16_bf16(TRF(Kt, 72, s, mt), vb, accB, 0, 0, 0); }
                        else accB = __builtin_amdgcn_mfma_f32_32x32x16_bf16(NATF(Aop, 72, s, mt), vb, accB, 0, 0, 0); }
                    if (grp == 0) { LAS float* ggb = IC + (32 * mt + 4 * hh) * 65 + 32 * nt + r32;
#pragma unroll
                        for (int r = 0; r < 16; ++r) ggb[crc(r) * 65] = accA[r]; }
                }
                __syncthreads();
                {
                    float xr[16];
                    if (wave < 4) {
#pragma unroll
                        for (int c = 0; c < 16; ++c) xr[c] = bflo((unsigned)At[lane * 72 + 16 * wave + c]);
                    } else { const LAS float* GG = IC;
#pragma unroll
                        for (int c = 0; c < 16; ++c) xr[c] = GG[lane * 65 + 16 * (wave - 4) + c];
                    }
                    __syncthreads();
                    const LAS float* LT = LW;
#pragma unroll 4
                    for (int t = 0; t < 63; ++t) { const float lt = LT[t * 64 + lane];
#pragma unroll
                        for (int c = 0; c < 16; ++c) { const float xt = __builtin_bit_cast(float, __builtin_amdgcn_readlane(__builtin_bit_cast(int, xr[c]), t)); xr[c] += lt * xt; } }
#pragma unroll
                    for (int c = 0; c < 16; ++c) XX[lane * 136 + 16 * wave + c] = (bf16_t)f2bf(xr[c]);
                }
                __syncthreads();
                {
                    f32x16 acc1;
#pragma unroll
                    for (int r = 0; r < 16; ++r) acc1[r] = 0.f;
#pragma unroll
                    for (int s = 0; s < 4; ++s) {
                        const bf16x8 a = grp == 0 ? TRF(Bt, 72, s, mt) : NATF(Mrb, 72, s, mt);
                        acc1 = __builtin_amdgcn_mfma_f32_32x32x16_bf16(a, TRF(XX, 136, s, nt), acc1, 0, 0, 0);
                        accB = __builtin_amdgcn_mfma_f32_32x32x16_bf16(a, TRF(XX + 64, 136, s, nt), accB, 0, 0, 0);
                    }
                    const int col = 32 * nt + r32, rb = 32 * mt + 4 * hh;
                    if (grp == 0) {
                        bf16_t* acb = (bf16_t*)cs + rb * 64 + col; bf16_t* dcb = (bf16_t*)(cs + 8192) + col * 64 + rb; const LAS float* gb = GAMC + rb;
#pragma unroll
                        for (int r = 0; r < 16; ++r) { const float gcv = gb[crc(r)]; acb[crc(r) * 64] = (bf16_t)f2bf(gcv * (acc1[r] + ((rb + crc(r)) == col ? 1.0f : 0.0f))); }
#pragma unroll
                        for (int rq = 0; rq < 4; ++rq) { const f32x4 g4 = *(const LAS f32x4*)(gb + 8 * rq);
                            u32x2 w; w.x = pk2(accB[4 * rq] * g4[0], accB[4 * rq + 1] * g4[1]); w.y = pk2(accB[4 * rq + 2] * g4[2], accB[4 * rq + 3] * g4[3]); *(u32x2*)(dcb + 8 * rq) = w; }
                    } else {
                        bf16_t* rpb = (bf16_t*)(cs + 16384) + rb * 64 + col; const LAS bf16_t* rtb = Rt + rb * 72 + col; bf16_t* yb = MIX + (size_t)(m0 + rb) * DM + 64 * h + col;
#pragma unroll
                        for (int r = 0; r < 16; ++r) { rpb[crc(r) * 64] = (bf16_t)f2bf(acc1[r] + bflo((unsigned)rtb[crc(r) * 72])); yb[crc(r) * DM] = (bf16_t)f2bf(accB[r]); }
                    }
                }
                __syncthreads();
            }
        }
        for (int unit = vcu; unit < MTOK / 64; unit += G) {
            const int m0 = unit * 64;
            {
                const int cgp = tid & 127, ts = tid >> 7, c0 = 8 * cgp; const float* cw = args.in[I_CONVW]; const float* cb = args.in[I_CONVB];
                float w[4][8], bb[8];
#pragma unroll
                for (int j = 0; j < 4; ++j)
#pragma unroll
                    for (int i = 0; i < 8; ++i) w[j][i] = cw[j * 1024 + c0 + i];
#pragma unroll
                for (int i = 0; i < 8; ++i) bb[i] = cb[c0 + i];
                float x0[8], x1[8], x2[8], x3[8];
                const int mstart = m0 + 16 * ts; const int tpos = mstart & (SEQ - 1);
                const bf16_t* srcp = PROJ + (size_t)mstart * NPROJ + 2304 + c0;
#pragma unroll
                for (int i = 0; i < 8; ++i) { x0[i] = 0.f; x1[i] = 0.f; x2[i] = 0.f; }
                if (tpos >= 3) unpack8(*(const u32x4*)(srcp - 3 * (size_t)NPROJ), x0);
                if (tpos >= 2) unpack8(*(const u32x4*)(srcp - 2 * (size_t)NPROJ), x1);
                if (tpos >= 1) unpack8(*(const u32x4*)(srcp - 1 * (size_t)NPROJ), x2);
                for (int t = 0; t < 16; ++t) {
                    unpack8(*(const u32x4*)(srcp + (size_t)t * NPROJ), x3);
                    float o[8];
#pragma unroll
                    for (int i = 0; i < 8; ++i) { const float y = bb[i] + w[0][i] * x0[i] + w[1][i] * x1[i] + w[2][i] * x2[i] + w[3][i] * x3[i]; o[i] = siluf_(y); x0[i] = x1[i]; x1[i] = x2[i]; x2[i] = x3[i]; }
                    *(u32x4*)(XBCC + (size_t)(mstart + t) * 1024 + c0) = pack8(o);
                }
            }
        }
#undef TRF
#undef NATF
    }

    SEAM(2);

    PHASE(3) { REPBAR
        if (vcu < 32) {
            const int b = vcu >> 3, h = vcu & 7, r32 = lane & 31, hh = lane >> 5;
            const unsigned char* cbase = (const unsigned char*)dout + (size_t)(b * 64 * 8 + h) * 24576;
            constexpr size_t CSTR = (size_t)8 * 24576; constexpr int SLOT = 27648;
            const bool loader = wave >= 2; const int lt = tid - 128;
            int poff[4];
#pragma unroll
            for (int k = 0; k < 4; ++k) { const int p = lt + 384 * k; poff[k] = (p >> 9) * 9216 + ((p & 511) >> 3) * 144 + (p & 7) * 16; }
            u32x4 st[4][4];
#define RB_ISSUE(set, ch) do { if (loader) { const unsigned char* g_ = cbase + (size_t)(ch) * CSTR + (size_t)lt * 16; _Pragma("unroll") for (int k = 0; k < 4; ++k) st[set][k] = *(const u32x4*)(g_ + k * 6144); } } while (0)
#define RB_WRITE(set, ch) do { if (loader) { LAS unsigned char* s_ = lds + ((ch) & 3) * SLOT; _Pragma("unroll") for (int k = 0; k < 4; ++k) *(LAS u32x4*)(s_ + poff[k]) = st[set][k]; } } while (0)
            RB_ISSUE(0, 0); RB_ISSUE(1, 1); RB_WRITE(0, 0); RB_WRITE(1, 1);
            RB_ISSUE(2, 2); RB_ISSUE(3, 3); RB_ISSUE(0, 4); RB_ISSUE(1, 5);
            __syncthreads();
            f32x16 H[2];
#pragma unroll
            for (int r = 0; r < 16; ++r) { H[0][r] = 0.f; H[1][r] = 0.f; }
            bf16_t* zp = (bf16_t*)((unsigned char*)dout + 48 * MiB) + (size_t)(b * SEQ + 4 * hh) * 512 + 64 * h + 32 * wave + r32;
#define RB_STEP(j, chv) do { const int ch_ = (chv); \
                if (loader) { if (ch_ + 2 < 64) RB_WRITE(((j) + 2) & 3, ch_ + 2); if (ch_ + 6 < 64) RB_ISSUE(((j) + 2) & 3, ch_ + 6); } \
                else { const LAS unsigned char* sl = lds + (ch_ & 3) * SLOT; f32x16 Hn[2], Z[2]; bf16x8 Hb[4]; \
                    _Pragma("unroll") for (int s = 0; s < 4; ++s) { const int m = s >> 1, o = 8 * (s & 1); u32x4 t; t.x = pk2(H[m][o], H[m][o + 1]); t.y = pk2(H[m][o + 2], H[m][o + 3]); t.z = pk2(H[m][o + 4], H[m][o + 5]); t.w = pk2(H[m][o + 6], H[m][o + 7]); Hb[s] = __builtin_bit_cast(bf16x8, t); } \
                    _Pragma("unroll") for (int m = 0; m < 2; ++m) { \
                        _Pragma("unroll") for (int rq = 0; rq < 4; ++rq) { const u32x2 d = *(const LAS u32x2*)(sl + 9216 + (32 * wave + r32) * 144 + (32 * m + 8 * rq + 4 * hh) * 2); \
                            Hn[m][4 * rq] = bflo(d.x); Hn[m][4 * rq + 1] = bfhi(d.x); Hn[m][4 * rq + 2] = bflo(d.y); Hn[m][4 * rq + 3] = bfhi(d.y); } \
                        _Pragma("unroll") for (int r = 0; r < 16; ++r) Z[m][r] = 0.f; } \
                    _Pragma("unroll") for (int s = 0; s < 4; ++s) \
                        _Pragma("unroll") for (int m = 0; m < 2; ++m) { const int o = (32 * m + r32) * 144 + (16 * s + 4 * hh) * 2; \
                            const u32x2 a0 = *(const LAS u32x2*)(sl + o), a1 = *(const LAS u32x2*)(sl + o + 16), q0 = *(const LAS u32x2*)(sl + 18432 + o), q1 = *(const LAS u32x2*)(sl + 18432 + o + 16); \
                            u32x4 t; t.x = a0.x; t.y = a0.y; t.z = a1.x; t.w = a1.y; Hn[m] = __builtin_amdgcn_mfma_f32_32x32x16_bf16(__builtin_bit_cast(bf16x8, t), Hb[s], Hn[m], 0, 0, 0); \
                            t.x = q0.x; t.y = q0.y; t.z = q1.x; t.w = q1.y; Z[m] = __builtin_amdgcn_mfma_f32_32x32x16_bf16(__builtin_bit_cast(bf16x8, t), Hb[s], Z[m], 0, 0, 0); } \
                    H[0] = Hn[0]; H[1] = Hn[1]; \
                    bf16_t* zq = zp + (size_t)ch_ * 64 * 512; \
                    _Pragma("unroll") for (int m = 0; m < 2; ++m) _Pragma("unroll") for (int r = 0; r < 16; ++r) zq[(32 * m + crc(r)) * 512] = (bf16_t)f2bf(Z[m][r]); } \
                __syncthreads(); } while (0)
            if (wave < 2 || loader) {
                for (int ch = 0; ch < 64; ch += 4) { RB_STEP(0, ch); RB_STEP(1, ch + 1); RB_STEP(2, ch + 2); RB_STEP(3, ch + 3); }
            }
#undef RB_STEP
#undef RB_ISSUE
#undef RB_WRITE
        }
    }

    SEAM(3);

    PHASE(4) { REPBAR
        const int b = vcu >> 6, h = (vcu >> 3) & 7, pg = vcu & 7, g = h >> 2;
        LAS float* Bm = (LAS float*)lds; LAS float* Cm = Bm + 8192; LAS float* Xs = Cm + 8192; LAS float* DTs = Xs + 512; LAS float* DECs = DTs + 64; LAS float* Yst = DECs + 64;
        const float a_h = -__expf(args.in[I_ALOG][h]);
        const int tt = tid >> 3, cg = tid & 7;
        u32x4 raw[5]; float dtv;
        auto issue = [&](int s) {
            const int m = b * SEQ + s * 64 + tt; const bf16_t* pc = XBCC + (size_t)m * 1024;
            raw[0] = *(const u32x4*)(pc + 512 + 128 * g + 16 * cg); raw[1] = *(const u32x4*)(pc + 512 + 128 * g + 16 * cg + 8);
            raw[2] = *(const u32x4*)(pc + 768 + 128 * g + 16 * cg); raw[3] = *(const u32x4*)(pc + 768 + 128 * g + 16 * cg + 8);
            raw[4] = *(const u32x4*)(pc + 64 * h + 8 * pg); dtv = DTSP[(size_t)m * 8 + h];
        };
        auto commit = [&]() {
            float f[8];
            unpack8(raw[0], f); *(LAS f32x4*)(Bm + tt * 128 + 16 * cg) = (f32x4){f[0], f[1], f[2], f[3]}; *(LAS f32x4*)(Bm + tt * 128 + 16 * cg + 4) = (f32x4){f[4], f[5], f[6], f[7]};
            unpack8(raw[1], f); *(LAS f32x4*)(Bm + tt * 128 + 16 * cg + 8) = (f32x4){f[0], f[1], f[2], f[3]}; *(LAS f32x4*)(Bm + tt * 128 + 16 * cg + 12) = (f32x4){f[4], f[5], f[6], f[7]};
            unpack8(raw[2], f); *(LAS f32x4*)(Cm + tt * 128 + 16 * cg) = (f32x4){f[0], f[1], f[2], f[3]}; *(LAS f32x4*)(Cm + tt * 128 + 16 * cg + 4) = (f32x4){f[4], f[5], f[6], f[7]};
            unpack8(raw[3], f); *(LAS f32x4*)(Cm + tt * 128 + 16 * cg + 8) = (f32x4){f[0], f[1], f[2], f[3]}; *(LAS f32x4*)(Cm + tt * 128 + 16 * cg + 12) = (f32x4){f[4], f[5], f[6], f[7]};
            if (cg == 0) { unpack8(raw[4], f); *(LAS f32x4*)(Xs + tt * 8) = (f32x4){f[0], f[1], f[2], f[3]}; *(LAS f32x4*)(Xs + tt * 8 + 4) = (f32x4){f[4], f[5], f[6], f[7]}; DTs[tt] = dtv; DECs[tt] = __expf(dtv * a_h); }
        };
        issue(0); commit(); __syncthreads();
        float h0 = 0.f, h1 = 0.f;
        for (int s = 0; s < SEQ / 64; ++s) {
            if (s + 1 < SEQ / 64) issue(s + 1);
#pragma unroll 4
            for (int t = 0; t < 64; ++t) {
                const f32x2 bv = *(const LAS f32x2*)(Bm + t * 128 + 2 * lane), cv = *(const LAS f32x2*)(Cm + t * 128 + 2 * lane);
                const float dtx = DTs[t] * Xs[t * 8 + wave], dec = DECs[t];
                h0 = h0 * dec + dtx * bv[0]; h1 = h1 * dec + dtx * bv[1];
                const float y = dpp_sum63(h0 * cv[0] + h1 * cv[1]);
                if (lane == 0) Yst[t * 8 + wave] = y;
            }
            __syncthreads();
            { const int m = b * SEQ + s * 64 + (tid >> 3); MIX[(size_t)m * DM + 512 + 64 * h + 8 * pg + (tid & 7)] = (bf16_t)f2bf(Yst[tid]); }
            if (s + 1 < SEQ / 64) commit();
            __syncthreads();
        }
    }
    SEAM(4);

    PHASE(5) { REPBAR
        const float* mu = args.in[I_MU];
        for (int m = gw; m < MTOK; m += NGW) {
            const bool hasprev = (m & (SEQ - 1)) != 0; const int c0 = 8 * lane, h = lane >> 3;
            float y[8], v[8], p[8], go[8];
            unpack8(*(const u32x4*)(MIX + (size_t)m * DM + c0), y);
            unpack8(*(const u32x4*)((const bf16_t*)((const unsigned char*)dout + 48 * MiB) + (size_t)m * 512 + c0), p);
#pragma unroll
            for (int i = 0; i < 8; ++i) y[i] += p[i];
            const bf16_t* pc = PROJ + (size_t)m * NPROJ + c0;
            unpack8(*(const u32x4*)(pc + 1024), v);
            if (hasprev) {
                unpack8(*(const u32x4*)(pc - NPROJ + 1024), p);
#pragma unroll
                for (int i = 0; i < 8; ++i) v[i] += (p[i] - v[i]) * mu[1024 + c0 + i];
            } else {
#pragma unroll
                for (int i = 0; i < 8; ++i) v[i] -= v[i] * mu[1024 + c0 + i];
            }
            unpack8(*(const u32x4*)(GOUT + (size_t)m * 512 + c0), go);
            float s1 = 0.f; const float bd = KKR[(size_t)m * 8 + h];
#pragma unroll
            for (int i = 0; i < 8; ++i) s1 += y[i];
            s1 += __shfl_xor(s1, 1); s1 += __shfl_xor(s1, 2); s1 += __shfl_xor(s1, 4);
            const float mean = s1 * (1.0f / 64.0f); float s2 = 0.f;
#pragma unroll
            for (int i = 0; i < 8; ++i) { const float d = y[i] - mean; s2 += d * d; }
            s2 += __shfl_xor(s2, 1); s2 += __shfl_xor(s2, 2); s2 += __shfl_xor(s2, 4);
            const float rs = 1.0f / sqrtf(s2 * (1.0f / 64.0f) + 64e-5f);
            float o[8];
#pragma unroll
            for (int i = 0; i < 8; ++i) o[i] = ((y[i] - mean) * rs * args.in[I_GNW][c0 + i] + args.in[I_GNB][c0 + i] + bd * v[i]) * go[i];
            *(u32x4*)(MIX + (size_t)m * DM + c0) = pack8(o);
            float ys[8], xs[8], z[8];
            unpack8(*(const u32x4*)(MIX + (size_t)m * DM + 512 + c0), ys); unpack8(*(const u32x4*)(XBCC + (size_t)m * 1024 + c0), xs); unpack8(*(const u32x4*)(PROJ + (size_t)m * NPROJ + 1792 + c0), z);
            const float dsk = args.in[I_DSKIP][h]; float q = 0.f;
#pragma unroll
            for (int i = 0; i < 8; ++i) { ys[i] = (ys[i] + dsk * xs[i]) * siluf_(z[i]); q += ys[i] * ys[i]; }
            q += __shfl_xor(q, 1); q += __shfl_xor(q, 2); q += __shfl_xor(q, 4); q += __shfl_xor(q, 8); q += __shfl_xor(q, 16);
            const float rq = 1.0f / sqrtf(q * (1.0f / 256.0f) + EPS);
#pragma unroll
            for (int i = 0; i < 8; ++i) ys[i] = ys[i] * rq * args.in[I_SSDN][c0 + i];
            *(u32x4*)(MIX + (size_t)m * DM + 512 + c0) = pack8(ys);
        }
    }
    SEAM(5);


    PHASE(6) { REPBAR
        pg8::Gemm g{MIX, WOUT, MTOK, DM, DM}; pg8::StaticOrder S; S.init(MTOK, DM, G, bx);
        pg8::EpiRes E{args.in[I_X], dout, XNB, args.in[I_NORM_FFN0], nullptr, SS};
        pg8::gemm_phase(lds, g, S, E);
    }
    SEAM(6);
    PHASE(7) { REPBAR
        pg8::Gemm g{XNB, WGU, MTOK, 2 * FFN, DM}; pg8::StaticOrder S; S.init(MTOK, 2 * FFN, G, bx);
        pg8::EpiSwiglu E{HID, FFN, SS, nullptr};
        pg8::gemm_phase(lds, g, S, E);
    }
    SEAM(7);
    PHASE(8) { REPBAR
        pg8::Gemm g{HID, WDN, MTOK, DM, FFN}; pg8::StaticOrder S; S.init(MTOK, DM, G, bx);
        pg8::EpiRes E{dout, dout, XNB, args.in[I_NORM_MIX1], nullptr, SS};
        pg8::gemm_phase(lds, g, S, E);
    }
    SEAM(8);
    PHASE(9) { REPBAR
        pg8::Gemm g{XNB, WQKV, MTOK, 1536, DM}; pg8::StaticOrder S; S.init(MTOK, 1536, G, bx);
        pg8::EpiQkv E{QKV, SS, args.in[I_BQKV], args.in[I_QN], args.in[I_KN], ROPE};
        pg8::gemm_phase(lds, g, S, E);
    }
    SEAM(9);

    PHASE(10) { REPBAR
        LAS bf16_t* Kt = (LAS bf16_t*)lds; LAS bf16_t* Vt = (LAS bf16_t*)(lds + 36864);
        const int r32 = lane & 31, hh = lane >> 5;
        for (int unit = vcu; unit < BATCH * 4 * 32; unit += G) {
            const int blk = unit & 31, kvh = (unit >> 5) & 3, b = unit >> 7;
            {
                const int rowi = tid >> 1, half = tid & 1; const int tpos = (blk - 1) * 128 + rowi;
#pragma unroll
                for (int q = 0; q < 4; ++q) { u32x4 kv = (u32x4){0, 0, 0, 0}, vv = kv;
                    if (tpos >= 0) { const bf16_t* p = QKV + (size_t)(b * SEQ + tpos) * 1536 + 1024 + kvh * 64 + half * 32 + 8 * q; kv = *(const u32x4*)p; vv = *(const u32x4*)(p + 256); }
                    *(LAS u32x4*)(Kt + rowi * 72 + half * 32 + 8 * q) = kv; *(LAS u32x4*)(Vt + rowi * 72 + half * 32 + 8 * q) = vv; }
            }
            __syncthreads();
            const int gq = wave >> 1, qh = kvh * 4 + gq; const float sink = args.in[I_SINK][qh];
            for (int it = 0; it < 2; ++it) {
                const int qi = (wave & 1) * 64 + it * 32 + r32; const size_t mq = (size_t)b * SEQ + blk * 128 + qi;
                bf16x8 qr[4];
#pragma unroll
                for (int s = 0; s < 4; ++s) qr[s] = *(const bf16x8*)(QKV + mq * 1536 + qh * 64 + 16 * s + 8 * hh);
                const int a0 = (wave & 1) * 2 + it;
                f32x16 sc[5];
#pragma unroll
                for (int j = 0; j < 5; ++j) {
#pragma unroll
                    for (int r = 0; r < 16; ++r) sc[j][r] = 0.f;
#pragma unroll
                    for (int s = 0; s < 4; ++s) { const bf16x8 kf = *(const LAS bf16x8*)(Kt + (32 * (a0 + j) + r32) * 72 + 16 * s + 8 * hh); sc[j] = __builtin_amdgcn_mfma_f32_32x32x16_bf16(kf, qr[s], sc[j], 0, 0, 0); }
                }
                float mx = sink;
#pragma unroll
                for (int j = 0; j < 5; ++j)
#pragma unroll
                    for (int r = 0; r < 16; ++r) { const int kj = 32 * (a0 + j) + crow(r, hh); const bool valid = (kj > qi) && (kj <= qi + 128) && (blk > 0 || kj >= 128);
                        const float x = valid ? sc[j][r] * 0.125f : -1e30f; sc[j][r] = x; mx = fmaxf(mx, x); }
                mx = fmaxf(mx, __shfl_xor(mx, 32));
                float l = 0.f;
#pragma unroll
                for (int j = 0; j < 5; ++j)
#pragma unroll
                    for (int r = 0; r < 16; ++r) { const float p = __expf(sc[j][r] - mx); sc[j][r] = p; l += p; }
                l += __shfl_xor(l, 32); l += __expf(sink - mx);
                const float inv = 1.0f / l;
                f32x16 o[2];
#pragma unroll
                for (int dt = 0; dt < 2; ++dt)
#pragma unroll
                    for (int r = 0; r < 16; ++r) o[dt][r] = 0.f;
#pragma unroll
                for (int j = 0; j < 5; ++j)
#pragma unroll
                    for (int s2 = 0; s2 < 2; ++s2) {
                        u32x4 pw; pw.x = pk2(sc[j][8 * s2 + 0], sc[j][8 * s2 + 1]); pw.y = pk2(sc[j][8 * s2 + 2], sc[j][8 * s2 + 3]); pw.z = pk2(sc[j][8 * s2 + 4], sc[j][8 * s2 + 5]); pw.w = pk2(sc[j][8 * s2 + 6], sc[j][8 * s2 + 7]);
                        const bf16x8 pf = __builtin_bit_cast(bf16x8, pw);
                        const int key0 = 32 * (a0 + j) + 16 * s2 + 4 * hh + ((lane & 15) >> 2);
#pragma unroll
                        for (int dt = 0; dt < 2; ++dt) {
                            const LAS bf16_t* vp = Vt + key0 * 72 + 32 * dt + 16 * ((lane >> 4) & 1) + 4 * (lane & 3);
                            const s16x4 lo = __builtin_bit_cast(s16x4, __builtin_amdgcn_ds_read_tr16_b64_v4i16((LAS s16x4*)vp));
                            const s16x4 hi = __builtin_bit_cast(s16x4, __builtin_amdgcn_ds_read_tr16_b64_v4i16((LAS s16x4*)(vp + 8 * 72)));
                            const bf16x8 vf = (bf16x8){lo[0], lo[1], lo[2], lo[3], hi[0], hi[1], hi[2], hi[3]};
                            o[dt] = __builtin_amdgcn_mfma_f32_32x32x16_bf16(vf, pf, o[dt], 0, 0, 0);
                        }
                    }
                bf16_t* op = ATTO + mq * DM + qh * 64;
#pragma unroll
                for (int dt = 0; dt < 2; ++dt)
#pragma unroll
                    for (int rq = 0; rq < 4; ++rq) { u32x2 w; w.x = pk2(o[dt][4 * rq] * inv, o[dt][4 * rq + 1] * inv); w.y = pk2(o[dt][4 * rq + 2] * inv, o[dt][4 * rq + 3] * inv);
                        *(u32x2*)(op + 32 * dt + 8 * rq + 4 * hh) = w; }
            }
            __syncthreads();
        }
    }
    SEAM(10);

    PHASE(11) { REPBAR
        pg8::Gemm g{ATTO, WO, MTOK, DM, DM}; pg8::StaticOrder S; S.init(MTOK, DM, G, bx);
        pg8::EpiRes E{dout, dout, XNB, args.in[I_NORM_FFN1], args.in[I_BO], SS};
        pg8::gemm_phase(lds, g, S, E);
    }
    SEAM(11);

    PHASE(12) { REPBAR
        {
            LAS float* scr = (LAS float*)(lds + wave * 16384);
            for (int it0 = gw; ; it0 += NGW) {
                int it = it0; bool done = false;
                for (int e = 0; e < NEXP && !done; ++e) {
                    if (transpose_matrix(it, args.in[I_EG] + (size_t)e * DM * FE, FE, DM, FE, EGU + (size_t)e * 2 * FE * DM, 1, scr, lane)) { done = true; break; }
                    if (transpose_matrix(it, args.in[I_EU] + (size_t)e * DM * FE, FE, DM, FE, EGU + (size_t)e * 2 * FE * DM, 2, scr, lane)) { done = true; break; }
                    if (transpose_matrix(it, args.in[I_ED] + (size_t)e * FE * DM, DM, FE, DM, EDN + (size_t)e * DM * FE, 0, scr, lane)) { done = true; break; }
                }
                if (!done) break;
            }
            __syncthreads();
        }
        LAS float* w8 = (LAS float*)lds;
        for (int r = tid; r < DM; r += 512) { const float* p = args.in[I_ROUTER] + (size_t)r * 8; *(LAS f32x4*)(w8 + r * 8) = *(const f32x4*)p; *(LAS f32x4*)(w8 + r * 8 + 4) = *(const f32x4*)(p + 4); }
        __syncthreads();
        const float* gm = args.in[I_NORM_FFN1];
        for (int m = gw; m < MTOK; m += NGW) {
            const f32x4* xr = (const f32x4*)(dout + (size_t)m * DM) + lane;
            f32x4 v[4]; float s = 0.f;
#pragma unroll
            for (int j = 0; j < 4; ++j) { v[j] = xr[64 * j]; s += (v[j][0] * v[j][0] + v[j][1] * v[j][1]) + (v[j][2] * v[j][2] + v[j][3] * v[j][3]); }
            const float rstd = 1.0f / sqrtf(wave_sum(s) * (1.0f / DM) + EPS);
            float d[8];
#pragma unroll
            for (int k = 0; k < 8; ++k) d[k] = 0.f;
#pragma unroll
            for (int j = 0; j < 4; ++j) { const f32x4 g4 = ((const f32x4*)gm)[64 * j + lane]; const f32x4 y = v[j] * rstd * g4;
#pragma unroll
                for (int i = 0; i < 4; ++i) { const int c = 256 * j + 4 * lane + i; const f32x4 wa = *(const LAS f32x4*)(w8 + c * 8), wb = *(const LAS f32x4*)(w8 + c * 8 + 4);
                    d[0] += y[i] * wa[0]; d[1] += y[i] * wa[1]; d[2] += y[i] * wa[2]; d[3] += y[i] * wa[3]; d[4] += y[i] * wb[0]; d[5] += y[i] * wb[1]; d[6] += y[i] * wb[2]; d[7] += y[i] * wb[3]; } }
#pragma unroll
            for (int k = 0; k < 8; ++k) d[k] = wave_sum(d[k]);
            int e0 = 0; float v0 = d[0];
#pragma unroll
            for (int k = 1; k < 8; ++k) if (d[k] > v0) { v0 = d[k]; e0 = k; }
            int e1 = -1; float v1 = -3.0e38f;
#pragma unroll
            for (int k = 0; k < 8; ++k) if (k != e0 && d[k] > v1) { v1 = d[k]; e1 = k; }
            if (lane == 0) {
                const float w0 = 1.0f / (1.0f + __expf(v1 - v0));
                const unsigned r0 = atomicAdd(CNT + e0, 1u), r1 = atomicAdd(CNT + e1, 1u);
                TOPE[2 * m] = e0; TOPE[2 * m + 1] = e1; RANK[2 * m] = (int)r0; RANK[2 * m + 1] = (int)r1; TOPW[2 * m] = w0; TOPW[2 * m + 1] = 1.0f - w0; RSTD4[m] = rstd;
            }
        }
        __syncthreads();
    }
    SEAM(12);

    PHASE(13) { REPBAR
        int roff[NEXP]; { int t = 0;
#pragma unroll
            for (int e = 0; e < NEXP; ++e) { roff[e] = t; t += (int)((CNT[e] + 255u) >> 8) << 8; } }
        for (int j = gw; j < 2 * MTOK; j += NGW) {
            const int m = j >> 1, e = TOPE[j]; int ro = roff[0];
#pragma unroll
            for (int k = 1; k < NEXP; ++k) ro = (e == k) ? roff[k] : ro;
            const int pos = ro + RANK[j];
            const u32x4* src = (const u32x4*)(XNB + (size_t)m * DM) + lane; u32x4* dst = (u32x4*)(AS + (size_t)pos * DM) + lane;
            dst[0] = src[0]; dst[64] = src[64];
            if (lane == 0) { POS[j] = pos; RSTDS[pos] = RSTD4[m]; }
        }
    }
    SEAM(13);
    PHASE(14) { REPBAR
        pg8::Gemm g{AS, EGU, SROWS, 2 * FE, DM}; pg8::MoeOrder S; S.init(CNT, 2 * FE / 256, G, bx, (long)2 * FE * DM * 2);
        pg8::EpiSwiglu E{HS, FE, nullptr, RSTDS};
        pg8::gemm_phase(lds, g, S, E);
    }
    SEAM(14);
    PHASE(15) { REPBAR
        pg8::Gemm g{HS, EDN, SROWS, DM, FE}; pg8::MoeOrder S; S.init(CNT, DM / 256, G, bx, (long)DM * FE * 2);
        pg8::EpiBf16 E{AS, DM};
        pg8::gemm_phase(lds, g, S, E);
    }
    SEAM(15);
    PHASE(16) { REPBAR
        for (int m = gw; m < MTOK; m += NGW) {
            const int p0 = POS[2 * m], p1 = POS[2 * m + 1]; const float w0 = TOPW[2 * m], w1 = TOPW[2 * m + 1];
            const u32x4* y0 = (const u32x4*)(AS + (size_t)p0 * DM) + lane; const u32x4* y1 = (const u32x4*)(AS + (size_t)p1 * DM) + lane;
            f32x4* o = (f32x4*)(dout + (size_t)m * DM);
#pragma unroll
            for (int q = 0; q < 2; ++q) { float a[8], c[8]; unpack8(y0[64 * q], a); unpack8(y1[64 * q], c);
                f32x4 h0 = o[128 * q + 2 * lane], h1 = o[128 * q + 2 * lane + 1];
#pragma unroll
                for (int i = 0; i < 4; ++i) { h0[i] += w0 * a[i] + w1 * c[i]; h1[i] += w0 * a[4 + i] + w1 * c[4 + i]; }
                o[128 * q + 2 * lane] = h0; o[128 * q + 2 * lane + 1] = h1; }
        }
    }
#undef IN
#undef SEAM
#undef PHASE
#undef REPBAR
}

constexpr int NPHASE = 17;
extern "C" void kernel_launch(void* const* d_in, const int* in_sizes, int n_in, void* d_out, int out_size, void* d_ws, size_t ws_size, hipStream_t stream) {
    static int grid = 0;
    if (grid == 0) {
        if (n_in != 39 || out_size != MTOK * DM || ws_size < WS_END) { fprintf(stderr, "kernel_launch: unexpected shapes n_in %d out %d ws %zu\n", n_in, out_size, ws_size); grid = -1; return; }
        int dev = 0, cus = 0;
        if (hipGetDevice(&dev) != hipSuccess || hipDeviceGetAttribute(&cus, hipDeviceAttributeMultiprocessorCount, dev) != hipSuccess) { grid = -1; return; }
        if (hipFuncSetAttribute((const void*)fwd_kernel, hipFuncAttributeMaxDynamicSharedMemorySize, LDS_BYTES) != hipSuccess) { fprintf(stderr, "kernel_launch: hipFuncSetAttribute failed\n"); grid = -1; return; }
        int per_cu = 0; (void)hipOccupancyMaxActiveBlocksPerMultiprocessor(&per_cu, (const void*)fwd_kernel, 512, LDS_BYTES); (void)hipGetLastError();
        grid = 256; if (cus != 256 || per_cu < 1) fprintf(stderr, "kernel_launch: note: cus %d per_cu %d\n", cus, per_cu);
    }
    if (grid < 0) return;
    Args a{};
    a.in[0] = (const float*)d_in[0];
    for (int i = 2; i < 39; ++i) a.in[i - 1] = (const float*)d_in[i];
    a.pos = (const int*)d_in[1]; a.out = (float*)d_out; a.ws = (unsigned char*)d_ws;
    (void)hipMemsetAsync((char*)d_ws + WS_CTL, 0, CTL_ZERO_BYTES, stream);
#ifdef PROBE_PHASE
    constexpr int pp = PROBE_PHASE; constexpr bool before = (pp == 2 || pp == 5 || pp == 6 || pp == 8 || pp == 11 || pp == 16);
    if (before) { a.ph_lo = pp; a.ph_hi = pp + 1; hipLaunchKernelGGL(fwd_kernel, dim3(grid), dim3(512), LDS_BYTES, stream, a); (void)hipMemsetAsync((char*)d_ws + WS_CTL, 0, CW_CNT * 4, stream); }
#endif
    a.ph_lo = 0; a.ph_hi = NPHASE;
    hipLaunchKernelGGL(fwd_kernel, dim3(grid), dim3(512), LDS_BYTES, stream, a);
#ifdef PROBE_PHASE
    if (!before) { (void)hipMemsetAsync((char*)d_ws + WS_CTL, 0, CW_CNT * 4, stream); a.ph_lo = pp; a.ph_hi = pp + 1; hipLaunchKernelGGL(fwd_kernel, dim3(grid), dim3(512), LDS_BYTES, stream, a); }
#endif
}
```

```cpp
#include <hip/hip_runtime.h>
#include <cstdio>
#include <cstdint>

#define LAS __attribute__((address_space(3)))
#define GAS __attribute__((address_space(1)))
typedef unsigned short bf16_t;
typedef short bf16x8 __attribute__((ext_vector_type(8)));
typedef float f32x4 __attribute__((ext_vector_type(4)));
typedef float f32x2 __attribute__((ext_vector_type(2)));
typedef float f32x16 __attribute__((ext_vector_type(16)));
typedef unsigned u32x4 __attribute__((ext_vector_type(4)));
typedef unsigned u32x2 __attribute__((ext_vector_type(2)));
typedef short s16x4 __attribute__((ext_vector_type(4)));

constexpr int BATCH = 4, SEQ = 4096, DM = 1024, MTOK = BATCH * SEQ;
constexpr int IN0 = 3336, NPROJ = 3328;
constexpr int FFN = 2816, FE = 1408, NEXP = 8;
constexpr int SROWS = 2 * MTOK + NEXP * 256;
constexpr float EPS = 1e-6f;

constexpr size_t MiB = 1u << 20;
constexpr size_t WS_CTL = 0, CTL_ZERO_BYTES = 64 * 1024;
constexpr size_t WS_DTSP = 1 * MiB;
constexpr size_t WS_KKR = 1 * MiB + 512 * 1024;
constexpr size_t WS_ROPE = 2 * MiB;
constexpr size_t WS_SS = 3 * MiB;
constexpr size_t WS_TOPE = 4 * MiB;
constexpr size_t WS_RANK = 4 * MiB + 128 * 1024;
constexpr size_t WS_TOPW = 4 * MiB + 256 * 1024;
constexpr size_t WS_POS = 4 * MiB + 384 * 1024;
constexpr size_t WS_RSTD4 = 4 * MiB + 512 * 1024;
constexpr size_t WS_RSTDS = 4 * MiB + 640 * 1024;
constexpr size_t WS_WDEC = 5 * MiB;
constexpr size_t WS_WICL = 5 * MiB + 64 * 1024;
constexpr size_t WS_WGAT = 5 * MiB + 128 * 1024;
constexpr size_t WS_EGU = 6 * MiB;
constexpr size_t WS_EDN = 50 * MiB;
constexpr size_t WS_WIN = 72 * MiB;
constexpr size_t WS_WOUT = WS_WIN + (size_t)NPROJ * DM * 2;
constexpr size_t WS_WGU = WS_WOUT + 2 * MiB;
constexpr size_t WS_WDN = WS_WGU + 11 * MiB;
constexpr size_t WS_WQKV = WS_WDN + (size_t)DM * FFN * 2;
constexpr size_t WS_WO = WS_WQKV + 3 * MiB;
constexpr size_t R0 = 102 * MiB;
static_assert(WS_WO + 2 * MiB <= R0, "weights");
constexpr size_t WS_XN = R0, WS_MIX = R0;
constexpr size_t WS_PROJ = R0 + 32 * MiB;
constexpr size_t WS_GOUT = R0 + 136 * MiB;
constexpr size_t WS_XNB = R0 + 104 * MiB;
constexpr size_t WS_HID = R0;
constexpr size_t WS_QKV = R0;
constexpr size_t WS_ATTO = R0 + 48 * MiB;
constexpr size_t WS_AS = 72 * MiB;
constexpr size_t WS_HS = 140 * MiB;
constexpr size_t WS_END = 254 * MiB;
static_assert(WS_AS + (size_t)SROWS * DM * 2 <= WS_HS && WS_HS + (size_t)SROWS * FE * 2 <= WS_END && WS_GOUT + 16 * MiB <= WS_END, "map");
constexpr size_t DO_XBCC = 0, DO_DECAY = 32 * MiB, DO_ICLR = 48 * MiB;
constexpr int CW_BAR = 4096, CW_CNT = 8192;

constexpr int LDS_BYTES = 147456, RING_BYTES = 131072, MISC_OFF = LDS_BYTES - 128;

__device__ __forceinline__ unsigned f2bf(float f) { unsigned u = __builtin_bit_cast(unsigned, f); return (u + 0x7fffu + ((u >> 16) & 1u)) >> 16; }
typedef __bf16 bf16x2_t __attribute__((ext_vector_type(2)));
__device__ __forceinline__ unsigned pk2(float lo, float hi) { const f32x2 v = {lo, hi}; const bf16x2_t b = __builtin_convertvector(v, bf16x2_t); return __builtin_bit_cast(unsigned, b); }
__device__ __forceinline__ float bflo(unsigned u) { return __builtin_bit_cast(float, u << 16); }
__device__ __forceinline__ float bfhi(unsigned u) { return __builtin_bit_cast(float, u & 0xffff0000u); }
__device__ __forceinline__ void unpack8(const u32x4 v, float* f) { f[0] = bflo(v.x); f[1] = bfhi(v.x); f[2] = bflo(v.y); f[3] = bfhi(v.y); f[4] = bflo(v.z); f[5] = bfhi(v.z); f[6] = bflo(v.w); f[7] = bfhi(v.w); }
__device__ __forceinline__ u32x4 pack8(const float* f) { u32x4 v; v.x = pk2(f[0], f[1]); v.y = pk2(f[2], f[3]); v.z = pk2(f[4], f[5]); v.w = pk2(f[6], f[7]); return v; }
__device__ __forceinline__ float sigmoidf_(float x) { return 1.0f / (1.0f + __expf(-x)); }
__device__ __forceinline__ float siluf_(float x) { return x / (1.0f + __expf(-x)); }
__device__ __forceinline__ float wave_sum(float v) {
#pragma unroll
    for (int o = 1; o < 64; o <<= 1) v += __shfl_xor(v, o);
    return v;
}
__device__ __forceinline__ float dpp_sum63(float x) {
    int v;
    v = __builtin_amdgcn_update_dpp(0, __builtin_bit_cast(int, x), 0xB1, 0xF, 0xF, false); x += __builtin_bit_cast(float, v);
    v = __builtin_amdgcn_update_dpp(0, __builtin_bit_cast(int, x), 0x4E, 0xF, 0xF, false); x += __builtin_bit_cast(float, v);
    v = __builtin_amdgcn_update_dpp(0, __builtin_bit_cast(int, x), 0x141, 0xF, 0xF, false); x += __builtin_bit_cast(float, v);
    v = __builtin_amdgcn_update_dpp(0, __builtin_bit_cast(int, x), 0x140, 0xF, 0xF, false); x += __builtin_bit_cast(float, v);
    v = __builtin_amdgcn_update_dpp(0, __builtin_bit_cast(int, x), 0x142, 0xA, 0xF, false); x += __builtin_bit_cast(float, v);
    v = __builtin_amdgcn_update_dpp(0, __builtin_bit_cast(int, x), 0x143, 0xC, 0xF, false); x += __builtin_bit_cast(float, v);
    return __builtin_bit_cast(float, __builtin_amdgcn_readlane(__builtin_bit_cast(int, x), 63));
}
__device__ __forceinline__ int crow(int r, int hi) { return (r & 3) + 8 * (r >> 2) + 4 * hi; }
__device__ __forceinline__ constexpr int crc(int r) { return (r & 3) + 8 * (r >> 2); }

namespace pg8 {
constexpr int BM = 256, BK = 64, HALF = 128, HTB = HALF * BK * 2, NXCD = 8, WGM = 8;
__host__ __device__ __forceinline__ int lds_byte(int r, int c) { const int st = (r >> 4) * 2 + (c >> 5), rr = r & 15, cc = c & 31, ob = rr * 64 + cc * 2; return st * 1024 + (ob ^ (((ob >> 9) & 1) << 5)); }
__host__ __device__ __forceinline__ void stage_rc(int b, int& R, int& C) { const int st = b / 1024, sb = b % 1024, swz = sb ^ (((sb >> 9) & 1) << 5); R = (st >> 1) * 16 + swz / 64; C = (st & 1) * 32 + (swz % 64) / 2; }
__host__ __device__ __forceinline__ int perm32(int rho) { const int n = rho >> 4, i = rho & 15; return 8 * (i >> 2) + 4 * n + (i & 3); }
struct Unit { int pm, pn; long bofs; };
struct Gemm { const bf16_t* A; const bf16_t* Bt; int M, N, K; };
struct StaticOrder {
    int nM, nN, nwg, G, c;
    __device__ void init(int M, int N, int G_, int c_) { nM = M / BM; nN = N / BM; nwg = nM * nN; G = G_; c = c_; }
    __device__ bool next(int i, Unit& u) const {
        const long L = (long)i * G + c; if (L >= nwg) return false;
        int wgid = (int)L; { const int q = nwg / NXCD, r = nwg % NXCD, xcd = wgid % NXCD, off = wgid / NXCD; wgid = (xcd < r ? xcd * (q + 1) : r * (q + 1) + (xcd - r) * q) + off; }
        const int nig = WGM * nN, gid = wgid / nig, fm = gid * WGM, gsz = (nM - fm) < WGM ? (nM - fm) : WGM;
        u.pm = fm + ((wgid % nig) % gsz); u.pn = (wgid % nig) / gsz; u.bofs = 0; return true;
    }
};
struct MoeOrder {
    int toff[NEXP + 1]; int nN, G, c; long estride;
    __device__ void init(const unsigned* cnt, int nN_, int G_, int c_, long estride_) {
        nN = nN_; G = G_; c = c_; estride = estride_; int t = 0;
#pragma unroll
        for (int e = 0; e < NEXP; ++e) { toff[e] = t; t += (int)((cnt[e] + 255u) >> 8); }
        toff[NEXP] = t;
    }
    __device__ bool next(int i, Unit& u) const {
        const long L = (long)i * G + c; if (L >= (long)toff[NEXP] * nN) return false;
        const int pm = (int)(L / nN); u.pm = pm; u.pn = (int)(L % nN); int e = 0;
#pragma unroll
        for (int j = 1; j < NEXP; ++j) e += (pm >= toff[j]) ? 1 : 0;
        u.bofs = (long)e * estride; return true;
    }
};

template <class Epi, class Sched>
__device__ __forceinline__ void gemm_phase(LAS unsigned char* lds, const Gemm g, const Sched& S, const Epi& E) {
    constexpr bool ALIGN_EPI = true;
    const int tid = threadIdx.x, wid = __builtin_amdgcn_readfirstlane(tid >> 6), lane = tid & 63, wr = wid >> 2, wc = wid & 3, fr = lane & 15, fq = lane >> 4;
    const int K = g.K, nt = K / BK;
    unsigned voffA[2], voffB[2];
#pragma unroll
    for (int i = 0; i < 2; ++i) { int R, C; stage_rc(tid * 16 + i * 8192, R, C); const int Rb = Epi::PERM ? ((R & ~31) + perm32(R & 31)) : R;
        voffA[i] = (unsigned)(R * K + C) * 2u; voffB[i] = (unsigned)(Rb * K + C) * 2u; }
    const size_t kstep = (size_t)(BK * 2);
    const size_t hstep = (size_t)HALF * K * 2;
    const size_t tstep = 2 * hstep;
    const unsigned ldsw = (unsigned)wid * 1024u;
    const int aoff = lds_byte(wr * 64 + fr, fq * 8), boff = lds_byte(wc * 32 + fr, fq * 8);
#define PG8_SA(b, h) (((b) * 2 + (h)) * HTB)
#define PG8_SB(b, h) ((4 + (b) * 2 + (h)) * HTB)
#define PG8_STAGE(bufoff, gbase, voff) do { _Pragma("unroll") for (int _i = 0; _i < 2; ++_i) \
        __builtin_amdgcn_global_load_lds((const unsigned*)((const char*)(gbase) + (voff)[_i]), (LAS unsigned*)(lds + (bufoff) + ldsw + _i * 8192), 16, 0, 0); } while (0)
#define PG8_LDA(dst, b, h) do { _Pragma("unroll") for (int m = 0; m < 4; ++m) _Pragma("unroll") for (int k = 0; k < 2; ++k) dst[m][k] = *(const LAS bf16x8*)(lds + PG8_SA(b, h) + aoff + m * 2048 + k * 1024); } while (0)
#define PG8_LDB(dst, b, h) do { _Pragma("unroll") for (int n = 0; n < 2; ++n) _Pragma("unroll") for (int k = 0; k < 2; ++k) dst[n][k] = *(const LAS bf16x8*)(lds + PG8_SB(b, h) + boff + n * 2048 + k * 1024); } while (0)
#define PG8_MMA(ai, bj, At, Bt) do { __builtin_amdgcn_s_setprio(1); _Pragma("unroll") for (int m = 0; m < 4; ++m) _Pragma("unroll") for (int n = 0; n < 2; ++n) _Pragma("unroll") for (int k = 0; k < 2; ++k) \
        acc[ai][bj][m][n] = __builtin_amdgcn_mfma_f32_16x16x32_bf16(Bt[n][k], At[m][k], acc[ai][bj][m][n], 0, 0, 0); __builtin_amdgcn_s_setprio(0); } while (0)
#define PG8_WAIT_V(n) asm volatile("s_waitcnt vmcnt(" #n ")" ::: "memory")
#define PG8_WAIT_L(n) asm volatile("s_waitcnt lgkmcnt(" #n ")" ::: "memory")
#define PG8_BAR __builtin_amdgcn_s_barrier()
#define PG8_SCHED __builtin_amdgcn_sched_barrier(0)
    Unit cur, nxt; int ui = 0;
    if (!S.next(0, cur)) return;
    f32x4 acc[2][2][4][2];
#pragma unroll
    for (int a = 0; a < 2; ++a)
#pragma unroll
        for (int b = 0; b < 2; ++b)
#pragma unroll
            for (int m = 0; m < 4; ++m)
#pragma unroll
                for (int n = 0; n < 2; ++n) acc[a][b][m][n] = (f32x4){0.f, 0.f, 0.f, 0.f};
    bf16x8 At[4][2], B0[2][2], B1[2][2];
    const char* cA = (const char*)g.A + (size_t)cur.pm * tstep; const char* cB = (const char*)g.Bt + cur.bofs + (size_t)cur.pn * tstep;
    PG8_STAGE(PG8_SB(0, 0), cB, voffB); PG8_STAGE(PG8_SB(0, 1), cB + hstep, voffB); PG8_STAGE(PG8_SA(0, 0), cA, voffA); PG8_STAGE(PG8_SA(0, 1), cA + hstep, voffA);
    if (wr == 1) PG8_BAR;
    PG8_WAIT_V(2); PG8_BAR;
    PG8_STAGE(PG8_SB(1, 0), cB + kstep, voffB); PG8_STAGE(PG8_SA(1, 0), cA + kstep, voffA); PG8_STAGE(PG8_SB(1, 1), cB + hstep + kstep, voffB);
    PG8_WAIT_V(6); PG8_BAR;
    for (;;) {
        const bool has_next = S.next(ui + 1, nxt);
        const char* nA = has_next ? (const char*)g.A + (size_t)nxt.pm * tstep : cA; const char* nB = has_next ? (const char*)g.Bt + nxt.bofs + (size_t)nxt.pn * tstep : cB;
        for (int t = 0; t < nt; t += 2) {
            const bool last = (t == nt - 2);
            const char* a1 = cA + (size_t)(t + 1) * kstep;
            const char* a2 = last ? nA : cA + (size_t)(t + 2) * kstep; const char* b2 = last ? nB : cB + (size_t)(t + 2) * kstep;
            const char* a3 = a2 + kstep; const char* b3 = b2 + kstep;
            PG8_LDB(B0, 0, 0); PG8_LDB(B1, 0, 1); PG8_SCHED; PG8_LDA(At, 0, 0); PG8_STAGE(PG8_SA(1, 1), a1 + hstep, voffA);
            PG8_WAIT_V(8); PG8_WAIT_L(0); PG8_BAR; PG8_MMA(0, 0, At, B0); PG8_MMA(0, 1, At, B1); PG8_BAR; PG8_SCHED;
            PG8_LDA(At, 0, 1); PG8_STAGE(PG8_SB(0, 0), b2, voffB); PG8_STAGE(PG8_SB(0, 1), b2 + hstep, voffB); PG8_STAGE(PG8_SA(0, 0), a2, voffA);
            PG8_WAIT_V(8); PG8_WAIT_L(0); PG8_BAR; PG8_MMA(1, 0, At, B0); PG8_MMA(1, 1, At, B1); PG8_BAR; PG8_SCHED;
            PG8_LDB(B0, 1, 0); PG8_LDB(B1, 1, 1); PG8_SCHED; PG8_LDA(At, 1, 0); PG8_STAGE(PG8_SA(0, 1), a2 + hstep, voffA);
            PG8_WAIT_V(8); PG8_WAIT_L(0); PG8_BAR; PG8_MMA(0, 0, At, B0); PG8_MMA(0, 1, At, B1); PG8_BAR; PG8_SCHED;
            PG8_LDA(At, 1, 1); PG8_STAGE(PG8_SB(1, 0), b3, voffB); PG8_STAGE(PG8_SB(1, 1), b3 + hstep, voffB); PG8_STAGE(PG8_SA(1, 0), a3, voffA);
            PG8_WAIT_V(8); PG8_WAIT_L(0); PG8_BAR; PG8_MMA(1, 0, At, B0); PG8_MMA(1, 1, At, B1); PG8_BAR; PG8_SCHED;
        }
        if constexpr (ALIGN_EPI) { if (wr == 0) PG8_BAR; }
        E(acc, cur, wr, wc, fr, fq);
        if (!has_next) break;
#pragma unroll
        for (int a = 0; a < 2; ++a)
#pragma unroll
            for (int b = 0; b < 2; ++b)
#pragma unroll
                for (int m = 0; m < 4; ++m)
#pragma unroll
                    for (int n = 0; n < 2; ++n) acc[a][b][m][n] = (f32x4){0.f, 0.f, 0.f, 0.f};
        cur = nxt; cA = nA; cB = nB; ++ui;
        if constexpr (ALIGN_EPI) { if (wr == 1) PG8_BAR; }
    }
    PG8_WAIT_V(0);
    if constexpr (!ALIGN_EPI) { if (wr == 0) PG8_BAR; }
    PG8_BAR;
#undef PG8_SA
#undef PG8_SB
#undef PG8_STAGE
#undef PG8_LDA
#undef PG8_LDB
#undef PG8_MMA
#undef PG8_WAIT_V
#undef PG8_WAIT_L
#undef PG8_BAR
#undef PG8_SCHED
}

struct EpiBf16 {
    static constexpr bool PERM = true;
    bf16_t* O; int ldc;
    __device__ __forceinline__ void operator()(const f32x4 (&acc)[2][2][4][2], const Unit& u, int wr, int wc, int fr, int fq) const {
        const int row0 = u.pm * BM + wr * 64 + fr, col0 = u.pn * BM + wc * 32 + 8 * fq;
#pragma unroll
        for (int ai = 0; ai < 2; ++ai)
#pragma unroll
            for (int m = 0; m < 4; ++m) { bf16_t* rowp = O + (size_t)(row0 + ai * HALF + m * 16) * ldc + col0;
#pragma unroll
                for (int bj = 0; bj < 2; ++bj) { const f32x4 v0 = acc[ai][bj][m][0], v1 = acc[ai][bj][m][1];
                    u32x4 w; w.x = pk2(v0[0], v0[1]); w.y = pk2(v0[2], v0[3]); w.z = pk2(v1[0], v1[1]); w.w = pk2(v1[2], v1[3]);
                    *(u32x4*)(rowp + bj * HALF) = w; } }
    }
};
struct EpiRes {
    static constexpr bool PERM = false;
    const float* base; float* out; bf16_t* xn; const float* gw; const float* bias; float* ss;
    __device__ __forceinline__ void operator()(const f32x4 (&acc)[2][2][4][2], const Unit& u, int wr, int wc, int fr, int fq) const {
        const int col0 = u.pn * BM + wc * 32 + 4 * fq;
        f32x4 gv[2][2], bv[2][2];
#pragma unroll
        for (int bj = 0; bj < 2; ++bj)
#pragma unroll
            for (int n = 0; n < 2; ++n) { gv[bj][n] = *(const f32x4*)(gw + col0 + bj * HALF + n * 16); bv[bj][n] = bias ? *(const f32x4*)(bias + col0 + bj * HALF + n * 16) : (f32x4){0.f, 0.f, 0.f, 0.f}; }
#pragma unroll
        for (int ai = 0; ai < 2; ++ai)
#pragma unroll
            for (int m = 0; m < 4; ++m) { const int row = u.pm * BM + ai * HALF + wr * 64 + m * 16 + fr; const size_t off = (size_t)row * DM + col0; float s = 0.f;
#pragma unroll
                for (int bj = 0; bj < 2; ++bj)
#pragma unroll
                    for (int n = 0; n < 2; ++n) { const f32x4 bs = *(const f32x4*)(base + off + bj * HALF + n * 16); const f32x4 o = bs + acc[ai][bj][m][n] + bv[bj][n];
                        *(f32x4*)(out + off + bj * HALF + n * 16) = o; s += (o[0] * o[0] + o[1] * o[1]) + (o[2] * o[2] + o[3] * o[3]);
                        const f32x4 x = o * gv[bj][n]; u32x2 w; w.x = pk2(x[0], x[1]); w.y = pk2(x[2], x[3]); *(u32x2*)(xn + off + bj * HALF + n * 16) = w; }
                s += __shfl_xor(s, 16); s += __shfl_xor(s, 32);
                if (fq == 0) ss[(size_t)row * 16 + u.pn * 4 + wc] = s; }
    }
};
__device__ __forceinline__ float rstd_from_ss(const float* ss, int row) {
    const f32x4* p = (const f32x4*)(ss + (size_t)row * 16); const f32x4 a = p[0], b = p[1], c = p[2], d = p[3];
    const float t = ((a[0] + a[1]) + (a[2] + a[3])) + ((b[0] + b[1]) + (b[2] + b[3])) + ((c[0] + c[1]) + (c[2] + c[3])) + ((d[0] + d[1]) + (d[2] + d[3]));
    return 1.0f / sqrtf(t * (1.0f / DM) + EPS);
}
struct EpiSwiglu {
    static constexpr bool PERM = true;
    bf16_t* O; int ldc; const float* ss; const float* rstd;
    __device__ __forceinline__ void operator()(const f32x4 (&acc)[2][2][4][2], const Unit& u, int wr, int wc, int fr, int fq) const {
        const int row0 = u.pm * BM + wr * 64 + fr, col0 = u.pn * HALF + wc * 32 + 8 * fq;
#pragma unroll
        for (int ai = 0; ai < 2; ++ai)
#pragma unroll
            for (int m = 0; m < 4; ++m) { const int row = row0 + ai * HALF + m * 16; const float rs = ss ? rstd_from_ss(ss, row) : rstd[row];
                float h[8];
#pragma unroll
                for (int n = 0; n < 2; ++n)
#pragma unroll
                    for (int i = 0; i < 4; ++i) { const float gg = acc[ai][0][m][n][i] * rs, uu = acc[ai][1][m][n][i] * rs; h[n * 4 + i] = siluf_(gg) * uu; }
                *(u32x4*)(O + (size_t)row * ldc + col0) = pack8(h); }
    }
};
struct EpiQkv {
    static constexpr bool PERM = true;
    bf16_t* O; const float* ss; const float* bias; const float* qn; const float* kn; const float* rope;
    __device__ __forceinline__ void operator()(const f32x4 (&acc)[2][2][4][2], const Unit& u, int wr, int wc, int fr, int fq) const {
        const int hd = u.pn * 4 + wc, row0 = u.pm * BM + wr * 64 + fr; const int kind = u.pn < 4 ? 0 : (u.pn == 4 ? 1 : 2);
        const float* nw = kind == 0 ? qn : kn;
        float bv[2][8], nv[2][8];
#pragma unroll
        for (int bj = 0; bj < 2; ++bj)
#pragma unroll
            for (int j = 0; j < 8; ++j) { bv[bj][j] = bias[hd * 64 + bj * 32 + fq * 8 + j]; nv[bj][j] = nw[bj * 32 + fq * 8 + j]; }
#pragma unroll
        for (int ai = 0; ai < 2; ++ai)
#pragma unroll
            for (int m = 0; m < 4; ++m) { const int row = row0 + ai * HALF + m * 16; const float rs = rstd_from_ss(ss, row);
                float v[2][8]; float s = 0.f;
#pragma unroll
                for (int bj = 0; bj < 2; ++bj)
#pragma unroll
                    for (int n = 0; n < 2; ++n)
#pragma unroll
                        for (int i = 0; i < 4; ++i) { const float x = acc[ai][bj][m][n][i] * rs + bv[bj][n * 4 + i]; v[bj][n * 4 + i] = x; s += x * x; }
                if (kind < 2) {
                    s += __shfl_xor(s, 16); s += __shfl_xor(s, 32);
                    const float r2 = 1.0f / sqrtf(s * (1.0f / 64.0f) + EPS);
#pragma unroll
                    for (int bj = 0; bj < 2; ++bj)
#pragma unroll
                        for (int j = 0; j < 8; ++j) v[bj][j] = v[bj][j] * r2 * nv[bj][j];
                    const f32x4* rp = (const f32x4*)(rope + (size_t)row * 16);
                    const f32x4 c0 = rp[0], c1 = rp[1], s0 = rp[2], s1 = rp[3];
#pragma unroll
                    for (int j = 0; j < 8; ++j) { const float other = __shfl_xor(v[0][j], 16); const float cc = j < 4 ? c0[j] : c1[j - 4], sn = j < 4 ? s0[j] : s1[j - 4];
                        const float mine = v[0][j]; const float rot = (fq == 0) ? (mine * cc - other * sn) : (mine * cc + other * sn);
                        v[0][j] = (fq < 2) ? rot : mine; }
                }
#pragma unroll
                for (int bj = 0; bj < 2; ++bj) *(u32x4*)(O + (size_t)row * 1536 + hd * 64 + bj * 32 + fq * 8) = pack8(v[bj]);
            }
    }
};
}

#define XB_TMO      128
#define XB_XCNT(j)  (256  + 64 * (j))
#define XB_XSUB(j)  (1280 + 64 * (j))
#define XB_XGEN(j)  (2304 + 64 * (j))
#define XB_TOP      3328
#define XB_TOPGEN   3392
#define XCD_BAR_WORDS 3456
#define XB_SPIN_CAP (1u << 20)
__device__ __forceinline__ unsigned xb_ld(unsigned* p)              { return __hip_atomic_load(p, __ATOMIC_RELAXED, __HIP_MEMORY_SCOPE_AGENT); }
__device__ __forceinline__ unsigned xb_add(unsigned* p, unsigned v) { return __hip_atomic_fetch_add(p, v, __ATOMIC_RELAXED, __HIP_MEMORY_SCOPE_AGENT); }
__device__ __forceinline__ unsigned xb_xcc_id() { return (unsigned)__builtin_amdgcn_s_getreg((3 << 11) | 20) & 0xFu; }
#define XB_SPIN(cond, bar) do { unsigned _sp = 0; while (cond) { __builtin_amdgcn_s_sleep(1); \
    if ((++_sp & 255u) == 0u) { if (xb_ld(&(bar)[XB_TMO])) break; if (_sp > XB_SPIN_CAP) { atomicAdd(&(bar)[XB_TMO], 1u); break; } } } } while (0)
struct XcdBarrier { unsigned* bar; unsigned x; volatile LAS unsigned* st; };
__device__ __forceinline__ XcdBarrier xcd_barrier_post(unsigned* bar, volatile LAS unsigned* st) {
    XcdBarrier b; b.bar = bar; b.x = xb_xcc_id(); b.st = st;
    if (threadIdx.x == 0) (void)xb_add(&bar[XB_XCNT(b.x)], 1u);
    return b;
}
__device__ __forceinline__ void xcd_barrier_complete(unsigned* bar, unsigned x, unsigned& nloc, unsigned& nx) {
    const unsigned G = gridDim.x * gridDim.y * gridDim.z;
    unsigned sum, cnt, mine, sp = 0u;
    for (;;) {
        sum = 0u; cnt = 0u; mine = 0u;
#pragma unroll
        for (unsigned j = 0; j < 16; ++j) { const unsigned c = xb_ld(&bar[XB_XCNT(j)]); sum += c; cnt += (c > 0u) ? 1u : 0u; mine = (j == x) ? c : mine; }
        if (sum == G) break;
        __builtin_amdgcn_s_sleep(1);
        if ((++sp & 255u) == 0u) { if (xb_ld(&bar[XB_TMO])) break; if (sp > XB_SPIN_CAP) { atomicAdd(&bar[XB_TMO], 1u); break; } }
    }
    nloc = mine > 0u ? mine : 1u; nx = cnt > 0u ? cnt : 1u;
}
__device__ __forceinline__ void xcd_barrier(const XcdBarrier& b) {
    asm volatile("s_waitcnt vmcnt(0)" ::: "memory");
    __syncthreads();
    if (threadIdx.x == 0) {
        unsigned* bar = b.bar;
        __builtin_amdgcn_s_waitcnt(0);
        unsigned nloc = b.st[0], nx = b.st[1];
        if (nloc == 0u) { xcd_barrier_complete(bar, b.x, nloc, nx); b.st[0] = nloc; b.st[1] = nx; }
        const unsigned old = xb_add(&bar[XB_XSUB(b.x)], 1u);
        const unsigned gen = old / nloc;
        if (old + 1u == (gen + 1u) * nloc) {
            __builtin_amdgcn_fence(__ATOMIC_RELEASE, "agent");
            asm volatile("s_waitcnt vmcnt(0)" ::: "memory");
            const unsigned og = xb_add(&bar[XB_TOP], 1u);
            const unsigned tg = og / nx;
            if (og + 1u == (tg + 1u) * nx) xb_add(&bar[XB_TOPGEN], 1u);
            else XB_SPIN(xb_ld(&bar[XB_TOPGEN]) == tg, bar);
            __builtin_amdgcn_fence(__ATOMIC_ACQUIRE, "agent");
            xb_add(&bar[XB_XGEN(b.x)], 1u);
            asm volatile("s_waitcnt vmcnt(0)" ::: "memory");
        } else {
            XB_SPIN(xb_ld(&bar[XB_XGEN(b.x)]) == gen, bar);
            __builtin_amdgcn_fence(__ATOMIC_ACQUIRE, "agent");
            asm volatile("s_waitcnt vmcnt(0)" ::: "memory");
        }
    }
    __syncthreads();
}

struct Args { const float* in[39]; const int* pos; float* out; unsigned char* ws; int ph_lo, ph_hi; };
enum InIdx { I_X = 0, I_NORM_MIX0 = 1, I_W_IN, I_MU, I_W0, I_WDEC, I_A0, I_WICL, I_WGAT, I_KK, I_KA, I_RK, I_GNW, I_GNB, I_CONVW, I_CONVB, I_DTB, I_ALOG, I_DSKIP, I_SSDN,
             I_WOUT, I_NORM_FFN0, I_FG, I_FU, I_FD, I_NORM_MIX1, I_WQKV, I_BQKV, I_QN, I_KN, I_SINK, I_WO, I_BO, I_NORM_FFN1, I_ROUTER, I_EG, I_EU, I_ED };

__device__ __forceinline__ void transpose_item(const float* W, int ld, int K, int k0, int n0, bf16_t* WT, int drow, LAS float* scr, int lane) {
#pragma unroll 8
    for (int i = 0; i < 32; ++i) { const int kk = 2 * i + (lane >> 5); scr[kk * 33 + (lane & 31)] = W[(size_t)(k0 + kk) * ld + n0 + (lane & 31)]; }
    asm volatile("s_waitcnt lgkmcnt(0)" ::: "memory");
    const int c = lane & 7;
#pragma unroll
    for (int j = 0; j < 4; ++j) { const int n = (lane >> 3) + 8 * j; const LAS float* s = scr + (8 * c) * 33 + n;
        u32x4 o; o.x = pk2(s[0 * 33], s[1 * 33]); o.y = pk2(s[2 * 33], s[3 * 33]); o.z = pk2(s[4 * 33], s[5 * 33]); o.w = pk2(s[6 * 33], s[7 * 33]);
        *(u32x4*)(WT + (size_t)(drow + n) * K + k0 + 8 * c) = o; }
    asm volatile("s_waitcnt lgkmcnt(0)" ::: "memory");
}
__device__ __forceinline__ int drow_of(int kind, int n0) {
    if (kind == 0) return n0;
    if (kind == 1) return 256 * (n0 >> 7) + (n0 & 127);
    if (kind == 2) return 256 * (n0 >> 7) + 128 + (n0 & 127);
    const int hd = n0 >> 6, bj = (n0 >> 5) & 1; return 256 * (hd >> 2) + 128 * bj + 32 * (hd & 3);
}
__device__ __forceinline__ bool transpose_matrix(int& it, const float* W, int ld, int K, int ncols, bf16_t* WT, int kind, LAS float* scr, int lane) {
    const int nnb = ncols / 32, items = (K / 64) * nnb;
    if (it < items) { const int kb = it / nnb, nb = it % nnb; transpose_item(W, ld, K, 64 * kb, 32 * nb, WT, drow_of(kind, 32 * nb), scr, lane); return true; }
    it -= items; return false;
}

#ifndef DUPM
#define DUPM 0u
#endif

#define XN ((bf16_t*)(ws + WS_XN))
#define MIX ((bf16_t*)(ws + WS_MIX))
#define PROJ ((bf16_t*)(ws + WS_PROJ))
#define GOUT ((bf16_t*)(ws + WS_GOUT))
#define XNB ((bf16_t*)(ws + WS_XNB))
#define HID ((bf16_t*)(ws + WS_HID))
#define QKV ((bf16_t*)(ws + WS_QKV))
#define ATTO ((bf16_t*)(ws + WS_ATTO))
#define AS ((bf16_t*)(ws + WS_AS))
#define HS ((bf16_t*)(ws + WS_HS))
#define XBCC ((bf16_t*)(ws + WS_EGU))
#define SSTATE ((bf16_t*)(ws + 38 * MiB))
#define CHDEC ((float*)(ws + WS_TOPE))
#define DTSP ((float*)(ws + WS_DTSP))
#define KKR ((float*)(ws + WS_KKR))
#define ROPE ((float*)(ws + WS_ROPE))
#define SS ((float*)(ws + WS_SS))
#define TOPE ((int*)(ws + WS_TOPE))
#define RANK ((int*)(ws + WS_RANK))
#define TOPW ((float*)(ws + WS_TOPW))
#define POS ((int*)(ws + WS_POS))
#define RSTD4 ((float*)(ws + WS_RSTD4))
#define RSTDS ((float*)(ws + WS_RSTDS))
#define WDEC ((bf16_t*)(ws + WS_WDEC))
#define WICL ((bf16_t*)(ws + WS_WICL))
#define WGAT ((bf16_t*)(ws + WS_WGAT))
#define EGU ((bf16_t*)(ws + WS_EGU))
#define EDN ((bf16_t*)(ws + WS_EDN))
#define WIN ((bf16_t*)(ws + WS_WIN))
#define WOUT ((bf16_t*)(ws + WS_WOUT))
#define WGU ((bf16_t*)(ws + WS_WGU))
#define WDN ((bf16_t*)(ws + WS_WDN))
#define WQKV ((bf16_t*)(ws + WS_WQKV))
#define WO ((bf16_t*)(ws + WS_WO))
__global__ void __launch_bounds__(512, 2) fwd_kernel(Args args) {
    extern __shared__ __attribute__((aligned(16))) unsigned char lds_raw[];
    LAS unsigned char* lds = (LAS unsigned char*)lds_raw;
    volatile LAS unsigned* MISC = (volatile LAS unsigned*)(lds + MISC_OFF);
    const int tid = threadIdx.x, lane = tid & 63, wave = __builtin_amdgcn_readfirstlane(tid >> 6);
    const int G = gridDim.x, bx = blockIdx.x;
    const int vcu = (G % 8 == 0) ? (bx % 8) * (G / 8) + bx / 8 : bx;
    unsigned char* ws = args.ws;
    unsigned* ctl = (unsigned*)(ws + WS_CTL);
    float* dout = args.out;
    if (tid < 32) ((LAS unsigned*)(lds + MISC_OFF))[tid] = 0u;
    __syncthreads();
    XcdBarrier bar = xcd_barrier_post(ctl + CW_BAR, MISC + 8);
    const int lo = args.ph_lo, hi = args.ph_hi;
#define IN(k) (lo <= (k) && (k) < hi)
#if DUPM
#define PHASE(k) for (int rep_ = 0; rep_ <= (int)((DUPM >> (k)) & 1u); ++rep_) if (IN(k))
#define REPBAR if (rep_) xcd_barrier(bar);
#else
#define PHASE(k) if (IN(k))
#define REPBAR
#endif
#define SEAM(k) do { if (IN(k) && IN((k) + 1)) xcd_barrier(bar); } while (0)
    const int gw = vcu * 8 + wave, NGW = G * 8;

    unsigned* CNT = ctl + CW_CNT;

    PHASE(0) { REPBAR
        LAS float* scr = (LAS float*)(lds + wave * 16384);
        for (int it0 = gw; ; it0 += NGW) {
            int it = it0;
            if (transpose_matrix(it, args.in[I_W_IN], IN0, DM, NPROJ, WIN, 0, scr, lane)) continue;
            if (transpose_matrix(it, args.in[I_WOUT], DM, DM, DM, WOUT, 0, scr, lane)) continue;
            if (transpose_matrix(it, args.in[I_FG], FFN, DM, FFN, WGU, 1, scr, lane)) continue;
            if (transpose_matrix(it, args.in[I_FU], FFN, DM, FFN, WGU, 2, scr, lane)) continue;
            if (transpose_matrix(it, args.in[I_FD], DM, FFN, DM, WDN, 0, scr, lane)) continue;
            if (transpose_matrix(it, args.in[I_WQKV], 1536, DM, 1536, WQKV, 3, scr, lane)) continue;
            if (transpose_matrix(it, args.in[I_WO], DM, DM, DM, WO, 0, scr, lane)) continue;
            if (transpose_matrix(it, args.in[I_WDEC], 512, 64, 512, WDEC, 0, scr, lane)) continue;
            if (transpose_matrix(it, args.in[I_WICL], 512, 64, 512, WICL, 0, scr, lane)) continue;
            if (transpose_matrix(it, args.in[I_WGAT], 512, 128, 512, WGAT, 0, scr, lane)) continue;
            break;
        }
        __syncthreads();
        LAS float* w8 = (LAS float*)lds;
        for (int r = tid; r < DM; r += 512) { const float* p = args.in[I_W_IN] + (size_t)r * IN0 + NPROJ; *(LAS f32x4*)(w8 + r * 8) = *(const f32x4*)p; *(LAS f32x4*)(w8 + r * 8 + 4) = *(const f32x4*)(p + 4); }
        __syncthreads();
        const float* gm = args.in[I_NORM_MIX0];
        for (int m = gw; m < MTOK; m += NGW) {
            const f32x4* xr = (const f32x4*)(args.in[I_X] + (size_t)m * DM) + lane;
            f32x4 v[4]; float s = 0.f;
#pragma unroll
            for (int j = 0; j < 4; ++j) { v[j] = xr[64 * j]; s += (v[j][0] * v[j][0] + v[j][1] * v[j][1]) + (v[j][2] * v[j][2] + v[j][3] * v[j][3]); }
            const float rstd = 1.0f / sqrtf(wave_sum(s) * (1.0f / DM) + EPS);
            float d[8];
#pragma unroll
            for (int k = 0; k < 8; ++k) d[k] = 0.f;
            unsigned long long* o8 = (unsigned long long*)(XN + (size_t)m * DM) + lane;
#pragma unroll
            for (int j = 0; j < 4; ++j) { const f32x4 g4 = ((const f32x4*)gm)[64 * j + lane]; const f32x4 y = v[j] * rstd * g4;
                o8[64 * j] = (unsigned long long)pk2(y[0], y[1]) | ((unsigned long long)pk2(y[2], y[3]) << 32);
#pragma unroll
                for (int i = 0; i < 4; ++i) { const int c = 256 * j + 4 * lane + i; const f32x4 wa = *(const LAS f32x4*)(w8 + c * 8), wb = *(const LAS f32x4*)(w8 + c * 8 + 4);
                    d[0] += y[i] * wa[0]; d[1] += y[i] * wa[1]; d[2] += y[i] * wa[2]; d[3] += y[i] * wa[3]; d[4] += y[i] * wb[0]; d[5] += y[i] * wb[1]; d[6] += y[i] * wb[2]; d[7] += y[i] * wb[3]; } }
#pragma unroll
            for (int k = 0; k < 8; ++k) d[k] = wave_sum(d[k]);
            if (lane < 8) { float dv = d[0];
#pragma unroll
                for (int k = 1; k < 8; ++k) dv = (lane == k) ? d[k] : dv;
                const float z = dv + args.in[I_DTB][lane]; DTSP[(size_t)m * 8 + lane] = z > 20.f ? z : log1pf(__expf(z)); }
            if (lane >= 16 && lane < 24) { const int j = lane - 16; const double inv = exp(-(double)j * 0.125 * 13.122363377404328); const double ang = (double)args.pos[m] * inv;
                ROPE[(size_t)m * 16 + j] = (float)cos(ang); ROPE[(size_t)m * 16 + 8 + j] = (float)sin(ang); }
        }
        __syncthreads();
    }
    SEAM(0);

    PHASE(1) { REPBAR
        pg8::Gemm g{XN, WIN, MTOK, NPROJ, DM}; pg8::StaticOrder S; S.init(MTOK, NPROJ, G, bx);
        pg8::EpiBf16 E{PROJ, NPROJ};
        pg8::gemm_phase(lds, g, S, E);
    }
    SEAM(1);

    const int r32 = lane & 31, hh = lane >> 5, trq = (lane & 15) >> 2, trc = 16 * ((lane >> 4) & 1) + 4 * (lane & 3);
#define TRF(M, P, s, blk) ({ const LAS bf16_t* p_ = (M) + (16 * (s) + 8 * hh + trq) * (P) + 32 * (blk) + trc; \
        const s16x4 lo_ = __builtin_bit_cast(s16x4, __builtin_amdgcn_ds_read_tr16_b64_v4i16((LAS s16x4*)p_)); \
        const s16x4 hi_ = __builtin_bit_cast(s16x4, __builtin_amdgcn_ds_read_tr16_b64_v4i16((LAS s16x4*)(p_ + 4 * (P)))); \
        (bf16x8){lo_[0], lo_[1], lo_[2], lo_[3], hi_[0], hi_[1], hi_[2], hi_[3]}; })
#define NATF(M, P, s, blk) (*(const LAS bf16x8*)((M) + (32 * (blk) + r32) * (P) + 16 * (s) + 8 * hh))
    PHASE(2) { REPBAR
        const float* mu = args.in[I_MU];
        LAS bf16_t* Aw = (LAS bf16_t*)lds; LAS bf16_t* Aa = (LAS bf16_t*)(lds + 9216); LAS bf16_t* Ag = (LAS bf16_t*)(lds + 18432);
        LAS float* LW = (LAS float*)(lds + 35840); LAS float* IC = LW + 4096;
        LAS bf16_t* At = (LAS bf16_t*)(lds + 68864); LAS bf16_t* Kt = At + 4608; LAS bf16_t* Bt = Kt + 4608; LAS bf16_t* Rt = Bt + 4608; LAS bf16_t* Vt = Rt + 4608;
        LAS bf16_t* XX = At;
        LAS bf16_t* Lak = (LAS bf16_t*)(lds + 114944); LAS bf16_t* Mrk = Lak + 4608; LAS bf16_t* Mrb = Mrk + 4608;
        LAS float* TOT = (LAS float*)(lds + 142592); LAS float* GAMC = TOT + 512;
        const int mt = (wave >> 1) & 1, nt = wave & 1, grp = wave >> 2;
        for (int unit = vcu; unit < MTOK / 64; unit += G) {
            const int m0 = unit * 64;
            {
                const int tt = tid >> 3, cg = tid & 7, m = m0 + tt; const bool hasprev = (m & (SEQ - 1)) != 0;
                const bf16_t* pc = PROJ + (size_t)m * NPROJ + 1536 + 32 * cg;
#pragma unroll 1
                for (int q = 0; q < 4; ++q) {
                    float c[8], p[8]; unpack8(*(const u32x4*)(pc + 8 * q), c);
                    if (hasprev) unpack8(*(const u32x4*)(pc - NPROJ + 8 * q), p); else { for (int i = 0; i < 8; ++i) p[i] = 0.f; }
                    float o[8];
#pragma unroll
                    for (int i = 0; i < 8; ++i) { const int col = 32 * cg + 8 * q + i; const float x = c[i] + (p[i] - c[i]) * mu[1536 + col];
                        o[i] = cg < 2 ? tanhf(x) : (cg < 4 ? x : sigmoidf_(x)); }
                    const u32x4 w = pack8(o); const int col0 = 32 * cg + 8 * q;
                    if (cg < 2) *(LAS u32x4*)(Aw + tt * 72 + col0) = w; else if (cg < 4) *(LAS u32x4*)(Aa + tt * 72 + (col0 - 64)) = w; else *(LAS u32x4*)(Ag + tt * 136 + (col0 - 128)) = w;
                }
            }
            __syncthreads();
#pragma unroll 1
            for (int h = 0; h < 8; ++h) {
                unsigned char* cs = (unsigned char*)dout + (size_t)(unit * 8 + h) * 24576;
                if (grp == 0) {
                    f32x16 ad, ai;
#pragma unroll
                    for (int r = 0; r < 16; ++r) { ad[r] = 0.f; ai[r] = 0.f; }
#pragma unroll
                    for (int s = 0; s < 4; ++s) {
                        const bf16x8 bd = *(const bf16x8*)(WDEC + (size_t)(64 * h + 32 * nt + r32) * 64 + 16 * s + 8 * hh), bi = *(const bf16x8*)(WICL + (size_t)(64 * h + 32 * nt + r32) * 64 + 16 * s + 8 * hh);
                        ad = __builtin_amdgcn_mfma_f32_32x32x16_bf16(NATF(Aw, 72, s, mt), bd, ad, 0, 0, 0);
                        ai = __builtin_amdgcn_mfma_f32_32x32x16_bf16(NATF(Aa, 72, s, mt), bi, ai, 0, 0, 0);
                    }
                    const int c = 32 * nt + r32; const float w0c = args.in[I_W0][64 * h + c], a0c = args.in[I_A0][64 * h + c];
                    LAS float* lwb = LW + (32 * mt + 4 * hh) * 64 + c;
#pragma unroll
                    for (int r = 0; r < 16; ++r) { lwb[crc(r) * 64] = -0.6065306597126334f * sigmoidf_(ad[r] + w0c); lwb[4096 + crc(r) * 64] = sigmoidf_(ai[r] + a0c); }
                } else {
                    f32x16 ag;
#pragma unroll
                    for (int r = 0; r < 16; ++r) ag[r] = 0.f;
#pragma unroll
                    for (int s = 0; s < 8; ++s) {
                        const bf16x8 bg = *(const bf16x8*)(WGAT + (size_t)(64 * h + 32 * nt + r32) * 128 + 16 * s + 8 * hh);
                        ag = __builtin_amdgcn_mfma_f32_32x32x16_bf16(NATF(Ag, 136, s, mt), bg, ag, 0, 0, 0);
                    }
                    bf16_t* gob = GOUT + (size_t)(m0 + 32 * mt + 4 * hh) * 512 + 64 * h + 32 * nt + r32;
#pragma unroll
                    for (int r = 0; r < 16; ++r) gob[crc(r) * 512] = (bf16_t)f2bf(ag[r]);
                }
                __syncthreads();
                {
                    const int c = lane, gc = 64 * h + c, t0 = 8 * wave;
                    const float mur = mu[gc], muk = mu[512 + gc], muv = mu[1024 + gc], kkc = args.in[I_KK][gc], kac = args.in[I_KA][gc], rkc = args.in[I_RK][gc];
                    const bf16_t* pp = PROJ + (size_t)(m0 + t0) * NPROJ + gc;
                    float pr = 0.f, pk = 0.f, pv = 0.f;
                    if (((m0 + t0) & (SEQ - 1)) != 0) { pr = bflo(pp[-NPROJ]); pk = bflo(pp[-NPROJ + 512]); pv = bflo(pp[-NPROJ + 1024]); }
                    float rr[8], kx[8], vv[8], an[8], bn[8], lw[8], cl[8]; float run = 0.f;
#pragma unroll
                    for (int i = 0; i < 8; ++i) {
                        const float r0 = bflo(pp[(size_t)i * NPROJ]), k0 = bflo(pp[(size_t)i * NPROJ + 512]), v0 = bflo(pp[(size_t)i * NPROJ + 1024]);
                        rr[i] = r0 + (pr - r0) * mur; const float kl = k0 + (pk - k0) * muk; vv[i] = v0 + (pv - v0) * muv; pr = r0; pk = k0; pv = v0;
                        const float ic = IC[(t0 + i) * 64 + c]; lw[i] = LW[(t0 + i) * 64 + c]; run += lw[i]; cl[i] = run;
                        const float xk = kl * kkc; const float ssq = dpp_sum63(xk * xk); const float kn = xk * (1.0f / sqrtf(ssq + 1e-12f));
                        an[i] = -kn; bn[i] = kn * ic; kx[i] = kl * (1.0f + (ic - 1.0f) * kac);
                        const float bon = dpp_sum63(rr[i] * kx[i] * rkc);
                        if (lane == 0) KKR[(size_t)(m0 + t0 + i) * 8 + h] = bon;
                    }
                    TOT[wave * 64 + c] = run;
                    __syncthreads();
                    float off = 0.f, totc = 0.f;
#pragma unroll
                    for (int w2 = 0; w2 < 8; ++w2) { const float tv = TOT[w2 * 64 + c]; totc += tv; off += (w2 < wave) ? tv : 0.f; }
                    if (wave == 0) GAMC[c] = __expf(totc);
#pragma unroll
                    for (int i = 0; i < 8; ++i) { const float cum = off + cl[i]; const float en = __expf(-cum), ep = __expf(cum), em = __expf(cum - lw[i]); const int o = (t0 + i) * 72 + c;
                        At[o] = (bf16_t)f2bf(an[i] * em); Kt[o] = (bf16_t)f2bf(kx[i] * en); Bt[o] = (bf16_t)f2bf(bn[i] * en); Rt[o] = (bf16_t)f2bf(rr[i] * ep); Vt[o] = (bf16_t)f2bf(vv[i]); }
                }
                __syncthreads();
                {
                    f32x16 pb, pk2_;
#pragma unroll
                    for (int r = 0; r < 16; ++r) { pb[r] = 0.f; pk2_[r] = 0.f; }
#pragma unroll
                    for (int s = 0; s < 4; ++s) {
                        if (grp == 0) { pb = __builtin_amdgcn_mfma_f32_32x32x16_bf16(NATF(Bt, 72, s, mt), NATF(At, 72, s, nt), pb, 0, 0, 0);
                                        pk2_ = __builtin_amdgcn_mfma_f32_32x32x16_bf16(NATF(At, 72, s, mt), NATF(Kt, 72, s, nt), pk2_, 0, 0, 0); }
                        else { const bf16x8 a = NATF(Rt, 72, s, mt);
                               pb = __builtin_amdgcn_mfma_f32_32x32x16_bf16(a, NATF(Bt, 72, s, nt), pb, 0, 0, 0);
                               pk2_ = __builtin_amdgcn_mfma_f32_32x32x16_bf16(a, NATF(Kt, 72, s, nt), pk2_, 0, 0, 0); }
                    }
                    const int sc = 32 * nt + r32, tb = 32 * mt + 4 * hh;
                    if (grp == 0) { LAS float* ltb = LW + tb * 64 + sc; LAS bf16_t* lkb = Lak + tb * 72 + sc;
#pragma unroll
                        for (int r = 0; r < 16; ++r) { const int t = tb + crc(r); ltb[crc(r) * 64] = (t < sc) ? pb[r] : 0.f;
                            lkb[crc(r) * 72] = (bf16_t)f2bf(sc < t ? pk2_[r] : 0.f); }
                    } else { LAS bf16_t* mbb = Mrb + tb * 72 + sc; LAS bf16_t* mkb = Mrk + tb * 72 + sc;
#pragma unroll
                        for (int r = 0; r < 16; ++r) { const bool keep = sc <= tb + crc(r); mbb[crc(r) * 72] = (bf16_t)f2bf(keep ? pb[r] : 0.f); mkb[crc(r) * 72] = (bf16_t)f2bf(keep ? pk2_[r] : 0.f); } }
                }
                __syncthreads();
                f32x16 accA, accB;
#pragma unroll
                for (int r = 0; r < 16; ++r) { accA[r] = 0.f; accB[r] = 0.f; }
                {
                    const LAS bf16_t* Aop = grp == 0 ? Lak : Mrk;
#pragma unroll
                    for (int s = 0; s < 4; ++s) { const bf16x8 vb = TRF(Vt, 72, s, nt);
                        if (grp == 0) { accA = __builtin_amdgcn_mfma_f32_32x32x16_bf16(NATF(Aop, 72, s, mt), vb, accA, 0, 0, 0); accB = __builtin_amdgcn_mfma_f32_32x32x16_bf16(TRF(Kt, 72, s, mt), vb, accB, 0, 0, 0); }
                        else accB = __builtin_amdgcn_mfma_f32_32x32x16_bf16(NATF(Aop, 72, s, mt), vb, accB, 0, 0, 0); }
                    if (grp == 0) { LAS float* ggb = IC + (32 * mt + 4 * hh) * 65 + 32 * nt + r32;
#pragma unroll
                        for (int r = 0; r < 16; ++r) ggb[crc(r) * 65] = accA[r]; }
                }
                __syncthreads();
                {
                    float xr[16];
                    if (wave < 4) {
#pragma unroll
                        for (int c = 0; c < 16; ++c) xr[c] = bflo((unsigned)At[lane * 72 + 16 * wave + c]);
                    } else { const LAS float* GG = IC;
#pragma unroll
                        for (int c = 0; c < 16; ++c) xr[c] = GG[lane * 65 + 16 * (wave - 4) + c];
                    }
                    __syncthreads();
                    const LAS float* LT = LW;
#pragma unroll 4
                    for (int t = 0; t < 63; ++t) { const float lt = LT[t * 64 + lane];
#pragma unroll
                        for (int c = 0; c < 16; ++c) { const float xt = __builtin_bit_cast(float, __builtin_amdgcn_readlane(__builtin_bit_cast(int, xr[c]), t)); xr[c] += lt * xt; } }
#pragma unroll
                    for (int c = 0; c < 16; ++c) XX[lane * 136 + 16 * wave + c] = (bf16_t)f2bf(xr[c]);
                }
                __syncthreads();
                {
                    f32x16 acc1;
#pragma unroll
                    for (int r = 0; r < 16; ++r) acc1[r] = 0.f;
#pragma unroll
                    for (int s = 0; s < 4; ++s) {
                        const bf16x8 a = grp == 0 ? TRF(Bt, 72, s, mt) : NATF(Mrb, 72, s, mt);
                        acc1 = __builtin_amdgcn_mfma_f32_32x32x16_bf16(a, TRF(XX, 136, s, nt), acc1, 0, 0, 0);
                        accB = __builtin_amdgcn_mfma_f32_32x32x16_bf16(a, TRF(XX + 64, 136, s, nt), accB, 0, 0, 0);
                    }
                    const int col = 32 * nt + r32, rb = 32 * mt + 4 * hh;
                    if (grp == 0) {
                        bf16_t* acb = (bf16_t*)cs + rb * 64 + col; bf16_t* dcb = (bf16_t*)(cs + 8192) + col * 64 + rb; const LAS float* gb = GAMC + rb;
#pragma unroll
                        for (int r = 0; r < 16; ++r) { const float gcv = gb[crc(r)]; acb[crc(r) * 64] = (bf16_t)f2bf(gcv * (acc1[r] + ((rb + crc(r)) == col ? 1.0f : 0.0f))); }
#pragma unroll
                        for (int rq = 0; rq < 4; ++rq) { const f32x4 g4 = *(const LAS f32x4*)(gb + 8 * rq);
                            u32x2 w; w.x = pk2(accB[4 * rq] * g4[0], accB[4 * rq + 1] * g4[1]); w.y = pk2(accB[4 * rq + 2] * g4[2], accB[4 * rq + 3] * g4[3]); *(u32x2*)(dcb + 8 * rq) = w; }
                    } else {
                        bf16_t* rpb = (bf16_t*)(cs + 16384) + rb * 64 + col; const LAS bf16_t* rtb = Rt + rb * 72 + col; bf16_t* yb = MIX + (size_t)(m0 + rb) * DM + 64 * h + col;
#pragma unroll
                        for (int r = 0; r < 16; ++r) { rpb[crc(r) * 64] = (bf16_t)f2bf(acc1[r] + bflo((unsigned)rtb[crc(r) * 72])); yb[crc(r) * DM] = (bf16_t)f2bf(accB[r]); }
                    }
                }
                __syncthreads();
            }
        }
        for (int unit = vcu; unit < MTOK / 64; unit += G) {
            const int m0 = unit * 64;
            {
                const int cgp = tid & 127, ts = tid >> 7, c0 = 8 * cgp; const float* cw = args.in[I_CONVW]; const float* cb = args.in[I_CONVB];
                float w[4][8], bb[8];
#pragma unroll
                for (int j = 0; j < 4; ++j)
#pragma unroll
                    for (int i = 0; i < 8; ++i) w[j][i] = cw[j * 1024 + c0 + i];
#pragma unroll
                for (int i = 0; i < 8; ++i) bb[i] = cb[c0 + i];
                float x0[8], x1[8], x2[8], x3[8];
                const int mstart = m0 + 16 * ts; const int tpos = mstart & (SEQ - 1);
                const bf16_t* srcp = PROJ + (size_t)mstart * NPROJ + 2304 + c0;
#pragma unroll
                for (int i = 0; i < 8; ++i) { x0[i] = 0.f; x1[i] = 0.f; x2[i] = 0.f; }
                if (tpos >= 3) unpack8(*(const u32x4*)(srcp - 3 * (size_t)NPROJ), x0);
                if (tpos >= 2) unpack8(*(const u32x4*)(srcp - 2 * (size_t)NPROJ), x1);
                if (tpos >= 1) unpack8(*(const u32x4*)(srcp - 1 * (size_t)NPROJ), x2);
                for (int t = 0; t < 16; ++t) {
                    unpack8(*(const u32x4*)(srcp + (size_t)t * NPROJ), x3);
                    float o[8];
#pragma unroll
                    for (int i = 0; i < 8; ++i) { const float y = bb[i] + w[0][i] * x0[i] + w[1][i] * x1[i] + w[2][i] * x2[i] + w[3][i] * x3[i]; o[i] = siluf_(y); x0[i] = x1[i]; x1[i] = x2[i]; x2[i] = x3[i]; }
                    *(u32x4*)(XBCC + (size_t)(mstart + t) * 1024 + c0) = pack8(o);
                }
            }
        }
    }

    SEAM(2);

    PHASE(3) { REPBAR
        if (vcu < 32) {
            const int b = vcu >> 3, h = vcu & 7;
            const unsigned char* cbase = (const unsigned char*)dout + (size_t)(b * 64 * 8 + h) * 24576;
            constexpr size_t CSTR = (size_t)8 * 24576; constexpr int SLOT = 27648;
            const bool loader = wave >= 2; const int lt = tid - 128;
            int poff[4];
#pragma unroll
            for (int k = 0; k < 4; ++k) { const int p = lt + 384 * k; poff[k] = (p >> 9) * 9216 + ((p & 511) >> 3) * 144 + (p & 7) * 16; }
            u32x4 st[4][4];
#define RB_ISSUE(set, ch) do { if (loader) { const unsigned char* g_ = cbase + (size_t)(ch) * CSTR + (size_t)lt * 16; _Pragma("unroll") for (int k = 0; k < 4; ++k) st[set][k] = *(const u32x4*)(g_ + k * 6144); } } while (0)
#define RB_WRITE(set, ch) do { if (loader) { LAS unsigned char* s_ = lds + ((ch) & 3) * SLOT; _Pragma("unroll") for (int k = 0; k < 4; ++k) *(LAS u32x4*)(s_ + poff[k]) = st[set][k]; } } while (0)
            RB_ISSUE(0, 0); RB_ISSUE(1, 1); RB_WRITE(0, 0); RB_WRITE(1, 1);
            RB_ISSUE(2, 2); RB_ISSUE(3, 3); RB_ISSUE(0, 4); RB_ISSUE(1, 5);
            __syncthreads();
            f32x16 H[2];
#pragma unroll
            for (int r = 0; r < 16; ++r) { H[0][r] = 0.f; H[1][r] = 0.f; }
            bf16_t* zp = (bf16_t*)((unsigned char*)dout + 48 * MiB) + (size_t)(b * SEQ + 4 * hh) * 512 + 64 * h + 32 * wave + r32;
#define RB_STEP(j, chv) do { const int ch_ = (chv); \
                if (loader) { if (ch_ + 2 < 64) RB_WRITE(((j) + 2) & 3, ch_ + 2); if (ch_ + 6 < 64) RB_ISSUE(((j) + 2) & 3, ch_ + 6); } \
                else { const LAS unsigned char* sl = lds + (ch_ & 3) * SLOT; f32x16 Hn[2], Z[2]; bf16x8 Hb[4]; \
                    _Pragma("unroll") for (int s = 0; s < 4; ++s) { const int m = s >> 1, o = 8 * (s & 1); u32x4 t; t.x = pk2(H[m][o], H[m][o + 1]); t.y = pk2(H[m][o + 2], H[m][o + 3]); t.z = pk2(H[m][o + 4], H[m][o + 5]); t.w = pk2(H[m][o + 6], H[m][o + 7]); Hb[s] = __builtin_bit_cast(bf16x8, t); } \
                    _Pragma("unroll") for (int m = 0; m < 2; ++m) { \
                        _Pragma("unroll") for (int rq = 0; rq < 4; ++rq) { const u32x2 d = *(const LAS u32x2*)(sl + 9216 + (32 * wave + r32) * 144 + (32 * m + 8 * rq + 4 * hh) * 2); \
                            Hn[m][4 * rq] = bflo(d.x); Hn[m][4 * rq + 1] = bfhi(d.x); Hn[m][4 * rq + 2] = bflo(d.y); Hn[m][4 * rq + 3] = bfhi(d.y); } \
                        _Pragma("unroll") for (int r = 0; r < 16; ++r) Z[m][r] = 0.f; } \
                    _Pragma("unroll") for (int s = 0; s < 4; ++s) \
                        _Pragma("unroll") for (int m = 0; m < 2; ++m) { const int o = (32 * m + r32) * 144 + (16 * s + 4 * hh) * 2; \
                            const u32x2 a0 = *(const LAS u32x2*)(sl + o), a1 = *(const LAS u32x2*)(sl + o + 16), q0 = *(const LAS u32x2*)(sl + 18432 + o), q1 = *(const LAS u32x2*)(sl + 18432 + o + 16); \
                            u32x4 t; t.x = a0.x; t.y = a0.y; t.z = a1.x; t.w = a1.y; Hn[m] = __builtin_amdgcn_mfma_f32_32x32x16_bf16(__builtin_bit_cast(bf16x8, t), Hb[s], Hn[m], 0, 0, 0); \
                            t.x = q0.x; t.y = q0.y; t.z = q1.x; t.w = q1.y; Z[m] = __builtin_amdgcn_mfma_f32_32x32x16_bf16(__builtin_bit_cast(bf16x8, t), Hb[s], Z[m], 0, 0, 0); } \
                    H[0] = Hn[0]; H[1] = Hn[1]; \
                    bf16_t* zq = zp + (size_t)ch_ * 64 * 512; \
                    _Pragma("unroll") for (int m = 0; m < 2; ++m) _Pragma("unroll") for (int r = 0; r < 16; ++r) zq[(32 * m + crc(r)) * 512] = (bf16_t)f2bf(Z[m][r]); } \
                __syncthreads(); } while (0)
            if (wave < 2 || loader) {
                for (int ch = 0; ch < 64; ch += 4) { RB_STEP(0, ch); RB_STEP(1, ch + 1); RB_STEP(2, ch + 2); RB_STEP(3, ch + 3); }
            }
#undef RB_STEP
#undef RB_ISSUE
#undef RB_WRITE
        } else {
            LAS bf16_t* Bm = (LAS bf16_t*)lds; LAS bf16_t* Xh = (LAS bf16_t*)(lds + 34816); LAS float* CUM = (LAS float*)(lds + 53248); LAS float* DTL = CUM + 512;
            for (int unit = vcu - 32; unit < 256; unit += G - 32) {
                const int g = unit & 1, c = (unit >> 1) & 31, b = unit >> 6, m0 = b * SEQ + c * 128;
#pragma unroll
                for (int k = 0; k < 4; ++k) { const int p = tid + 512 * k, row = p >> 4, c16 = p & 15; *(LAS u32x4*)(Bm + row * 136 + 8 * c16) = *(const u32x4*)(XBCC + (size_t)(m0 + row) * 1024 + 512 + 128 * g + 8 * c16); }
                if (wave < 4) { const int h = 4 * g + wave; const float a_h = -__expf(args.in[I_ALOG][h]);
                    const float v0 = DTSP[(size_t)(m0 + 2 * lane) * 8 + h], v1 = DTSP[(size_t)(m0 + 2 * lane + 1) * 8 + h]; float s = v0 + v1;
#pragma unroll
                    for (int o = 1; o < 64; o <<= 1) { const float t = __shfl_up(s, o); if (lane >= o) s += t; }
                    const float ex = s - (v0 + v1);
                    CUM[wave * 128 + 2 * lane] = a_h * (ex + v0); CUM[wave * 128 + 2 * lane + 1] = a_h * (ex + v0 + v1); DTL[wave * 128 + 2 * lane] = v0; DTL[wave * 128 + 2 * lane + 1] = v1; }
                __syncthreads();
#pragma unroll 1
                for (int hq = 0; hq < 4; ++hq) { const int h = 4 * g + hq;
                    { const int s = tid >> 2, cq = 16 * (tid & 3); const float sc = DTL[hq * 128 + s] * __expf(CUM[hq * 128 + 127] - CUM[hq * 128 + s]);
                      const bf16_t* xp = XBCC + (size_t)(m0 + s) * 1024 + 64 * h + cq;
#pragma unroll
                      for (int q = 0; q < 2; ++q) { float f[8]; unpack8(*(const u32x4*)(xp + 8 * q), f);
#pragma unroll
                          for (int i = 0; i < 8; ++i) f[i] *= sc;
                          *(LAS u32x4*)(Xh + s * 72 + cq + 8 * q) = pack8(f); } }
                    __syncthreads();
                    const int mt = wave >> 2, nt = wave & 3; f32x16 acc;
#pragma unroll
                    for (int r = 0; r < 16; ++r) acc[r] = 0.f;
#pragma unroll
                    for (int ks = 0; ks < 8; ++ks) acc = __builtin_amdgcn_mfma_f32_32x32x16_bf16(TRF(Xh, 72, ks, mt), TRF(Bm, 136, ks, nt), acc, 0, 0, 0);
                    bf16_t* sp = SSTATE + ((size_t)((b * 32 + c) * 8 + h)) * 8192 + (32 * mt + 4 * hh) * 128 + 32 * nt + r32;
#pragma unroll
                    for (int r = 0; r < 16; ++r) sp[crc(r) * 128] = (bf16_t)f2bf(acc[r]);
                    if (tid == 0) CHDEC[(b * 32 + c) * 8 + h] = __expf(CUM[hq * 128 + 127]);
                    __syncthreads();
                }
            }
        }
    }

    SEAM(3);

    PHASE(4) { REPBAR
        const int gt = vcu * 512 + tid, bh = gt >> 12, e2 = gt & 4095, b = bh >> 3, h = bh & 7;
        unsigned* sp = (unsigned*)SSTATE + ((size_t)(b * 32 * 8 + h)) * 4096 + e2;
        unsigned vals[32];
#pragma unroll
        for (int c = 0; c < 32; ++c) vals[c] = sp[(size_t)c * 8 * 4096];
        float r0 = 0.f, r1 = 0.f;
#pragma unroll
        for (int c = 0; c < 32; ++c) { const float dec = CHDEC[(b * 32 + c) * 8 + h]; sp[(size_t)c * 8 * 4096] = pk2(r0, r1); r0 = r0 * dec + bflo(vals[c]); r1 = r1 * dec + bfhi(vals[c]); }
    }
    SEAM(4);

    PHASE(5) { REPBAR
        {
            LAS bf16_t* Cm = (LAS bf16_t*)lds; LAS bf16_t* Bm = (LAS bf16_t*)(lds + 34816); LAS bf16_t* Xh = (LAS bf16_t*)(lds + 69632); LAS bf16_t* Hp = (LAS bf16_t*)(lds + 88064);
            LAS float* CUM = (LAS float*)(lds + 105472); LAS float* DTL = CUM + 512; LAS bf16_t* YL = (LAS bf16_t*)lds;
            for (int unit = vcu; unit < 256; unit += G) {
                const int g = unit & 1, c = (unit >> 1) & 31, b = unit >> 6, m0 = b * SEQ + c * 128;
#pragma unroll
                for (int k = 0; k < 4; ++k) { const int p = tid + 512 * k, row = p >> 4, c16 = p & 15; const bf16_t* sp = XBCC + (size_t)(m0 + row) * 1024 + 128 * g + 8 * c16;
                    *(LAS u32x4*)(Bm + row * 136 + 8 * c16) = *(const u32x4*)(sp + 512); *(LAS u32x4*)(Cm + row * 136 + 8 * c16) = *(const u32x4*)(sp + 768); }
                if (wave < 4) { const int h = 4 * g + wave; const float a_h = -__expf(args.in[I_ALOG][h]);
                    const float v0 = DTSP[(size_t)(m0 + 2 * lane) * 8 + h], v1 = DTSP[(size_t)(m0 + 2 * lane + 1) * 8 + h]; float s = v0 + v1;
#pragma unroll
                    for (int o = 1; o < 64; o <<= 1) { const float t = __shfl_up(s, o); if (lane >= o) s += t; }
                    const float ex = s - (v0 + v1);
                    CUM[wave * 128 + 2 * lane] = a_h * (ex + v0); CUM[wave * 128 + 2 * lane + 1] = a_h * (ex + v0 + v1); DTL[wave * 128 + 2 * lane] = v0; DTL[wave * 128 + 2 * lane + 1] = v1; }
                __syncthreads();
                const int mt = wave >> 1, nb = 2 * (wave & 1), nt2 = wave & 1;
                f32x16 cb[2];
#pragma unroll
                for (int r = 0; r < 16; ++r) { cb[0][r] = 0.f; cb[1][r] = 0.f; }
#pragma unroll
                for (int ks = 0; ks < 8; ++ks) { const bf16x8 a = NATF(Cm, 136, ks, mt);
                    cb[0] = __builtin_amdgcn_mfma_f32_32x32x16_bf16(a, NATF(Bm, 136, ks, nb), cb[0], 0, 0, 0); cb[1] = __builtin_amdgcn_mfma_f32_32x32x16_bf16(a, NATF(Bm, 136, ks, nb + 1), cb[1], 0, 0, 0); }
                __syncthreads();
                LAS bf16_t* Wt = Bm;
                f32x16 yt[4];
#pragma unroll
                for (int hq = 0; hq < 4; ++hq) { const int h = 4 * g + hq;
#pragma unroll
                    for (int j = 0; j < 2; ++j) { const int s = 32 * (nb + j) + r32; const float cs = CUM[hq * 128 + s], ds = DTL[hq * 128 + s]; const int lb = 32 * mt + 4 * hh;
                        LAS bf16_t* wp = Wt + lb * 136 + s; const LAS float* cl = CUM + hq * 128 + lb;
#pragma unroll
                        for (int r = 0; r < 16; ++r) { const float w = (s <= lb + crc(r)) ? cb[j][r] * __expf(cl[crc(r)] - cs) * ds : 0.f; wp[crc(r) * 136] = (bf16_t)f2bf(w); } }
                    { const int s = tid >> 2, cq = 16 * (tid & 3); const bf16_t* xp = XBCC + (size_t)(m0 + s) * 1024 + 64 * h + cq;
                      *(LAS u32x4*)(Xh + s * 72 + cq) = *(const u32x4*)xp; *(LAS u32x4*)(Xh + s * 72 + cq + 8) = *(const u32x4*)(xp + 8); }
                    { const bf16_t* hp = SSTATE + ((size_t)((b * 32 + c) * 8 + h)) * 8192;
#pragma unroll
                      for (int k = 0; k < 2; ++k) { const int p = tid + 512 * k, row = p >> 4, c16 = p & 15; *(LAS u32x4*)(Hp + row * 136 + 8 * c16) = *(const u32x4*)(hp + row * 128 + 8 * c16); } }
                    __syncthreads();
                    f32x16 yd, yo;
#pragma unroll
                    for (int r = 0; r < 16; ++r) { yd[r] = 0.f; yo[r] = 0.f; }
#pragma unroll
                    for (int ks = 0; ks < 8; ++ks) { yd = __builtin_amdgcn_mfma_f32_32x32x16_bf16(NATF(Wt, 136, ks, mt), TRF(Xh, 72, ks, nt2), yd, 0, 0, 0);
                        yo = __builtin_amdgcn_mfma_f32_32x32x16_bf16(NATF(Cm, 136, ks, mt), NATF(Hp, 136, ks, nt2), yo, 0, 0, 0); }
                    { const LAS float* cl = CUM + hq * 128 + 32 * mt + 4 * hh;
#pragma unroll
                      for (int r = 0; r < 16; ++r) yt[hq][r] = yd[r] + __expf(cl[crc(r)]) * yo[r]; }
                    __syncthreads();
                }
                { LAS bf16_t* yp = YL + (32 * mt + 4 * hh) * 264 + 32 * nt2 + r32;
#pragma unroll
                  for (int hq = 0; hq < 4; ++hq)
#pragma unroll
                      for (int r = 0; r < 16; ++r) yp[crc(r) * 264 + 64 * hq] = (bf16_t)f2bf(yt[hq][r]); }
                __syncthreads();
                for (int i = 0; i < 16; ++i) { const int l = wave * 16 + i; const size_t m = (size_t)(m0 + l); const int ch = 256 * g + 4 * lane;
                    const u32x2 yv = *(const LAS u32x2*)(YL + l * 264 + 4 * lane), xv = *(const u32x2*)(XBCC + m * 1024 + ch), zv = *(const u32x2*)(PROJ + m * NPROJ + 1792 + ch);
                    const float dsk = args.in[I_DSKIP][4 * g + (lane >> 4)];
                    float v[4] = {bflo(yv.x), bfhi(yv.x), bflo(yv.y), bfhi(yv.y)}; const float xs[4] = {bflo(xv.x), bfhi(xv.x), bflo(xv.y), bfhi(xv.y)}, zz[4] = {bflo(zv.x), bfhi(zv.x), bflo(zv.y), bfhi(zv.y)};
                    float q = 0.f;
#pragma unroll
                    for (int j = 0; j < 4; ++j) { v[j] = (v[j] + dsk * xs[j]) * siluf_(zz[j]); q += v[j] * v[j]; }
                    q = wave_sum(q); const float rq = 1.0f / sqrtf(q * (1.0f / 256.0f) + EPS); const f32x4 nw = *(const f32x4*)(args.in[I_SSDN] + ch);
                    u32x2 o; o.x = pk2(v[0] * rq * nw[0], v[1] * rq * nw[1]); o.y = pk2(v[2] * rq * nw[2], v[3] * rq * nw[3]); *(u32x2*)(MIX + m * DM + 512 + ch) = o; }
                __syncthreads();
            }
        }
        const float* mu = args.in[I_MU];
        for (int m = gw; m < MTOK; m += NGW) {
            const bool hasprev = (m & (SEQ - 1)) != 0; const int c0 = 8 * lane, h = lane >> 3;
            float y[8], v[8], p[8], go[8];
            unpack8(*(const u32x4*)(MIX + (size_t)m * DM + c0), y);
            unpack8(*(const u32x4*)((const bf16_t*)((const unsigned char*)dout + 48 * MiB) + (size_t)m * 512 + c0), p);
#pragma unroll
            for (int i = 0; i < 8; ++i) y[i] += p[i];
            const bf16_t* pc = PROJ + (size_t)m * NPROJ + c0;
            unpack8(*(const u32x4*)(pc + 1024), v);
            if (hasprev) {
                unpack8(*(const u32x4*)(pc - NPROJ + 1024), p);
#pragma unroll
                for (int i = 0; i < 8; ++i) v[i] += (p[i] - v[i]) * mu[1024 + c0 + i];
            } else {
#pragma unroll
                for (int i = 0; i < 8; ++i) v[i] -= v[i] * mu[1024 + c0 + i];
            }
            unpack8(*(const u32x4*)(GOUT + (size_t)m * 512 + c0), go);
            float s1 = 0.f; const float bd = KKR[(size_t)m * 8 + h];
#pragma unroll
            for (int i = 0; i < 8; ++i) s1 += y[i];
            s1 += __shfl_xor(s1, 1); s1 += __shfl_xor(s1, 2); s1 += __shfl_xor(s1, 4);
            const float mean = s1 * (1.0f / 64.0f); float s2 = 0.f;
#pragma unroll
            for (int i = 0; i < 8; ++i) { const float d = y[i] - mean; s2 += d * d; }
            s2 += __shfl_xor(s2, 1); s2 += __shfl_xor(s2, 2); s2 += __shfl_xor(s2, 4);
            const float rs = 1.0f / sqrtf(s2 * (1.0f / 64.0f) + 64e-5f);
            float o[8];
#pragma unroll
            for (int i = 0; i < 8; ++i) o[i] = ((y[i] - mean) * rs * args.in[I_GNW][c0 + i] + args.in[I_GNB][c0 + i] + bd * v[i]) * go[i];
            *(u32x4*)(MIX + (size_t)m * DM + c0) = pack8(o);
        }
    }
    SEAM(5);


    PHASE(6) { REPBAR
        pg8::Gemm g{MIX, WOUT, MTOK, DM, DM}; pg8::StaticOrder S; S.init(MTOK, DM, G, bx);
        pg8::EpiRes E{args.in[I_X], dout, XNB, args.in[I_NORM_FFN0], nullptr, SS};
        pg8::gemm_phase(lds, g, S, E);
    }
    SEAM(6);
    PHASE(7) { REPBAR
        pg8::Gemm g{XNB, WGU, MTOK, 2 * FFN, DM}; pg8::StaticOrder S; S.init(MTOK, 2 * FFN, G, bx);
        pg8::EpiSwiglu E{HID, FFN, SS, nullptr};
        pg8::gemm_phase(lds, g, S, E);
    }
    SEAM(7);
    PHASE(8) { REPBAR
        pg8::Gemm g{HID, WDN, MTOK, DM, FFN}; pg8::StaticOrder S; S.init(MTOK, DM, G, bx);
        pg8::EpiRes E{dout, dout, XNB, args.in[I_NORM_MIX1], nullptr, SS};
        pg8::gemm_phase(lds, g, S, E);
    }
    SEAM(8);
    PHASE(9) { REPBAR
        pg8::Gemm g{XNB, WQKV, MTOK, 1536, DM}; pg8::StaticOrder S; S.init(MTOK, 1536, G, bx);
        pg8::EpiQkv E{QKV, SS, args.in[I_BQKV], args.in[I_QN], args.in[I_KN], ROPE};
        pg8::gemm_phase(lds, g, S, E);
    }
    SEAM(9);

    PHASE(10) { REPBAR
        LAS bf16_t* Kt = (LAS bf16_t*)lds; LAS bf16_t* Vt = (LAS bf16_t*)(lds + 36864);
        const int r32 = lane & 31, hh = lane >> 5;
        for (int unit = vcu; unit < BATCH * 4 * 32; unit += G) {
            const int blk = unit & 31, kvh = (unit >> 5) & 3, b = unit >> 7;
            {
                const int rowi = tid >> 1, half = tid & 1; const int tpos = (blk - 1) * 128 + rowi;
#pragma unroll
                for (int q = 0; q < 4; ++q) { u32x4 kv = (u32x4){0, 0, 0, 0}, vv = kv;
                    if (tpos >= 0) { const bf16_t* p = QKV + (size_t)(b * SEQ + tpos) * 1536 + 1024 + kvh * 64 + half * 32 + 8 * q; kv = *(const u32x4*)p; vv = *(const u32x4*)(p + 256); }
                    *(LAS u32x4*)(Kt + rowi * 72 + half * 32 + 8 * q) = kv; *(LAS u32x4*)(Vt + rowi * 72 + half * 32 + 8 * q) = vv; }
            }
            __syncthreads();
            const int gq = wave >> 1, qh = kvh * 4 + gq; const float sink = args.in[I_SINK][qh];
            for (int it = 0; it < 2; ++it) {
                const int qi = (wave & 1) * 64 + it * 32 + r32; const size_t mq = (size_t)b * SEQ + blk * 128 + qi;
                bf16x8 qr[4];
#pragma unroll
                for (int s = 0; s < 4; ++s) qr[s] = *(const bf16x8*)(QKV + mq * 1536 + qh * 64 + 16 * s + 8 * hh);
                const int a0 = (wave & 1) * 2 + it;
                f32x16 sc[5];
#pragma unroll
                for (int j = 0; j < 5; ++j) {
#pragma unroll
                    for (int r = 0; r < 16; ++r) sc[j][r] = 0.f;
#pragma unroll
                    for (int s = 0; s < 4; ++s) { const bf16x8 kf = *(const LAS bf16x8*)(Kt + (32 * (a0 + j) + r32) * 72 + 16 * s + 8 * hh); sc[j] = __builtin_amdgcn_mfma_f32_32x32x16_bf16(kf, qr[s], sc[j], 0, 0, 0); }
                }
                float mx = sink;
#pragma unroll
                for (int j = 0; j < 5; ++j)
#pragma unroll
                    for (int r = 0; r < 16; ++r) { const int kj = 32 * (a0 + j) + crow(r, hh); const bool valid = (kj > qi) && (kj <= qi + 128) && (blk > 0 || kj >= 128);
                        const float x = valid ? sc[j][r] * 0.125f : -1e30f; sc[j][r] = x; mx = fmaxf(mx, x); }
                mx = fmaxf(mx, __shfl_xor(mx, 32));
                float l = 0.f;
#pragma unroll
                for (int j = 0; j < 5; ++j)
#pragma unroll
                    for (int r = 0; r < 16; ++r) { const float p = __expf(sc[j][r] - mx); sc[j][r] = p; l += p; }
                l += __shfl_xor(l, 32); l += __expf(sink - mx);
                const float inv = 1.0f / l;
                f32x16 o[2];
#pragma unroll
                for (int dt = 0; dt < 2; ++dt)
#pragma unroll
                    for (int r = 0; r < 16; ++r) o[dt][r] = 0.f;
#pragma unroll
                for (int j = 0; j < 5; ++j)
#pragma unroll
                    for (int s2 = 0; s2 < 2; ++s2) {
                        u32x4 pw; pw.x = pk2(sc[j][8 * s2 + 0], sc[j][8 * s2 + 1]); pw.y = pk2(sc[j][8 * s2 + 2], sc[j][8 * s2 + 3]); pw.z = pk2(sc[j][8 * s2 + 4], sc[j][8 * s2 + 5]); pw.w = pk2(sc[j][8 * s2 + 6], sc[j][8 * s2 + 7]);
                        const bf16x8 pf = __builtin_bit_cast(bf16x8, pw);
                        const int key0 = 32 * (a0 + j) + 16 * s2 + 4 * hh + ((lane & 15) >> 2);
#pragma unroll
                        for (int dt = 0; dt < 2; ++dt) {
                            const LAS bf16_t* vp = Vt + key0 * 72 + 32 * dt + 16 * ((lane >> 4) & 1) + 4 * (lane & 3);
                            const s16x4 lo = __builtin_bit_cast(s16x4, __builtin_amdgcn_ds_read_tr16_b64_v4i16((LAS s16x4*)vp));
                            const s16x4 hi = __builtin_bit_cast(s16x4, __builtin_amdgcn_ds_read_tr16_b64_v4i16((LAS s16x4*)(vp + 8 * 72)));
                            const bf16x8 vf = (bf16x8){lo[0], lo[1], lo[2], lo[3], hi[0], hi[1], hi[2], hi[3]};
                            o[dt] = __builtin_amdgcn_mfma_f32_32x32x16_bf16(vf, pf, o[dt], 0, 0, 0);
                        }
                    }
                bf16_t* op = ATTO + mq * DM + qh * 64;
#pragma unroll
                for (int dt = 0; dt < 2; ++dt)
#pragma unroll
                    for (int rq = 0; rq < 4; ++rq) { u32x2 w; w.x = pk2(o[dt][4 * rq] * inv, o[dt][4 * rq + 1] * inv); w.y = pk2(o[dt][4 * rq + 2] * inv, o[dt][4 * rq + 3] * inv);
                        *(u32x2*)(op + 32 * dt + 8 * rq + 4 * hh) = w; }
            }
            __syncthreads();
        }
    }
    SEAM(10);

    PHASE(11) { REPBAR
        pg8::Gemm g{ATTO, WO, MTOK, DM, DM}; pg8::StaticOrder S; S.init(MTOK, DM, G, bx);
        pg8::EpiRes E{dout, dout, XNB, args.in[I_NORM_FFN1], args.in[I_BO], SS};
        pg8::gemm_phase(lds, g, S, E);
    }
    SEAM(11);

    PHASE(12) { REPBAR
        {
            LAS float* scr = (LAS float*)(lds + wave * 16384);
            for (int it0 = gw; ; it0 += NGW) {
                int it = it0; bool done = false;
                for (int e = 0; e < NEXP && !done; ++e) {
                    if (transpose_matrix(it, args.in[I_EG] + (size_t)e * DM * FE, FE, DM, FE, EGU + (size_t)e * 2 * FE * DM, 1, scr, lane)) { done = true; break; }
                    if (transpose_matrix(it, args.in[I_EU] + (size_t)e * DM * FE, FE, DM, FE, EGU + (size_t)e * 2 * FE * DM, 2, scr, lane)) { done = true; break; }
                    if (transpose_matrix(it, args.in[I_ED] + (size_t)e * FE * DM, DM, FE, DM, EDN + (size_t)e * DM * FE, 0, scr, lane)) { done = true; break; }
                }
                if (!done) break;
            }
            __syncthreads();
        }
        LAS float* w8 = (LAS float*)lds;
        for (int r = tid; r < DM; r += 512) { const float* p = args.in[I_ROUTER] + (size_t)r * 8; *(LAS f32x4*)(w8 + r * 8) = *(const f32x4*)p; *(LAS f32x4*)(w8 + r * 8 + 4) = *(const f32x4*)(p + 4); }
        __syncthreads();
        const float* gm = args.in[I_NORM_FFN1];
        for (int m = gw; m < MTOK; m += NGW) {
            const f32x4* xr = (const f32x4*)(dout + (size_t)m * DM) + lane;
            f32x4 v[4]; float s = 0.f;
#pragma unroll
            for (int j = 0; j < 4; ++j) { v[j] = xr[64 * j]; s += (v[j][0] * v[j][0] + v[j][1] * v[j][1]) + (v[j][2] * v[j][2] + v[j][3] * v[j][3]); }
            const float rstd = 1.0f / sqrtf(wave_sum(s) * (1.0f / DM) + EPS);
            float d[8];
#pragma unroll
            for (int k = 0; k < 8; ++k) d[k] = 0.f;
#pragma unroll
            for (int j = 0; j < 4; ++j) { const f32x4 g4 = ((const f32x4*)gm)[64 * j + lane]; const f32x4 y = v[j] * rstd * g4;
#pragma unroll
                for (int i = 0; i < 4; ++i) { const int c = 256 * j + 4 * lane + i; const f32x4 wa = *(const LAS f32x4*)(w8 + c * 8), wb = *(const LAS f32x4*)(w8 + c * 8 + 4);
                    d[0] += y[i] * wa[0]; d[1] += y[i] * wa[1]; d[2] += y[i] * wa[2]; d[3] += y[i] * wa[3]; d[4] += y[i] * wb[0]; d[5] += y[i] * wb[1]; d[6] += y[i] * wb[2]; d[7] += y[i] * wb[3]; } }
#pragma unroll
            for (int k = 0; k < 8; ++k) d[k] = wave_sum(d[k]);
            int e0 = 0; float v0 = d[0];
#pragma unroll
            for (int k = 1; k < 8; ++k) if (d[k] > v0) { v0 = d[k]; e0 = k; }
            int e1 = -1; float v1 = -3.0e38f;
#pragma unroll
            for (int k = 0; k < 8; ++k) if (k != e0 && d[k] > v1) { v1 = d[k]; e1 = k; }
            if (lane == 0) {
                const float w0 = 1.0f / (1.0f + __expf(v1 - v0));
                const unsigned r0 = atomicAdd(CNT + e0, 1u), r1 = atomicAdd(CNT + e1, 1u);
                TOPE[2 * m] = e0; TOPE[2 * m + 1] = e1; RANK[2 * m] = (int)r0; RANK[2 * m + 1] = (int)r1; TOPW[2 * m] = w0; TOPW[2 * m + 1] = 1.0f - w0; RSTD4[m] = rstd;
            }
        }
        __syncthreads();
    }
    SEAM(12);

    PHASE(13) { REPBAR
        int roff[NEXP]; { int t = 0;
#pragma unroll
            for (int e = 0; e < NEXP; ++e) { roff[e] = t; t += (int)((CNT[e] + 255u) >> 8) << 8; } }
        for (int j = gw; j < 2 * MTOK; j += NGW) {
            const int m = j >> 1, e = TOPE[j]; int ro = roff[0];
#pragma unroll
            for (int k = 1; k < NEXP; ++k) ro = (e == k) ? roff[k] : ro;
            const int pos = ro + RANK[j];
            const u32x4* src = (const u32x4*)(XNB + (size_t)m * DM) + lane; u32x4* dst = (u32x4*)(AS + (size_t)pos * DM) + lane;
            dst[0] = src[0]; dst[64] = src[64];
            if (lane == 0) { POS[j] = pos; RSTDS[pos] = RSTD4[m]; }
        }
    }
    SEAM(13);
    PHASE(14) { REPBAR
        pg8::Gemm g{AS, EGU, SROWS, 2 * FE, DM}; pg8::MoeOrder S; S.init(CNT, 2 * FE / 256, G, bx, (long)2 * FE * DM * 2);
        pg8::EpiSwiglu E{HS, FE, nullptr, RSTDS};
        pg8::gemm_phase(lds, g, S, E);
    }
    SEAM(14);
    PHASE(15) { REPBAR
        pg8::Gemm g{HS, EDN, SROWS, DM, FE}; pg8::MoeOrder S; S.init(CNT, DM / 256, G, bx, (long)DM * FE * 2);
        pg8::EpiBf16 E{AS, DM};
        pg8::gemm_phase(lds, g, S, E);
    }
    SEAM(15);
    PHASE(16) { REPBAR
        for (int m = gw; m < MTOK; m += NGW) {
            const int p0 = POS[2 * m], p1 = POS[2 * m + 1]; const float w0 = TOPW[2 * m], w1 = TOPW[2 * m + 1];
            const u32x4* y0 = (const u32x4*)(AS + (size_t)p0 * DM) + lane; const u32x4* y1 = (const u32x4*)(AS + (size_t)p1 * DM) + lane;
            f32x4* o = (f32x4*)(dout + (size_t)m * DM);
#pragma unroll
            for (int q = 0; q < 2; ++q) { float a[8], c[8]; unpack8(y0[64 * q], a); unpack8(y1[64 * q], c);
                f32x4 h0 = o[128 * q + 2 * lane], h1 = o[128 * q + 2 * lane + 1];
#pragma unroll
                for (int i = 0; i < 4; ++i) { h0[i] += w0 * a[i] + w1 * c[i]; h1[i] += w0 * a[4 + i] + w1 * c[4 + i]; }
                o[128 * q + 2 * lane] = h0; o[128 * q + 2 * lane + 1] = h1; }
        }
    }
#undef TRF
#undef NATF
#undef IN
#undef SEAM
#undef PHASE
#undef REPBAR
}

constexpr int NPHASE = 17;
extern "C" void kernel_launch(void* const* d_in, const int* in_sizes, int n_in, void* d_out, int out_size, void* d_ws, size_t ws_size, hipStream_t stream) {
    static int grid = 0;
    if (grid == 0) {
        if (n_in != 39 || out_size != MTOK * DM || ws_size < WS_END) { fprintf(stderr, "kernel_launch: unexpected shapes n_in %d out %d ws %zu\n", n_in, out_size, ws_size); grid = -1; return; }
        int dev = 0, cus = 0;
        if (hipGetDevice(&dev) != hipSuccess || hipDeviceGetAttribute(&cus, hipDeviceAttributeMultiprocessorCount, dev) != hipSuccess) { grid = -1; return; }
        if (hipFuncSetAttribute((const void*)fwd_kernel, hipFuncAttributeMaxDynamicSharedMemorySize, LDS_BYTES) != hipSuccess) { fprintf(stderr, "kernel_launch: hipFuncSetAttribute failed\n"); grid = -1; return; }
        int per_cu = 0; (void)hipOccupancyMaxActiveBlocksPerMultiprocessor(&per_cu, (const void*)fwd_kernel, 512, LDS_BYTES); (void)hipGetLastError();
        grid = 256; if (cus != 256 || per_cu < 1) fprintf(stderr, "kernel_launch: note: cus %d per_cu %d\n", cus, per_cu);
    }
    if (grid < 0) return;
    Args a{};
    a.in[0] = (const float*)d_in[0];
    for (int i = 2; i < 39; ++i) a.in[i - 1] = (const float*)d_in[i];
    a.pos = (const int*)d_in[1]; a.out = (float*)d_out; a.ws = (unsigned char*)d_ws;
    (void)hipMemsetAsync((char*)d_ws + WS_CTL, 0, CTL_ZERO_BYTES, stream);
#ifdef PROBE_PHASE
    constexpr int pp = PROBE_PHASE; constexpr bool before = (pp == 2 || pp == 5 || pp == 6 || pp == 8 || pp == 11 || pp == 16);
    if (before) { a.ph_lo = pp; a.ph_hi = pp + 1; hipLaunchKernelGGL(fwd_kernel, dim3(grid), dim3(512), LDS_BYTES, stream, a); (void)hipMemsetAsync((char*)d_ws + WS_CTL, 0, CW_CNT * 4, stream); }
#endif
    a.ph_lo = 0; a.ph_hi = NPHASE;
    hipLaunchKernelGGL(fwd_kernel, dim3(grid), dim3(512), LDS_BYTES, stream, a);
#ifdef PROBE_PHASE
    if (!before) { (void)hipMemsetAsync((char*)d_ws + WS_CTL, 0, CW_CNT * 4, stream); a.ph_lo = pp; a.ph_hi = pp + 1; hipLaunchKernelGGL(fwd_kernel, dim3(grid), dim3(512), LDS_BYTES, stream, a); }
#endif
}
```

```cpp
#include <hip/hip_runtime.h>
#include <cstdio>
#include <cstdint>

#define LAS __attribute__((address_space(3)))
#define GAS __attribute__((address_space(1)))
typedef unsigned short bf16_t;
typedef short bf16x8 __attribute__((ext_vector_type(8)));
typedef float f32x4 __attribute__((ext_vector_type(4)));
typedef float f32x2 __attribute__((ext_vector_type(2)));
typedef float f32x16 __attribute__((ext_vector_type(16)));
typedef unsigned u32x4 __attribute__((ext_vector_type(4)));
typedef unsigned u32x2 __attribute__((ext_vector_type(2)));
typedef short s16x4 __attribute__((ext_vector_type(4)));

constexpr int BATCH = 4, SEQ = 4096, DM = 1024, MTOK = BATCH * SEQ;
constexpr int IN0 = 3336, NPROJ = 3328;
constexpr int FFN = 2816, FE = 1408, NEXP = 8;
constexpr int SROWS = 2 * MTOK + NEXP * 256;
constexpr float EPS = 1e-6f;

constexpr size_t MiB = 1u << 20;
constexpr size_t WS_CTL = 0, CTL_ZERO_BYTES = 64 * 1024;
constexpr size_t WS_DTSP = 1 * MiB;
constexpr size_t WS_KKR = 1 * MiB + 512 * 1024;
constexpr size_t WS_ROPE = 2 * MiB;
constexpr size_t WS_SS = 3 * MiB;
constexpr size_t WS_TOPE = 4 * MiB;
constexpr size_t WS_RANK = 4 * MiB + 128 * 1024;
constexpr size_t WS_TOPW = 4 * MiB + 256 * 1024;
constexpr size_t WS_POS = 4 * MiB + 384 * 1024;
constexpr size_t WS_RSTD4 = 4 * MiB + 512 * 1024;
constexpr size_t WS_RSTDS = 4 * MiB + 640 * 1024;
constexpr size_t WS_WDEC = 5 * MiB;
constexpr size_t WS_WICL = 5 * MiB + 64 * 1024;
constexpr size_t WS_WGAT = 5 * MiB + 128 * 1024;
constexpr size_t WS_EGU = 6 * MiB;
constexpr size_t WS_EDN = 50 * MiB;
constexpr size_t WS_WIN = 72 * MiB;
constexpr size_t WS_WOUT = WS_WIN + (size_t)NPROJ * DM * 2;
constexpr size_t WS_WGU = WS_WOUT + 2 * MiB;
constexpr size_t WS_WDN = WS_WGU + 11 * MiB;
constexpr size_t WS_WQKV = WS_WDN + (size_t)DM * FFN * 2;
constexpr size_t WS_WO = WS_WQKV + 3 * MiB;
constexpr size_t R0 = 102 * MiB;
static_assert(WS_WO + 2 * MiB <= R0, "weights");
constexpr size_t WS_XN = R0, WS_MIX = R0;
constexpr size_t WS_PROJ = R0 + 32 * MiB;
constexpr size_t WS_GOUT = R0 + 136 * MiB;
constexpr size_t WS_XNB = R0 + 104 * MiB;
constexpr size_t WS_HID = R0;
constexpr size_t WS_QKV = R0;
constexpr size_t WS_ATTO = R0 + 48 * MiB;
constexpr size_t WS_AS = 72 * MiB;
constexpr size_t WS_HS = 140 * MiB;
constexpr size_t WS_END = 254 * MiB;
static_assert(WS_AS + (size_t)SROWS * DM * 2 <= WS_HS && WS_HS + (size_t)SROWS * FE * 2 <= WS_END && WS_GOUT + 16 * MiB <= WS_END, "map");
constexpr size_t DO_XBCC = 0, DO_DECAY = 32 * MiB, DO_ICLR = 48 * MiB;
constexpr int CW_BAR = 4096, CW_CNT = 8192;

constexpr int LDS_BYTES = 147456, RING_BYTES = 131072, MISC_OFF = LDS_BYTES - 128;

__device__ __forceinline__ unsigned f2bf(float f) { unsigned u = __builtin_bit_cast(unsigned, f); return (u + 0x7fffu + ((u >> 16) & 1u)) >> 16; }
typedef __bf16 bf16x2_t __attribute__((ext_vector_type(2)));
__device__ __forceinline__ unsigned pk2(float lo, float hi) { const f32x2 v = {lo, hi}; const bf16x2_t b = __builtin_convertvector(v, bf16x2_t); return __builtin_bit_cast(unsigned, b); }
__device__ __forceinline__ float bflo(unsigned u) { return __builtin_bit_cast(float, u << 16); }
__device__ __forceinline__ float bfhi(unsigned u) { return __builtin_bit_cast(float, u & 0xffff0000u); }
__device__ __forceinline__ void unpack8(const u32x4 v, float* f) { f[0] = bflo(v.x); f[1] = bfhi(v.x); f[2] = bflo(v.y); f[3] = bfhi(v.y); f[4] = bflo(v.z); f[5] = bfhi(v.z); f[6] = bflo(v.w); f[7] = bfhi(v.w); }
__device__ __forceinline__ u32x4 pack8(const float* f) { u32x4 v; v.x = pk2(f[0], f[1]); v.y = pk2(f[2], f[3]); v.z = pk2(f[4], f[5]); v.w = pk2(f[6], f[7]); return v; }
__device__ __forceinline__ float sigmoidf_(float x) { return __builtin_amdgcn_rcpf(1.0f + __expf(-x)); }
__device__ __forceinline__ float siluf_(float x) { return x * __builtin_amdgcn_rcpf(1.0f + __expf(-x)); }
#define LBAR() do { asm volatile("s_waitcnt lgkmcnt(0)" ::: "memory"); __builtin_amdgcn_s_barrier(); asm volatile("" ::: "memory"); } while (0)
__device__ __forceinline__ float wave_sum(float v) {
#pragma unroll
    for (int o = 1; o < 64; o <<= 1) v += __shfl_xor(v, o);
    return v;
}
__device__ __forceinline__ float dpp_sum63(float x) {
    int v;
    v = __builtin_amdgcn_update_dpp(0, __builtin_bit_cast(int, x), 0xB1, 0xF, 0xF, false); x += __builtin_bit_cast(float, v);
    v = __builtin_amdgcn_update_dpp(0, __builtin_bit_cast(int, x), 0x4E, 0xF, 0xF, false); x += __builtin_bit_cast(float, v);
    v = __builtin_amdgcn_update_dpp(0, __builtin_bit_cast(int, x), 0x141, 0xF, 0xF, false); x += __builtin_bit_cast(float, v);
    v = __builtin_amdgcn_update_dpp(0, __builtin_bit_cast(int, x), 0x140, 0xF, 0xF, false); x += __builtin_bit_cast(float, v);
    v = __builtin_amdgcn_update_dpp(0, __builtin_bit_cast(int, x), 0x142, 0xA, 0xF, false); x += __builtin_bit_cast(float, v);
    v = __builtin_amdgcn_update_dpp(0, __builtin_bit_cast(int, x), 0x143, 0xC, 0xF, false); x += __builtin_bit_cast(float, v);
    return __builtin_bit_cast(float, __builtin_amdgcn_readlane(__builtin_bit_cast(int, x), 63));
}
__device__ __forceinline__ int crow(int r, int hi) { return (r & 3) + 8 * (r >> 2) + 4 * hi; }
__device__ __forceinline__ constexpr int crc(int r) { return (r & 3) + 8 * (r >> 2); }

namespace pg8 {
constexpr int BM = 256, BK = 64, HALF = 128, HTB = HALF * BK * 2, NXCD = 8, WGM = 8;
__host__ __device__ __forceinline__ int lds_byte(int r, int c) { const int st = (r >> 4) * 2 + (c >> 5), rr = r & 15, cc = c & 31, ob = rr * 64 + cc * 2; return st * 1024 + (ob ^ (((ob >> 9) & 1) << 5)); }
__host__ __device__ __forceinline__ void stage_rc(int b, int& R, int& C) { const int st = b / 1024, sb = b % 1024, swz = sb ^ (((sb >> 9) & 1) << 5); R = (st >> 1) * 16 + swz / 64; C = (st & 1) * 32 + (swz % 64) / 2; }
__host__ __device__ __forceinline__ int perm32(int rho) { const int n = rho >> 4, i = rho & 15; return 8 * (i >> 2) + 4 * n + (i & 3); }
struct Unit { int pm, pn; long bofs; };
struct Gemm { const bf16_t* A; const bf16_t* Bt; int M, N, K; };
struct StaticOrder {
    int nM, nN, nwg, G, c;
    __device__ void init(int M, int N, int G_, int c_) { nM = M / BM; nN = N / BM; nwg = nM * nN; G = G_; c = c_; }
    __device__ bool next(int i, Unit& u) const {
        const long L = (long)i * G + c; if (L >= nwg) return false;
        int wgid = (int)L; { const int q = nwg / NXCD, r = nwg % NXCD, xcd = wgid % NXCD, off = wgid / NXCD; wgid = (xcd < r ? xcd * (q + 1) : r * (q + 1) + (xcd - r) * q) + off; }
        const int nig = WGM * nN, gid = wgid / nig, fm = gid * WGM, gsz = (nM - fm) < WGM ? (nM - fm) : WGM;
        u.pm = fm + ((wgid % nig) % gsz); u.pn = (wgid % nig) / gsz; u.bofs = 0; return true;
    }
};
struct MoeOrder {
    int toff[NEXP + 1]; int nN, G, c; long estride;
    __device__ void init(const unsigned* cnt, int nN_, int G_, int c_, long estride_) {
        nN = nN_; G = G_; c = c_; estride = estride_; int t = 0;
#pragma unroll
        for (int e = 0; e < NEXP; ++e) { toff[e] = t; t += (int)((cnt[e] + 255u) >> 8); }
        toff[NEXP] = t;
    }
    __device__ bool next(int i, Unit& u) const {
        const long L = (long)i * G + c; if (L >= (long)toff[NEXP] * nN) return false;
        const int pm = (int)(L / nN); u.pm = pm; u.pn = (int)(L % nN); int e = 0;
#pragma unroll
        for (int j = 1; j < NEXP; ++j) e += (pm >= toff[j]) ? 1 : 0;
        u.bofs = (long)e * estride; return true;
    }
};

template <class Epi, class Sched>
__device__ __forceinline__ void gemm_phase(LAS unsigned char* lds, const Gemm g, const Sched& S, const Epi& E) {
    constexpr bool ALIGN_EPI = true;
    const int tid = threadIdx.x, wid = __builtin_amdgcn_readfirstlane(tid >> 6), lane = tid & 63, wr = wid >> 2, wc = wid & 3, fr = lane & 15, fq = lane >> 4;
    const int K = g.K, nt = K / BK;
    unsigned voffA[2], voffB[2];
#pragma unroll
    for (int i = 0; i < 2; ++i) { int R, C; stage_rc(tid * 16 + i * 8192, R, C); const int Rb = Epi::PERM ? ((R & ~31) + perm32(R & 31)) : R;
        voffA[i] = (unsigned)(R * K + C) * 2u; voffB[i] = (unsigned)(Rb * K + C) * 2u; }
    const size_t kstep = (size_t)(BK * 2);
    const size_t hstep = (size_t)HALF * K * 2;
    const size_t tstep = 2 * hstep;
    const unsigned ldsw = (unsigned)wid * 1024u;
    const int aoff = lds_byte(wr * 64 + fr, fq * 8), boff = lds_byte(wc * 32 + fr, fq * 8);
#define PG8_SA(b, h) (((b) * 2 + (h)) * HTB)
#define PG8_SB(b, h) ((4 + (b) * 2 + (h)) * HTB)
#define PG8_STAGE(bufoff, gbase, voff) do { _Pragma("unroll") for (int _i = 0; _i < 2; ++_i) \
        __builtin_amdgcn_global_load_lds((const unsigned*)((const char*)(gbase) + (voff)[_i]), (LAS unsigned*)(lds + (bufoff) + ldsw + _i * 8192), 16, 0, 0); } while (0)
#define PG8_LDA(dst, b, h) do { _Pragma("unroll") for (int m = 0; m < 4; ++m) _Pragma("unroll") for (int k = 0; k < 2; ++k) dst[m][k] = *(const LAS bf16x8*)(lds + PG8_SA(b, h) + aoff + m * 2048 + k * 1024); } while (0)
#define PG8_LDB(dst, b, h) do { _Pragma("unroll") for (int n = 0; n < 2; ++n) _Pragma("unroll") for (int k = 0; k < 2; ++k) dst[n][k] = *(const LAS bf16x8*)(lds + PG8_SB(b, h) + boff + n * 2048 + k * 1024); } while (0)
#define PG8_MMA(ai, bj, At, Bt) do { __builtin_amdgcn_s_setprio(1); _Pragma("unroll") for (int m = 0; m < 4; ++m) _Pragma("unroll") for (int n = 0; n < 2; ++n) _Pragma("unroll") for (int k = 0; k < 2; ++k) \
        acc[ai][bj][m][n] = __builtin_amdgcn_mfma_f32_16x16x32_bf16(Bt[n][k], At[m][k], acc[ai][bj][m][n], 0, 0, 0); __builtin_amdgcn_s_setprio(0); } while (0)
#define PG8_WAIT_V(n) asm volatile("s_waitcnt vmcnt(" #n ")" ::: "memory")
#define PG8_WAIT_L(n) asm volatile("s_waitcnt lgkmcnt(" #n ")" ::: "memory")
#define PG8_BAR __builtin_amdgcn_s_barrier()
#define PG8_SCHED __builtin_amdgcn_sched_barrier(0)
    Unit cur, nxt; int ui = 0;
    if (!S.next(0, cur)) return;
    f32x4 acc[2][2][4][2];
#pragma unroll
    for (int a = 0; a < 2; ++a)
#pragma unroll
        for (int b = 0; b < 2; ++b)
#pragma unroll
            for (int m = 0; m < 4; ++m)
#pragma unroll
                for (int n = 0; n < 2; ++n) acc[a][b][m][n] = (f32x4){0.f, 0.f, 0.f, 0.f};
    bf16x8 At[4][2], B0[2][2], B1[2][2];
    const char* cA = (const char*)g.A + (size_t)cur.pm * tstep; const char* cB = (const char*)g.Bt + cur.bofs + (size_t)cur.pn * tstep;
    PG8_STAGE(PG8_SB(0, 0), cB, voffB); PG8_STAGE(PG8_SB(0, 1), cB + hstep, voffB); PG8_STAGE(PG8_SA(0, 0), cA, voffA); PG8_STAGE(PG8_SA(0, 1), cA + hstep, voffA);
    if (wr == 1) PG8_BAR;
    PG8_WAIT_V(2); PG8_BAR;
    PG8_STAGE(PG8_SB(1, 0), cB + kstep, voffB); PG8_STAGE(PG8_SA(1, 0), cA + kstep, voffA); PG8_STAGE(PG8_SB(1, 1), cB + hstep + kstep, voffB);
    PG8_WAIT_V(6); PG8_BAR;
    for (;;) {
        const bool has_next = S.next(ui + 1, nxt);
        const char* nA = has_next ? (const char*)g.A + (size_t)nxt.pm * tstep : cA; const char* nB = has_next ? (const char*)g.Bt + nxt.bofs + (size_t)nxt.pn * tstep : cB;
        for (int t = 0; t < nt; t += 2) {
            const bool last = (t == nt - 2);
            const char* a1 = cA + (size_t)(t + 1) * kstep;
            const char* a2 = last ? nA : cA + (size_t)(t + 2) * kstep; const char* b2 = last ? nB : cB + (size_t)(t + 2) * kstep;
            const char* a3 = a2 + kstep; const char* b3 = b2 + kstep;
            PG8_LDB(B0, 0, 0); PG8_LDB(B1, 0, 1); PG8_SCHED; PG8_LDA(At, 0, 0); PG8_STAGE(PG8_SA(1, 1), a1 + hstep, voffA);
            PG8_WAIT_V(8); PG8_WAIT_L(0); PG8_BAR; PG8_MMA(0, 0, At, B0); PG8_MMA(0, 1, At, B1); PG8_BAR; PG8_SCHED;
            PG8_LDA(At, 0, 1); PG8_STAGE(PG8_SB(0, 0), b2, voffB); PG8_STAGE(PG8_SB(0, 1), b2 + hstep, voffB); PG8_STAGE(PG8_SA(0, 0), a2, voffA);
            PG8_WAIT_V(8); PG8_WAIT_L(0); PG8_BAR; PG8_MMA(1, 0, At, B0); PG8_MMA(1, 1, At, B1); PG8_BAR; PG8_SCHED;
            PG8_LDB(B0, 1, 0); PG8_LDB(B1, 1, 1); PG8_SCHED; PG8_LDA(At, 1, 0); PG8_STAGE(PG8_SA(0, 1), a2 + hstep, voffA);
            PG8_WAIT_V(8); PG8_WAIT_L(0); PG8_BAR; PG8_MMA(0, 0, At, B0); PG8_MMA(0, 1, At, B1); PG8_BAR; PG8_SCHED;
            PG8_LDA(At, 1, 1); PG8_STAGE(PG8_SB(1, 0), b3, voffB); PG8_STAGE(PG8_SB(1, 1), b3 + hstep, voffB); PG8_STAGE(PG8_SA(1, 0), a3, voffA);
            PG8_WAIT_V(8); PG8_WAIT_L(0); PG8_BAR; PG8_MMA(1, 0, At, B0); PG8_MMA(1, 1, At, B1); PG8_BAR; PG8_SCHED;
        }
        if constexpr (ALIGN_EPI) { if (wr == 0) PG8_BAR; }
        E(acc, cur, wr, wc, fr, fq);
        if (!has_next) break;
#pragma unroll
        for (int a = 0; a < 2; ++a)
#pragma unroll
            for (int b = 0; b < 2; ++b)
#pragma unroll
                for (int m = 0; m < 4; ++m)
#pragma unroll
                    for (int n = 0; n < 2; ++n) acc[a][b][m][n] = (f32x4){0.f, 0.f, 0.f, 0.f};
        cur = nxt; cA = nA; cB = nB; ++ui;
        if constexpr (ALIGN_EPI) { if (wr == 1) PG8_BAR; }
    }
    PG8_WAIT_V(0);
    if constexpr (!ALIGN_EPI) { if (wr == 0) PG8_BAR; }
    PG8_BAR;
#undef PG8_SA
#undef PG8_SB
#undef PG8_STAGE
#undef PG8_LDA
#undef PG8_LDB
#undef PG8_MMA
#undef PG8_WAIT_V
#undef PG8_WAIT_L
#undef PG8_BAR
#undef PG8_SCHED
}

struct EpiBf16 {
    static constexpr bool PERM = true;
    bf16_t* O; int ldc;
    __device__ __forceinline__ void operator()(const f32x4 (&acc)[2][2][4][2], const Unit& u, int wr, int wc, int fr, int fq) const {
        const int row0 = u.pm * BM + wr * 64 + fr, col0 = u.pn * BM + wc * 32 + 8 * fq;
#pragma unroll
        for (int ai = 0; ai < 2; ++ai)
#pragma unroll
            for (int m = 0; m < 4; ++m) { bf16_t* rowp = O + (size_t)(row0 + ai * HALF + m * 16) * ldc + col0;
#pragma unroll
                for (int bj = 0; bj < 2; ++bj) { const f32x4 v0 = acc[ai][bj][m][0], v1 = acc[ai][bj][m][1];
                    u32x4 w; w.x = pk2(v0[0], v0[1]); w.y = pk2(v0[2], v0[3]); w.z = pk2(v1[0], v1[1]); w.w = pk2(v1[2], v1[3]);
                    *(u32x4*)(rowp + bj * HALF) = w; } }
    }
};
struct EpiRes {
    static constexpr bool PERM = false;
    const float* base; float* out; bf16_t* xn; const float* gw; const float* bias; float* ss;
    __device__ __forceinline__ void operator()(const f32x4 (&acc)[2][2][4][2], const Unit& u, int wr, int wc, int fr, int fq) const {
        const int col0 = u.pn * BM + wc * 32 + 4 * fq;
        f32x4 gv[2][2], bv[2][2];
#pragma unroll
        for (int bj = 0; bj < 2; ++bj)
#pragma unroll
            for (int n = 0; n < 2; ++n) { gv[bj][n] = *(const f32x4*)(gw + col0 + bj * HALF + n * 16); bv[bj][n] = bias ? *(const f32x4*)(bias + col0 + bj * HALF + n * 16) : (f32x4){0.f, 0.f, 0.f, 0.f}; }
#pragma unroll
        for (int ai = 0; ai < 2; ++ai)
#pragma unroll
            for (int m = 0; m < 4; ++m) { const int row = u.pm * BM + ai * HALF + wr * 64 + m * 16 + fr; const size_t off = (size_t)row * DM + col0; float s = 0.f;
#pragma unroll
                for (int bj = 0; bj < 2; ++bj)
#pragma unroll
                    for (int n = 0; n < 2; ++n) { const f32x4 bs = *(const f32x4*)(base + off + bj * HALF + n * 16); const f32x4 o = bs + acc[ai][bj][m][n] + bv[bj][n];
                        *(f32x4*)(out + off + bj * HALF + n * 16) = o; s += (o[0] * o[0] + o[1] * o[1]) + (o[2] * o[2] + o[3] * o[3]);
                        const f32x4 x = o * gv[bj][n]; u32x2 w; w.x = pk2(x[0], x[1]); w.y = pk2(x[2], x[3]); *(u32x2*)(xn + off + bj * HALF + n * 16) = w; }
                s += __shfl_xor(s, 16); s += __shfl_xor(s, 32);
                if (fq == 0) ss[(size_t)row * 16 + u.pn * 4 + wc] = s; }
    }
};
__device__ __forceinline__ float rstd_from_ss(const float* ss, int row) {
    const f32x4* p = (const f32x4*)(ss + (size_t)row * 16); const f32x4 a = p[0], b = p[1], c = p[2], d = p[3];
    const float t = ((a[0] + a[1]) + (a[2] + a[3])) + ((b[0] + b[1]) + (b[2] + b[3])) + ((c[0] + c[1]) + (c[2] + c[3])) + ((d[0] + d[1]) + (d[2] + d[3]));
    return __builtin_amdgcn_rsqf(t * (1.0f / DM) + EPS);
}
struct EpiSwiglu {
    static constexpr bool PERM = true;
    bf16_t* O; int ldc; const float* ss; const float* rstd;
    __device__ __forceinline__ void operator()(const f32x4 (&acc)[2][2][4][2], const Unit& u, int wr, int wc, int fr, int fq) const {
        const int row0 = u.pm * BM + wr * 64 + fr, col0 = u.pn * HALF + wc * 32 + 8 * fq;
#pragma unroll
        for (int ai = 0; ai < 2; ++ai)
#pragma unroll
            for (int m = 0; m < 4; ++m) { const int row = row0 + ai * HALF + m * 16; const float rs = ss ? rstd_from_ss(ss, row) : rstd[row];
                float h[8];
#pragma unroll
                for (int n = 0; n < 2; ++n)
#pragma unroll
                    for (int i = 0; i < 4; ++i) { const float gg = acc[ai][0][m][n][i] * rs, uu = acc[ai][1][m][n][i] * rs; h[n * 4 + i] = siluf_(gg) * uu; }
                *(u32x4*)(O + (size_t)row * ldc + col0) = pack8(h); }
    }
};
struct EpiQkv {
    static constexpr bool PERM = true;
    bf16_t* O; const float* ss; const float* bias; const float* qn; const float* kn; const float* rope;
    __device__ __forceinline__ void operator()(const f32x4 (&acc)[2][2][4][2], const Unit& u, int wr, int wc, int fr, int fq) const {
        const int hd = u.pn * 4 + wc, row0 = u.pm * BM + wr * 64 + fr; const int kind = u.pn < 4 ? 0 : (u.pn == 4 ? 1 : 2);
        const float* nw = kind == 0 ? qn : kn;
        float bv[2][8], nv[2][8];
#pragma unroll
        for (int bj = 0; bj < 2; ++bj)
#pragma unroll
            for (int j = 0; j < 8; ++j) { bv[bj][j] = bias[hd * 64 + bj * 32 + fq * 8 + j]; nv[bj][j] = nw[bj * 32 + fq * 8 + j]; }
#pragma unroll
        for (int ai = 0; ai < 2; ++ai)
#pragma unroll
            for (int m = 0; m < 4; ++m) { const int row = row0 + ai * HALF + m * 16; const float rs = rstd_from_ss(ss, row);
                float v[2][8]; float s = 0.f;
#pragma unroll
                for (int bj = 0; bj < 2; ++bj)
#pragma unroll
                    for (int n = 0; n < 2; ++n)
#pragma unroll
                        for (int i = 0; i < 4; ++i) { const float x = acc[ai][bj][m][n][i] * rs + bv[bj][n * 4 + i]; v[bj][n * 4 + i] = x; s += x * x; }
                if (kind < 2) {
                    s += __shfl_xor(s, 16); s += __shfl_xor(s, 32);
                    const float r2 = __builtin_amdgcn_rsqf(s * (1.0f / 64.0f) + EPS);
#pragma unroll
                    for (int bj = 0; bj < 2; ++bj)
#pragma unroll
                        for (int j = 0; j < 8; ++j) v[bj][j] = v[bj][j] * r2 * nv[bj][j];
                    const f32x4* rp = (const f32x4*)(rope + (size_t)row * 16);
                    const f32x4 c0 = rp[0], c1 = rp[1], s0 = rp[2], s1 = rp[3];
#pragma unroll
                    for (int j = 0; j < 8; ++j) { const float other = __shfl_xor(v[0][j], 16); const float cc = j < 4 ? c0[j] : c1[j - 4], sn = j < 4 ? s0[j] : s1[j - 4];
                        const float mine = v[0][j]; const float rot = (fq == 0) ? (mine * cc - other * sn) : (mine * cc + other * sn);
                        v[0][j] = (fq < 2) ? rot : mine; }
                }
#pragma unroll
                for (int bj = 0; bj < 2; ++bj) *(u32x4*)(O + (size_t)row * 1536 + hd * 64 + bj * 32 + fq * 8) = pack8(v[bj]);
            }
    }
};
}

#define XB_TMO      128
#define XB_XCNT(j)  (256  + 64 * (j))
#define XB_XSUB(j)  (1280 + 64 * (j))
#define XB_XGEN(j)  (2304 + 64 * (j))
#define XB_TOP      3328
#define XB_TOPGEN   3392
#define XCD_BAR_WORDS 3456
#define XB_SPIN_CAP (1u << 20)
__device__ __forceinline__ unsigned xb_ld(unsigned* p)              { return __hip_atomic_load(p, __ATOMIC_RELAXED, __HIP_MEMORY_SCOPE_AGENT); }
__device__ __forceinline__ unsigned xb_add(unsigned* p, unsigned v) { return __hip_atomic_fetch_add(p, v, __ATOMIC_RELAXED, __HIP_MEMORY_SCOPE_AGENT); }
__device__ __forceinline__ unsigned xb_xcc_id() { return (unsigned)__builtin_amdgcn_s_getreg((3 << 11) | 20) & 0xFu; }
#define XB_SPIN(cond, bar) do { unsigned _sp = 0; while (cond) { __builtin_amdgcn_s_sleep(1); \
    if ((++_sp & 255u) == 0u) { if (xb_ld(&(bar)[XB_TMO])) break; if (_sp > XB_SPIN_CAP) { atomicAdd(&(bar)[XB_TMO], 1u); break; } } } } while (0)
struct XcdBarrier { unsigned* bar; unsigned x; volatile LAS unsigned* st; };
__device__ __forceinline__ XcdBarrier xcd_barrier_post(unsigned* bar, volatile LAS unsigned* st) {
    XcdBarrier b; b.bar = bar; b.x = xb_xcc_id(); b.st = st;
    if (threadIdx.x == 0) (void)xb_add(&bar[XB_XCNT(b.x)], 1u);
    return b;
}
__device__ __forceinline__ void xcd_barrier_complete(unsigned* bar, unsigned x, unsigned& nloc, unsigned& nx) {
    const unsigned G = gridDim.x * gridDim.y * gridDim.z;
    unsigned sum, cnt, mine, sp = 0u;
    for (;;) {
        sum = 0u; cnt = 0u; mine = 0u;
#pragma unroll
        for (unsigned j = 0; j < 16; ++j) { const unsigned c = xb_ld(&bar[XB_XCNT(j)]); sum += c; cnt += (c > 0u) ? 1u : 0u; mine = (j == x) ? c : mine; }
        if (sum == G) break;
        __builtin_amdgcn_s_sleep(1);
        if ((++sp & 255u) == 0u) { if (xb_ld(&bar[XB_TMO])) break; if (sp > XB_SPIN_CAP) { atomicAdd(&bar[XB_TMO], 1u); break; } }
    }
    nloc = mine > 0u ? mine : 1u; nx = cnt > 0u ? cnt : 1u;
}
__device__ __forceinline__ void xcd_barrier(const XcdBarrier& b) {
    asm volatile("s_waitcnt vmcnt(0)" ::: "memory");
    __syncthreads();
    if (threadIdx.x == 0) {
        unsigned* bar = b.bar;
        __builtin_amdgcn_s_waitcnt(0);
        unsigned nloc = b.st[0], nx = b.st[1];
        if (nloc == 0u) { xcd_barrier_complete(bar, b.x, nloc, nx); b.st[0] = nloc; b.st[1] = nx; }
        const unsigned old = xb_add(&bar[XB_XSUB(b.x)], 1u);
        const unsigned gen = old / nloc;
        if (old + 1u == (gen + 1u) * nloc) {
            __builtin_amdgcn_fence(__ATOMIC_RELEASE, "agent");
            asm volatile("s_waitcnt vmcnt(0)" ::: "memory");
            const unsigned og = xb_add(&bar[XB_TOP], 1u);
            const unsigned tg = og / nx;
            if (og + 1u == (tg + 1u) * nx) xb_add(&bar[XB_TOPGEN], 1u);
            else XB_SPIN(xb_ld(&bar[XB_TOPGEN]) == tg, bar);
            __builtin_amdgcn_fence(__ATOMIC_ACQUIRE, "agent");
            xb_add(&bar[XB_XGEN(b.x)], 1u);
            asm volatile("s_waitcnt vmcnt(0)" ::: "memory");
        } else {
            XB_SPIN(xb_ld(&bar[XB_XGEN(b.x)]) == gen, bar);
            __builtin_amdgcn_fence(__ATOMIC_ACQUIRE, "agent");
            asm volatile("s_waitcnt vmcnt(0)" ::: "memory");
        }
    }
    __syncthreads();
}

struct Args { const float* in[39]; const int* pos; float* out; unsigned char* ws; int ph_lo, ph_hi, variant, pad; };
enum InIdx { I_X = 0, I_NORM_MIX0 = 1, I_W_IN, I_MU, I_W0, I_WDEC, I_A0, I_WICL, I_WGAT, I_KK, I_KA, I_RK, I_GNW, I_GNB, I_CONVW, I_CONVB, I_DTB, I_ALOG, I_DSKIP, I_SSDN,
             I_WOUT, I_NORM_FFN0, I_FG, I_FU, I_FD, I_NORM_MIX1, I_WQKV, I_BQKV, I_QN, I_KN, I_SINK, I_WO, I_BO, I_NORM_FFN1, I_ROUTER, I_EG, I_EU, I_ED };

__device__ __forceinline__ void transpose_item(const float* W, int ld, int K, int k0, int n0, bf16_t* WT, int drow, LAS float* scr, int lane) {
#pragma unroll 8
    for (int i = 0; i < 32; ++i) { const int kk = 2 * i + (lane >> 5); scr[kk * 33 + (lane & 31)] = W[(size_t)(k0 + kk) * ld + n0 + (lane & 31)]; }
    asm volatile("s_waitcnt lgkmcnt(0)" ::: "memory");
    const int c = lane & 7;
#pragma unroll
    for (int j = 0; j < 4; ++j) { const int n = (lane >> 3) + 8 * j; const LAS float* s = scr + (8 * c) * 33 + n;
        u32x4 o; o.x = pk2(s[0 * 33], s[1 * 33]); o.y = pk2(s[2 * 33], s[3 * 33]); o.z = pk2(s[4 * 33], s[5 * 33]); o.w = pk2(s[6 * 33], s[7 * 33]);
        *(u32x4*)(WT + (size_t)(drow + n) * K + k0 + 8 * c) = o; }
    asm volatile("s_waitcnt lgkmcnt(0)" ::: "memory");
}
__device__ __forceinline__ int drow_of(int kind, int n0) {
    if (kind == 0) return n0;
    if (kind == 1) return 256 * (n0 >> 7) + (n0 & 127);
    if (kind == 2) return 256 * (n0 >> 7) + 128 + (n0 & 127);
    const int hd = n0 >> 6, bj = (n0 >> 5) & 1; return 256 * (hd >> 2) + 128 * bj + 32 * (hd & 3);
}
__device__ __forceinline__ bool transpose_matrix(int& it, const float* W, int ld, int K, int ncols, bf16_t* WT, int kind, LAS float* scr, int lane) {
    const int nnb = ncols / 32, items = (K / 64) * nnb;
    if (it < items) { const int kb = it / nnb, nb = it % nnb; transpose_item(W, ld, K, 64 * kb, 32 * nb, WT, drow_of(kind, 32 * nb), scr, lane); return true; }
    it -= items; return false;
}

#ifndef DUPM
#define DUPM 0u
#endif

#define XN ((bf16_t*)(ws + WS_XN))
#define MIX ((bf16_t*)(ws + WS_MIX))
#define PROJ ((bf16_t*)(ws + WS_PROJ))
#define GOUT ((bf16_t*)(ws + WS_GOUT))
#define XNB ((bf16_t*)(ws + WS_XNB))
#define HID ((bf16_t*)(ws + WS_HID))
#define QKV ((bf16_t*)(ws + WS_QKV))
#define ATTO ((bf16_t*)(ws + WS_ATTO))
#define AS ((bf16_t*)(ws + WS_AS))
#define HS ((bf16_t*)(ws + WS_HS))
#define XBCC ((bf16_t*)(ws + WS_EGU))
#define SSTATE ((bf16_t*)(ws + 38 * MiB))
#define CHDEC ((float*)(ws + WS_TOPE))
#define DTSP ((float*)(ws + WS_DTSP))
#define KKR ((float*)(ws + WS_KKR))
#define ROPE ((float*)(ws + WS_ROPE))
#define SS ((float*)(ws + WS_SS))
#define TOPE ((int*)(ws + WS_TOPE))
#define RANK ((int*)(ws + WS_RANK))
#define TOPW ((float*)(ws + WS_TOPW))
#define POS ((int*)(ws + WS_POS))
#define RSTD4 ((float*)(ws + WS_RSTD4))
#define RSTDS ((float*)(ws + WS_RSTDS))
#define WDEC ((bf16_t*)(ws + WS_WDEC))
#define WICL ((bf16_t*)(ws + WS_WICL))
#define WGAT ((bf16_t*)(ws + WS_WGAT))
#define EGU ((bf16_t*)(ws + WS_EGU))
#define EDN ((bf16_t*)(ws + WS_EDN))
#define WIN ((bf16_t*)(ws + WS_WIN))
#define WOUT ((bf16_t*)(ws + WS_WOUT))
#define WGU ((bf16_t*)(ws + WS_WGU))
#define WDN ((bf16_t*)(ws + WS_WDN))
#define WQKV ((bf16_t*)(ws + WS_WQKV))
#define WO ((bf16_t*)(ws + WS_WO))
__global__ void __launch_bounds__(512, 2) fwd_kernel(Args args) {
    extern __shared__ __attribute__((aligned(16))) unsigned char lds_raw[];
    LAS unsigned char* lds = (LAS unsigned char*)lds_raw;
    volatile LAS unsigned* MISC = (volatile LAS unsigned*)(lds + MISC_OFF);
    const int tid = threadIdx.x, lane = tid & 63, wave = __builtin_amdgcn_readfirstlane(tid >> 6);
    const int G = gridDim.x, bx = blockIdx.x;
    const int vcu = (G % 8 == 0) ? (bx % 8) * (G / 8) + bx / 8 : bx;
    unsigned char* ws = args.ws;
    unsigned* ctl = (unsigned*)(ws + WS_CTL);
    float* dout = args.out;
    if (tid < 32) ((LAS unsigned*)(lds + MISC_OFF))[tid] = 0u;
    __syncthreads();
    XcdBarrier bar = xcd_barrier_post(ctl + CW_BAR, MISC + 8);
    const int lo = args.ph_lo, hi = args.ph_hi;
#define IN(k) (lo <= (k) && (k) < hi)
#if DUPM
#define PHASE(k) for (int rep_ = 0; rep_ <= (int)((DUPM >> (k)) & 1u); ++rep_) if (IN(k))
#define REPBAR if (rep_) xcd_barrier(bar);
#else
#define PHASE(k) if (IN(k))
#define REPBAR
#endif
#define SEAM(k) do { if (IN(k) && IN((k) + 1)) xcd_barrier(bar); } while (0)
    const int gw = vcu * 8 + wave, NGW = G * 8;

    unsigned* CNT = ctl + CW_CNT;

    PHASE(0) { REPBAR
        LAS float* scr = (LAS float*)(lds + wave * 16384);
        for (int it0 = gw; ; it0 += NGW) {
            int it = it0;
            if (transpose_matrix(it, args.in[I_W_IN], IN0, DM, NPROJ, WIN, 0, scr, lane)) continue;
            if (transpose_matrix(it, args.in[I_WOUT], DM, DM, DM, WOUT, 0, scr, lane)) continue;
            if (transpose_matrix(it, args.in[I_FG], FFN, DM, FFN, WGU, 1, scr, lane)) continue;
            if (transpose_matrix(it, args.in[I_FU], FFN, DM, FFN, WGU, 2, scr, lane)) continue;
            if (transpose_matrix(it, args.in[I_FD], DM, FFN, DM, WDN, 0, scr, lane)) continue;
            if (transpose_matrix(it, args.in[I_WQKV], 1536, DM, 1536, WQKV, 3, scr, lane)) continue;
            if (transpose_matrix(it, args.in[I_WO], DM, DM, DM, WO, 0, scr, lane)) continue;
            if (transpose_matrix(it, args.in[I_WDEC], 512, 64, 512, WDEC, 0, scr, lane)) continue;
            if (transpose_matrix(it, args.in[I_WICL], 512, 64, 512, WICL, 0, scr, lane)) continue;
            if (transpose_matrix(it, args.in[I_WGAT], 512, 128, 512, WGAT, 0, scr, lane)) continue;
            break;
        }
        __syncthreads();
        LAS float* w8 = (LAS float*)lds;
        for (int r = tid; r < DM; r += 512) { const float* p = args.in[I_W_IN] + (size_t)r * IN0 + NPROJ; *(LAS f32x4*)(w8 + r * 8) = *(const f32x4*)p; *(LAS f32x4*)(w8 + r * 8 + 4) = *(const f32x4*)(p + 4); }
        __syncthreads();
        const float* gm = args.in[I_NORM_MIX0];
        for (int m = gw; m < MTOK; m += NGW) {
            const f32x4* xr = (const f32x4*)(args.in[I_X] + (size_t)m * DM) + lane;
            f32x4 v[4]; float s = 0.f;
#pragma unroll
            for (int j = 0; j < 4; ++j) { v[j] = xr[64 * j]; s += (v[j][0] * v[j][0] + v[j][1] * v[j][1]) + (v[j][2] * v[j][2] + v[j][3] * v[j][3]); }
            const float rstd = __builtin_amdgcn_rsqf(wave_sum(s) * (1.0f / DM) + EPS);
            float d[8];
#pragma unroll
            for (int k = 0; k < 8; ++k) d[k] = 0.f;
            unsigned long long* o8 = (unsigned long long*)(XN + (size_t)m * DM) + lane;
#pragma unroll
            for (int j = 0; j < 4; ++j) { const f32x4 g4 = ((const f32x4*)gm)[64 * j + lane]; const f32x4 y = v[j] * rstd * g4;
                o8[64 * j] = (unsigned long long)pk2(y[0], y[1]) | ((unsigned long long)pk2(y[2], y[3]) << 32);
#pragma unroll
                for (int i = 0; i < 4; ++i) { const int c = 256 * j + 4 * lane + i; const f32x4 wa = *(const LAS f32x4*)(w8 + c * 8), wb = *(const LAS f32x4*)(w8 + c * 8 + 4);
                    d[0] += y[i] * wa[0]; d[1] += y[i] * wa[1]; d[2] += y[i] * wa[2]; d[3] += y[i] * wa[3]; d[4] += y[i] * wb[0]; d[5] += y[i] * wb[1]; d[6] += y[i] * wb[2]; d[7] += y[i] * wb[3]; } }
#pragma unroll
            for (int k = 0; k < 8; ++k) d[k] = wave_sum(d[k]);
            if (lane < 8) { float dv = d[0];
#pragma unroll
                for (int k = 1; k < 8; ++k) dv = (lane == k) ? d[k] : dv;
                const float z = dv + args.in[I_DTB][lane]; DTSP[(size_t)m * 8 + lane] = z > 20.f ? z : log1pf(__expf(z)); }
            if (lane >= 16 && lane < 24) { const int j = lane - 16; const double inv = exp(-(double)j * 0.125 * 13.122363377404328); const double ang = (double)args.pos[m] * inv;
                ROPE[(size_t)m * 16 + j] = (float)cos(ang); ROPE[(size_t)m * 16 + 8 + j] = (float)sin(ang); }
        }
        __syncthreads();
    }
    SEAM(0);

    PHASE(1) { REPBAR
        pg8::Gemm g{XN, WIN, MTOK, NPROJ, DM}; pg8::StaticOrder S; S.init(MTOK, NPROJ, G, bx);
        pg8::EpiBf16 E{PROJ, NPROJ};
        pg8::gemm_phase(lds, g, S, E);
    }
    SEAM(1);

    const int r32 = lane & 31, hh = lane >> 5, trq = (lane & 15) >> 2, trc = 16 * ((lane >> 4) & 1) + 4 * (lane & 3);
#define TRF(M, P, s, blk) ({ const LAS bf16_t* p_ = (M) + (16 * (s) + 8 * hh + trq) * (P) + 32 * (blk) + trc; \
        const s16x4 lo_ = __builtin_bit_cast(s16x4, __builtin_amdgcn_ds_read_tr16_b64_v4i16((LAS s16x4*)p_)); \
        const s16x4 hi_ = __builtin_bit_cast(s16x4, __builtin_amdgcn_ds_read_tr16_b64_v4i16((LAS s16x4*)(p_ + 4 * (P)))); \
        (bf16x8){lo_[0], lo_[1], lo_[2], lo_[3], hi_[0], hi_[1], hi_[2], hi_[3]}; })
#define NATF(M, P, s, blk) (*(const LAS bf16x8*)((M) + (32 * (blk) + r32) * (P) + 16 * (s) + 8 * hh))
    PHASE(2) { REPBAR
        const float* mu = args.in[I_MU];
        LAS bf16_t* Aw = (LAS bf16_t*)lds; LAS bf16_t* Aa = (LAS bf16_t*)(lds + 9216); LAS bf16_t* Ag = (LAS bf16_t*)(lds + 18432);
        LAS float* LW = (LAS float*)(lds + 35840); LAS float* IC = LW + 4096;
        LAS bf16_t* At = (LAS bf16_t*)(lds + 68864); LAS bf16_t* Kt = At + 4608; LAS bf16_t* Bt = Kt + 4608; LAS bf16_t* Rt = Bt + 4608; LAS bf16_t* Vt = Rt + 4608;
        LAS bf16_t* Lab = (LAS bf16_t*)(lds + 35840);
        LAS bf16_t* XX = At;
        LAS bf16_t* Lak = (LAS bf16_t*)(lds + 114944); LAS bf16_t* Mrk = Lak + 4608; LAS bf16_t* Mrb = Mrk + 4608;
        LAS float* TOT = (LAS float*)(lds + 142592); LAS float* GAMC = TOT + 512;
        const int mt = (wave >> 1) & 1, nt = wave & 1, grp = wave >> 2;
        const int var = args.variant;
        for (int unit = vcu; unit < MTOK / 64; unit += G) {
            const int m0 = unit * 64;
            if (!(var & 2)) {
                const int tt = tid >> 3, cg = tid & 7, m = m0 + tt; const bool hasprev = (m & (SEQ - 1)) != 0;
                const bf16_t* pc = PROJ + (size_t)m * NPROJ + 1536 + 32 * cg;
#pragma unroll 1
                for (int q = 0; q < 4; ++q) {
                    float c[8], p[8]; unpack8(*(const u32x4*)(pc + 8 * q), c);
                    if (hasprev) unpack8(*(const u32x4*)(pc - NPROJ + 8 * q), p); else { for (int i = 0; i < 8; ++i) p[i] = 0.f; }
                    float o[8];
#pragma unroll
                    for (int i = 0; i < 8; ++i) { const int col = 32 * cg + 8 * q + i; const float x = c[i] + (p[i] - c[i]) * mu[1536 + col];
                        o[i] = cg < 2 ? tanhf(x) : (cg < 4 ? x : sigmoidf_(x)); }
                    const u32x4 w = pack8(o); const int col0 = 32 * cg + 8 * q;
                    if (cg < 2) *(LAS u32x4*)(Aw + tt * 72 + col0) = w; else if (cg < 4) *(LAS u32x4*)(Aa + tt * 72 + (col0 - 64)) = w; else *(LAS u32x4*)(Ag + tt * 136 + (col0 - 128)) = w;
                }
            }
            LBAR();
#pragma unroll 1
            for (int h = 0; h < ((var & 16) ? 0 : 8); ++h) {
                unsigned char* cs = (unsigned char*)dout + (size_t)(unit * 8 + h) * 24576;
                float r0v[8], k0v[8], v0v[8]; float pr = 0.f, pk = 0.f, pv = 0.f;
                {   const bf16_t* pp = PROJ + (size_t)(m0 + 8 * wave) * NPROJ + 64 * h + lane;
                    if (((m0 + 8 * wave) & (SEQ - 1)) != 0) { pr = bflo(pp[-NPROJ]); pk = bflo(pp[-NPROJ + 512]); pv = bflo(pp[-NPROJ + 1024]); }
#pragma unroll
                    for (int i = 0; i < 8; ++i) { r0v[i] = bflo(pp[(size_t)i * NPROJ]); k0v[i] = bflo(pp[(size_t)i * NPROJ + 512]); v0v[i] = bflo(pp[(size_t)i * NPROJ + 1024]); } }
                if (grp == 0) {
                    f32x16 ad, ai;
#pragma unroll
                    for (int r = 0; r < 16; ++r) { ad[r] = 0.f; ai[r] = 0.f; }
#pragma unroll
                    for (int s = 0; s < 4; ++s) {
                        const bf16x8 bd = *(const bf16x8*)(WDEC + (size_t)(64 * h + 32 * nt + r32) * 64 + 16 * s + 8 * hh), bi = *(const bf16x8*)(WICL + (size_t)(64 * h + 32 * nt + r32) * 64 + 16 * s + 8 * hh);
                        ad = __builtin_amdgcn_mfma_f32_32x32x16_bf16(NATF(Aw, 72, s, mt), bd, ad, 0, 0, 0);
                        ai = __builtin_amdgcn_mfma_f32_32x32x16_bf16(NATF(Aa, 72, s, mt), bi, ai, 0, 0, 0);
                    }
                    const int c = 32 * nt + r32; const float w0c = args.in[I_W0][64 * h + c], a0c = args.in[I_A0][64 * h + c];
                    LAS float* lwb = LW + (32 * mt + 4 * hh) * 64 + c;
#pragma unroll
                    for (int r = 0; r < 16; ++r) { lwb[crc(r) * 64] = -0.6065306597126334f * sigmoidf_(ad[r] + w0c); lwb[4096 + crc(r) * 64] = sigmoidf_(ai[r] + a0c); }
                } else {
                    f32x16 ag;
#pragma unroll
                    for (int r = 0; r < 16; ++r) ag[r] = 0.f;
#pragma unroll
                    for (int s = 0; s < 8; ++s) {
                        const bf16x8 bg = *(const bf16x8*)(WGAT + (size_t)(64 * h + 32 * nt + r32) * 128 + 16 * s + 8 * hh);
                        ag = __builtin_amdgcn_mfma_f32_32x32x16_bf16(NATF(Ag, 136, s, mt), bg, ag, 0, 0, 0);
                    }
                    bf16_t* gob = GOUT + (size_t)(m0 + 32 * mt + 4 * hh) * 512 + 64 * h + 32 * nt + r32;
#pragma unroll
                    for (int r = 0; r < 16; ++r) gob[crc(r) * 512] = (bf16_t)f2bf(ag[r]);
                }
                LBAR();
                {
                    const int c = lane, gc = 64 * h + c, t0 = 8 * wave;
                    const float mur = mu[gc], muk = mu[512 + gc], muv = mu[1024 + gc], kkc = args.in[I_KK][gc], kac = args.in[I_KA][gc], rkc = args.in[I_RK][gc];
                    float rr[8], kx[8], vv[8], an[8], bn[8], lw[8], cl[8]; float run = 0.f;
#pragma unroll
                    for (int i = 0; i < 8; ++i) {
                        const float r0 = r0v[i], k0 = k0v[i], v0 = v0v[i];
                        rr[i] = r0 + (pr - r0) * mur; const float kl = k0 + (pk - k0) * muk; vv[i] = v0 + (pv - v0) * muv; pr = r0; pk = k0; pv = v0;
                        const float ic = IC[(t0 + i) * 64 + c]; lw[i] = LW[(t0 + i) * 64 + c]; run += lw[i]; cl[i] = run;
                        const float xk = kl * kkc; const float ssq = dpp_sum63(xk * xk); const float kn = xk * __builtin_amdgcn_rsqf(ssq + 1e-12f);
                        an[i] = -kn; bn[i] = kn * ic; kx[i] = kl * (1.0f + (ic - 1.0f) * kac);
                        const float bon = dpp_sum63(rr[i] * kx[i] * rkc);
                        if (lane == 0) KKR[(size_t)(m0 + t0 + i) * 8 + h] = bon;
                    }
                    TOT[wave * 64 + c] = run;
                    LBAR();
                    float off = 0.f, totc = 0.f;
#pragma unroll
                    for (int w2 = 0; w2 < 8; ++w2) { const float tv = TOT[w2 * 64 + c]; totc += tv; off += (w2 < wave) ? tv : 0.f; }
                    if (wave == 0) GAMC[c] = __expf(totc);
#pragma unroll
                    for (int i = 0; i < 8; ++i) { const float cum = off + cl[i]; const float en = __expf(-cum), ep = __expf(cum), em = __expf(cum - lw[i]); const int o = (t0 + i) * 72 + c;
                        At[o] = (bf16_t)f2bf(an[i] * em); Kt[o] = (bf16_t)f2bf(kx[i] * en); Bt[o] = (bf16_t)f2bf(bn[i] * en); Rt[o] = (bf16_t)f2bf(rr[i] * ep); Vt[o] = (bf16_t)f2bf(vv[i]); }
                }
                LBAR();
                {
                    f32x16 pb, pk2_;
#pragma unroll
                    for (int r = 0; r < 16; ++r) { pb[r] = 0.f; pk2_[r] = 0.f; }
                    const LAS bf16_t* Aop = grp == 0 ? At : Rt;
#pragma unroll
                    for (int s = 0; s < 4; ++s) { const bf16x8 a = NATF(Aop, 72, s, mt);
                        pb = __builtin_amdgcn_mfma_f32_32x32x16_bf16(a, NATF(Bt, 72, s, nt), pb, 0, 0, 0);
                        pk2_ = __builtin_amdgcn_mfma_f32_32x32x16_bf16(a, NATF(Kt, 72, s, nt), pk2_, 0, 0, 0); }
                    const int sc = 32 * nt + r32, tb = 32 * mt + 4 * hh;
                    LAS bf16_t* o1 = (grp == 0 ? Lab : Mrb) + tb * 72 + sc; LAS bf16_t* o2 = (grp == 0 ? Lak : Mrk) + tb * 72 + sc;
#pragma unroll
                    for (int r = 0; r < 16; ++r) { const int t = tb + crc(r); const bool keep = grp == 0 ? (sc < t) : (sc <= t);
                        o1[crc(r) * 72] = (bf16_t)f2bf(keep ? pb[r] : 0.f); o2[crc(r) * 72] = (bf16_t)f2bf(keep ? pk2_[r] : 0.f); }
                }
                LBAR();
                f32x16 accA, accB;
#pragma unroll
                for (int r = 0; r < 16; ++r) { accA[r] = 0.f; accB[r] = 0.f; }
                {
                    const LAS bf16_t* Aop = grp == 0 ? Lak : Mrk;
#pragma unroll
                    for (int s = 0; s < 4; ++s) { const bf16x8 vb = TRF(Vt, 72, s, nt);
                        if (grp == 0) { accA = __builtin_amdgcn_mfma_f32_32x32x16_bf16(NATF(Aop, 72, s, mt), vb, accA, 0, 0, 0); accB = __builtin_amdgcn_mfma_f32_32x32x16_bf16(TRF(Kt, 72, s, mt), vb, accB, 0, 0, 0); }
                        else accB = __builtin_amdgcn_mfma_f32_32x32x16_bf16(NATF(Aop, 72, s, mt), vb, accB, 0, 0, 0); }
                    if (grp == 0) { LAS float* ggb = IC + (32 * mt + 4 * hh) * 65 + 32 * nt + r32;
#pragma unroll
                        for (int r = 0; r < 16; ++r) ggb[crc(r) * 65] = accA[r]; }
                }
                LBAR();
                {
                    const int n16 = lane & 15, g4 = lane >> 4;
                    f32x4 Rr[4];
                    if (wave < 4) {
#pragma unroll
                        for (int I = 0; I < 4; ++I)
#pragma unroll
                            for (int j = 0; j < 4; ++j) Rr[I][j] = bflo((unsigned)At[(16 * I + 4 * g4 + j) * 72 + 16 * wave + n16]);
                    } else { const LAS float* GG = IC;
#pragma unroll
                        for (int I = 0; I < 4; ++I)
#pragma unroll
                            for (int j = 0; j < 4; ++j) Rr[I][j] = GG[(16 * I + 4 * g4 + j) * 65 + 16 * (wave - 4) + n16];
                    }
                    LBAR();
                    const LAS bf16_t* lrow = Lab + n16 * 72 + 4 * g4;
#define LF(I, J) (*(const LAS u32x2*)(lrow + (16 * (I)) * 72 + 16 * (J)))
#define MF16(A0, A1, B0, B1, C) __builtin_amdgcn_mfma_f32_16x16x32_bf16(__builtin_bit_cast(bf16x8, (u32x4){(A0).x, (A0).y, (A1).x, (A1).y}), __builtin_bit_cast(bf16x8, (u32x4){(B0).x, (B0).y, (B1).x, (B1).y}), (C), 0, 0, 0)
                    const u32x2 zz = (u32x2){0u, 0u};
                    u32x2 Xb[4];
#pragma unroll
                    for (int I = 0; I < 4; ++I) {
                        f32x4 Z = Rr[I];
                        if (I == 1) Z = MF16(LF(1, 0), zz, Xb[0], zz, Z);
                        if (I == 2) Z = MF16(LF(2, 0), LF(2, 1), Xb[0], Xb[1], Z);
                        if (I == 3) { Z = MF16(LF(3, 0), LF(3, 1), Xb[0], Xb[1], Z); Z = MF16(LF(3, 2), zz, Xb[2], zz, Z); }
                        const u32x2 ld = LF(I, I);
                        f32x4 X = Z;
#pragma unroll
                        for (int it = 0; it < 15; ++it) { u32x2 xb; xb.x = pk2(X[0], X[1]); xb.y = pk2(X[2], X[3]); X = MF16(ld, zz, xb, zz, Z); }
                        Xb[I].x = pk2(X[0], X[1]); Xb[I].y = pk2(X[2], X[3]);
                        LAS bf16_t* xo = XX + (16 * I + 4 * g4) * 136 + 16 * wave + n16;
                        xo[0] = (bf16_t)(Xb[I].x & 0xffffu); xo[136] = (bf16_t)(Xb[I].x >> 16); xo[272] = (bf16_t)(Xb[I].y & 0xffffu); xo[408] = (bf16_t)(Xb[I].y >> 16);
                    }
#undef LF
#undef MF16
                }
                LBAR();
                {
                    f32x16 acc1;
#pragma unroll
                    for (int r = 0; r < 16; ++r) acc1[r] = 0.f;
#pragma unroll
                    for (int s = 0; s < 4; ++s) {
                        const bf16x8 a = grp == 0 ? TRF(Bt, 72, s, mt) : NATF(Mrb, 72, s, mt);
                        acc1 = __builtin_amdgcn_mfma_f32_32x32x16_bf16(a, TRF(XX, 136, s, nt), acc1, 0, 0, 0);
                        accB = __builtin_amdgcn_mfma_f32_32x32x16_bf16(a, TRF(XX + 64, 136, s, nt), accB, 0, 0, 0);
                    }
                    const int col = 32 * nt + r32, rb = 32 * mt + 4 * hh;
                    if (grp == 0) {
                        bf16_t* acb = (bf16_t*)cs + rb * 64 + col; bf16_t* dcb = (bf16_t*)(cs + 8192) + col * 64 + rb; const LAS float* gb = GAMC + rb;
#pragma unroll
                        for (int r = 0; r < 16; ++r) { const float gcv = gb[crc(r)]; acb[crc(r) * 64] = (bf16_t)f2bf(gcv * (acc1[r] + ((rb + crc(r)) == col ? 1.0f : 0.0f))); }
#pragma unroll
                        for (int rq = 0; rq < 4; ++rq) { const f32x4 g4 = *(const LAS f32x4*)(gb + 8 * rq);
                            u32x2 w; w.x = pk2(accB[4 * rq] * g4[0], accB[4 * rq + 1] * g4[1]); w.y = pk2(accB[4 * rq + 2] * g4[2], accB[4 * rq + 3] * g4[3]); *(u32x2*)(dcb + 8 * rq) = w; }
                    } else {
                        bf16_t* rpb = (bf16_t*)(cs + 16384) + rb * 64 + col; const LAS bf16_t* rtb = Rt + rb * 72 + col; bf16_t* yb = MIX + (size_t)(m0 + rb) * DM + 64 * h + col;
#pragma unroll
                        for (int r = 0; r < 16; ++r) { rpb[crc(r) * 64] = (bf16_t)f2bf(acc1[r] + bflo((unsigned)rtb[crc(r) * 72])); yb[crc(r) * DM] = (bf16_t)f2bf(accB[r]); }
                    }
                }
                LBAR();
            }
        }
        for (int unit = vcu; unit < ((var & 1) ? 0 : MTOK / 64); unit += G) {
            const int m0 = unit * 64;
            {
                const int cgp = tid & 127, ts = tid >> 7, c0 = 8 * cgp; const float* cw = args.in[I_CONVW]; const float* cb = args.in[I_CONVB];
                float w[4][8], bb[8];
#pragma unroll
                for (int j = 0; j < 4; ++j)
#pragma unroll
                    for (int i = 0; i < 8; ++i) w[j][i] = cw[j * 1024 + c0 + i];
#pragma unroll
                for (int i = 0; i < 8; ++i) bb[i] = cb[c0 + i];
                float x0[8], x1[8], x2[8], x3[8];
                const int mstart = m0 + 16 * ts; const int tpos = mstart & (SEQ - 1);
                const bf16_t* srcp = PROJ + (size_t)mstart * NPROJ + 2304 + c0;
#pragma unroll
                for (int i = 0; i < 8; ++i) { x0[i] = 0.f; x1[i] = 0.f; x2[i] = 0.f; }
                if (tpos >= 3) unpack8(*(const u32x4*)(srcp - 3 * (size_t)NPROJ), x0);
                if (tpos >= 2) unpack8(*(const u32x4*)(srcp - 2 * (size_t)NPROJ), x1);
                if (tpos >= 1) unpack8(*(const u32x4*)(srcp - 1 * (size_t)NPROJ), x2);
                for (int t = 0; t < 16; ++t) {
                    unpack8(*(const u32x4*)(srcp + (size_t)t * NPROJ), x3);
                    float o[8];
#pragma unroll
                    for (int i = 0; i < 8; ++i) { const float y = bb[i] + w[0][i] * x0[i] + w[1][i] * x1[i] + w[2][i] * x2[i] + w[3][i] * x3[i]; o[i] = siluf_(y); x0[i] = x1[i]; x1[i] = x2[i]; x2[i] = x3[i]; }
                    *(u32x4*)(XBCC + (size_t)(mstart + t) * 1024 + c0) = pack8(o);
                }
            }
        }
    }

    SEAM(2);

    PHASE(3) { REPBAR
        if (vcu < 32) {
            const int b = vcu >> 3, h = vcu & 7;
            const unsigned char* cbase = (const unsigned char*)dout + (size_t)(b * 64 * 8 + h) * 24576;
            constexpr size_t CSTR = (size_t)8 * 24576; constexpr int SLOT = 27648;
            const bool loader = wave >= 2; const int lt = tid - 128;
            int poff[4];
#pragma unroll
            for (int k = 0; k < 4; ++k) { const int p = lt + 384 * k; poff[k] = (p >> 9) * 9216 + ((p & 511) >> 3) * 144 + (p & 7) * 16; }
            u32x4 st[4][4];
#define RB_ISSUE(set, ch) do { if (loader) { const unsigned char* g_ = cbase + (size_t)(ch) * CSTR + (size_t)lt * 16; _Pragma("unroll") for (int k = 0; k < 4; ++k) st[set][k] = *(const u32x4*)(g_ + k * 6144); } } while (0)
#define RB_WRITE(set, ch) do { if (loader) { LAS unsigned char* s_ = lds + ((ch) & 3) * SLOT; _Pragma("unroll") for (int k = 0; k < 4; ++k) *(LAS u32x4*)(s_ + poff[k]) = st[set][k]; } } while (0)
            RB_ISSUE(0, 0); RB_ISSUE(1, 1); RB_WRITE(0, 0); RB_WRITE(1, 1);
            RB_ISSUE(2, 2); RB_ISSUE(3, 3); RB_ISSUE(0, 4); RB_ISSUE(1, 5);
            LBAR();
            f32x16 H[2];
#pragma unroll
            for (int r = 0; r < 16; ++r) { H[0][r] = 0.f; H[1][r] = 0.f; }
            bf16_t* zp = (bf16_t*)((unsigned char*)dout + 48 * MiB) + (size_t)(b * SEQ + 4 * hh) * 512 + 64 * h + 32 * wave + r32;
#define RB_STEP(j, chv) do { const int ch_ = (chv); \
                if (loader) { if (ch_ + 2 < 64) RB_WRITE(((j) + 2) & 3, ch_ + 2); if (ch_ + 6 < 64) RB_ISSUE(((j) + 2) & 3, ch_ + 6); } \
                else { const LAS unsigned char* sl = lds + (ch_ & 3) * SLOT; f32x16 Hn[2], Z[2]; bf16x8 Hb[4]; \
                    _Pragma("unroll") for (int s = 0; s < 4; ++s) { const int m = s >> 1, o = 8 * (s & 1); u32x4 t; t.x = pk2(H[m][o], H[m][o + 1]); t.y = pk2(H[m][o + 2], H[m][o + 3]); t.z = pk2(H[m][o + 4], H[m][o + 5]); t.w = pk2(H[m][o + 6], H[m][o + 7]); Hb[s] = __builtin_bit_cast(bf16x8, t); } \
                    _Pragma("unroll") for (int m = 0; m < 2; ++m) { \
                        _Pragma("unroll") for (int rq = 0; rq < 4; ++rq) { const u32x2 d = *(const LAS u32x2*)(sl + 9216 + (32 * wave + r32) * 144 + (32 * m + 8 * rq + 4 * hh) * 2); \
                            Hn[m][4 * rq] = bflo(d.x); Hn[m][4 * rq + 1] = bfhi(d.x); Hn[m][4 * rq + 2] = bflo(d.y); Hn[m][4 * rq + 3] = bfhi(d.y); } \
                        _Pragma("unroll") for (int r = 0; r < 16; ++r) Z[m][r] = 0.f; } \
                    _Pragma("unroll") for (int s = 0; s < 4; ++s) \
                        _Pragma("unroll") for (int m = 0; m < 2; ++m) { const int o = (32 * m + r32) * 144 + (16 * s + 4 * hh) * 2; \
                            const u32x2 a0 = *(const LAS u32x2*)(sl + o), a1 = *(const LAS u32x2*)(sl + o + 16), q0 = *(const LAS u32x2*)(sl + 18432 + o), q1 = *(const LAS u32x2*)(sl + 18432 + o + 16); \
                            u32x4 t; t.x = a0.x; t.y = a0.y; t.z = a1.x; t.w = a1.y; Hn[m] = __builtin_amdgcn_mfma_f32_32x32x16_bf16(__builtin_bit_cast(bf16x8, t), Hb[s], Hn[m], 0, 0, 0); \
                            t.x = q0.x; t.y = q0.y; t.z = q1.x; t.w = q1.y; Z[m] = __builtin_amdgcn_mfma_f32_32x32x16_bf16(__builtin_bit_cast(bf16x8, t), Hb[s], Z[m], 0, 0, 0); } \
                    H[0] = Hn[0]; H[1] = Hn[1]; \
                    bf16_t* zq = zp + (size_t)ch_ * 64 * 512; \
                    _Pragma("unroll") for (int m = 0; m < 2; ++m) _Pragma("unroll") for (int r = 0; r < 16; ++r) zq[(32 * m + crc(r)) * 512] = (bf16_t)f2bf(Z[m][r]); } \
                LBAR(); } while (0)
            if (wave < 2 || loader) {
                for (int ch = 0; ch < 64; ch += 4) { RB_STEP(0, ch); RB_STEP(1, ch + 1); RB_STEP(2, ch + 2); RB_STEP(3, ch + 3); }
            }
#undef RB_STEP
#undef RB_ISSUE
#undef RB_WRITE
        } else {
            LAS bf16_t* Bm = (LAS bf16_t*)lds; LAS bf16_t* Xh = (LAS bf16_t*)(lds + 34816); LAS float* CUM = (LAS float*)(lds + 53248); LAS float* DTL = CUM + 512;
            for (int unit = vcu - 32; unit < 256; unit += G - 32) {
                const int g = unit & 1, c = (unit >> 1) & 31, b = unit >> 6, m0 = b * SEQ + c * 128;
#pragma unroll
                for (int k = 0; k < 4; ++k) { const int p = tid + 512 * k, row = p >> 4, c16 = p & 15; *(LAS u32x4*)(Bm + row * 136 + 8 * c16) = *(const u32x4*)(XBCC + (size_t)(m0 + row) * 1024 + 512 + 128 * g + 8 * c16); }
                if (wave < 4) { const int h = 4 * g + wave; const float a_h = -__expf(args.in[I_ALOG][h]);
                    const float v0 = DTSP[(size_t)(m0 + 2 * lane) * 8 + h], v1 = DTSP[(size_t)(m0 + 2 * lane + 1) * 8 + h]; float s = v0 + v1;
#pragma unroll
                    for (int o = 1; o < 64; o <<= 1) { const float t = __shfl_up(s, o); if (lane >= o) s += t; }
                    const float ex = s - (v0 + v1);
                    CUM[wave * 128 + 2 * lane] = a_h * (ex + v0); CUM[wave * 128 + 2 * lane + 1] = a_h * (ex + v0 + v1); DTL[wave * 128 + 2 * lane] = v0; DTL[wave * 128 + 2 * lane + 1] = v1; }
                LBAR();
#pragma unroll 1
                for (int hq = 0; hq < 4; ++hq) { const int h = 4 * g + hq;
                    { const int s = tid >> 2, cq = 16 * (tid & 3); const float sc = DTL[hq * 128 + s] * __expf(CUM[hq * 128 + 127] - CUM[hq * 128 + s]);
                      const bf16_t* xp = XBCC + (size_t)(m0 + s) * 1024 + 64 * h + cq;
#pragma unroll
                      for (int q = 0; q < 2; ++q) { float f[8]; unpack8(*(const u32x4*)(xp + 8 * q), f);
#pragma unroll
                          for (int i = 0; i < 8; ++i) f[i] *= sc;
                          *(LAS u32x4*)(Xh + s * 72 + cq + 8 * q) = pack8(f); } }
                    LBAR();
                    const int mt = wave >> 2, nt = wave & 3; f32x16 acc;
#pragma unroll
                    for (int r = 0; r < 16; ++r) acc[r] = 0.f;
#pragma unroll
                    for (int ks = 0; ks < 8; ++ks) acc = __builtin_amdgcn_mfma_f32_32x32x16_bf16(TRF(Xh, 72, ks, mt), TRF(Bm, 136, ks, nt), acc, 0, 0, 0);
                    bf16_t* sp = SSTATE + ((size_t)((b * 32 + c) * 8 + h)) * 8192 + (32 * mt + 4 * hh) * 128 + 32 * nt + r32;
#pragma unroll
                    for (int r = 0; r < 16; ++r) sp[crc(r) * 128] = (bf16_t)f2bf(acc[r]);
                    if (tid == 0) CHDEC[(b * 32 + c) * 8 + h] = __expf(CUM[hq * 128 + 127]);
                    LBAR();
                }
            }
        }
    }

    SEAM(3);

    PHASE(4) { REPBAR
        const int gt = vcu * 512 + tid, bh = gt >> 12, e2 = gt & 4095, b = bh >> 3, h = bh & 7;
        unsigned* sp = (unsigned*)SSTATE + ((size_t)(b * 32 * 8 + h)) * 4096 + e2;
        unsigned vals[32];
#pragma unroll
        for (int c = 0; c < 32; ++c) vals[c] = sp[(size_t)c * 8 * 4096];
        float r0 = 0.f, r1 = 0.f;
#pragma unroll
        for (int c = 0; c < 32; ++c) { const float dec = CHDEC[(b * 32 + c) * 8 + h]; sp[(size_t)c * 8 * 4096] = pk2(r0, r1); r0 = r0 * dec + bflo(vals[c]); r1 = r1 * dec + bfhi(vals[c]); }
    }
    SEAM(4);

    PHASE(5) { REPBAR
        {
            LAS bf16_t* Cm = (LAS bf16_t*)lds; LAS bf16_t* Bm = (LAS bf16_t*)(lds + 34816); LAS bf16_t* Xh = (LAS bf16_t*)(lds + 69632); LAS bf16_t* Hp = (LAS bf16_t*)(lds + 88064);
            LAS float* CUM = (LAS float*)(lds + 105472); LAS float* DTL = CUM + 512; LAS bf16_t* YL = (LAS bf16_t*)lds;
            for (int unit = vcu; unit < 256; unit += G) {
                const int g = unit & 1, c = (unit >> 1) & 31, b = unit >> 6, m0 = b * SEQ + c * 128;
#pragma unroll
                for (int k = 0; k < 4; ++k) { const int p = tid + 512 * k, row = p >> 4, c16 = p & 15; const bf16_t* sp = XBCC + (size_t)(m0 + row) * 1024 + 128 * g + 8 * c16;
                    *(LAS u32x4*)(Bm + row * 136 + 8 * c16) = *(const u32x4*)(sp + 512); *(LAS u32x4*)(Cm + row * 136 + 8 * c16) = *(const u32x4*)(sp + 768); }
                if (wave < 4) { const int h = 4 * g + wave; const float a_h = -__expf(args.in[I_ALOG][h]);
                    const float v0 = DTSP[(size_t)(m0 + 2 * lane) * 8 + h], v1 = DTSP[(size_t)(m0 + 2 * lane + 1) * 8 + h]; float s = v0 + v1;
#pragma unroll
                    for (int o = 1; o < 64; o <<= 1) { const float t = __shfl_up(s, o); if (lane >= o) s += t; }
                    const float ex = s - (v0 + v1);
                    CUM[wave * 128 + 2 * lane] = a_h * (ex + v0); CUM[wave * 128 + 2 * lane + 1] = a_h * (ex + v0 + v1); DTL[wave * 128 + 2 * lane] = v0; DTL[wave * 128 + 2 * lane + 1] = v1; }
                LBAR();
                const int mt = wave >> 1, nb = 2 * (wave & 1), nt2 = wave & 1;
                f32x16 cb[2];
#pragma unroll
                for (int r = 0; r < 16; ++r) { cb[0][r] = 0.f; cb[1][r] = 0.f; }
#pragma unroll
                for (int ks = 0; ks < 8; ++ks) { const bf16x8 a = NATF(Cm, 136, ks, mt);
                    cb[0] = __builtin_amdgcn_mfma_f32_32x32x16_bf16(a, NATF(Bm, 136, ks, nb), cb[0], 0, 0, 0); cb[1] = __builtin_amdgcn_mfma_f32_32x32x16_bf16(a, NATF(Bm, 136, ks, nb + 1), cb[1], 0, 0, 0); }
                LBAR();
                LAS bf16_t* Wt = Bm;
                f32x16 yt[4];
#pragma unroll
                for (int hq = 0; hq < 4; ++hq) { const int h = 4 * g + hq;
#pragma unroll
                    for (int j = 0; j < 2; ++j) { const int s = 32 * (nb + j) + r32; const float cs = CUM[hq * 128 + s], ds = DTL[hq * 128 + s]; const int lb = 32 * mt + 4 * hh;
                        LAS bf16_t* wp = Wt + lb * 136 + s; const LAS float* cl = CUM + hq * 128 + lb;
#pragma unroll
                        for (int r = 0; r < 16; ++r) { const float w = (s <= lb + crc(r)) ? cb[j][r] * __expf(cl[crc(r)] - cs) * ds : 0.f; wp[crc(r) * 136] = (bf16_t)f2bf(w); } }
                    { const int s = tid >> 2, cq = 16 * (tid & 3); const bf16_t* xp = XBCC + (size_t)(m0 + s) * 1024 + 64 * h + cq;
                      *(LAS u32x4*)(Xh + s * 72 + cq) = *(const u32x4*)xp; *(LAS u32x4*)(Xh + s * 72 + cq + 8) = *(const u32x4*)(xp + 8); }
                    { const bf16_t* hp = SSTATE + ((size_t)((b * 32 + c) * 8 + h)) * 8192;
#pragma unroll
                      for (int k = 0; k < 2; ++k) { const int p = tid + 512 * k, row = p >> 4, c16 = p & 15; *(LAS u32x4*)(Hp + row * 136 + 8 * c16) = *(const u32x4*)(hp + row * 128 + 8 * c16); } }
                    LBAR();
                    f32x16 yd, yo;
#pragma unroll
                    for (int r = 0; r < 16; ++r) { yd[r] = 0.f; yo[r] = 0.f; }
#pragma unroll
                    for (int ks = 0; ks < 8; ++ks) { yd = __builtin_amdgcn_mfma_f32_32x32x16_bf16(NATF(Wt, 136, ks, mt), TRF(Xh, 72, ks, nt2), yd, 0, 0, 0);
                        yo = __builtin_amdgcn_mfma_f32_32x32x16_bf16(NATF(Cm, 136, ks, mt), NATF(Hp, 136, ks, nt2), yo, 0, 0, 0); }
                    { const LAS float* cl = CUM + hq * 128 + 32 * mt + 4 * hh;
#pragma unroll
                      for (int r = 0; r < 16; ++r) yt[hq][r] = yd[r] + __expf(cl[crc(r)]) * yo[r]; }
                    LBAR();
                }
                { LAS bf16_t* yp = YL + (32 * mt + 4 * hh) * 264 + 32 * nt2 + r32;
#pragma unroll
                  for (int hq = 0; hq < 4; ++hq)
#pragma unroll
                      for (int r = 0; r < 16; ++r) yp[crc(r) * 264 + 64 * hq] = (bf16_t)f2bf(yt[hq][r]); }
                LBAR();
                for (int i = 0; i < 16; ++i) { const int l = wave * 16 + i; const size_t m = (size_t)(m0 + l); const int ch = 256 * g + 4 * lane;
                    const u32x2 yv = *(const LAS u32x2*)(YL + l * 264 + 4 * lane), xv = *(const u32x2*)(XBCC + m * 1024 + ch), zv = *(const u32x2*)(PROJ + m * NPROJ + 1792 + ch);
                    const float dsk = args.in[I_DSKIP][4 * g + (lane >> 4)];
                    float v[4] = {bflo(yv.x), bfhi(yv.x), bflo(yv.y), bfhi(yv.y)}; const float xs[4] = {bflo(xv.x), bfhi(xv.x), bflo(xv.y), bfhi(xv.y)}, zz[4] = {bflo(zv.x), bfhi(zv.x), bflo(zv.y), bfhi(zv.y)};
                    float q = 0.f;
#pragma unroll
                    for (int j = 0; j < 4; ++j) { v[j] = (v[j] + dsk * xs[j]) * siluf_(zz[j]); q += v[j] * v[j]; }
                    q = wave_sum(q); const float rq = __builtin_amdgcn_rsqf(q * (1.0f / 256.0f) + EPS); const f32x4 nw = *(const f32x4*)(args.in[I_SSDN] + ch);
                    u32x2 o; o.x = pk2(v[0] * rq * nw[0], v[1] * rq * nw[1]); o.y = pk2(v[2] * rq * nw[2], v[3] * rq * nw[3]); *(u32x2*)(MIX + m * DM + 512 + ch) = o; }
                LBAR();
            }
        }
        const float* mu = args.in[I_MU];
        for (int m = gw; m < MTOK; m += NGW) {
            const bool hasprev = (m & (SEQ - 1)) != 0; const int c0 = 8 * lane, h = lane >> 3;
            float y[8], v[8], p[8], go[8];
            unpack8(*(const u32x4*)(MIX + (size_t)m * DM + c0), y);
            unpack8(*(const u32x4*)((const bf16_t*)((const unsigned char*)dout + 48 * MiB) + (size_t)m * 512 + c0), p);
#pragma unroll
            for (int i = 0; i < 8; ++i) y[i] += p[i];
            const bf16_t* pc = PROJ + (size_t)m * NPROJ + c0;
            unpack8(*(const u32x4*)(pc + 1024), v);
            if (hasprev) {
                unpack8(*(const u32x4*)(pc - NPROJ + 1024), p);
#pragma unroll
                for (int i = 0; i < 8; ++i) v[i] += (p[i] - v[i]) * mu[1024 + c0 + i];
            } else {
#pragma unroll
                for (int i = 0; i < 8; ++i) v[i] -= v[i] * mu[1024 + c0 + i];
            }
            unpack8(*(const u32x4*)(GOUT + (size_t)m * 512 + c0), go);
            float s1 = 0.f; const float bd = KKR[(size_t)m * 8 + h];
#pragma unroll
            for (int i = 0; i < 8; ++i) s1 += y[i];
            s1 += __shfl_xor(s1, 1); s1 += __shfl_xor(s1, 2); s1 += __shfl_xor(s1, 4);
            const float mean = s1 * (1.0f / 64.0f); float s2 = 0.f;
#pragma unroll
            for (int i = 0; i < 8; ++i) { const float d = y[i] - mean; s2 += d * d; }
            s2 += __shfl_xor(s2, 1); s2 += __shfl_xor(s2, 2); s2 += __shfl_xor(s2, 4);
            const float rs = __builtin_amdgcn_rsqf(s2 * (1.0f / 64.0f) + 64e-5f);
            float o[8];
#pragma unroll
            for (int i = 0; i < 8; ++i) o[i] = ((y[i] - mean) * rs * args.in[I_GNW][c0 + i] + args.in[I_GNB][c0 + i] + bd * v[i]) * go[i];
            *(u32x4*)(MIX + (size_t)m * DM + c0) = pack8(o);
        }
    }
    SEAM(5);


    PHASE(6) { REPBAR
        pg8::Gemm g{MIX, WOUT, MTOK, DM, DM}; pg8::StaticOrder S; S.init(MTOK, DM, G, bx);
        pg8::EpiRes E{args.in[I_X], dout, XNB, args.in[I_NORM_FFN0], nullptr, SS};
        pg8::gemm_phase(lds, g, S, E);
    }
    SEAM(6);
    PHASE(7) { REPBAR
        pg8::Gemm g{XNB, WGU, MTOK, 2 * FFN, DM}; pg8::StaticOrder S; S.init(MTOK, 2 * FFN, G, bx);
        pg8::EpiSwiglu E{HID, FFN, SS, nullptr};
        pg8::gemm_phase(lds, g, S, E);
    }
    SEAM(7);
    PHASE(8) { REPBAR
        pg8::Gemm g{HID, WDN, MTOK, DM, FFN}; pg8::StaticOrder S; S.init(MTOK, DM, G, bx);
        pg8::EpiRes E{dout, dout, XNB, args.in[I_NORM_MIX1], nullptr, SS};
        pg8::gemm_phase(lds, g, S, E);
    }
    SEAM(8);
    PHASE(9) { REPBAR
        pg8::Gemm g{XNB, WQKV, MTOK, 1536, DM}; pg8::StaticOrder S; S.init(MTOK, 1536, G, bx);
        pg8::EpiQkv E{QKV, SS, args.in[I_BQKV], args.in[I_QN], args.in[I_KN], ROPE};
        pg8::gemm_phase(lds, g, S, E);
    }
    SEAM(9);

    PHASE(10) { REPBAR
        LAS bf16_t* Kt = (LAS bf16_t*)lds; LAS bf16_t* Vt = (LAS bf16_t*)(lds + 36864);
        const int r32 = lane & 31, hh = lane >> 5;
        for (int unit = vcu; unit < BATCH * 4 * 32; unit += G) {
            const int blk = unit & 31, kvh = (unit >> 5) & 3, b = unit >> 7;
            {
                const int rowi = tid >> 1, half = tid & 1; const int tpos = (blk - 1) * 128 + rowi;
#pragma unroll
                for (int q = 0; q < 4; ++q) { u32x4 kv = (u32x4){0, 0, 0, 0}, vv = kv;
                    if (tpos >= 0) { const bf16_t* p = QKV + (size_t)(b * SEQ + tpos) * 1536 + 1024 + kvh * 64 + half * 32 + 8 * q; kv = *(const u32x4*)p; vv = *(const u32x4*)(p + 256); }
                    *(LAS u32x4*)(Kt + rowi * 72 + half * 32 + 8 * q) = kv; *(LAS u32x4*)(Vt + rowi * 72 + half * 32 + 8 * q) = vv; }
            }
            __syncthreads();
            const int gq = wave >> 1, qh = kvh * 4 + gq; const float sink = args.in[I_SINK][qh];
            for (int it = 0; it < 2; ++it) {
                const int qi = (wave & 1) * 64 + it * 32 + r32; const size_t mq = (size_t)b * SEQ + blk * 128 + qi;
                bf16x8 qr[4];
#pragma unroll
                for (int s = 0; s < 4; ++s) qr[s] = *(const bf16x8*)(QKV + mq * 1536 + qh * 64 + 16 * s + 8 * hh);
                const int a0 = (wave & 1) * 2 + it;
                f32x16 sc[5];
#pragma unroll
                for (int j = 0; j < 5; ++j) {
#pragma unroll
                    for (int r = 0; r < 16; ++r) sc[j][r] = 0.f;
#pragma unroll
                    for (int s = 0; s < 4; ++s) { const bf16x8 kf = *(const LAS bf16x8*)(Kt + (32 * (a0 + j) + r32) * 72 + 16 * s + 8 * hh); sc[j] = __builtin_amdgcn_mfma_f32_32x32x16_bf16(kf, qr[s], sc[j], 0, 0, 0); }
                }
                float mx = sink;
#pragma unroll
                for (int j = 0; j < 5; ++j)
#pragma unroll
                    for (int r = 0; r < 16; ++r) { const int kj = 32 * (a0 + j) + crow(r, hh); const bool valid = (kj > qi) && (kj <= qi + 128) && (blk > 0 || kj >= 128);
                        const float x = valid ? sc[j][r] * 0.125f : -1e30f; sc[j][r] = x; mx = fmaxf(mx, x); }
                mx = fmaxf(mx, __shfl_xor(mx, 32));
                float l = 0.f;
#pragma unroll
                for (int j = 0; j < 5; ++j)
#pragma unroll
                    for (int r = 0; r < 16; ++r) { const float p = __expf(sc[j][r] - mx); sc[j][r] = p; l += p; }
                l += __shfl_xor(l, 32); l += __expf(sink - mx);
                const float inv = 1.0f / l;
                f32x16 o[2];
#pragma unroll
                for (int dt = 0; dt < 2; ++dt)
#pragma unroll
                    for (int r = 0; r < 16; ++r) o[dt][r] = 0.f;
#pragma unroll
                for (int j = 0; j < 5; ++j)
#pragma unroll
                    for (int s2 = 0; s2 < 2; ++s2) {
                        u32x4 pw; pw.x = pk2(sc[j][8 * s2 + 0], sc[j][8 * s2 + 1]); pw.y = pk2(sc[j][8 * s2 + 2], sc[j][8 * s2 + 3]); pw.z = pk2(sc[j][8 * s2 + 4], sc[j][8 * s2 + 5]); pw.w = pk2(sc[j][8 * s2 + 6], sc[j][8 * s2 + 7]);
                        const bf16x8 pf = __builtin_bit_cast(bf16x8, pw);
                        const int key0 = 32 * (a0 + j) + 16 * s2 + 4 * hh + ((lane & 15) >> 2);
#pragma unroll
                        for (int dt = 0; dt < 2; ++dt) {
                            const LAS bf16_t* vp = Vt + key0 * 72 + 32 * dt + 16 * ((lane >> 4) & 1) + 4 * (lane & 3);
                            const s16x4 lo = __builtin_bit_cast(s16x4, __builtin_amdgcn_ds_read_tr16_b64_v4i16((LAS s16x4*)vp));
                            const s16x4 hi = __builtin_bit_cast(s16x4, __builtin_amdgcn_ds_read_tr16_b64_v4i16((LAS s16x4*)(vp + 8 * 72)));
                            const bf16x8 vf = (bf16x8){lo[0], lo[1], lo[2], lo[3], hi[0], hi[1], hi[2], hi[3]};
                            o[dt] = __builtin_amdgcn_mfma_f32_32x32x16_bf16(vf, pf, o[dt], 0, 0, 0);
                        }
                    }
                bf16_t* op = ATTO + mq * DM + qh * 64;
#pragma unroll
                for (int dt = 0; dt < 2; ++dt)
#pragma unroll
                    for (int rq = 0; rq < 4; ++rq) { u32x2 w; w.x = pk2(o[dt][4 * rq] * inv, o[dt][4 * rq + 1] * inv); w.y = pk2(o[dt][4 * rq + 2] * inv, o[dt][4 * rq + 3] * inv);
                        *(u32x2*)(op + 32 * dt + 8 * rq + 4 * hh) = w; }
            }
            __syncthreads();
        }
    }
    SEAM(10);

    PHASE(11) { REPBAR
        pg8::Gemm g{ATTO, WO, MTOK, DM, DM}; pg8::StaticOrder S; S.init(MTOK, DM, G, bx);
        pg8::EpiRes E{dout, dout, XNB, args.in[I_NORM_FFN1], args.in[I_BO], SS};
        pg8::gemm_phase(lds, g, S, E);
    }
    SEAM(11);

    PHASE(12) { REPBAR
        {
            LAS float* scr = (LAS float*)(lds + wave * 16384);
            for (int it0 = gw; ; it0 += NGW) {
                int it = it0; bool done = false;
                for (int e = 0; e < NEXP && !done; ++e) {
                    if (transpose_matrix(it, args.in[I_EG] + (size_t)e * DM * FE, FE, DM, FE, EGU + (size_t)e * 2 * FE * DM, 1, scr, lane)) { done = true; break; }
                    if (transpose_matrix(it, args.in[I_EU] + (size_t)e * DM * FE, FE, DM, FE, EGU + (size_t)e * 2 * FE * DM, 2, scr, lane)) { done = true; break; }
                    if (transpose_matrix(it, args.in[I_ED] + (size_t)e * FE * DM, DM, FE, DM, EDN + (size_t)e * DM * FE, 0, scr, lane)) { done = true; break; }
                }
                if (!done) break;
            }
            __syncthreads();
        }
        LAS float* w8 = (LAS float*)lds;
        for (int r = tid; r < DM; r += 512) { const float* p = args.in[I_ROUTER] + (size_t)r * 8; *(LAS f32x4*)(w8 + r * 8) = *(const f32x4*)p; *(LAS f32x4*)(w8 + r * 8 + 4) = *(const f32x4*)(p + 4); }
        __syncthreads();
        const float* gm = args.in[I_NORM_FFN1];
        for (int m = gw; m < MTOK; m += NGW) {
            const f32x4* xr = (const f32x4*)(dout + (size_t)m * DM) + lane;
            f32x4 v[4]; float s = 0.f;
#pragma unroll
            for (int j = 0; j < 4; ++j) { v[j] = xr[64 * j]; s += (v[j][0] * v[j][0] + v[j][1] * v[j][1]) + (v[j][2] * v[j][2] + v[j][3] * v[j][3]); }
            const float rstd = __builtin_amdgcn_rsqf(wave_sum(s) * (1.0f / DM) + EPS);
            float d[8];
#pragma unroll
            for (int k = 0; k < 8; ++k) d[k] = 0.f;
#pragma unroll
            for (int j = 0; j < 4; ++j) { const f32x4 g4 = ((const f32x4*)gm)[64 * j + lane]; const f32x4 y = v[j] * rstd * g4;
#pragma unroll
                for (int i = 0; i < 4; ++i) { const int c = 256 * j + 4 * lane + i; const f32x4 wa = *(const LAS f32x4*)(w8 + c * 8), wb = *(const LAS f32x4*)(w8 + c * 8 + 4);
                    d[0] += y[i] * wa[0]; d[1] += y[i] * wa[1]; d[2] += y[i] * wa[2]; d[3] += y[i] * wa[3]; d[4] += y[i] * wb[0]; d[5] += y[i] * wb[1]; d[6] += y[i] * wb[2]; d[7] += y[i] * wb[3]; } }
#pragma unroll
            for (int k = 0; k < 8; ++k) d[k] = wave_sum(d[k]);
            int e0 = 0; float v0 = d[0];
#pragma unroll
            for (int k = 1; k < 8; ++k) if (d[k] > v0) { v0 = d[k]; e0 = k; }
            int e1 = -1; float v1 = -3.0e38f;
#pragma unroll
            for (int k = 0; k < 8; ++k) if (k != e0 && d[k] > v1) { v1 = d[k]; e1 = k; }
            if (lane == 0) {
                const float w0 = 1.0f / (1.0f + __expf(v1 - v0));
                const unsigned r0 = atomicAdd(CNT + e0, 1u), r1 = atomicAdd(CNT + e1, 1u);
                TOPE[2 * m] = e0; TOPE[2 * m + 1] = e1; RANK[2 * m] = (int)r0; RANK[2 * m + 1] = (int)r1; TOPW[2 * m] = w0; TOPW[2 * m + 1] = 1.0f - w0; RSTD4[m] = rstd;
            }
        }
        __syncthreads();
    }
    SEAM(12);

    PHASE(13) { REPBAR
        int roff[NEXP]; { int t = 0;
#pragma unroll
            for (int e = 0; e < NEXP; ++e) { roff[e] = t; t += (int)((CNT[e] + 255u) >> 8) << 8; } }
        for (int j = gw; j < 2 * MTOK; j += NGW) {
            const int m = j >> 1, e = TOPE[j]; int ro = roff[0];
#pragma unroll
            for (int k = 1; k < NEXP; ++k) ro = (e == k) ? roff[k] : ro;
            const int pos = ro + RANK[j];
            const u32x4* src = (const u32x4*)(XNB + (size_t)m * DM) + lane; u32x4* dst = (u32x4*)(AS + (size_t)pos * DM) + lane;
            dst[0] = src[0]; dst[64] = src[64];
            if (lane == 0) { POS[j] = pos; RSTDS[pos] = RSTD4[m]; }
        }
    }
    SEAM(13);
    PHASE(14) { REPBAR
        pg8::Gemm g{AS, EGU, SROWS, 2 * FE, DM}; pg8::MoeOrder S; S.init(CNT, 2 * FE / 256, G, bx, (long)2 * FE * DM * 2);
        pg8::EpiSwiglu E{HS, FE, nullptr, RSTDS};
        pg8::gemm_phase(lds, g, S, E);
    }
    SEAM(14);
    PHASE(15) { REPBAR
        pg8::Gemm g{HS, EDN, SROWS, DM, FE}; pg8::MoeOrder S; S.init(CNT, DM / 256, G, bx, (long)DM * FE * 2);
        pg8::EpiBf16 E{AS, DM};
        pg8::gemm_phase(lds, g, S, E);
    }
    SEAM(15);
    PHASE(16) { REPBAR
        for (int m = gw; m < MTOK; m += NGW) {
            const int p0 = POS[2 * m], p1 = POS[2 * m + 1]; const float w0 = TOPW[2 * m], w1 = TOPW[2 * m + 1];
            const u32x4* y0 = (const u32x4*)(AS + (size_t)p0 * DM) + lane; const u32x4* y1 = (const u32x4*)(AS + (size_t)p1 * DM) + lane;
            f32x4* o = (f32x4*)(dout + (size_t)m * DM);
#pragma unroll
            for (int q = 0; q < 2; ++q) { float a[8], c[8]; unpack8(y0[64 * q], a); unpack8(y1[64 * q], c);
                f32x4 h0 = o[128 * q + 2 * lane], h1 = o[128 * q + 2 * lane + 1];
#pragma unroll
                for (int i = 0; i < 4; ++i) { h0[i] += w0 * a[i] + w1 * c[i]; h1[i] += w0 * a[4 + i] + w1 * c[4 + i]; }
                o[128 * q + 2 * lane] = h0; o[128 * q + 2 * lane + 1] = h1; }
        }
    }
#undef TRF
#undef NATF
#undef IN
#undef SEAM
#undef PHASE
#undef REPBAR
}

constexpr int NPHASE = 17;
extern "C" void kernel_launch(void* const* d_in, const int* in_sizes, int n_in, void* d_out, int out_size, void* d_ws, size_t ws_size, hipStream_t stream) {
    static int grid = 0;
    if (grid == 0) {
        if (n_in != 39 || out_size != MTOK * DM || ws_size < WS_END) { fprintf(stderr, "kernel_launch: unexpected shapes n_in %d out %d ws %zu\n", n_in, out_size, ws_size); grid = -1; return; }
        int dev = 0, cus = 0;
        if (hipGetDevice(&dev) != hipSuccess || hipDeviceGetAttribute(&cus, hipDeviceAttributeMultiprocessorCount, dev) != hipSuccess) { grid = -1; return; }
        if (hipFuncSetAttribute((const void*)fwd_kernel, hipFuncAttributeMaxDynamicSharedMemorySize, LDS_BYTES) != hipSuccess) { fprintf(stderr, "kernel_launch: hipFuncSetAttribute failed\n"); grid = -1; return; }
        int per_cu = 0; (void)hipOccupancyMaxActiveBlocksPerMultiprocessor(&per_cu, (const void*)fwd_kernel, 512, LDS_BYTES); (void)hipGetLastError();
        grid = 256; if (cus != 256 || per_cu < 1) fprintf(stderr, "kernel_launch: note: cus %d per_cu %d\n", cus, per_cu);
    }
    if (grid < 0) return;
    Args a{};
    a.in[0] = (const float*)d_in[0];
    for (int i = 2; i < 39; ++i) a.in[i - 1] = (const float*)d_in[i];
    a.pos = (const int*)d_in[1]; a.out = (float*)d_out; a.ws = (unsigned char*)d_ws;
    (void)hipMemsetAsync((char*)d_ws + WS_CTL, 0, CTL_ZERO_BYTES, stream);
#ifdef PROBE_PHASE
    constexpr int pp = PROBE_PHASE; constexpr bool before = (pp == 2 || pp == 3 || pp == 5 || pp == 6 || pp == 8 || pp == 11 || pp == 12);
#ifdef PROBE_VARIANT
    a.variant = PROBE_VARIANT;
#endif
    if (before) { a.ph_lo = pp; a.ph_hi = pp + 1; hipLaunchKernelGGL(fwd_kernel, dim3(grid), dim3(512), LDS_BYTES, stream, a); (void)hipMemsetAsync((char*)d_ws + WS_CTL, 0, CTL_ZERO_BYTES, stream); }
    a.variant = 0;
#endif
    a.ph_lo = 0; a.ph_hi = NPHASE;
    hipLaunchKernelGGL(fwd_kernel, dim3(grid), dim3(512), LDS_BYTES, stream, a);
#ifdef PROBE_PHASE
    if (!before) { (void)hipMemsetAsync((char*)d_ws + WS_CTL, 0, CW_CNT * 4, stream);
#ifdef PROBE_VARIANT
        a.variant = PROBE_VARIANT;
#endif
        a.ph_lo = pp; a.ph_hi = pp + 1; hipLaunchKernelGGL(fwd_kernel, dim3(grid), dim3(512), LDS_BYTES, stream, a); }
#endif
}
```

```cpp
#include <hip/hip_runtime.h>
#include <cstdio>
#include <cstdint>

#define LAS __attribute__((address_space(3)))
#define GAS __attribute__((address_space(1)))
typedef unsigned short bf16_t;
typedef short bf16x8 __attribute__((ext_vector_type(8)));
typedef float f32x4 __attribute__((ext_vector_type(4)));
typedef float f32x2 __attribute__((ext_vector_type(2)));
typedef float f32x16 __attribute__((ext_vector_type(16)));
typedef unsigned u32x4 __attribute__((ext_vector_type(4)));
typedef unsigned u32x2 __attribute__((ext_vector_type(2)));
typedef short s16x4 __attribute__((ext_vector_type(4)));

constexpr int BATCH = 4, SEQ = 4096, DM = 1024, MTOK = BATCH * SEQ;
constexpr int IN0 = 3336, NPROJ = 3328;
constexpr int FFN = 2816, FE = 1408, NEXP = 8;
constexpr int SROWS = 2 * MTOK + NEXP * 256;
constexpr float EPS = 1e-6f;

constexpr size_t MiB = 1u << 20;
constexpr size_t WS_CTL = 0, CTL_ZERO_BYTES = 64 * 1024;
constexpr size_t WS_DTSP = 1 * MiB;
constexpr size_t WS_KKR = 1 * MiB + 512 * 1024;
constexpr size_t WS_ROPE = 2 * MiB;
constexpr size_t WS_SS = 3 * MiB;
constexpr size_t WS_TOPE = 4 * MiB;
constexpr size_t WS_RANK = 4 * MiB + 128 * 1024;
constexpr size_t WS_TOPW = 4 * MiB + 256 * 1024;
constexpr size_t WS_POS = 4 * MiB + 384 * 1024;
constexpr size_t WS_RSTD4 = 4 * MiB + 512 * 1024;
constexpr size_t WS_RSTDS = 4 * MiB + 640 * 1024;
constexpr size_t WS_WDEC = 5 * MiB;
constexpr size_t WS_WICL = 5 * MiB + 64 * 1024;
constexpr size_t WS_WGAT = 5 * MiB + 128 * 1024;
constexpr size_t WS_EGU = 6 * MiB;
constexpr size_t WS_EDN = 50 * MiB;
constexpr size_t WS_WIN = 72 * MiB;
constexpr size_t WS_WOUT = WS_WIN + (size_t)NPROJ * DM * 2;
constexpr size_t WS_WGU = WS_WOUT + 2 * MiB;
constexpr size_t WS_WDN = WS_WGU + 11 * MiB;
constexpr size_t WS_WQKV = WS_WDN + (size_t)DM * FFN * 2;
constexpr size_t WS_WO = WS_WQKV + 3 * MiB;
constexpr size_t R0 = 102 * MiB;
static_assert(WS_WO + 2 * MiB <= R0, "weights");
constexpr size_t WS_XN = R0, WS_MIX = R0;
constexpr size_t WS_PROJ = R0 + 32 * MiB;
constexpr size_t WS_GOUT = R0 + 136 * MiB;
constexpr size_t WS_XNB = R0 + 104 * MiB;
constexpr size_t WS_HID = R0;
constexpr size_t WS_QKV = R0;
constexpr size_t WS_ATTO = R0 + 48 * MiB;
constexpr size_t WS_AS = 72 * MiB;
constexpr size_t WS_HS = 140 * MiB;
constexpr size_t WS_END = 254 * MiB;
static_assert(WS_AS + (size_t)SROWS * DM * 2 <= WS_HS && WS_HS + (size_t)SROWS * FE * 2 <= WS_END && WS_GOUT + 16 * MiB <= WS_END, "map");
constexpr size_t DO_XBCC = 0, DO_DECAY = 32 * MiB, DO_ICLR = 48 * MiB;
constexpr int CW_BAR = 4096, CW_CNT = 8192;

constexpr int LDS_BYTES = 147456, RING_BYTES = 131072, MISC_OFF = LDS_BYTES - 128;

__device__ __forceinline__ unsigned f2bf(float f) { unsigned u = __builtin_bit_cast(unsigned, f); return (u + 0x7fffu + ((u >> 16) & 1u)) >> 16; }
typedef __bf16 bf16x2_t __attribute__((ext_vector_type(2)));
__device__ __forceinline__ unsigned pk2(float lo, float hi) { const f32x2 v = {lo, hi}; const bf16x2_t b = __builtin_convertvector(v, bf16x2_t); return __builtin_bit_cast(unsigned, b); }
__device__ __forceinline__ float bflo(unsigned u) { return __builtin_bit_cast(float, u << 16); }
__device__ __forceinline__ float bfhi(unsigned u) { return __builtin_bit_cast(float, u & 0xffff0000u); }
__device__ __forceinline__ void unpack8(const u32x4 v, float* f) { f[0] = bflo(v.x); f[1] = bfhi(v.x); f[2] = bflo(v.y); f[3] = bfhi(v.y); f[4] = bflo(v.z); f[5] = bfhi(v.z); f[6] = bflo(v.w); f[7] = bfhi(v.w); }
__device__ __forceinline__ u32x4 pack8(const float* f) { u32x4 v; v.x = pk2(f[0], f[1]); v.y = pk2(f[2], f[3]); v.z = pk2(f[4], f[5]); v.w = pk2(f[6], f[7]); return v; }
__device__ __forceinline__ float sigmoidf_(float x) { return __builtin_amdgcn_rcpf(1.0f + __expf(-x)); }
__device__ __forceinline__ float siluf_(float x) { return x * __builtin_amdgcn_rcpf(1.0f + __expf(-x)); }
#define LBAR() do { asm volatile("s_waitcnt lgkmcnt(0)" ::: "memory"); __builtin_amdgcn_s_barrier(); asm volatile("" ::: "memory"); } while (0)
__device__ __forceinline__ float wave_sum(float v) {
#pragma unroll
    for (int o = 1; o < 64; o <<= 1) v += __shfl_xor(v, o);
    return v;
}
__device__ __forceinline__ float dpp_sum63(float x) {
    int v;
    v = __builtin_amdgcn_update_dpp(0, __builtin_bit_cast(int, x), 0xB1, 0xF, 0xF, false); x += __builtin_bit_cast(float, v);
    v = __builtin_amdgcn_update_dpp(0, __builtin_bit_cast(int, x), 0x4E, 0xF, 0xF, false); x += __builtin_bit_cast(float, v);
    v = __builtin_amdgcn_update_dpp(0, __builtin_bit_cast(int, x), 0x141, 0xF, 0xF, false); x += __builtin_bit_cast(float, v);
    v = __builtin_amdgcn_update_dpp(0, __builtin_bit_cast(int, x), 0x140, 0xF, 0xF, false); x += __builtin_bit_cast(float, v);
    v = __builtin_amdgcn_update_dpp(0, __builtin_bit_cast(int, x), 0x142, 0xA, 0xF, false); x += __builtin_bit_cast(float, v);
    v = __builtin_amdgcn_update_dpp(0, __builtin_bit_cast(int, x), 0x143, 0xC, 0xF, false); x += __builtin_bit_cast(float, v);
    return __builtin_bit_cast(float, __builtin_amdgcn_readlane(__builtin_bit_cast(int, x), 63));
}
__device__ __forceinline__ int crow(int r, int hi) { return (r & 3) + 8 * (r >> 2) + 4 * hi; }
__device__ __forceinline__ constexpr int crc(int r) { return (r & 3) + 8 * (r >> 2); }

namespace pg8 {
constexpr int BM = 256, BK = 64, HALF = 128, HTB = HALF * BK * 2, NXCD = 8, WGM = 8;
__host__ __device__ __forceinline__ int lds_byte(int r, int c) { const int st = (r >> 4) * 2 + (c >> 5), rr = r & 15, cc = c & 31, ob = rr * 64 + cc * 2; return st * 1024 + (ob ^ (((ob >> 9) & 1) << 5)); }
__host__ __device__ __forceinline__ void stage_rc(int b, int& R, int& C) { const int st = b / 1024, sb = b % 1024, swz = sb ^ (((sb >> 9) & 1) << 5); R = (st >> 1) * 16 + swz / 64; C = (st & 1) * 32 + (swz % 64) / 2; }
__host__ __device__ __forceinline__ int perm32(int rho) { const int n = rho >> 4, i = rho & 15; return 8 * (i >> 2) + 4 * n + (i & 3); }
struct Unit { int pm, pn; long bofs; };
struct Gemm { const bf16_t* A; const bf16_t* Bt; int M, N, K; };
struct StaticOrder {
    int nM, nN, nwg, G, c;
    __device__ void init(int M, int N, int G_, int c_) { nM = M / BM; nN = N / BM; nwg = nM * nN; G = G_; c = c_; }
    __device__ bool next(int i, Unit& u) const {
        const long L = (long)i * G + c; if (L >= nwg) return false;
        int wgid = (int)L; { const int q = nwg / NXCD, r = nwg % NXCD, xcd = wgid % NXCD, off = wgid / NXCD; wgid = (xcd < r ? xcd * (q + 1) : r * (q + 1) + (xcd - r) * q) + off; }
        const int nig = WGM * nN, gid = wgid / nig, fm = gid * WGM, gsz = (nM - fm) < WGM ? (nM - fm) : WGM;
        u.pm = fm + ((wgid % nig) % gsz); u.pn = (wgid % nig) / gsz; u.bofs = 0; return true;
    }
};
struct MoeOrder {
    int toff[NEXP + 1]; int nN, G, c; long estride;
    __device__ void init(const unsigned* cnt, int nN_, int G_, int c_, long estride_) {
        nN = nN_; G = G_; c = c_; estride = estride_; int t = 0;
#pragma unroll
        for (int e = 0; e < NEXP; ++e) { toff[e] = t; t += (int)((cnt[e] + 255u) >> 8); }
        toff[NEXP] = t;
    }
    __device__ bool next(int i, Unit& u) const {
        const long L = (long)i * G + c; if (L >= (long)toff[NEXP] * nN) return false;
        const int pm = (int)(L / nN); u.pm = pm; u.pn = (int)(L % nN); int e = 0;
#pragma unroll
        for (int j = 1; j < NEXP; ++j) e += (pm >= toff[j]) ? 1 : 0;
        u.bofs = (long)e * estride; return true;
    }
};

template <class Epi, class Sched>
__device__ __forceinline__ void gemm_phase(LAS unsigned char* lds, const Gemm g, const Sched& S, const Epi& E) {
    constexpr bool ALIGN_EPI = true;
    const int tid = threadIdx.x, wid = __builtin_amdgcn_readfirstlane(tid >> 6), lane = tid & 63, wr = wid >> 2, wc = wid & 3, fr = lane & 15, fq = lane >> 4;
    const int K = g.K, nt = K / BK;
    unsigned voffA[2], voffB[2];
#pragma unroll
    for (int i = 0; i < 2; ++i) { int R, C; stage_rc(tid * 16 + i * 8192, R, C); const int Rb = Epi::PERM ? ((R & ~31) + perm32(R & 31)) : R;
        voffA[i] = (unsigned)(R * K + C) * 2u; voffB[i] = (unsigned)(Rb * K + C) * 2u; }
    const size_t kstep = (size_t)(BK * 2);
    const size_t hstep = (size_t)HALF * K * 2;
    const size_t tstep = 2 * hstep;
    const unsigned ldsw = (unsigned)wid * 1024u;
    const int aoff = lds_byte(wr * 64 + fr, fq * 8), boff = lds_byte(wc * 32 + fr, fq * 8);
#define PG8_SA(b, h) (((b) * 2 + (h)) * HTB)
#define PG8_SB(b, h) ((4 + (b) * 2 + (h)) * HTB)
#define PG8_STAGE(bufoff, gbase, voff) do { _Pragma("unroll") for (int _i = 0; _i < 2; ++_i) \
        __builtin_amdgcn_global_load_lds((const unsigned*)((const char*)(gbase) + (voff)[_i]), (LAS unsigned*)(lds + (bufoff) + ldsw + _i * 8192), 16, 0, 0); } while (0)
#define PG8_LDA(dst, b, h) do { _Pragma("unroll") for (int m = 0; m < 4; ++m) _Pragma("unroll") for (int k = 0; k < 2; ++k) dst[m][k] = *(const LAS bf16x8*)(lds + PG8_SA(b, h) + aoff + m * 2048 + k * 1024); } while (0)
#define PG8_LDB(dst, b, h) do { _Pragma("unroll") for (int n = 0; n < 2; ++n) _Pragma("unroll") for (int k = 0; k < 2; ++k) dst[n][k] = *(const LAS bf16x8*)(lds + PG8_SB(b, h) + boff + n * 2048 + k * 1024); } while (0)
#define PG8_MMA(ai, bj, At, Bt) do { __builtin_amdgcn_s_setprio(1); _Pragma("unroll") for (int m = 0; m < 4; ++m) _Pragma("unroll") for (int n = 0; n < 2; ++n) _Pragma("unroll") for (int k = 0; k < 2; ++k) \
        acc[ai][bj][m][n] = __builtin_amdgcn_mfma_f32_16x16x32_bf16(Bt[n][k], At[m][k], acc[ai][bj][m][n], 0, 0, 0); __builtin_amdgcn_s_setprio(0); } while (0)
#define PG8_WAIT_V(n) asm volatile("s_waitcnt vmcnt(" #n ")" ::: "memory")
#define PG8_WAIT_L(n) asm volatile("s_waitcnt lgkmcnt(" #n ")" ::: "memory")
#define PG8_BAR __builtin_amdgcn_s_barrier()
#define PG8_SCHED __builtin_amdgcn_sched_barrier(0)
    Unit cur, nxt; int ui = 0;
    if (!S.next(0, cur)) return;
    f32x4 acc[2][2][4][2];
#pragma unroll
    for (int a = 0; a < 2; ++a)
#pragma unroll
        for (int b = 0; b < 2; ++b)
#pragma unroll
            for (int m = 0; m < 4; ++m)
#pragma unroll
                for (int n = 0; n < 2; ++n) acc[a][b][m][n] = (f32x4){0.f, 0.f, 0.f, 0.f};
    bf16x8 At[4][2], B0[2][2], B1[2][2];
    const char* cA = (const char*)g.A + (size_t)cur.pm * tstep; const char* cB = (const char*)g.Bt + cur.bofs + (size_t)cur.pn * tstep;
    PG8_STAGE(PG8_SB(0, 0), cB, voffB); PG8_STAGE(PG8_SB(0, 1), cB + hstep, voffB); PG8_STAGE(PG8_SA(0, 0), cA, voffA); PG8_STAGE(PG8_SA(0, 1), cA + hstep, voffA);
    if (wr == 1) PG8_BAR;
    PG8_WAIT_V(2); PG8_BAR;
    PG8_STAGE(PG8_SB(1, 0), cB + kstep, voffB); PG8_STAGE(PG8_SA(1, 0), cA + kstep, voffA); PG8_STAGE(PG8_SB(1, 1), cB + hstep + kstep, voffB);
    PG8_WAIT_V(6); PG8_BAR;
    for (;;) {
        const bool has_next = S.next(ui + 1, nxt);
        const char* nA = has_next ? (const char*)g.A + (size_t)nxt.pm * tstep : cA; const char* nB = has_next ? (const char*)g.Bt + nxt.bofs + (size_t)nxt.pn * tstep : cB;
        for (int t = 0; t < nt; t += 2) {
            const bool last = (t == nt - 2);
            const char* a1 = cA + (size_t)(t + 1) * kstep;
            const char* a2 = last ? nA : cA + (size_t)(t + 2) * kstep; const char* b2 = last ? nB : cB + (size_t)(t + 2) * kstep;
            const char* a3 = a2 + kstep; const char* b3 = b2 + kstep;
            PG8_LDB(B0, 0, 0); PG8_LDB(B1, 0, 1); PG8_SCHED; PG8_LDA(At, 0, 0); PG8_STAGE(PG8_SA(1, 1), a1 + hstep, voffA);
            PG8_WAIT_V(8); PG8_WAIT_L(0); PG8_BAR; PG8_MMA(0, 0, At, B0); PG8_MMA(0, 1, At, B1); PG8_BAR; PG8_SCHED;
            PG8_LDA(At, 0, 1); PG8_STAGE(PG8_SB(0, 0), b2, voffB); PG8_STAGE(PG8_SB(0, 1), b2 + hstep, voffB); PG8_STAGE(PG8_SA(0, 0), a2, voffA);
            PG8_WAIT_V(8); PG8_WAIT_L(0); PG8_BAR; PG8_MMA(1, 0, At, B0); PG8_MMA(1, 1, At, B1); PG8_BAR; PG8_SCHED;
            PG8_LDB(B0, 1, 0); PG8_LDB(B1, 1, 1); PG8_SCHED; PG8_LDA(At, 1, 0); PG8_STAGE(PG8_SA(0, 1), a2 + hstep, voffA);
            PG8_WAIT_V(8); PG8_WAIT_L(0); PG8_BAR; PG8_MMA(0, 0, At, B0); PG8_MMA(0, 1, At, B1); PG8_BAR; PG8_SCHED;
            PG8_LDA(At, 1, 1); PG8_STAGE(PG8_SB(1, 0), b3, voffB); PG8_STAGE(PG8_SB(1, 1), b3 + hstep, voffB); PG8_STAGE(PG8_SA(1, 0), a3, voffA);
            PG8_WAIT_V(8); PG8_WAIT_L(0); PG8_BAR; PG8_MMA(1, 0, At, B0); PG8_MMA(1, 1, At, B1); PG8_BAR; PG8_SCHED;
        }
        if constexpr (ALIGN_EPI) { if (wr == 0) PG8_BAR; }
        E(acc, cur, wr, wc, fr, fq);
        if (!has_next) break;
#pragma unroll
        for (int a = 0; a < 2; ++a)
#pragma unroll
            for (int b = 0; b < 2; ++b)
#pragma unroll
                for (int m = 0; m < 4; ++m)
#pragma unroll
                    for (int n = 0; n < 2; ++n) acc[a][b][m][n] = (f32x4){0.f, 0.f, 0.f, 0.f};
        cur = nxt; cA = nA; cB = nB; ++ui;
        if constexpr (ALIGN_EPI) { if (wr == 1) PG8_BAR; }
    }
    PG8_WAIT_V(0);
    if constexpr (!ALIGN_EPI) { if (wr == 0) PG8_BAR; }
    PG8_BAR;
#undef PG8_SA
#undef PG8_SB
#undef PG8_STAGE
#undef PG8_LDA
#undef PG8_LDB
#undef PG8_MMA
#undef PG8_WAIT_V
#undef PG8_WAIT_L
#undef PG8_BAR
#undef PG8_SCHED
}

struct EpiBf16 {
    static constexpr bool PERM = true;
    bf16_t* O; int ldc;
    __device__ __forceinline__ void operator()(const f32x4 (&acc)[2][2][4][2], const Unit& u, int wr, int wc, int fr, int fq) const {
        const int row0 = u.pm * BM + wr * 64 + fr, col0 = u.pn * BM + wc * 32 + 8 * fq;
#pragma unroll
        for (int ai = 0; ai < 2; ++ai)
#pragma unroll
            for (int m = 0; m < 4; ++m) { bf16_t* rowp = O + (size_t)(row0 + ai * HALF + m * 16) * ldc + col0;
#pragma unroll
                for (int bj = 0; bj < 2; ++bj) { const f32x4 v0 = acc[ai][bj][m][0], v1 = acc[ai][bj][m][1];
                    u32x4 w; w.x = pk2(v0[0], v0[1]); w.y = pk2(v0[2], v0[3]); w.z = pk2(v1[0], v1[1]); w.w = pk2(v1[2], v1[3]);
                    *(u32x4*)(rowp + bj * HALF) = w; } }
    }
};
struct EpiRes {
    static constexpr bool PERM = false;
    const float* base; float* out; bf16_t* xn; const float* gw; const float* bias; float* ss;
    __device__ __forceinline__ void operator()(const f32x4 (&acc)[2][2][4][2], const Unit& u, int wr, int wc, int fr, int fq) const {
        const int col0 = u.pn * BM + wc * 32 + 4 * fq;
        f32x4 gv[2][2], bv[2][2];
#pragma unroll
        for (int bj = 0; bj < 2; ++bj)
#pragma unroll
            for (int n = 0; n < 2; ++n) { gv[bj][n] = *(const f32x4*)(gw + col0 + bj * HALF + n * 16); bv[bj][n] = bias ? *(const f32x4*)(bias + col0 + bj * HALF + n * 16) : (f32x4){0.f, 0.f, 0.f, 0.f}; }
#pragma unroll
        for (int ai = 0; ai < 2; ++ai)
#pragma unroll
            for (int m = 0; m < 4; ++m) { const int row = u.pm * BM + ai * HALF + wr * 64 + m * 16 + fr; const size_t off = (size_t)row * DM + col0; float s = 0.f;
#pragma unroll
                for (int bj = 0; bj < 2; ++bj)
#pragma unroll
                    for (int n = 0; n < 2; ++n) { const f32x4 bs = *(const f32x4*)(base + off + bj * HALF + n * 16); const f32x4 o = bs + acc[ai][bj][m][n] + bv[bj][n];
                        *(f32x4*)(out + off + bj * HALF + n * 16) = o; s += (o[0] * o[0] + o[1] * o[1]) + (o[2] * o[2] + o[3] * o[3]);
                        const f32x4 x = o * gv[bj][n]; u32x2 w; w.x = pk2(x[0], x[1]); w.y = pk2(x[2], x[3]); *(u32x2*)(xn + off + bj * HALF + n * 16) = w; }
                s += __shfl_xor(s, 16); s += __shfl_xor(s, 32);
                if (fq == 0) ss[(size_t)row * 16 + u.pn * 4 + wc] = s; }
    }
};
__device__ __forceinline__ float rstd_from_ss(const float* ss, int row) {
    const f32x4* p = (const f32x4*)(ss + (size_t)row * 16); const f32x4 a = p[0], b = p[1], c = p[2], d = p[3];
    const float t = ((a[0] + a[1]) + (a[2] + a[3])) + ((b[0] + b[1]) + (b[2] + b[3])) + ((c[0] + c[1]) + (c[2] + c[3])) + ((d[0] + d[1]) + (d[2] + d[3]));
    return __builtin_amdgcn_rsqf(t * (1.0f / DM) + EPS);
}
struct EpiSwiglu {
    static constexpr bool PERM = true;
    bf16_t* O; int ldc; const float* ss; const float* rstd;
    __device__ __forceinline__ void operator()(const f32x4 (&acc)[2][2][4][2], const Unit& u, int wr, int wc, int fr, int fq) const {
        const int row0 = u.pm * BM + wr * 64 + fr, col0 = u.pn * HALF + wc * 32 + 8 * fq;
#pragma unroll
        for (int ai = 0; ai < 2; ++ai)
#pragma unroll
            for (int m = 0; m < 4; ++m) { const int row = row0 + ai * HALF + m * 16; const float rs = ss ? rstd_from_ss(ss, row) : rstd[row];
                float h[8];
#pragma unroll
                for (int n = 0; n < 2; ++n)
#pragma unroll
                    for (int i = 0; i < 4; ++i) { const float gg = acc[ai][0][m][n][i] * rs, uu = acc[ai][1][m][n][i] * rs; h[n * 4 + i] = siluf_(gg) * uu; }
                *(u32x4*)(O + (size_t)row * ldc + col0) = pack8(h); }
    }
};
struct EpiQkv {
    static constexpr bool PERM = true;
    bf16_t* O; const float* ss; const float* bias; const float* qn; const float* kn; const float* rope;
    __device__ __forceinline__ void operator()(const f32x4 (&acc)[2][2][4][2], const Unit& u, int wr, int wc, int fr, int fq) const {
        const int hd = u.pn * 4 + wc, row0 = u.pm * BM + wr * 64 + fr; const int kind = u.pn < 4 ? 0 : (u.pn == 4 ? 1 : 2);
        const float* nw = kind == 0 ? qn : kn;
        float bv[2][8], nv[2][8];
#pragma unroll
        for (int bj = 0; bj < 2; ++bj)
#pragma unroll
            for (int j = 0; j < 8; ++j) { bv[bj][j] = bias[hd * 64 + bj * 32 + fq * 8 + j]; nv[bj][j] = nw[bj * 32 + fq * 8 + j]; }
#pragma unroll
        for (int ai = 0; ai < 2; ++ai)
#pragma unroll
            for (int m = 0; m < 4; ++m) { const int row = row0 + ai * HALF + m * 16; const float rs = rstd_from_ss(ss, row);
                float v[2][8]; float s = 0.f;
#pragma unroll
                for (int bj = 0; bj < 2; ++bj)
#pragma unroll
                    for (int n = 0; n < 2; ++n)
#pragma unroll
                        for (int i = 0; i < 4; ++i) { const float x = acc[ai][bj][m][n][i] * rs + bv[bj][n * 4 + i]; v[bj][n * 4 + i] = x; s += x * x; }
                if (kind < 2) {
                    s += __shfl_xor(s, 16); s += __shfl_xor(s, 32);
                    const float r2 = __builtin_amdgcn_rsqf(s * (1.0f / 64.0f) + EPS);
#pragma unroll
                    for (int bj = 0; bj < 2; ++bj)
#pragma unroll
                        for (int j = 0; j < 8; ++j) v[bj][j] = v[bj][j] * r2 * nv[bj][j];
                    const f32x4* rp = (const f32x4*)(rope + (size_t)row * 16);
                    const f32x4 c0 = rp[0], c1 = rp[1], s0 = rp[2], s1 = rp[3];
#pragma unroll
                    for (int j = 0; j < 8; ++j) { const float other = __shfl_xor(v[0][j], 16); const float cc = j < 4 ? c0[j] : c1[j - 4], sn = j < 4 ? s0[j] : s1[j - 4];
                        const float mine = v[0][j]; const float rot = (fq == 0) ? (mine * cc - other * sn) : (mine * cc + other * sn);
                        v[0][j] = (fq < 2) ? rot : mine; }
                }
#pragma unroll
                for (int bj = 0; bj < 2; ++bj) *(u32x4*)(O + (size_t)row * 1536 + hd * 64 + bj * 32 + fq * 8) = pack8(v[bj]);
            }
    }
};
}

#define XB_TMO      128
#define XB_XCNT(j)  (256  + 64 * (j))
#define XB_XSUB(j)  (1280 + 64 * (j))
#define XB_XGEN(j)  (2304 + 64 * (j))
#define XB_TOP      3328
#define XB_TOPGEN   3392
#define XCD_BAR_WORDS 3456
#define XB_SPIN_CAP (1u << 20)
__device__ __forceinline__ unsigned xb_ld(unsigned* p)              { return __hip_atomic_load(p, __ATOMIC_RELAXED, __HIP_MEMORY_SCOPE_AGENT); }
__device__ __forceinline__ unsigned xb_add(unsigned* p, unsigned v) { return __hip_atomic_fetch_add(p, v, __ATOMIC_RELAXED, __HIP_MEMORY_SCOPE_AGENT); }
__device__ __forceinline__ unsigned xb_xcc_id() { return (unsigned)__builtin_amdgcn_s_getreg((3 << 11) | 20) & 0xFu; }
#define XB_SPIN(cond, bar) do { unsigned _sp = 0; while (cond) { __builtin_amdgcn_s_sleep(1); \
    if ((++_sp & 255u) == 0u) { if (xb_ld(&(bar)[XB_TMO])) break; if (_sp > XB_SPIN_CAP) { atomicAdd(&(bar)[XB_TMO], 1u); break; } } } } while (0)
struct XcdBarrier { unsigned* bar; unsigned x; volatile LAS unsigned* st; };
__device__ __forceinline__ XcdBarrier xcd_barrier_post(unsigned* bar, volatile LAS unsigned* st) {
    XcdBarrier b; b.bar = bar; b.x = xb_xcc_id(); b.st = st;
    if (threadIdx.x == 0) (void)xb_add(&bar[XB_XCNT(b.x)], 1u);
    return b;
}
__device__ __forceinline__ void xcd_barrier_complete(unsigned* bar, unsigned x, unsigned& nloc, unsigned& nx) {
    const unsigned G = gridDim.x * gridDim.y * gridDim.z;
    unsigned sum, cnt, mine, sp = 0u;
    for (;;) {
        sum = 0u; cnt = 0u; mine = 0u;
#pragma unroll
        for (unsigned j = 0; j < 16; ++j) { const unsigned c = xb_ld(&bar[XB_XCNT(j)]); sum += c; cnt += (c > 0u) ? 1u : 0u; mine = (j == x) ? c : mine; }
        if (sum == G) break;
        __builtin_amdgcn_s_sleep(1);
        if ((++sp & 255u) == 0u) { if (xb_ld(&bar[XB_TMO])) break; if (sp > XB_SPIN_CAP) { atomicAdd(&bar[XB_TMO], 1u); break; } }
    }
    nloc = mine > 0u ? mine : 1u; nx = cnt > 0u ? cnt : 1u;
}
__device__ __forceinline__ void xcd_barrier(const XcdBarrier& b) {
    asm volatile("s_waitcnt vmcnt(0)" ::: "memory");
    __syncthreads();
    if (threadIdx.x == 0) {
        unsigned* bar = b.bar;
        __builtin_amdgcn_s_waitcnt(0);
        unsigned nloc = b.st[0], nx = b.st[1];
        if (nloc == 0u) { xcd_barrier_complete(bar, b.x, nloc, nx); b.st[0] = nloc; b.st[1] = nx; }
        const unsigned old = xb_add(&bar[XB_XSUB(b.x)], 1u);
        const unsigned gen = old / nloc;
        if (old + 1u == (gen + 1u) * nloc) {
            __builtin_amdgcn_fence(__ATOMIC_RELEASE, "agent");
            asm volatile("s_waitcnt vmcnt(0)" ::: "memory");
            const unsigned og = xb_add(&bar[XB_TOP], 1u);
            const unsigned tg = og / nx;
            if (og + 1u == (tg + 1u) * nx) xb_add(&bar[XB_TOPGEN], 1u);
            else XB_SPIN(xb_ld(&bar[XB_TOPGEN]) == tg, bar);
            __builtin_amdgcn_fence(__ATOMIC_ACQUIRE, "agent");
            xb_add(&bar[XB_XGEN(b.x)], 1u);
            asm volatile("s_waitcnt vmcnt(0)" ::: "memory");
        } else {
            XB_SPIN(xb_ld(&bar[XB_XGEN(b.x)]) == gen, bar);
            __builtin_amdgcn_fence(__ATOMIC_ACQUIRE, "agent");
            asm volatile("s_waitcnt vmcnt(0)" ::: "memory");
        }
    }
    __syncthreads();
}

struct Args { const float* in[39]; const int* pos; float* out; unsigned char* ws; int ph_lo, ph_hi, variant, pad; };
enum InIdx { I_X = 0, I_NORM_MIX0 = 1, I_W_IN, I_MU, I_W0, I_WDEC, I_A0, I_WICL, I_WGAT, I_KK, I_KA, I_RK, I_GNW, I_GNB, I_CONVW, I_CONVB, I_DTB, I_ALOG, I_DSKIP, I_SSDN,
             I_WOUT, I_NORM_FFN0, I_FG, I_FU, I_FD, I_NORM_MIX1, I_WQKV, I_BQKV, I_QN, I_KN, I_SINK, I_WO, I_BO, I_NORM_FFN1, I_ROUTER, I_EG, I_EU, I_ED };

__device__ __forceinline__ void transpose_item(const float* W, int ld, int K, int k0, int n0, bf16_t* WT, int drow, LAS float* scr, int lane) {
#pragma unroll 8
    for (int i = 0; i < 32; ++i) { const int kk = 2 * i + (lane >> 5); scr[kk * 33 + (lane & 31)] = W[(size_t)(k0 + kk) * ld + n0 + (lane & 31)]; }
    asm volatile("s_waitcnt lgkmcnt(0)" ::: "memory");
    const int c = lane & 7;
#pragma unroll
    for (int j = 0; j < 4; ++j) { const int n = (lane >> 3) + 8 * j; const LAS float* s = scr + (8 * c) * 33 + n;
        u32x4 o; o.x = pk2(s[0 * 33], s[1 * 33]); o.y = pk2(s[2 * 33], s[3 * 33]); o.z = pk2(s[4 * 33], s[5 * 33]); o.w = pk2(s[6 * 33], s[7 * 33]);
        *(u32x4*)(WT + (size_t)(drow + n) * K + k0 + 8 * c) = o; }
    asm volatile("s_waitcnt lgkmcnt(0)" ::: "memory");
}
__device__ __forceinline__ int drow_of(int kind, int n0) {
    if (kind == 0) return n0;
    if (kind == 1) return 256 * (n0 >> 7) + (n0 & 127);
    if (kind == 2) return 256 * (n0 >> 7) + 128 + (n0 & 127);
    const int hd = n0 >> 6, bj = (n0 >> 5) & 1; return 256 * (hd >> 2) + 128 * bj + 32 * (hd & 3);
}
__device__ __forceinline__ bool transpose_matrix(int& it, const float* W, int ld, int K, int ncols, bf16_t* WT, int kind, LAS float* scr, int lane) {
    const int nnb = ncols / 32, items = (K / 64) * nnb;
    if (it < items) { const int kb = it / nnb, nb = it % nnb; transpose_item(W, ld, K, 64 * kb, 32 * nb, WT, drow_of(kind, 32 * nb), scr, lane); return true; }
    it -= items; return false;
}

#ifndef DUPM
#define DUPM 0u
#endif

#define XN ((bf16_t*)(ws + WS_XN))
#define MIX ((bf16_t*)(ws + WS_MIX))
#define PROJ ((bf16_t*)(ws + WS_PROJ))
#define GOUT ((bf16_t*)(ws + WS_GOUT))
#define XNB ((bf16_t*)(ws + WS_XNB))
#define HID ((bf16_t*)(ws + WS_HID))
#define QKV ((bf16_t*)(ws + WS_QKV))
#define ATTO ((bf16_t*)(ws + WS_ATTO))
#define AS ((bf16_t*)(ws + WS_AS))
#define HS ((bf16_t*)(ws + WS_HS))
#define XBCC ((bf16_t*)(ws + WS_EGU))
#define SSTATE ((bf16_t*)(ws + 38 * MiB))
#define CHDEC ((float*)(ws + WS_TOPE))
#define DTSP ((float*)(ws + WS_DTSP))
#define KKR ((float*)(ws + WS_KKR))
#define ROPE ((float*)(ws + WS_ROPE))
#define SS ((float*)(ws + WS_SS))
#define TOPE ((int*)(ws + WS_TOPE))
#define RANK ((int*)(ws + WS_RANK))
#define TOPW ((float*)(ws + WS_TOPW))
#define POS ((int*)(ws + WS_POS))
#define RSTD4 ((float*)(ws + WS_RSTD4))
#define RSTDS ((float*)(ws + WS_RSTDS))
#define WDEC ((bf16_t*)(ws + WS_WDEC))
#define WICL ((bf16_t*)(ws + WS_WICL))
#define WGAT ((bf16_t*)(ws + WS_WGAT))
#define EGU ((bf16_t*)(ws + WS_EGU))
#define EDN ((bf16_t*)(ws + WS_EDN))
#define WIN ((bf16_t*)(ws + WS_WIN))
#define WOUT ((bf16_t*)(ws + WS_WOUT))
#define WGU ((bf16_t*)(ws + WS_WGU))
#define WDN ((bf16_t*)(ws + WS_WDN))
#define WQKV ((bf16_t*)(ws + WS_WQKV))
#define WO ((bf16_t*)(ws + WS_WO))
__global__ void __launch_bounds__(512, 2) fwd_kernel(Args args) {
    extern __shared__ __attribute__((aligned(16))) unsigned char lds_raw[];
    LAS unsigned char* lds = (LAS unsigned char*)lds_raw;
    volatile LAS unsigned* MISC = (volatile LAS unsigned*)(lds + MISC_OFF);
    const int tid = threadIdx.x, lane = tid & 63, wave = __builtin_amdgcn_readfirstlane(tid >> 6);
    const int G = gridDim.x, bx = blockIdx.x;
    const int vcu = (G % 8 == 0) ? (bx % 8) * (G / 8) + bx / 8 : bx;
    unsigned char* ws = args.ws;
    unsigned* ctl = (unsigned*)(ws + WS_CTL);
    float* dout = args.out;
    if (tid < 32) ((LAS unsigned*)(lds + MISC_OFF))[tid] = 0u;
    __syncthreads();
    XcdBarrier bar = xcd_barrier_post(ctl + CW_BAR, MISC + 8);
    const int lo = args.ph_lo, hi = args.ph_hi;
#define IN(k) (lo <= (k) && (k) < hi)
#if DUPM
#define PHASE(k) for (int rep_ = 0; rep_ <= (int)((DUPM >> (k)) & 1u); ++rep_) if (IN(k))
#define REPBAR if (rep_) xcd_barrier(bar);
#else
#define PHASE(k) if (IN(k))
#define REPBAR
#endif
#define SEAM(k) do { if (IN(k) && IN((k) + 1)) xcd_barrier(bar); } while (0)
    const int gw = vcu * 8 + wave, NGW = G * 8;

    unsigned* CNT = ctl + CW_CNT;

    PHASE(0) { REPBAR
        LAS float* scr = (LAS float*)(lds + wave * 16384);
        for (int it0 = gw; ; it0 += NGW) {
            int it = it0;
            if (transpose_matrix(it, args.in[I_W_IN], IN0, DM, NPROJ, WIN, 0, scr, lane)) continue;
            if (transpose_matrix(it, args.in[I_WDEC], 512, 64, 512, WDEC, 0, scr, lane)) continue;
            if (transpose_matrix(it, args.in[I_WICL], 512, 64, 512, WICL, 0, scr, lane)) continue;
            if (transpose_matrix(it, args.in[I_WGAT], 512, 128, 512, WGAT, 0, scr, lane)) continue;
            break;
        }
        __syncthreads();
        LAS float* w8 = (LAS float*)lds;
        for (int r = tid; r < DM; r += 512) { const float* p = args.in[I_W_IN] + (size_t)r * IN0 + NPROJ; *(LAS f32x4*)(w8 + r * 8) = *(const f32x4*)p; *(LAS f32x4*)(w8 + r * 8 + 4) = *(const f32x4*)(p + 4); }
        __syncthreads();
        const float* gm = args.in[I_NORM_MIX0];
        for (int m = gw; m < MTOK; m += NGW) {
            const f32x4* xr = (const f32x4*)(args.in[I_X] + (size_t)m * DM) + lane;
            f32x4 v[4]; float s = 0.f;
#pragma unroll
            for (int j = 0; j < 4; ++j) { v[j] = xr[64 * j]; s += (v[j][0] * v[j][0] + v[j][1] * v[j][1]) + (v[j][2] * v[j][2] + v[j][3] * v[j][3]); }
            const float rstd = __builtin_amdgcn_rsqf(wave_sum(s) * (1.0f / DM) + EPS);
            float d[8];
#pragma unroll
            for (int k = 0; k < 8; ++k) d[k] = 0.f;
            unsigned long long* o8 = (unsigned long long*)(XN + (size_t)m * DM) + lane;
#pragma unroll
            for (int j = 0; j < 4; ++j) { const f32x4 g4 = ((const f32x4*)gm)[64 * j + lane]; const f32x4 y = v[j] * rstd * g4;
                o8[64 * j] = (unsigned long long)pk2(y[0], y[1]) | ((unsigned long long)pk2(y[2], y[3]) << 32);
#pragma unroll
                for (int i = 0; i < 4; ++i) { const int c = 256 * j + 4 * lane + i; const f32x4 wa = *(const LAS f32x4*)(w8 + c * 8), wb = *(const LAS f32x4*)(w8 + c * 8 + 4);
                    d[0] += y[i] * wa[0]; d[1] += y[i] * wa[1]; d[2] += y[i] * wa[2]; d[3] += y[i] * wa[3]; d[4] += y[i] * wb[0]; d[5] += y[i] * wb[1]; d[6] += y[i] * wb[2]; d[7] += y[i] * wb[3]; } }
#pragma unroll
            for (int k = 0; k < 8; ++k) d[k] = wave_sum(d[k]);
            if (lane < 8) { float dv = d[0];
#pragma unroll
                for (int k = 1; k < 8; ++k) dv = (lane == k) ? d[k] : dv;
                const float z = dv + args.in[I_DTB][lane]; DTSP[(size_t)m * 8 + lane] = z > 20.f ? z : log1pf(__expf(z)); }
            if (lane >= 16 && lane < 24) { const int j = lane - 16; const double inv = exp(-(double)j * 0.125 * 13.122363377404328); const double ang = (double)args.pos[m] * inv;
                ROPE[(size_t)m * 16 + j] = (float)cos(ang); ROPE[(size_t)m * 16 + 8 + j] = (float)sin(ang); }
        }
        __syncthreads();
    }
    SEAM(0);

    PHASE(1) { REPBAR
        pg8::Gemm g{XN, WIN, MTOK, NPROJ, DM}; pg8::StaticOrder S; S.init(MTOK, NPROJ, G, bx);
        pg8::EpiBf16 E{PROJ, NPROJ};
        pg8::gemm_phase(lds, g, S, E);
    }
    SEAM(1);

    const int r32 = lane & 31, hh = lane >> 5, trq = (lane & 15) >> 2, trc = 16 * ((lane >> 4) & 1) + 4 * (lane & 3);
#define TRF(M, P, s, blk) ({ const LAS bf16_t* p_ = (M) + (16 * (s) + 8 * hh + trq) * (P) + 32 * (blk) + trc; \
        const s16x4 lo_ = __builtin_bit_cast(s16x4, __builtin_amdgcn_ds_read_tr16_b64_v4i16((LAS s16x4*)p_)); \
        const s16x4 hi_ = __builtin_bit_cast(s16x4, __builtin_amdgcn_ds_read_tr16_b64_v4i16((LAS s16x4*)(p_ + 4 * (P)))); \
        (bf16x8){lo_[0], lo_[1], lo_[2], lo_[3], hi_[0], hi_[1], hi_[2], hi_[3]}; })
#define NATF(M, P, s, blk) (*(const LAS bf16x8*)((M) + (32 * (blk) + r32) * (P) + 16 * (s) + 8 * hh))
    PHASE(2) { REPBAR
        const float* mu = args.in[I_MU];
        LAS bf16_t* Aw = (LAS bf16_t*)lds; LAS bf16_t* Aa = (LAS bf16_t*)(lds + 9216); LAS bf16_t* Ag = (LAS bf16_t*)(lds + 18432);
        LAS float* LW = (LAS float*)(lds + 35840); LAS float* IC = LW + 4096;
        LAS bf16_t* At = (LAS bf16_t*)(lds + 68864); LAS bf16_t* Kt = At + 4608; LAS bf16_t* Bt = Kt + 4608; LAS bf16_t* Rt = Bt + 4608; LAS bf16_t* Vt = Rt + 4608;
        LAS bf16_t* Lab = (LAS bf16_t*)(lds + 35840);
        LAS bf16_t* XX = At;
        LAS bf16_t* Lak = (LAS bf16_t*)(lds + 114944); LAS bf16_t* Mrk = Lak + 4608; LAS bf16_t* Mrb = Mrk + 4608;
        LAS float* TOT = (LAS float*)(lds + 142592); LAS float* GAMC = TOT + 512;
        const int mt = (wave >> 1) & 1, nt = wave & 1, grp = wave >> 2;
        for (int unit = vcu; unit < MTOK / 64; unit += G) {
            const int m0 = unit * 64;
            {
                const int tt = tid >> 3, cg = tid & 7, m = m0 + tt; const bool hasprev = (m & (SEQ - 1)) != 0;
                const bf16_t* pc = PROJ + (size_t)m * NPROJ + 1536 + 32 * cg;
#pragma unroll 1
                for (int q = 0; q < 4; ++q) {
                    float c[8], p[8]; unpack8(*(const u32x4*)(pc + 8 * q), c);
                    if (hasprev) unpack8(*(const u32x4*)(pc - NPROJ + 8 * q), p); else { for (int i = 0; i < 8; ++i) p[i] = 0.f; }
                    float o[8];
#pragma unroll
                    for (int i = 0; i < 8; ++i) { const int col = 32 * cg + 8 * q + i; const float x = c[i] + (p[i] - c[i]) * mu[1536 + col];
                        o[i] = cg < 2 ? tanhf(x) : (cg < 4 ? x : sigmoidf_(x)); }
                    const u32x4 w = pack8(o); const int col0 = 32 * cg + 8 * q;
                    if (cg < 2) *(LAS u32x4*)(Aw + tt * 72 + col0) = w; else if (cg < 4) *(LAS u32x4*)(Aa + tt * 72 + (col0 - 64)) = w; else *(LAS u32x4*)(Ag + tt * 136 + (col0 - 128)) = w;
                }
            }
            LBAR();
#pragma unroll 1
            for (int h = 0; h < 8; ++h) {
                unsigned char* cs = (unsigned char*)dout + (size_t)(unit * 8 + h) * 24576;
                float r0v[8], k0v[8], v0v[8]; float pr = 0.f, pk = 0.f, pv = 0.f;
                {   const bf16_t* pp = PROJ + (size_t)(m0 + 8 * wave) * NPROJ + 64 * h + lane;
                    if (((m0 + 8 * wave) & (SEQ - 1)) != 0) { pr = bflo(pp[-NPROJ]); pk = bflo(pp[-NPROJ + 512]); pv = bflo(pp[-NPROJ + 1024]); }
#pragma unroll
                    for (int i = 0; i < 8; ++i) { r0v[i] = bflo(pp[(size_t)i * NPROJ]); k0v[i] = bflo(pp[(size_t)i * NPROJ + 512]); v0v[i] = bflo(pp[(size_t)i * NPROJ + 1024]); } }
                if (grp == 0) {
                    f32x16 ad, ai;
#pragma unroll
                    for (int r = 0; r < 16; ++r) { ad[r] = 0.f; ai[r] = 0.f; }
#pragma unroll
                    for (int s = 0; s < 4; ++s) {
                        const bf16x8 bd = *(const bf16x8*)(WDEC + (size_t)(64 * h + 32 * nt + r32) * 64 + 16 * s + 8 * hh), bi = *(const bf16x8*)(WICL + (size_t)(64 * h + 32 * nt + r32) * 64 + 16 * s + 8 * hh);
                        ad = __builtin_amdgcn_mfma_f32_32x32x16_bf16(NATF(Aw, 72, s, mt), bd, ad, 0, 0, 0);
                        ai = __builtin_amdgcn_mfma_f32_32x32x16_bf16(NATF(Aa, 72, s, mt), bi, ai, 0, 0, 0);
                    }
                    const int c = 32 * nt + r32; const float w0c = args.in[I_W0][64 * h + c], a0c = args.in[I_A0][64 * h + c];
                    LAS float* lwb = LW + (32 * mt + 4 * hh) * 64 + c;
#pragma unroll
                    for (int r = 0; r < 16; ++r) { lwb[crc(r) * 64] = -0.6065306597126334f * sigmoidf_(ad[r] + w0c); lwb[4096 + crc(r) * 64] = sigmoidf_(ai[r] + a0c); }
                } else {
                    f32x16 ag;
#pragma unroll
                    for (int r = 0; r < 16; ++r) ag[r] = 0.f;
#pragma unroll
                    for (int s = 0; s < 8; ++s) {
                        const bf16x8 bg = *(const bf16x8*)(WGAT + (size_t)(64 * h + 32 * nt + r32) * 128 + 16 * s + 8 * hh);
                        ag = __builtin_amdgcn_mfma_f32_32x32x16_bf16(NATF(Ag, 136, s, mt), bg, ag, 0, 0, 0);
                    }
                    bf16_t* gob = GOUT + (size_t)(m0 + 32 * mt + 4 * hh) * 512 + 64 * h + 32 * nt + r32;
#pragma unroll
                    for (int r = 0; r < 16; ++r) gob[crc(r) * 512] = (bf16_t)f2bf(ag[r]);
                }
                LBAR();
                {
                    const int c = lane, gc = 64 * h + c, t0 = 8 * wave;
                    const float mur = mu[gc], muk = mu[512 + gc], muv = mu[1024 + gc], kkc = args.in[I_KK][gc], kac = args.in[I_KA][gc], rkc = args.in[I_RK][gc];
                    float rr[8], kx[8], vv[8], an[8], bn[8], lw[8], cl[8]; float run = 0.f;
#pragma unroll
                    for (int i = 0; i < 8; ++i) {
                        const float r0 = r0v[i], k0 = k0v[i], v0 = v0v[i];
                        rr[i] = r0 + (pr - r0) * mur; const float kl = k0 + (pk - k0) * muk; vv[i] = v0 + (pv - v0) * muv; pr = r0; pk = k0; pv = v0;
                        const float ic = IC[(t0 + i) * 64 + c]; lw[i] = LW[(t0 + i) * 64 + c]; run += lw[i]; cl[i] = run;
                        const float xk = kl * kkc; const float ssq = dpp_sum63(xk * xk); const float kn = xk * __builtin_amdgcn_rsqf(ssq + 1e-12f);
                        an[i] = -kn; bn[i] = kn * ic; kx[i] = kl * (1.0f + (ic - 1.0f) * kac);
                        const float bon = dpp_sum63(rr[i] * kx[i] * rkc);
                        if (lane == 0) KKR[(size_t)(m0 + t0 + i) * 8 + h] = bon;
                    }
                    TOT[wave * 64 + c] = run;
                    LBAR();
                    float off = 0.f, totc = 0.f;
#pragma unroll
                    for (int w2 = 0; w2 < 8; ++w2) { const float tv = TOT[w2 * 64 + c]; totc += tv; off += (w2 < wave) ? tv : 0.f; }
                    if (wave == 0) GAMC[c] = __expf(totc);
#pragma unroll
                    for (int i = 0; i < 8; ++i) { const float cum = off + cl[i]; const float en = __expf(-cum), ep = __expf(cum), em = __expf(cum - lw[i]); const int o = (t0 + i) * 72 + c;
                        At[o] = (bf16_t)f2bf(an[i] * em); Kt[o] = (bf16_t)f2bf(kx[i] * en); Bt[o] = (bf16_t)f2bf(bn[i] * en); Rt[o] = (bf16_t)f2bf(rr[i] * ep); Vt[o] = (bf16_t)f2bf(vv[i]); }
                }
                LBAR();
                {
                    f32x16 pb, pk2_;
#pragma unroll
                    for (int r = 0; r < 16; ++r) { pb[r] = 0.f; pk2_[r] = 0.f; }
                    const LAS bf16_t* Aop = grp == 0 ? At : Rt;
#pragma unroll
                    for (int s = 0; s < 4; ++s) { const bf16x8 a = NATF(Aop, 72, s, mt);
                        pb = __builtin_amdgcn_mfma_f32_32x32x16_bf16(a, NATF(Bt, 72, s, nt), pb, 0, 0, 0);
                        pk2_ = __builtin_amdgcn_mfma_f32_32x32x16_bf16(a, NATF(Kt, 72, s, nt), pk2_, 0, 0, 0); }
                    const int sc = 32 * nt + r32, tb = 32 * mt + 4 * hh;
                    LAS bf16_t* o1 = (grp == 0 ? Lab : Mrb) + tb * 72 + sc; LAS bf16_t* o2 = (grp == 0 ? Lak : Mrk) + tb * 72 + sc;
#pragma unroll
                    for (int r = 0; r < 16; ++r) { const int t = tb + crc(r); const bool keep = grp == 0 ? (sc < t) : (sc <= t);
                        o1[crc(r) * 72] = (bf16_t)f2bf(keep ? pb[r] : 0.f); o2[crc(r) * 72] = (bf16_t)f2bf(keep ? pk2_[r] : 0.f); }
                }
                LBAR();
                f32x16 accA, accB;
#pragma unroll
                for (int r = 0; r < 16; ++r) { accA[r] = 0.f; accB[r] = 0.f; }
                {
                    const LAS bf16_t* Aop = grp == 0 ? Lak : Mrk;
#pragma unroll
                    for (int s = 0; s < 4; ++s) { const bf16x8 vb = TRF(Vt, 72, s, nt);
                        if (grp == 0) { accA = __builtin_amdgcn_mfma_f32_32x32x16_bf16(NATF(Aop, 72, s, mt), vb, accA, 0, 0, 0); accB = __builtin_amdgcn_mfma_f32_32x32x16_bf16(TRF(Kt, 72, s, mt), vb, accB, 0, 0, 0); }
                        else accB = __builtin_amdgcn_mfma_f32_32x32x16_bf16(NATF(Aop, 72, s, mt), vb, accB, 0, 0, 0); }
                    if (grp == 0) { LAS float* ggb = IC + (32 * mt + 4 * hh) * 65 + 32 * nt + r32;
#pragma unroll
                        for (int r = 0; r < 16; ++r) ggb[crc(r) * 65] = accA[r]; }
                }
                LBAR();
                {
                    const int n16 = lane & 15, g4 = lane >> 4;
                    f32x4 Rr[4];
                    if (wave < 4) {
#pragma unroll
                        for (int I = 0; I < 4; ++I)
#pragma unroll
                            for (int j = 0; j < 4; ++j) Rr[I][j] = bflo((unsigned)At[(16 * I + 4 * g4 + j) * 72 + 16 * wave + n16]);
                    } else { const LAS float* GG = IC;
#pragma unroll
                        for (int I = 0; I < 4; ++I)
#pragma unroll
                            for (int j = 0; j < 4; ++j) Rr[I][j] = GG[(16 * I + 4 * g4 + j) * 65 + 16 * (wave - 4) + n16];
                    }
                    LBAR();
                    const LAS bf16_t* lrow = Lab + n16 * 72 + 4 * g4;
#define LF(I, J) (*(const LAS u32x2*)(lrow + (16 * (I)) * 72 + 16 * (J)))
#define MF16(A0, A1, B0, B1, C) __builtin_amdgcn_mfma_f32_16x16x32_bf16(__builtin_bit_cast(bf16x8, (u32x4){(A0).x, (A0).y, (A1).x, (A1).y}), __builtin_bit_cast(bf16x8, (u32x4){(B0).x, (B0).y, (B1).x, (B1).y}), (C), 0, 0, 0)
                    const u32x2 zz = (u32x2){0u, 0u};
                    u32x2 Xb[4];
#pragma unroll
                    for (int I = 0; I < 4; ++I) {
                        f32x4 Z = Rr[I];
                        if (I == 1) Z = MF16(LF(1, 0), zz, Xb[0], zz, Z);
                        if (I == 2) Z = MF16(LF(2, 0), LF(2, 1), Xb[0], Xb[1], Z);
                        if (I == 3) { Z = MF16(LF(3, 0), LF(3, 1), Xb[0], Xb[1], Z); Z = MF16(LF(3, 2), zz, Xb[2], zz, Z); }
                        const u32x2 ld = LF(I, I);
                        f32x4 X = Z;
#pragma unroll
                        for (int it = 0; it < 15; ++it) { u32x2 xb; xb.x = pk2(X[0], X[1]); xb.y = pk2(X[2], X[3]); X = MF16(ld, zz, xb, zz, Z); }
                        Xb[I].x = pk2(X[0], X[1]); Xb[I].y = pk2(X[2], X[3]);
                        LAS bf16_t* xo = XX + (16 * I + 4 * g4) * 136 + 16 * wave + n16;
                        xo[0] = (bf16_t)(Xb[I].x & 0xffffu); xo[136] = (bf16_t)(Xb[I].x >> 16); xo[272] = (bf16_t)(Xb[I].y & 0xffffu); xo[408] = (bf16_t)(Xb[I].y >> 16);
                    }
#undef LF
#undef MF16
                }
                LBAR();
                {
                    f32x16 acc1;
#pragma unroll
                    for (int r = 0; r < 16; ++r) acc1[r] = 0.f;
#pragma unroll
                    for (int s = 0; s < 4; ++s) {
                        const bf16x8 a = grp == 0 ? TRF(Bt, 72, s, mt) : NATF(Mrb, 72, s, mt);
                        acc1 = __builtin_amdgcn_mfma_f32_32x32x16_bf16(a, TRF(XX, 136, s, nt), acc1, 0, 0, 0);
                        accB = __builtin_amdgcn_mfma_f32_32x32x16_bf16(a, TRF(XX + 64, 136, s, nt), accB, 0, 0, 0);
                    }
                    const int col = 32 * nt + r32, rb = 32 * mt + 4 * hh;
                    if (grp == 0) {
                        bf16_t* acb = (bf16_t*)cs + rb * 64 + col; bf16_t* dcb = (bf16_t*)(cs + 8192) + col * 64 + rb; const LAS float* gb = GAMC + rb;
#pragma unroll
                        for (int r = 0; r < 16; ++r) { const float gcv = gb[crc(r)]; acb[crc(r) * 64] = (bf16_t)f2bf(gcv * (acc1[r] + ((rb + crc(r)) == col ? 1.0f : 0.0f))); }
#pragma unroll
                        for (int rq = 0; rq < 4; ++rq) { const f32x4 g4 = *(const LAS f32x4*)(gb + 8 * rq);
                            u32x2 w; w.x = pk2(accB[4 * rq] * g4[0], accB[4 * rq + 1] * g4[1]); w.y = pk2(accB[4 * rq + 2] * g4[2], accB[4 * rq + 3] * g4[3]); *(u32x2*)(dcb + 8 * rq) = w; }
                    } else {
                        bf16_t* rpb = (bf16_t*)(cs + 16384) + rb * 64 + col; const LAS bf16_t* rtb = Rt + rb * 72 + col; bf16_t* yb = MIX + (size_t)(m0 + rb) * DM + 64 * h + col;
#pragma unroll
                        for (int r = 0; r < 16; ++r) { rpb[crc(r) * 64] = (bf16_t)f2bf(acc1[r] + bflo((unsigned)rtb[crc(r) * 72])); yb[crc(r) * DM] = (bf16_t)f2bf(accB[r]); }
                    }
                }
                LBAR();
            }
        }
        for (int unit = vcu; unit < MTOK / 64; unit += G) {
            const int m0 = unit * 64;
            {
                const int cgp = tid & 127, ts = tid >> 7, c0 = 8 * cgp; const float* cw = args.in[I_CONVW]; const float* cb = args.in[I_CONVB];
                float w[4][8], bb[8];
#pragma unroll
                for (int j = 0; j < 4; ++j)
#pragma unroll
                    for (int i = 0; i < 8; ++i) w[j][i] = cw[j * 1024 + c0 + i];
#pragma unroll
                for (int i = 0; i < 8; ++i) bb[i] = cb[c0 + i];
                float x0[8], x1[8], x2[8], x3[8];
                const int mstart = m0 + 16 * ts; const int tpos = mstart & (SEQ - 1);
                const bf16_t* srcp = PROJ + (size_t)mstart * NPROJ + 2304 + c0;
#pragma unroll
                for (int i = 0; i < 8; ++i) { x0[i] = 0.f; x1[i] = 0.f; x2[i] = 0.f; }
                if (tpos >= 3) unpack8(*(const u32x4*)(srcp - 3 * (size_t)NPROJ), x0);
                if (tpos >= 2) unpack8(*(const u32x4*)(srcp - 2 * (size_t)NPROJ), x1);
                if (tpos >= 1) unpack8(*(const u32x4*)(srcp - 1 * (size_t)NPROJ), x2);
                for (int t = 0; t < 16; ++t) {
                    unpack8(*(const u32x4*)(srcp + (size_t)t * NPROJ), x3);
                    float o[8];
#pragma unroll
                    for (int i = 0; i < 8; ++i) { const float y = bb[i] + w[0][i] * x0[i] + w[1][i] * x1[i] + w[2][i] * x2[i] + w[3][i] * x3[i]; o[i] = siluf_(y); x0[i] = x1[i]; x1[i] = x2[i]; x2[i] = x3[i]; }
                    *(u32x4*)(XBCC + (size_t)(mstart + t) * 1024 + c0) = pack8(o);
                }
            }
        }
    }

    SEAM(2);

    PHASE(3) { REPBAR
        if (vcu < 32) {
            const int b = vcu >> 3, h = vcu & 7;
            const unsigned char* cbase = (const unsigned char*)dout + (size_t)(b * 64 * 8 + h) * 24576;
            constexpr size_t CSTR = (size_t)8 * 24576; constexpr int SLOT = 27648;
            const bool loader = wave >= 2; const int lt = tid - 128;
            int poff[4];
#pragma unroll
            for (int k = 0; k < 4; ++k) { const int p = lt + 384 * k; poff[k] = (p >> 9) * 9216 + ((p & 511) >> 3) * 144 + (p & 7) * 16; }
            u32x4 st[4][4];
#define RB_ISSUE(set, ch) do { if (loader) { const unsigned char* g_ = cbase + (size_t)(ch) * CSTR + (size_t)lt * 16; _Pragma("unroll") for (int k = 0; k < 4; ++k) st[set][k] = *(const u32x4*)(g_ + k * 6144); } } while (0)
#define RB_WRITE(set, ch) do { if (loader) { LAS unsigned char* s_ = lds + ((ch) & 3) * SLOT; _Pragma("unroll") for (int k = 0; k < 4; ++k) *(LAS u32x4*)(s_ + poff[k]) = st[set][k]; } } while (0)
            RB_ISSUE(0, 0); RB_ISSUE(1, 1); RB_WRITE(0, 0); RB_WRITE(1, 1);
            RB_ISSUE(2, 2); RB_ISSUE(3, 3); RB_ISSUE(0, 4); RB_ISSUE(1, 5);
            LBAR();
            f32x16 H[2];
#pragma unroll
            for (int r = 0; r < 16; ++r) { H[0][r] = 0.f; H[1][r] = 0.f; }
            bf16_t* zp = (bf16_t*)((unsigned char*)dout + 48 * MiB) + (size_t)(b * SEQ + 4 * hh) * 512 + 64 * h + 32 * wave + r32;
#define RB_STEP(j, chv) do { const int ch_ = (chv); \
                if (loader) { if (ch_ + 2 < 64) RB_WRITE(((j) + 2) & 3, ch_ + 2); if (ch_ + 6 < 64) RB_ISSUE(((j) + 2) & 3, ch_ + 6); } \
                else { const LAS unsigned char* sl = lds + (ch_ & 3) * SLOT; f32x16 Hn[2], Z[2]; bf16x8 Hb[4]; \
                    _Pragma("unroll") for (int s = 0; s < 4; ++s) { const int m = s >> 1, o = 8 * (s & 1); u32x4 t; t.x = pk2(H[m][o], H[m][o + 1]); t.y = pk2(H[m][o + 2], H[m][o + 3]); t.z = pk2(H[m][o + 4], H[m][o + 5]); t.w = pk2(H[m][o + 6], H[m][o + 7]); Hb[s] = __builtin_bit_cast(bf16x8, t); } \
                    _Pragma("unroll") for (int m = 0; m < 2; ++m) { \
                        _Pragma("unroll") for (int rq = 0; rq < 4; ++rq) { const u32x2 d = *(const LAS u32x2*)(sl + 9216 + (32 * wave + r32) * 144 + (32 * m + 8 * rq + 4 * hh) * 2); \
                            Hn[m][4 * rq] = bflo(d.x); Hn[m][4 * rq + 1] = bfhi(d.x); Hn[m][4 * rq + 2] = bflo(d.y); Hn[m][4 * rq + 3] = bfhi(d.y); } \
                        _Pragma("unroll") for (int r = 0; r < 16; ++r) Z[m][r] = 0.f; } \
                    _Pragma("unroll") for (int s = 0; s < 4; ++s) \
                        _Pragma("unroll") for (int m = 0; m < 2; ++m) { const int o = (32 * m + r32) * 144 + (16 * s + 4 * hh) * 2; \
                            const u32x2 a0 = *(const LAS u32x2*)(sl + o), a1 = *(const LAS u32x2*)(sl + o + 16), q0 = *(const LAS u32x2*)(sl + 18432 + o), q1 = *(const LAS u32x2*)(sl + 18432 + o + 16); \
                            u32x4 t; t.x = a0.x; t.y = a0.y; t.z = a1.x; t.w = a1.y; Hn[m] = __builtin_amdgcn_mfma_f32_32x32x16_bf16(__builtin_bit_cast(bf16x8, t), Hb[s], Hn[m], 0, 0, 0); \
                            t.x = q0.x; t.y = q0.y; t.z = q1.x; t.w = q1.y; Z[m] = __builtin_amdgcn_mfma_f32_32x32x16_bf16(__builtin_bit_cast(bf16x8, t), Hb[s], Z[m], 0, 0, 0); } \
                    H[0] = Hn[0]; H[1] = Hn[1]; \
                    bf16_t* zq = zp + (size_t)ch_ * 64 * 512; \
                    _Pragma("unroll") for (int m = 0; m < 2; ++m) _Pragma("unroll") for (int r = 0; r < 16; ++r) zq[(32 * m + crc(r)) * 512] = (bf16_t)f2bf(Z[m][r]); } \
                LBAR(); } while (0)
            if (wave < 2 || loader) {
                for (int ch = 0; ch < 64; ch += 4) { RB_STEP(0, ch); RB_STEP(1, ch + 1); RB_STEP(2, ch + 2); RB_STEP(3, ch + 3); }
            }
#undef RB_STEP
#undef RB_ISSUE
#undef RB_WRITE
        } else {
            LAS bf16_t* Bm = (LAS bf16_t*)lds; LAS bf16_t* Xh = (LAS bf16_t*)(lds + 34816); LAS float* CUM = (LAS float*)(lds + 53248); LAS float* DTL = CUM + 512;
            for (int unit = vcu - 32; unit < 256; unit += G - 32) {
                const int g = unit & 1, c = (unit >> 1) & 31, b = unit >> 6, m0 = b * SEQ + c * 128;
#pragma unroll
                for (int k = 0; k < 4; ++k) { const int p = tid + 512 * k, row = p >> 4, c16 = p & 15; *(LAS u32x4*)(Bm + row * 136 + 8 * c16) = *(const u32x4*)(XBCC + (size_t)(m0 + row) * 1024 + 512 + 128 * g + 8 * c16); }
                if (wave < 4) { const int h = 4 * g + wave; const float a_h = -__expf(args.in[I_ALOG][h]);
                    const float v0 = DTSP[(size_t)(m0 + 2 * lane) * 8 + h], v1 = DTSP[(size_t)(m0 + 2 * lane + 1) * 8 + h]; float s = v0 + v1;
#pragma unroll
                    for (int o = 1; o < 64; o <<= 1) { const float t = __shfl_up(s, o); if (lane >= o) s += t; }
                    const float ex = s - (v0 + v1);
                    CUM[wave * 128 + 2 * lane] = a_h * (ex + v0); CUM[wave * 128 + 2 * lane + 1] = a_h * (ex + v0 + v1); DTL[wave * 128 + 2 * lane] = v0; DTL[wave * 128 + 2 * lane + 1] = v1; }
                LBAR();
#pragma unroll 1
                for (int hq = 0; hq < 4; ++hq) { const int h = 4 * g + hq;
                    { const int s = tid >> 2, cq = 16 * (tid & 3); const float sc = DTL[hq * 128 + s] * __expf(CUM[hq * 128 + 127] - CUM[hq * 128 + s]);
                      const bf16_t* xp = XBCC + (size_t)(m0 + s) * 1024 + 64 * h + cq;
#pragma unroll
                      for (int q = 0; q < 2; ++q) { float f[8]; unpack8(*(const u32x4*)(xp + 8 * q), f);
#pragma unroll
                          for (int i = 0; i < 8; ++i) f[i] *= sc;
                          *(LAS u32x4*)(Xh + s * 72 + cq + 8 * q) = pack8(f); } }
                    LBAR();
                    const int mt = wave >> 2, nt = wave & 3; f32x16 acc;
#pragma unroll
                    for (int r = 0; r < 16; ++r) acc[r] = 0.f;
#pragma unroll
                    for (int ks = 0; ks < 8; ++ks) acc = __builtin_amdgcn_mfma_f32_32x32x16_bf16(TRF(Xh, 72, ks, mt), TRF(Bm, 136, ks, nt), acc, 0, 0, 0);
                    bf16_t* sp = SSTATE + ((size_t)((b * 32 + c) * 8 + h)) * 8192 + (32 * mt + 4 * hh) * 128 + 32 * nt + r32;
#pragma unroll
                    for (int r = 0; r < 16; ++r) sp[crc(r) * 128] = (bf16_t)f2bf(acc[r]);
                    if (tid == 0) CHDEC[(b * 32 + c) * 8 + h] = __expf(CUM[hq * 128 + 127]);
                    LBAR();
                }
            }
            {
                LAS float* scr = (LAS float*)(lds + wave * 16384);
                for (int it0 = (vcu - 32) * 8 + wave; ; it0 += (G - 32) * 8) {
                    int it = it0;
                    if (transpose_matrix(it, args.in[I_WOUT], DM, DM, DM, WOUT, 0, scr, lane)) continue;
                    if (transpose_matrix(it, args.in[I_FG], FFN, DM, FFN, WGU, 1, scr, lane)) continue;
                    if (transpose_matrix(it, args.in[I_FU], FFN, DM, FFN, WGU, 2, scr, lane)) continue;
                    if (transpose_matrix(it, args.in[I_FD], DM, FFN, DM, WDN, 0, scr, lane)) continue;
                    if (transpose_matrix(it, args.in[I_WQKV], 1536, DM, 1536, WQKV, 3, scr, lane)) continue;
                    if (transpose_matrix(it, args.in[I_WO], DM, DM, DM, WO, 0, scr, lane)) continue;
                    break;
                }
            }
        }
    }

    SEAM(3);

    PHASE(4) { REPBAR
        const int gt = vcu * 512 + tid, bh = gt >> 12, e2 = gt & 4095, b = bh >> 3, h = bh & 7;
        unsigned* sp = (unsigned*)SSTATE + ((size_t)(b * 32 * 8 + h)) * 4096 + e2;
        unsigned vals[32];
#pragma unroll
        for (int c = 0; c < 32; ++c) vals[c] = sp[(size_t)c * 8 * 4096];
        float r0 = 0.f, r1 = 0.f;
#pragma unroll
        for (int c = 0; c < 32; ++c) { const float dec = CHDEC[(b * 32 + c) * 8 + h]; sp[(size_t)c * 8 * 4096] = pk2(r0, r1); r0 = r0 * dec + bflo(vals[c]); r1 = r1 * dec + bfhi(vals[c]); }
    }
    SEAM(4);

    PHASE(5) { REPBAR
        {
            LAS bf16_t* Cm = (LAS bf16_t*)lds; LAS bf16_t* Bm = (LAS bf16_t*)(lds + 34816); LAS bf16_t* Xh = (LAS bf16_t*)(lds + 69632); LAS bf16_t* Hp = (LAS bf16_t*)(lds + 88064);
            LAS float* CUM = (LAS float*)(lds + 105472); LAS float* DTL = CUM + 512; LAS bf16_t* YL = (LAS bf16_t*)lds;
            for (int unit = vcu; unit < 256; unit += G) {
                const int g = unit & 1, c = (unit >> 1) & 31, b = unit >> 6, m0 = b * SEQ + c * 128;
#pragma unroll
                for (int k = 0; k < 4; ++k) { const int p = tid + 512 * k, row = p >> 4, c16 = p & 15; const bf16_t* sp = XBCC + (size_t)(m0 + row) * 1024 + 128 * g + 8 * c16;
                    *(LAS u32x4*)(Bm + row * 136 + 8 * c16) = *(const u32x4*)(sp + 512); *(LAS u32x4*)(Cm + row * 136 + 8 * c16) = *(const u32x4*)(sp + 768); }
                if (wave < 4) { const int h = 4 * g + wave; const float a_h = -__expf(args.in[I_ALOG][h]);
                    const float v0 = DTSP[(size_t)(m0 + 2 * lane) * 8 + h], v1 = DTSP[(size_t)(m0 + 2 * lane + 1) * 8 + h]; float s = v0 + v1;
#pragma unroll
                    for (int o = 1; o < 64; o <<= 1) { const float t = __shfl_up(s, o); if (lane >= o) s += t; }
                    const float ex = s - (v0 + v1);
                    CUM[wave * 128 + 2 * lane] = a_h * (ex + v0); CUM[wave * 128 + 2 * lane + 1] = a_h * (ex + v0 + v1); DTL[wave * 128 + 2 * lane] = v0; DTL[wave * 128 + 2 * lane + 1] = v1; }
                LBAR();
                const int mt = wave >> 1, nb = 2 * (wave & 1), nt2 = wave & 1;
                f32x16 cb[2];
#pragma unroll
                for (int r = 0; r < 16; ++r) { cb[0][r] = 0.f; cb[1][r] = 0.f; }
#pragma unroll
                for (int ks = 0; ks < 8; ++ks) { const bf16x8 a = NATF(Cm, 136, ks, mt);
                    cb[0] = __builtin_amdgcn_mfma_f32_32x32x16_bf16(a, NATF(Bm, 136, ks, nb), cb[0], 0, 0, 0); cb[1] = __builtin_amdgcn_mfma_f32_32x32x16_bf16(a, NATF(Bm, 136, ks, nb + 1), cb[1], 0, 0, 0); }
                LBAR();
                LAS bf16_t* Wt = Bm;
                f32x16 yt[4];
#pragma unroll
                for (int hq = 0; hq < 4; ++hq) { const int h = 4 * g + hq;
#pragma unroll
                    for (int j = 0; j < 2; ++j) { const int s = 32 * (nb + j) + r32; const float cs = CUM[hq * 128 + s], ds = DTL[hq * 128 + s]; const int lb = 32 * mt + 4 * hh;
                        LAS bf16_t* wp = Wt + lb * 136 + s; const LAS float* cl = CUM + hq * 128 + lb;
#pragma unroll
                        for (int r = 0; r < 16; ++r) { const float w = (s <= lb + crc(r)) ? cb[j][r] * __expf(cl[crc(r)] - cs) * ds : 0.f; wp[crc(r) * 136] = (bf16_t)f2bf(w); } }
                    { const int s = tid >> 2, cq = 16 * (tid & 3); const bf16_t* xp = XBCC + (size_t)(m0 + s) * 1024 + 64 * h + cq;
                      *(LAS u32x4*)(Xh + s * 72 + cq) = *(const u32x4*)xp; *(LAS u32x4*)(Xh + s * 72 + cq + 8) = *(const u32x4*)(xp + 8); }
                    { const bf16_t* hp = SSTATE + ((size_t)((b * 32 + c) * 8 + h)) * 8192;
#pragma unroll
                      for (int k = 0; k < 2; ++k) { const int p = tid + 512 * k, row = p >> 4, c16 = p & 15; *(LAS u32x4*)(Hp + row * 136 + 8 * c16) = *(const u32x4*)(hp + row * 128 + 8 * c16); } }
                    LBAR();
                    f32x16 yd, yo;
#pragma unroll
                    for (int r = 0; r < 16; ++r) { yd[r] = 0.f; yo[r] = 0.f; }
#pragma unroll
                    for (int ks = 0; ks < 8; ++ks) { yd = __builtin_amdgcn_mfma_f32_32x32x16_bf16(NATF(Wt, 136, ks, mt), TRF(Xh, 72, ks, nt2), yd, 0, 0, 0);
                        yo = __builtin_amdgcn_mfma_f32_32x32x16_bf16(NATF(Cm, 136, ks, mt), NATF(Hp, 136, ks, nt2), yo, 0, 0, 0); }
                    { const LAS float* cl = CUM + hq * 128 + 32 * mt + 4 * hh;
#pragma unroll
                      for (int r = 0; r < 16; ++r) yt[hq][r] = yd[r] + __expf(cl[crc(r)]) * yo[r]; }
                    LBAR();
                }
                { LAS bf16_t* yp = YL + (32 * mt + 4 * hh) * 264 + 32 * nt2 + r32;
#pragma unroll
                  for (int hq = 0; hq < 4; ++hq)
#pragma unroll
                      for (int r = 0; r < 16; ++r) yp[crc(r) * 264 + 64 * hq] = (bf16_t)f2bf(yt[hq][r]); }
                LBAR();
                for (int i = 0; i < 16; ++i) { const int l = wave * 16 + i; const size_t m = (size_t)(m0 + l); const int ch = 256 * g + 4 * lane;
                    const u32x2 yv = *(const LAS u32x2*)(YL + l * 264 + 4 * lane), xv = *(const u32x2*)(XBCC + m * 1024 + ch), zv = *(const u32x2*)(PROJ + m * NPROJ + 1792 + ch);
                    const float dsk = args.in[I_DSKIP][4 * g + (lane >> 4)];
                    float v[4] = {bflo(yv.x), bfhi(yv.x), bflo(yv.y), bfhi(yv.y)}; const float xs[4] = {bflo(xv.x), bfhi(xv.x), bflo(xv.y), bfhi(xv.y)}, zz[4] = {bflo(zv.x), bfhi(zv.x), bflo(zv.y), bfhi(zv.y)};
                    float q = 0.f;
#pragma unroll
                    for (int j = 0; j < 4; ++j) { v[j] = (v[j] + dsk * xs[j]) * siluf_(zz[j]); q += v[j] * v[j]; }
                    q = wave_sum(q); const float rq = __builtin_amdgcn_rsqf(q * (1.0f / 256.0f) + EPS); const f32x4 nw = *(const f32x4*)(args.in[I_SSDN] + ch);
                    u32x2 o; o.x = pk2(v[0] * rq * nw[0], v[1] * rq * nw[1]); o.y = pk2(v[2] * rq * nw[2], v[3] * rq * nw[3]); *(u32x2*)(MIX + m * DM + 512 + ch) = o; }
                LBAR();
            }
        }
        const float* mu = args.in[I_MU];
        for (int m = gw; m < MTOK; m += NGW) {
            const bool hasprev = (m & (SEQ - 1)) != 0; const int c0 = 8 * lane, h = lane >> 3;
            float y[8], v[8], p[8], go[8];
            unpack8(*(const u32x4*)(MIX + (size_t)m * DM + c0), y);
            unpack8(*(const u32x4*)((const bf16_t*)((const unsigned char*)dout + 48 * MiB) + (size_t)m * 512 + c0), p);
#pragma unroll
            for (int i = 0; i < 8; ++i) y[i] += p[i];
            const bf16_t* pc = PROJ + (size_t)m * NPROJ + c0;
            unpack8(*(const u32x4*)(pc + 1024), v);
            if (hasprev) {
                unpack8(*(const u32x4*)(pc - NPROJ + 1024), p);
#pragma unroll
                for (int i = 0; i < 8; ++i) v[i] += (p[i] - v[i]) * mu[1024 + c0 + i];
            } else {
#pragma unroll
                for (int i = 0; i < 8; ++i) v[i] -= v[i] * mu[1024 + c0 + i];
            }
            unpack8(*(const u32x4*)(GOUT + (size_t)m * 512 + c0), go);
            float s1 = 0.f; const float bd = KKR[(size_t)m * 8 + h];
#pragma unroll
            for (int i = 0; i < 8; ++i) s1 += y[i];
            s1 += __shfl_xor(s1, 1); s1 += __shfl_xor(s1, 2); s1 += __shfl_xor(s1, 4);
            const float mean = s1 * (1.0f / 64.0f); float s2 = 0.f;
#pragma unroll
            for (int i = 0; i < 8; ++i) { const float d = y[i] - mean; s2 += d * d; }
            s2 += __shfl_xor(s2, 1); s2 += __shfl_xor(s2, 2); s2 += __shfl_xor(s2, 4);
            const float rs = __builtin_amdgcn_rsqf(s2 * (1.0f / 64.0f) + 64e-5f);
            float o[8];
#pragma unroll
            for (int i = 0; i < 8; ++i) o[i] = ((y[i] - mean) * rs * args.in[I_GNW][c0 + i] + args.in[I_GNB][c0 + i] + bd * v[i]) * go[i];
            *(u32x4*)(MIX + (size_t)m * DM + c0) = pack8(o);
        }
    }
    SEAM(5);


    PHASE(6) { REPBAR
        pg8::Gemm g{MIX, WOUT, MTOK, DM, DM}; pg8::StaticOrder S; S.init(MTOK, DM, G, bx);
        pg8::EpiRes E{args.in[I_X], dout, XNB, args.in[I_NORM_FFN0], nullptr, SS};
        pg8::gemm_phase(lds, g, S, E);
    }
    SEAM(6);
    PHASE(7) { REPBAR
        pg8::Gemm g{XNB, WGU, MTOK, 2 * FFN, DM}; pg8::StaticOrder S; S.init(MTOK, 2 * FFN, G, bx);
        pg8::EpiSwiglu E{HID, FFN, SS, nullptr};
        pg8::gemm_phase(lds, g, S, E);
    }
    SEAM(7);
    PHASE(8) { REPBAR
        pg8::Gemm g{HID, WDN, MTOK, DM, FFN}; pg8::StaticOrder S; S.init(MTOK, DM, G, bx);
        pg8::EpiRes E{dout, dout, XNB, args.in[I_NORM_MIX1], nullptr, SS};
        pg8::gemm_phase(lds, g, S, E);
    }
    SEAM(8);
    PHASE(9) { REPBAR
        pg8::Gemm g{XNB, WQKV, MTOK, 1536, DM}; pg8::StaticOrder S; S.init(MTOK, 1536, G, bx);
        pg8::EpiQkv E{QKV, SS, args.in[I_BQKV], args.in[I_QN], args.in[I_KN], ROPE};
        pg8::gemm_phase(lds, g, S, E);
    }
    SEAM(9);

    PHASE(10) { REPBAR
        LAS bf16_t* Kt = (LAS bf16_t*)lds; LAS bf16_t* Vt = (LAS bf16_t*)(lds + 36864);
        const int r32 = lane & 31, hh = lane >> 5;
        for (int unit = vcu; unit < BATCH * 4 * 32; unit += G) {
            const int blk = unit & 31, kvh = (unit >> 5) & 3, b = unit >> 7;
            {
                const int rowi = tid >> 1, half = tid & 1; const int tpos = (blk - 1) * 128 + rowi;
#pragma unroll
                for (int q = 0; q < 4; ++q) { u32x4 kv = (u32x4){0, 0, 0, 0}, vv = kv;
                    if (tpos >= 0) { const bf16_t* p = QKV + (size_t)(b * SEQ + tpos) * 1536 + 1024 + kvh * 64 + half * 32 + 8 * q; kv = *(const u32x4*)p; vv = *(const u32x4*)(p + 256); }
                    *(LAS u32x4*)(Kt + rowi * 72 + half * 32 + 8 * q) = kv; *(LAS u32x4*)(Vt + rowi * 72 + half * 32 + 8 * q) = vv; }
            }
            __syncthreads();
            const int gq = wave >> 1, qh = kvh * 4 + gq; const float sink = args.in[I_SINK][qh];
            for (int it = 0; it < 2; ++it) {
                const int qi = (wave & 1) * 64 + it * 32 + r32; const size_t mq = (size_t)b * SEQ + blk * 128 + qi;
                bf16x8 qr[4];
#pragma unroll
                for (int s = 0; s < 4; ++s) qr[s] = *(const bf16x8*)(QKV + mq * 1536 + qh * 64 + 16 * s + 8 * hh);
                const int a0 = (wave & 1) * 2 + it;
                f32x16 sc[5];
#pragma unroll
                for (int j = 0; j < 5; ++j) {
#pragma unroll
                    for (int r = 0; r < 16; ++r) sc[j][r] = 0.f;
#pragma unroll
                    for (int s = 0; s < 4; ++s) { const bf16x8 kf = *(const LAS bf16x8*)(Kt + (32 * (a0 + j) + r32) * 72 + 16 * s + 8 * hh); sc[j] = __builtin_amdgcn_mfma_f32_32x32x16_bf16(kf, qr[s], sc[j], 0, 0, 0); }
                }
                float mx = sink;
#pragma unroll
                for (int j = 0; j < 5; ++j)
#pragma unroll
                    for (int r = 0; r < 16; ++r) { const int kj = 32 * (a0 + j) + crow(r, hh); const bool valid = (kj > qi) && (kj <= qi + 128) && (blk > 0 || kj >= 128);
                        const float x = valid ? sc[j][r] * 0.125f : -1e30f; sc[j][r] = x; mx = fmaxf(mx, x); }
                mx = fmaxf(mx, __shfl_xor(mx, 32));
                float l = 0.f;
#pragma unroll
                for (int j = 0; j < 5; ++j)
#pragma unroll
                    for (int r = 0; r < 16; ++r) { const float p = __expf(sc[j][r] - mx); sc[j][r] = p; l += p; }
                l += __shfl_xor(l, 32); l += __expf(sink - mx);
                const float inv = 1.0f / l;
                f32x16 o[2];
#pragma unroll
                for (int dt = 0; dt < 2; ++dt)
#pragma unroll
                    for (int r = 0; r < 16; ++r) o[dt][r] = 0.f;
#pragma unroll
                for (int j = 0; j < 5; ++j)
#pragma unroll
                    for (int s2 = 0; s2 < 2; ++s2) {
                        u32x4 pw; pw.x = pk2(sc[j][8 * s2 + 0], sc[j][8 * s2 + 1]); pw.y = pk2(sc[j][8 * s2 + 2], sc[j][8 * s2 + 3]); pw.z = pk2(sc[j][8 * s2 + 4], sc[j][8 * s2 + 5]); pw.w = pk2(sc[j][8 * s2 + 6], sc[j][8 * s2 + 7]);
                        const bf16x8 pf = __builtin_bit_cast(bf16x8, pw);
                        const int key0 = 32 * (a0 + j) + 16 * s2 + 4 * hh + ((lane & 15) >> 2);
#pragma unroll
                        for (int dt = 0; dt < 2; ++dt) {
                            const LAS bf16_t* vp = Vt + key0 * 72 + 32 * dt + 16 * ((lane >> 4) & 1) + 4 * (lane & 3);
                            const s16x4 lo = __builtin_bit_cast(s16x4, __builtin_amdgcn_ds_read_tr16_b64_v4i16((LAS s16x4*)vp));
                            const s16x4 hi = __builtin_bit_cast(s16x4, __builtin_amdgcn_ds_read_tr16_b64_v4i16((LAS s16x4*)(vp + 8 * 72)));
                            const bf16x8 vf = (bf16x8){lo[0], lo[1], lo[2], lo[3], hi[0], hi[1], hi[2], hi[3]};
                            o[dt] = __builtin_amdgcn_mfma_f32_32x32x16_bf16(vf, pf, o[dt], 0, 0, 0);
                        }
                    }
                bf16_t* op = ATTO + mq * DM + qh * 64;
#pragma unroll
                for (int dt = 0; dt < 2; ++dt)
#pragma unroll
                    for (int rq = 0; rq < 4; ++rq) { u32x2 w; w.x = pk2(o[dt][4 * rq] * inv, o[dt][4 * rq + 1] * inv); w.y = pk2(o[dt][4 * rq + 2] * inv, o[dt][4 * rq + 3] * inv);
                        *(u32x2*)(op + 32 * dt + 8 * rq + 4 * hh) = w; }
            }
            __syncthreads();
        }
    }
    SEAM(10);

    PHASE(11) { REPBAR
        pg8::Gemm g{ATTO, WO, MTOK, DM, DM}; pg8::StaticOrder S; S.init(MTOK, DM, G, bx);
        pg8::EpiRes E{dout, dout, XNB, args.in[I_NORM_FFN1], args.in[I_BO], SS};
        pg8::gemm_phase(lds, g, S, E);
    }
    SEAM(11);

    PHASE(12) { REPBAR
        {
            LAS float* scr = (LAS float*)(lds + wave * 16384);
            for (int it0 = gw; ; it0 += NGW) {
                int it = it0; bool done = false;
                for (int e = 0; e < NEXP && !done; ++e) {
                    if (transpose_matrix(it, args.in[I_EG] + (size_t)e * DM * FE, FE, DM, FE, EGU + (size_t)e * 2 * FE * DM, 1, scr, lane)) { done = true; break; }
                    if (transpose_matrix(it, args.in[I_EU] + (size_t)e * DM * FE, FE, DM, FE, EGU + (size_t)e * 2 * FE * DM, 2, scr, lane)) { done = true; break; }
                    if (transpose_matrix(it, args.in[I_ED] + (size_t)e * FE * DM, DM, FE, DM, EDN + (size_t)e * DM * FE, 0, scr, lane)) { done = true; break; }
                }
                if (!done) break;
            }
            __syncthreads();
        }
        LAS float* w8 = (LAS float*)lds; LAS unsigned* lcnt = (LAS unsigned*)(lds + 32768); LAS unsigned* lbase = lcnt + 8; LAS unsigned* lsel = lcnt + 16;
        for (int r = tid; r < DM; r += 512) { const float* p = args.in[I_ROUTER] + (size_t)r * 8; *(LAS f32x4*)(w8 + r * 8) = *(const f32x4*)p; *(LAS f32x4*)(w8 + r * 8 + 4) = *(const f32x4*)(p + 4); }
        if (tid < 8) lcnt[tid] = 0u;
        __syncthreads();
        const float* gm = args.in[I_NORM_FFN1];
        int kk = 0;
        for (int m = gw; m < MTOK; m += NGW, ++kk) {
            const f32x4* xr = (const f32x4*)(dout + (size_t)m * DM) + lane;
            f32x4 v[4]; float s = 0.f;
#pragma unroll
            for (int j = 0; j < 4; ++j) { v[j] = xr[64 * j]; s += (v[j][0] * v[j][0] + v[j][1] * v[j][1]) + (v[j][2] * v[j][2] + v[j][3] * v[j][3]); }
            const float rstd = __builtin_amdgcn_rsqf(wave_sum(s) * (1.0f / DM) + EPS);
            float d[8];
#pragma unroll
            for (int k = 0; k < 8; ++k) d[k] = 0.f;
#pragma unroll
            for (int j = 0; j < 4; ++j) { const f32x4 g4 = ((const f32x4*)gm)[64 * j + lane]; const f32x4 y = v[j] * rstd * g4;
#pragma unroll
                for (int i = 0; i < 4; ++i) { const int c = 256 * j + 4 * lane + i; const f32x4 wa = *(const LAS f32x4*)(w8 + c * 8), wb = *(const LAS f32x4*)(w8 + c * 8 + 4);
                    d[0] += y[i] * wa[0]; d[1] += y[i] * wa[1]; d[2] += y[i] * wa[2]; d[3] += y[i] * wa[3]; d[4] += y[i] * wb[0]; d[5] += y[i] * wb[1]; d[6] += y[i] * wb[2]; d[7] += y[i] * wb[3]; } }
#pragma unroll
            for (int k = 0; k < 8; ++k) d[k] = wave_sum(d[k]);
            int e0 = 0; float v0 = d[0];
#pragma unroll
            for (int k = 1; k < 8; ++k) if (d[k] > v0) { v0 = d[k]; e0 = k; }
            int e1 = -1; float v1 = -3.0e38f;
#pragma unroll
            for (int k = 0; k < 8; ++k) if (k != e0 && d[k] > v1) { v1 = d[k]; e1 = k; }
            if (lane == 0) {
                const float w0 = __builtin_amdgcn_rcpf(1.0f + __expf(v1 - v0));
                const unsigned r0 = atomicAdd((unsigned*)(lcnt + e0), 1u), r1 = atomicAdd((unsigned*)(lcnt + e1), 1u);
                lsel[(wave * 8 + kk) * 2] = ((unsigned)e0 << 16) | r0; lsel[(wave * 8 + kk) * 2 + 1] = ((unsigned)e1 << 16) | r1;
                TOPE[2 * m] = e0; TOPE[2 * m + 1] = e1; TOPW[2 * m] = w0; TOPW[2 * m + 1] = 1.0f - w0; RSTD4[m] = rstd;
            }
        }
        __syncthreads();
        if (tid < 8) lbase[tid] = atomicAdd(CNT + tid, lcnt[tid]);
        __syncthreads();
        if (tid < 128) { const int row = tid >> 1, w_ = row >> 3, k_ = row & 7; const int m = (vcu * 8 + w_) + k_ * NGW; if (m < MTOK) { const unsigned sv = lsel[tid]; RANK[2 * m + (tid & 1)] = (int)(lbase[sv >> 16] + (sv & 0xffffu)); } }
        __syncthreads();
    }
    SEAM(12);

    PHASE(13) { REPBAR
        int roff[NEXP]; { int t = 0;
#pragma unroll
            for (int e = 0; e < NEXP; ++e) { roff[e] = t; t += (int)((CNT[e] + 255u) >> 8) << 8; } }
        for (int j = gw; j < 2 * MTOK; j += NGW) {
            const int m = j >> 1, e = TOPE[j]; int ro = roff[0];
#pragma unroll
            for (int k = 1; k < NEXP; ++k) ro = (e == k) ? roff[k] : ro;
            const int pos = ro + RANK[j];
            const u32x4* src = (const u32x4*)(XNB + (size_t)m * DM) + lane; u32x4* dst = (u32x4*)(AS + (size_t)pos * DM) + lane;
            dst[0] = src[0]; dst[64] = src[64];
            if (lane == 0) { POS[j] = pos; RSTDS[pos] = RSTD4[m]; }
        }
    }
    SEAM(13);
    PHASE(14) { REPBAR
        pg8::Gemm g{AS, EGU, SROWS, 2 * FE, DM}; pg8::MoeOrder S; S.init(CNT, 2 * FE / 256, G, bx, (long)2 * FE * DM * 2);
        pg8::EpiSwiglu E{HS, FE, nullptr, RSTDS};
        pg8::gemm_phase(lds, g, S, E);
    }
    SEAM(14);
    PHASE(15) { REPBAR
        pg8::Gemm g{HS, EDN, SROWS, DM, FE}; pg8::MoeOrder S; S.init(CNT, DM / 256, G, bx, (long)DM * FE * 2);
        pg8::EpiBf16 E{AS, DM};
        pg8::gemm_phase(lds, g, S, E);
    }
    SEAM(15);
    PHASE(16) { REPBAR
        for (int m = gw; m < MTOK; m += NGW) {
            const int p0 = POS[2 * m], p1 = POS[2 * m + 1]; const float w0 = TOPW[2 * m], w1 = TOPW[2 * m + 1];
            const u32x4* y0 = (const u32x4*)(AS + (size_t)p0 * DM) + lane; const u32x4* y1 = (const u32x4*)(AS + (size_t)p1 * DM) + lane;
            f32x4* o = (f32x4*)(dout + (size_t)m * DM);
#pragma unroll
            for (int q = 0; q < 2; ++q) { float a[8], c[8]; unpack8(y0[64 * q], a); unpack8(y1[64 * q], c);
                f32x4 h0 = o[128 * q + 2 * lane], h1 = o[128 * q + 2 * lane + 1];
#pragma unroll
                for (int i = 0; i < 4; ++i) { h0[i] += w0 * a[i] + w1 * c[i]; h1[i] += w0 * a[4 + i] + w1 * c[4 + i]; }
                o[128 * q + 2 * lane] = h0; o[128 * q + 2 * lane + 1] = h1; }
        }
    }
#undef TRF
#undef NATF
#undef IN
#undef SEAM
#undef PHASE
#undef REPBAR
}

constexpr int NPHASE = 17;
extern "C" void kernel_launch(void* const* d_in, const int* in_sizes, int n_in, void* d_out, int out_size, void* d_ws, size_t ws_size, hipStream_t stream) {
    static int grid = 0;
    if (grid == 0) {
        if (n_in != 39 || out_size != MTOK * DM || ws_size < WS_END) { fprintf(stderr, "kernel_launch: unexpected shapes n_in %d out %d ws %zu\n", n_in, out_size, ws_size); grid = -1; return; }
        int dev = 0, cus = 0;
        if (hipGetDevice(&dev) != hipSuccess || hipDeviceGetAttribute(&cus, hipDeviceAttributeMultiprocessorCount, dev) != hipSuccess) { grid = -1; return; }
        if (hipFuncSetAttribute((const void*)fwd_kernel, hipFuncAttributeMaxDynamicSharedMemorySize, LDS_BYTES) != hipSuccess) { fprintf(stderr, "kernel_launch: hipFuncSetAttribute failed\n"); grid = -1; return; }
        int per_cu = 0; (void)hipOccupancyMaxActiveBlocksPerMultiprocessor(&per_cu, (const void*)fwd_kernel, 512, LDS_BYTES); (void)hipGetLastError();
        grid = 256; if (cus != 256 || per_cu < 1) fprintf(stderr, "kernel_launch: note: cus %d per_cu %d\n", cus, per_cu);
    }
    if (grid < 0) return;
    Args a{};
    a.in[0] = (const float*)d_in[0];
    for (int i = 2; i < 39; ++i) a.in[i - 1] = (const float*)d_in[i];
    a.pos = (const int*)d_in[1]; a.out = (float*)d_out; a.ws = (unsigned char*)d_ws;
    (void)hipMemsetAsync((char*)d_ws + WS_CTL, 0, CTL_ZERO_BYTES, stream);
#ifdef PROBE_PHASE
    constexpr int pp = PROBE_PHASE; constexpr bool before = (pp == 2 || pp == 3 || pp == 5 || pp == 6 || pp == 8 || pp == 11 || pp == 12);
#ifdef PROBE_VARIANT
    a.variant = PROBE_VARIANT;
#endif
    if (before) { a.ph_lo = pp; a.ph_hi = pp + 1; hipLaunchKernelGGL(fwd_kernel, dim3(grid), dim3(512), LDS_BYTES, stream, a); (void)hipMemsetAsync((char*)d_ws + WS_CTL, 0, CTL_ZERO_BYTES, stream); }
    a.variant = 0;
#endif
    a.ph_lo = 0; a.ph_hi = NPHASE;
    hipLaunchKernelGGL(fwd_kernel, dim3(grid), dim3(512), LDS_BYTES, stream, a);
#ifdef PROBE_PHASE
    if (!before) { (void)hipMemsetAsync((char*)d_ws + WS_CTL, 0, CW_CNT * 4, stream);
#ifdef PROBE_VARIANT
        a.variant = PROBE_VARIANT;
#endif
        a.ph_lo = pp; a.ph_hi = pp + 1; hipLaunchKernelGGL(fwd_kernel, dim3(grid), dim3(512), LDS_BYTES, stream, a); }
#endif
}
```

```cpp
#include <hip/hip_runtime.h>
#include <cstdio>
#include <cstdint>

#define LAS __attribute__((address_space(3)))
#define GAS __attribute__((address_space(1)))
typedef unsigned short bf16_t;
typedef short bf16x8 __attribute__((ext_vector_type(8)));
typedef float f32x4 __attribute__((ext_vector_type(4)));
typedef float f32x2 __attribute__((ext_vector_type(2)));
typedef float f32x16 __attribute__((ext_vector_type(16)));
typedef unsigned u32x4 __attribute__((ext_vector_type(4)));
typedef unsigned u32x2 __attribute__((ext_vector_type(2)));
typedef short s16x4 __attribute__((ext_vector_type(4)));

constexpr int BATCH = 4, SEQ = 4096, DM = 1024, MTOK = BATCH * SEQ;
constexpr int IN0 = 3336, NPROJ = 3328;
constexpr int FFN = 2816, FE = 1408, NEXP = 8;
constexpr int SROWS = 2 * MTOK + NEXP * 256;
constexpr float EPS = 1e-6f;

constexpr size_t MiB = 1u << 20;
constexpr size_t WS_CTL = 0, CTL_ZERO_BYTES = 64 * 1024;
constexpr size_t WS_DTSP = 1 * MiB;
constexpr size_t WS_KKR = 1 * MiB + 512 * 1024;
constexpr size_t WS_ROPE = 2 * MiB;
constexpr size_t WS_SS = 3 * MiB;
constexpr size_t WS_TOPE = 4 * MiB;
constexpr size_t WS_RANK = 4 * MiB + 128 * 1024;
constexpr size_t WS_TOPW = 4 * MiB + 256 * 1024;
constexpr size_t WS_POS = 4 * MiB + 384 * 1024;
constexpr size_t WS_RSTD4 = 4 * MiB + 512 * 1024;
constexpr size_t WS_RSTDS = 4 * MiB + 640 * 1024;
constexpr size_t WS_WDEC = 5 * MiB;
constexpr size_t WS_WICL = 5 * MiB + 64 * 1024;
constexpr size_t WS_WGAT = 5 * MiB + 128 * 1024;
constexpr size_t WS_EGU = 6 * MiB;
constexpr size_t WS_EDN = 50 * MiB;
constexpr size_t WS_WIN = 72 * MiB;
constexpr size_t WS_WOUT = WS_WIN + (size_t)NPROJ * DM * 2;
constexpr size_t WS_WGU = WS_WOUT + 2 * MiB;
constexpr size_t WS_WDN = WS_WGU + 11 * MiB;
constexpr size_t WS_WQKV = WS_WDN + (size_t)DM * FFN * 2;
constexpr size_t WS_WO = WS_WQKV + 3 * MiB;
constexpr size_t R0 = 102 * MiB;
static_assert(WS_WO + 2 * MiB <= R0, "weights");
constexpr size_t WS_XN = R0, WS_MIX = R0;
constexpr size_t WS_PROJ = R0 + 32 * MiB;
constexpr size_t WS_GOUT = R0 + 136 * MiB;
constexpr size_t WS_XNB = R0 + 104 * MiB;
constexpr size_t WS_HID = R0;
constexpr size_t WS_QKV = R0;
constexpr size_t WS_ATTO = R0 + 48 * MiB;
constexpr size_t WS_AS = 72 * MiB;
constexpr size_t WS_HS = 140 * MiB;
constexpr size_t WS_END = 254 * MiB;
static_assert(WS_AS + (size_t)SROWS * DM * 2 <= WS_HS && WS_HS + (size_t)SROWS * FE * 2 <= WS_END && WS_GOUT + 16 * MiB <= WS_END, "map");
constexpr size_t DO_XBCC = 0, DO_DECAY = 32 * MiB, DO_ICLR = 48 * MiB;
constexpr int CW_BAR = 4096, CW_CNT = 8192;

constexpr int LDS_BYTES = 147456, RING_BYTES = 131072, MISC_OFF = LDS_BYTES - 128;

__device__ __forceinline__ unsigned f2bf(float f) { unsigned u = __builtin_bit_cast(unsigned, f); return (u + 0x7fffu + ((u >> 16) & 1u)) >> 16; }
typedef __bf16 bf16x2_t __attribute__((ext_vector_type(2)));
__device__ __forceinline__ unsigned pk2(float lo, float hi) { const f32x2 v = {lo, hi}; const bf16x2_t b = __builtin_convertvector(v, bf16x2_t); return __builtin_bit_cast(unsigned, b); }
__device__ __forceinline__ float bflo(unsigned u) { return __builtin_bit_cast(float, u << 16); }
__device__ __forceinline__ float bfhi(unsigned u) { return __builtin_bit_cast(float, u & 0xffff0000u); }
__device__ __forceinline__ void unpack8(const u32x4 v, float* f) { f[0] = bflo(v.x); f[1] = bfhi(v.x); f[2] = bflo(v.y); f[3] = bfhi(v.y); f[4] = bflo(v.z); f[5] = bfhi(v.z); f[6] = bflo(v.w); f[7] = bfhi(v.w); }
__device__ __forceinline__ u32x4 pack8(const float* f) { u32x4 v; v.x = pk2(f[0], f[1]); v.y = pk2(f[2], f[3]); v.z = pk2(f[4], f[5]); v.w = pk2(f[6], f[7]); return v; }
__device__ __forceinline__ float sigmoidf_(float x) { return __builtin_amdgcn_rcpf(1.0f + __expf(-x)); }
__device__ __forceinline__ float siluf_(float x) { return x * __builtin_amdgcn_rcpf(1.0f + __expf(-x)); }
#define LBAR() do { asm volatile("s_waitcnt lgkmcnt(0)" ::: "memory"); __builtin_amdgcn_s_barrier(); asm volatile("" ::: "memory"); } while (0)
__device__ __forceinline__ float wave_sum(float v) {
#pragma unroll
    for (int o = 1; o < 64; o <<= 1) v += __shfl_xor(v, o);
    return v;
}
__device__ __forceinline__ float dpp_sum63(float x) {
    int v;
    v = __builtin_amdgcn_update_dpp(0, __builtin_bit_cast(int, x), 0xB1, 0xF, 0xF, false); x += __builtin_bit_cast(float, v);
    v = __builtin_amdgcn_update_dpp(0, __builtin_bit_cast(int, x), 0x4E, 0xF, 0xF, false); x += __builtin_bit_cast(float, v);
    v = __builtin_amdgcn_update_dpp(0, __builtin_bit_cast(int, x), 0x141, 0xF, 0xF, false); x += __builtin_bit_cast(float, v);
    v = __builtin_amdgcn_update_dpp(0, __builtin_bit_cast(int, x), 0x140, 0xF, 0xF, false); x += __builtin_bit_cast(float, v);
    v = __builtin_amdgcn_update_dpp(0, __builtin_bit_cast(int, x), 0x142, 0xA, 0xF, false); x += __builtin_bit_cast(float, v);
    v = __builtin_amdgcn_update_dpp(0, __builtin_bit_cast(int, x), 0x143, 0xC, 0xF, false); x += __builtin_bit_cast(float, v);
    return __builtin_bit_cast(float, __builtin_amdgcn_readlane(__builtin_bit_cast(int, x), 63));
}
__device__ __forceinline__ void wave_sum8(float (&d)[8]) {
    float e4[4], e2[2], e1;
    { const bool up = (threadIdx.x & 32) != 0;
#pragma unroll
      for (int k = 0; k < 4; ++k) { const float keep = up ? d[k + 4] : d[k], send = up ? d[k] : d[k + 4]; e4[k] = keep + __shfl_xor(send, 32); } }
    { const bool up = (threadIdx.x & 16) != 0;
#pragma unroll
      for (int k = 0; k < 2; ++k) { const float keep = up ? e4[k + 2] : e4[k], send = up ? e4[k] : e4[k + 2]; e2[k] = keep + __shfl_xor(send, 16); } }
    { const bool up = (threadIdx.x & 8) != 0; const float keep = up ? e2[1] : e2[0], send = up ? e2[0] : e2[1]; e1 = keep + __shfl_xor(send, 8); }
    e1 += __shfl_xor(e1, 4); e1 += __shfl_xor(e1, 2); e1 += __shfl_xor(e1, 1);
#pragma unroll
    for (int k = 0; k < 8; ++k) d[k] = __builtin_bit_cast(float, __builtin_amdgcn_readlane(__builtin_bit_cast(int, e1), 8 * k));
}
__device__ __forceinline__ int crow(int r, int hi) { return (r & 3) + 8 * (r >> 2) + 4 * hi; }
__device__ __forceinline__ constexpr int crc(int r) { return (r & 3) + 8 * (r >> 2); }

namespace pg8 {
constexpr int BM = 256, BK = 64, HALF = 128, HTB = HALF * BK * 2, NXCD = 8, WGM = 8;
__host__ __device__ __forceinline__ int lds_byte(int r, int c) { const int st = (r >> 4) * 2 + (c >> 5), rr = r & 15, cc = c & 31, ob = rr * 64 + cc * 2; return st * 1024 + (ob ^ (((ob >> 9) & 1) << 5)); }
__host__ __device__ __forceinline__ void stage_rc(int b, int& R, int& C) { const int st = b / 1024, sb = b % 1024, swz = sb ^ (((sb >> 9) & 1) << 5); R = (st >> 1) * 16 + swz / 64; C = (st & 1) * 32 + (swz % 64) / 2; }
__host__ __device__ __forceinline__ int perm32(int rho) { const int n = rho >> 4, i = rho & 15; return 8 * (i >> 2) + 4 * n + (i & 3); }
struct Unit { int pm, pn; long bofs; };
struct Gemm { const bf16_t* A; const bf16_t* Bt; int M, N, K; };
struct StaticOrder {
    int nM, nN, nwg, G, c;
    __device__ void init(int M, int N, int G_, int c_) { nM = M / BM; nN = N / BM; nwg = nM * nN; G = G_; c = c_; }
    __device__ bool next(int i, Unit& u) const {
        const long L = (long)i * G + c; if (L >= nwg) return false;
        int wgid = (int)L; { const int q = nwg / NXCD, r = nwg % NXCD, xcd = wgid % NXCD, off = wgid / NXCD; wgid = (xcd < r ? xcd * (q + 1) : r * (q + 1) + (xcd - r) * q) + off; }
        const int nig = WGM * nN, gid = wgid / nig, fm = gid * WGM, gsz = (nM - fm) < WGM ? (nM - fm) : WGM;
        u.pm = fm + ((wgid % nig) % gsz); u.pn = (wgid % nig) / gsz; u.bofs = 0; return true;
    }
};
struct MoeOrder {
    int toff[NEXP + 1]; int nN, G, c; long estride;
    __device__ void init(const unsigned* cnt, int nN_, int G_, int c_, long estride_) {
        nN = nN_; G = G_; c = c_; estride = estride_; int t = 0;
#pragma unroll
        for (int e = 0; e < NEXP; ++e) { toff[e] = t; t += (int)((cnt[e] + 255u) >> 8); }
        toff[NEXP] = t;
    }
    __device__ bool next(int i, Unit& u) const {
        const long L = (long)i * G + c; if (L >= (long)toff[NEXP] * nN) return false;
        const int pm = (int)(L / nN); u.pm = pm; u.pn = (int)(L % nN); int e = 0;
#pragma unroll
        for (int j = 1; j < NEXP; ++j) e += (pm >= toff[j]) ? 1 : 0;
        u.bofs = (long)e * estride; return true;
    }
};

template <class Epi, class Sched>
__device__ __forceinline__ void gemm_phase(LAS unsigned char* lds, const Gemm g, const Sched& S, const Epi& E) {
    constexpr bool ALIGN_EPI = true;
    const int tid = threadIdx.x, wid = __builtin_amdgcn_readfirstlane(tid >> 6), lane = tid & 63, wr = wid >> 2, wc = wid & 3, fr = lane & 15, fq = lane >> 4;
    const int K = g.K, nt = K / BK;
    unsigned voffA[2], voffB[2];
#pragma unroll
    for (int i = 0; i < 2; ++i) { int R, C; stage_rc(tid * 16 + i * 8192, R, C); const int Rb = Epi::PERM ? ((R & ~31) + perm32(R & 31)) : R;
        voffA[i] = (unsigned)(R * K + C) * 2u; voffB[i] = (unsigned)(Rb * K + C) * 2u; }
    const size_t kstep = (size_t)(BK * 2);
    const size_t hstep = (size_t)HALF * K * 2;
    const size_t tstep = 2 * hstep;
    const unsigned ldsw = (unsigned)wid * 1024u;
    const int aoff = lds_byte(wr * 64 + fr, fq * 8), boff = lds_byte(wc * 32 + fr, fq * 8);
#define PG8_SA(b, h) (((b) * 2 + (h)) * HTB)
#define PG8_SB(b, h) ((4 + (b) * 2 + (h)) * HTB)
#define PG8_STAGE(bufoff, gbase, voff) do { _Pragma("unroll") for (int _i = 0; _i < 2; ++_i) \
        __builtin_amdgcn_global_load_lds((const unsigned*)((const char*)(gbase) + (voff)[_i]), (LAS unsigned*)(lds + (bufoff) + ldsw + _i * 8192), 16, 0, 0); } while (0)
#define PG8_LDA(dst, b, h) do { _Pragma("unroll") for (int m = 0; m < 4; ++m) _Pragma("unroll") for (int k = 0; k < 2; ++k) dst[m][k] = *(const LAS bf16x8*)(lds + PG8_SA(b, h) + aoff + m * 2048 + k * 1024); } while (0)
#define PG8_LDB(dst, b, h) do { _Pragma("unroll") for (int n = 0; n < 2; ++n) _Pragma("unroll") for (int k = 0; k < 2; ++k) dst[n][k] = *(const LAS bf16x8*)(lds + PG8_SB(b, h) + boff + n * 2048 + k * 1024); } while (0)
#define PG8_MMA(ai, bj, At, Bt) do { __builtin_amdgcn_s_setprio(1); _Pragma("unroll") for (int m = 0; m < 4; ++m) _Pragma("unroll") for (int n = 0; n < 2; ++n) _Pragma("unroll") for (int k = 0; k < 2; ++k) \
        acc[ai][bj][m][n] = __builtin_amdgcn_mfma_f32_16x16x32_bf16(Bt[n][k], At[m][k], acc[ai][bj][m][n], 0, 0, 0); __builtin_amdgcn_s_setprio(0); } while (0)
#define PG8_WAIT_V(n) asm volatile("s_waitcnt vmcnt(" #n ")" ::: "memory")
#define PG8_WAIT_L(n) asm volatile("s_waitcnt lgkmcnt(" #n ")" ::: "memory")
#define PG8_BAR __builtin_amdgcn_s_barrier()
#define PG8_SCHED __builtin_amdgcn_sched_barrier(0)
    Unit cur, nxt; int ui = 0;
    if (!S.next(0, cur)) return;
    f32x4 acc[2][2][4][2];
#pragma unroll
    for (int a = 0; a < 2; ++a)
#pragma unroll
        for (int b = 0; b < 2; ++b)
#pragma unroll
            for (int m = 0; m < 4; ++m)
#pragma unroll
                for (int n = 0; n < 2; ++n) acc[a][b][m][n] = (f32x4){0.f, 0.f, 0.f, 0.f};
    bf16x8 At[4][2], B0[2][2], B1[2][2];
    const char* cA = (const char*)g.A + (size_t)cur.pm * tstep; const char* cB = (const char*)g.Bt + cur.bofs + (size_t)cur.pn * tstep;
    PG8_STAGE(PG8_SB(0, 0), cB, voffB); PG8_STAGE(PG8_SB(0, 1), cB + hstep, voffB); PG8_STAGE(PG8_SA(0, 0), cA, voffA); PG8_STAGE(PG8_SA(0, 1), cA + hstep, voffA);
    if (wr == 1) PG8_BAR;
    PG8_WAIT_V(2); PG8_BAR;
    PG8_STAGE(PG8_SB(1, 0), cB + kstep, voffB); PG8_STAGE(PG8_SA(1, 0), cA + kstep, voffA); PG8_STAGE(PG8_SB(1, 1), cB + hstep + kstep, voffB);
    PG8_WAIT_V(6); PG8_BAR;
    for (;;) {
        const bool has_next = S.next(ui + 1, nxt);
        const char* nA = has_next ? (const char*)g.A + (size_t)nxt.pm * tstep : cA; const char* nB = has_next ? (const char*)g.Bt + nxt.bofs + (size_t)nxt.pn * tstep : cB;
        for (int t = 0; t < nt; t += 2) {
            const bool last = (t == nt - 2);
            const char* a1 = cA + (size_t)(t + 1) * kstep;
            const char* a2 = last ? nA : cA + (size_t)(t + 2) * kstep; const char* b2 = last ? nB : cB + (size_t)(t + 2) * kstep;
            const char* a3 = a2 + kstep; const char* b3 = b2 + kstep;
            PG8_LDB(B0, 0, 0); PG8_LDB(B1, 0, 1); PG8_SCHED; PG8_LDA(At, 0, 0); PG8_STAGE(PG8_SA(1, 1), a1 + hstep, voffA);
            PG8_WAIT_V(8); PG8_WAIT_L(0); PG8_BAR; PG8_MMA(0, 0, At, B0); PG8_MMA(0, 1, At, B1); PG8_BAR; PG8_SCHED;
            PG8_LDA(At, 0, 1); PG8_STAGE(PG8_SB(0, 0), b2, voffB); PG8_STAGE(PG8_SB(0, 1), b2 + hstep, voffB); PG8_STAGE(PG8_SA(0, 0), a2, voffA);
            PG8_WAIT_V(8); PG8_WAIT_L(0); PG8_BAR; PG8_MMA(1, 0, At, B0); PG8_MMA(1, 1, At, B1); PG8_BAR; PG8_SCHED;
            PG8_LDB(B0, 1, 0); PG8_LDB(B1, 1, 1); PG8_SCHED; PG8_LDA(At, 1, 0); PG8_STAGE(PG8_SA(0, 1), a2 + hstep, voffA);
            PG8_WAIT_V(8); PG8_WAIT_L(0); PG8_BAR; PG8_MMA(0, 0, At, B0); PG8_MMA(0, 1, At, B1); PG8_BAR; PG8_SCHED;
            PG8_LDA(At, 1, 1); PG8_STAGE(PG8_SB(1, 0), b3, voffB); PG8_STAGE(PG8_SB(1, 1), b3 + hstep, voffB); PG8_STAGE(PG8_SA(1, 0), a3, voffA);
            PG8_WAIT_V(8); PG8_WAIT_L(0); PG8_BAR; PG8_MMA(1, 0, At, B0); PG8_MMA(1, 1, At, B1); PG8_BAR; PG8_SCHED;
        }
        if constexpr (ALIGN_EPI) { if (wr == 0) PG8_BAR; }
        E(acc, cur, wr, wc, fr, fq);
        if (!has_next) break;
#pragma unroll
        for (int a = 0; a < 2; ++a)
#pragma unroll
            for (int b = 0; b < 2; ++b)
#pragma unroll
                for (int m = 0; m < 4; ++m)
#pragma unroll
                    for (int n = 0; n < 2; ++n) acc[a][b][m][n] = (f32x4){0.f, 0.f, 0.f, 0.f};
        cur = nxt; cA = nA; cB = nB; ++ui;
        if constexpr (ALIGN_EPI) { if (wr == 1) PG8_BAR; }
    }
    PG8_WAIT_V(0);
    if constexpr (!ALIGN_EPI) { if (wr == 0) PG8_BAR; }
    PG8_BAR;
#undef PG8_SA
#undef PG8_SB
#undef PG8_STAGE
#undef PG8_LDA
#undef PG8_LDB
#undef PG8_MMA
#undef PG8_WAIT_V
#undef PG8_WAIT_L
#undef PG8_BAR
#undef PG8_SCHED
}

struct EpiBf16 {
    static constexpr bool PERM = true;
    bf16_t* O; int ldc;
    __device__ __forceinline__ void operator()(const f32x4 (&acc)[2][2][4][2], const Unit& u, int wr, int wc, int fr, int fq) const {
        const int row0 = u.pm * BM + wr * 64 + fr, col0 = u.pn * BM + wc * 32 + 8 * fq;
#pragma unroll
        for (int ai = 0; ai < 2; ++ai)
#pragma unroll
            for (int m = 0; m < 4; ++m) { bf16_t* rowp = O + (size_t)(row0 + ai * HALF + m * 16) * ldc + col0;
#pragma unroll
                for (int bj = 0; bj < 2; ++bj) { const f32x4 v0 = acc[ai][bj][m][0], v1 = acc[ai][bj][m][1];
                    u32x4 w; w.x = pk2(v0[0], v0[1]); w.y = pk2(v0[2], v0[3]); w.z = pk2(v1[0], v1[1]); w.w = pk2(v1[2], v1[3]);
                    *(u32x4*)(rowp + bj * HALF) = w; } }
    }
};
template <bool BASE_BF16, bool F32OUT> struct EpiRes {
    static constexpr bool PERM = false;
    const void* base; float* out; bf16_t* hb; const float* bias; float* ss;
    __device__ __forceinline__ void operator()(const f32x4 (&acc)[2][2][4][2], const Unit& u, int wr, int wc, int fr, int fq) const {
        const int col0 = u.pn * BM + wc * 32 + 4 * fq;
        f32x4 bv[2][2];
#pragma unroll
        for (int bj = 0; bj < 2; ++bj)
#pragma unroll
            for (int n = 0; n < 2; ++n) bv[bj][n] = bias ? *(const f32x4*)(bias + col0 + bj * HALF + n * 16) : (f32x4){0.f, 0.f, 0.f, 0.f};
#pragma unroll
        for (int ai = 0; ai < 2; ++ai)
#pragma unroll
            for (int m = 0; m < 4; ++m) { const int row = u.pm * BM + ai * HALF + wr * 64 + m * 16 + fr; const size_t off = (size_t)row * DM + col0; float s = 0.f;
#pragma unroll
                for (int bj = 0; bj < 2; ++bj)
#pragma unroll
                    for (int n = 0; n < 2; ++n) { const size_t o2 = off + bj * HALF + n * 16; f32x4 bs;
                        if (BASE_BF16) { const u32x2 w = *(const u32x2*)((const bf16_t*)base + o2); bs = (f32x4){bflo(w.x), bfhi(w.x), bflo(w.y), bfhi(w.y)}; } else bs = *(const f32x4*)((const float*)base + o2);
                        const f32x4 o = bs + acc[ai][bj][m][n] + bv[bj][n];
                        if (F32OUT) *(f32x4*)(out + o2) = o;
                        s += (o[0] * o[0] + o[1] * o[1]) + (o[2] * o[2] + o[3] * o[3]);
                        u32x2 w; w.x = pk2(o[0], o[1]); w.y = pk2(o[2], o[3]); *(u32x2*)(hb + o2) = w; }
                s += __shfl_xor(s, 16); s += __shfl_xor(s, 32);
                if (fq == 0) ss[(size_t)row * 16 + u.pn * 4 + wc] = s; }
    }
};
__device__ __forceinline__ float rstd_from_ss(const float* ss, int row) {
    const f32x4* p = (const f32x4*)(ss + (size_t)row * 16); const f32x4 a = p[0], b = p[1], c = p[2], d = p[3];
    const float t = ((a[0] + a[1]) + (a[2] + a[3])) + ((b[0] + b[1]) + (b[2] + b[3])) + ((c[0] + c[1]) + (c[2] + c[3])) + ((d[0] + d[1]) + (d[2] + d[3]));
    return __builtin_amdgcn_rsqf(t * (1.0f / DM) + EPS);
}
struct EpiSwiglu {
    static constexpr bool PERM = true;
    bf16_t* O; int ldc; const float* ss; const float* rstd;
    __device__ __forceinline__ void operator()(const f32x4 (&acc)[2][2][4][2], const Unit& u, int wr, int wc, int fr, int fq) const {
        const int row0 = u.pm * BM + wr * 64 + fr, col0 = u.pn * HALF + wc * 32 + 8 * fq;
#pragma unroll
        for (int ai = 0; ai < 2; ++ai)
#pragma unroll
            for (int m = 0; m < 4; ++m) { const int row = row0 + ai * HALF + m * 16; const float rs = ss ? rstd_from_ss(ss, row) : rstd[row];
                float h[8];
#pragma unroll
                for (int n = 0; n < 2; ++n)
#pragma unroll
                    for (int i = 0; i < 4; ++i) { const float gg = acc[ai][0][m][n][i] * rs, uu = acc[ai][1][m][n][i] * rs; h[n * 4 + i] = siluf_(gg) * uu; }
                *(u32x4*)(O + (size_t)row * ldc + col0) = pack8(h); }
    }
};
struct EpiQkv {
    static constexpr bool PERM = true;
    bf16_t* O; const float* ss; const float* bias; const float* qn; const float* kn; const float* rope;
    __device__ __forceinline__ void operator()(const f32x4 (&acc)[2][2][4][2], const Unit& u, int wr, int wc, int fr, int fq) const {
        const int hd = u.pn * 4 + wc, row0 = u.pm * BM + wr * 64 + fr; const int kind = u.pn < 4 ? 0 : (u.pn == 4 ? 1 : 2);
        const float* nw = kind == 0 ? qn : kn;
        float bv[2][8], nv[2][8];
#pragma unroll
        for (int bj = 0; bj < 2; ++bj)
#pragma unroll
            for (int j = 0; j < 8; ++j) { bv[bj][j] = bias[hd * 64 + bj * 32 + fq * 8 + j]; nv[bj][j] = nw[bj * 32 + fq * 8 + j]; }
#pragma unroll
        for (int ai = 0; ai < 2; ++ai)
#pragma unroll
            for (int m = 0; m < 4; ++m) { const int row = row0 + ai * HALF + m * 16; const float rs = rstd_from_ss(ss, row);
                float v[2][8]; float s = 0.f;
#pragma unroll
                for (int bj = 0; bj < 2; ++bj)
#pragma unroll
                    for (int n = 0; n < 2; ++n)
#pragma unroll
                        for (int i = 0; i < 4; ++i) { const float x = acc[ai][bj][m][n][i] * rs + bv[bj][n * 4 + i]; v[bj][n * 4 + i] = x; s += x * x; }
                if (kind < 2) {
                    s += __shfl_xor(s, 16); s += __shfl_xor(s, 32);
                    const float r2 = __builtin_amdgcn_rsqf(s * (1.0f / 64.0f) + EPS);
#pragma unroll
                    for (int bj = 0; bj < 2; ++bj)
#pragma unroll
                        for (int j = 0; j < 8; ++j) v[bj][j] = v[bj][j] * r2 * nv[bj][j];
                    const f32x4* rp = (const f32x4*)(rope + (size_t)row * 16);
                    const f32x4 c0 = rp[0], c1 = rp[1], s0 = rp[2], s1 = rp[3];
#pragma unroll
                    for (int j = 0; j < 8; ++j) { const float other = __shfl_xor(v[0][j], 16); const float cc = j < 4 ? c0[j] : c1[j - 4], sn = j < 4 ? s0[j] : s1[j - 4];
                        const float mine = v[0][j]; const float rot = (fq == 0) ? (mine * cc - other * sn) : (mine * cc + other * sn);
                        v[0][j] = (fq < 2) ? rot : mine; }
                }
#pragma unroll
                for (int bj = 0; bj < 2; ++bj) *(u32x4*)(O + (size_t)row * 1536 + hd * 64 + bj * 32 + fq * 8) = pack8(v[bj]);
            }
    }
};
}

#define XB_TMO      128
#define XB_XCNT(j)  (256  + 64 * (j))
#define XB_XSUB(j)  (1280 + 64 * (j))
#define XB_XGEN(j)  (2304 + 64 * (j))
#define XB_TOP      3328
#define XB_TOPGEN   3392
#define XCD_BAR_WORDS 3456
#define XB_SPIN_CAP (1u << 20)
__device__ __forceinline__ unsigned xb_ld(unsigned* p)              { return __hip_atomic_load(p, __ATOMIC_RELAXED, __HIP_MEMORY_SCOPE_AGENT); }
__device__ __forceinline__ unsigned xb_add(unsigned* p, unsigned v) { return __hip_atomic_fetch_add(p, v, __ATOMIC_RELAXED, __HIP_MEMORY_SCOPE_AGENT); }
__device__ __forceinline__ unsigned xb_xcc_id() { return (unsigned)__builtin_amdgcn_s_getreg((3 << 11) | 20) & 0xFu; }
#define XB_SPIN(cond, bar) do { unsigned _sp = 0; while (cond) { __builtin_amdgcn_s_sleep(1); \
    if ((++_sp & 255u) == 0u) { if (xb_ld(&(bar)[XB_TMO])) break; if (_sp > XB_SPIN_CAP) { atomicAdd(&(bar)[XB_TMO], 1u); break; } } } } while (0)
struct XcdBarrier { unsigned* bar; unsigned x; volatile LAS unsigned* st; };
__device__ __forceinline__ XcdBarrier xcd_barrier_post(unsigned* bar, volatile LAS unsigned* st) {
    XcdBarrier b; b.bar = bar; b.x = xb_xcc_id(); b.st = st;
    if (threadIdx.x == 0) (void)xb_add(&bar[XB_XCNT(b.x)], 1u);
    return b;
}
__device__ __forceinline__ void xcd_barrier_complete(unsigned* bar, unsigned x, unsigned& nloc, unsigned& nx) {
    const unsigned G = gridDim.x * gridDim.y * gridDim.z;
    unsigned sum, cnt, mine, sp = 0u;
    for (;;) {
        sum = 0u; cnt = 0u; mine = 0u;
#pragma unroll
        for (unsigned j = 0; j < 16; ++j) { const unsigned c = xb_ld(&bar[XB_XCNT(j)]); sum += c; cnt += (c > 0u) ? 1u : 0u; mine = (j == x) ? c : mine; }
        if (sum == G) break;
        __builtin_amdgcn_s_sleep(1);
        if ((++sp & 255u) == 0u) { if (xb_ld(&bar[XB_TMO])) break; if (sp > XB_SPIN_CAP) { atomicAdd(&bar[XB_TMO], 1u); break; } }
    }
    nloc = mine > 0u ? mine : 1u; nx = cnt > 0u ? cnt : 1u;
}
__device__ __forceinline__ void xcd_barrier(const XcdBarrier& b) {
    asm volatile("s_waitcnt vmcnt(0)" ::: "memory");
    __syncthreads();
    if (threadIdx.x == 0) {
        unsigned* bar = b.bar;
        __builtin_amdgcn_s_waitcnt(0);
        unsigned nloc = b.st[0], nx = b.st[1];
        if (nloc == 0u) { xcd_barrier_complete(bar, b.x, nloc, nx); b.st[0] = nloc; b.st[1] = nx; }
        const unsigned old = xb_add(&bar[XB_XSUB(b.x)], 1u);
        const unsigned gen = old / nloc;
        if (old + 1u == (gen + 1u) * nloc) {
            __builtin_amdgcn_fence(__ATOMIC_RELEASE, "agent");
            asm volatile("s_waitcnt vmcnt(0)" ::: "memory");
            const unsigned og = xb_add(&bar[XB_TOP], 1u);
            const unsigned tg = og / nx;
            if (og + 1u == (tg + 1u) * nx) xb_add(&bar[XB_TOPGEN], 1u);
            else XB_SPIN(xb_ld(&bar[XB_TOPGEN]) == tg, bar);
            __builtin_amdgcn_fence(__ATOMIC_ACQUIRE, "agent");
            xb_add(&bar[XB_XGEN(b.x)], 1u);
            asm volatile("s_waitcnt vmcnt(0)" ::: "memory");
        } else {
            XB_SPIN(xb_ld(&bar[XB_XGEN(b.x)]) == gen, bar);
            __builtin_amdgcn_fence(__ATOMIC_ACQUIRE, "agent");
            asm volatile("s_waitcnt vmcnt(0)" ::: "memory");
        }
    }
    __syncthreads();
}

struct Args { const float* in[39]; const int* pos; float* out; unsigned char* ws; int ph_lo, ph_hi, variant, pad; };
enum InIdx { I_X = 0, I_NORM_MIX0 = 1, I_W_IN, I_MU, I_W0, I_WDEC, I_A0, I_WICL, I_WGAT, I_KK, I_KA, I_RK, I_GNW, I_GNB, I_CONVW, I_CONVB, I_DTB, I_ALOG, I_DSKIP, I_SSDN,
             I_WOUT, I_NORM_FFN0, I_FG, I_FU, I_FD, I_NORM_MIX1, I_WQKV, I_BQKV, I_QN, I_KN, I_SINK, I_WO, I_BO, I_NORM_FFN1, I_ROUTER, I_EG, I_EU, I_ED };

__device__ __forceinline__ void transpose_item(const float* W, int ld, int K, int k0, int n0, bf16_t* WT, int drow, LAS float* scr, int lane, const float* gk) {
    float v[32]; const float* wp = W + (size_t)(k0 + (lane >> 5)) * ld + n0 + (lane & 31);
#pragma unroll
    for (int i = 0; i < 32; ++i) v[i] = wp[(size_t)(2 * i) * ld];
    if (gk) { const float* gp = gk + k0 + (lane >> 5);
#pragma unroll
        for (int i = 0; i < 32; ++i) v[i] *= gp[2 * i]; }
#pragma unroll
    for (int i = 0; i < 32; ++i) scr[(2 * i + (lane >> 5)) * 33 + (lane & 31)] = v[i];
    asm volatile("s_waitcnt lgkmcnt(0)" ::: "memory");
    const int c = lane & 7;
#pragma unroll
    for (int j = 0; j < 4; ++j) { const int n = (lane >> 3) + 8 * j; const LAS float* s = scr + (8 * c) * 33 + n;
        u32x4 o; o.x = pk2(s[0 * 33], s[1 * 33]); o.y = pk2(s[2 * 33], s[3 * 33]); o.z = pk2(s[4 * 33], s[5 * 33]); o.w = pk2(s[6 * 33], s[7 * 33]);
        *(u32x4*)(WT + (size_t)(drow + n) * K + k0 + 8 * c) = o; }
    asm volatile("s_waitcnt lgkmcnt(0)" ::: "memory");
}
__device__ __forceinline__ int drow_of(int kind, int n0) {
    if (kind == 0) return n0;
    if (kind == 1) return 256 * (n0 >> 7) + (n0 & 127);
    if (kind == 2) return 256 * (n0 >> 7) + 128 + (n0 & 127);
    const int hd = n0 >> 6, bj = (n0 >> 5) & 1; return 256 * (hd >> 2) + 128 * bj + 32 * (hd & 3);
}
__device__ __forceinline__ bool transpose_matrix(int& it, const float* W, int ld, int K, int ncols, bf16_t* WT, int kind, LAS float* scr, int lane, const float* gk = nullptr) {
    const int nnb = ncols / 32, items = (K / 64) * nnb;
    if (it < items) { const int kb = it / nnb, nb = it % nnb; transpose_item(W, ld, K, 64 * kb, 32 * nb, WT, drow_of(kind, 32 * nb), scr, lane, gk); return true; }
    it -= items; return false;
}

#ifndef DUPM
#define DUPM 0u
#endif

#define XN ((bf16_t*)(ws + WS_XN))
#define MIX ((bf16_t*)(ws + WS_MIX))
#define PROJ ((bf16_t*)(ws + WS_PROJ))
#define GOUT ((bf16_t*)(ws + WS_GOUT))
#define XNB ((bf16_t*)(ws + WS_XNB))
#define HID ((bf16_t*)(ws + WS_HID))
#define QKV ((bf16_t*)(ws + WS_QKV))
#define ATTO ((bf16_t*)(ws + WS_ATTO))
#define AS ((bf16_t*)(ws + WS_AS))
#define HS ((bf16_t*)(ws + WS_HS))
#define XBCC ((bf16_t*)(ws + WS_EGU))
#define SSTATE ((bf16_t*)(ws + 38 * MiB))
#define CHDEC ((float*)(ws + WS_TOPE))
#define DTSP ((float*)(ws + WS_DTSP))
#define KKR ((float*)(ws + WS_KKR))
#define ROPE ((float*)(ws + WS_ROPE))
#define SS ((float*)(ws + WS_SS))
#define TOPE ((int*)(ws + WS_TOPE))
#define RANK ((int*)(ws + WS_RANK))
#define TOPW ((float*)(ws + WS_TOPW))
#define POS ((int*)(ws + WS_POS))
#define RSTD4 ((float*)(ws + WS_RSTD4))
#define RSTDS ((float*)(ws + WS_RSTDS))
#define WDEC ((bf16_t*)(ws + WS_WDEC))
#define WICL ((bf16_t*)(ws + WS_WICL))
#define WGAT ((bf16_t*)(ws + WS_WGAT))
#define EGU ((bf16_t*)(ws + WS_EGU))
#define EDN ((bf16_t*)(ws + WS_EDN))
#define WIN ((bf16_t*)(ws + WS_WIN))
#define WOUT ((bf16_t*)(ws + WS_WOUT))
#define WGU ((bf16_t*)(ws + WS_WGU))
#define WDN ((bf16_t*)(ws + WS_WDN))
#define WQKV ((bf16_t*)(ws + WS_WQKV))
#define WO ((bf16_t*)(ws + WS_WO))
__global__ void __launch_bounds__(512, 2) fwd_kernel(Args args) {
    extern __shared__ __attribute__((aligned(16))) unsigned char lds_raw[];
    LAS unsigned char* lds = (LAS unsigned char*)lds_raw;
    volatile LAS unsigned* MISC = (volatile LAS unsigned*)(lds + MISC_OFF);
    const int tid = threadIdx.x, lane = tid & 63, wave = __builtin_amdgcn_readfirstlane(tid >> 6);
    const int G = gridDim.x, bx = blockIdx.x;
    const int vcu = (G % 8 == 0) ? (bx % 8) * (G / 8) + bx / 8 : bx;
    unsigned char* ws = args.ws;
    unsigned* ctl = (unsigned*)(ws + WS_CTL);
    float* dout = args.out;
    if (tid < 32) ((LAS unsigned*)(lds + MISC_OFF))[tid] = 0u;
    __syncthreads();
    XcdBarrier bar = xcd_barrier_post(ctl + CW_BAR, MISC + 8);
    const int lo = args.ph_lo, hi = args.ph_hi;
#define IN(k) (lo <= (k) && (k) < hi)
#if DUPM
#define PHASE(k) for (int rep_ = 0; rep_ <= (int)((DUPM >> (k)) & 1u); ++rep_) if (IN(k))
#define REPBAR if (rep_) xcd_barrier(bar);
#else
#define PHASE(k) if (IN(k))
#define REPBAR
#endif
#define SEAM(k) do { if (IN(k) && IN((k) + 1)) xcd_barrier(bar); } while (0)
    const int gw = vcu * 8 + wave, NGW = G * 8;

    unsigned* CNT = ctl + CW_CNT;

    PHASE(0) { REPBAR
        LAS float* scr = (LAS float*)(lds + wave * 16384);
        for (int it0 = gw; ; it0 += NGW) {
            int it = it0;
            if (transpose_matrix(it, args.in[I_W_IN], IN0, DM, NPROJ, WIN, 0, scr, lane)) continue;
            if (transpose_matrix(it, args.in[I_WDEC], 512, 64, 512, WDEC, 0, scr, lane)) continue;
            if (transpose_matrix(it, args.in[I_WICL], 512, 64, 512, WICL, 0, scr, lane)) continue;
            if (transpose_matrix(it, args.in[I_WGAT], 512, 128, 512, WGAT, 0, scr, lane)) continue;
            break;
        }
        __syncthreads();
        LAS float* w8 = (LAS float*)lds;
        for (int r = tid; r < DM; r += 512) { const float* p = args.in[I_W_IN] + (size_t)r * IN0 + NPROJ; *(LAS f32x4*)(w8 + r * 8) = *(const f32x4*)p; *(LAS f32x4*)(w8 + r * 8 + 4) = *(const f32x4*)(p + 4); }
        __syncthreads();
        const float* gm = args.in[I_NORM_MIX0];
        for (int m = gw; m < MTOK; m += NGW) {
            const f32x4* xr = (const f32x4*)(args.in[I_X] + (size_t)m * DM) + lane;
            f32x4 v[4]; float s = 0.f;
#pragma unroll
            for (int j = 0; j < 4; ++j) { v[j] = xr[64 * j]; s += (v[j][0] * v[j][0] + v[j][1] * v[j][1]) + (v[j][2] * v[j][2] + v[j][3] * v[j][3]); }
            const float rstd = __builtin_amdgcn_rsqf(wave_sum(s) * (1.0f / DM) + EPS);
            float d[8];
#pragma unroll
            for (int k = 0; k < 8; ++k) d[k] = 0.f;
            unsigned long long* o8 = (unsigned long long*)(XN + (size_t)m * DM) + lane;
#pragma unroll
            for (int j = 0; j < 4; ++j) { const f32x4 g4 = ((const f32x4*)gm)[64 * j + lane]; const f32x4 y = v[j] * rstd * g4;
                o8[64 * j] = (unsigned long long)pk2(y[0], y[1]) | ((unsigned long long)pk2(y[2], y[3]) << 32);
#pragma unroll
                for (int i = 0; i < 4; ++i) { const int c = 256 * j + 4 * lane + i; const f32x4 wa = *(const LAS f32x4*)(w8 + c * 8), wb = *(const LAS f32x4*)(w8 + c * 8 + 4);
                    d[0] += y[i] * wa[0]; d[1] += y[i] * wa[1]; d[2] += y[i] * wa[2]; d[3] += y[i] * wa[3]; d[4] += y[i] * wb[0]; d[5] += y[i] * wb[1]; d[6] += y[i] * wb[2]; d[7] += y[i] * wb[3]; } }
            wave_sum8(d);
            if (lane < 8) { float dv = d[0];
#pragma unroll
                for (int k = 1; k < 8; ++k) dv = (lane == k) ? d[k] : dv;
                const float z = dv + args.in[I_DTB][lane]; DTSP[(size_t)m * 8 + lane] = z > 20.f ? z : log1pf(__expf(z)); }
            if (lane >= 16 && lane < 24) { const int j = lane - 16; const double inv = exp(-(double)j * 0.125 * 13.122363377404328); const double ang = (double)args.pos[m] * inv;
                ROPE[(size_t)m * 16 + j] = (float)cos(ang); ROPE[(size_t)m * 16 + 8 + j] = (float)sin(ang); }
        }
        __syncthreads();
    }
    SEAM(0);

    PHASE(1) { REPBAR
        pg8::Gemm g{XN, WIN, MTOK, NPROJ, DM}; pg8::StaticOrder S; S.init(MTOK, NPROJ, G, bx);
        pg8::EpiBf16 E{PROJ, NPROJ};
        pg8::gemm_phase(lds, g, S, E);
    }
    SEAM(1);

    const int r32 = lane & 31, hh = lane >> 5, trq = (lane & 15) >> 2, trc = 16 * ((lane >> 4) & 1) + 4 * (lane & 3);
#define TRF(M, P, s, blk) ({ const LAS bf16_t* p_ = (M) + (16 * (s) + 8 * hh + trq) * (P) + 32 * (blk) + trc; \
        const s16x4 lo_ = __builtin_bit_cast(s16x4, __builtin_amdgcn_ds_read_tr16_b64_v4i16((LAS s16x4*)p_)); \
        const s16x4 hi_ = __builtin_bit_cast(s16x4, __builtin_amdgcn_ds_read_tr16_b64_v4i16((LAS s16x4*)(p_ + 4 * (P)))); \
        (bf16x8){lo_[0], lo_[1], lo_[2], lo_[3], hi_[0], hi_[1], hi_[2], hi_[3]}; })
#define NATF(M, P, s, blk) (*(const LAS bf16x8*)((M) + (32 * (blk) + r32) * (P) + 16 * (s) + 8 * hh))
    PHASE(2) { REPBAR
        const float* mu = args.in[I_MU];
        LAS bf16_t* Aw = (LAS bf16_t*)lds; LAS bf16_t* Aa = (LAS bf16_t*)(lds + 9216); LAS bf16_t* Ag = (LAS bf16_t*)(lds + 18432);
        LAS float* LW = (LAS float*)(lds + 35840); LAS float* IC = LW + 4096;
        LAS bf16_t* At = (LAS bf16_t*)(lds + 68864); LAS bf16_t* Kt = At + 4608; LAS bf16_t* Bt = Kt + 4608; LAS bf16_t* Rt = Bt + 4608; LAS bf16_t* Vt = Rt + 4608;
        LAS bf16_t* Lab = (LAS bf16_t*)(lds + 35840);
        LAS bf16_t* XX = At;
        LAS bf16_t* Lak = (LAS bf16_t*)(lds + 114944); LAS bf16_t* Mrk = Lak + 4608; LAS bf16_t* Mrb = Mrk + 4608;
        LAS float* TOT = (LAS float*)(lds + 142592); LAS float* GAMC = TOT + 512;
        const int mt = (wave >> 1) & 1, nt = wave & 1, grp = wave >> 2;
        for (int unit = vcu; unit < MTOK / 64; unit += G) {
            const int m0 = unit * 64;
            {
                const int tt = tid >> 3, cg = tid & 7, m = m0 + tt; const bool hasprev = (m & (SEQ - 1)) != 0;
                const bf16_t* pc = PROJ + (size_t)m * NPROJ + 1536 + 32 * cg;
#pragma unroll 1
                for (int q = 0; q < 4; ++q) {
                    float c[8], p[8]; unpack8(*(const u32x4*)(pc + 8 * q), c);
                    if (hasprev) unpack8(*(const u32x4*)(pc - NPROJ + 8 * q), p); else { for (int i = 0; i < 8; ++i) p[i] = 0.f; }
                    float o[8];
#pragma unroll
                    for (int i = 0; i < 8; ++i) { const int col = 32 * cg + 8 * q + i; const float x = c[i] + (p[i] - c[i]) * mu[1536 + col];
                        o[i] = cg < 2 ? tanhf(x) : (cg < 4 ? x : sigmoidf_(x)); }
                    const u32x4 w = pack8(o); const int col0 = 32 * cg + 8 * q;
                    if (cg < 2) *(LAS u32x4*)(Aw + tt * 72 + col0) = w; else if (cg < 4) *(LAS u32x4*)(Aa + tt * 72 + (col0 - 64)) = w; else *(LAS u32x4*)(Ag + tt * 136 + (col0 - 128)) = w;
                }
            }
            LBAR();
#pragma unroll 1
            for (int h = 0; h < 8; ++h) {
                unsigned char* cs = (unsigned char*)dout + (size_t)(unit * 8 + h) * 24576;
                float r0v[8], k0v[8], v0v[8]; float pr = 0.f, pk = 0.f, pv = 0.f;
                {   const bf16_t* pp = PROJ + (size_t)(m0 + 8 * wave) * NPROJ + 64 * h + lane;
                    if (((m0 + 8 * wave) & (SEQ - 1)) != 0) { pr = bflo(pp[-NPROJ]); pk = bflo(pp[-NPROJ + 512]); pv = bflo(pp[-NPROJ + 1024]); }
#pragma unroll
                    for (int i = 0; i < 8; ++i) { r0v[i] = bflo(pp[(size_t)i * NPROJ]); k0v[i] = bflo(pp[(size_t)i * NPROJ + 512]); v0v[i] = bflo(pp[(size_t)i * NPROJ + 1024]); } }
                if (grp == 0) {
                    f32x16 ad, ai;
#pragma unroll
                    for (int r = 0; r < 16; ++r) { ad[r] = 0.f; ai[r] = 0.f; }
#pragma unroll
                    for (int s = 0; s < 4; ++s) {
                        const bf16x8 bd = *(const bf16x8*)(WDEC + (size_t)(64 * h + 32 * nt + r32) * 64 + 16 * s + 8 * hh), bi = *(const bf16x8*)(WICL + (size_t)(64 * h + 32 * nt + r32) * 64 + 16 * s + 8 * hh);
                        ad = __builtin_amdgcn_mfma_f32_32x32x16_bf16(NATF(Aw, 72, s, mt), bd, ad, 0, 0, 0);
                        ai = __builtin_amdgcn_mfma_f32_32x32x16_bf16(NATF(Aa, 72, s, mt), bi, ai, 0, 0, 0);
                    }
                    const int c = 32 * nt + r32; const float w0c = args.in[I_W0][64 * h + c], a0c = args.in[I_A0][64 * h + c];
                    LAS float* lwb = LW + (32 * mt + 4 * hh) * 64 + c;
#pragma unroll
                    for (int r = 0; r < 16; ++r) { lwb[crc(r) * 64] = -0.6065306597126334f * sigmoidf_(ad[r] + w0c); lwb[4096 + crc(r) * 64] = sigmoidf_(ai[r] + a0c); }
                } else {
                    f32x16 ag;
#pragma unroll
                    for (int r = 0; r < 16; ++r) ag[r] = 0.f;
#pragma unroll
                    for (int s = 0; s < 8; ++s) {
                        const bf16x8 bg = *(const bf16x8*)(WGAT + (size_t)(64 * h + 32 * nt + r32) * 128 + 16 * s + 8 * hh);
                        ag = __builtin_amdgcn_mfma_f32_32x32x16_bf16(NATF(Ag, 136, s, mt), bg, ag, 0, 0, 0);
                    }
                    bf16_t* gob = GOUT + (size_t)(m0 + 32 * mt + 4 * hh) * 512 + 64 * h + 32 * nt + r32;
#pragma unroll
                    for (int r = 0; r < 16; ++r) gob[crc(r) * 512] = (bf16_t)f2bf(ag[r]);
                }
                LBAR();
                {
                    const int c = lane, gc = 64 * h + c, t0 = 8 * wave;
                    const float mur = mu[gc], muk = mu[512 + gc], muv = mu[1024 + gc], kkc = args.in[I_KK][gc], kac = args.in[I_KA][gc], rkc = args.in[I_RK][gc];
                    float rr[8], kx[8], vv[8], an[8], bn[8], lw[8], cl[8]; float run = 0.f;
#pragma unroll
                    for (int i = 0; i < 8; ++i) {
                        const float r0 = r0v[i], k0 = k0v[i], v0 = v0v[i];
                        rr[i] = r0 + (pr - r0) * mur; const float kl = k0 + (pk - k0) * muk; vv[i] = v0 + (pv - v0) * muv; pr = r0; pk = k0; pv = v0;
                        const float ic = IC[(t0 + i) * 64 + c]; lw[i] = LW[(t0 + i) * 64 + c]; run += lw[i]; cl[i] = run;
                        const float xk = kl * kkc; const float ssq = dpp_sum63(xk * xk); const float kn = xk * __builtin_amdgcn_rsqf(ssq + 1e-12f);
                        an[i] = -kn; bn[i] = kn * ic; kx[i] = kl * (1.0f + (ic - 1.0f) * kac);
                        const float bon = dpp_sum63(rr[i] * kx[i] * rkc);
                        if (lane == 0) KKR[(size_t)(m0 + t0 + i) * 8 + h] = bon;
                    }
                    TOT[wave * 64 + c] = run;
                    LBAR();
                    float off = 0.f, totc = 0.f;
#pragma unroll
                    for (int w2 = 0; w2 < 8; ++w2) { const float tv = TOT[w2 * 64 + c]; totc += tv; off += (w2 < wave) ? tv : 0.f; }
                    if (wave == 0) GAMC[c] = __expf(totc);
#pragma unroll
                    for (int i = 0; i < 8; ++i) { const float cum = off + cl[i]; const float en = __expf(-cum), ep = __expf(cum), em = __expf(cum - lw[i]); const int o = (t0 + i) * 72 + c;
                        At[o] = (bf16_t)f2bf(an[i] * em); Kt[o] = (bf16_t)f2bf(kx[i] * en); Bt[o] = (bf16_t)f2bf(bn[i] * en); Rt[o] = (bf16_t)f2bf(rr[i] * ep); Vt[o] = (bf16_t)f2bf(vv[i]); }
                }
                LBAR();
                {
                    f32x16 pb, pk2_;
#pragma unroll
                    for (int r = 0; r < 16; ++r) { pb[r] = 0.f; pk2_[r] = 0.f; }
                    const LAS bf16_t* Aop = grp == 0 ? At : Rt;
#pragma unroll
                    for (int s = 0; s < 4; ++s) { const bf16x8 a = NATF(Aop, 72, s, mt);
                        pb = __builtin_amdgcn_mfma_f32_32x32x16_bf16(a, NATF(Bt, 72, s, nt), pb, 0, 0, 0);
                        pk2_ = __builtin_amdgcn_mfma_f32_32x32x16_bf16(a, NATF(Kt, 72, s, nt), pk2_, 0, 0, 0); }
                    const int sc = 32 * nt + r32, tb = 32 * mt + 4 * hh;
                    LAS bf16_t* o1 = (grp == 0 ? Lab : Mrb) + tb * 72 + sc; LAS bf16_t* o2 = (grp == 0 ? Lak : Mrk) + tb * 72 + sc;
#pragma unroll
                    for (int r = 0; r < 16; ++r) { const int t = tb + crc(r); const bool keep = grp == 0 ? (sc < t) : (sc <= t);
                        o1[crc(r) * 72] = (bf16_t)f2bf(keep ? pb[r] : 0.f); o2[crc(r) * 72] = (bf16_t)f2bf(keep ? pk2_[r] : 0.f); }
                }
                LBAR();
                f32x16 accA, accB;
#pragma unroll
                for (int r = 0; r < 16; ++r) { accA[r] = 0.f; accB[r] = 0.f; }
                {
                    const LAS bf16_t* Aop = grp == 0 ? Lak : Mrk;
#pragma unroll
                    for (int s = 0; s < 4; ++s) { const bf16x8 vb = TRF(Vt, 72, s, nt);
                        if (grp == 0) { accA = __builtin_amdgcn_mfma_f32_32x32x16_bf16(NATF(Aop, 72, s, mt), vb, accA, 0, 0, 0); accB = __builtin_amdgcn_mfma_f32_32x32x16_bf16(TRF(Kt, 72, s, mt), vb, accB, 0, 0, 0); }
                        else accB = __builtin_amdgcn_mfma_f32_32x32x16_bf16(NATF(Aop, 72, s, mt), vb, accB, 0, 0, 0); }
                    if (grp == 0) { LAS float* ggb = IC + (32 * mt + 4 * hh) * 65 + 32 * nt + r32;
#pragma unroll
                        for (int r = 0; r < 16; ++r) ggb[crc(r) * 65] = accA[r]; }
                }
                LBAR();
                {
                    const int n16 = lane & 15, g4 = lane >> 4;
                    f32x4 Rr[4];
                    if (wave < 4) {
#pragma unroll
                        for (int I = 0; I < 4; ++I)
#pragma unroll
                            for (int j = 0; j < 4; ++j) Rr[I][j] = bflo((unsigned)At[(16 * I + 4 * g4 + j) * 72 + 16 * wave + n16]);
                    } else { const LAS float* GG = IC;
#pragma unroll
                        for (int I = 0; I < 4; ++I)
#pragma unroll
                            for (int j = 0; j < 4; ++j) Rr[I][j] = GG[(16 * I + 4 * g4 + j) * 65 + 16 * (wave - 4) + n16];
                    }
                    LBAR();
                    const LAS bf16_t* lrow = Lab + n16 * 72 + 4 * g4;
#define LF(I, J) (*(const LAS u32x2*)(lrow + (16 * (I)) * 72 + 16 * (J)))
#define MF16(A0, A1, B0, B1, C) __builtin_amdgcn_mfma_f32_16x16x32_bf16(__builtin_bit_cast(bf16x8, (u32x4){(A0).x, (A0).y, (A1).x, (A1).y}), __builtin_bit_cast(bf16x8, (u32x4){(B0).x, (B0).y, (B1).x, (B1).y}), (C), 0, 0, 0)
                    const u32x2 zz = (u32x2){0u, 0u};
                    u32x2 Xb[4];
#pragma unroll
                    for (int I = 0; I < 4; ++I) {
                        f32x4 Z = Rr[I];
                        if (I == 1) Z = MF16(LF(1, 0), zz, Xb[0], zz, Z);
                        if (I == 2) Z = MF16(LF(2, 0), LF(2, 1), Xb[0], Xb[1], Z);
                        if (I == 3) { Z = MF16(LF(3, 0), LF(3, 1), Xb[0], Xb[1], Z); Z = MF16(LF(3, 2), zz, Xb[2], zz, Z); }
                        const u32x2 ld = LF(I, I);
                        f32x4 X = Z;
#pragma unroll
                        for (int it = 0; it < 15; ++it) { u32x2 xb; xb.x = pk2(X[0], X[1]); xb.y = pk2(X[2], X[3]); X = MF16(ld, zz, xb, zz, Z); }
                        Xb[I].x = pk2(X[0], X[1]); Xb[I].y = pk2(X[2], X[3]);
                        LAS bf16_t* xo = XX + (16 * I + 4 * g4) * 136 + 16 * wave + n16;
                        xo[0] = (bf16_t)(Xb[I].x & 0xffffu); xo[136] = (bf16_t)(Xb[I].x >> 16); xo[272] = (bf16_t)(Xb[I].y & 0xffffu); xo[408] = (bf16_t)(Xb[I].y >> 16);
                    }
#undef LF
#undef MF16
                }
                LBAR();
                {
                    f32x16 acc1;
#pragma unroll
                    for (int r = 0; r < 16; ++r) acc1[r] = 0.f;
#pragma unroll
                    for (int s = 0; s < 4; ++s) {
                        const bf16x8 a = grp == 0 ? TRF(Bt, 72, s, mt) : NATF(Mrb, 72, s, mt);
                        acc1 = __builtin_amdgcn_mfma_f32_32x32x16_bf16(a, TRF(XX, 136, s, nt), acc1, 0, 0, 0);
                        accB = __builtin_amdgcn_mfma_f32_32x32x16_bf16(a, TRF(XX + 64, 136, s, nt), accB, 0, 0, 0);
                    }
                    const int col = 32 * nt + r32, rb = 32 * mt + 4 * hh;
                    if (grp == 0) {
                        bf16_t* acb = (bf16_t*)cs + rb * 64 + col; bf16_t* dcb = (bf16_t*)(cs + 8192) + col * 64 + rb; const LAS float* gb = GAMC + rb;
#pragma unroll
                        for (int r = 0; r < 16; ++r) { const float gcv = gb[crc(r)]; acb[crc(r) * 64] = (bf16_t)f2bf(gcv * (acc1[r] + ((rb + crc(r)) == col ? 1.0f : 0.0f))); }
#pragma unroll
                        for (int rq = 0; rq < 4; ++rq) { const f32x4 g4 = *(const LAS f32x4*)(gb + 8 * rq);
                            u32x2 w; w.x = pk2(accB[4 * rq] * g4[0], accB[4 * rq + 1] * g4[1]); w.y = pk2(accB[4 * rq + 2] * g4[2], accB[4 * rq + 3] * g4[3]); *(u32x2*)(dcb + 8 * rq) = w; }
                    } else {
                        bf16_t* rpb = (bf16_t*)(cs + 16384) + rb * 64 + col; const LAS bf16_t* rtb = Rt + rb * 72 + col; bf16_t* yb = MIX + (size_t)(m0 + rb) * DM + 64 * h + col;
#pragma unroll
                        for (int r = 0; r < 16; ++r) { rpb[crc(r) * 64] = (bf16_t)f2bf(acc1[r] + bflo((unsigned)rtb[crc(r) * 72])); yb[crc(r) * DM] = (bf16_t)f2bf(accB[r]); }
                    }
                }
                LBAR();
            }
        }
        for (int unit = vcu; unit < MTOK / 64; unit += G) {
            const int m0 = unit * 64;
            {
                const int cgp = tid & 127, ts = tid >> 7, c0 = 8 * cgp; const float* cw = args.in[I_CONVW]; const float* cb = args.in[I_CONVB];
                float w[4][8], bb[8];
#pragma unroll
                for (int j = 0; j < 4; ++j)
#pragma unroll
                    for (int i = 0; i < 8; ++i) w[j][i] = cw[j * 1024 + c0 + i];
#pragma unroll
                for (int i = 0; i < 8; ++i) bb[i] = cb[c0 + i];
                float x0[8], x1[8], x2[8], x3[8];
                const int mstart = m0 + 16 * ts; const int tpos = mstart & (SEQ - 1);
                const bf16_t* srcp = PROJ + (size_t)mstart * NPROJ + 2304 + c0;
#pragma unroll
                for (int i = 0; i < 8; ++i) { x0[i] = 0.f; x1[i] = 0.f; x2[i] = 0.f; }
                if (tpos >= 3) unpack8(*(const u32x4*)(srcp - 3 * (size_t)NPROJ), x0);
                if (tpos >= 2) unpack8(*(const u32x4*)(srcp - 2 * (size_t)NPROJ), x1);
                if (tpos >= 1) unpack8(*(const u32x4*)(srcp - 1 * (size_t)NPROJ), x2);
                for (int t = 0; t < 16; ++t) {
                    unpack8(*(const u32x4*)(srcp + (size_t)t * NPROJ), x3);
                    float o[8];
#pragma unroll
                    for (int i = 0; i < 8; ++i) { const float y = bb[i] + w[0][i] * x0[i] + w[1][i] * x1[i] + w[2][i] * x2[i] + w[3][i] * x3[i]; o[i] = siluf_(y); x0[i] = x1[i]; x1[i] = x2[i]; x2[i] = x3[i]; }
                    *(u32x4*)(XBCC + (size_t)(mstart + t) * 1024 + c0) = pack8(o);
                }
            }
        }
    }

    SEAM(2);

    PHASE(3) { REPBAR
        if (vcu < 32) {
            const int b = vcu >> 3, h = vcu & 7;
            const unsigned char* cbase = (const unsigned char*)dout + (size_t)(b * 64 * 8 + h) * 24576;
            constexpr size_t CSTR = (size_t)8 * 24576; constexpr int SLOT = 27648;
            const bool loader = wave >= 2; const int lt = tid - 128;
            int poff[4];
#pragma unroll
            for (int k = 0; k < 4; ++k) { const int p = lt + 384 * k; poff[k] = (p >> 9) * 9216 + ((p & 511) >> 3) * 144 + (p & 7) * 16; }
            u32x4 st[4][4];
#define RB_ISSUE(set, ch) do { if (loader) { const unsigned char* g_ = cbase + (size_t)(ch) * CSTR + (size_t)lt * 16; _Pragma("unroll") for (int k = 0; k < 4; ++k) st[set][k] = *(const u32x4*)(g_ + k * 6144); } } while (0)
#define RB_WRITE(set, ch) do { if (loader) { LAS unsigned char* s_ = lds + ((ch) & 3) * SLOT; _Pragma("unroll") for (int k = 0; k < 4; ++k) *(LAS u32x4*)(s_ + poff[k]) = st[set][k]; } } while (0)
            RB_ISSUE(0, 0); RB_ISSUE(1, 1); RB_WRITE(0, 0); RB_WRITE(1, 1);
            RB_ISSUE(2, 2); RB_ISSUE(3, 3); RB_ISSUE(0, 4); RB_ISSUE(1, 5);
            LBAR();
            f32x16 H[2];
#pragma unroll
            for (int r = 0; r < 16; ++r) { H[0][r] = 0.f; H[1][r] = 0.f; }
            bf16_t* zp = (bf16_t*)((unsigned char*)dout + 48 * MiB) + (size_t)(b * SEQ + 4 * hh) * 512 + 64 * h + 32 * wave + r32;
#define RB_STEP(j, chv) do { const int ch_ = (chv); \
                if (loader) { if (ch_ + 2 < 64) RB_WRITE(((j) + 2) & 3, ch_ + 2); if (ch_ + 6 < 64) RB_ISSUE(((j) + 2) & 3, ch_ + 6); } \
                else { const LAS unsigned char* sl = lds + (ch_ & 3) * SLOT; f32x16 Hn[2], Z[2]; bf16x8 Hb[4]; \
                    _Pragma("unroll") for (int s = 0; s < 4; ++s) { const int m = s >> 1, o = 8 * (s & 1); u32x4 t; t.x = pk2(H[m][o], H[m][o + 1]); t.y = pk2(H[m][o + 2], H[m][o + 3]); t.z = pk2(H[m][o + 4], H[m][o + 5]); t.w = pk2(H[m][o + 6], H[m][o + 7]); Hb[s] = __builtin_bit_cast(bf16x8, t); } \
                    _Pragma("unroll") for (int m = 0; m < 2; ++m) { \
                        _Pragma("unroll") for (int rq = 0; rq < 4; ++rq) { const u32x2 d = *(const LAS u32x2*)(sl + 9216 + (32 * wave + r32) * 144 + (32 * m + 8 * rq + 4 * hh) * 2); \
                            Hn[m][4 * rq] = bflo(d.x); Hn[m][4 * rq + 1] = bfhi(d.x); Hn[m][4 * rq + 2] = bflo(d.y); Hn[m][4 * rq + 3] = bfhi(d.y); } \
                        _Pragma("unroll") for (int r = 0; r < 16; ++r) Z[m][r] = 0.f; } \
                    _Pragma("unroll") for (int s = 0; s < 4; ++s) \
                        _Pragma("unroll") for (int m = 0; m < 2; ++m) { const int o = (32 * m + r32) * 144 + (16 * s + 4 * hh) * 2; \
                            const u32x2 a0 = *(const LAS u32x2*)(sl + o), a1 = *(const LAS u32x2*)(sl + o + 16), q0 = *(const LAS u32x2*)(sl + 18432 + o), q1 = *(const LAS u32x2*)(sl + 18432 + o + 16); \
                            u32x4 t; t.x = a0.x; t.y = a0.y; t.z = a1.x; t.w = a1.y; Hn[m] = __builtin_amdgcn_mfma_f32_32x32x16_bf16(__builtin_bit_cast(bf16x8, t), Hb[s], Hn[m], 0, 0, 0); \
                            t.x = q0.x; t.y = q0.y; t.z = q1.x; t.w = q1.y; Z[m] = __builtin_amdgcn_mfma_f32_32x32x16_bf16(__builtin_bit_cast(bf16x8, t), Hb[s], Z[m], 0, 0, 0); } \
                    H[0] = Hn[0]; H[1] = Hn[1]; \
                    bf16_t* zq = zp + (size_t)ch_ * 64 * 512; \
                    _Pragma("unroll") for (int m = 0; m < 2; ++m) _Pragma("unroll") for (int r = 0; r < 16; ++r) zq[(32 * m + crc(r)) * 512] = (bf16_t)f2bf(Z[m][r]); } \
                LBAR(); } while (0)
            if (wave < 2 || loader) {
                for (int ch = 0; ch < 64; ch += 4) { RB_STEP(0, ch); RB_STEP(1, ch + 1); RB_STEP(2, ch + 2); RB_STEP(3, ch + 3); }
            }
#undef RB_STEP
#undef RB_ISSUE
#undef RB_WRITE
        } else {
            LAS bf16_t* Bm = (LAS bf16_t*)lds; LAS bf16_t* Xh = (LAS bf16_t*)(lds + 34816); LAS float* CUM = (LAS float*)(lds + 53248); LAS float* DTL = CUM + 512;
            for (int unit = vcu - 32; unit < 256; unit += G - 32) {
                const int g = unit & 1, c = (unit >> 1) & 31, b = unit >> 6, m0 = b * SEQ + c * 128;
#pragma unroll
                for (int k = 0; k < 4; ++k) { const int p = tid + 512 * k, row = p >> 4, c16 = p & 15; *(LAS u32x4*)(Bm + row * 136 + 8 * c16) = *(const u32x4*)(XBCC + (size_t)(m0 + row) * 1024 + 512 + 128 * g + 8 * c16); }
                if (wave < 4) { const int h = 4 * g + wave; const float a_h = -__expf(args.in[I_ALOG][h]);
                    const float v0 = DTSP[(size_t)(m0 + 2 * lane) * 8 + h], v1 = DTSP[(size_t)(m0 + 2 * lane + 1) * 8 + h]; float s = v0 + v1;
#pragma unroll
                    for (int o = 1; o < 64; o <<= 1) { const float t = __shfl_up(s, o); if (lane >= o) s += t; }
                    const float ex = s - (v0 + v1);
                    CUM[wave * 128 + 2 * lane] = a_h * (ex + v0); CUM[wave * 128 + 2 * lane + 1] = a_h * (ex + v0 + v1); DTL[wave * 128 + 2 * lane] = v0; DTL[wave * 128 + 2 * lane + 1] = v1; }
                LBAR();
#pragma unroll 1
                for (int hq = 0; hq < 4; ++hq) { const int h = 4 * g + hq;
                    { const int s = tid >> 2, cq = 16 * (tid & 3); const float sc = DTL[hq * 128 + s] * __expf(CUM[hq * 128 + 127] - CUM[hq * 128 + s]);
                      const bf16_t* xp = XBCC + (size_t)(m0 + s) * 1024 + 64 * h + cq;
#pragma unroll
                      for (int q = 0; q < 2; ++q) { float f[8]; unpack8(*(const u32x4*)(xp + 8 * q), f);
#pragma unroll
                          for (int i = 0; i < 8; ++i) f[i] *= sc;
                          *(LAS u32x4*)(Xh + s * 72 + cq + 8 * q) = pack8(f); } }
                    LBAR();
                    const int mt = wave >> 2, nt = wave & 3; f32x16 acc;
#pragma unroll
                    for (int r = 0; r < 16; ++r) acc[r] = 0.f;
#pragma unroll
                    for (int ks = 0; ks < 8; ++ks) acc = __builtin_amdgcn_mfma_f32_32x32x16_bf16(TRF(Xh, 72, ks, mt), TRF(Bm, 136, ks, nt), acc, 0, 0, 0);
                    bf16_t* sp = SSTATE + ((size_t)((b * 32 + c) * 8 + h)) * 8192 + (32 * mt + 4 * hh) * 128 + 32 * nt + r32;
#pragma unroll
                    for (int r = 0; r < 16; ++r) sp[crc(r) * 128] = (bf16_t)f2bf(acc[r]);
                    if (tid == 0) CHDEC[(b * 32 + c) * 8 + h] = __expf(CUM[hq * 128 + 127]);
                    LBAR();
                }
            }
            {
                LAS float* scr = (LAS float*)(lds + wave * 16384);
                for (int it0 = (vcu - 32) * 8 + wave; ; it0 += (G - 32) * 8) {
                    int it = it0;
                    if (transpose_matrix(it, args.in[I_WOUT], DM, DM, DM, WOUT, 0, scr, lane)) continue;
                    if (transpose_matrix(it, args.in[I_FG], FFN, DM, FFN, WGU, 1, scr, lane, args.in[I_NORM_FFN0])) continue;
                    if (transpose_matrix(it, args.in[I_FU], FFN, DM, FFN, WGU, 2, scr, lane, args.in[I_NORM_FFN0])) continue;
                    if (transpose_matrix(it, args.in[I_FD], DM, FFN, DM, WDN, 0, scr, lane)) continue;
                    if (transpose_matrix(it, args.in[I_WQKV], 1536, DM, 1536, WQKV, 3, scr, lane, args.in[I_NORM_MIX1])) continue;
                    if (transpose_matrix(it, args.in[I_WO], DM, DM, DM, WO, 0, scr, lane)) continue;
                    break;
                }
            }
        }
    }

    SEAM(3);

    PHASE(4) { REPBAR
        const int gt = vcu * 512 + tid, bh = gt >> 12, e2 = gt & 4095, b = bh >> 3, h = bh & 7;
        unsigned* sp = (unsigned*)SSTATE + ((size_t)(b * 32 * 8 + h)) * 4096 + e2;
        unsigned vals[32];
#pragma unroll
        for (int c = 0; c < 32; ++c) vals[c] = sp[(size_t)c * 8 * 4096];
        float r0 = 0.f, r1 = 0.f;
#pragma unroll
        for (int c = 0; c < 32; ++c) { const float dec = CHDEC[(b * 32 + c) * 8 + h]; sp[(size_t)c * 8 * 4096] = pk2(r0, r1); r0 = r0 * dec + bflo(vals[c]); r1 = r1 * dec + bfhi(vals[c]); }
    }
    SEAM(4);

    PHASE(5) { REPBAR
        {
            LAS bf16_t* Cm = (LAS bf16_t*)lds; LAS bf16_t* Bm = (LAS bf16_t*)(lds + 34816); LAS bf16_t* Xh = (LAS bf16_t*)(lds + 69632); LAS bf16_t* Hp = (LAS bf16_t*)(lds + 88064);
            LAS float* CUM = (LAS float*)(lds + 105472); LAS float* DTL = CUM + 512; LAS bf16_t* YL = (LAS bf16_t*)lds;
            for (int unit = vcu; unit < 256; unit += G) {
                const int g = unit & 1, c = (unit >> 1) & 31, b = unit >> 6, m0 = b * SEQ + c * 128;
#pragma unroll
                for (int k = 0; k < 4; ++k) { const int p = tid + 512 * k, row = p >> 4, c16 = p & 15; const bf16_t* sp = XBCC + (size_t)(m0 + row) * 1024 + 128 * g + 8 * c16;
                    *(LAS u32x4*)(Bm + row * 136 + 8 * c16) = *(const u32x4*)(sp + 512); *(LAS u32x4*)(Cm + row * 136 + 8 * c16) = *(const u32x4*)(sp + 768); }
                if (wave < 4) { const int h = 4 * g + wave; const float a_h = -__expf(args.in[I_ALOG][h]);
                    const float v0 = DTSP[(size_t)(m0 + 2 * lane) * 8 + h], v1 = DTSP[(size_t)(m0 + 2 * lane + 1) * 8 + h]; float s = v0 + v1;
#pragma unroll
                    for (int o = 1; o < 64; o <<= 1) { const float t = __shfl_up(s, o); if (lane >= o) s += t; }
                    const float ex = s - (v0 + v1);
                    CUM[wave * 128 + 2 * lane] = a_h * (ex + v0); CUM[wave * 128 + 2 * lane + 1] = a_h * (ex + v0 + v1); DTL[wave * 128 + 2 * lane] = v0; DTL[wave * 128 + 2 * lane + 1] = v1; }
                LBAR();
                const int mt = wave >> 1, nb = 2 * (wave & 1), nt2 = wave & 1;
                f32x16 cb[2];
#pragma unroll
                for (int r = 0; r < 16; ++r) { cb[0][r] = 0.f; cb[1][r] = 0.f; }
#pragma unroll
                for (int ks = 0; ks < 8; ++ks) { const bf16x8 a = NATF(Cm, 136, ks, mt);
                    cb[0] = __builtin_amdgcn_mfma_f32_32x32x16_bf16(a, NATF(Bm, 136, ks, nb), cb[0], 0, 0, 0); cb[1] = __builtin_amdgcn_mfma_f32_32x32x16_bf16(a, NATF(Bm, 136, ks, nb + 1), cb[1], 0, 0, 0); }
                LBAR();
                LAS bf16_t* Wt = Bm;
                f32x16 yt[4];
#pragma unroll
                for (int hq = 0; hq < 4; ++hq) { const int h = 4 * g + hq;
#pragma unroll
                    for (int j = 0; j < 2; ++j) { const int s = 32 * (nb + j) + r32; const float cs = CUM[hq * 128 + s], ds = DTL[hq * 128 + s]; const int lb = 32 * mt + 4 * hh;
                        LAS bf16_t* wp = Wt + lb * 136 + s; const LAS float* cl = CUM + hq * 128 + lb;
#pragma unroll
                        for (int r = 0; r < 16; ++r) { const float w = (s <= lb + crc(r)) ? cb[j][r] * __expf(cl[crc(r)] - cs) * ds : 0.f; wp[crc(r) * 136] = (bf16_t)f2bf(w); } }
                    { const int s = tid >> 2, cq = 16 * (tid & 3); const bf16_t* xp = XBCC + (size_t)(m0 + s) * 1024 + 64 * h + cq;
                      *(LAS u32x4*)(Xh + s * 72 + cq) = *(const u32x4*)xp; *(LAS u32x4*)(Xh + s * 72 + cq + 8) = *(const u32x4*)(xp + 8); }
                    { const bf16_t* hp = SSTATE + ((size_t)((b * 32 + c) * 8 + h)) * 8192;
#pragma unroll
                      for (int k = 0; k < 2; ++k) { const int p = tid + 512 * k, row = p >> 4, c16 = p & 15; *(LAS u32x4*)(Hp + row * 136 + 8 * c16) = *(const u32x4*)(hp + row * 128 + 8 * c16); } }
                    LBAR();
                    f32x16 yd, yo;
#pragma unroll
                    for (int r = 0; r < 16; ++r) { yd[r] = 0.f; yo[r] = 0.f; }
#pragma unroll
                    for (int ks = 0; ks < 8; ++ks) { yd = __builtin_amdgcn_mfma_f32_32x32x16_bf16(NATF(Wt, 136, ks, mt), TRF(Xh, 72, ks, nt2), yd, 0, 0, 0);
                        yo = __builtin_amdgcn_mfma_f32_32x32x16_bf16(NATF(Cm, 136, ks, mt), NATF(Hp, 136, ks, nt2), yo, 0, 0, 0); }
                    { const LAS float* cl = CUM + hq * 128 + 32 * mt + 4 * hh;
#pragma unroll
                      for (int r = 0; r < 16; ++r) yt[hq][r] = yd[r] + __expf(cl[crc(r)]) * yo[r]; }
                    LBAR();
                }
                { LAS bf16_t* yp = YL + (32 * mt + 4 * hh) * 264 + 32 * nt2 + r32;
#pragma unroll
                  for (int hq = 0; hq < 4; ++hq)
#pragma unroll
                      for (int r = 0; r < 16; ++r) yp[crc(r) * 264 + 64 * hq] = (bf16_t)f2bf(yt[hq][r]); }
                LBAR();
                for (int i = 0; i < 16; ++i) { const int l = wave * 16 + i; const size_t m = (size_t)(m0 + l); const int ch = 256 * g + 4 * lane;
                    const u32x2 yv = *(const LAS u32x2*)(YL + l * 264 + 4 * lane), xv = *(const u32x2*)(XBCC + m * 1024 + ch), zv = *(const u32x2*)(PROJ + m * NPROJ + 1792 + ch);
                    const float dsk = args.in[I_DSKIP][4 * g + (lane >> 4)];
                    float v[4] = {bflo(yv.x), bfhi(yv.x), bflo(yv.y), bfhi(yv.y)}; const float xs[4] = {bflo(xv.x), bfhi(xv.x), bflo(xv.y), bfhi(xv.y)}, zz[4] = {bflo(zv.x), bfhi(zv.x), bflo(zv.y), bfhi(zv.y)};
                    float q = 0.f;
#pragma unroll
                    for (int j = 0; j < 4; ++j) { v[j] = (v[j] + dsk * xs[j]) * siluf_(zz[j]); q += v[j] * v[j]; }
                    q = wave_sum(q); const float rq = __builtin_amdgcn_rsqf(q * (1.0f / 256.0f) + EPS); const f32x4 nw = *(const f32x4*)(args.in[I_SSDN] + ch);
                    u32x2 o; o.x = pk2(v[0] * rq * nw[0], v[1] * rq * nw[1]); o.y = pk2(v[2] * rq * nw[2], v[3] * rq * nw[3]); *(u32x2*)(MIX + m * DM + 512 + ch) = o; }
                LBAR();
            }
        }
        const float* mu = args.in[I_MU];
        for (int m = gw; m < MTOK; m += NGW) {
            const bool hasprev = (m & (SEQ - 1)) != 0; const int c0 = 8 * lane, h = lane >> 3;
            float y[8], v[8], p[8], go[8];
            unpack8(*(const u32x4*)(MIX + (size_t)m * DM + c0), y);
            unpack8(*(const u32x4*)((const bf16_t*)((const unsigned char*)dout + 48 * MiB) + (size_t)m * 512 + c0), p);
#pragma unroll
            for (int i = 0; i < 8; ++i) y[i] += p[i];
            const bf16_t* pc = PROJ + (size_t)m * NPROJ + c0;
            unpack8(*(const u32x4*)(pc + 1024), v);
            if (hasprev) {
                unpack8(*(const u32x4*)(pc - NPROJ + 1024), p);
#pragma unroll
                for (int i = 0; i < 8; ++i) v[i] += (p[i] - v[i]) * mu[1024 + c0 + i];
            } else {
#pragma unroll
                for (int i = 0; i < 8; ++i) v[i] -= v[i] * mu[1024 + c0 + i];
            }
            unpack8(*(const u32x4*)(GOUT + (size_t)m * 512 + c0), go);
            float s1 = 0.f; const float bd = KKR[(size_t)m * 8 + h];
#pragma unroll
            for (int i = 0; i < 8; ++i) s1 += y[i];
            s1 += __shfl_xor(s1, 1); s1 += __shfl_xor(s1, 2); s1 += __shfl_xor(s1, 4);
            const float mean = s1 * (1.0f / 64.0f); float s2 = 0.f;
#pragma unroll
            for (int i = 0; i < 8; ++i) { const float d = y[i] - mean; s2 += d * d; }
            s2 += __shfl_xor(s2, 1); s2 += __shfl_xor(s2, 2); s2 += __shfl_xor(s2, 4);
            const float rs = __builtin_amdgcn_rsqf(s2 * (1.0f / 64.0f) + 64e-5f);
            float o[8];
#pragma unroll
            for (int i = 0; i < 8; ++i) o[i] = ((y[i] - mean) * rs * args.in[I_GNW][c0 + i] + args.in[I_GNB][c0 + i] + bd * v[i]) * go[i];
            *(u32x4*)(MIX + (size_t)m * DM + c0) = pack8(o);
        }
    }
    SEAM(5);


    PHASE(6) { REPBAR
        pg8::Gemm g{MIX, WOUT, MTOK, DM, DM}; pg8::StaticOrder S; S.init(MTOK, DM, G, bx);
        pg8::EpiRes<false, false> E{args.in[I_X], nullptr, XNB, nullptr, SS};
        pg8::gemm_phase(lds, g, S, E);
    }
    SEAM(6);
    PHASE(7) { REPBAR
        pg8::Gemm g{XNB, WGU, MTOK, 2 * FFN, DM}; pg8::StaticOrder S; S.init(MTOK, 2 * FFN, G, bx);
        pg8::EpiSwiglu E{HID, FFN, SS, nullptr};
        pg8::gemm_phase(lds, g, S, E);
    }
    SEAM(7);
    PHASE(8) { REPBAR
        pg8::Gemm g{HID, WDN, MTOK, DM, FFN}; pg8::StaticOrder S; S.init(MTOK, DM, G, bx);
        pg8::EpiRes<true, false> E{XNB, nullptr, XNB, nullptr, SS};
        pg8::gemm_phase(lds, g, S, E);
    }
    SEAM(8);
    PHASE(9) { REPBAR
        pg8::Gemm g{XNB, WQKV, MTOK, 1536, DM}; pg8::StaticOrder S; S.init(MTOK, 1536, G, bx);
        pg8::EpiQkv E{QKV, SS, args.in[I_BQKV], args.in[I_QN], args.in[I_KN], ROPE};
        pg8::gemm_phase(lds, g, S, E);
    }
    SEAM(9);

    PHASE(10) { REPBAR
        LAS bf16_t* Kt = (LAS bf16_t*)lds; LAS bf16_t* Vt = (LAS bf16_t*)(lds + 36864);
        const int r32 = lane & 31, hh = lane >> 5;
        for (int unit = vcu; unit < BATCH * 4 * 32; unit += G) {
            const int blk = unit & 31, kvh = (unit >> 5) & 3, b = unit >> 7;
            {
                const int rowi = tid >> 1, half = tid & 1; const int tpos = (blk - 1) * 128 + rowi;
#pragma unroll
                for (int q = 0; q < 4; ++q) { u32x4 kv = (u32x4){0, 0, 0, 0}, vv = kv;
                    if (tpos >= 0) { const bf16_t* p = QKV + (size_t)(b * SEQ + tpos) * 1536 + 1024 + kvh * 64 + half * 32 + 8 * q; kv = *(const u32x4*)p; vv = *(const u32x4*)(p + 256); }
                    *(LAS u32x4*)(Kt + rowi * 72 + half * 32 + 8 * q) = kv; *(LAS u32x4*)(Vt + rowi * 72 + half * 32 + 8 * q) = vv; }
            }
            __syncthreads();
            const int gq = wave >> 1, qh = kvh * 4 + gq; const float sink = args.in[I_SINK][qh];
            for (int it = 0; it < 2; ++it) {
                const int qi = (wave & 1) * 64 + it * 32 + r32; const size_t mq = (size_t)b * SEQ + blk * 128 + qi;
                bf16x8 qr[4];
#pragma unroll
                for (int s = 0; s < 4; ++s) qr[s] = *(const bf16x8*)(QKV + mq * 1536 + qh * 64 + 16 * s + 8 * hh);
                const int a0 = (wave & 1) * 2 + it;
                f32x16 sc[5];
#pragma unroll
                for (int j = 0; j < 5; ++j) {
#pragma unroll
                    for (int r = 0; r < 16; ++r) sc[j][r] = 0.f;
#pragma unroll
                    for (int s = 0; s < 4; ++s) { const bf16x8 kf = *(const LAS bf16x8*)(Kt + (32 * (a0 + j) + r32) * 72 + 16 * s + 8 * hh); sc[j] = __builtin_amdgcn_mfma_f32_32x32x16_bf16(kf, qr[s], sc[j], 0, 0, 0); }
                }
                float mx = sink;
#pragma unroll
                for (int j = 0; j < 5; ++j)
#pragma unroll
                    for (int r = 0; r < 16; ++r) { const int kj = 32 * (a0 + j) + crow(r, hh); const bool valid = (kj > qi) && (kj <= qi + 128) && (blk > 0 || kj >= 128);
                        const float x = valid ? sc[j][r] * 0.125f : -1e30f; sc[j][r] = x; mx = fmaxf(mx, x); }
                mx = fmaxf(mx, __shfl_xor(mx, 32));
                float l = 0.f;
#pragma unroll
                for (int j = 0; j < 5; ++j)
#pragma unroll
                    for (int r = 0; r < 16; ++r) { const float p = __expf(sc[j][r] - mx); sc[j][r] = p; l += p; }
                l += __shfl_xor(l, 32); l += __expf(sink - mx);
                const float inv = 1.0f / l;
                f32x16 o[2];
#pragma unroll
                for (int dt = 0; dt < 2; ++dt)
#pragma unroll
                    for (int r = 0; r < 16; ++r) o[dt][r] = 0.f;
#pragma unroll
                for (int j = 0; j < 5; ++j)
#pragma unroll
                    for (int s2 = 0; s2 < 2; ++s2) {
                        u32x4 pw; pw.x = pk2(sc[j][8 * s2 + 0], sc[j][8 * s2 + 1]); pw.y = pk2(sc[j][8 * s2 + 2], sc[j][8 * s2 + 3]); pw.z = pk2(sc[j][8 * s2 + 4], sc[j][8 * s2 + 5]); pw.w = pk2(sc[j][8 * s2 + 6], sc[j][8 * s2 + 7]);
                        const bf16x8 pf = __builtin_bit_cast(bf16x8, pw);
                        const int key0 = 32 * (a0 + j) + 16 * s2 + 4 * hh + ((lane & 15) >> 2);
#pragma unroll
                        for (int dt = 0; dt < 2; ++dt) {
                            const LAS bf16_t* vp = Vt + key0 * 72 + 32 * dt + 16 * ((lane >> 4) & 1) + 4 * (lane & 3);
                            const s16x4 lo = __builtin_bit_cast(s16x4, __builtin_amdgcn_ds_read_tr16_b64_v4i16((LAS s16x4*)vp));
                            const s16x4 hi = __builtin_bit_cast(s16x4, __builtin_amdgcn_ds_read_tr16_b64_v4i16((LAS s16x4*)(vp + 8 * 72)));
                            const bf16x8 vf = (bf16x8){lo[0], lo[1], lo[2], lo[3], hi[0], hi[1], hi[2], hi[3]};
                            o[dt] = __builtin_amdgcn_mfma_f32_32x32x16_bf16(vf, pf, o[dt], 0, 0, 0);
                        }
                    }
                bf16_t* op = ATTO + mq * DM + qh * 64;
#pragma unroll
                for (int dt = 0; dt < 2; ++dt)
#pragma unroll
                    for (int rq = 0; rq < 4; ++rq) { u32x2 w; w.x = pk2(o[dt][4 * rq] * inv, o[dt][4 * rq + 1] * inv); w.y = pk2(o[dt][4 * rq + 2] * inv, o[dt][4 * rq + 3] * inv);
                        *(u32x2*)(op + 32 * dt + 8 * rq + 4 * hh) = w; }
            }
            __syncthreads();
        }
    }
    SEAM(10);

    PHASE(11) { REPBAR
        pg8::Gemm g{ATTO, WO, MTOK, DM, DM}; pg8::StaticOrder S; S.init(MTOK, DM, G, bx);
        pg8::EpiRes<true, true> E{XNB, dout, XNB, args.in[I_BO], SS};
        pg8::gemm_phase(lds, g, S, E);
    }
    SEAM(11);

    PHASE(12) { REPBAR
        {
            LAS float* scr = (LAS float*)(lds + wave * 16384);
            for (int it0 = gw; ; it0 += NGW) {
                int it = it0; bool done = false;
                for (int e = 0; e < NEXP && !done; ++e) {
                    if (transpose_matrix(it, args.in[I_EG] + (size_t)e * DM * FE, FE, DM, FE, EGU + (size_t)e * 2 * FE * DM, 1, scr, lane, args.in[I_NORM_FFN1])) { done = true; break; }
                    if (transpose_matrix(it, args.in[I_EU] + (size_t)e * DM * FE, FE, DM, FE, EGU + (size_t)e * 2 * FE * DM, 2, scr, lane, args.in[I_NORM_FFN1])) { done = true; break; }
                    if (transpose_matrix(it, args.in[I_ED] + (size_t)e * FE * DM, DM, FE, DM, EDN + (size_t)e * DM * FE, 0, scr, lane)) { done = true; break; }
                }
                if (!done) break;
            }
            __syncthreads();
        }
        LAS float* w8 = (LAS float*)lds; LAS unsigned* lcnt = (LAS unsigned*)(lds + 32768); LAS unsigned* lbase = lcnt + 8; LAS unsigned* lsel = lcnt + 16;
        for (int r = tid; r < DM; r += 512) { const float* p = args.in[I_ROUTER] + (size_t)r * 8; *(LAS f32x4*)(w8 + r * 8) = *(const f32x4*)p; *(LAS f32x4*)(w8 + r * 8 + 4) = *(const f32x4*)(p + 4); }
        if (tid < 8) lcnt[tid] = 0u;
        __syncthreads();
        const float* gm = args.in[I_NORM_FFN1];
        int kk = 0;
        for (int m = gw; m < MTOK; m += NGW, ++kk) {
            const f32x4* xr = (const f32x4*)(dout + (size_t)m * DM) + lane;
            f32x4 v[4]; float s = 0.f;
#pragma unroll
            for (int j = 0; j < 4; ++j) { v[j] = xr[64 * j]; s += (v[j][0] * v[j][0] + v[j][1] * v[j][1]) + (v[j][2] * v[j][2] + v[j][3] * v[j][3]); }
            const float rstd = __builtin_amdgcn_rsqf(wave_sum(s) * (1.0f / DM) + EPS);
            float d[8];
#pragma unroll
            for (int k = 0; k < 8; ++k) d[k] = 0.f;
#pragma unroll
            for (int j = 0; j < 4; ++j) { const f32x4 g4 = ((const f32x4*)gm)[64 * j + lane]; const f32x4 y = v[j] * rstd * g4;
#pragma unroll
                for (int i = 0; i < 4; ++i) { const int c = 256 * j + 4 * lane + i; const f32x4 wa = *(const LAS f32x4*)(w8 + c * 8), wb = *(const LAS f32x4*)(w8 + c * 8 + 4);
                    d[0] += y[i] * wa[0]; d[1] += y[i] * wa[1]; d[2] += y[i] * wa[2]; d[3] += y[i] * wa[3]; d[4] += y[i] * wb[0]; d[5] += y[i] * wb[1]; d[6] += y[i] * wb[2]; d[7] += y[i] * wb[3]; } }
            wave_sum8(d);
            int e0 = 0; float v0 = d[0];
#pragma unroll
            for (int k = 1; k < 8; ++k) if (d[k] > v0) { v0 = d[k]; e0 = k; }
            int e1 = -1; float v1 = -3.0e38f;
#pragma unroll
            for (int k = 0; k < 8; ++k) if (k != e0 && d[k] > v1) { v1 = d[k]; e1 = k; }
            if (lane == 0) {
                const float w0 = __builtin_amdgcn_rcpf(1.0f + __expf(v1 - v0));
                const unsigned r0 = atomicAdd((unsigned*)(lcnt + e0), 1u), r1 = atomicAdd((unsigned*)(lcnt + e1), 1u);
                lsel[(wave * 8 + kk) * 2] = ((unsigned)e0 << 16) | r0; lsel[(wave * 8 + kk) * 2 + 1] = ((unsigned)e1 << 16) | r1;
                TOPE[2 * m] = e0; TOPE[2 * m + 1] = e1; TOPW[2 * m] = w0; TOPW[2 * m + 1] = 1.0f - w0; RSTD4[m] = rstd;
            }
        }
        __syncthreads();
        if (tid < 8) lbase[tid] = atomicAdd(CNT + tid, lcnt[tid]);
        __syncthreads();
        if (tid < 128) { const int row = tid >> 1, w_ = row >> 3, k_ = row & 7; const int m = (vcu * 8 + w_) + k_ * NGW; if (m < MTOK) { const unsigned sv = lsel[tid]; RANK[2 * m + (tid & 1)] = (int)(lbase[sv >> 16] + (sv & 0xffffu)); } }
        __syncthreads();
    }
    SEAM(12);

    PHASE(13) { REPBAR
        int roff[NEXP]; { int t = 0;
#pragma unroll
            for (int e = 0; e < NEXP; ++e) { roff[e] = t; t += (int)((CNT[e] + 255u) >> 8) << 8; } }
        {
            const int myj = gw + (lane & 15) * NGW, e = TOPE[myj]; int ro = roff[0];
#pragma unroll
            for (int k = 1; k < NEXP; ++k) ro = (e == k) ? roff[k] : ro;
            const int mypos = ro + RANK[myj];
            if (lane < 16) { POS[myj] = mypos; RSTDS[mypos] = RSTD4[myj >> 1]; }
#pragma unroll
            for (int k0 = 0; k0 < 16; k0 += 4) {
                u32x4 v[4][2]; int pos[4];
#pragma unroll
                for (int q = 0; q < 4; ++q) { pos[q] = __builtin_amdgcn_readlane(mypos, k0 + q); const int m = (gw + (k0 + q) * NGW) >> 1;
                    const u32x4* sp = (const u32x4*)(XNB + (size_t)m * DM) + lane; v[q][0] = sp[0]; v[q][1] = sp[64]; }
#pragma unroll
                for (int q = 0; q < 4; ++q) { u32x4* dp = (u32x4*)(AS + (size_t)pos[q] * DM) + lane; dp[0] = v[q][0]; dp[64] = v[q][1]; }
            }
        }
    }
    SEAM(13);
    PHASE(14) { REPBAR
        pg8::Gemm g{AS, EGU, SROWS, 2 * FE, DM}; pg8::MoeOrder S; S.init(CNT, 2 * FE / 256, G, bx, (long)2 * FE * DM * 2);
        pg8::EpiSwiglu E{HS, FE, nullptr, RSTDS};
        pg8::gemm_phase(lds, g, S, E);
    }
    SEAM(14);
    PHASE(15) { REPBAR
        pg8::Gemm g{HS, EDN, SROWS, DM, FE}; pg8::MoeOrder S; S.init(CNT, DM / 256, G, bx, (long)DM * FE * 2);
        pg8::EpiBf16 E{AS, DM};
        pg8::gemm_phase(lds, g, S, E);
    }
    SEAM(15);
    PHASE(16) { REPBAR
        {
            const int mym = gw + (lane & 7) * NGW; const int q0 = POS[2 * mym], q1 = POS[2 * mym + 1]; const float u0 = TOPW[2 * mym], u1 = TOPW[2 * mym + 1];
#pragma unroll
            for (int k0 = 0; k0 < 8; k0 += 2) {
                u32x4 ya[2][2], yb[2][2]; f32x4 hv[2][4]; float w0[2], w1[2];
#pragma unroll
                for (int t = 0; t < 2; ++t) { const int p0 = __builtin_amdgcn_readlane(q0, k0 + t), p1 = __builtin_amdgcn_readlane(q1, k0 + t);
                    w0[t] = __builtin_bit_cast(float, __builtin_amdgcn_readlane(__builtin_bit_cast(int, u0), k0 + t)); w1[t] = __builtin_bit_cast(float, __builtin_amdgcn_readlane(__builtin_bit_cast(int, u1), k0 + t));
                    const u32x4* y0 = (const u32x4*)(AS + (size_t)p0 * DM) + lane; const u32x4* y1 = (const u32x4*)(AS + (size_t)p1 * DM) + lane;
                    ya[t][0] = y0[0]; ya[t][1] = y0[64]; yb[t][0] = y1[0]; yb[t][1] = y1[64];
                    const f32x4* o = (const f32x4*)(dout + (size_t)(gw + (k0 + t) * NGW) * DM);
                    hv[t][0] = o[2 * lane]; hv[t][1] = o[2 * lane + 1]; hv[t][2] = o[128 + 2 * lane]; hv[t][3] = o[128 + 2 * lane + 1]; }
#pragma unroll
                for (int t = 0; t < 2; ++t) { f32x4* o = (f32x4*)(dout + (size_t)(gw + (k0 + t) * NGW) * DM);
#pragma unroll
                    for (int q = 0; q < 2; ++q) { float a[8], c[8]; unpack8(ya[t][q], a); unpack8(yb[t][q], c); f32x4 h0 = hv[t][2 * q], h1 = hv[t][2 * q + 1];
#pragma unroll
                        for (int i = 0; i < 4; ++i) { h0[i] += w0[t] * a[i] + w1[t] * c[i]; h1[i] += w0[t] * a[4 + i] + w1[t] * c[4 + i]; }
                        o[128 * q + 2 * lane] = h0; o[128 * q + 2 * lane + 1] = h1; } }
            }
        }
    }
#undef TRF
#undef NATF
#undef IN
#undef SEAM
#undef PHASE
#undef REPBAR
}

constexpr int NPHASE = 17;
extern "C" void kernel_launch(void* const* d_in, const int* in_sizes, int n_in, void* d_out, int out_size, void* d_ws, size_t ws_size, hipStream_t stream) {
    static int grid = 0;
    if (grid == 0) {
        if (n_in != 39 || out_size != MTOK * DM || ws_size < WS_END) { fprintf(stderr, "kernel_launch: unexpected shapes n_in %d out %d ws %zu\n", n_in, out_size, ws_size); grid = -1; return; }
        int dev = 0, cus = 0;
        if (hipGetDevice(&dev) != hipSuccess || hipDeviceGetAttribute(&cus, hipDeviceAttributeMultiprocessorCount, dev) != hipSuccess) { grid = -1; return; }
        if (hipFuncSetAttribute((const void*)fwd_kernel, hipFuncAttributeMaxDynamicSharedMemorySize, LDS_BYTES) != hipSuccess) { fprintf(stderr, "kernel_launch: hipFuncSetAttribute failed\n"); grid = -1; return; }
        int per_cu = 0; (void)hipOccupancyMaxActiveBlocksPerMultiprocessor(&per_cu, (const void*)fwd_kernel, 512, LDS_BYTES); (void)hipGetLastError();
        grid = 256; if (cus != 256 || per_cu < 1) fprintf(stderr, "kernel_launch: note: cus %d per_cu %d\n", cus, per_cu);
    }
    if (grid < 0) return;
    Args a{};
    a.in[0] = (const float*)d_in[0];
    for (int i = 2; i < 39; ++i) a.in[i - 1] = (const float*)d_in[i];
    a.pos = (const int*)d_in[1]; a.out = (float*)d_out; a.ws = (unsigned char*)d_ws;
    (void)hipMemsetAsync((char*)d_ws + WS_CTL, 0, CTL_ZERO_BYTES, stream);
#ifdef PROBE_PHASE
    constexpr int pp = PROBE_PHASE; constexpr bool before = (pp == 2 || pp == 3 || pp == 5 || pp == 6 || pp == 8 || pp == 11 || pp == 12);
#ifdef PROBE_VARIANT
    a.variant = PROBE_VARIANT;
#endif
    if (before) { a.ph_lo = pp; a.ph_hi = pp + 1; hipLaunchKernelGGL(fwd_kernel, dim3(grid), dim3(512), LDS_BYTES, stream, a); (void)hipMemsetAsync((char*)d_ws + WS_CTL, 0, CTL_ZERO_BYTES, stream); }
    a.variant = 0;
#endif
    a.ph_lo = 0; a.ph_hi = NPHASE;
    hipLaunchKernelGGL(fwd_kernel, dim3(grid), dim3(512), LDS_BYTES, stream, a);
#ifdef PROBE_PHASE
    if (!before) { (void)hipMemsetAsync((char*)d_ws + WS_CTL, 0, CW_CNT * 4, stream);
#ifdef PROBE_VARIANT
        a.variant = PROBE_VARIANT;
#endif
        a.ph_lo = pp; a.ph_hi = pp + 1; hipLaunchKernelGGL(fwd_kernel, dim3(grid), dim3(512), LDS_BYTES, stream, a); }
#endif
}
```

```cpp
#include <hip/hip_runtime.h>
#include <cstdio>
#include <cstdint>

#define LAS __attribute__((address_space(3)))
#define GAS __attribute__((address_space(1)))
typedef unsigned short bf16_t;
typedef short bf16x8 __attribute__((ext_vector_type(8)));
typedef float f32x4 __attribute__((ext_vector_type(4)));
typedef float f32x2 __attribute__((ext_vector_type(2)));
typedef float f32x16 __attribute__((ext_vector_type(16)));
typedef unsigned u32x4 __attribute__((ext_vector_type(4)));
typedef unsigned u32x2 __attribute__((ext_vector_type(2)));
typedef short s16x4 __attribute__((ext_vector_type(4)));

constexpr int BATCH = 4, SEQ = 4096, DM = 1024, MTOK = BATCH * SEQ;
constexpr int IN0 = 3336, NPROJ = 3328;
constexpr int FFN = 2816, FE = 1408, NEXP = 8;
constexpr int SROWS = 2 * MTOK + NEXP * 256;
constexpr float EPS = 1e-6f;

constexpr size_t MiB = 1u << 20;
constexpr size_t WS_CTL = 0, CTL_ZERO_BYTES = 64 * 1024;
constexpr size_t WS_DTSP = 1 * MiB;
constexpr size_t WS_KKR = 1 * MiB + 512 * 1024;
constexpr size_t WS_ROPE = 2 * MiB;
constexpr size_t WS_SS = 3 * MiB;
constexpr size_t WS_TOPE = 4 * MiB;
constexpr size_t WS_RANK = 4 * MiB + 128 * 1024;
constexpr size_t WS_TOPW = 4 * MiB + 256 * 1024;
constexpr size_t WS_POS = 4 * MiB + 384 * 1024;
constexpr size_t WS_RSTD4 = 4 * MiB + 512 * 1024;
constexpr size_t WS_RSTDS = 4 * MiB + 640 * 1024;
constexpr size_t WS_WDEC = 5 * MiB;
constexpr size_t WS_WICL = 5 * MiB + 64 * 1024;
constexpr size_t WS_WGAT = 5 * MiB + 128 * 1024;
constexpr size_t WS_EGU = 6 * MiB;
constexpr size_t WS_EDN = 50 * MiB;
constexpr size_t WS_WIN = 72 * MiB;
constexpr size_t WS_WOUT = WS_WIN + (size_t)NPROJ * DM * 2;
constexpr size_t WS_WGU = WS_WOUT + 2 * MiB;
constexpr size_t WS_WDN = WS_WGU + 11 * MiB;
constexpr size_t WS_WQKV = WS_WDN + (size_t)DM * FFN * 2;
constexpr size_t WS_WO = WS_WQKV + 3 * MiB;
constexpr size_t R0 = 102 * MiB;
static_assert(WS_WO + 2 * MiB <= R0, "weights");
constexpr size_t WS_XN = R0, WS_MIX = R0;
constexpr size_t WS_PROJ = R0 + 32 * MiB;
constexpr size_t WS_GOUT = R0 + 136 * MiB;
constexpr size_t WS_XNB = R0 + 104 * MiB;
constexpr size_t WS_HID = R0;
constexpr size_t WS_QKV = R0;
constexpr size_t WS_ATTO = R0 + 48 * MiB;
constexpr size_t WS_AS = 72 * MiB;
constexpr size_t WS_HS = 140 * MiB;
constexpr size_t WS_END = 254 * MiB;
static_assert(WS_AS + (size_t)SROWS * DM * 2 <= WS_HS && WS_HS + (size_t)SROWS * FE * 2 <= WS_END && WS_GOUT + 16 * MiB <= WS_END, "map");
constexpr size_t DO_XBCC = 0, DO_DECAY = 32 * MiB, DO_ICLR = 48 * MiB;
constexpr int CW_BAR = 4096, CW_CNT = 8192;

constexpr int LDS_BYTES = 147456, RING_BYTES = 131072, MISC_OFF = LDS_BYTES - 128;

__device__ __forceinline__ unsigned f2bf(float f) { unsigned u = __builtin_bit_cast(unsigned, f); return (u + 0x7fffu + ((u >> 16) & 1u)) >> 16; }
typedef __bf16 bf16x2_t __attribute__((ext_vector_type(2)));
__device__ __forceinline__ unsigned pk2(float lo, float hi) { const f32x2 v = {lo, hi}; const bf16x2_t b = __builtin_convertvector(v, bf16x2_t); return __builtin_bit_cast(unsigned, b); }
__device__ __forceinline__ float bflo(unsigned u) { return __builtin_bit_cast(float, u << 16); }
__device__ __forceinline__ float bfhi(unsigned u) { return __builtin_bit_cast(float, u & 0xffff0000u); }
__device__ __forceinline__ void unpack8(const u32x4 v, float* f) { f[0] = bflo(v.x); f[1] = bfhi(v.x); f[2] = bflo(v.y); f[3] = bfhi(v.y); f[4] = bflo(v.z); f[5] = bfhi(v.z); f[6] = bflo(v.w); f[7] = bfhi(v.w); }
__device__ __forceinline__ u32x4 pack8(const float* f) { u32x4 v; v.x = pk2(f[0], f[1]); v.y = pk2(f[2], f[3]); v.z = pk2(f[4], f[5]); v.w = pk2(f[6], f[7]); return v; }
__device__ __forceinline__ float sigmoidf_(float x) { return __builtin_amdgcn_rcpf(1.0f + __expf(-x)); }
__device__ __forceinline__ float siluf_(float x) { return x * __builtin_amdgcn_rcpf(1.0f + __expf(-x)); }
#define LBAR() do { asm volatile("s_waitcnt lgkmcnt(0)" ::: "memory"); __builtin_amdgcn_s_barrier(); asm volatile("" ::: "memory"); } while (0)
__device__ __forceinline__ float wave_sum(float v) {
#pragma unroll
    for (int o = 1; o < 64; o <<= 1) v += __shfl_xor(v, o);
    return v;
}
__device__ __forceinline__ float dpp_sum63(float x) {
    int v;
    v = __builtin_amdgcn_update_dpp(0, __builtin_bit_cast(int, x), 0xB1, 0xF, 0xF, false); x += __builtin_bit_cast(float, v);
    v = __builtin_amdgcn_update_dpp(0, __builtin_bit_cast(int, x), 0x4E, 0xF, 0xF, false); x += __builtin_bit_cast(float, v);
    v = __builtin_amdgcn_update_dpp(0, __builtin_bit_cast(int, x), 0x141, 0xF, 0xF, false); x += __builtin_bit_cast(float, v);
    v = __builtin_amdgcn_update_dpp(0, __builtin_bit_cast(int, x), 0x140, 0xF, 0xF, false); x += __builtin_bit_cast(float, v);
    v = __builtin_amdgcn_update_dpp(0, __builtin_bit_cast(int, x), 0x142, 0xA, 0xF, false); x += __builtin_bit_cast(float, v);
    v = __builtin_amdgcn_update_dpp(0, __builtin_bit_cast(int, x), 0x143, 0xC, 0xF, false); x += __builtin_bit_cast(float, v);
    return __builtin_bit_cast(float, __builtin_amdgcn_readlane(__builtin_bit_cast(int, x), 63));
}
__device__ __forceinline__ void wave_sum8(float (&d)[8]) {
    float e4[4], e2[2], e1;
    { const bool up = (threadIdx.x & 32) != 0;
#pragma unroll
      for (int k = 0; k < 4; ++k) { const float keep = up ? d[k + 4] : d[k], send = up ? d[k] : d[k + 4]; e4[k] = keep + __shfl_xor(send, 32); } }
    { const bool up = (threadIdx.x & 16) != 0;
#pragma unroll
      for (int k = 0; k < 2; ++k) { const float keep = up ? e4[k + 2] : e4[k], send = up ? e4[k] : e4[k + 2]; e2[k] = keep + __shfl_xor(send, 16); } }
    { const bool up = (threadIdx.x & 8) != 0; const float keep = up ? e2[1] : e2[0], send = up ? e2[0] : e2[1]; e1 = keep + __shfl_xor(send, 8); }
    e1 += __shfl_xor(e1, 4); e1 += __shfl_xor(e1, 2); e1 += __shfl_xor(e1, 1);
#pragma unroll
    for (int k = 0; k < 8; ++k) d[k] = __builtin_bit_cast(float, __builtin_amdgcn_readlane(__builtin_bit_cast(int, e1), 8 * k));
}
__device__ __forceinline__ int crow(int r, int hi) { return (r & 3) + 8 * (r >> 2) + 4 * hi; }
__device__ __forceinline__ constexpr int crc(int r) { return (r & 3) + 8 * (r >> 2); }

namespace pg8 {
constexpr int BM = 256, BK = 64, HALF = 128, HTB = HALF * BK * 2, NXCD = 8, WGM = 8;
__host__ __device__ __forceinline__ int lds_byte(int r, int c) { const int st = (r >> 4) * 2 + (c >> 5), rr = r & 15, cc = c & 31, ob = rr * 64 + cc * 2; return st * 1024 + (ob ^ (((ob >> 9) & 1) << 5)); }
__host__ __device__ __forceinline__ void stage_rc(int b, int& R, int& C) { const int st = b / 1024, sb = b % 1024, swz = sb ^ (((sb >> 9) & 1) << 5); R = (st >> 1) * 16 + swz / 64; C = (st & 1) * 32 + (swz % 64) / 2; }
__host__ __device__ __forceinline__ int perm32(int rho) { const int n = rho >> 4, i = rho & 15; return 8 * (i >> 2) + 4 * n + (i & 3); }
struct Unit { int pm, pn; long bofs; };
struct Gemm { const bf16_t* A; const bf16_t* Bt; int M, N, K; };
struct StaticOrder {
    int nM, nN, nwg, G, c;
    __device__ void init(int M, int N, int G_, int c_) { nM = M / BM; nN = N / BM; nwg = nM * nN; G = G_; c = c_; }
    __device__ bool next(int i, Unit& u) const {
        const long L = (long)i * G + c; if (L >= nwg) return false;
        int wgid = (int)L; { const int q = nwg / NXCD, r = nwg % NXCD, xcd = wgid % NXCD, off = wgid / NXCD; wgid = (xcd < r ? xcd * (q + 1) : r * (q + 1) + (xcd - r) * q) + off; }
        const int nig = WGM * nN, gid = wgid / nig, fm = gid * WGM, gsz = (nM - fm) < WGM ? (nM - fm) : WGM;
        u.pm = fm + ((wgid % nig) % gsz); u.pn = (wgid % nig) / gsz; u.bofs = 0; return true;
    }
};
struct MoeOrder {
    int toff[NEXP + 1]; int nN, G, c; long estride;
    __device__ void init(const unsigned* cnt, int nN_, int G_, int c_, long estride_) {
        nN = nN_; G = G_; c = c_; estride = estride_; int t = 0;
#pragma unroll
        for (int e = 0; e < NEXP; ++e) { toff[e] = t; t += (int)((cnt[e] + 255u) >> 8); }
        toff[NEXP] = t;
    }
    __device__ bool next(int i, Unit& u) const {
        const int nM = toff[NEXP], nwg = nM * nN; const long L = (long)i * G + c; if (L >= nwg) return false;
        int wgid = (int)L; { const int q = nwg / NXCD, r = nwg % NXCD, xcd = wgid % NXCD, off = wgid / NXCD; wgid = (xcd < r ? xcd * (q + 1) : r * (q + 1) + (xcd - r) * q) + off; }
        const int nig = WGM * nN, gid = wgid / nig, fm = gid * WGM, gsz = (nM - fm) < WGM ? (nM - fm) : WGM;
        const int pm = fm + ((wgid % nig) % gsz); u.pm = pm; u.pn = (wgid % nig) / gsz; int e = 0;
#pragma unroll
        for (int j = 1; j < NEXP; ++j) e += (pm >= toff[j]) ? 1 : 0;
        u.bofs = (long)e * estride; return true;
    }
};

template <class Epi, class Sched>
__device__ __forceinline__ void gemm_phase(LAS unsigned char* lds, const Gemm g, const Sched& S, const Epi& E) {
    constexpr bool ALIGN_EPI = true;
    const int tid = threadIdx.x, wid = __builtin_amdgcn_readfirstlane(tid >> 6), lane = tid & 63, wr = wid >> 2, wc = wid & 3, fr = lane & 15, fq = lane >> 4;
    const int K = g.K, nt = K / BK;
    unsigned voffA[2], voffB[2];
#pragma unroll
    for (int i = 0; i < 2; ++i) { int R, C; stage_rc(tid * 16 + i * 8192, R, C); const int Rb = Epi::PERM ? ((R & ~31) + perm32(R & 31)) : R;
        voffA[i] = (unsigned)(R * K + C) * 2u; voffB[i] = (unsigned)(Rb * K + C) * 2u; }
    const size_t kstep = (size_t)(BK * 2);
    const size_t hstep = (size_t)HALF * K * 2;
    const size_t tstep = 2 * hstep;
    const unsigned ldsw = (unsigned)wid * 1024u;
    const int aoff = lds_byte(wr * 64 + fr, fq * 8), boff = lds_byte(wc * 32 + fr, fq * 8);
#define PG8_SA(b, h) (((b) * 2 + (h)) * HTB)
#define PG8_SB(b, h) ((4 + (b) * 2 + (h)) * HTB)
#define PG8_STAGE(bufoff, gbase, voff) do { _Pragma("unroll") for (int _i = 0; _i < 2; ++_i) \
        __builtin_amdgcn_global_load_lds((const unsigned*)((const char*)(gbase) + (voff)[_i]), (LAS unsigned*)(lds + (bufoff) + ldsw + _i * 8192), 16, 0, 0); } while (0)
#define PG8_LDA(dst, b, h) do { _Pragma("unroll") for (int m = 0; m < 4; ++m) _Pragma("unroll") for (int k = 0; k < 2; ++k) dst[m][k] = *(const LAS bf16x8*)(lds + PG8_SA(b, h) + aoff + m * 2048 + k * 1024); } while (0)
#define PG8_LDB(dst, b, h) do { _Pragma("unroll") for (int n = 0; n < 2; ++n) _Pragma("unroll") for (int k = 0; k < 2; ++k) dst[n][k] = *(const LAS bf16x8*)(lds + PG8_SB(b, h) + boff + n * 2048 + k * 1024); } while (0)
#define PG8_MMA(ai, bj, At, Bt) do { __builtin_amdgcn_s_setprio(1); _Pragma("unroll") for (int m = 0; m < 4; ++m) _Pragma("unroll") for (int n = 0; n < 2; ++n) _Pragma("unroll") for (int k = 0; k < 2; ++k) \
        acc[ai][bj][m][n] = __builtin_amdgcn_mfma_f32_16x16x32_bf16(Bt[n][k], At[m][k], acc[ai][bj][m][n], 0, 0, 0); __builtin_amdgcn_s_setprio(0); } while (0)
#define PG8_WAIT_V(n) asm volatile("s_waitcnt vmcnt(" #n ")" ::: "memory")
#define PG8_WAIT_L(n) asm volatile("s_waitcnt lgkmcnt(" #n ")" ::: "memory")
#define PG8_BAR __builtin_amdgcn_s_barrier()
#define PG8_SCHED __builtin_amdgcn_sched_barrier(0)
    Unit cur, nxt; int ui = 0;
    if (!S.next(0, cur)) return;
    f32x4 acc[2][2][4][2];
#pragma unroll
    for (int a = 0; a < 2; ++a)
#pragma unroll
        for (int b = 0; b < 2; ++b)
#pragma unroll
            for (int m = 0; m < 4; ++m)
#pragma unroll
                for (int n = 0; n < 2; ++n) acc[a][b][m][n] = (f32x4){0.f, 0.f, 0.f, 0.f};
    bf16x8 At[4][2], B0[2][2], B1[2][2];
    const char* cA = (const char*)g.A + (size_t)cur.pm * tstep; const char* cB = (const char*)g.Bt + cur.bofs + (size_t)cur.pn * tstep;
    PG8_STAGE(PG8_SB(0, 0), cB, voffB); PG8_STAGE(PG8_SB(0, 1), cB + hstep, voffB); PG8_STAGE(PG8_SA(0, 0), cA, voffA); PG8_STAGE(PG8_SA(0, 1), cA + hstep, voffA);
    if (wr == 1) PG8_BAR;
    PG8_WAIT_V(2); PG8_BAR;
    PG8_STAGE(PG8_SB(1, 0), cB + kstep, voffB); PG8_STAGE(PG8_SA(1, 0), cA + kstep, voffA); PG8_STAGE(PG8_SB(1, 1), cB + hstep + kstep, voffB);
    PG8_WAIT_V(6); PG8_BAR;
    for (;;) {
        const bool has_next = S.next(ui + 1, nxt);
        const char* nA = has_next ? (const char*)g.A + (size_t)nxt.pm * tstep : cA; const char* nB = has_next ? (const char*)g.Bt + nxt.bofs + (size_t)nxt.pn * tstep : cB;
        for (int t = 0; t < nt; t += 2) {
            const bool last = (t == nt - 2);
            const char* a1 = cA + (size_t)(t + 1) * kstep;
            const char* a2 = last ? nA : cA + (size_t)(t + 2) * kstep; const char* b2 = last ? nB : cB + (size_t)(t + 2) * kstep;
            const char* a3 = a2 + kstep; const char* b3 = b2 + kstep;
            PG8_LDB(B0, 0, 0); PG8_LDB(B1, 0, 1); PG8_SCHED; PG8_LDA(At, 0, 0); PG8_STAGE(PG8_SA(1, 1), a1 + hstep, voffA);
            PG8_WAIT_V(8); PG8_WAIT_L(0); PG8_BAR; PG8_MMA(0, 0, At, B0); PG8_MMA(0, 1, At, B1); PG8_BAR; PG8_SCHED;
            PG8_LDA(At, 0, 1); PG8_STAGE(PG8_SB(0, 0), b2, voffB); PG8_STAGE(PG8_SB(0, 1), b2 + hstep, voffB); PG8_STAGE(PG8_SA(0, 0), a2, voffA);
            PG8_WAIT_V(8); PG8_WAIT_L(0); PG8_BAR; PG8_MMA(1, 0, At, B0); PG8_MMA(1, 1, At, B1); PG8_BAR; PG8_SCHED;
            PG8_LDB(B0, 1, 0); PG8_LDB(B1, 1, 1); PG8_SCHED; PG8_LDA(At, 1, 0); PG8_STAGE(PG8_SA(0, 1), a2 + hstep, voffA);
            PG8_WAIT_V(8); PG8_WAIT_L(0); PG8_BAR; PG8_MMA(0, 0, At, B0); PG8_MMA(0, 1, At, B1); PG8_BAR; PG8_SCHED;
            PG8_LDA(At, 1, 1); PG8_STAGE(PG8_SB(1, 0), b3, voffB); PG8_STAGE(PG8_SB(1, 1), b3 + hstep, voffB); PG8_STAGE(PG8_SA(1, 0), a3, voffA);
            PG8_WAIT_V(8); PG8_WAIT_L(0); PG8_BAR; PG8_MMA(1, 0, At, B0); PG8_MMA(1, 1, At, B1); PG8_BAR; PG8_SCHED;
        }
        if constexpr (ALIGN_EPI) { if (wr == 0) PG8_BAR; }
        E(acc, cur, wr, wc, fr, fq);
        if (!has_next) break;
#pragma unroll
        for (int a = 0; a < 2; ++a)
#pragma unroll
            for (int b = 0; b < 2; ++b)
#pragma unroll
                for (int m = 0; m < 4; ++m)
#pragma unroll
                    for (int n = 0; n < 2; ++n) acc[a][b][m][n] = (f32x4){0.f, 0.f, 0.f, 0.f};
        cur = nxt; cA = nA; cB = nB; ++ui;
        if constexpr (ALIGN_EPI) { if (wr == 1) PG8_BAR; }
    }
    PG8_WAIT_V(0);
    if constexpr (!ALIGN_EPI) { if (wr == 0) PG8_BAR; }
    PG8_BAR;
#undef PG8_SA
#undef PG8_SB
#undef PG8_STAGE
#undef PG8_LDA
#undef PG8_LDB
#undef PG8_MMA
#undef PG8_WAIT_V
#undef PG8_WAIT_L
#undef PG8_BAR
#undef PG8_SCHED
}

struct EpiBf16 {
    static constexpr bool PERM = true;
    bf16_t* O; int ldc;
    __device__ __forceinline__ void operator()(const f32x4 (&acc)[2][2][4][2], const Unit& u, int wr, int wc, int fr, int fq) const {
        const int row0 = u.pm * BM + wr * 64 + fr, col0 = u.pn * BM + wc * 32 + 8 * fq;
#pragma unroll
        for (int ai = 0; ai < 2; ++ai)
#pragma unroll
            for (int m = 0; m < 4; ++m) { bf16_t* rowp = O + (size_t)(row0 + ai * HALF + m * 16) * ldc + col0;
#pragma unroll
                for (int bj = 0; bj < 2; ++bj) { const f32x4 v0 = acc[ai][bj][m][0], v1 = acc[ai][bj][m][1];
                    u32x4 w; w.x = pk2(v0[0], v0[1]); w.y = pk2(v0[2], v0[3]); w.z = pk2(v1[0], v1[1]); w.w = pk2(v1[2], v1[3]);
                    *(u32x4*)(rowp + bj * HALF) = w; } }
    }
};
template <bool BASE_BF16, bool F32OUT> struct EpiRes {
    static constexpr bool PERM = false;
    const void* base; float* out; bf16_t* hb; const float* bias; float* ss;
    __device__ __forceinline__ void operator()(const f32x4 (&acc)[2][2][4][2], const Unit& u, int wr, int wc, int fr, int fq) const {
        const int col0 = u.pn * BM + wc * 32 + 4 * fq;
        f32x4 bv[2][2];
#pragma unroll
        for (int bj = 0; bj < 2; ++bj)
#pragma unroll
            for (int n = 0; n < 2; ++n) bv[bj][n] = bias ? *(const f32x4*)(bias + col0 + bj * HALF + n * 16) : (f32x4){0.f, 0.f, 0.f, 0.f};
#pragma unroll
        for (int ai = 0; ai < 2; ++ai)
#pragma unroll
            for (int m = 0; m < 4; ++m) { const int row = u.pm * BM + ai * HALF + wr * 64 + m * 16 + fr; const size_t off = (size_t)row * DM + col0; float s = 0.f;
#pragma unroll
                for (int bj = 0; bj < 2; ++bj)
#pragma unroll
                    for (int n = 0; n < 2; ++n) { const size_t o2 = off + bj * HALF + n * 16; f32x4 bs;
                        if (BASE_BF16) { const u32x2 w = *(const u32x2*)((const bf16_t*)base + o2); bs = (f32x4){bflo(w.x), bfhi(w.x), bflo(w.y), bfhi(w.y)}; } else bs = *(const f32x4*)((const float*)base + o2);
                        const f32x4 o = bs + acc[ai][bj][m][n] + bv[bj][n];
                        if (F32OUT) *(f32x4*)(out + o2) = o;
                        s += (o[0] * o[0] + o[1] * o[1]) + (o[2] * o[2] + o[3] * o[3]);
                        u32x2 w; w.x = pk2(o[0], o[1]); w.y = pk2(o[2], o[3]); *(u32x2*)(hb + o2) = w; }
                s += __shfl_xor(s, 16); s += __shfl_xor(s, 32);
                if (fq == 0) ss[(size_t)row * 16 + u.pn * 4 + wc] = s; }
    }
};
__device__ __forceinline__ float rstd_from_ss(const float* ss, int row) {
    const f32x4* p = (const f32x4*)(ss + (size_t)row * 16); const f32x4 a = p[0], b = p[1], c = p[2], d = p[3];
    const float t = ((a[0] + a[1]) + (a[2] + a[3])) + ((b[0] + b[1]) + (b[2] + b[3])) + ((c[0] + c[1]) + (c[2] + c[3])) + ((d[0] + d[1]) + (d[2] + d[3]));
    return __builtin_amdgcn_rsqf(t * (1.0f / DM) + EPS);
}
struct EpiSwiglu {
    static constexpr bool PERM = true;
    bf16_t* O; int ldc; const float* ss; const float* rstd;
    __device__ __forceinline__ void operator()(const f32x4 (&acc)[2][2][4][2], const Unit& u, int wr, int wc, int fr, int fq) const {
        const int row0 = u.pm * BM + wr * 64 + fr, col0 = u.pn * HALF + wc * 32 + 8 * fq;
#pragma unroll
        for (int ai = 0; ai < 2; ++ai)
#pragma unroll
            for (int m = 0; m < 4; ++m) { const int row = row0 + ai * HALF + m * 16; const float rs = ss ? rstd_from_ss(ss, row) : rstd[row];
                float h[8];
#pragma unroll
                for (int n = 0; n < 2; ++n)
#pragma unroll
                    for (int i = 0; i < 4; ++i) { const float gg = acc[ai][0][m][n][i] * rs, uu = acc[ai][1][m][n][i] * rs; h[n * 4 + i] = siluf_(gg) * uu; }
                *(u32x4*)(O + (size_t)row * ldc + col0) = pack8(h); }
    }
};
struct EpiQkv {
    static constexpr bool PERM = true;
    bf16_t* O; const float* ss; const float* bias; const float* qn; const float* kn; const float* rope;
    __device__ __forceinline__ void operator()(const f32x4 (&acc)[2][2][4][2], const Unit& u, int wr, int wc, int fr, int fq) const {
        const int hd = u.pn * 4 + wc, row0 = u.pm * BM + wr * 64 + fr; const int kind = u.pn < 4 ? 0 : (u.pn == 4 ? 1 : 2);
        const float* nw = kind == 0 ? qn : kn;
        float bv[2][8], nv[2][8];
#pragma unroll
        for (int bj = 0; bj < 2; ++bj)
#pragma unroll
            for (int j = 0; j < 8; ++j) { bv[bj][j] = bias[hd * 64 + bj * 32 + fq * 8 + j]; nv[bj][j] = nw[bj * 32 + fq * 8 + j]; }
#pragma unroll
        for (int ai = 0; ai < 2; ++ai)
#pragma unroll
            for (int m = 0; m < 4; ++m) { const int row = row0 + ai * HALF + m * 16; const float rs = rstd_from_ss(ss, row);
                float v[2][8]; float s = 0.f;
#pragma unroll
                for (int bj = 0; bj < 2; ++bj)
#pragma unroll
                    for (int n = 0; n < 2; ++n)
#pragma unroll
                        for (int i = 0; i < 4; ++i) { const float x = acc[ai][bj][m][n][i] * rs + bv[bj][n * 4 + i]; v[bj][n * 4 + i] = x; s += x * x; }
                if (kind < 2) {
                    s += __shfl_xor(s, 16); s += __shfl_xor(s, 32);
                    const float r2 = __builtin_amdgcn_rsqf(s * (1.0f / 64.0f) + EPS);
#pragma unroll
                    for (int bj = 0; bj < 2; ++bj)
#pragma unroll
                        for (int j = 0; j < 8; ++j) v[bj][j] = v[bj][j] * r2 * nv[bj][j];
                    const f32x4* rp = (const f32x4*)(rope + (size_t)row * 16);
                    const f32x4 c0 = rp[0], c1 = rp[1], s0 = rp[2], s1 = rp[3];
#pragma unroll
                    for (int j = 0; j < 8; ++j) { const float other = __shfl_xor(v[0][j], 16); const float cc = j < 4 ? c0[j] : c1[j - 4], sn = j < 4 ? s0[j] : s1[j - 4];
                        const float mine = v[0][j]; const float rot = (fq == 0) ? (mine * cc - other * sn) : (mine * cc + other * sn);
                        v[0][j] = (fq < 2) ? rot : mine; }
                }
#pragma unroll
                for (int bj = 0; bj < 2; ++bj) *(u32x4*)(O + (size_t)row * 1536 + hd * 64 + bj * 32 + fq * 8) = pack8(v[bj]);
            }
    }
};
}

#define XB_TMO      128
#define XB_XCNT(j)  (256  + 64 * (j))
#define XB_XSUB(j)  (1280 + 64 * (j))
#define XB_XGEN(j)  (2304 + 64 * (j))
#define XB_TOP      3328
#define XB_TOPGEN   3392
#define XCD_BAR_WORDS 3456
#define XB_SPIN_CAP (1u << 20)
__device__ __forceinline__ unsigned xb_ld(unsigned* p)              { return __hip_atomic_load(p, __ATOMIC_RELAXED, __HIP_MEMORY_SCOPE_AGENT); }
__device__ __forceinline__ unsigned xb_add(unsigned* p, unsigned v) { return __hip_atomic_fetch_add(p, v, __ATOMIC_RELAXED, __HIP_MEMORY_SCOPE_AGENT); }
__device__ __forceinline__ unsigned xb_xcc_id() { return (unsigned)__builtin_amdgcn_s_getreg((3 << 11) | 20) & 0xFu; }
#define XB_SPIN(cond, bar) do { unsigned _sp = 0; while (cond) { __builtin_amdgcn_s_sleep(1); \
    if ((++_sp & 255u) == 0u) { if (xb_ld(&(bar)[XB_TMO])) break; if (_sp > XB_SPIN_CAP) { atomicAdd(&(bar)[XB_TMO], 1u); break; } } } } while (0)
struct XcdBarrier { unsigned* bar; unsigned x; volatile LAS unsigned* st; };
__device__ __forceinline__ XcdBarrier xcd_barrier_post(unsigned* bar, volatile LAS unsigned* st) {
    XcdBarrier b; b.bar = bar; b.x = xb_xcc_id(); b.st = st;
    if (threadIdx.x == 0) (void)xb_add(&bar[XB_XCNT(b.x)], 1u);
    return b;
}
__device__ __forceinline__ void xcd_barrier_complete(unsigned* bar, unsigned x, unsigned& nloc, unsigned& nx) {
    const unsigned G = gridDim.x * gridDim.y * gridDim.z;
    unsigned sum, cnt, mine, sp = 0u;
    for (;;) {
        sum = 0u; cnt = 0u; mine = 0u;
#pragma unroll
        for (unsigned j = 0; j < 16; ++j) { const unsigned c = xb_ld(&bar[XB_XCNT(j)]); sum += c; cnt += (c > 0u) ? 1u : 0u; mine = (j == x) ? c : mine; }
        if (sum == G) break;
        __builtin_amdgcn_s_sleep(1);
        if ((++sp & 255u) == 0u) { if (xb_ld(&bar[XB_TMO])) break; if (sp > XB_SPIN_CAP) { atomicAdd(&bar[XB_TMO], 1u); break; } }
    }
    nloc = mine > 0u ? mine : 1u; nx = cnt > 0u ? cnt : 1u;
}
__device__ __forceinline__ void xcd_barrier(const XcdBarrier& b) {
    asm volatile("s_waitcnt vmcnt(0)" ::: "memory");
    __syncthreads();
    if (threadIdx.x == 0) {
        unsigned* bar = b.bar;
        __builtin_amdgcn_s_waitcnt(0);
        unsigned nloc = b.st[0], nx = b.st[1];
        if (nloc == 0u) { xcd_barrier_complete(bar, b.x, nloc, nx); b.st[0] = nloc; b.st[1] = nx; }
        const unsigned old = xb_add(&bar[XB_XSUB(b.x)], 1u);
        const unsigned gen = old / nloc;
        if (old + 1u == (gen + 1u) * nloc) {
            __builtin_amdgcn_fence(__ATOMIC_RELEASE, "agent");
            asm volatile("s_waitcnt vmcnt(0)" ::: "memory");
            const unsigned og = xb_add(&bar[XB_TOP], 1u);
            const unsigned tg = og / nx;
            if (og + 1u == (tg + 1u) * nx) xb_add(&bar[XB_TOPGEN], 1u);
            else XB_SPIN(xb_ld(&bar[XB_TOPGEN]) == tg, bar);
            __builtin_amdgcn_fence(__ATOMIC_ACQUIRE, "agent");
            xb_add(&bar[XB_XGEN(b.x)], 1u);
            asm volatile("s_waitcnt vmcnt(0)" ::: "memory");
        } else {
            XB_SPIN(xb_ld(&bar[XB_XGEN(b.x)]) == gen, bar);
            __builtin_amdgcn_fence(__ATOMIC_ACQUIRE, "agent");
            asm volatile("s_waitcnt vmcnt(0)" ::: "memory");
        }
    }
    __syncthreads();
}

struct Args { const float* in[39]; const int* pos; float* out; unsigned char* ws; int ph_lo, ph_hi, variant, pad; };
enum InIdx { I_X = 0, I_NORM_MIX0 = 1, I_W_IN, I_MU, I_W0, I_WDEC, I_A0, I_WICL, I_WGAT, I_KK, I_KA, I_RK, I_GNW, I_GNB, I_CONVW, I_CONVB, I_DTB, I_ALOG, I_DSKIP, I_SSDN,
             I_WOUT, I_NORM_FFN0, I_FG, I_FU, I_FD, I_NORM_MIX1, I_WQKV, I_BQKV, I_QN, I_KN, I_SINK, I_WO, I_BO, I_NORM_FFN1, I_ROUTER, I_EG, I_EU, I_ED };

__device__ __forceinline__ void transpose_item(const float* W, int ld, int K, int k0, int n0, bf16_t* WT, int drow, LAS float* scr, int lane, const float* gk) {
    f32x4 v[8]; const int kr = lane >> 3, n4 = 4 * (lane & 7); const float* wp = W + (size_t)(k0 + kr) * ld + n0 + n4;
#pragma unroll
    for (int i = 0; i < 8; ++i) v[i] = *(const f32x4*)(wp + (size_t)(8 * i) * ld);
    if (gk) { const float* gp = gk + k0 + kr;
#pragma unroll
        for (int i = 0; i < 8; ++i) v[i] = v[i] * gp[8 * i]; }
#pragma unroll
    for (int i = 0; i < 8; ++i) { LAS float* sp = scr + (8 * i + kr) * 33 + n4; sp[0] = v[i][0]; sp[1] = v[i][1]; sp[2] = v[i][2]; sp[3] = v[i][3]; }
    asm volatile("s_waitcnt lgkmcnt(0)" ::: "memory");
    const int c = lane & 7;
#pragma unroll
    for (int j = 0; j < 4; ++j) { const int n = (lane >> 3) + 8 * j; const LAS float* s = scr + (8 * c) * 33 + n;
        u32x4 o; o.x = pk2(s[0 * 33], s[1 * 33]); o.y = pk2(s[2 * 33], s[3 * 33]); o.z = pk2(s[4 * 33], s[5 * 33]); o.w = pk2(s[6 * 33], s[7 * 33]);
        *(u32x4*)(WT + (size_t)(drow + n) * K + k0 + 8 * c) = o; }
    asm volatile("s_waitcnt lgkmcnt(0)" ::: "memory");
}
__device__ __forceinline__ int drow_of(int kind, int n0) {
    if (kind == 0) return n0;
    if (kind == 1) return 256 * (n0 >> 7) + (n0 & 127);
    if (kind == 2) return 256 * (n0 >> 7) + 128 + (n0 & 127);
    const int hd = n0 >> 6, bj = (n0 >> 5) & 1; return 256 * (hd >> 2) + 128 * bj + 32 * (hd & 3);
}
__device__ __forceinline__ bool transpose_matrix(int& it, const float* W, int ld, int K, int ncols, bf16_t* WT, int kind, LAS float* scr, int lane, const float* gk = nullptr) {
    const int nnb = ncols / 32, items = (K / 64) * nnb;
    if (it < items) { const int kb = it / nnb, nb = it % nnb; transpose_item(W, ld, K, 64 * kb, 32 * nb, WT, drow_of(kind, 32 * nb), scr, lane, gk); return true; }
    it -= items; return false;
}

__device__ __forceinline__ u32x4 conv8(const bf16_t* proj, size_t m, int tpos, int c, const float* cw, const float* cb) {
    const bf16_t* p = proj + m * NPROJ + 2304 + c; u32x4 raw[4];
#pragma unroll
    for (int k = 0; k < 4; ++k) raw[k] = *(const u32x4*)(p - (size_t)(tpos >= k ? k : 0) * NPROJ);
    float acc[8];
    { const f32x4 b0 = *(const f32x4*)(cb + c), b1 = *(const f32x4*)(cb + c + 4); acc[0] = b0[0]; acc[1] = b0[1]; acc[2] = b0[2]; acc[3] = b0[3]; acc[4] = b1[0]; acc[5] = b1[1]; acc[6] = b1[2]; acc[7] = b1[3]; }
#pragma unroll
    for (int k = 0; k < 4; ++k) { float x[8]; unpack8(raw[k], x); const float ok = tpos >= k ? 1.f : 0.f; const f32x4 w0 = *(const f32x4*)(cw + (3 - k) * 1024 + c), w1 = *(const f32x4*)(cw + (3 - k) * 1024 + c + 4);
        acc[0] += ok * w0[0] * x[0]; acc[1] += ok * w0[1] * x[1]; acc[2] += ok * w0[2] * x[2]; acc[3] += ok * w0[3] * x[3]; acc[4] += ok * w1[0] * x[4]; acc[5] += ok * w1[1] * x[5]; acc[6] += ok * w1[2] * x[6]; acc[7] += ok * w1[3] * x[7]; }
#pragma unroll
    for (int i = 0; i < 8; ++i) acc[i] = siluf_(acc[i]);
    return pack8(acc);
}
__device__ __forceinline__ u32x2 conv4(const bf16_t* proj, size_t m, int tpos, int c, const float* cw, const float* cb) {
    const bf16_t* p = proj + m * NPROJ + 2304 + c; u32x2 raw[4];
#pragma unroll
    for (int k = 0; k < 4; ++k) raw[k] = *(const u32x2*)(p - (size_t)(tpos >= k ? k : 0) * NPROJ);
    f32x4 acc = *(const f32x4*)(cb + c);
#pragma unroll
    for (int k = 0; k < 4; ++k) { const float ok = tpos >= k ? 1.f : 0.f; const f32x4 w0 = *(const f32x4*)(cw + (3 - k) * 1024 + c);
        acc[0] += ok * w0[0] * bflo(raw[k].x); acc[1] += ok * w0[1] * bfhi(raw[k].x); acc[2] += ok * w0[2] * bflo(raw[k].y); acc[3] += ok * w0[3] * bfhi(raw[k].y); }
    u32x2 o; o.x = pk2(siluf_(acc[0]), siluf_(acc[1])); o.y = pk2(siluf_(acc[2]), siluf_(acc[3])); return o;
}

#ifndef DUPM
#define DUPM 0u
#endif

#define XN ((bf16_t*)(ws + WS_XN))
#define MIX ((bf16_t*)(ws + WS_MIX))
#define PROJ ((bf16_t*)(ws + WS_PROJ))
#define GOUT ((bf16_t*)(ws + WS_GOUT))
#define XNB ((bf16_t*)(ws + WS_XNB))
#define HID ((bf16_t*)(ws + WS_HID))
#define QKV ((bf16_t*)(ws + WS_QKV))
#define ATTO ((bf16_t*)(ws + WS_ATTO))
#define AS ((bf16_t*)(ws + WS_AS))
#define HS ((bf16_t*)(ws + WS_HS))
#define SSTATE ((bf16_t*)(ws + 54 * MiB))
#define CHDEC ((float*)(ws + WS_TOPE))
#define DTSP ((float*)(ws + WS_DTSP))
#define KKR ((float*)(ws + WS_KKR))
#define ROPE ((float*)(ws + WS_ROPE))
#define SS ((float*)(ws + WS_SS))
#define TOPE ((int*)(ws + WS_TOPE))
#define RANK ((int*)(ws + WS_RANK))
#define TOPW ((float*)(ws + WS_TOPW))
#define POS ((int*)(ws + WS_POS))
#define RSTD4 ((float*)(ws + WS_RSTD4))
#define RSTDS ((float*)(ws + WS_RSTDS))
#define WDEC ((bf16_t*)(ws + WS_WDEC))
#define WICL ((bf16_t*)(ws + WS_WICL))
#define WGAT ((bf16_t*)(ws + WS_WGAT))
#define EGU ((bf16_t*)(ws + WS_EGU))
#define EDN ((bf16_t*)(ws + WS_EDN))
#define WIN ((bf16_t*)(ws + WS_WIN))
#define WOUT ((bf16_t*)(ws + WS_WOUT))
#define WGU ((bf16_t*)(ws + WS_WGU))
#define WDN ((bf16_t*)(ws + WS_WDN))
#define WQKV ((bf16_t*)(ws + WS_WQKV))
#define WO ((bf16_t*)(ws + WS_WO))
struct TDesc { const float* src; bf16_t* dst; const float* gk; int ld, K; };
__device__ __forceinline__ void tdesc(TDesc& d, int it, const float* W, int ld, int K, int ncols, bf16_t* WT, int kind, const float* gk) {
    const int nnb = ncols / 32, kb = it / nnb, nb = it % nnb;
    d.src = W + (size_t)(64 * kb) * ld + 32 * nb; d.dst = WT + (size_t)drow_of(kind, 32 * nb) * K + 64 * kb; d.gk = gk ? gk + 64 * kb : nullptr; d.ld = ld; d.K = K;
}
constexpr int CV_P0 = 1728, CV_NE = CV_P0 + 6016, CV_EGU = CV_NE + 16 * 704, CV_END = CV_EGU + 8 * 704;
__device__ __forceinline__ void conv_resolve(const float* const* in, unsigned char* ws, int id, TDesc& d) {
    if (id < 1664) { tdesc(d, id, in[I_W_IN], IN0, DM, NPROJ, (bf16_t*)(ws + WS_WIN), 0, nullptr); return; } id -= 1664;
    if (id < 16) { tdesc(d, id, in[I_WDEC], 512, 64, 512, (bf16_t*)(ws + WS_WDEC), 0, nullptr); return; } id -= 16;
    if (id < 16) { tdesc(d, id, in[I_WICL], 512, 64, 512, (bf16_t*)(ws + WS_WICL), 0, nullptr); return; } id -= 16;
    if (id < 32) { tdesc(d, id, in[I_WGAT], 512, 128, 512, (bf16_t*)(ws + WS_WGAT), 0, nullptr); return; } id -= 32;
    if (id < 512) { tdesc(d, id, in[I_WOUT], DM, DM, DM, (bf16_t*)(ws + WS_WOUT), 0, nullptr); return; } id -= 512;
    if (id < 1408) { tdesc(d, id, in[I_FG], FFN, DM, FFN, (bf16_t*)(ws + WS_WGU), 1, in[I_NORM_FFN0]); return; } id -= 1408;
    if (id < 1408) { tdesc(d, id, in[I_FU], FFN, DM, FFN, (bf16_t*)(ws + WS_WGU), 2, in[I_NORM_FFN0]); return; } id -= 1408;
    if (id < 1408) { tdesc(d, id, in[I_FD], DM, FFN, DM, (bf16_t*)(ws + WS_WDN), 0, nullptr); return; } id -= 1408;
    if (id < 768) { tdesc(d, id, in[I_WQKV], 1536, DM, 1536, (bf16_t*)(ws + WS_WQKV), 3, in[I_NORM_MIX1]); return; } id -= 768;
    if (id < 512) { tdesc(d, id, in[I_WO], DM, DM, DM, (bf16_t*)(ws + WS_WO), 0, nullptr); return; } id -= 512;
    if (id < 16 * 704) { const int e = id / 1408, r = id % 1408, up = r / 704;
        tdesc(d, r % 704, in[up ? I_EU : I_EG] + (size_t)e * DM * FE, FE, DM, FE, (bf16_t*)(ws + WS_EGU) + (size_t)e * 2 * FE * DM, 1 + up, in[I_NORM_FFN1]); return; } id -= 16 * 704;
    { const int e = id / 704; tdesc(d, id % 704, in[I_ED] + (size_t)e * FE * DM, DM, FE, DM, (bf16_t*)(ws + WS_EDN) + (size_t)e * DM * FE, 0, nullptr); }
}
__device__ __forceinline__ void conv_load(const TDesc& d, f32x4 (&v)[8], int lane) {
    const float* wp = d.src + (size_t)(lane >> 3) * d.ld + 4 * (lane & 7);
#pragma unroll
    for (int i = 0; i < 8; ++i) v[i] = *(const f32x4*)(wp + (size_t)(8 * i) * d.ld);
}
__device__ __forceinline__ void conv_finish(const TDesc& d, f32x4 (&v)[8], LAS float* scr, int lane) {
    const int kr = lane >> 3, n4 = 4 * (lane & 7);
    if (d.gk) {
#pragma unroll
        for (int i = 0; i < 8; ++i) v[i] = v[i] * d.gk[kr + 8 * i]; }
#pragma unroll
    for (int i = 0; i < 8; ++i) { LAS float* sp = scr + (8 * i + kr) * 33 + n4; sp[0] = v[i][0]; sp[1] = v[i][1]; sp[2] = v[i][2]; sp[3] = v[i][3]; }
    asm volatile("s_waitcnt lgkmcnt(0)" ::: "memory");
    const int c = lane & 7;
#pragma unroll
    for (int j = 0; j < 4; ++j) { const int n = (lane >> 3) + 8 * j; const LAS float* s = scr + (8 * c) * 33 + n;
        u32x4 o; o.x = pk2(s[0 * 33], s[1 * 33]); o.y = pk2(s[2 * 33], s[3 * 33]); o.z = pk2(s[4 * 33], s[5 * 33]); o.w = pk2(s[6 * 33], s[7 * 33]);
        *(u32x4*)(d.dst + (size_t)n * d.K + 8 * c) = o; }
    asm volatile("s_waitcnt lgkmcnt(0)" ::: "memory");
}
__device__ __forceinline__ void conv_range(const float* const* in, unsigned char* ws, int lo, int hi, int first, int stride, LAS float* scr, int lane) {
    int id = lo + first; if (id >= hi) return;
    TDesc cur; conv_resolve(in, ws, id, cur); f32x4 v[8]; conv_load(cur, v, lane);
    for (;;) {
        const int idn = id + stride; const bool hn = idn < hi; TDesc nx = cur; f32x4 w[8];
        if (hn) { conv_resolve(in, ws, idn, nx); conv_load(nx, w, lane); }
        conv_finish(cur, v, scr, lane);
        if (!hn) break;
        cur = nx; id = idn;
#pragma unroll
        for (int i = 0; i < 8; ++i) v[i] = w[i];
    }
}

__global__ void __launch_bounds__(512, 2) fwd_kernel(Args args) {
    extern __shared__ __attribute__((aligned(16))) unsigned char lds_raw[];
    LAS unsigned char* lds = (LAS unsigned char*)lds_raw;
    volatile LAS unsigned* MISC = (volatile LAS unsigned*)(lds + MISC_OFF);
    const int tid = threadIdx.x, lane = tid & 63, wave = __builtin_amdgcn_readfirstlane(tid >> 6);
    const int G = gridDim.x, bx = blockIdx.x;
    const int vcu = (G % 8 == 0) ? (bx % 8) * (G / 8) + bx / 8 : bx;
    unsigned char* ws = args.ws;
    unsigned* ctl = (unsigned*)(ws + WS_CTL);
    float* dout = args.out;
    if (tid < 32) ((LAS unsigned*)(lds + MISC_OFF))[tid] = 0u;
    __syncthreads();
    XcdBarrier bar = xcd_barrier_post(ctl + CW_BAR, MISC + 8);
    const int lo = args.ph_lo, hi = args.ph_hi;
#define IN(k) (lo <= (k) && (k) < hi)
#if DUPM
#define PHASE(k) for (int rep_ = 0; rep_ <= (int)((DUPM >> (k)) & 1u); ++rep_) if (IN(k))
#define REPBAR if (rep_) xcd_barrier(bar);
#else
#define PHASE(k) if (IN(k))
#define REPBAR
#endif
#define SEAM(k) do { if (IN(k) && IN((k) + 1)) xcd_barrier(bar); } while (0)
    const int gw = vcu * 8 + wave, NGW = G * 8;

    unsigned* CNT = ctl + CW_CNT;

    PHASE(0) { REPBAR
        conv_range(args.in, ws, 0, CV_P0, gw, NGW, (LAS float*)(lds + wave * 16384), lane);
        __syncthreads();
        LAS float* w8 = (LAS float*)lds;
        for (int r = tid; r < DM; r += 512) { const float* p = args.in[I_W_IN] + (size_t)r * IN0 + NPROJ; *(LAS f32x4*)(w8 + r * 8) = *(const f32x4*)p; *(LAS f32x4*)(w8 + r * 8 + 4) = *(const f32x4*)(p + 4); }
        __syncthreads();
        const float* gm = args.in[I_NORM_MIX0];
#pragma unroll 1
        for (int k0 = 0; k0 < MTOK / NGW; k0 += 2) {
          f32x4 vv[2][4];
#pragma unroll
          for (int q = 0; q < 2; ++q) { const f32x4* xr = (const f32x4*)(args.in[I_X] + (size_t)(gw + (k0 + q) * NGW) * DM) + lane;
#pragma unroll
              for (int j = 0; j < 4; ++j) vv[q][j] = xr[64 * j]; }
#pragma unroll
          for (int q = 0; q < 2; ++q) { const int m = gw + (k0 + q) * NGW;
            f32x4 v[4]; float s = 0.f;
#pragma unroll
            for (int j = 0; j < 4; ++j) { v[j] = vv[q][j]; s += (v[j][0] * v[j][0] + v[j][1] * v[j][1]) + (v[j][2] * v[j][2] + v[j][3] * v[j][3]); }
            const float rstd = __builtin_amdgcn_rsqf(wave_sum(s) * (1.0f / DM) + EPS);
            float d[8];
#pragma unroll
            for (int k = 0; k < 8; ++k) d[k] = 0.f;
            unsigned long long* o8 = (unsigned long long*)(XN + (size_t)m * DM) + lane;
#pragma unroll
            for (int j = 0; j < 4; ++j) { const f32x4 g4 = ((const f32x4*)gm)[64 * j + lane]; const f32x4 y = v[j] * rstd * g4;
                o8[64 * j] = (unsigned long long)pk2(y[0], y[1]) | ((unsigned long long)pk2(y[2], y[3]) << 32);
#pragma unroll
                for (int i = 0; i < 4; ++i) { const int c = 256 * j + 4 * lane + i; const f32x4 wa = *(const LAS f32x4*)(w8 + c * 8), wb = *(const LAS f32x4*)(w8 + c * 8 + 4);
                    d[0] += y[i] * wa[0]; d[1] += y[i] * wa[1]; d[2] += y[i] * wa[2]; d[3] += y[i] * wa[3]; d[4] += y[i] * wb[0]; d[5] += y[i] * wb[1]; d[6] += y[i] * wb[2]; d[7] += y[i] * wb[3]; } }
            wave_sum8(d);
            if (lane < 8) { float dv = d[0];
#pragma unroll
                for (int k = 1; k < 8; ++k) dv = (lane == k) ? d[k] : dv;
                const float z = dv + args.in[I_DTB][lane]; DTSP[(size_t)m * 8 + lane] = z > 20.f ? z : log1pf(__expf(z)); }
            if (lane >= 16 && lane < 24) { const int j = lane - 16; const float inv = expf(-(float)j * (0.125f * 13.122363377404328f)); const float ang = (float)args.pos[m] * inv;
                float sn, cs; sincosf(ang, &sn, &cs); ROPE[(size_t)m * 16 + j] = cs; ROPE[(size_t)m * 16 + 8 + j] = sn; }
          }
        }
        __syncthreads();
    }
    SEAM(0);

    PHASE(1) { REPBAR
        pg8::Gemm g{XN, WIN, MTOK, NPROJ, DM}; pg8::StaticOrder S; S.init(MTOK, NPROJ, G, bx);
        pg8::EpiBf16 E{PROJ, NPROJ};
        pg8::gemm_phase(lds, g, S, E);
        if (bx >= 64) {
            conv_range(args.in, ws, CV_P0, CV_NE + 8 * 704, (bx - 64) * 8 + wave, 192 * 8, (LAS float*)(lds + wave * 16384), lane);
        }
    }
    SEAM(1);

#define LANE_CONSTS const int r32 = lane & 31, hh = lane >> 5, trq = (lane & 15) >> 2, trc = 16 * ((lane >> 4) & 1) + 4 * (lane & 3)
#define TRF(M, P, s, blk) ({ const LAS bf16_t* p_ = (M) + (16 * (s) + 8 * hh + trq) * (P) + 32 * (blk) + trc; \
        const s16x4 lo_ = __builtin_bit_cast(s16x4, __builtin_amdgcn_ds_read_tr16_b64_v4i16((LAS s16x4*)p_)); \
        const s16x4 hi_ = __builtin_bit_cast(s16x4, __builtin_amdgcn_ds_read_tr16_b64_v4i16((LAS s16x4*)(p_ + 4 * (P)))); \
        (bf16x8){lo_[0], lo_[1], lo_[2], lo_[3], hi_[0], hi_[1], hi_[2], hi_[3]}; })
#define NATF(M, P, s, blk) (*(const LAS bf16x8*)((M) + (32 * (blk) + r32) * (P) + 16 * (s) + 8 * hh))
    PHASE(2) { REPBAR
        LANE_CONSTS;
        const float* mu = args.in[I_MU];
        LAS bf16_t* Aw = (LAS bf16_t*)lds; LAS bf16_t* Aa = (LAS bf16_t*)(lds + 9216); LAS bf16_t* Ag = (LAS bf16_t*)(lds + 18432);
        LAS float* LW = (LAS float*)(lds + 35840); LAS float* IC = LW + 4096;
        LAS bf16_t* At = (LAS bf16_t*)(lds + 68864); LAS bf16_t* Kt = At + 4608; LAS bf16_t* Bt = Kt + 4608; LAS bf16_t* Rt = Bt + 4608; LAS bf16_t* Vt = Rt + 4608;
        LAS bf16_t* Lab = (LAS bf16_t*)(lds + 35840);
        LAS bf16_t* XX = At;
        LAS bf16_t* Lak = (LAS bf16_t*)(lds + 114944); LAS bf16_t* Mrk = Lak + 4608; LAS bf16_t* Mrb = Mrk + 4608;
        LAS float* TOT = (LAS float*)(lds + 142592); LAS float* GAMC = TOT + 512;
        const int mt = (wave >> 1) & 1, nt = wave & 1, grp = wave >> 2;
        for (int unit = vcu; unit < MTOK / 64; unit += G) {
            const int m0 = unit * 64;
            {
                const int tt = tid >> 3, cg = tid & 7, m = m0 + tt; const bool hasprev = (m & (SEQ - 1)) != 0;
                const bf16_t* pc = PROJ + (size_t)m * NPROJ + 1536 + 32 * cg;
#pragma unroll 1
                for (int q = 0; q < 4; ++q) {
                    float c[8], p[8]; unpack8(*(const u32x4*)(pc + 8 * q), c);
                    if (hasprev) unpack8(*(const u32x4*)(pc - NPROJ + 8 * q), p); else { for (int i = 0; i < 8; ++i) p[i] = 0.f; }
                    float o[8];
#pragma unroll
                    for (int i = 0; i < 8; ++i) { const int col = 32 * cg + 8 * q + i; const float x = c[i] + (p[i] - c[i]) * mu[1536 + col];
                        o[i] = cg < 2 ? tanhf(x) : (cg < 4 ? x : sigmoidf_(x)); }
                    const u32x4 w = pack8(o); const int col0 = 32 * cg + 8 * q;
                    if (cg < 2) *(LAS u32x4*)(Aw + tt * 72 + col0) = w; else if (cg < 4) *(LAS u32x4*)(Aa + tt * 72 + (col0 - 64)) = w; else *(LAS u32x4*)(Ag + tt * 136 + (col0 - 128)) = w;
                }
            }
            LBAR();
#pragma unroll 1
            for (int h = 0; h < 8; ++h) {
                unsigned char* cs = (unsigned char*)dout + (size_t)(unit * 8 + h) * 24576;
                float r0v[8], k0v[8], v0v[8]; float pr = 0.f, pk = 0.f, pv = 0.f;
                {   const bf16_t* pp = PROJ + (size_t)(m0 + 8 * wave) * NPROJ + 64 * h + lane;
                    if (((m0 + 8 * wave) & (SEQ - 1)) != 0) { pr = bflo(pp[-NPROJ]); pk = bflo(pp[-NPROJ + 512]); pv = bflo(pp[-NPROJ + 1024]); }
#pragma unroll
                    for (int i = 0; i < 8; ++i) { r0v[i] = bflo(pp[(size_t)i * NPROJ]); k0v[i] = bflo(pp[(size_t)i * NPROJ + 512]); v0v[i] = bflo(pp[(size_t)i * NPROJ + 1024]); } }
                if (grp == 0) {
                    f32x16 ad, ai;
#pragma unroll
                    for (int r = 0; r < 16; ++r) { ad[r] = 0.f; ai[r] = 0.f; }
#pragma unroll
                    for (int s = 0; s < 4; ++s) {
                        const bf16x8 bd = *(const bf16x8*)(WDEC + (size_t)(64 * h + 32 * nt + r32) * 64 + 16 * s + 8 * hh), bi = *(const bf16x8*)(WICL + (size_t)(64 * h + 32 * nt + r32) * 64 + 16 * s + 8 * hh);
                        ad = __builtin_amdgcn_mfma_f32_32x32x16_bf16(NATF(Aw, 72, s, mt), bd, ad, 0, 0, 0);
                        ai = __builtin_amdgcn_mfma_f32_32x32x16_bf16(NATF(Aa, 72, s, mt), bi, ai, 0, 0, 0);
                    }
                    const int c = 32 * nt + r32; const float w0c = args.in[I_W0][64 * h + c], a0c = args.in[I_A0][64 * h + c];
                    LAS float* lwb = LW + (32 * mt + 4 * hh) * 64 + c;
#pragma unroll
                    for (int r = 0; r < 16; ++r) { lwb[crc(r) * 64] = -0.6065306597126334f * sigmoidf_(ad[r] + w0c); lwb[4096 + crc(r) * 64] = sigmoidf_(ai[r] + a0c); }
                } else {
                    f32x16 ag;
#pragma unroll
                    for (int r = 0; r < 16; ++r) ag[r] = 0.f;
#pragma unroll
                    for (int s = 0; s < 8; ++s) {
                        const bf16x8 bg = *(const bf16x8*)(WGAT + (size_t)(64 * h + 32 * nt + r32) * 128 + 16 * s + 8 * hh);
                        ag = __builtin_amdgcn_mfma_f32_32x32x16_bf16(NATF(Ag, 136, s, mt), bg, ag, 0, 0, 0);
                    }
                    bf16_t* gob = GOUT + (size_t)(m0 + 32 * mt + 4 * hh) * 512 + 64 * h + 32 * nt + r32;
#pragma unroll
                    for (int r = 0; r < 16; ++r) gob[crc(r) * 512] = (bf16_t)f2bf(ag[r]);
                }
                LBAR();
                {
                    const int c = lane, gc = 64 * h + c, t0 = 8 * wave;
                    const float mur = mu[gc], muk = mu[512 + gc], muv = mu[1024 + gc], kkc = args.in[I_KK][gc], kac = args.in[I_KA][gc], rkc = args.in[I_RK][gc];
                    float rr[8], kx[8], vv[8], an[8], bn[8], lw[8], cl[8]; float run = 0.f;
#pragma unroll
                    for (int i = 0; i < 8; ++i) {
                        const float r0 = r0v[i], k0 = k0v[i], v0 = v0v[i];
                        rr[i] = r0 + (pr - r0) * mur; const float kl = k0 + (pk - k0) * muk; vv[i] = v0 + (pv - v0) * muv; pr = r0; pk = k0; pv = v0;
                        const float ic = IC[(t0 + i) * 64 + c]; lw[i] = LW[(t0 + i) * 64 + c]; run += lw[i]; cl[i] = run;
                        const float xk = kl * kkc; const float ssq = dpp_sum63(xk * xk); const float kn = xk * __builtin_amdgcn_rsqf(ssq + 1e-12f);
                        an[i] = -kn; bn[i] = kn * ic; kx[i] = kl * (1.0f + (ic - 1.0f) * kac);
                        const float bon = dpp_sum63(rr[i] * kx[i] * rkc);
                        if (lane == 0) KKR[(size_t)(m0 + t0 + i) * 8 + h] = bon;
                    }
                    TOT[wave * 64 + c] = run;
                    LBAR();
                    float off = 0.f, totc = 0.f;
#pragma unroll
                    for (int w2 = 0; w2 < 8; ++w2) { const float tv = TOT[w2 * 64 + c]; totc += tv; off += (w2 < wave) ? tv : 0.f; }
                    if (wave == 0) GAMC[c] = __expf(totc);
#pragma unroll
                    for (int i = 0; i < 8; ++i) { const float cum = off + cl[i]; const float en = __expf(-cum), ep = __expf(cum), em = __expf(cum - lw[i]); const int o = (t0 + i) * 72 + c;
                        At[o] = (bf16_t)f2bf(an[i] * em); Kt[o] = (bf16_t)f2bf(kx[i] * en); Bt[o] = (bf16_t)f2bf(bn[i] * en); Rt[o] = (bf16_t)f2bf(rr[i] * ep); Vt[o] = (bf16_t)f2bf(vv[i]); }
                }
                LBAR();
                {
                    f32x16 pb, pk2_;
#pragma unroll
                    for (int r = 0; r < 16; ++r) { pb[r] = 0.f; pk2_[r] = 0.f; }
                    const LAS bf16_t* Aop = grp == 0 ? At : Rt;
#pragma unroll
                    for (int s = 0; s < 4; ++s) { const bf16x8 a = NATF(Aop, 72, s, mt);
                        pb = __builtin_amdgcn_mfma_f32_32x32x16_bf16(a, NATF(Bt, 72, s, nt), pb, 0, 0, 0);
                        pk2_ = __builtin_amdgcn_mfma_f32_32x32x16_bf16(a, NATF(Kt, 72, s, nt), pk2_, 0, 0, 0); }
                    const int sc = 32 * nt + r32, tb = 32 * mt + 4 * hh;
                    LAS bf16_t* o1 = (grp == 0 ? Lab : Mrb) + tb * 72 + sc; LAS bf16_t* o2 = (grp == 0 ? Lak : Mrk) + tb * 72 + sc;
#pragma unroll
                    for (int r = 0; r < 16; ++r) { const int t = tb + crc(r); const bool keep = grp == 0 ? (sc < t) : (sc <= t);
                        o1[crc(r) * 72] = (bf16_t)f2bf(keep ? pb[r] : 0.f); o2[crc(r) * 72] = (bf16_t)f2bf(keep ? pk2_[r] : 0.f); }
                }
                LBAR();
                f32x16 accA, accB;
#pragma unroll
                for (int r = 0; r < 16; ++r) { accA[r] = 0.f; accB[r] = 0.f; }
                {
                    const LAS bf16_t* Aop = grp == 0 ? Lak : Mrk;
#pragma unroll
                    for (int s = 0; s < 4; ++s) { const bf16x8 vb = TRF(Vt, 72, s, nt);
                        if (grp == 0) { accA = __builtin_amdgcn_mfma_f32_32x32x16_bf16(NATF(Aop, 72, s, mt), vb, accA, 0, 0, 0); accB = __builtin_amdgcn_mfma_f32_32x32x16_bf16(TRF(Kt, 72, s, mt), vb, accB, 0, 0, 0); }
                        else accB = __builtin_amdgcn_mfma_f32_32x32x16_bf16(NATF(Aop, 72, s, mt), vb, accB, 0, 0, 0); }
                    if (grp == 0) { LAS float* ggb = IC + (32 * mt + 4 * hh) * 65 + 32 * nt + r32;
#pragma unroll
                        for (int r = 0; r < 16; ++r) ggb[crc(r) * 65] = accA[r]; }
                }
                LBAR();
                {
                    const int n16 = lane & 15, g4 = lane >> 4;
                    f32x4 Rr[4];
                    if (wave < 4) {
#pragma unroll
                        for (int I = 0; I < 4; ++I)
#pragma unroll
                            for (int j = 0; j < 4; ++j) Rr[I][j] = bflo((unsigned)At[(16 * I + 4 * g4 + j) * 72 + 16 * wave + n16]);
                    } else { const LAS float* GG = IC;
#pragma unroll
                        for (int I = 0; I < 4; ++I)
#pragma unroll
                            for (int j = 0; j < 4; ++j) Rr[I][j] = GG[(16 * I + 4 * g4 + j) * 65 + 16 * (wave - 4) + n16];
                    }
                    LBAR();
                    const LAS bf16_t* lrow = Lab + n16 * 72 + 4 * g4;
#define LF(I, J) (*(const LAS u32x2*)(lrow + (16 * (I)) * 72 + 16 * (J)))
#define MF16(A0, A1, B0, B1, C) __builtin_amdgcn_mfma_f32_16x16x32_bf16(__builtin_bit_cast(bf16x8, (u32x4){(A0).x, (A0).y, (A1).x, (A1).y}), __builtin_bit_cast(bf16x8, (u32x4){(B0).x, (B0).y, (B1).x, (B1).y}), (C), 0, 0, 0)
                    const u32x2 zz = (u32x2){0u, 0u};
                    u32x2 Xb[4];
#pragma unroll
                    for (int I = 0; I < 4; ++I) {
                        f32x4 Z = Rr[I];
                        if (I == 1) Z = MF16(LF(1, 0), zz, Xb[0], zz, Z);
                        if (I == 2) Z = MF16(LF(2, 0), LF(2, 1), Xb[0], Xb[1], Z);
                        if (I == 3) { Z = MF16(LF(3, 0), LF(3, 1), Xb[0], Xb[1], Z); Z = MF16(LF(3, 2), zz, Xb[2], zz, Z); }
                        const u32x2 ld = LF(I, I);
                        f32x4 X = Z;
#pragma unroll
                        for (int it = 0; it < 15; ++it) { u32x2 xb; xb.x = pk2(X[0], X[1]); xb.y = pk2(X[2], X[3]); X = MF16(ld, zz, xb, zz, Z); }
                        Xb[I].x = pk2(X[0], X[1]); Xb[I].y = pk2(X[2], X[3]);
                        LAS bf16_t* xo = XX + (16 * I + 4 * g4) * 136 + 16 * wave + n16;
                        xo[0] = (bf16_t)(Xb[I].x & 0xffffu); xo[136] = (bf16_t)(Xb[I].x >> 16); xo[272] = (bf16_t)(Xb[I].y & 0xffffu); xo[408] = (bf16_t)(Xb[I].y >> 16);
                    }
#undef LF
#undef MF16
                }
                LBAR();
                {
                    f32x16 acc1;
#pragma unroll
                    for (int r = 0; r < 16; ++r) acc1[r] = 0.f;
#pragma unroll
                    for (int s = 0; s < 4; ++s) {
                        const bf16x8 a = grp == 0 ? TRF(Bt, 72, s, mt) : NATF(Mrb, 72, s, mt);
                        acc1 = __builtin_amdgcn_mfma_f32_32x32x16_bf16(a, TRF(XX, 136, s, nt), acc1, 0, 0, 0);
                        accB = __builtin_amdgcn_mfma_f32_32x32x16_bf16(a, TRF(XX + 64, 136, s, nt), accB, 0, 0, 0);
                    }
                    const int col = 32 * nt + r32, rb = 32 * mt + 4 * hh;
                    if (grp == 0) {
                        bf16_t* acb = (bf16_t*)cs + rb * 64 + col; bf16_t* dcb = (bf16_t*)(cs + 8192) + col * 64 + rb; const LAS float* gb = GAMC + rb;
#pragma unroll
                        for (int r = 0; r < 16; ++r) { const float gcv = gb[crc(r)]; acb[crc(r) * 64] = (bf16_t)f2bf(gcv * (acc1[r] + ((rb + crc(r)) == col ? 1.0f : 0.0f))); }
#pragma unroll
                        for (int rq = 0; rq < 4; ++rq) { const f32x4 g4 = *(const LAS f32x4*)(gb + 8 * rq);
                            u32x2 w; w.x = pk2(accB[4 * rq] * g4[0], accB[4 * rq + 1] * g4[1]); w.y = pk2(accB[4 * rq + 2] * g4[2], accB[4 * rq + 3] * g4[3]); *(u32x2*)(dcb + 8 * rq) = w; }
                    } else {
                        bf16_t* rpb = (bf16_t*)(cs + 16384) + rb * 64 + col; const LAS bf16_t* rtb = Rt + rb * 72 + col; bf16_t* yb = MIX + (size_t)(m0 + rb) * DM + 64 * h + col;
#pragma unroll
                        for (int r = 0; r < 16; ++r) { rpb[crc(r) * 64] = (bf16_t)f2bf(acc1[r] + bflo((unsigned)rtb[crc(r) * 72])); yb[crc(r) * DM] = (bf16_t)f2bf(accB[r]); }
                    }
                }
                LBAR();
            }
        }
    }

    SEAM(2);

    PHASE(3) { REPBAR
        LANE_CONSTS;
        if (vcu < 32) {
            const int b = vcu >> 3, h = vcu & 7;
            const unsigned char* cbase = (const unsigned char*)dout + (size_t)(b * 64 * 8 + h) * 24576;
            constexpr size_t CSTR = (size_t)8 * 24576; constexpr int SLOT = 27648;
            const bool loader = wave >= 2; const int lt = tid - 128;
            int poff[4];
#pragma unroll
            for (int k = 0; k < 4; ++k) { const int p = lt + 384 * k; poff[k] = (p >> 9) * 9216 + ((p & 511) >> 3) * 144 + (p & 7) * 16; }
            u32x4 st[4][4];
#define RB_ISSUE(set, ch) do { if (loader) { const unsigned char* g_ = cbase + (size_t)(ch) * CSTR + (size_t)lt * 16; _Pragma("unroll") for (int k = 0; k < 4; ++k) st[set][k] = *(const u32x4*)(g_ + k * 6144); } } while (0)
#define RB_WRITE(set, ch) do { if (loader) { LAS unsigned char* s_ = lds + ((ch) & 3) * SLOT; _Pragma("unroll") for (int k = 0; k < 4; ++k) *(LAS u32x4*)(s_ + poff[k]) = st[set][k]; } } while (0)
            RB_ISSUE(0, 0); RB_ISSUE(1, 1); RB_WRITE(0, 0); RB_WRITE(1, 1);
            RB_ISSUE(2, 2); RB_ISSUE(3, 3); RB_ISSUE(0, 4); RB_ISSUE(1, 5);
            LBAR();
            f32x16 H[2];
#pragma unroll
            for (int r = 0; r < 16; ++r) { H[0][r] = 0.f; H[1][r] = 0.f; }
            bf16_t* zp = (bf16_t*)((unsigned char*)dout + 48 * MiB) + (size_t)(b * SEQ + 4 * hh) * 512 + 64 * h + 32 * wave + r32;
#define RB_STEP(j, chv) do { const int ch_ = (chv); \
                if (loader) { if (ch_ + 2 < 64) RB_WRITE(((j) + 2) & 3, ch_ + 2); if (ch_ + 6 < 64) RB_ISSUE(((j) + 2) & 3, ch_ + 6); } \
                else { const LAS unsigned char* sl = lds + (ch_ & 3) * SLOT; f32x16 Hn[2], Z[2]; bf16x8 Hb[4]; \
                    _Pragma("unroll") for (int s = 0; s < 4; ++s) { const int m = s >> 1, o = 8 * (s & 1); u32x4 t; t.x = pk2(H[m][o], H[m][o + 1]); t.y = pk2(H[m][o + 2], H[m][o + 3]); t.z = pk2(H[m][o + 4], H[m][o + 5]); t.w = pk2(H[m][o + 6], H[m][o + 7]); Hb[s] = __builtin_bit_cast(bf16x8, t); } \
                    _Pragma("unroll") for (int m = 0; m < 2; ++m) { \
                        _Pragma("unroll") for (int rq = 0; rq < 4; ++rq) { const u32x2 d = *(const LAS u32x2*)(sl + 9216 + (32 * wave + r32) * 144 + (32 * m + 8 * rq + 4 * hh) * 2); \
                            Hn[m][4 * rq] = bflo(d.x); Hn[m][4 * rq + 1] = bfhi(d.x); Hn[m][4 * rq + 2] = bflo(d.y); Hn[m][4 * rq + 3] = bfhi(d.y); } \
                        _Pragma("unroll") for (int r = 0; r < 16; ++r) Z[m][r] = 0.f; } \
                    _Pragma("unroll") for (int s = 0; s < 4; ++s) \
                        _Pragma("unroll") for (int m = 0; m < 2; ++m) { const int o = (32 * m + r32) * 144 + (16 * s + 4 * hh) * 2; \
                            const u32x2 a0 = *(const LAS u32x2*)(sl + o), a1 = *(const LAS u32x2*)(sl + o + 16), q0 = *(const LAS u32x2*)(sl + 18432 + o), q1 = *(const LAS u32x2*)(sl + 18432 + o + 16); \
                            u32x4 t; t.x = a0.x; t.y = a0.y; t.z = a1.x; t.w = a1.y; Hn[m] = __builtin_amdgcn_mfma_f32_32x32x16_bf16(__builtin_bit_cast(bf16x8, t), Hb[s], Hn[m], 0, 0, 0); \
                            t.x = q0.x; t.y = q0.y; t.z = q1.x; t.w = q1.y; Z[m] = __builtin_amdgcn_mfma_f32_32x32x16_bf16(__builtin_bit_cast(bf16x8, t), Hb[s], Z[m], 0, 0, 0); } \
                    H[0] = Hn[0]; H[1] = Hn[1]; \
                    bf16_t* zq = zp + (size_t)ch_ * 64 * 512; \
                    _Pragma("unroll") for (int m = 0; m < 2; ++m) _Pragma("unroll") for (int r = 0; r < 16; ++r) zq[(32 * m + crc(r)) * 512] = (bf16_t)f2bf(Z[m][r]); } \
                LBAR(); } while (0)
            if (wave < 2 || loader) {
                for (int ch = 0; ch < 64; ch += 4) { RB_STEP(0, ch); RB_STEP(1, ch + 1); RB_STEP(2, ch + 2); RB_STEP(3, ch + 3); }
            }
#undef RB_STEP
#undef RB_ISSUE
#undef RB_WRITE
        } else {
            LAS bf16_t* Bm = (LAS bf16_t*)lds; LAS bf16_t* Xh = (LAS bf16_t*)(lds + 34816); LAS float* CUM = (LAS float*)(lds + 53248); LAS float* DTL = CUM + 512;
            for (int unit = vcu - 32; unit < 256; unit += G - 32) {
                const int g = unit & 1, c = (unit >> 1) & 31, b = unit >> 6, m0 = b * SEQ + c * 128;
#pragma unroll 1
                for (int k = 0; k < 4; ++k) { const int p = tid + 512 * k, row = p >> 4, c16 = p & 15; *(LAS u32x4*)(Bm + row * 136 + 8 * c16) = conv8(PROJ, (size_t)(m0 + row), c * 128 + row, 512 + 128 * g + 8 * c16, args.in[I_CONVW], args.in[I_CONVB]); }
                if (wave < 4) { const int h = 4 * g + wave; const float a_h = -__expf(args.in[I_ALOG][h]);
                    const float v0 = DTSP[(size_t)(m0 + 2 * lane) * 8 + h], v1 = DTSP[(size_t)(m0 + 2 * lane + 1) * 8 + h]; float s = v0 + v1;
#pragma unroll
                    for (int o = 1; o < 64; o <<= 1) { const float t = __shfl_up(s, o); if (lane >= o) s += t; }
                    const float ex = s - (v0 + v1);
                    CUM[wave * 128 + 2 * lane] = a_h * (ex + v0); CUM[wave * 128 + 2 * lane + 1] = a_h * (ex + v0 + v1); DTL[wave * 128 + 2 * lane] = v0; DTL[wave * 128 + 2 * lane + 1] = v1; }
                LBAR();
#pragma unroll 1
                for (int hq = 0; hq < 4; ++hq) { const int h = 4 * g + hq;
                    { const int s = tid >> 2, cq = 16 * (tid & 3); const float sc = DTL[hq * 128 + s] * __expf(CUM[hq * 128 + 127] - CUM[hq * 128 + s]);
#pragma unroll 1
                      for (int q = 0; q < 2; ++q) { float f[8]; unpack8(conv8(PROJ, (size_t)(m0 + s), c * 128 + s, 64 * h + cq + 8 * q, args.in[I_CONVW], args.in[I_CONVB]), f);
#pragma unroll
                          for (int i = 0; i < 8; ++i) f[i] *= sc;
                          *(LAS u32x4*)(Xh + s * 72 + cq + 8 * q) = pack8(f); } }
                    LBAR();
                    const int mt = wave >> 2, nt = wave & 3; f32x16 acc;
#pragma unroll
                    for (int r = 0; r < 16; ++r) acc[r] = 0.f;
#pragma unroll
                    for (int ks = 0; ks < 8; ++ks) acc = __builtin_amdgcn_mfma_f32_32x32x16_bf16(TRF(Xh, 72, ks, mt), TRF(Bm, 136, ks, nt), acc, 0, 0, 0);
                    bf16_t* sp = SSTATE + ((size_t)((b * 32 + c) * 8 + h)) * 8192 + (32 * mt + 4 * hh) * 128 + 32 * nt + r32;
#pragma unroll
                    for (int r = 0; r < 16; ++r) sp[crc(r) * 128] = (bf16_t)f2bf(acc[r]);
                    if (tid == 0) CHDEC[(b * 32 + c) * 8 + h] = __expf(CUM[hq * 128 + 127]);
                    LBAR();
                }
            }
            conv_range(args.in, ws, CV_NE + 8 * 704, CV_EGU, (vcu - 32) * 8 + wave, (G - 32) * 8, (LAS float*)(lds + wave * 16384), lane);
        }
    }

    SEAM(3);

    PHASE(4) { REPBAR
        const int gt = vcu * 512 + tid, bh = gt >> 12, e2 = gt & 4095, b = bh >> 3, h = bh & 7;
        unsigned* sp = (unsigned*)SSTATE + ((size_t)(b * 32 * 8 + h)) * 4096 + e2;
        unsigned vals[32];
#pragma unroll
        for (int c = 0; c < 32; ++c) vals[c] = sp[(size_t)c * 8 * 4096];
        float r0 = 0.f, r1 = 0.f;
#pragma unroll
        for (int c = 0; c < 32; ++c) { const float dec = CHDEC[(b * 32 + c) * 8 + h]; sp[(size_t)c * 8 * 4096] = pk2(r0, r1); r0 = r0 * dec + bflo(vals[c]); r1 = r1 * dec + bfhi(vals[c]); }
    }
    SEAM(4);

    PHASE(5) { REPBAR
        LANE_CONSTS;
        {
            LAS bf16_t* Cm = (LAS bf16_t*)lds; LAS bf16_t* Bm = (LAS bf16_t*)(lds + 34816); LAS bf16_t* Xh = (LAS bf16_t*)(lds + 69632); LAS bf16_t* Hp = (LAS bf16_t*)(lds + 88064);
            LAS float* CUM = (LAS float*)(lds + 105472); LAS float* DTL = CUM + 512;
            for (int unit = vcu; unit < 256; unit += G) {
                const int g = unit & 1, c = (unit >> 1) & 31, b = unit >> 6, m0 = b * SEQ + c * 128;
#pragma unroll 1
                for (int k = 0; k < 4; ++k) { const int p = tid + 512 * k, row = p >> 4, c16 = p & 15;
                    *(LAS u32x4*)(Bm + row * 136 + 8 * c16) = conv8(PROJ, (size_t)(m0 + row), c * 128 + row, 512 + 128 * g + 8 * c16, args.in[I_CONVW], args.in[I_CONVB]);
                    *(LAS u32x4*)(Cm + row * 136 + 8 * c16) = conv8(PROJ, (size_t)(m0 + row), c * 128 + row, 768 + 128 * g + 8 * c16, args.in[I_CONVW], args.in[I_CONVB]); }
                if (wave < 4) { const int h = 4 * g + wave; const float a_h = -__expf(args.in[I_ALOG][h]);
                    const float v0 = DTSP[(size_t)(m0 + 2 * lane) * 8 + h], v1 = DTSP[(size_t)(m0 + 2 * lane + 1) * 8 + h]; float s = v0 + v1;
#pragma unroll
                    for (int o = 1; o < 64; o <<= 1) { const float t = __shfl_up(s, o); if (lane >= o) s += t; }
                    const float ex = s - (v0 + v1);
                    CUM[wave * 128 + 2 * lane] = a_h * (ex + v0); CUM[wave * 128 + 2 * lane + 1] = a_h * (ex + v0 + v1); DTL[wave * 128 + 2 * lane] = v0; DTL[wave * 128 + 2 * lane + 1] = v1; }
                LBAR();
                const int mt = wave >> 1, nb = 2 * (wave & 1), nt2 = wave & 1;
                f32x16 cb[2];
#pragma unroll
                for (int r = 0; r < 16; ++r) { cb[0][r] = 0.f; cb[1][r] = 0.f; }
#pragma unroll
                for (int ks = 0; ks < 8; ++ks) { const bf16x8 a = NATF(Cm, 136, ks, mt);
                    cb[0] = __builtin_amdgcn_mfma_f32_32x32x16_bf16(a, NATF(Bm, 136, ks, nb), cb[0], 0, 0, 0); cb[1] = __builtin_amdgcn_mfma_f32_32x32x16_bf16(a, NATF(Bm, 136, ks, nb + 1), cb[1], 0, 0, 0); }
                LBAR();
                LAS bf16_t* Wt = Bm;
#pragma unroll 1
                for (int hq = 0; hq < 4; ++hq) { const int h = 4 * g + hq;
                    u32x4 ph[2];
                    { const bf16_t* hp = SSTATE + ((size_t)((b * 32 + c) * 8 + h)) * 8192;
#pragma unroll
                      for (int k = 0; k < 2; ++k) { const int p = tid + 512 * k; ph[k] = *(const u32x4*)(hp + (p >> 4) * 128 + 8 * (p & 15)); } }
#pragma unroll
                    for (int j = 0; j < 2; ++j) { const int s = 32 * (nb + j) + r32; const float cs = CUM[hq * 128 + s], ds = DTL[hq * 128 + s]; const int lb = 32 * mt + 4 * hh;
                        LAS bf16_t* wp = Wt + lb * 136 + s; const LAS float* cl = CUM + hq * 128 + lb;
#pragma unroll
                        for (int r = 0; r < 16; ++r) { const float w = (s <= lb + crc(r)) ? cb[j][r] * __expf(cl[crc(r)] - cs) * ds : 0.f; wp[crc(r) * 136] = (bf16_t)f2bf(w); } }
                    { const int s = tid >> 2, cq = 16 * (tid & 3);
#pragma unroll 1
                      for (int q = 0; q < 2; ++q) *(LAS u32x4*)(Xh + s * 72 + cq + 8 * q) = conv8(PROJ, (size_t)(m0 + s), c * 128 + s, 64 * h + cq + 8 * q, args.in[I_CONVW], args.in[I_CONVB]); }
#pragma unroll
                    for (int k = 0; k < 2; ++k) { const int p = tid + 512 * k, row = p >> 4, c16 = p & 15; *(LAS u32x4*)(Hp + row * 136 + 8 * c16) = ph[k]; }
                    LBAR();
                    f32x16 yd, yo;
#pragma unroll
                    for (int r = 0; r < 16; ++r) { yd[r] = 0.f; yo[r] = 0.f; }
#pragma unroll
                    for (int ks = 0; ks < 8; ++ks) { yd = __builtin_amdgcn_mfma_f32_32x32x16_bf16(NATF(Wt, 136, ks, mt), TRF(Xh, 72, ks, nt2), yd, 0, 0, 0);
                        yo = __builtin_amdgcn_mfma_f32_32x32x16_bf16(NATF(Cm, 136, ks, mt), NATF(Hp, 136, ks, nt2), yo, 0, 0, 0); }
                    { const LAS float* cl = CUM + hq * 128 + 32 * mt + 4 * hh; bf16_t* yb = MIX + (size_t)(m0 + 32 * mt + 4 * hh) * DM + 512 + 256 * g + 64 * hq + 32 * nt2 + r32;
#pragma unroll
                      for (int r = 0; r < 16; ++r) yb[crc(r) * DM] = (bf16_t)f2bf(yd[r] + __expf(cl[crc(r)]) * yo[r]); }
                    LBAR();
                }
                __syncthreads();
                for (int i4 = 0; i4 < 16; i4 += 4) { const int ch = 256 * g + 4 * lane; const float dsk = args.in[I_DSKIP][4 * g + (lane >> 4)]; const f32x4 nw = *(const f32x4*)(args.in[I_SSDN] + ch);
                  u32x2 xv4[4], zv4[4];
#pragma unroll
                  for (int q = 0; q < 4; ++q) { const size_t m = (size_t)(m0 + wave * 16 + i4 + q); xv4[q] = conv4(PROJ, m, c * 128 + wave * 16 + i4 + q, ch, args.in[I_CONVW], args.in[I_CONVB]); zv4[q] = *(const u32x2*)(PROJ + m * NPROJ + 1792 + ch); }
#pragma unroll
                  for (int q = 0; q < 4; ++q) { const int l = wave * 16 + i4 + q; const size_t m = (size_t)(m0 + l);
                    const u32x2 yv = *(const u32x2*)(MIX + m * DM + 512 + ch), xv = xv4[q], zv = zv4[q];
                    float v[4] = {bflo(yv.x), bfhi(yv.x), bflo(yv.y), bfhi(yv.y)}; const float xs[4] = {bflo(xv.x), bfhi(xv.x), bflo(xv.y), bfhi(xv.y)}, zz[4] = {bflo(zv.x), bfhi(zv.x), bflo(zv.y), bfhi(zv.y)};
                    float qs = 0.f;
#pragma unroll
                    for (int j = 0; j < 4; ++j) { v[j] = (v[j] + dsk * xs[j]) * siluf_(zz[j]); qs += v[j] * v[j]; }
                    qs = wave_sum(qs); const float rq = __builtin_amdgcn_rsqf(qs * (1.0f / 256.0f) + EPS);
                    u32x2 o; o.x = pk2(v[0] * rq * nw[0], v[1] * rq * nw[1]); o.y = pk2(v[2] * rq * nw[2], v[3] * rq * nw[3]); *(u32x2*)(MIX + m * DM + 512 + ch) = o; } }
                LBAR();
            }
        }
        {
            const int c0 = 8 * lane, h = lane >> 3; const float* mu = args.in[I_MU];
            float muv[8], gw_[8], gb_[8];
#pragma unroll
            for (int i = 0; i < 8; ++i) { muv[i] = mu[1024 + c0 + i]; gw_[i] = args.in[I_GNW][c0 + i]; gb_[i] = args.in[I_GNB][c0 + i]; }
#pragma unroll 1
            for (int k0 = 0; k0 < MTOK / NGW; k0 += 4) {
                u32x4 ry[4], rz[4], rv[4], rp[4], rg[4]; float bdv[4];
#pragma unroll
                for (int q = 0; q < 4; ++q) { const size_t m = (size_t)(gw + (k0 + q) * NGW); const bool hasprev = (m & (SEQ - 1)) != 0;
                    ry[q] = *(const u32x4*)(MIX + m * DM + c0); rz[q] = *(const u32x4*)((const bf16_t*)((const unsigned char*)dout + 48 * MiB) + m * 512 + c0);
                    const bf16_t* pc = PROJ + m * NPROJ + c0 + 1024; rv[q] = *(const u32x4*)pc; rp[q] = hasprev ? *(const u32x4*)(pc - NPROJ) : (u32x4){0u, 0u, 0u, 0u};
                    rg[q] = *(const u32x4*)(GOUT + m * 512 + c0); bdv[q] = KKR[m * 8 + h]; }
#pragma unroll
                for (int q = 0; q < 4; ++q) { const size_t m = (size_t)(gw + (k0 + q) * NGW);
                    float y[8], v[8], p[8], go[8];
                    unpack8(ry[q], y); unpack8(rz[q], p);
#pragma unroll
                    for (int i = 0; i < 8; ++i) y[i] += p[i];
                    unpack8(rv[q], v); unpack8(rp[q], p);
#pragma unroll
                    for (int i = 0; i < 8; ++i) v[i] += (p[i] - v[i]) * muv[i];
                    unpack8(rg[q], go);
                    float s1 = 0.f; const float bd = bdv[q];
#pragma unroll
                    for (int i = 0; i < 8; ++i) s1 += y[i];
                    s1 += __shfl_xor(s1, 1); s1 += __shfl_xor(s1, 2); s1 += __shfl_xor(s1, 4);
                    const float mean = s1 * (1.0f / 64.0f); float s2 = 0.f;
#pragma unroll
                    for (int i = 0; i < 8; ++i) { const float d = y[i] - mean; s2 += d * d; }
                    s2 += __shfl_xor(s2, 1); s2 += __shfl_xor(s2, 2); s2 += __shfl_xor(s2, 4);
                    const float rs = __builtin_amdgcn_rsqf(s2 * (1.0f / 64.0f) + 64e-5f);
                    float o[8];
#pragma unroll
                    for (int i = 0; i < 8; ++i) o[i] = ((y[i] - mean) * rs * gw_[i] + gb_[i] + bd * v[i]) * go[i];
                    *(u32x4*)(MIX + m * DM + c0) = pack8(o); }
            }
        }
    }
    SEAM(5);


    PHASE(6) { REPBAR
        pg8::Gemm g{MIX, WOUT, MTOK, DM, DM}; pg8::StaticOrder S; S.init(MTOK, DM, G, bx);
        pg8::EpiRes<false, false> E{args.in[I_X], nullptr, XNB, nullptr, SS};
        pg8::gemm_phase(lds, g, S, E);
    }
    SEAM(6);
    PHASE(7) { REPBAR
        pg8::Gemm g{XNB, WGU, MTOK, 2 * FFN, DM}; pg8::StaticOrder S; S.init(MTOK, 2 * FFN, G, bx);
        pg8::EpiSwiglu E{HID, FFN, SS, nullptr};
        pg8::gemm_phase(lds, g, S, E);
    }
    SEAM(7);
    PHASE(8) { REPBAR
        pg8::Gemm g{HID, WDN, MTOK, DM, FFN}; pg8::StaticOrder S; S.init(MTOK, DM, G, bx);
        pg8::EpiRes<true, false> E{XNB, nullptr, XNB, nullptr, SS};
        pg8::gemm_phase(lds, g, S, E);
    }
    SEAM(8);
    PHASE(9) { REPBAR
        pg8::Gemm g{XNB, WQKV, MTOK, 1536, DM}; pg8::StaticOrder S; S.init(MTOK, 1536, G, bx);
        pg8::EpiQkv E{QKV, SS, args.in[I_BQKV], args.in[I_QN], args.in[I_KN], ROPE};
        pg8::gemm_phase(lds, g, S, E);
        if (bx >= 128) {
            conv_range(args.in, ws, CV_EGU, CV_END, (bx - 128) * 8 + wave, 128 * 8, (LAS float*)(lds + wave * 16384), lane);
        }
    }
    SEAM(9);

    PHASE(10) { REPBAR
        LAS bf16_t* Kt = (LAS bf16_t*)lds; LAS bf16_t* Vt = (LAS bf16_t*)(lds + 36864);
        const int r32 = lane & 31, hh = lane >> 5;
        for (int unit = vcu; unit < BATCH * 4 * 32; unit += G) {
            const int blk = unit & 31, kvh = (unit >> 5) & 3, b = unit >> 7;
            {
                const int rowi = tid >> 1, half = tid & 1; const int tpos = (blk - 1) * 128 + rowi;
#pragma unroll
                for (int q = 0; q < 4; ++q) { u32x4 kv = (u32x4){0, 0, 0, 0}, vv = kv;
                    if (tpos >= 0) { const bf16_t* p = QKV + (size_t)(b * SEQ + tpos) * 1536 + 1024 + kvh * 64 + half * 32 + 8 * q; kv = *(const u32x4*)p; vv = *(const u32x4*)(p + 256); }
                    *(LAS u32x4*)(Kt + rowi * 72 + half * 32 + 8 * q) = kv; *(LAS u32x4*)(Vt + rowi * 72 + half * 32 + 8 * q) = vv; }
            }
            __syncthreads();
            const int gq = wave >> 1, qh = kvh * 4 + gq; const float sink = args.in[I_SINK][qh];
            for (int it = 0; it < 2; ++it) {
                const int qi = (wave & 1) * 64 + it * 32 + r32; const size_t mq = (size_t)b * SEQ + blk * 128 + qi;
                bf16x8 qr[4];
#pragma unroll
                for (int s = 0; s < 4; ++s) qr[s] = *(const bf16x8*)(QKV + mq * 1536 + qh * 64 + 16 * s + 8 * hh);
                const int a0 = (wave & 1) * 2 + it;
                f32x16 sc[5];
#pragma unroll
                for (int j = 0; j < 5; ++j) {
#pragma unroll
                    for (int r = 0; r < 16; ++r) sc[j][r] = 0.f;
#pragma unroll
                    for (int s = 0; s < 4; ++s) { const bf16x8 kf = *(const LAS bf16x8*)(Kt + (32 * (a0 + j) + r32) * 72 + 16 * s + 8 * hh); sc[j] = __builtin_amdgcn_mfma_f32_32x32x16_bf16(kf, qr[s], sc[j], 0, 0, 0); }
                }
                float mx = sink;
#pragma unroll
                for (int j = 0; j < 5; ++j)
#pragma unroll
                    for (int r = 0; r < 16; ++r) { const int kj = 32 * (a0 + j) + crow(r, hh); const bool valid = (kj > qi) && (kj <= qi + 128) && (blk > 0 || kj >= 128);
                        const float x = valid ? sc[j][r] * 0.125f : -1e30f; sc[j][r] = x; mx = fmaxf(mx, x); }
                mx = fmaxf(mx, __shfl_xor(mx, 32));
                float l = 0.f;
#pragma unroll
                for (int j = 0; j < 5; ++j)
#pragma unroll
                    for (int r = 0; r < 16; ++r) { const float p = __expf(sc[j][r] - mx); sc[j][r] = p; l += p; }
                l += __shfl_xor(l, 32); l += __expf(sink - mx);
                const float inv = 1.0f / l;
                f32x16 o[2];
#pragma unroll
                for (int dt = 0; dt < 2; ++dt)
#pragma unroll
                    for (int r = 0; r < 16; ++r) o[dt][r] = 0.f;
#pragma unroll
                for (int j = 0; j < 5; ++j)
#pragma unroll
                    for (int s2 = 0; s2 < 2; ++s2) {
                        u32x4 pw; pw.x = pk2(sc[j][8 * s2 + 0], sc[j][8 * s2 + 1]); pw.y = pk2(sc[j][8 * s2 + 2], sc[j][8 * s2 + 3]); pw.z = pk2(sc[j][8 * s2 + 4], sc[j][8 * s2 + 5]); pw.w = pk2(sc[j][8 * s2 + 6], sc[j][8 * s2 + 7]);
                        const bf16x8 pf = __builtin_bit_cast(bf16x8, pw);
                        const int key0 = 32 * (a0 + j) + 16 * s2 + 4 * hh + ((lane & 15) >> 2);
#pragma unroll
                        for (int dt = 0; dt < 2; ++dt) {
                            const LAS bf16_t* vp = Vt + key0 * 72 + 32 * dt + 16 * ((lane >> 4) & 1) + 4 * (lane & 3);
                            const s16x4 lo = __builtin_bit_cast(s16x4, __builtin_amdgcn_ds_read_tr16_b64_v4i16((LAS s16x4*)vp));
                            const s16x4 hi = __builtin_bit_cast(s16x4, __builtin_amdgcn_ds_read_tr16_b64_v4i16((LAS s16x4*)(vp + 8 * 72)));
                            const bf16x8 vf = (bf16x8){lo[0], lo[1], lo[2], lo[3], hi[0], hi[1], hi[2], hi[3]};
                            o[dt] = __builtin_amdgcn_mfma_f32_32x32x16_bf16(vf, pf, o[dt], 0, 0, 0);
                        }
                    }
                bf16_t* op = ATTO + mq * DM + qh * 64;
#pragma unroll
                for (int dt = 0; dt < 2; ++dt)
#pragma unroll
                    for (int rq = 0; rq < 4; ++rq) { u32x2 w; w.x = pk2(o[dt][4 * rq] * inv, o[dt][4 * rq + 1] * inv); w.y = pk2(o[dt][4 * rq + 2] * inv, o[dt][4 * rq + 3] * inv);
                        *(u32x2*)(op + 32 * dt + 8 * rq + 4 * hh) = w; }
            }
            __syncthreads();
        }
    }
    SEAM(10);

    PHASE(11) { REPBAR
        pg8::Gemm g{ATTO, WO, MTOK, DM, DM}; pg8::StaticOrder S; S.init(MTOK, DM, G, bx);
        pg8::EpiRes<true, true> E{XNB, dout, XNB, args.in[I_BO], SS};
        pg8::gemm_phase(lds, g, S, E);
    }
    SEAM(11);

    PHASE(12) { REPBAR
        LAS float* w8 = (LAS float*)lds; LAS unsigned* lcnt = (LAS unsigned*)(lds + 32768); LAS unsigned* lbase = lcnt + 8; LAS unsigned* lsel = lcnt + 16;
        for (int r = tid; r < DM; r += 512) { const float* p = args.in[I_ROUTER] + (size_t)r * 8; *(LAS f32x4*)(w8 + r * 8) = *(const f32x4*)p; *(LAS f32x4*)(w8 + r * 8 + 4) = *(const f32x4*)(p + 4); }
        if (tid < 8) lcnt[tid] = 0u;
        __syncthreads();
        const float* gm = args.in[I_NORM_FFN1];
        int kk = 0;
        for (int m = gw; m < MTOK; m += NGW, ++kk) {
            const f32x4* xr = (const f32x4*)(dout + (size_t)m * DM) + lane;
            f32x4 v[4]; float s = 0.f;
#pragma unroll
            for (int j = 0; j < 4; ++j) { v[j] = xr[64 * j]; s += (v[j][0] * v[j][0] + v[j][1] * v[j][1]) + (v[j][2] * v[j][2] + v[j][3] * v[j][3]); }
            const float rstd = __builtin_amdgcn_rsqf(wave_sum(s) * (1.0f / DM) + EPS);
            float d[8];
#pragma unroll
            for (int k = 0; k < 8; ++k) d[k] = 0.f;
#pragma unroll
            for (int j = 0; j < 4; ++j) { const f32x4 g4 = ((const f32x4*)gm)[64 * j + lane]; const f32x4 y = v[j] * rstd * g4;
#pragma unroll
                for (int i = 0; i < 4; ++i) { const int c = 256 * j + 4 * lane + i; const f32x4 wa = *(const LAS f32x4*)(w8 + c * 8), wb = *(const LAS f32x4*)(w8 + c * 8 + 4);
                    d[0] += y[i] * wa[0]; d[1] += y[i] * wa[1]; d[2] += y[i] * wa[2]; d[3] += y[i] * wa[3]; d[4] += y[i] * wb[0]; d[5] += y[i] * wb[1]; d[6] += y[i] * wb[2]; d[7] += y[i] * wb[3]; } }
            wave_sum8(d);
            int e0 = 0; float v0 = d[0];
#pragma unroll
            for (int k = 1; k < 8; ++k) if (d[k] > v0) { v0 = d[k]; e0 = k; }
            int e1 = -1; float v1 = -3.0e38f;
#pragma unroll
            for (int k = 0; k < 8; ++k) if (k != e0 && d[k] > v1) { v1 = d[k]; e1 = k; }
            if (lane == 0) {
                const float w0 = __builtin_amdgcn_rcpf(1.0f + __expf(v1 - v0));
                const unsigned r0 = atomicAdd((unsigned*)(lcnt + e0), 1u), r1 = atomicAdd((unsigned*)(lcnt + e1), 1u);
                lsel[(wave * 8 + kk) * 2] = ((unsigned)e0 << 16) | r0; lsel[(wave * 8 + kk) * 2 + 1] = ((unsigned)e1 << 16) | r1;
                TOPE[2 * m] = e0; TOPE[2 * m + 1] = e1; TOPW[2 * m] = w0; TOPW[2 * m + 1] = 1.0f - w0; RSTD4[m] = rstd;
            }
        }
        __syncthreads();
        if (tid < 8) lbase[tid] = atomicAdd(CNT + tid, lcnt[tid]);
        __syncthreads();
        if (tid < 128) { const int row = tid >> 1, w_ = row >> 3, k_ = row & 7; const int m = (vcu * 8 + w_) + k_ * NGW; if (m < MTOK) { const unsigned sv = lsel[tid]; RANK[2 * m + (tid & 1)] = (int)(lbase[sv >> 16] + (sv & 0xffffu)); } }
        __syncthreads();
    }
    SEAM(12);

    PHASE(13) { REPBAR
        int roff[NEXP]; { int t = 0;
#pragma unroll
            for (int e = 0; e < NEXP; ++e) { roff[e] = t; t += (int)((CNT[e] + 255u) >> 8) << 8; } }
        {
            const int myj = gw + (lane & 15) * NGW, e = TOPE[myj]; int ro = roff[0];
#pragma unroll
            for (int k = 1; k < NEXP; ++k) ro = (e == k) ? roff[k] : ro;
            const int mypos = ro + RANK[myj];
            if (lane < 16) { POS[myj] = mypos; RSTDS[mypos] = RSTD4[myj >> 1]; }
#pragma unroll
            for (int k0 = 0; k0 < 16; k0 += 4) {
                u32x4 v[4][2]; int pos[4];
#pragma unroll
                for (int q = 0; q < 4; ++q) { pos[q] = __builtin_amdgcn_readlane(mypos, k0 + q); const int m = (gw + (k0 + q) * NGW) >> 1;
                    const u32x4* sp = (const u32x4*)(XNB + (size_t)m * DM) + lane; v[q][0] = sp[0]; v[q][1] = sp[64]; }
#pragma unroll
                for (int q = 0; q < 4; ++q) { u32x4* dp = (u32x4*)(AS + (size_t)pos[q] * DM) + lane; dp[0] = v[q][0]; dp[64] = v[q][1]; }
            }
        }
    }
    SEAM(13);
    PHASE(14) { REPBAR
        pg8::Gemm g{AS, EGU, SROWS, 2 * FE, DM}; pg8::MoeOrder S; S.init(CNT, 2 * FE / 256, G, bx, (long)2 * FE * DM * 2);
        pg8::EpiSwiglu E{HS, FE, nullptr, RSTDS};
        pg8::gemm_phase(lds, g, S, E);
    }
    SEAM(14);
    PHASE(15) { REPBAR
        pg8::Gemm g{HS, EDN, SROWS, DM, FE}; pg8::MoeOrder S; S.init(CNT, DM / 256, G, bx, (long)DM * FE * 2);
        pg8::EpiBf16 E{AS, DM};
        pg8::gemm_phase(lds, g, S, E);
    }
    SEAM(15);
    PHASE(16) { REPBAR
        {
            const int mym = gw + (lane & 7) * NGW; const int q0 = POS[2 * mym], q1 = POS[2 * mym + 1]; const float u0 = TOPW[2 * mym], u1 = TOPW[2 * mym + 1];
#pragma unroll
            for (int k0 = 0; k0 < 8; k0 += 2) {
                u32x4 ya[2][2], yb[2][2]; f32x4 hv[2][4]; float w0[2], w1[2];
#pragma unroll
                for (int t = 0; t < 2; ++t) { const int p0 = __builtin_amdgcn_readlane(q0, k0 + t), p1 = __builtin_amdgcn_readlane(q1, k0 + t);
                    w0[t] = __builtin_bit_cast(float, __builtin_amdgcn_readlane(__builtin_bit_cast(int, u0), k0 + t)); w1[t] = __builtin_bit_cast(float, __builtin_amdgcn_readlane(__builtin_bit_cast(int, u1), k0 + t));
                    const u32x4* y0 = (const u32x4*)(AS + (size_t)p0 * DM) + lane; const u32x4* y1 = (const u32x4*)(AS + (size_t)p1 * DM) + lane;
                    ya[t][0] = y0[0]; ya[t][1] = y0[64]; yb[t][0] = y1[0]; yb[t][1] = y1[64];
                    const f32x4* o = (const f32x4*)(dout + (size_t)(gw + (k0 + t) * NGW) * DM);
                    hv[t][0] = o[2 * lane]; hv[t][1] = o[2 * lane + 1]; hv[t][2] = o[128 + 2 * lane]; hv[t][3] = o[128 + 2 * lane + 1]; }
#pragma unroll
                for (int t = 0; t < 2; ++t) { f32x4* o = (f32x4*)(dout + (size_t)(gw + (k0 + t) * NGW) * DM);
#pragma unroll
                    for (int q = 0; q < 2; ++q) { float a[8], c[8]; unpack8(ya[t][q], a); unpack8(yb[t][q], c); f32x4 h0 = hv[t][2 * q], h1 = hv[t][2 * q + 1];
#pragma unroll
                        for (int i = 0; i < 4; ++i) { h0[i] += w0[t] * a[i] + w1[t] * c[i]; h1[i] += w0[t] * a[4 + i] + w1[t] * c[4 + i]; }
                        o[128 * q + 2 * lane] = h0; o[128 * q + 2 * lane + 1] = h1; } }
            }
        }
    }
#undef TRF
#undef NATF
#undef IN
#undef SEAM
#undef PHASE
#undef REPBAR
}

constexpr int NPHASE = 17;
extern "C" void kernel_launch(void* const* d_in, const int* in_sizes, int n_in, void* d_out, int out_size, void* d_ws, size_t ws_size, hipStream_t stream) {
    static int grid = 0;
    if (grid == 0) {
        if (n_in != 39 || out_size != MTOK * DM || ws_size < WS_END) { fprintf(stderr, "kernel_launch: unexpected shapes n_in %d out %d ws %zu\n", n_in, out_size, ws_size); grid = -1; return; }
        int dev = 0, cus = 0;
        if (hipGetDevice(&dev) != hipSuccess || hipDeviceGetAttribute(&cus, hipDeviceAttributeMultiprocessorCount, dev) != hipSuccess) { grid = -1; return; }
        if (hipFuncSetAttribute((const void*)fwd_kernel, hipFuncAttributeMaxDynamicSharedMemorySize, LDS_BYTES) != hipSuccess) { fprintf(stderr, "kernel_launch: hipFuncSetAttribute failed\n"); grid = -1; return; }
        int per_cu = 0; (void)hipOccupancyMaxActiveBlocksPerMultiprocessor(&per_cu, (const void*)fwd_kernel, 512, LDS_BYTES); (void)hipGetLastError();
        grid = 256; if (cus != 256 || per_cu < 1) fprintf(stderr, "kernel_launch: note: cus %d per_cu %d\n", cus, per_cu);
    }
    if (grid < 0) return;
    Args a{};
    a.in[0] = (const float*)d_in[0];
    for (int i = 2; i < 39; ++i) a.in[i - 1] = (const float*)d_in[i];
    a.pos = (const int*)d_in[1]; a.out = (float*)d_out; a.ws = (unsigned char*)d_ws;
    (void)hipMemsetAsync((char*)d_ws + WS_CTL, 0, CTL_ZERO_BYTES, stream);
#ifdef PROBE_PHASE
    constexpr int pp = PROBE_PHASE; constexpr bool before = (pp == 2 || pp == 3 || pp == 5 || pp == 6 || pp == 8 || pp == 11 || pp == 12);
#ifdef PROBE_VARIANT
    a.variant = PROBE_VARIANT;
#endif
    if (before) { a.ph_lo = pp; a.ph_hi = pp + 1; hipLaunchKernelGGL(fwd_kernel, dim3(grid), dim3(512), LDS_BYTES, stream, a); (void)hipMemsetAsync((char*)d_ws + WS_CTL, 0, CTL_ZERO_BYTES, stream); }
    a.variant = 0;
#endif
    a.ph_lo = 0; a.ph_hi = NPHASE;
    hipLaunchKernelGGL(fwd_kernel, dim3(grid), dim3(512), LDS_BYTES, stream, a);
#ifdef PROBE_PHASE
    if (!before) { (void)hipMemsetAsync((char*)d_ws + WS_CTL, 0, CW_CNT * 4, stream);
#ifdef PROBE_VARIANT
        a.variant = PROBE_VARIANT;
#endif
        a.ph_lo = pp; a.ph_hi = pp + 1; hipLaunchKernelGGL(fwd_kernel, dim3(grid), dim3(512), LDS_BYTES, stream, a); }
#endif
}
```

```cpp
#include <hip/hip_runtime.h>
#include <cstdio>
#include <cstdint>

#define LAS __attribute__((address_space(3)))
#define GAS __attribute__((address_space(1)))
typedef unsigned short bf16_t;
typedef short bf16x8 __attribute__((ext_vector_type(8)));
typedef float f32x4 __attribute__((ext_vector_type(4)));
typedef float f32x2 __attribute__((ext_vector_type(2)));
typedef float f32x16 __attribute__((ext_vector_type(16)));
typedef unsigned u32x4 __attribute__((ext_vector_type(4)));
typedef unsigned u32x2 __attribute__((ext_vector_type(2)));
typedef short s16x4 __attribute__((ext_vector_type(4)));

constexpr int BATCH = 4, SEQ = 4096, DM = 1024, MTOK = BATCH * SEQ;
constexpr int IN0 = 3336, NPROJ = 3328;
constexpr int FFN = 2816, FE = 1408, NEXP = 8;
constexpr int SROWS = 2 * MTOK + NEXP * 256;
constexpr float EPS = 1e-6f;

constexpr size_t MiB = 1u << 20;
constexpr size_t WS_CTL = 0, CTL_ZERO_BYTES = 64 * 1024;
constexpr size_t WS_DTSP = 1 * MiB;
constexpr size_t WS_KKR = 1 * MiB + 512 * 1024;
constexpr size_t WS_ROPE = 2 * MiB;
constexpr size_t WS_SS = 3 * MiB;
constexpr size_t WS_TOPE = 4 * MiB;
constexpr size_t WS_RANK = 4 * MiB + 128 * 1024;
constexpr size_t WS_TOPW = 4 * MiB + 256 * 1024;
constexpr size_t WS_POS = 4 * MiB + 384 * 1024;
constexpr size_t WS_RSTD4 = 4 * MiB + 512 * 1024;
constexpr size_t WS_RSTDS = 4 * MiB + 640 * 1024;
constexpr size_t WS_WDEC = 5 * MiB;
constexpr size_t WS_WICL = 5 * MiB + 64 * 1024;
constexpr size_t WS_WGAT = 5 * MiB + 128 * 1024;
constexpr size_t WS_EGU = 6 * MiB;
constexpr size_t WS_EDN = 50 * MiB;
constexpr size_t WS_WIN = 72 * MiB;
constexpr size_t WS_WOUT = WS_WIN + (size_t)NPROJ * DM * 2;
constexpr size_t WS_WGU = WS_WOUT + 2 * MiB;
constexpr size_t WS_WDN = WS_WGU + 11 * MiB;
constexpr size_t WS_WQKV = WS_WDN + (size_t)DM * FFN * 2;
constexpr size_t WS_WO = WS_WQKV + 3 * MiB;
constexpr size_t R0 = 102 * MiB;
static_assert(WS_WO + 2 * MiB <= R0, "weights");
constexpr size_t WS_XN = R0, WS_MIX = R0;
constexpr size_t WS_PROJ = R0 + 32 * MiB;
constexpr size_t WS_GOUT = R0 + 136 * MiB;
constexpr size_t WS_XNB = R0 + 104 * MiB;
constexpr size_t WS_HID = R0;
constexpr size_t WS_QKV = R0;
constexpr size_t WS_ATTO = R0 + 48 * MiB;
constexpr size_t WS_AS = 72 * MiB;
constexpr size_t WS_HS = 140 * MiB;
constexpr size_t WS_END = 254 * MiB;
static_assert(WS_AS + (size_t)SROWS * DM * 2 <= WS_HS && WS_HS + (size_t)SROWS * FE * 2 <= WS_END && WS_GOUT + 16 * MiB <= WS_END, "map");
constexpr size_t DO_XBCC = 0, DO_DECAY = 32 * MiB, DO_ICLR = 48 * MiB;
constexpr int CW_BAR = 4096, CW_CNT = 8192;

constexpr int LDS_BYTES = 147456, RING_BYTES = 131072, MISC_OFF = LDS_BYTES - 128;

__device__ __forceinline__ unsigned f2bf(float f) { unsigned u = __builtin_bit_cast(unsigned, f); return (u + 0x7fffu + ((u >> 16) & 1u)) >> 16; }
typedef __bf16 bf16x2_t __attribute__((ext_vector_type(2)));
__device__ __forceinline__ unsigned pk2(float lo, float hi) { const f32x2 v = {lo, hi}; const bf16x2_t b = __builtin_convertvector(v, bf16x2_t); return __builtin_bit_cast(unsigned, b); }
__device__ __forceinline__ float bflo(unsigned u) { return __builtin_bit_cast(float, u << 16); }
__device__ __forceinline__ float bfhi(unsigned u) { return __builtin_bit_cast(float, u & 0xffff0000u); }
__device__ __forceinline__ void unpack8(const u32x4 v, float* f) { f[0] = bflo(v.x); f[1] = bfhi(v.x); f[2] = bflo(v.y); f[3] = bfhi(v.y); f[4] = bflo(v.z); f[5] = bfhi(v.z); f[6] = bflo(v.w); f[7] = bfhi(v.w); }
__device__ __forceinline__ u32x4 pack8(const float* f) { u32x4 v; v.x = pk2(f[0], f[1]); v.y = pk2(f[2], f[3]); v.z = pk2(f[4], f[5]); v.w = pk2(f[6], f[7]); return v; }
__device__ __forceinline__ float sigmoidf_(float x) { return __builtin_amdgcn_rcpf(1.0f + __expf(-x)); }
__device__ __forceinline__ float siluf_(float x) { return x * __builtin_amdgcn_rcpf(1.0f + __expf(-x)); }
#define LBAR() do { asm volatile("s_waitcnt lgkmcnt(0)" ::: "memory"); __builtin_amdgcn_s_barrier(); asm volatile("" ::: "memory"); } while (0)
__device__ __forceinline__ float wave_sum(float v) {
#pragma unroll
    for (int o = 1; o < 64; o <<= 1) v += __shfl_xor(v, o);
    return v;
}
__device__ __forceinline__ float dpp_sum63(float x) {
    int v;
    v = __builtin_amdgcn_update_dpp(0, __builtin_bit_cast(int, x), 0xB1, 0xF, 0xF, false); x += __builtin_bit_cast(float, v);
    v = __builtin_amdgcn_update_dpp(0, __builtin_bit_cast(int, x), 0x4E, 0xF, 0xF, false); x += __builtin_bit_cast(float, v);
    v = __builtin_amdgcn_update_dpp(0, __builtin_bit_cast(int, x), 0x141, 0xF, 0xF, false); x += __builtin_bit_cast(float, v);
    v = __builtin_amdgcn_update_dpp(0, __builtin_bit_cast(int, x), 0x140, 0xF, 0xF, false); x += __builtin_bit_cast(float, v);
    v = __builtin_amdgcn_update_dpp(0, __builtin_bit_cast(int, x), 0x142, 0xA, 0xF, false); x += __builtin_bit_cast(float, v);
    v = __builtin_amdgcn_update_dpp(0, __builtin_bit_cast(int, x), 0x143, 0xC, 0xF, false); x += __builtin_bit_cast(float, v);
    return __builtin_bit_cast(float, __builtin_amdgcn_readlane(__builtin_bit_cast(int, x), 63));
}
__device__ __forceinline__ void wave_sum8(float (&d)[8]) {
    float e4[4], e2[2], e1;
    { const bool up = (threadIdx.x & 32) != 0;
#pragma unroll
      for (int k = 0; k < 4; ++k) { const float keep = up ? d[k + 4] : d[k], send = up ? d[k] : d[k + 4]; e4[k] = keep + __shfl_xor(send, 32); } }
    { const bool up = (threadIdx.x & 16) != 0;
#pragma unroll
      for (int k = 0; k < 2; ++k) { const float keep = up ? e4[k + 2] : e4[k], send = up ? e4[k] : e4[k + 2]; e2[k] = keep + __shfl_xor(send, 16); } }
    { const bool up = (threadIdx.x & 8) != 0; const float keep = up ? e2[1] : e2[0], send = up ? e2[0] : e2[1]; e1 = keep + __shfl_xor(send, 8); }
    e1 += __shfl_xor(e1, 4); e1 += __shfl_xor(e1, 2); e1 += __shfl_xor(e1, 1);
#pragma unroll
    for (int k = 0; k < 8; ++k) d[k] = __builtin_bit_cast(float, __builtin_amdgcn_readlane(__builtin_bit_cast(int, e1), 8 * k));
}
__device__ __forceinline__ int crow(int r, int hi) { return (r & 3) + 8 * (r >> 2) + 4 * hi; }
__device__ __forceinline__ constexpr int crc(int r) { return (r & 3) + 8 * (r >> 2); }

namespace pg8 {
constexpr int BM = 256, BK = 64, HALF = 128, HTB = HALF * BK * 2, NXCD = 8, WGM = 8;
__host__ __device__ __forceinline__ int lds_byte(int r, int c) { const int st = (r >> 4) * 2 + (c >> 5), rr = r & 15, cc = c & 31, ob = rr * 64 + cc * 2; return st * 1024 + (ob ^ (((ob >> 9) & 1) << 5)); }
__host__ __device__ __forceinline__ void stage_rc(int b, int& R, int& C) { const int st = b / 1024, sb = b % 1024, swz = sb ^ (((sb >> 9) & 1) << 5); R = (st >> 1) * 16 + swz / 64; C = (st & 1) * 32 + (swz % 64) / 2; }
__host__ __device__ __forceinline__ int perm32(int rho) { const int n = rho >> 4, i = rho & 15; return 8 * (i >> 2) + 4 * n + (i & 3); }
struct Unit { int pm, pn; long bofs; };
struct Gemm { const bf16_t* A; const bf16_t* Bt; int M, N, K; };
struct StaticOrder {
    int nM, nN, nwg, G, c;
    __device__ void init(int M, int N, int G_, int c_) { nM = M / BM; nN = N / BM; nwg = nM * nN; G = G_; c = c_; }
    __device__ bool next(int i, Unit& u) const {
        const long L = (long)i * G + c; if (L >= nwg) return false;
        int wgid = (int)L; { const int q = nwg / NXCD, r = nwg % NXCD, xcd = wgid % NXCD, off = wgid / NXCD; wgid = (xcd < r ? xcd * (q + 1) : r * (q + 1) + (xcd - r) * q) + off; }
        const int nig = WGM * nN, gid = wgid / nig, fm = gid * WGM, gsz = (nM - fm) < WGM ? (nM - fm) : WGM;
        u.pm = fm + ((wgid % nig) % gsz); u.pn = (wgid % nig) / gsz; u.bofs = 0; return true;
    }
};
struct MoeOrder {
    int toff[NEXP + 1]; int nN, G, c; long estride;
    __device__ void init(const unsigned* cnt, int nN_, int G_, int c_, long estride_) {
        nN = nN_; G = G_; c = c_; estride = estride_; int t = 0;
#pragma unroll
        for (int e = 0; e < NEXP; ++e) { toff[e] = t; t += (int)((cnt[e] + 255u) >> 8); }
        toff[NEXP] = t;
    }
    __device__ bool next(int i, Unit& u) const {
        const int nM = toff[NEXP], nwg = nM * nN; const long L = (long)i * G + c; if (L >= nwg) return false;
        int wgid = (int)L; { const int q = nwg / NXCD, r = nwg % NXCD, xcd = wgid % NXCD, off = wgid / NXCD; wgid = (xcd < r ? xcd * (q + 1) : r * (q + 1) + (xcd - r) * q) + off; }
        const int nig = WGM * nN, gid = wgid / nig, fm = gid * WGM, gsz = (nM - fm) < WGM ? (nM - fm) : WGM;
        const int pm = fm + ((wgid % nig) % gsz); u.pm = pm; u.pn = (wgid % nig) / gsz; int e = 0;
#pragma unroll
        for (int j = 1; j < NEXP; ++j) e += (pm >= toff[j]) ? 1 : 0;
        u.bofs = (long)e * estride; return true;
    }
};

template <class Epi, class Sched>
__device__ __forceinline__ void gemm_phase(LAS unsigned char* lds, const Gemm g, const Sched& S, const Epi& E) {
    constexpr bool ALIGN_EPI = true;
    const int tid = threadIdx.x, wid = __builtin_amdgcn_readfirstlane(tid >> 6), lane = tid & 63, wr = wid >> 2, wc = wid & 3, fr = lane & 15, fq = lane >> 4;
    const int K = g.K, nt = K / BK;
    unsigned voffA[2], voffB[2];
#pragma unroll
    for (int i = 0; i < 2; ++i) { int R, C; stage_rc(tid * 16 + i * 8192, R, C); const int Rb = Epi::PERM ? ((R & ~31) + perm32(R & 31)) : R;
        voffA[i] = (unsigned)(R * K + C) * 2u; voffB[i] = (unsigned)(Rb * K + C) * 2u; }
    const size_t kstep = (size_t)(BK * 2);
    const size_t hstep = (size_t)HALF * K * 2;
    const size_t tstep = 2 * hstep;
    const unsigned ldsw = (unsigned)wid * 1024u;
    const int aoff = lds_byte(wr * 64 + fr, fq * 8), boff = lds_byte(wc * 32 + fr, fq * 8);
#define PG8_SA(b, h) (((b) * 2 + (h)) * HTB)
#define PG8_SB(b, h) ((4 + (b) * 2 + (h)) * HTB)
#define PG8_STAGE(bufoff, gbase, voff) do { _Pragma("unroll") for (int _i = 0; _i < 2; ++_i) \
        __builtin_amdgcn_global_load_lds((const unsigned*)((const char*)(gbase) + (voff)[_i]), (LAS unsigned*)(lds + (bufoff) + ldsw + _i * 8192), 16, 0, 0); } while (0)
#define PG8_LDA(dst, b, h) do { _Pragma("unroll") for (int m = 0; m < 4; ++m) _Pragma("unroll") for (int k = 0; k < 2; ++k) dst[m][k] = *(const LAS bf16x8*)(lds + PG8_SA(b, h) + aoff + m * 2048 + k * 1024); } while (0)
#define PG8_LDB(dst, b, h) do { _Pragma("unroll") for (int n = 0; n < 2; ++n) _Pragma("unroll") for (int k = 0; k < 2; ++k) dst[n][k] = *(const LAS bf16x8*)(lds + PG8_SB(b, h) + boff + n * 2048 + k * 1024); } while (0)
#define PG8_MMA(ai, bj, At, Bt) do { __builtin_amdgcn_s_setprio(1); _Pragma("unroll") for (int m = 0; m < 4; ++m) _Pragma("unroll") for (int n = 0; n < 2; ++n) _Pragma("unroll") for (int k = 0; k < 2; ++k) \
        acc[ai][bj][m][n] = __builtin_amdgcn_mfma_f32_16x16x32_bf16(Bt[n][k], At[m][k], acc[ai][bj][m][n], 0, 0, 0); __builtin_amdgcn_s_setprio(0); } while (0)
#define PG8_WAIT_V(n) asm volatile("s_waitcnt vmcnt(" #n ")" ::: "memory")
#define PG8_WAIT_L(n) asm volatile("s_waitcnt lgkmcnt(" #n ")" ::: "memory")
#define PG8_BAR __builtin_amdgcn_s_barrier()
#define PG8_SCHED __builtin_amdgcn_sched_barrier(0)
    Unit cur, nxt; int ui = 0;
    if (!S.next(0, cur)) return;
    f32x4 acc[2][2][4][2];
#pragma unroll
    for (int a = 0; a < 2; ++a)
#pragma unroll
        for (int b = 0; b < 2; ++b)
#pragma unroll
            for (int m = 0; m < 4; ++m)
#pragma unroll
                for (int n = 0; n < 2; ++n) acc[a][b][m][n] = (f32x4){0.f, 0.f, 0.f, 0.f};
    bf16x8 At[4][2], B0[2][2], B1[2][2];
    const char* cA = (const char*)g.A + (size_t)cur.pm * tstep; const char* cB = (const char*)g.Bt + cur.bofs + (size_t)cur.pn * tstep;
    PG8_STAGE(PG8_SB(0, 0), cB, voffB); PG8_STAGE(PG8_SB(0, 1), cB + hstep, voffB); PG8_STAGE(PG8_SA(0, 0), cA, voffA); PG8_STAGE(PG8_SA(0, 1), cA + hstep, voffA);
    if (wr == 1) PG8_BAR;
    PG8_WAIT_V(2); PG8_BAR;
    PG8_STAGE(PG8_SB(1, 0), cB + kstep, voffB); PG8_STAGE(PG8_SA(1, 0), cA + kstep, voffA); PG8_STAGE(PG8_SB(1, 1), cB + hstep + kstep, voffB);
    PG8_WAIT_V(6); PG8_BAR;
    for (;;) {
        const bool has_next = S.next(ui + 1, nxt);
        const char* nA = has_next ? (const char*)g.A + (size_t)nxt.pm * tstep : cA; const char* nB = has_next ? (const char*)g.Bt + nxt.bofs + (size_t)nxt.pn * tstep : cB;
        for (int t = 0; t < nt; t += 2) {
            const bool last = (t == nt - 2);
            const char* a1 = cA + (size_t)(t + 1) * kstep;
            const char* a2 = last ? nA : cA + (size_t)(t + 2) * kstep; const char* b2 = last ? nB : cB + (size_t)(t + 2) * kstep;
            const char* a3 = a2 + kstep; const char* b3 = b2 + kstep;
            PG8_LDB(B0, 0, 0); PG8_LDB(B1, 0, 1); PG8_SCHED; PG8_LDA(At, 0, 0); PG8_STAGE(PG8_SA(1, 1), a1 + hstep, voffA);
            PG8_WAIT_V(8); PG8_WAIT_L(0); PG8_BAR; PG8_MMA(0, 0, At, B0); PG8_MMA(0, 1, At, B1); PG8_BAR; PG8_SCHED;
            PG8_LDA(At, 0, 1); PG8_STAGE(PG8_SB(0, 0), b2, voffB); PG8_STAGE(PG8_SB(0, 1), b2 + hstep, voffB); PG8_STAGE(PG8_SA(0, 0), a2, voffA);
            PG8_WAIT_V(8); PG8_WAIT_L(0); PG8_BAR; PG8_MMA(1, 0, At, B0); PG8_MMA(1, 1, At, B1); PG8_BAR; PG8_SCHED;
            PG8_LDB(B0, 1, 0); PG8_LDB(B1, 1, 1); PG8_SCHED; PG8_LDA(At, 1, 0); PG8_STAGE(PG8_SA(0, 1), a2 + hstep, voffA);
            PG8_WAIT_V(8); PG8_WAIT_L(0); PG8_BAR; PG8_MMA(0, 0, At, B0); PG8_MMA(0, 1, At, B1); PG8_BAR; PG8_SCHED;
            PG8_LDA(At, 1, 1); PG8_STAGE(PG8_SB(1, 0), b3, voffB); PG8_STAGE(PG8_SB(1, 1), b3 + hstep, voffB); PG8_STAGE(PG8_SA(1, 0), a3, voffA);
            PG8_WAIT_V(8); PG8_WAIT_L(0); PG8_BAR; PG8_MMA(1, 0, At, B0); PG8_MMA(1, 1, At, B1); PG8_BAR; PG8_SCHED;
        }
        if constexpr (ALIGN_EPI) { if (wr == 0) PG8_BAR; }
        if constexpr (!Epi::AFTER_DRAIN) E(acc, cur, wr, wc, fr, fq);
        if (!has_next) break;
#pragma unroll
        for (int a = 0; a < 2; ++a)
#pragma unroll
            for (int b = 0; b < 2; ++b)
#pragma unroll
                for (int m = 0; m < 4; ++m)
#pragma unroll
                    for (int n = 0; n < 2; ++n) acc[a][b][m][n] = (f32x4){0.f, 0.f, 0.f, 0.f};
        cur = nxt; cA = nA; cB = nB; ++ui;
        if constexpr (ALIGN_EPI) { if (wr == 1) PG8_BAR; }
    }
    PG8_WAIT_V(0);
    if constexpr (!ALIGN_EPI) { if (wr == 0) PG8_BAR; }
    PG8_BAR;
    if constexpr (Epi::AFTER_DRAIN) E.fused(acc, cur, wr, wc, fr, fq, lds);
#undef PG8_SA
#undef PG8_SB
#undef PG8_STAGE
#undef PG8_LDA
#undef PG8_LDB
#undef PG8_MMA
#undef PG8_WAIT_V
#undef PG8_WAIT_L
#undef PG8_BAR
#undef PG8_SCHED
}

struct EpiBf16 {
    static constexpr bool PERM = true, AFTER_DRAIN = false;
    bf16_t* O; int ldc;
    __device__ __forceinline__ void operator()(const f32x4 (&acc)[2][2][4][2], const Unit& u, int wr, int wc, int fr, int fq) const {
        const int row0 = u.pm * BM + wr * 64 + fr, col0 = u.pn * BM + wc * 32 + 8 * fq;
#pragma unroll
        for (int ai = 0; ai < 2; ++ai)
#pragma unroll
            for (int m = 0; m < 4; ++m) { bf16_t* rowp = O + (size_t)(row0 + ai * HALF + m * 16) * ldc + col0;
#pragma unroll
                for (int bj = 0; bj < 2; ++bj) { const f32x4 v0 = acc[ai][bj][m][0], v1 = acc[ai][bj][m][1];
                    u32x4 w; w.x = pk2(v0[0], v0[1]); w.y = pk2(v0[2], v0[3]); w.z = pk2(v1[0], v1[1]); w.w = pk2(v1[2], v1[3]);
                    *(u32x4*)(rowp + bj * HALF) = w; } }
    }
};
template <bool BASE_BF16, bool F32OUT> struct EpiRes {
    static constexpr bool PERM = false, AFTER_DRAIN = false;
    const void* base; float* out; bf16_t* hb; const float* bias; float* ss;
    __device__ __forceinline__ void operator()(const f32x4 (&acc)[2][2][4][2], const Unit& u, int wr, int wc, int fr, int fq) const {
        const int col0 = u.pn * BM + wc * 32 + 4 * fq;
        f32x4 bv[2][2];
#pragma unroll
        for (int bj = 0; bj < 2; ++bj)
#pragma unroll
            for (int n = 0; n < 2; ++n) bv[bj][n] = bias ? *(const f32x4*)(bias + col0 + bj * HALF + n * 16) : (f32x4){0.f, 0.f, 0.f, 0.f};
#pragma unroll
        for (int ai = 0; ai < 2; ++ai)
#pragma unroll
            for (int m = 0; m < 4; ++m) { const int row = u.pm * BM + ai * HALF + wr * 64 + m * 16 + fr; const size_t off = (size_t)row * DM + col0; float s = 0.f;
#pragma unroll
                for (int bj = 0; bj < 2; ++bj)
#pragma unroll
                    for (int n = 0; n < 2; ++n) { const size_t o2 = off + bj * HALF + n * 16; f32x4 bs;
                        if (BASE_BF16) { const u32x2 w = *(const u32x2*)((const bf16_t*)base + o2); bs = (f32x4){bflo(w.x), bfhi(w.x), bflo(w.y), bfhi(w.y)}; } else bs = *(const f32x4*)((const float*)base + o2);
                        const f32x4 o = bs + acc[ai][bj][m][n] + bv[bj][n];
                        if (F32OUT) *(f32x4*)(out + o2) = o;
                        s += (o[0] * o[0] + o[1] * o[1]) + (o[2] * o[2] + o[3] * o[3]);
                        u32x2 w; w.x = pk2(o[0], o[1]); w.y = pk2(o[2], o[3]); *(u32x2*)(hb + o2) = w; }
                s += __shfl_xor(s, 16); s += __shfl_xor(s, 32);
                if (fq == 0) ss[(size_t)row * 16 + u.pn * 4 + wc] = s; }
    }
};
struct EpiResRouter {
    static constexpr bool PERM = false, AFTER_DRAIN = true;
    bf16_t* hb; float* out; const float* bias; float* ss; float* lp; const float* gw; const float* wr8;
    __device__ __forceinline__ void fused(const f32x4 (&acc)[2][2][4][2], const Unit& u, int wr, int wc, int fr, int fq, LAS unsigned char* lds) const {
        LAS float* GW = (LAS float*)lds;
        { const int t = threadIdx.x, c = t >> 1, hf = t & 1; const float g = gw[u.pn * BM + c]; const f32x4 w = *(const f32x4*)(wr8 + (size_t)(u.pn * BM + c) * 8 + 4 * hf); *(LAS f32x4*)(GW + c * 8 + 4 * hf) = w * g; }
        asm volatile("s_waitcnt lgkmcnt(0)" ::: "memory"); __builtin_amdgcn_s_barrier(); asm volatile("" ::: "memory");
        const int col0 = u.pn * BM + wc * 32 + 4 * fq, lc0 = wc * 32 + 4 * fq;
        f32x4 bv[2][2];
#pragma unroll
        for (int bj = 0; bj < 2; ++bj)
#pragma unroll
            for (int n = 0; n < 2; ++n) bv[bj][n] = *(const f32x4*)(bias + col0 + bj * HALF + n * 16);
#pragma unroll
        for (int ai = 0; ai < 2; ++ai)
#pragma unroll
            for (int m = 0; m < 4; ++m) { const int row = u.pm * BM + ai * HALF + wr * 64 + m * 16 + fr; const size_t off = (size_t)row * DM + col0; float s = 0.f;
                float lg[8];
#pragma unroll
                for (int e = 0; e < 8; ++e) lg[e] = 0.f;
#pragma unroll
                for (int bj = 0; bj < 2; ++bj)
#pragma unroll
                    for (int n = 0; n < 2; ++n) { const size_t o2 = off + bj * HALF + n * 16; const u32x2 w = *(const u32x2*)(hb + o2);
                        const f32x4 o = (f32x4){bflo(w.x), bfhi(w.x), bflo(w.y), bfhi(w.y)} + acc[ai][bj][m][n] + bv[bj][n];
                        s += (o[0] * o[0] + o[1] * o[1]) + (o[2] * o[2] + o[3] * o[3]);
                        u32x2 wo; wo.x = pk2(o[0], o[1]); wo.y = pk2(o[2], o[3]); *(u32x2*)(hb + o2) = wo; *(f32x4*)(out + o2) = o;
#pragma unroll
                        for (int i = 0; i < 4; ++i) { const LAS float* gp = GW + (lc0 + bj * HALF + n * 16 + i) * 8; const f32x4 wa = *(const LAS f32x4*)gp, wb = *(const LAS f32x4*)(gp + 4);
                            lg[0] += o[i] * wa[0]; lg[1] += o[i] * wa[1]; lg[2] += o[i] * wa[2]; lg[3] += o[i] * wa[3]; lg[4] += o[i] * wb[0]; lg[5] += o[i] * wb[1]; lg[6] += o[i] * wb[2]; lg[7] += o[i] * wb[3]; } }
                s += __shfl_xor(s, 16); s += __shfl_xor(s, 32);
#pragma unroll
                for (int e = 0; e < 8; ++e) { lg[e] += __shfl_xor(lg[e], 16); lg[e] += __shfl_xor(lg[e], 32); }
                if (fq == 0) { ss[(size_t)row * 16 + u.pn * 4 + wc] = s; float* lpp = lp + ((size_t)row * 16 + u.pn * 4 + wc) * 8;
                    *(f32x4*)lpp = (f32x4){lg[0], lg[1], lg[2], lg[3]}; *(f32x4*)(lpp + 4) = (f32x4){lg[4], lg[5], lg[6], lg[7]}; }
                asm volatile("" ::: "memory"); }
    }
};
__device__ __forceinline__ float rstd_from_ss(const float* ss, int row) {
    const f32x4* p = (const f32x4*)(ss + (size_t)row * 16); const f32x4 a = p[0], b = p[1], c = p[2], d = p[3];
    const float t = ((a[0] + a[1]) + (a[2] + a[3])) + ((b[0] + b[1]) + (b[2] + b[3])) + ((c[0] + c[1]) + (c[2] + c[3])) + ((d[0] + d[1]) + (d[2] + d[3]));
    return __builtin_amdgcn_rsqf(t * (1.0f / DM) + EPS);
}
struct EpiSwiglu {
    static constexpr bool PERM = true, AFTER_DRAIN = false;
    bf16_t* O; int ldc; const float* ss; const float* rstd;
    __device__ __forceinline__ void operator()(const f32x4 (&acc)[2][2][4][2], const Unit& u, int wr, int wc, int fr, int fq) const {
        const int row0 = u.pm * BM + wr * 64 + fr, col0 = u.pn * HALF + wc * 32 + 8 * fq;
#pragma unroll
        for (int ai = 0; ai < 2; ++ai)
#pragma unroll
            for (int m = 0; m < 4; ++m) { const int row = row0 + ai * HALF + m * 16; const float rs = ss ? rstd_from_ss(ss, row) : rstd[row];
                float h[8];
#pragma unroll
                for (int n = 0; n < 2; ++n)
#pragma unroll
                    for (int i = 0; i < 4; ++i) { const float gg = acc[ai][0][m][n][i] * rs, uu = acc[ai][1][m][n][i] * rs; h[n * 4 + i] = siluf_(gg) * uu; }
                *(u32x4*)(O + (size_t)row * ldc + col0) = pack8(h); }
    }
};
struct EpiQkv {
    static constexpr bool PERM = true, AFTER_DRAIN = false;
    bf16_t* O; const float* ss; const float* bias; const float* qn; const float* kn; const float* rope;
    __device__ __forceinline__ void operator()(const f32x4 (&acc)[2][2][4][2], const Unit& u, int wr, int wc, int fr, int fq) const {
        const int hd = u.pn * 4 + wc, row0 = u.pm * BM + wr * 64 + fr; const int kind = u.pn < 4 ? 0 : (u.pn == 4 ? 1 : 2);
        const float* nw = kind == 0 ? qn : kn;
        float bv[2][8], nv[2][8];
#pragma unroll
        for (int bj = 0; bj < 2; ++bj)
#pragma unroll
            for (int j = 0; j < 8; ++j) { bv[bj][j] = bias[hd * 64 + bj * 32 + fq * 8 + j]; nv[bj][j] = nw[bj * 32 + fq * 8 + j]; }
#pragma unroll
        for (int ai = 0; ai < 2; ++ai)
#pragma unroll
            for (int m = 0; m < 4; ++m) { const int row = row0 + ai * HALF + m * 16; const float rs = rstd_from_ss(ss, row);
                float v[2][8]; float s = 0.f;
#pragma unroll
                for (int bj = 0; bj < 2; ++bj)
#pragma unroll
                    for (int n = 0; n < 2; ++n)
#pragma unroll
                        for (int i = 0; i < 4; ++i) { const float x = acc[ai][bj][m][n][i] * rs + bv[bj][n * 4 + i]; v[bj][n * 4 + i] = x; s += x * x; }
                if (kind < 2) {
                    s += __shfl_xor(s, 16); s += __shfl_xor(s, 32);
                    const float r2 = __builtin_amdgcn_rsqf(s * (1.0f / 64.0f) + EPS);
#pragma unroll
                    for (int bj = 0; bj < 2; ++bj)
#pragma unroll
                        for (int j = 0; j < 8; ++j) v[bj][j] = v[bj][j] * r2 * nv[bj][j];
                    const f32x4* rp = (const f32x4*)(rope + (size_t)row * 16);
                    const f32x4 c0 = rp[0], c1 = rp[1], s0 = rp[2], s1 = rp[3];
#pragma unroll
                    for (int j = 0; j < 8; ++j) { const float other = __shfl_xor(v[0][j], 16); const float cc = j < 4 ? c0[j] : c1[j - 4], sn = j < 4 ? s0[j] : s1[j - 4];
                        const float mine = v[0][j]; const float rot = (fq == 0) ? (mine * cc - other * sn) : (mine * cc + other * sn);
                        v[0][j] = (fq < 2) ? rot : mine; }
                }
#pragma unroll
                for (int bj = 0; bj < 2; ++bj) *(u32x4*)(O + (size_t)row * 1536 + hd * 64 + bj * 32 + fq * 8) = pack8(v[bj]);
            }
    }
};
}

#define XB_TMO      128
#define XB_XCNT(j)  (256  + 64 * (j))
#define XB_XSUB(j)  (1280 + 64 * (j))
#define XB_XGEN(j)  (2304 + 64 * (j))
#define XB_TOP      3328
#define XB_TOPGEN   3392
#define XCD_BAR_WORDS 3456
#define XB_SPIN_CAP (1u << 20)
__device__ __forceinline__ unsigned xb_ld(unsigned* p)              { return __hip_atomic_load(p, __ATOMIC_RELAXED, __HIP_MEMORY_SCOPE_AGENT); }
__device__ __forceinline__ unsigned xb_add(unsigned* p, unsigned v) { return __hip_atomic_fetch_add(p, v, __ATOMIC_RELAXED, __HIP_MEMORY_SCOPE_AGENT); }
__device__ __forceinline__ unsigned xb_xcc_id() { return (unsigned)__builtin_amdgcn_s_getreg((3 << 11) | 20) & 0xFu; }
#define XB_SPIN(cond, bar) do { unsigned _sp = 0; while (cond) { __builtin_amdgcn_s_sleep(1); \
    if ((++_sp & 255u) == 0u) { if (xb_ld(&(bar)[XB_TMO])) break; if (_sp > XB_SPIN_CAP) { atomicAdd(&(bar)[XB_TMO], 1u); break; } } } } while (0)
struct XcdBarrier { unsigned* bar; unsigned x; volatile LAS unsigned* st; };
__device__ __forceinline__ XcdBarrier xcd_barrier_post(unsigned* bar, volatile LAS unsigned* st) {
    XcdBarrier b; b.bar = bar; b.x = xb_xcc_id(); b.st = st;
    if (threadIdx.x == 0) (void)xb_add(&bar[XB_XCNT(b.x)], 1u);
    return b;
}
__device__ __forceinline__ void xcd_barrier_complete(unsigned* bar, unsigned x, unsigned& nloc, unsigned& nx) {
    const unsigned G = gridDim.x * gridDim.y * gridDim.z;
    unsigned sum, cnt, mine, sp = 0u;
    for (;;) {
        sum = 0u; cnt = 0u; mine = 0u;
#pragma unroll
        for (unsigned j = 0; j < 16; ++j) { const unsigned c = xb_ld(&bar[XB_XCNT(j)]); sum += c; cnt += (c > 0u) ? 1u : 0u; mine = (j == x) ? c : mine; }
        if (sum == G) break;
        __builtin_amdgcn_s_sleep(1);
        if ((++sp & 255u) == 0u) { if (xb_ld(&bar[XB_TMO])) break; if (sp > XB_SPIN_CAP) { atomicAdd(&bar[XB_TMO], 1u); break; } }
    }
    nloc = mine > 0u ? mine : 1u; nx = cnt > 0u ? cnt : 1u;
}
__device__ __forceinline__ void xcd_barrier(const XcdBarrier& b) {
    asm volatile("s_waitcnt vmcnt(0)" ::: "memory");
    __syncthreads();
    if (threadIdx.x == 0) {
        unsigned* bar = b.bar;
        __builtin_amdgcn_s_waitcnt(0);
        unsigned nloc = b.st[0], nx = b.st[1];
        if (nloc == 0u) { xcd_barrier_complete(bar, b.x, nloc, nx); b.st[0] = nloc; b.st[1] = nx; }
        const unsigned old = xb_add(&bar[XB_XSUB(b.x)], 1u);
        const unsigned gen = old / nloc;
        if (old + 1u == (gen + 1u) * nloc) {
            __builtin_amdgcn_fence(__ATOMIC_RELEASE, "agent");
            asm volatile("s_waitcnt vmcnt(0)" ::: "memory");
            const unsigned og = xb_add(&bar[XB_TOP], 1u);
            const unsigned tg = og / nx;
            if (og + 1u == (tg + 1u) * nx) xb_add(&bar[XB_TOPGEN], 1u);
            else XB_SPIN(xb_ld(&bar[XB_TOPGEN]) == tg, bar);
            __builtin_amdgcn_fence(__ATOMIC_ACQUIRE, "agent");
            xb_add(&bar[XB_XGEN(b.x)], 1u);
            asm volatile("s_waitcnt vmcnt(0)" ::: "memory");
        } else {
            XB_SPIN(xb_ld(&bar[XB_XGEN(b.x)]) == gen, bar);
            __builtin_amdgcn_fence(__ATOMIC_ACQUIRE, "agent");
            asm volatile("s_waitcnt vmcnt(0)" ::: "memory");
        }
    }
    __syncthreads();
}

struct Args { const float* in[39]; const int* pos; float* out; unsigned char* ws; int ph_lo, ph_hi, variant, pad; };
enum InIdx { I_X = 0, I_NORM_MIX0 = 1, I_W_IN, I_MU, I_W0, I_WDEC, I_A0, I_WICL, I_WGAT, I_KK, I_KA, I_RK, I_GNW, I_GNB, I_CONVW, I_CONVB, I_DTB, I_ALOG, I_DSKIP, I_SSDN,
             I_WOUT, I_NORM_FFN0, I_FG, I_FU, I_FD, I_NORM_MIX1, I_WQKV, I_BQKV, I_QN, I_KN, I_SINK, I_WO, I_BO, I_NORM_FFN1, I_ROUTER, I_EG, I_EU, I_ED };

__device__ __forceinline__ void transpose_item(const float* W, int ld, int K, int k0, int n0, bf16_t* WT, int drow, LAS float* scr, int lane, const float* gk) {
    f32x4 v[8]; const int kr = lane >> 3, n4 = 4 * (lane & 7); const float* wp = W + (size_t)(k0 + kr) * ld + n0 + n4;
#pragma unroll
    for (int i = 0; i < 8; ++i) v[i] = *(const f32x4*)(wp + (size_t)(8 * i) * ld);
    if (gk) { const float* gp = gk + k0 + kr;
#pragma unroll
        for (int i = 0; i < 8; ++i) v[i] = v[i] * gp[8 * i]; }
#pragma unroll
    for (int i = 0; i < 8; ++i) { LAS float* sp = scr + (8 * i + kr) * 33 + n4; sp[0] = v[i][0]; sp[1] = v[i][1]; sp[2] = v[i][2]; sp[3] = v[i][3]; }
    asm volatile("s_waitcnt lgkmcnt(0)" ::: "memory");
    const int c = lane & 7;
#pragma unroll
    for (int j = 0; j < 4; ++j) { const int n = (lane >> 3) + 8 * j; const LAS float* s = scr + (8 * c) * 33 + n;
        u32x4 o; o.x = pk2(s[0 * 33], s[1 * 33]); o.y = pk2(s[2 * 33], s[3 * 33]); o.z = pk2(s[4 * 33], s[5 * 33]); o.w = pk2(s[6 * 33], s[7 * 33]);
        *(u32x4*)(WT + (size_t)(drow + n) * K + k0 + 8 * c) = o; }
    asm volatile("s_waitcnt lgkmcnt(0)" ::: "memory");
}
__device__ __forceinline__ int drow_of(int kind, int n0) {
    if (kind == 0) return n0;
    if (kind == 1) return 256 * (n0 >> 7) + (n0 & 127);
    if (kind == 2) return 256 * (n0 >> 7) + 128 + (n0 & 127);
    const int hd = n0 >> 6, bj = (n0 >> 5) & 1; return 256 * (hd >> 2) + 128 * bj + 32 * (hd & 3);
}
__device__ __forceinline__ bool transpose_matrix(int& it, const float* W, int ld, int K, int ncols, bf16_t* WT, int kind, LAS float* scr, int lane, const float* gk = nullptr) {
    const int nnb = ncols / 32, items = (K / 64) * nnb;
    if (it < items) { const int kb = it / nnb, nb = it % nnb; transpose_item(W, ld, K, 64 * kb, 32 * nb, WT, drow_of(kind, 32 * nb), scr, lane, gk); return true; }
    it -= items; return false;
}

__device__ __forceinline__ u32x4 conv8(const bf16_t* proj, size_t m, int tpos, int c, const float* cw, const float* cb) {
    const bf16_t* p = proj + m * NPROJ + 2304 + c; u32x4 raw[4];
#pragma unroll
    for (int k = 0; k < 4; ++k) raw[k] = *(const u32x4*)(p - (size_t)(tpos >= k ? k : 0) * NPROJ);
    float acc[8];
    { const f32x4 b0 = *(const f32x4*)(cb + c), b1 = *(const f32x4*)(cb + c + 4); acc[0] = b0[0]; acc[1] = b0[1]; acc[2] = b0[2]; acc[3] = b0[3]; acc[4] = b1[0]; acc[5] = b1[1]; acc[6] = b1[2]; acc[7] = b1[3]; }
#pragma unroll
    for (int k = 0; k < 4; ++k) { float x[8]; unpack8(raw[k], x); const float ok = tpos >= k ? 1.f : 0.f; const f32x4 w0 = *(const f32x4*)(cw + (3 - k) * 1024 + c), w1 = *(const f32x4*)(cw + (3 - k) * 1024 + c + 4);
        acc[0] += ok * w0[0] * x[0]; acc[1] += ok * w0[1] * x[1]; acc[2] += ok * w0[2] * x[2]; acc[3] += ok * w0[3] * x[3]; acc[4] += ok * w1[0] * x[4]; acc[5] += ok * w1[1] * x[5]; acc[6] += ok * w1[2] * x[6]; acc[7] += ok * w1[3] * x[7]; }
#pragma unroll
    for (int i = 0; i < 8; ++i) acc[i] = siluf_(acc[i]);
    return pack8(acc);
}
__device__ __forceinline__ u32x2 conv4(const bf16_t* proj, size_t m, int tpos, int c, const float* cw, const float* cb) {
    const bf16_t* p = proj + m * NPROJ + 2304 + c; u32x2 raw[4];
#pragma unroll
    for (int k = 0; k < 4; ++k) raw[k] = *(const u32x2*)(p - (size_t)(tpos >= k ? k : 0) * NPROJ);
    f32x4 acc = *(const f32x4*)(cb + c);
#pragma unroll
    for (int k = 0; k < 4; ++k) { const float ok = tpos >= k ? 1.f : 0.f; const f32x4 w0 = *(const f32x4*)(cw + (3 - k) * 1024 + c);
        acc[0] += ok * w0[0] * bflo(raw[k].x); acc[1] += ok * w0[1] * bfhi(raw[k].x); acc[2] += ok * w0[2] * bflo(raw[k].y); acc[3] += ok * w0[3] * bfhi(raw[k].y); }
    u32x2 o; o.x = pk2(siluf_(acc[0]), siluf_(acc[1])); o.y = pk2(siluf_(acc[2]), siluf_(acc[3])); return o;
}

#ifndef DUPM
#define DUPM 0u
#endif

#define XN ((bf16_t*)(ws + WS_XN))
#define MIX ((bf16_t*)(ws + WS_MIX))
#define PROJ ((bf16_t*)(ws + WS_PROJ))
#define GOUT ((bf16_t*)(ws + WS_GOUT))
#define XNB ((bf16_t*)(ws + WS_XNB))
#define HID ((bf16_t*)(ws + WS_HID))
#define QKV ((bf16_t*)(ws + WS_QKV))
#define ATTO ((bf16_t*)(ws + WS_ATTO))
#define AS ((bf16_t*)(ws + WS_AS))
#define HS ((bf16_t*)(ws + WS_HS))
#define SSTATE ((bf16_t*)(ws + 54 * MiB))
#define CHDEC ((float*)(ws + WS_TOPE))
#define DTSP ((float*)(ws + WS_DTSP))
#define KKR ((float*)(ws + WS_KKR))
#define ROPE ((float*)(ws + WS_ROPE))
#define SS ((float*)(ws + WS_SS))
#define TOPE ((int*)(ws + WS_TOPE))
#define RANK ((int*)(ws + WS_RANK))
#define TOPW ((float*)(ws + WS_TOPW))
#define POS ((int*)(ws + WS_POS))
#define RSTD4 ((float*)(ws + WS_RSTD4))
#define RSTDS ((float*)(ws + WS_RSTDS))
#define WDEC ((bf16_t*)(ws + WS_WDEC))
#define WICL ((bf16_t*)(ws + WS_WICL))
#define WGAT ((bf16_t*)(ws + WS_WGAT))
#define EGU ((bf16_t*)(ws + WS_EGU))
#define EDN ((bf16_t*)(ws + WS_EDN))
#define WIN ((bf16_t*)(ws + WS_WIN))
#define WOUT ((bf16_t*)(ws + WS_WOUT))
#define WGU ((bf16_t*)(ws + WS_WGU))
#define WDN ((bf16_t*)(ws + WS_WDN))
#define WQKV ((bf16_t*)(ws + WS_WQKV))
#define WO ((bf16_t*)(ws + WS_WO))
struct TDesc { const float* src; bf16_t* dst; const float* gk; int ld, K; };
__device__ __forceinline__ void tdesc(TDesc& d, int it, const float* W, int ld, int K, int ncols, bf16_t* WT, int kind, const float* gk) {
    const int nnb = ncols / 32, kb = it / nnb, nb = it % nnb;
    d.src = W + (size_t)(64 * kb) * ld + 32 * nb; d.dst = WT + (size_t)drow_of(kind, 32 * nb) * K + 64 * kb; d.gk = gk ? gk + 64 * kb : nullptr; d.ld = ld; d.K = K;
}
constexpr int CV_P0 = 1728, CV_NE = CV_P0 + 6016, CV_EGU = CV_NE + 16 * 704, CV_END = CV_EGU + 8 * 704;
__device__ __forceinline__ void conv_resolve(const float* const* in, unsigned char* ws, int id, TDesc& d) {
    if (id < 1664) { tdesc(d, id, in[I_W_IN], IN0, DM, NPROJ, (bf16_t*)(ws + WS_WIN), 0, nullptr); return; } id -= 1664;
    if (id < 16) { tdesc(d, id, in[I_WDEC], 512, 64, 512, (bf16_t*)(ws + WS_WDEC), 0, nullptr); return; } id -= 16;
    if (id < 16) { tdesc(d, id, in[I_WICL], 512, 64, 512, (bf16_t*)(ws + WS_WICL), 0, nullptr); return; } id -= 16;
    if (id < 32) { tdesc(d, id, in[I_WGAT], 512, 128, 512, (bf16_t*)(ws + WS_WGAT), 0, nullptr); return; } id -= 32;
    if (id < 512) { tdesc(d, id, in[I_WOUT], DM, DM, DM, (bf16_t*)(ws + WS_WOUT), 0, nullptr); return; } id -= 512;
    if (id < 1408) { tdesc(d, id, in[I_FG], FFN, DM, FFN, (bf16_t*)(ws + WS_WGU), 1, in[I_NORM_FFN0]); return; } id -= 1408;
    if (id < 1408) { tdesc(d, id, in[I_FU], FFN, DM, FFN, (bf16_t*)(ws + WS_WGU), 2, in[I_NORM_FFN0]); return; } id -= 1408;
    if (id < 1408) { tdesc(d, id, in[I_FD], DM, FFN, DM, (bf16_t*)(ws + WS_WDN), 0, nullptr); return; } id -= 1408;
    if (id < 768) { tdesc(d, id, in[I_WQKV], 1536, DM, 1536, (bf16_t*)(ws + WS_WQKV), 3, in[I_NORM_MIX1]); return; } id -= 768;
    if (id < 512) { tdesc(d, id, in[I_WO], DM, DM, DM, (bf16_t*)(ws + WS_WO), 0, nullptr); return; } id -= 512;
    if (id < 16 * 704) { const int e = id / 1408, r = id % 1408, up = r / 704;
        tdesc(d, r % 704, in[up ? I_EU : I_EG] + (size_t)e * DM * FE, FE, DM, FE, (bf16_t*)(ws + WS_EGU) + (size_t)e * 2 * FE * DM, 1 + up, in[I_NORM_FFN1]); return; } id -= 16 * 704;
    { const int e = id / 704; tdesc(d, id % 704, in[I_ED] + (size_t)e * FE * DM, DM, FE, DM, (bf16_t*)(ws + WS_EDN) + (size_t)e * DM * FE, 0, nullptr); }
}
__device__ __forceinline__ void conv_load(const TDesc& d, f32x4 (&v)[8], int lane) {
    const float* wp = d.src + (size_t)(lane >> 3) * d.ld + 4 * (lane & 7);
#pragma unroll
    for (int i = 0; i < 8; ++i) v[i] = *(const f32x4*)(wp + (size_t)(8 * i) * d.ld);
}
__device__ __forceinline__ void conv_finish(const TDesc& d, f32x4 (&v)[8], LAS float* scr, int lane) {
    const int kr = lane >> 3, n4 = 4 * (lane & 7);
    if (d.gk) {
#pragma unroll
        for (int i = 0; i < 8; ++i) v[i] = v[i] * d.gk[kr + 8 * i]; }
#pragma unroll
    for (int i = 0; i < 8; ++i) { LAS float* sp = scr + (8 * i + kr) * 33 + n4; sp[0] = v[i][0]; sp[1] = v[i][1]; sp[2] = v[i][2]; sp[3] = v[i][3]; }
    asm volatile("s_waitcnt lgkmcnt(0)" ::: "memory");
    const int c = lane & 7;
#pragma unroll
    for (int j = 0; j < 4; ++j) { const int n = (lane >> 3) + 8 * j; const LAS float* s = scr + (8 * c) * 33 + n;
        u32x4 o; o.x = pk2(s[0 * 33], s[1 * 33]); o.y = pk2(s[2 * 33], s[3 * 33]); o.z = pk2(s[4 * 33], s[5 * 33]); o.w = pk2(s[6 * 33], s[7 * 33]);
        *(u32x4*)(d.dst + (size_t)n * d.K + 8 * c) = o; }
    asm volatile("s_waitcnt lgkmcnt(0)" ::: "memory");
}
__device__ __forceinline__ void conv_range(const float* const* in, unsigned char* ws, int lo, int hi, int first, int stride, LAS float* scr, int lane) {
    int id = lo + first; if (id >= hi) return;
    TDesc cur; conv_resolve(in, ws, id, cur); f32x4 v[8]; conv_load(cur, v, lane);
    for (;;) {
        const int idn = id + stride; const bool hn = idn < hi; TDesc nx = cur; f32x4 w[8];
        if (hn) { conv_resolve(in, ws, idn, nx); conv_load(nx, w, lane); }
        conv_finish(cur, v, scr, lane);
        if (!hn) break;
        cur = nx; id = idn;
#pragma unroll
        for (int i = 0; i < 8; ++i) v[i] = w[i];
    }
}

__global__ void __launch_bounds__(512, 2) fwd_kernel(Args args) {
    extern __shared__ __attribute__((aligned(16))) unsigned char lds_raw[];
    LAS unsigned char* lds = (LAS unsigned char*)lds_raw;
    volatile LAS unsigned* MISC = (volatile LAS unsigned*)(lds + MISC_OFF);
    const int tid = threadIdx.x, lane = tid & 63, wave = __builtin_amdgcn_readfirstlane(tid >> 6);
    const int G = gridDim.x, bx = blockIdx.x;
    const int vcu = (G % 8 == 0) ? (bx % 8) * (G / 8) + bx / 8 : bx;
    unsigned char* ws = args.ws;
    unsigned* ctl = (unsigned*)(ws + WS_CTL);
    float* dout = args.out;
    if (tid < 32) ((LAS unsigned*)(lds + MISC_OFF))[tid] = 0u;
    __syncthreads();
    XcdBarrier bar = xcd_barrier_post(ctl + CW_BAR, MISC + 8);
    const int lo = args.ph_lo, hi = args.ph_hi;
#define IN(k) (lo <= (k) && (k) < hi)
#if DUPM
#define PHASE(k) for (int rep_ = 0; rep_ <= (int)((DUPM >> (k)) & 1u); ++rep_) if (IN(k))
#define REPBAR if (rep_) xcd_barrier(bar);
#else
#define PHASE(k) if (IN(k))
#define REPBAR
#endif
#define SEAM(k) do { if (IN(k) && IN((k) + 1)) xcd_barrier(bar); } while (0)
    const int gw = vcu * 8 + wave, NGW = G * 8;

    unsigned* CNT = ctl + CW_CNT;

    PHASE(0) { REPBAR
        conv_range(args.in, ws, 0, CV_P0, gw, NGW, (LAS float*)(lds + wave * 16384), lane);
        __syncthreads();
        LAS float* w8 = (LAS float*)lds;
        for (int r = tid; r < DM; r += 512) { const float* p = args.in[I_W_IN] + (size_t)r * IN0 + NPROJ; *(LAS f32x4*)(w8 + r * 8) = *(const f32x4*)p; *(LAS f32x4*)(w8 + r * 8 + 4) = *(const f32x4*)(p + 4); }
        __syncthreads();
        const float* gm = args.in[I_NORM_MIX0];
#pragma unroll 1
        for (int k0 = 0; k0 < MTOK / NGW; k0 += 2) {
          f32x4 vv[2][4];
#pragma unroll
          for (int q = 0; q < 2; ++q) { const f32x4* xr = (const f32x4*)(args.in[I_X] + (size_t)(gw + (k0 + q) * NGW) * DM) + lane;
#pragma unroll
              for (int j = 0; j < 4; ++j) vv[q][j] = xr[64 * j]; }
#pragma unroll
          for (int q = 0; q < 2; ++q) { const int m = gw + (k0 + q) * NGW;
            f32x4 v[4]; float s = 0.f;
#pragma unroll
            for (int j = 0; j < 4; ++j) { v[j] = vv[q][j]; s += (v[j][0] * v[j][0] + v[j][1] * v[j][1]) + (v[j][2] * v[j][2] + v[j][3] * v[j][3]); }
            const float rstd = __builtin_amdgcn_rsqf(wave_sum(s) * (1.0f / DM) + EPS);
            float d[8];
#pragma unroll
            for (int k = 0; k < 8; ++k) d[k] = 0.f;
            unsigned long long* o8 = (unsigned long long*)(XN + (size_t)m * DM) + lane;
#pragma unroll
            for (int j = 0; j < 4; ++j) { const f32x4 g4 = ((const f32x4*)gm)[64 * j + lane]; const f32x4 y = v[j] * rstd * g4;
                o8[64 * j] = (unsigned long long)pk2(y[0], y[1]) | ((unsigned long long)pk2(y[2], y[3]) << 32);
#pragma unroll
                for (int i = 0; i < 4; ++i) { const int c = 256 * j + 4 * lane + i; const f32x4 wa = *(const LAS f32x4*)(w8 + c * 8), wb = *(const LAS f32x4*)(w8 + c * 8 + 4);
                    d[0] += y[i] * wa[0]; d[1] += y[i] * wa[1]; d[2] += y[i] * wa[2]; d[3] += y[i] * wa[3]; d[4] += y[i] * wb[0]; d[5] += y[i] * wb[1]; d[6] += y[i] * wb[2]; d[7] += y[i] * wb[3]; } }
            wave_sum8(d);
            if (lane < 8) { float dv = d[0];
#pragma unroll
                for (int k = 1; k < 8; ++k) dv = (lane == k) ? d[k] : dv;
                const float z = dv + args.in[I_DTB][lane]; DTSP[(size_t)m * 8 + lane] = z > 20.f ? z : log1pf(__expf(z)); }
            if (lane >= 16 && lane < 24) { const int j = lane - 16; const float inv = expf(-(float)j * (0.125f * 13.122363377404328f)); const float ang = (float)args.pos[m] * inv;
                float sn, cs; sincosf(ang, &sn, &cs); ROPE[(size_t)m * 16 + j] = cs; ROPE[(size_t)m * 16 + 8 + j] = sn; }
          }
        }
        __syncthreads();
    }
    SEAM(0);

    PHASE(1) { REPBAR
        pg8::Gemm g{XN, WIN, MTOK, NPROJ, DM}; pg8::StaticOrder S; S.init(MTOK, NPROJ, G, bx);
        pg8::EpiBf16 E{PROJ, NPROJ};
        pg8::gemm_phase(lds, g, S, E);
        if (bx >= 64) {
            conv_range(args.in, ws, CV_P0, CV_NE + 8 * 704, (bx - 64) * 8 + wave, 192 * 8, (LAS float*)(lds + wave * 16384), lane);
        }
    }
    SEAM(1);

#define LANE_CONSTS const int r32 = lane & 31, hh = lane >> 5, trq = (lane & 15) >> 2, trc = 16 * ((lane >> 4) & 1) + 4 * (lane & 3)
#define TRF(M, P, s, blk) ({ const LAS bf16_t* p_ = (M) + (16 * (s) + 8 * hh + trq) * (P) + 32 * (blk) + trc; \
        const s16x4 lo_ = __builtin_bit_cast(s16x4, __builtin_amdgcn_ds_read_tr16_b64_v4i16((LAS s16x4*)p_)); \
        const s16x4 hi_ = __builtin_bit_cast(s16x4, __builtin_amdgcn_ds_read_tr16_b64_v4i16((LAS s16x4*)(p_ + 4 * (P)))); \
        (bf16x8){lo_[0], lo_[1], lo_[2], lo_[3], hi_[0], hi_[1], hi_[2], hi_[3]}; })
#define NATF(M, P, s, blk) (*(const LAS bf16x8*)((M) + (32 * (blk) + r32) * (P) + 16 * (s) + 8 * hh))
    PHASE(2) { REPBAR
        LANE_CONSTS;
        const float* mu = args.in[I_MU];
        LAS bf16_t* Aw = (LAS bf16_t*)lds; LAS bf16_t* Aa = (LAS bf16_t*)(lds + 9216); LAS bf16_t* Ag = (LAS bf16_t*)(lds + 18432);
        LAS float* LW = (LAS float*)(lds + 35840); LAS float* IC = LW + 4096;
        LAS bf16_t* At = (LAS bf16_t*)(lds + 68864); LAS bf16_t* Kt = At + 4608; LAS bf16_t* Bt = Kt + 4608; LAS bf16_t* Rt = Bt + 4608; LAS bf16_t* Vt = Rt + 4608;
        LAS bf16_t* Lab = (LAS bf16_t*)(lds + 35840);
        LAS bf16_t* XX = At;
        LAS bf16_t* Lak = (LAS bf16_t*)(lds + 114944); LAS bf16_t* Mrk = Lak + 4608; LAS bf16_t* Mrb = Mrk + 4608;
        LAS float* TOT = (LAS float*)(lds + 142592); LAS float* GAMC = TOT + 512;
        const int mt = (wave >> 1) & 1, nt = wave & 1, grp = wave >> 2;
        for (int unit = vcu; unit < MTOK / 64; unit += G) {
            const int m0 = unit * 64;
            {
                const int tt = tid >> 3, cg = tid & 7, m = m0 + tt; const bool hasprev = (m & (SEQ - 1)) != 0;
                const bf16_t* pc = PROJ + (size_t)m * NPROJ + 1536 + 32 * cg;
#pragma unroll 1
                for (int q = 0; q < 4; ++q) {
                    float c[8], p[8]; unpack8(*(const u32x4*)(pc + 8 * q), c);
                    if (hasprev) unpack8(*(const u32x4*)(pc - NPROJ + 8 * q), p); else { for (int i = 0; i < 8; ++i) p[i] = 0.f; }
                    float o[8];
#pragma unroll
                    for (int i = 0; i < 8; ++i) { const int col = 32 * cg + 8 * q + i; const float x = c[i] + (p[i] - c[i]) * mu[1536 + col];
                        o[i] = cg < 2 ? tanhf(x) : (cg < 4 ? x : sigmoidf_(x)); }
                    const u32x4 w = pack8(o); const int col0 = 32 * cg + 8 * q;
                    if (cg < 2) *(LAS u32x4*)(Aw + tt * 72 + col0) = w; else if (cg < 4) *(LAS u32x4*)(Aa + tt * 72 + (col0 - 64)) = w; else *(LAS u32x4*)(Ag + tt * 136 + (col0 - 128)) = w;
                }
            }
            LBAR();
#pragma unroll 1
            for (int h = 0; h < 8; ++h) {
                unsigned char* cs = (unsigned char*)dout + (size_t)(unit * 8 + h) * 24576;
                float r0v[8], k0v[8], v0v[8]; float pr = 0.f, pk = 0.f, pv = 0.f;
                {   const bf16_t* pp = PROJ + (size_t)(m0 + 8 * wave) * NPROJ + 64 * h + lane;
                    if (((m0 + 8 * wave) & (SEQ - 1)) != 0) { pr = bflo(pp[-NPROJ]); pk = bflo(pp[-NPROJ + 512]); pv = bflo(pp[-NPROJ + 1024]); }
#pragma unroll
                    for (int i = 0; i < 8; ++i) { r0v[i] = bflo(pp[(size_t)i * NPROJ]); k0v[i] = bflo(pp[(size_t)i * NPROJ + 512]); v0v[i] = bflo(pp[(size_t)i * NPROJ + 1024]); } }
                if (grp == 0) {
                    f32x16 ad, ai;
#pragma unroll
                    for (int r = 0; r < 16; ++r) { ad[r] = 0.f; ai[r] = 0.f; }
#pragma unroll
                    for (int s = 0; s < 4; ++s) {
                        const bf16x8 bd = *(const bf16x8*)(WDEC + (size_t)(64 * h + 32 * nt + r32) * 64 + 16 * s + 8 * hh), bi = *(const bf16x8*)(WICL + (size_t)(64 * h + 32 * nt + r32) * 64 + 16 * s + 8 * hh);
                        ad = __builtin_amdgcn_mfma_f32_32x32x16_bf16(NATF(Aw, 72, s, mt), bd, ad, 0, 0, 0);
                        ai = __builtin_amdgcn_mfma_f32_32x32x16_bf16(NATF(Aa, 72, s, mt), bi, ai, 0, 0, 0);
                    }
                    const int c = 32 * nt + r32; const float w0c = args.in[I_W0][64 * h + c], a0c = args.in[I_A0][64 * h + c];
                    LAS float* lwb = LW + (32 * mt + 4 * hh) * 64 + c;
#pragma unroll
                    for (int r = 0; r < 16; ++r) { lwb[crc(r) * 64] = -0.6065306597126334f * sigmoidf_(ad[r] + w0c); lwb[4096 + crc(r) * 64] = sigmoidf_(ai[r] + a0c); }
                } else {
                    f32x16 ag;
#pragma unroll
                    for (int r = 0; r < 16; ++r) ag[r] = 0.f;
#pragma unroll
                    for (int s = 0; s < 8; ++s) {
                        const bf16x8 bg = *(const bf16x8*)(WGAT + (size_t)(64 * h + 32 * nt + r32) * 128 + 16 * s + 8 * hh);
                        ag = __builtin_amdgcn_mfma_f32_32x32x16_bf16(NATF(Ag, 136, s, mt), bg, ag, 0, 0, 0);
                    }
                    bf16_t* gob = GOUT + (size_t)(m0 + 32 * mt + 4 * hh) * 512 + 64 * h + 32 * nt + r32;
#pragma unroll
                    for (int r = 0; r < 16; ++r) gob[crc(r) * 512] = (bf16_t)f2bf(ag[r]);
                }
                LBAR();
                {
                    const int c = lane, gc = 64 * h + c, t0 = 8 * wave;
                    const float mur = mu[gc], muk = mu[512 + gc], muv = mu[1024 + gc], kkc = args.in[I_KK][gc], kac = args.in[I_KA][gc], rkc = args.in[I_RK][gc];
                    float rr[8], kx[8], vv[8], an[8], bn[8], lw[8], cl[8]; float run = 0.f;
#pragma unroll
                    for (int i = 0; i < 8; ++i) {
                        const float r0 = r0v[i], k0 = k0v[i], v0 = v0v[i];
                        rr[i] = r0 + (pr - r0) * mur; const float kl = k0 + (pk - k0) * muk; vv[i] = v0 + (pv - v0) * muv; pr = r0; pk = k0; pv = v0;
                        const float ic = IC[(t0 + i) * 64 + c]; lw[i] = LW[(t0 + i) * 64 + c]; run += lw[i]; cl[i] = run;
                        const float xk = kl * kkc; const float ssq = dpp_sum63(xk * xk); const float kn = xk * __builtin_amdgcn_rsqf(ssq + 1e-12f);
                        an[i] = -kn; bn[i] = kn * ic; kx[i] = kl * (1.0f + (ic - 1.0f) * kac);
                        const float bon = dpp_sum63(rr[i] * kx[i] * rkc);
                        if (lane == 0) KKR[(size_t)(m0 + t0 + i) * 8 + h] = bon;
                    }
                    TOT[wave * 64 + c] = run;
                    LBAR();
                    float off = 0.f, totc = 0.f;
#pragma unroll
                    for (int w2 = 0; w2 < 8; ++w2) { const float tv = TOT[w2 * 64 + c]; totc += tv; off += (w2 < wave) ? tv : 0.f; }
                    if (wave == 0) GAMC[c] = __expf(totc);
#pragma unroll
                    for (int i = 0; i < 8; ++i) { const float cum = off + cl[i]; const float en = __expf(-cum), ep = __expf(cum), em = __expf(cum - lw[i]); const int o = (t0 + i) * 72 + c;
                        At[o] = (bf16_t)f2bf(an[i] * em); Kt[o] = (bf16_t)f2bf(kx[i] * en); Bt[o] = (bf16_t)f2bf(bn[i] * en); Rt[o] = (bf16_t)f2bf(rr[i] * ep); Vt[o] = (bf16_t)f2bf(vv[i]); }
                }
                LBAR();
                {
                    f32x16 pb, pk2_;
#pragma unroll
                    for (int r = 0; r < 16; ++r) { pb[r] = 0.f; pk2_[r] = 0.f; }
                    const LAS bf16_t* Aop = grp == 0 ? At : Rt;
#pragma unroll
                    for (int s = 0; s < 4; ++s) { const bf16x8 a = NATF(Aop, 72, s, mt);
                        pb = __builtin_amdgcn_mfma_f32_32x32x16_bf16(a, NATF(Bt, 72, s, nt), pb, 0, 0, 0);
                        pk2_ = __builtin_amdgcn_mfma_f32_32x32x16_bf16(a, NATF(Kt, 72, s, nt), pk2_, 0, 0, 0); }
                    const int sc = 32 * nt + r32, tb = 32 * mt + 4 * hh;
                    LAS bf16_t* o1 = (grp == 0 ? Lab : Mrb) + tb * 72 + sc; LAS bf16_t* o2 = (grp == 0 ? Lak : Mrk) + tb * 72 + sc;
#pragma unroll
                    for (int r = 0; r < 16; ++r) { const int t = tb + crc(r); const bool keep = grp == 0 ? (sc < t) : (sc <= t);
                        o1[crc(r) * 72] = (bf16_t)f2bf(keep ? pb[r] : 0.f); o2[crc(r) * 72] = (bf16_t)f2bf(keep ? pk2_[r] : 0.f); }
                }
                LBAR();
                f32x16 accA, accB;
#pragma unroll
                for (int r = 0; r < 16; ++r) { accA[r] = 0.f; accB[r] = 0.f; }
                {
                    const LAS bf16_t* Aop = grp == 0 ? Lak : Mrk;
#pragma unroll
                    for (int s = 0; s < 4; ++s) { const bf16x8 vb = TRF(Vt, 72, s, nt);
                        if (grp == 0) { accA = __builtin_amdgcn_mfma_f32_32x32x16_bf16(NATF(Aop, 72, s, mt), vb, accA, 0, 0, 0); accB = __builtin_amdgcn_mfma_f32_32x32x16_bf16(TRF(Kt, 72, s, mt), vb, accB, 0, 0, 0); }
                        else accB = __builtin_amdgcn_mfma_f32_32x32x16_bf16(NATF(Aop, 72, s, mt), vb, accB, 0, 0, 0); }
                    if (grp == 0) { LAS float* ggb = IC + (32 * mt + 4 * hh) * 65 + 32 * nt + r32;
#pragma unroll
                        for (int r = 0; r < 16; ++r) ggb[crc(r) * 65] = accA[r]; }
                }
                LBAR();
                {
                    const int n16 = lane & 15, g4 = lane >> 4;
                    f32x4 Rr[4];
                    if (wave < 4) {
#pragma unroll
                        for (int I = 0; I < 4; ++I)
#pragma unroll
                            for (int j = 0; j < 4; ++j) Rr[I][j] = bflo((unsigned)At[(16 * I + 4 * g4 + j) * 72 + 16 * wave + n16]);
                    } else { const LAS float* GG = IC;
#pragma unroll
                        for (int I = 0; I < 4; ++I)
#pragma unroll
                            for (int j = 0; j < 4; ++j) Rr[I][j] = GG[(16 * I + 4 * g4 + j) * 65 + 16 * (wave - 4) + n16];
                    }
                    LBAR();
                    const LAS bf16_t* lrow = Lab + n16 * 72 + 4 * g4;
#define LF(I, J) (*(const LAS u32x2*)(lrow + (16 * (I)) * 72 + 16 * (J)))
#define MF16(A0, A1, B0, B1, C) __builtin_amdgcn_mfma_f32_16x16x32_bf16(__builtin_bit_cast(bf16x8, (u32x4){(A0).x, (A0).y, (A1).x, (A1).y}), __builtin_bit_cast(bf16x8, (u32x4){(B0).x, (B0).y, (B1).x, (B1).y}), (C), 0, 0, 0)
                    const u32x2 zz = (u32x2){0u, 0u};
                    u32x2 Xb[4];
#pragma unroll
                    for (int I = 0; I < 4; ++I) {
                        f32x4 Z = Rr[I];
                        if (I == 1) Z = MF16(LF(1, 0), zz, Xb[0], zz, Z);
                        if (I == 2) Z = MF16(LF(2, 0), LF(2, 1), Xb[0], Xb[1], Z);
                        if (I == 3) { Z = MF16(LF(3, 0), LF(3, 1), Xb[0], Xb[1], Z); Z = MF16(LF(3, 2), zz, Xb[2], zz, Z); }
                        const u32x2 ld = LF(I, I);
                        f32x4 X = Z;
#pragma unroll
                        for (int it = 0; it < 15; ++it) { u32x2 xb; xb.x = pk2(X[0], X[1]); xb.y = pk2(X[2], X[3]); X = MF16(ld, zz, xb, zz, Z); }
                        Xb[I].x = pk2(X[0], X[1]); Xb[I].y = pk2(X[2], X[3]);
                        LAS bf16_t* xo = XX + (16 * I + 4 * g4) * 136 + 16 * wave + n16;
                        xo[0] = (bf16_t)(Xb[I].x & 0xffffu); xo[136] = (bf16_t)(Xb[I].x >> 16); xo[272] = (bf16_t)(Xb[I].y & 0xffffu); xo[408] = (bf16_t)(Xb[I].y >> 16);
                    }
#undef LF
#undef MF16
                }
                LBAR();
                {
                    f32x16 acc1;
#pragma unroll
                    for (int r = 0; r < 16; ++r) acc1[r] = 0.f;
#pragma unroll
                    for (int s = 0; s < 4; ++s) {
                        const bf16x8 a = grp == 0 ? TRF(Bt, 72, s, mt) : NATF(Mrb, 72, s, mt);
                        acc1 = __builtin_amdgcn_mfma_f32_32x32x16_bf16(a, TRF(XX, 136, s, nt), acc1, 0, 0, 0);
                        accB = __builtin_amdgcn_mfma_f32_32x32x16_bf16(a, TRF(XX + 64, 136, s, nt), accB, 0, 0, 0);
                    }
                    const int col = 32 * nt + r32, rb = 32 * mt + 4 * hh;
                    if (grp == 0) {
                        bf16_t* acb = (bf16_t*)cs + rb * 64 + col; bf16_t* dcb = (bf16_t*)(cs + 8192) + col * 64 + rb; const LAS float* gb = GAMC + rb;
#pragma unroll
                        for (int r = 0; r < 16; ++r) { const float gcv = gb[crc(r)]; acb[crc(r) * 64] = (bf16_t)f2bf(gcv * (acc1[r] + ((rb + crc(r)) == col ? 1.0f : 0.0f))); }
#pragma unroll
                        for (int rq = 0; rq < 4; ++rq) { const f32x4 g4 = *(const LAS f32x4*)(gb + 8 * rq);
                            u32x2 w; w.x = pk2(accB[4 * rq] * g4[0], accB[4 * rq + 1] * g4[1]); w.y = pk2(accB[4 * rq + 2] * g4[2], accB[4 * rq + 3] * g4[3]); *(u32x2*)(dcb + 8 * rq) = w; }
                    } else {
                        bf16_t* rpb = (bf16_t*)(cs + 16384) + rb * 64 + col; const LAS bf16_t* rtb = Rt + rb * 72 + col; bf16_t* yb = MIX + (size_t)(m0 + rb) * DM + 64 * h + col;
#pragma unroll
                        for (int r = 0; r < 16; ++r) { rpb[crc(r) * 64] = (bf16_t)f2bf(acc1[r] + bflo((unsigned)rtb[crc(r) * 72])); yb[crc(r) * DM] = (bf16_t)f2bf(accB[r]); }
                    }
                }
                LBAR();
            }
        }
    }

    SEAM(2);

    PHASE(3) { REPBAR
        LANE_CONSTS;
        if (vcu < 32) {
            const int b = vcu >> 3, h = vcu & 7;
            const unsigned char* cbase = (const unsigned char*)dout + (size_t)(b * 64 * 8 + h) * 24576;
            constexpr size_t CSTR = (size_t)8 * 24576; constexpr int SLOT = 27648;
            const bool loader = wave >= 2; const int lt = tid - 128;
            int poff[4];
#pragma unroll
            for (int k = 0; k < 4; ++k) { const int p = lt + 384 * k; poff[k] = (p >> 9) * 9216 + ((p & 511) >> 3) * 144 + (p & 7) * 16; }
            u32x4 st[4][4];
#define RB_ISSUE(set, ch) do { if (loader) { const unsigned char* g_ = cbase + (size_t)(ch) * CSTR + (size_t)lt * 16; _Pragma("unroll") for (int k = 0; k < 4; ++k) st[set][k] = *(const u32x4*)(g_ + k * 6144); } } while (0)
#define RB_WRITE(set, ch) do { if (loader) { LAS unsigned char* s_ = lds + ((ch) & 3) * SLOT; _Pragma("unroll") for (int k = 0; k < 4; ++k) *(LAS u32x4*)(s_ + poff[k]) = st[set][k]; } } while (0)
            RB_ISSUE(0, 0); RB_ISSUE(1, 1); RB_WRITE(0, 0); RB_WRITE(1, 1);
            RB_ISSUE(2, 2); RB_ISSUE(3, 3); RB_ISSUE(0, 4); RB_ISSUE(1, 5);
            LBAR();
            f32x16 H[2];
#pragma unroll
            for (int r = 0; r < 16; ++r) { H[0][r] = 0.f; H[1][r] = 0.f; }
            bf16_t* zp = (bf16_t*)((unsigned char*)dout + 48 * MiB) + (size_t)(b * SEQ + 4 * hh) * 512 + 64 * h + 32 * wave + r32;
#define RB_STEP(j, chv) do { const int ch_ = (chv); \
                if (loader) { if (ch_ + 2 < 64) RB_WRITE(((j) + 2) & 3, ch_ + 2); if (ch_ + 6 < 64) RB_ISSUE(((j) + 2) & 3, ch_ + 6); } \
                else { const LAS unsigned char* sl = lds + (ch_ & 3) * SLOT; f32x16 Hn[2], Z[2]; bf16x8 Hb[4]; \
                    _Pragma("unroll") for (int s = 0; s < 4; ++s) { const int m = s >> 1, o = 8 * (s & 1); u32x4 t; t.x = pk2(H[m][o], H[m][o + 1]); t.y = pk2(H[m][o + 2], H[m][o + 3]); t.z = pk2(H[m][o + 4], H[m][o + 5]); t.w = pk2(H[m][o + 6], H[m][o + 7]); Hb[s] = __builtin_bit_cast(bf16x8, t); } \
                    _Pragma("unroll") for (int m = 0; m < 2; ++m) { \
                        _Pragma("unroll") for (int rq = 0; rq < 4; ++rq) { const u32x2 d = *(const LAS u32x2*)(sl + 9216 + (32 * wave + r32) * 144 + (32 * m + 8 * rq + 4 * hh) * 2); \
                            Hn[m][4 * rq] = bflo(d.x); Hn[m][4 * rq + 1] = bfhi(d.x); Hn[m][4 * rq + 2] = bflo(d.y); Hn[m][4 * rq + 3] = bfhi(d.y); } \
                        _Pragma("unroll") for (int r = 0; r < 16; ++r) Z[m][r] = 0.f; } \
                    _Pragma("unroll") for (int s = 0; s < 4; ++s) \
                        _Pragma("unroll") for (int m = 0; m < 2; ++m) { const int o = (32 * m + r32) * 144 + (16 * s + 4 * hh) * 2; \
                            const u32x2 a0 = *(const LAS u32x2*)(sl + o), a1 = *(const LAS u32x2*)(sl + o + 16), q0 = *(const LAS u32x2*)(sl + 18432 + o), q1 = *(const LAS u32x2*)(sl + 18432 + o + 16); \
                            u32x4 t; t.x = a0.x; t.y = a0.y; t.z = a1.x; t.w = a1.y; Hn[m] = __builtin_amdgcn_mfma_f32_32x32x16_bf16(__builtin_bit_cast(bf16x8, t), Hb[s], Hn[m], 0, 0, 0); \
                            t.x = q0.x; t.y = q0.y; t.z = q1.x; t.w = q1.y; Z[m] = __builtin_amdgcn_mfma_f32_32x32x16_bf16(__builtin_bit_cast(bf16x8, t), Hb[s], Z[m], 0, 0, 0); } \
                    H[0] = Hn[0]; H[1] = Hn[1]; \
                    bf16_t* zq = zp + (size_t)ch_ * 64 * 512; \
                    _Pragma("unroll") for (int m = 0; m < 2; ++m) _Pragma("unroll") for (int r = 0; r < 16; ++r) zq[(32 * m + crc(r)) * 512] = (bf16_t)f2bf(Z[m][r]); } \
                LBAR(); } while (0)
            if (wave < 2 || loader) {
                for (int ch = 0; ch < 64; ch += 4) { RB_STEP(0, ch); RB_STEP(1, ch + 1); RB_STEP(2, ch + 2); RB_STEP(3, ch + 3); }
            }
#undef RB_STEP
#undef RB_ISSUE
#undef RB_WRITE
        } else {
            LAS bf16_t* Bm = (LAS bf16_t*)lds; LAS bf16_t* Xh = (LAS bf16_t*)(lds + 34816); LAS float* CUM = (LAS float*)(lds + 53248); LAS float* DTL = CUM + 512;
            for (int unit = vcu - 32; unit < 256; unit += G - 32) {
                const int g = unit & 1, c = (unit >> 1) & 31, b = unit >> 6, m0 = b * SEQ + c * 128;
#pragma unroll 1
                for (int k = 0; k < 4; ++k) { const int p = tid + 512 * k, row = p >> 4, c16 = p & 15; *(LAS u32x4*)(Bm + row * 136 + 8 * c16) = conv8(PROJ, (size_t)(m0 + row), c * 128 + row, 512 + 128 * g + 8 * c16, args.in[I_CONVW], args.in[I_CONVB]); }
                if (wave < 4) { const int h = 4 * g + wave; const float a_h = -__expf(args.in[I_ALOG][h]);
                    const float v0 = DTSP[(size_t)(m0 + 2 * lane) * 8 + h], v1 = DTSP[(size_t)(m0 + 2 * lane + 1) * 8 + h]; float s = v0 + v1;
#pragma unroll
                    for (int o = 1; o < 64; o <<= 1) { const float t = __shfl_up(s, o); if (lane >= o) s += t; }
                    const float ex = s - (v0 + v1);
                    CUM[wave * 128 + 2 * lane] = a_h * (ex + v0); CUM[wave * 128 + 2 * lane + 1] = a_h * (ex + v0 + v1); DTL[wave * 128 + 2 * lane] = v0; DTL[wave * 128 + 2 * lane + 1] = v1; }
                LBAR();
#pragma unroll 1
                for (int hq = 0; hq < 4; ++hq) { const int h = 4 * g + hq;
                    { const int s = tid >> 2, cq = 16 * (tid & 3); const float sc = DTL[hq * 128 + s] * __expf(CUM[hq * 128 + 127] - CUM[hq * 128 + s]);
#pragma unroll 1
                      for (int q = 0; q < 2; ++q) { float f[8]; unpack8(conv8(PROJ, (size_t)(m0 + s), c * 128 + s, 64 * h + cq + 8 * q, args.in[I_CONVW], args.in[I_CONVB]), f);
#pragma unroll
                          for (int i = 0; i < 8; ++i) f[i] *= sc;
                          *(LAS u32x4*)(Xh + s * 72 + cq + 8 * q) = pack8(f); } }
                    LBAR();
                    const int mt = wave >> 2, nt = wave & 3; f32x16 acc;
#pragma unroll
                    for (int r = 0; r < 16; ++r) acc[r] = 0.f;
#pragma unroll
                    for (int ks = 0; ks < 8; ++ks) acc = __builtin_amdgcn_mfma_f32_32x32x16_bf16(TRF(Xh, 72, ks, mt), TRF(Bm, 136, ks, nt), acc, 0, 0, 0);
                    bf16_t* sp = SSTATE + ((size_t)((b * 32 + c) * 8 + h)) * 8192 + (32 * mt + 4 * hh) * 128 + 32 * nt + r32;
#pragma unroll
                    for (int r = 0; r < 16; ++r) sp[crc(r) * 128] = (bf16_t)f2bf(acc[r]);
                    if (tid == 0) CHDEC[(b * 32 + c) * 8 + h] = __expf(CUM[hq * 128 + 127]);
                    LBAR();
                }
            }
            conv_range(args.in, ws, CV_NE + 8 * 704, CV_EGU, (vcu - 32) * 8 + wave, (G - 32) * 8, (LAS float*)(lds + wave * 16384), lane);
        }
    }

    SEAM(3);

    PHASE(4) { REPBAR
        const int gt = vcu * 512 + tid, bh = gt >> 12, e2 = gt & 4095, b = bh >> 3, h = bh & 7;
        unsigned* sp = (unsigned*)SSTATE + ((size_t)(b * 32 * 8 + h)) * 4096 + e2;
        unsigned vals[32];
#pragma unroll
        for (int c = 0; c < 32; ++c) vals[c] = sp[(size_t)c * 8 * 4096];
        float r0 = 0.f, r1 = 0.f;
#pragma unroll
        for (int c = 0; c < 32; ++c) { const float dec = CHDEC[(b * 32 + c) * 8 + h]; sp[(size_t)c * 8 * 4096] = pk2(r0, r1); r0 = r0 * dec + bflo(vals[c]); r1 = r1 * dec + bfhi(vals[c]); }
    }
    SEAM(4);

    PHASE(5) { REPBAR
        LANE_CONSTS;
        {
            LAS bf16_t* Cm = (LAS bf16_t*)lds; LAS bf16_t* Bm = (LAS bf16_t*)(lds + 34816); LAS bf16_t* Xh = (LAS bf16_t*)(lds + 69632); LAS bf16_t* Hp = (LAS bf16_t*)(lds + 88064);
            LAS float* CUM = (LAS float*)(lds + 105472); LAS float* DTL = CUM + 512;
            for (int unit = vcu; unit < 256; unit += G) {
                const int g = unit & 1, c = (unit >> 1) & 31, b = unit >> 6, m0 = b * SEQ + c * 128;
#pragma unroll 1
                for (int k = 0; k < 4; ++k) { const int p = tid + 512 * k, row = p >> 4, c16 = p & 15;
                    *(LAS u32x4*)(Bm + row * 136 + 8 * c16) = conv8(PROJ, (size_t)(m0 + row), c * 128 + row, 512 + 128 * g + 8 * c16, args.in[I_CONVW], args.in[I_CONVB]);
                    *(LAS u32x4*)(Cm + row * 136 + 8 * c16) = conv8(PROJ, (size_t)(m0 + row), c * 128 + row, 768 + 128 * g + 8 * c16, args.in[I_CONVW], args.in[I_CONVB]); }
                if (wave < 4) { const int h = 4 * g + wave; const float a_h = -__expf(args.in[I_ALOG][h]);
                    const float v0 = DTSP[(size_t)(m0 + 2 * lane) * 8 + h], v1 = DTSP[(size_t)(m0 + 2 * lane + 1) * 8 + h]; float s = v0 + v1;
#pragma unroll
                    for (int o = 1; o < 64; o <<= 1) { const float t = __shfl_up(s, o); if (lane >= o) s += t; }
                    const float ex = s - (v0 + v1);
                    CUM[wave * 128 + 2 * lane] = a_h * (ex + v0); CUM[wave * 128 + 2 * lane + 1] = a_h * (ex + v0 + v1); DTL[wave * 128 + 2 * lane] = v0; DTL[wave * 128 + 2 * lane + 1] = v1; }
                LBAR();
                const int mt = wave >> 1, nb = 2 * (wave & 1), nt2 = wave & 1;
                f32x16 cb[2];
#pragma unroll
                for (int r = 0; r < 16; ++r) { cb[0][r] = 0.f; cb[1][r] = 0.f; }
#pragma unroll
                for (int ks = 0; ks < 8; ++ks) { const bf16x8 a = NATF(Cm, 136, ks, mt);
                    cb[0] = __builtin_amdgcn_mfma_f32_32x32x16_bf16(a, NATF(Bm, 136, ks, nb), cb[0], 0, 0, 0); cb[1] = __builtin_amdgcn_mfma_f32_32x32x16_bf16(a, NATF(Bm, 136, ks, nb + 1), cb[1], 0, 0, 0); }
                LBAR();
                LAS bf16_t* Wt = Bm;
#pragma unroll 1
                for (int hq = 0; hq < 4; ++hq) { const int h = 4 * g + hq;
                    u32x4 ph[2];
                    { const bf16_t* hp = SSTATE + ((size_t)((b * 32 + c) * 8 + h)) * 8192;
#pragma unroll
                      for (int k = 0; k < 2; ++k) { const int p = tid + 512 * k; ph[k] = *(const u32x4*)(hp + (p >> 4) * 128 + 8 * (p & 15)); } }
#pragma unroll
                    for (int j = 0; j < 2; ++j) { const int s = 32 * (nb + j) + r32; const float cs = CUM[hq * 128 + s], ds = DTL[hq * 128 + s]; const int lb = 32 * mt + 4 * hh;
                        LAS bf16_t* wp = Wt + lb * 136 + s; const LAS float* cl = CUM + hq * 128 + lb;
#pragma unroll
                        for (int r = 0; r < 16; ++r) { const float w = (s <= lb + crc(r)) ? cb[j][r] * __expf(cl[crc(r)] - cs) * ds : 0.f; wp[crc(r) * 136] = (bf16_t)f2bf(w); } }
                    { const int s = tid >> 2, cq = 16 * (tid & 3);
#pragma unroll 1
                      for (int q = 0; q < 2; ++q) *(LAS u32x4*)(Xh + s * 72 + cq + 8 * q) = conv8(PROJ, (size_t)(m0 + s), c * 128 + s, 64 * h + cq + 8 * q, args.in[I_CONVW], args.in[I_CONVB]); }
#pragma unroll
                    for (int k = 0; k < 2; ++k) { const int p = tid + 512 * k, row = p >> 4, c16 = p & 15; *(LAS u32x4*)(Hp + row * 136 + 8 * c16) = ph[k]; }
                    LBAR();
                    f32x16 yd, yo;
#pragma unroll
                    for (int r = 0; r < 16; ++r) { yd[r] = 0.f; yo[r] = 0.f; }
#pragma unroll
                    for (int ks = 0; ks < 8; ++ks) { yd = __builtin_amdgcn_mfma_f32_32x32x16_bf16(NATF(Wt, 136, ks, mt), TRF(Xh, 72, ks, nt2), yd, 0, 0, 0);
                        yo = __builtin_amdgcn_mfma_f32_32x32x16_bf16(NATF(Cm, 136, ks, mt), NATF(Hp, 136, ks, nt2), yo, 0, 0, 0); }
                    { const LAS float* cl = CUM + hq * 128 + 32 * mt + 4 * hh; bf16_t* yb = MIX + (size_t)(m0 + 32 * mt + 4 * hh) * DM + 512 + 256 * g + 64 * hq + 32 * nt2 + r32;
#pragma unroll
                      for (int r = 0; r < 16; ++r) yb[crc(r) * DM] = (bf16_t)f2bf(yd[r] + __expf(cl[crc(r)]) * yo[r]); }
                    LBAR();
                }
                __syncthreads();
                for (int i4 = 0; i4 < 16; i4 += 4) { const int ch = 256 * g + 4 * lane; const float dsk = args.in[I_DSKIP][4 * g + (lane >> 4)]; const f32x4 nw = *(const f32x4*)(args.in[I_SSDN] + ch);
                  u32x2 xv4[4], zv4[4];
#pragma unroll
                  for (int q = 0; q < 4; ++q) { const size_t m = (size_t)(m0 + wave * 16 + i4 + q); xv4[q] = conv4(PROJ, m, c * 128 + wave * 16 + i4 + q, ch, args.in[I_CONVW], args.in[I_CONVB]); zv4[q] = *(const u32x2*)(PROJ + m * NPROJ + 1792 + ch); }
#pragma unroll
                  for (int q = 0; q < 4; ++q) { const int l = wave * 16 + i4 + q; const size_t m = (size_t)(m0 + l);
                    const u32x2 yv = *(const u32x2*)(MIX + m * DM + 512 + ch), xv = xv4[q], zv = zv4[q];
                    float v[4] = {bflo(yv.x), bfhi(yv.x), bflo(yv.y), bfhi(yv.y)}; const float xs[4] = {bflo(xv.x), bfhi(xv.x), bflo(xv.y), bfhi(xv.y)}, zz[4] = {bflo(zv.x), bfhi(zv.x), bflo(zv.y), bfhi(zv.y)};
                    float qs = 0.f;
#pragma unroll
                    for (int j = 0; j < 4; ++j) { v[j] = (v[j] + dsk * xs[j]) * siluf_(zz[j]); qs += v[j] * v[j]; }
                    qs = wave_sum(qs); const float rq = __builtin_amdgcn_rsqf(qs * (1.0f / 256.0f) + EPS);
                    u32x2 o; o.x = pk2(v[0] * rq * nw[0], v[1] * rq * nw[1]); o.y = pk2(v[2] * rq * nw[2], v[3] * rq * nw[3]); *(u32x2*)(MIX + m * DM + 512 + ch) = o; } }
                LBAR();
            }
        }
        {
            const int c0 = 8 * lane, h = lane >> 3; const float* mu = args.in[I_MU];
            float muv[8], gw_[8], gb_[8];
#pragma unroll
            for (int i = 0; i < 8; ++i) { muv[i] = mu[1024 + c0 + i]; gw_[i] = args.in[I_GNW][c0 + i]; gb_[i] = args.in[I_GNB][c0 + i]; }
#pragma unroll 1
            for (int k0 = 0; k0 < MTOK / NGW; k0 += 4) {
                u32x4 ry[4], rz[4], rv[4], rp[4], rg[4]; float bdv[4];
#pragma unroll
                for (int q = 0; q < 4; ++q) { const size_t m = (size_t)(gw + (k0 + q) * NGW); const bool hasprev = (m & (SEQ - 1)) != 0;
                    ry[q] = *(const u32x4*)(MIX + m * DM + c0); rz[q] = *(const u32x4*)((const bf16_t*)((const unsigned char*)dout + 48 * MiB) + m * 512 + c0);
                    const bf16_t* pc = PROJ + m * NPROJ + c0 + 1024; rv[q] = *(const u32x4*)pc; rp[q] = hasprev ? *(const u32x4*)(pc - NPROJ) : (u32x4){0u, 0u, 0u, 0u};
                    rg[q] = *(const u32x4*)(GOUT + m * 512 + c0); bdv[q] = KKR[m * 8 + h]; }
#pragma unroll
                for (int q = 0; q < 4; ++q) { const size_t m = (size_t)(gw + (k0 + q) * NGW);
                    float y[8], v[8], p[8], go[8];
                    unpack8(ry[q], y); unpack8(rz[q], p);
#pragma unroll
                    for (int i = 0; i < 8; ++i) y[i] += p[i];
                    unpack8(rv[q], v); unpack8(rp[q], p);
#pragma unroll
                    for (int i = 0; i < 8; ++i) v[i] += (p[i] - v[i]) * muv[i];
                    unpack8(rg[q], go);
                    float s1 = 0.f; const float bd = bdv[q];
#pragma unroll
                    for (int i = 0; i < 8; ++i) s1 += y[i];
                    s1 += __shfl_xor(s1, 1); s1 += __shfl_xor(s1, 2); s1 += __shfl_xor(s1, 4);
                    const float mean = s1 * (1.0f / 64.0f); float s2 = 0.f;
#pragma unroll
                    for (int i = 0; i < 8; ++i) { const float d = y[i] - mean; s2 += d * d; }
                    s2 += __shfl_xor(s2, 1); s2 += __shfl_xor(s2, 2); s2 += __shfl_xor(s2, 4);
                    const float rs = __builtin_amdgcn_rsqf(s2 * (1.0f / 64.0f) + 64e-5f);
                    float o[8];
#pragma unroll
                    for (int i = 0; i < 8; ++i) o[i] = ((y[i] - mean) * rs * gw_[i] + gb_[i] + bd * v[i]) * go[i];
                    *(u32x4*)(MIX + m * DM + c0) = pack8(o); }
            }
        }
    }
    SEAM(5);


    PHASE(6) { REPBAR
        pg8::Gemm g{MIX, WOUT, MTOK, DM, DM}; pg8::StaticOrder S; S.init(MTOK, DM, G, bx);
        pg8::EpiRes<false, false> E{args.in[I_X], nullptr, XNB, nullptr, SS};
        pg8::gemm_phase(lds, g, S, E);
    }
    SEAM(6);
    PHASE(7) { REPBAR
        pg8::Gemm g{XNB, WGU, MTOK, 2 * FFN, DM}; pg8::StaticOrder S; S.init(MTOK, 2 * FFN, G, bx);
        pg8::EpiSwiglu E{HID, FFN, SS, nullptr};
        pg8::gemm_phase(lds, g, S, E);
    }
    SEAM(7);
    PHASE(8) { REPBAR
        pg8::Gemm g{HID, WDN, MTOK, DM, FFN}; pg8::StaticOrder S; S.init(MTOK, DM, G, bx);
        pg8::EpiRes<true, false> E{XNB, nullptr, XNB, nullptr, SS};
        pg8::gemm_phase(lds, g, S, E);
    }
    SEAM(8);
    PHASE(9) { REPBAR
        pg8::Gemm g{XNB, WQKV, MTOK, 1536, DM}; pg8::StaticOrder S; S.init(MTOK, 1536, G, bx);
        pg8::EpiQkv E{QKV, SS, args.in[I_BQKV], args.in[I_QN], args.in[I_KN], ROPE};
        pg8::gemm_phase(lds, g, S, E);
        if (bx >= 128) {
            conv_range(args.in, ws, CV_EGU, CV_END, (bx - 128) * 8 + wave, 128 * 8, (LAS float*)(lds + wave * 16384), lane);
        }
    }
    SEAM(9);

    PHASE(10) { REPBAR
        LAS bf16_t* Kt = (LAS bf16_t*)lds; LAS bf16_t* Vt = (LAS bf16_t*)(lds + 36864);
        const int r32 = lane & 31, hh = lane >> 5;
        for (int unit = vcu; unit < BATCH * 4 * 32; unit += G) {
            const int blk = unit & 31, kvh = (unit >> 5) & 3, b = unit >> 7;
            {
                const int rowi = tid >> 1, half = tid & 1; const int tpos = (blk - 1) * 128 + rowi;
#pragma unroll
                for (int q = 0; q < 4; ++q) { u32x4 kv = (u32x4){0, 0, 0, 0}, vv = kv;
                    if (tpos >= 0) { const bf16_t* p = QKV + (size_t)(b * SEQ + tpos) * 1536 + 1024 + kvh * 64 + half * 32 + 8 * q; kv = *(const u32x4*)p; vv = *(const u32x4*)(p + 256); }
                    *(LAS u32x4*)(Kt + rowi * 72 + half * 32 + 8 * q) = kv; *(LAS u32x4*)(Vt + rowi * 72 + half * 32 + 8 * q) = vv; }
            }
            __syncthreads();
            const int gq = wave >> 1, qh = kvh * 4 + gq; const float sink = args.in[I_SINK][qh];
            for (int it = 0; it < 2; ++it) {
                const int qi = (wave & 1) * 64 + it * 32 + r32; const size_t mq = (size_t)b * SEQ + blk * 128 + qi;
                bf16x8 qr[4];
#pragma unroll
                for (int s = 0; s < 4; ++s) qr[s] = *(const bf16x8*)(QKV + mq * 1536 + qh * 64 + 16 * s + 8 * hh);
                const int a0 = (wave & 1) * 2 + it;
                f32x16 sc[5];
#pragma unroll
                for (int j = 0; j < 5; ++j) {
#pragma unroll
                    for (int r = 0; r < 16; ++r) sc[j][r] = 0.f;
#pragma unroll
                    for (int s = 0; s < 4; ++s) { const bf16x8 kf = *(const LAS bf16x8*)(Kt + (32 * (a0 + j) + r32) * 72 + 16 * s + 8 * hh); sc[j] = __builtin_amdgcn_mfma_f32_32x32x16_bf16(kf, qr[s], sc[j], 0, 0, 0); }
                }
                float mx = sink;
#pragma unroll
                for (int j = 0; j < 5; ++j)
#pragma unroll
                    for (int r = 0; r < 16; ++r) { const int kj = 32 * (a0 + j) + crow(r, hh); const bool valid = (kj > qi) && (kj <= qi + 128) && (blk > 0 || kj >= 128);
                        const float x = valid ? sc[j][r] * 0.125f : -1e30f; sc[j][r] = x; mx = fmaxf(mx, x); }
                mx = fmaxf(mx, __shfl_xor(mx, 32));
                float l = 0.f;
#pragma unroll
                for (int j = 0; j < 5; ++j)
#pragma unroll
                    for (int r = 0; r < 16; ++r) { const float p = __expf(sc[j][r] - mx); sc[j][r] = p; l += p; }
                l += __shfl_xor(l, 32); l += __expf(sink - mx);
                const float inv = 1.0f / l;
                f32x16 o[2];
#pragma unroll
                for (int dt = 0; dt < 2; ++dt)
#pragma unroll
                    for (int r = 0; r < 16; ++r) o[dt][r] = 0.f;
#pragma unroll
                for (int j = 0; j < 5; ++j)
#pragma unroll
                    for (int s2 = 0; s2 < 2; ++s2) {
                        u32x4 pw; pw.x = pk2(sc[j][8 * s2 + 0], sc[j][8 * s2 + 1]); pw.y = pk2(sc[j][8 * s2 + 2], sc[j][8 * s2 + 3]); pw.z = pk2(sc[j][8 * s2 + 4], sc[j][8 * s2 + 5]); pw.w = pk2(sc[j][8 * s2 + 6], sc[j][8 * s2 + 7]);
                        const bf16x8 pf = __builtin_bit_cast(bf16x8, pw);
                        const int key0 = 32 * (a0 + j) + 16 * s2 + 4 * hh + ((lane & 15) >> 2);
#pragma unroll
                        for (int dt = 0; dt < 2; ++dt) {
                            const LAS bf16_t* vp = Vt + key0 * 72 + 32 * dt + 16 * ((lane >> 4) & 1) + 4 * (lane & 3);
                            const s16x4 lo = __builtin_bit_cast(s16x4, __builtin_amdgcn_ds_read_tr16_b64_v4i16((LAS s16x4*)vp));
                            const s16x4 hi = __builtin_bit_cast(s16x4, __builtin_amdgcn_ds_read_tr16_b64_v4i16((LAS s16x4*)(vp + 8 * 72)));
                            const bf16x8 vf = (bf16x8){lo[0], lo[1], lo[2], lo[3], hi[0], hi[1], hi[2], hi[3]};
                            o[dt] = __builtin_amdgcn_mfma_f32_32x32x16_bf16(vf, pf, o[dt], 0, 0, 0);
                        }
                    }
                bf16_t* op = ATTO + mq * DM + qh * 64;
#pragma unroll
                for (int dt = 0; dt < 2; ++dt)
#pragma unroll
                    for (int rq = 0; rq < 4; ++rq) { u32x2 w; w.x = pk2(o[dt][4 * rq] * inv, o[dt][4 * rq + 1] * inv); w.y = pk2(o[dt][4 * rq + 2] * inv, o[dt][4 * rq + 3] * inv);
                        *(u32x2*)(op + 32 * dt + 8 * rq + 4 * hh) = w; }
            }
            __syncthreads();
        }
    }
    SEAM(10);

    PHASE(11) { REPBAR
        pg8::Gemm g{ATTO, WO, MTOK, DM, DM}; pg8::StaticOrder S; S.init(MTOK, DM, G, bx);
        pg8::EpiResRouter E{XNB, dout, args.in[I_BO], SS, (float*)(ws + WS_GOUT)  , args.in[I_NORM_FFN1], args.in[I_ROUTER]};
        pg8::gemm_phase(lds, g, S, E);
    }
    SEAM(11);

    PHASE(12) { REPBAR
        LAS unsigned* lcnt = (LAS unsigned*)lds; LAS unsigned* lbase = lcnt + 8;
        if (tid < 8) lcnt[tid] = 0u;
        __syncthreads();
        int e0 = 0, e1 = 1; unsigned r0 = 0u, r1 = 0u; const int m = vcu * 64 + tid;
        if (tid < 64) {
            const float rstd = pg8::rstd_from_ss(SS, m);
            float d[8];
#pragma unroll
            for (int k = 0; k < 8; ++k) d[k] = 0.f;
            const f32x4* lp = (const f32x4*)((const float*)(ws + WS_GOUT) + (size_t)m * 128);
#pragma unroll
            for (int q = 0; q < 16; ++q) { const f32x4 a = lp[2 * q], b2 = lp[2 * q + 1]; d[0] += a[0]; d[1] += a[1]; d[2] += a[2]; d[3] += a[3]; d[4] += b2[0]; d[5] += b2[1]; d[6] += b2[2]; d[7] += b2[3]; }
            float v0 = d[0];
#pragma unroll
            for (int k = 1; k < 8; ++k) if (d[k] > v0) { v0 = d[k]; e0 = k; }
            float v1 = -3.0e38f; e1 = -1;
#pragma unroll
            for (int k = 0; k < 8; ++k) if (k != e0 && d[k] > v1) { v1 = d[k]; e1 = k; }
            const float w0 = __builtin_amdgcn_rcpf(1.0f + __expf((v1 - v0) * rstd));
            r0 = atomicAdd((unsigned*)(lcnt + e0), 1u); r1 = atomicAdd((unsigned*)(lcnt + e1), 1u);
            TOPE[2 * m] = e0; TOPE[2 * m + 1] = e1; TOPW[2 * m] = w0; TOPW[2 * m + 1] = 1.0f - w0; RSTD4[m] = rstd;
        }
        __syncthreads();
        if (tid < 8) lbase[tid] = atomicAdd(CNT + tid, lcnt[tid]);
        __syncthreads();
        if (tid < 64) { RANK[2 * m] = (int)(lbase[e0] + r0); RANK[2 * m + 1] = (int)(lbase[e1] + r1); }
        __syncthreads();
    }
    SEAM(12);

    PHASE(13) { REPBAR
        int roff[NEXP]; { int t = 0;
#pragma unroll
            for (int e = 0; e < NEXP; ++e) { roff[e] = t; t += (int)((CNT[e] + 255u) >> 8) << 8; } }
        {
            const int myj = gw + (lane & 15) * NGW, e = TOPE[myj]; int ro = roff[0];
#pragma unroll
            for (int k = 1; k < NEXP; ++k) ro = (e == k) ? roff[k] : ro;
            const int mypos = ro + RANK[myj];
            if (lane < 16) { POS[myj] = mypos; RSTDS[mypos] = RSTD4[myj >> 1]; }
#pragma unroll
            for (int k0 = 0; k0 < 16; k0 += 4) {
                u32x4 v[4][2]; int pos[4];
#pragma unroll
                for (int q = 0; q < 4; ++q) { pos[q] = __builtin_amdgcn_readlane(mypos, k0 + q); const int m = (gw + (k0 + q) * NGW) >> 1;
                    const u32x4* sp = (const u32x4*)(XNB + (size_t)m * DM) + lane; v[q][0] = sp[0]; v[q][1] = sp[64]; }
#pragma unroll
                for (int q = 0; q < 4; ++q) { u32x4* dp = (u32x4*)(AS + (size_t)pos[q] * DM) + lane; dp[0] = v[q][0]; dp[64] = v[q][1]; }
            }
        }
    }
    SEAM(13);
    PHASE(14) { REPBAR
        pg8::Gemm g{AS, EGU, SROWS, 2 * FE, DM}; pg8::MoeOrder S; S.init(CNT, 2 * FE / 256, G, bx, (long)2 * FE * DM * 2);
        pg8::EpiSwiglu E{HS, FE, nullptr, RSTDS};
        pg8::gemm_phase(lds, g, S, E);
    }
    SEAM(14);
    PHASE(15) { REPBAR
        pg8::Gemm g{HS, EDN, SROWS, DM, FE}; pg8::MoeOrder S; S.init(CNT, DM / 256, G, bx, (long)DM * FE * 2);
        pg8::EpiBf16 E{AS, DM};
        pg8::gemm_phase(lds, g, S, E);
    }
    SEAM(15);
    PHASE(16) { REPBAR
        {
            const int mym = gw + (lane & 7) * NGW; const int q0 = POS[2 * mym], q1 = POS[2 * mym + 1]; const float u0 = TOPW[2 * mym], u1 = TOPW[2 * mym + 1];
#pragma unroll
            for (int k0 = 0; k0 < 8; k0 += 2) {
                u32x4 ya[2][2], yb[2][2]; f32x4 hv[2][4]; float w0[2], w1[2];
#pragma unroll
                for (int t = 0; t < 2; ++t) { const int p0 = __builtin_amdgcn_readlane(q0, k0 + t), p1 = __builtin_amdgcn_readlane(q1, k0 + t);
                    w0[t] = __builtin_bit_cast(float, __builtin_amdgcn_readlane(__builtin_bit_cast(int, u0), k0 + t)); w1[t] = __builtin_bit_cast(float, __builtin_amdgcn_readlane(__builtin_bit_cast(int, u1), k0 + t));
                    const u32x4* y0 = (const u32x4*)(AS + (size_t)p0 * DM) + lane; const u32x4* y1 = (const u32x4*)(AS + (size_t)p1 * DM) + lane;
                    ya[t][0] = y0[0]; ya[t][1] = y0[64]; yb[t][0] = y1[0]; yb[t][1] = y1[64];
                    const f32x4* o = (const f32x4*)(dout + (size_t)(gw + (k0 + t) * NGW) * DM);
                    hv[t][0] = o[2 * lane]; hv[t][1] = o[2 * lane + 1]; hv[t][2] = o[128 + 2 * lane]; hv[t][3] = o[128 + 2 * lane + 1]; }
#pragma unroll
                for (int t = 0; t < 2; ++t) { f32x4* o = (f32x4*)(dout + (size_t)(gw + (k0 + t) * NGW) * DM);
#pragma unroll
                    for (int q = 0; q < 2; ++q) { float a[8], c[8]; unpack8(ya[t][q], a); unpack8(yb[t][q], c); f32x4 h0 = hv[t][2 * q], h1 = hv[t][2 * q + 1];
#pragma unroll
                        for (int i = 0; i < 4; ++i) { h0[i] += w0[t] * a[i] + w1[t] * c[i]; h1[i] += w0[t] * a[4 + i] + w1[t] * c[4 + i]; }
                        o[128 * q + 2 * lane] = h0; o[128 * q + 2 * lane + 1] = h1; } }
            }
        }
    }
#undef TRF
#undef NATF
#undef IN
#undef SEAM
#undef PHASE
#undef REPBAR
}

constexpr int NPHASE = 17;
extern "C" void kernel_launch(void* const* d_in, const int* in_sizes, int n_in, void* d_out, int out_size, void* d_ws, size_t ws_size, hipStream_t stream) {
    static int grid = 0;
    if (grid == 0) {
        if (n_in != 39 || out_size != MTOK * DM || ws_size < WS_END) { fprintf(stderr, "kernel_launch: unexpected shapes n_in %d out %d ws %zu\n", n_in, out_size, ws_size); grid = -1; return; }
        int dev = 0, cus = 0;
        if (hipGetDevice(&dev) != hipSuccess || hipDeviceGetAttribute(&cus, hipDeviceAttributeMultiprocessorCount, dev) != hipSuccess) { grid = -1; return; }
        if (hipFuncSetAttribute((const void*)fwd_kernel, hipFuncAttributeMaxDynamicSharedMemorySize, LDS_BYTES) != hipSuccess) { fprintf(stderr, "kernel_launch: hipFuncSetAttribute failed\n"); grid = -1; return; }
        int per_cu = 0; (void)hipOccupancyMaxActiveBlocksPerMultiprocessor(&per_cu, (const void*)fwd_kernel, 512, LDS_BYTES); (void)hipGetLastError();
        grid = 256; if (cus != 256 || per_cu < 1) fprintf(stderr, "kernel_launch: note: cus %d per_cu %d\n", cus, per_cu);
    }
    if (grid < 0) return;
    Args a{};
    a.in[0] = (const float*)d_in[0];
    for (int i = 2; i < 39; ++i) a.in[i - 1] = (const float*)d_in[i];
    a.pos = (const int*)d_in[1]; a.out = (float*)d_out; a.ws = (unsigned char*)d_ws;
    (void)hipMemsetAsync((char*)d_ws + WS_CTL, 0, CTL_ZERO_BYTES, stream);
#ifdef PROBE_PHASE
    constexpr int pp = PROBE_PHASE; constexpr bool before = (pp == 2 || pp == 3 || pp == 5 || pp == 6 || pp == 8 || pp == 11 || pp == 12);
#ifdef PROBE_VARIANT
    a.variant = PROBE_VARIANT;
#endif
    if (before) { a.ph_lo = pp; a.ph_hi = pp + 1; hipLaunchKernelGGL(fwd_kernel, dim3(grid), dim3(512), LDS_BYTES, stream, a); (void)hipMemsetAsync((char*)d_ws + WS_CTL, 0, CTL_ZERO_BYTES, stream); }
    a.variant = 0;
#endif
    a.ph_lo = 0; a.ph_hi = NPHASE;
    hipLaunchKernelGGL(fwd_kernel, dim3(grid), dim3(512), LDS_BYTES, stream, a);
#ifdef PROBE_PHASE
    if (!before) { (void)hipMemsetAsync((char*)d_ws + WS_CTL, 0, CW_CNT * 4, stream);
#ifdef PROBE_VARIANT
        a.variant = PROBE_VARIANT;
#endif
        a.ph_lo = pp; a.ph_hi = pp + 1; hipLaunchKernelGGL(fwd_kernel, dim3(grid), dim3(512), LDS_BYTES, stream, a); }
#endif
}
```

```cpp
#include <hip/hip_runtime.h>
#include <cstdio>
#include <cstdint>

#define LAS __attribute__((address_space(3)))
#define GAS __attribute__((address_space(1)))
typedef unsigned short bf16_t;
typedef short bf16x8 __attribute__((ext_vector_type(8)));
typedef float f32x4 __attribute__((ext_vector_type(4)));
typedef float f32x2 __attribute__((ext_vector_type(2)));
typedef float f32x16 __attribute__((ext_vector_type(16)));
typedef unsigned u32x4 __attribute__((ext_vector_type(4)));
typedef unsigned u32x2 __attribute__((ext_vector_type(2)));
typedef short s16x4 __attribute__((ext_vector_type(4)));

constexpr int BATCH = 4, SEQ = 4096, DM = 1024, MTOK = BATCH * SEQ;
constexpr int IN0 = 3336, NPROJ = 3328;
constexpr int FFN = 2816, FE = 1408, NEXP = 8;
constexpr int SROWS = 2 * MTOK + NEXP * 256;
constexpr float EPS = 1e-6f;

constexpr size_t MiB = 1u << 20;
constexpr size_t WS_CTL = 0, CTL_ZERO_BYTES = 64 * 1024;
constexpr size_t WS_DTSP = 1 * MiB;
constexpr size_t WS_KKR = 1 * MiB + 512 * 1024;
constexpr size_t WS_ROPE = 2 * MiB;
constexpr size_t WS_SS = 3 * MiB;
constexpr size_t WS_TOPE = 4 * MiB;
constexpr size_t WS_RANK = 4 * MiB + 128 * 1024;
constexpr size_t WS_TOPW = 4 * MiB + 256 * 1024;
constexpr size_t WS_POS = 4 * MiB + 384 * 1024;
constexpr size_t WS_RSTD4 = 4 * MiB + 512 * 1024;
constexpr size_t WS_RSTDS = 4 * MiB + 640 * 1024;
constexpr size_t WS_WDEC = 5 * MiB;
constexpr size_t WS_WICL = 5 * MiB + 64 * 1024;
constexpr size_t WS_WGAT = 5 * MiB + 128 * 1024;
constexpr size_t WS_EGU = 6 * MiB;
constexpr size_t WS_EDN = 50 * MiB;
constexpr size_t WS_WIN = 72 * MiB;
constexpr size_t WS_WOUT = WS_WIN + (size_t)NPROJ * DM * 2;
constexpr size_t WS_WGU = WS_WOUT + 2 * MiB;
constexpr size_t WS_WDN = WS_WGU + 11 * MiB;
constexpr size_t WS_WQKV = WS_WDN + (size_t)DM * FFN * 2;
constexpr size_t WS_WO = WS_WQKV + 3 * MiB;
constexpr size_t R0 = 102 * MiB;
static_assert(WS_WO + 2 * MiB <= R0, "weights");
constexpr size_t WS_XN = R0, WS_MIX = R0;
constexpr size_t WS_PROJ = R0 + 32 * MiB;
constexpr size_t WS_GOUT = R0 + 136 * MiB;
constexpr size_t WS_XNB = R0 + 104 * MiB;
constexpr size_t WS_HID = R0;
constexpr size_t WS_QKV = R0;
constexpr size_t WS_ATTO = R0 + 48 * MiB;
constexpr size_t WS_AS = 72 * MiB;
constexpr size_t WS_HS = 140 * MiB;
constexpr size_t WS_END = 254 * MiB;
static_assert(WS_AS + (size_t)SROWS * DM * 2 <= WS_HS && WS_HS + (size_t)SROWS * FE * 2 <= WS_END && WS_GOUT + 16 * MiB <= WS_END, "map");
constexpr size_t DO_XBCC = 0, DO_DECAY = 32 * MiB, DO_ICLR = 48 * MiB;
constexpr int CW_BAR = 4096, CW_CNT = 8192;

constexpr int LDS_BYTES = 147456, RING_BYTES = 131072, MISC_OFF = LDS_BYTES - 128;

__device__ __forceinline__ unsigned f2bf(float f) { unsigned u = __builtin_bit_cast(unsigned, f); return (u + 0x7fffu + ((u >> 16) & 1u)) >> 16; }
typedef __bf16 bf16x2_t __attribute__((ext_vector_type(2)));
__device__ __forceinline__ unsigned pk2(float lo, float hi) { const f32x2 v = {lo, hi}; const bf16x2_t b = __builtin_convertvector(v, bf16x2_t); return __builtin_bit_cast(unsigned, b); }
__device__ __forceinline__ float bflo(unsigned u) { return __builtin_bit_cast(float, u << 16); }
__device__ __forceinline__ float bfhi(unsigned u) { return __builtin_bit_cast(float, u & 0xffff0000u); }
__device__ __forceinline__ void unpack8(const u32x4 v, float* f) { f[0] = bflo(v.x); f[1] = bfhi(v.x); f[2] = bflo(v.y); f[3] = bfhi(v.y); f[4] = bflo(v.z); f[5] = bfhi(v.z); f[6] = bflo(v.w); f[7] = bfhi(v.w); }
__device__ __forceinline__ u32x4 pack8(const float* f) { u32x4 v; v.x = pk2(f[0], f[1]); v.y = pk2(f[2], f[3]); v.z = pk2(f[4], f[5]); v.w = pk2(f[6], f[7]); return v; }
__device__ __forceinline__ float sigmoidf_(float x) { return __builtin_amdgcn_rcpf(1.0f + __expf(-x)); }
__device__ __forceinline__ float siluf_(float x) { return x * __builtin_amdgcn_rcpf(1.0f + __expf(-x)); }
#define LBAR() do { asm volatile("s_waitcnt lgkmcnt(0)" ::: "memory"); __builtin_amdgcn_s_barrier(); asm volatile("" ::: "memory"); } while (0)
__device__ __forceinline__ float wave_sum(float v) {
#pragma unroll
    for (int o = 1; o < 64; o <<= 1) v += __shfl_xor(v, o);
    return v;
}
__device__ __forceinline__ float dpp_sum63(float x) {
    int v;
    v = __builtin_amdgcn_update_dpp(0, __builtin_bit_cast(int, x), 0xB1, 0xF, 0xF, false); x += __builtin_bit_cast(float, v);
    v = __builtin_amdgcn_update_dpp(0, __builtin_bit_cast(int, x), 0x4E, 0xF, 0xF, false); x += __builtin_bit_cast(float, v);
    v = __builtin_amdgcn_update_dpp(0, __builtin_bit_cast(int, x), 0x141, 0xF, 0xF, false); x += __builtin_bit_cast(float, v);
    v = __builtin_amdgcn_update_dpp(0, __builtin_bit_cast(int, x), 0x140, 0xF, 0xF, false); x += __builtin_bit_cast(float, v);
    v = __builtin_amdgcn_update_dpp(0, __builtin_bit_cast(int, x), 0x142, 0xA, 0xF, false); x += __builtin_bit_cast(float, v);
    v = __builtin_amdgcn_update_dpp(0, __builtin_bit_cast(int, x), 0x143, 0xC, 0xF, false); x += __builtin_bit_cast(float, v);
    return __builtin_bit_cast(float, __builtin_amdgcn_readlane(__builtin_bit_cast(int, x), 63));
}
__device__ __forceinline__ void wave_sum8(float (&d)[8]) {
    float e4[4], e2[2], e1;
    { const bool up = (threadIdx.x & 32) != 0;
#pragma unroll
      for (int k = 0; k < 4; ++k) { const float keep = up ? d[k + 4] : d[k], send = up ? d[k] : d[k + 4]; e4[k] = keep + __shfl_xor(send, 32); } }
    { const bool up = (threadIdx.x & 16) != 0;
#pragma unroll
      for (int k = 0; k < 2; ++k) { const float keep = up ? e4[k + 2] : e4[k], send = up ? e4[k] : e4[k + 2]; e2[k] = keep + __shfl_xor(send, 16); } }
    { const bool up = (threadIdx.x & 8) != 0; const float keep = up ? e2[1] : e2[0], send = up ? e2[0] : e2[1]; e1 = keep + __shfl_xor(send, 8); }
    e1 += __shfl_xor(e1, 4); e1 += __shfl_xor(e1, 2); e1 += __shfl_xor(e1, 1);
#pragma unroll
    for (int k = 0; k < 8; ++k) d[k] = __builtin_bit_cast(float, __builtin_amdgcn_readlane(__builtin_bit_cast(int, e1), 8 * k));
}
__device__ __forceinline__ int crow(int r, int hi) { return (r & 3) + 8 * (r >> 2) + 4 * hi; }
__device__ __forceinline__ constexpr int crc(int r) { return (r & 3) + 8 * (r >> 2); }

namespace pg8 {
constexpr int BM = 256, BK = 64, HALF = 128, HTB = HALF * BK * 2, NXCD = 8, WGM = 2;
__host__ __device__ __forceinline__ int lds_byte(int r, int c) { const int st = (r >> 4) * 2 + (c >> 5), rr = r & 15, cc = c & 31, ob = rr * 64 + cc * 2; return st * 1024 + (ob ^ (((ob >> 9) & 1) << 5)); }
__host__ __device__ __forceinline__ void stage_rc(int b, int& R, int& C) { const int st = b / 1024, sb = b % 1024, swz = sb ^ (((sb >> 9) & 1) << 5); R = (st >> 1) * 16 + swz / 64; C = (st & 1) * 32 + (swz % 64) / 2; }
__host__ __device__ __forceinline__ int perm32(int rho) { const int n = rho >> 4, i = rho & 15; return 8 * (i >> 2) + 4 * n + (i & 3); }
struct Unit { int pm, pn; long bofs; };
struct Gemm { const bf16_t* A; const bf16_t* Bt; int M, N, K; };
struct StaticOrder {
    int nM, nN, nwg, G, c;
    __device__ void init(int M, int N, int G_, int c_) { nM = M / BM; nN = N / BM; nwg = nM * nN; G = G_; c = c_; }
    __device__ bool next(int i, Unit& u) const {
        const long L = (long)i * G + c; if (L >= nwg) return false;
        int wgid = (int)L; { const int q = nwg / NXCD, r = nwg % NXCD, xcd = wgid % NXCD, off = wgid / NXCD; wgid = (xcd < r ? xcd * (q + 1) : r * (q + 1) + (xcd - r) * q) + off; }
        const int nig = WGM * nN, gid = wgid / nig, fm = gid * WGM, gsz = (nM - fm) < WGM ? (nM - fm) : WGM;
        u.pm = fm + ((wgid % nig) % gsz); u.pn = (wgid % nig) / gsz; u.bofs = 0; return true;
    }
};
struct MoeOrder {
    int toff[NEXP + 1]; int nN, G, c; long estride;
    __device__ void init(const unsigned* cnt, int nN_, int G_, int c_, long estride_) {
        nN = nN_; G = G_; c = c_; estride = estride_; int t = 0;
#pragma unroll
        for (int e = 0; e < NEXP; ++e) { toff[e] = t; t += (int)((cnt[e] + 255u) >> 8); }
        toff[NEXP] = t;
    }
    __device__ bool next(int i, Unit& u) const {
        const int nM = toff[NEXP], nwg = nM * nN; const long L = (long)i * G + c; if (L >= nwg) return false;
        int wgid = (int)L; { const int q = nwg / NXCD, r = nwg % NXCD, xcd = wgid % NXCD, off = wgid / NXCD; wgid = (xcd < r ? xcd * (q + 1) : r * (q + 1) + (xcd - r) * q) + off; }
        const int nig = WGM * nN, gid = wgid / nig, fm = gid * WGM, gsz = (nM - fm) < WGM ? (nM - fm) : WGM;
        const int pm = fm + ((wgid % nig) % gsz); u.pm = pm; u.pn = (wgid % nig) / gsz; int e = 0;
#pragma unroll
        for (int j = 1; j < NEXP; ++j) e += (pm >= toff[j]) ? 1 : 0;
        u.bofs = (long)e * estride; return true;
    }
};

template <class Epi, class Sched>
__device__ __forceinline__ void gemm_phase(LAS unsigned char* lds, const Gemm g, const Sched& S, const Epi& E) {
    constexpr bool ALIGN_EPI = true;
    const int tid = threadIdx.x, wid = __builtin_amdgcn_readfirstlane(tid >> 6), lane = tid & 63, wr = wid >> 2, wc = wid & 3, fr = lane & 15, fq = lane >> 4;
    const int K = g.K, nt = K / BK;
    unsigned voffA[2], voffB[2];
#pragma unroll
    for (int i = 0; i < 2; ++i) { int R, C; stage_rc(tid * 16 + i * 8192, R, C); const int Rb = Epi::PERM ? ((R & ~31) + perm32(R & 31)) : R;
        voffA[i] = (unsigned)(R * K + C) * 2u; voffB[i] = (unsigned)(Rb * K + C) * 2u; }
    const size_t kstep = (size_t)(BK * 2);
    const size_t hstep = (size_t)HALF * K * 2;
    const size_t tstep = 2 * hstep;
    const unsigned ldsw = (unsigned)wid * 1024u;
    const int aoff = lds_byte(wr * 64 + fr, fq * 8), boff = lds_byte(wc * 32 + fr, fq * 8);
#define PG8_SA(b, h) (((b) * 2 + (h)) * HTB)
#define PG8_SB(b, h) ((4 + (b) * 2 + (h)) * HTB)
#define PG8_STAGE(bufoff, gbase, voff) do { _Pragma("unroll") for (int _i = 0; _i < 2; ++_i) \
        __builtin_amdgcn_global_load_lds((const unsigned*)((const char*)(gbase) + (voff)[_i]), (LAS unsigned*)(lds + (bufoff) + ldsw + _i * 8192), 16, 0, 0); } while (0)
#define PG8_LDA(dst, b, h) do { _Pragma("unroll") for (int m = 0; m < 4; ++m) _Pragma("unroll") for (int k = 0; k < 2; ++k) dst[m][k] = *(const LAS bf16x8*)(lds + PG8_SA(b, h) + aoff + m * 2048 + k * 1024); } while (0)
#define PG8_LDB(dst, b, h) do { _Pragma("unroll") for (int n = 0; n < 2; ++n) _Pragma("unroll") for (int k = 0; k < 2; ++k) dst[n][k] = *(const LAS bf16x8*)(lds + PG8_SB(b, h) + boff + n * 2048 + k * 1024); } while (0)
#define PG8_MMA(ai, bj, At, Bt) do { __builtin_amdgcn_s_setprio(1); _Pragma("unroll") for (int m = 0; m < 4; ++m) _Pragma("unroll") for (int n = 0; n < 2; ++n) _Pragma("unroll") for (int k = 0; k < 2; ++k) \
        acc[ai][bj][m][n] = __builtin_amdgcn_mfma_f32_16x16x32_bf16(Bt[n][k], At[m][k], acc[ai][bj][m][n], 0, 0, 0); __builtin_amdgcn_s_setprio(0); } while (0)
#define PG8_WAIT_V(n) asm volatile("s_waitcnt vmcnt(" #n ")" ::: "memory")
#define PG8_WAIT_L(n) asm volatile("s_waitcnt lgkmcnt(" #n ")" ::: "memory")
#define PG8_BAR __builtin_amdgcn_s_barrier()
#define PG8_SCHED __builtin_amdgcn_sched_barrier(0)
    Unit cur, nxt; int ui = 0;
    if (!S.next(0, cur)) return;
    f32x4 acc[2][2][4][2];
#pragma unroll
    for (int a = 0; a < 2; ++a)
#pragma unroll
        for (int b = 0; b < 2; ++b)
#pragma unroll
            for (int m = 0; m < 4; ++m)
#pragma unroll
                for (int n = 0; n < 2; ++n) acc[a][b][m][n] = (f32x4){0.f, 0.f, 0.f, 0.f};
    bf16x8 At[4][2], B0[2][2], B1[2][2];
    const char* cA = (const char*)g.A + (size_t)cur.pm * tstep; const char* cB = (const char*)g.Bt + cur.bofs + (size_t)cur.pn * tstep;
    PG8_STAGE(PG8_SB(0, 0), cB, voffB); PG8_STAGE(PG8_SB(0, 1), cB + hstep, voffB); PG8_STAGE(PG8_SA(0, 0), cA, voffA); PG8_STAGE(PG8_SA(0, 1), cA + hstep, voffA);
    if (wr == 1) PG8_BAR;
    PG8_WAIT_V(2); PG8_BAR;
    PG8_STAGE(PG8_SB(1, 0), cB + kstep, voffB); PG8_STAGE(PG8_SA(1, 0), cA + kstep, voffA); PG8_STAGE(PG8_SB(1, 1), cB + hstep + kstep, voffB);
    PG8_WAIT_V(6); PG8_BAR;
    for (;;) {
        const bool has_next = S.next(ui + 1, nxt);
        const char* nA = has_next ? (const char*)g.A + (size_t)nxt.pm * tstep : cA; const char* nB = has_next ? (const char*)g.Bt + nxt.bofs + (size_t)nxt.pn * tstep : cB;
        for (int t = 0; t < nt; t += 2) {
            const bool last = (t == nt - 2);
            const char* a1 = cA + (size_t)(t + 1) * kstep;
            const char* a2 = last ? nA : cA + (size_t)(t + 2) * kstep; const char* b2 = last ? nB : cB + (size_t)(t + 2) * kstep;
            const char* a3 = a2 + kstep; const char* b3 = b2 + kstep;
            PG8_LDB(B0, 0, 0); PG8_LDB(B1, 0, 1); PG8_SCHED; PG8_LDA(At, 0, 0); PG8_STAGE(PG8_SA(1, 1), a1 + hstep, voffA);
            PG8_WAIT_V(8); PG8_WAIT_L(0); PG8_BAR; PG8_MMA(0, 0, At, B0); PG8_MMA(0, 1, At, B1); PG8_BAR; PG8_SCHED;
            PG8_LDA(At, 0, 1); PG8_STAGE(PG8_SB(0, 0), b2, voffB); PG8_STAGE(PG8_SB(0, 1), b2 + hstep, voffB); PG8_STAGE(PG8_SA(0, 0), a2, voffA);
            PG8_WAIT_V(8); PG8_WAIT_L(0); PG8_BAR; PG8_MMA(1, 0, At, B0); PG8_MMA(1, 1, At, B1); PG8_BAR; PG8_SCHED;
            PG8_LDB(B0, 1, 0); PG8_LDB(B1, 1, 1); PG8_SCHED; PG8_LDA(At, 1, 0); PG8_STAGE(PG8_SA(0, 1), a2 + hstep, voffA);
            PG8_WAIT_V(8); PG8_WAIT_L(0); PG8_BAR; PG8_MMA(0, 0, At, B0); PG8_MMA(0, 1, At, B1); PG8_BAR; PG8_SCHED;
            PG8_LDA(At, 1, 1); PG8_STAGE(PG8_SB(1, 0), b3, voffB); PG8_STAGE(PG8_SB(1, 1), b3 + hstep, voffB); PG8_STAGE(PG8_SA(1, 0), a3, voffA);
            PG8_WAIT_V(8); PG8_WAIT_L(0); PG8_BAR; PG8_MMA(1, 0, At, B0); PG8_MMA(1, 1, At, B1); PG8_BAR; PG8_SCHED;
        }
        if constexpr (ALIGN_EPI) { if (wr == 0) PG8_BAR; }
        if constexpr (!Epi::AFTER_DRAIN) E(acc, cur, wr, wc, fr, fq);
        if (!has_next) break;
#pragma unroll
        for (int a = 0; a < 2; ++a)
#pragma unroll
            for (int b = 0; b < 2; ++b)
#pragma unroll
                for (int m = 0; m < 4; ++m)
#pragma unroll
                    for (int n = 0; n < 2; ++n) acc[a][b][m][n] = (f32x4){0.f, 0.f, 0.f, 0.f};
        cur = nxt; cA = nA; cB = nB; ++ui;
        if constexpr (ALIGN_EPI) { if (wr == 1) PG8_BAR; }
    }
    PG8_WAIT_V(0);
    if constexpr (!ALIGN_EPI) { if (wr == 0) PG8_BAR; }
    PG8_BAR;
    if constexpr (Epi::AFTER_DRAIN) E.fused(acc, cur, wr, wc, fr, fq, lds);
#undef PG8_SA
#undef PG8_SB
#undef PG8_STAGE
#undef PG8_LDA
#undef PG8_LDB
#undef PG8_MMA
#undef PG8_WAIT_V
#undef PG8_WAIT_L
#undef PG8_BAR
#undef PG8_SCHED
}

struct EpiBf16 {
    static constexpr bool PERM = true, AFTER_DRAIN = false;
    bf16_t* O; int ldc;
    __device__ __forceinline__ void operator()(const f32x4 (&acc)[2][2][4][2], const Unit& u, int wr, int wc, int fr, int fq) const {
        const int row0 = u.pm * BM + wr * 64 + fr, col0 = u.pn * BM + wc * 32 + 8 * fq;
#pragma unroll
        for (int ai = 0; ai < 2; ++ai)
#pragma unroll
            for (int m = 0; m < 4; ++m) { bf16_t* rowp = O + (size_t)(row0 + ai * HALF + m * 16) * ldc + col0;
#pragma unroll
                for (int bj = 0; bj < 2; ++bj) { const f32x4 v0 = acc[ai][bj][m][0], v1 = acc[ai][bj][m][1];
                    u32x4 w; w.x = pk2(v0[0], v0[1]); w.y = pk2(v0[2], v0[3]); w.z = pk2(v1[0], v1[1]); w.w = pk2(v1[2], v1[3]);
                    *(u32x4*)(rowp + bj * HALF) = w; } }
    }
};
template <bool BASE_BF16, bool F32OUT> struct EpiRes {
    static constexpr bool PERM = false, AFTER_DRAIN = false;
    const void* base; float* out; bf16_t* hb; const float* bias; float* ss;
    __device__ __forceinline__ void operator()(const f32x4 (&acc)[2][2][4][2], const Unit& u, int wr, int wc, int fr, int fq) const {
        const int col0 = u.pn * BM + wc * 32 + 4 * fq;
        f32x4 bv[2][2];
#pragma unroll
        for (int bj = 0; bj < 2; ++bj)
#pragma unroll
            for (int n = 0; n < 2; ++n) bv[bj][n] = bias ? *(const f32x4*)(bias + col0 + bj * HALF + n * 16) : (f32x4){0.f, 0.f, 0.f, 0.f};
#pragma unroll
        for (int ai = 0; ai < 2; ++ai) {
            f32x4 pre[4][2][2];
#pragma unroll
            for (int m = 0; m < 4; ++m) { const size_t off = (size_t)(u.pm * BM + ai * HALF + wr * 64 + m * 16 + fr) * DM + col0;
#pragma unroll
                for (int bj = 0; bj < 2; ++bj)
#pragma unroll
                    for (int n = 0; n < 2; ++n) { const size_t o2 = off + bj * HALF + n * 16;
                        if (BASE_BF16) { const u32x2 w = *(const u32x2*)((const bf16_t*)base + o2); pre[m][bj][n] = (f32x4){bflo(w.x), bfhi(w.x), bflo(w.y), bfhi(w.y)}; } else pre[m][bj][n] = *(const f32x4*)((const float*)base + o2); } }
            asm volatile("" ::: "memory");
#pragma unroll
            for (int m = 0; m < 4; ++m) { const int row = u.pm * BM + ai * HALF + wr * 64 + m * 16 + fr; const size_t off = (size_t)row * DM + col0; float s = 0.f;
#pragma unroll
                for (int bj = 0; bj < 2; ++bj)
#pragma unroll
                    for (int n = 0; n < 2; ++n) { const size_t o2 = off + bj * HALF + n * 16;
                        const f32x4 o = pre[m][bj][n] + acc[ai][bj][m][n] + bv[bj][n];
                        if (F32OUT) *(f32x4*)(out + o2) = o;
                        s += (o[0] * o[0] + o[1] * o[1]) + (o[2] * o[2] + o[3] * o[3]);
                        u32x2 w; w.x = pk2(o[0], o[1]); w.y = pk2(o[2], o[3]); *(u32x2*)(hb + o2) = w; }
                s += __shfl_xor(s, 16); s += __shfl_xor(s, 32);
                if (fq == 0) ss[(size_t)row * 16 + u.pn * 4 + wc] = s; }
        }
    }
};
struct EpiResRouter {
    static constexpr bool PERM = false, AFTER_DRAIN = true;
    bf16_t* hb; float* out; const float* bias; float* ss; float* lp; const float* gw; const float* wr8;
    __device__ __forceinline__ void fused(const f32x4 (&acc)[2][2][4][2], const Unit& u, int wr, int wc, int fr, int fq, LAS unsigned char* lds) const {
        LAS float* GW = (LAS float*)lds;
        { const int t = threadIdx.x, c = t >> 1, hf = t & 1; const float g = gw[u.pn * BM + c]; const f32x4 w = *(const f32x4*)(wr8 + (size_t)(u.pn * BM + c) * 8 + 4 * hf); *(LAS f32x4*)(GW + c * 8 + 4 * hf) = w * g; }
        asm volatile("s_waitcnt lgkmcnt(0)" ::: "memory"); __builtin_amdgcn_s_barrier(); asm volatile("" ::: "memory");
        const int col0 = u.pn * BM + wc * 32 + 4 * fq, lc0 = wc * 32 + 4 * fq;
        f32x4 bv[2][2];
#pragma unroll
        for (int bj = 0; bj < 2; ++bj)
#pragma unroll
            for (int n = 0; n < 2; ++n) bv[bj][n] = *(const f32x4*)(bias + col0 + bj * HALF + n * 16);
#pragma unroll
        for (int ai = 0; ai < 2; ++ai) {
#pragma unroll
          for (int mh = 0; mh < 2; ++mh) {
            u32x2 pre[4][2][2];
#pragma unroll
            for (int m = 2 * mh; m < 2 * mh + 2; ++m) { const size_t off = (size_t)(u.pm * BM + ai * HALF + wr * 64 + m * 16 + fr) * DM + col0;
#pragma unroll
                for (int bj = 0; bj < 2; ++bj)
#pragma unroll
                    for (int n = 0; n < 2; ++n) pre[m][bj][n] = *(const u32x2*)(hb + off + bj * HALF + n * 16); }
            asm volatile("" ::: "memory");
#pragma unroll
            for (int m = 2 * mh; m < 2 * mh + 2; ++m) { const int row = u.pm * BM + ai * HALF + wr * 64 + m * 16 + fr; const size_t off = (size_t)row * DM + col0; float s = 0.f;
                float lg[8];
#pragma unroll
                for (int e = 0; e < 8; ++e) lg[e] = 0.f;
#pragma unroll
                for (int bj = 0; bj < 2; ++bj)
#pragma unroll
                    for (int n = 0; n < 2; ++n) { const size_t o2 = off + bj * HALF + n * 16; const u32x2 w = pre[m][bj][n];
                        const f32x4 o = (f32x4){bflo(w.x), bfhi(w.x), bflo(w.y), bfhi(w.y)} + acc[ai][bj][m][n] + bv[bj][n];
                        s += (o[0] * o[0] + o[1] * o[1]) + (o[2] * o[2] + o[3] * o[3]);
                        u32x2 wo; wo.x = pk2(o[0], o[1]); wo.y = pk2(o[2], o[3]); *(u32x2*)(hb + o2) = wo; *(f32x4*)(out + o2) = o;
#pragma unroll
                        for (int i = 0; i < 4; ++i) { const LAS float* gp = GW + (lc0 + bj * HALF + n * 16 + i) * 8; const f32x4 wa = *(const LAS f32x4*)gp, wb = *(const LAS f32x4*)(gp + 4);
                            lg[0] += o[i] * wa[0]; lg[1] += o[i] * wa[1]; lg[2] += o[i] * wa[2]; lg[3] += o[i] * wa[3]; lg[4] += o[i] * wb[0]; lg[5] += o[i] * wb[1]; lg[6] += o[i] * wb[2]; lg[7] += o[i] * wb[3]; } }
                s += __shfl_xor(s, 16); s += __shfl_xor(s, 32);
#pragma unroll
                for (int e = 0; e < 8; ++e) { lg[e] += __shfl_xor(lg[e], 16); lg[e] += __shfl_xor(lg[e], 32); }
                if (fq == 0) { ss[(size_t)row * 16 + u.pn * 4 + wc] = s; float* lpp = lp + ((size_t)row * 16 + u.pn * 4 + wc) * 8;
                    *(f32x4*)lpp = (f32x4){lg[0], lg[1], lg[2], lg[3]}; *(f32x4*)(lpp + 4) = (f32x4){lg[4], lg[5], lg[6], lg[7]}; }
                asm volatile("" ::: "memory"); }
          }
        }
    }
};
__device__ __forceinline__ float rstd_from_ss(const float* ss, int row) {
    const f32x4* p = (const f32x4*)(ss + (size_t)row * 16); const f32x4 a = p[0], b = p[1], c = p[2], d = p[3];
    const float t = ((a[0] + a[1]) + (a[2] + a[3])) + ((b[0] + b[1]) + (b[2] + b[3])) + ((c[0] + c[1]) + (c[2] + c[3])) + ((d[0] + d[1]) + (d[2] + d[3]));
    return __builtin_amdgcn_rsqf(t * (1.0f / DM) + EPS);
}
struct EpiSwiglu {
    static constexpr bool PERM = true, AFTER_DRAIN = false;
    bf16_t* O; int ldc; const float* ss; const float* rstd;
    __device__ __forceinline__ void operator()(const f32x4 (&acc)[2][2][4][2], const Unit& u, int wr, int wc, int fr, int fq) const {
        const int row0 = u.pm * BM + wr * 64 + fr, col0 = u.pn * HALF + wc * 32 + 8 * fq;
#pragma unroll
        for (int ai = 0; ai < 2; ++ai) {
            float rs[4];
#pragma unroll
            for (int m = 0; m < 4; ++m) { const int row = row0 + ai * HALF + m * 16; rs[m] = ss ? rstd_from_ss(ss, row) : rstd[row]; }
            asm volatile("" ::: "memory");
#pragma unroll
            for (int m = 0; m < 4; ++m) { const int row = row0 + ai * HALF + m * 16;
                float h[8];
#pragma unroll
                for (int n = 0; n < 2; ++n)
#pragma unroll
                    for (int i = 0; i < 4; ++i) { const float gg = acc[ai][0][m][n][i] * rs[m], uu = acc[ai][1][m][n][i] * rs[m]; h[n * 4 + i] = siluf_(gg) * uu; }
                *(u32x4*)(O + (size_t)row * ldc + col0) = pack8(h); }
        }
    }
};
struct EpiQkv {
    static constexpr bool PERM = true, AFTER_DRAIN = false;
    bf16_t* O; const float* ss; const float* bias; const float* qn; const float* kn; const float* rope;
    __device__ __forceinline__ void operator()(const f32x4 (&acc)[2][2][4][2], const Unit& u, int wr, int wc, int fr, int fq) const {
        const int hd = u.pn * 4 + wc, row0 = u.pm * BM + wr * 64 + fr; const int kind = u.pn < 4 ? 0 : (u.pn == 4 ? 1 : 2);
        const float* nw = kind == 0 ? qn : kn;
        float bv[2][8], nv[2][8];
#pragma unroll
        for (int bj = 0; bj < 2; ++bj)
#pragma unroll
            for (int j = 0; j < 8; ++j) { bv[bj][j] = bias[hd * 64 + bj * 32 + fq * 8 + j]; nv[bj][j] = nw[bj * 32 + fq * 8 + j]; }
#pragma unroll
        for (int ai = 0; ai < 2; ++ai)
#pragma unroll
            for (int m = 0; m < 4; ++m) { const int row = row0 + ai * HALF + m * 16; const float rs = rstd_from_ss(ss, row);
                float v[2][8]; float s = 0.f;
#pragma unroll
                for (int bj = 0; bj < 2; ++bj)
#pragma unroll
                    for (int n = 0; n < 2; ++n)
#pragma unroll
                        for (int i = 0; i < 4; ++i) { const float x = acc[ai][bj][m][n][i] * rs + bv[bj][n * 4 + i]; v[bj][n * 4 + i] = x; s += x * x; }
                if (kind < 2) {
                    s += __shfl_xor(s, 16); s += __shfl_xor(s, 32);
                    const float r2 = __builtin_amdgcn_rsqf(s * (1.0f / 64.0f) + EPS);
#pragma unroll
                    for (int bj = 0; bj < 2; ++bj)
#pragma unroll
                        for (int j = 0; j < 8; ++j) v[bj][j] = v[bj][j] * r2 * nv[bj][j];
                    const f32x4* rp = (const f32x4*)(rope + (size_t)row * 16);
                    const f32x4 c0 = rp[0], c1 = rp[1], s0 = rp[2], s1 = rp[3];
#pragma unroll
                    for (int j = 0; j < 8; ++j) { const float other = __shfl_xor(v[0][j], 16); const float cc = j < 4 ? c0[j] : c1[j - 4], sn = j < 4 ? s0[j] : s1[j - 4];
                        const float mine = v[0][j]; const float rot = (fq == 0) ? (mine * cc - other * sn) : (mine * cc + other * sn);
                        v[0][j] = (fq < 2) ? rot : mine; }
                }
#pragma unroll
                for (int bj = 0; bj < 2; ++bj) *(u32x4*)(O + (size_t)row * 1536 + hd * 64 + bj * 32 + fq * 8) = pack8(v[bj]);
            }
    }
};
}

#define XB_TMO      128
#define XB_XCNT(j)  (256  + 64 * (j))
#define XB_XSUB(j)  (1280 + 64 * (j))
#define XB_XGEN(j)  (2304 + 64 * (j))
#define XB_TOP      3328
#define XB_TOPGEN   3392
#define XCD_BAR_WORDS 3456
#define XB_SPIN_CAP (1u << 20)
__device__ __forceinline__ unsigned xb_ld(unsigned* p)              { return __hip_atomic_load(p, __ATOMIC_RELAXED, __HIP_MEMORY_SCOPE_AGENT); }
__device__ __forceinline__ unsigned xb_add(unsigned* p, unsigned v) { return __hip_atomic_fetch_add(p, v, __ATOMIC_RELAXED, __HIP_MEMORY_SCOPE_AGENT); }
__device__ __forceinline__ unsigned xb_xcc_id() { return (unsigned)__builtin_amdgcn_s_getreg((3 << 11) | 20) & 0xFu; }
#define XB_SPIN(cond, bar) do { unsigned _sp = 0; while (cond) { __builtin_amdgcn_s_sleep(1); \
    if ((++_sp & 255u) == 0u) { if (xb_ld(&(bar)[XB_TMO])) break; if (_sp > XB_SPIN_CAP) { atomicAdd(&(bar)[XB_TMO], 1u); break; } } } } while (0)
struct XcdBarrier { unsigned* bar; unsigned x; volatile LAS unsigned* st; };
__device__ __forceinline__ XcdBarrier xcd_barrier_post(unsigned* bar, volatile LAS unsigned* st) {
    XcdBarrier b; b.bar = bar; b.x = xb_xcc_id(); b.st = st;
    if (threadIdx.x == 0) (void)xb_add(&bar[XB_XCNT(b.x)], 1u);
    return b;
}
__device__ __forceinline__ void xcd_barrier_complete(unsigned* bar, unsigned x, unsigned& nloc, unsigned& nx) {
    const unsigned G = gridDim.x * gridDim.y * gridDim.z;
    unsigned sum, cnt, mine, sp = 0u;
    for (;;) {
        sum = 0u; cnt = 0u; mine = 0u;
#pragma unroll
        for (unsigned j = 0; j < 16; ++j) { const unsigned c = xb_ld(&bar[XB_XCNT(j)]); sum += c; cnt += (c > 0u) ? 1u : 0u; mine = (j == x) ? c : mine; }
        if (sum == G) break;
        __builtin_amdgcn_s_sleep(1);
        if ((++sp & 255u) == 0u) { if (xb_ld(&bar[XB_TMO])) break; if (sp > XB_SPIN_CAP) { atomicAdd(&bar[XB_TMO], 1u); break; } }
    }
    nloc = mine > 0u ? mine : 1u; nx = cnt > 0u ? cnt : 1u;
}
__device__ __forceinline__ void xcd_barrier(const XcdBarrier& b) {
    asm volatile("s_waitcnt vmcnt(0)" ::: "memory");
    __syncthreads();
    if (threadIdx.x == 0) {
        unsigned* bar = b.bar;
        __builtin_amdgcn_s_waitcnt(0);
        unsigned nloc = b.st[0], nx = b.st[1];
        if (nloc == 0u) { xcd_barrier_complete(bar, b.x, nloc, nx); b.st[0] = nloc; b.st[1] = nx; }
        const unsigned old = xb_add(&bar[XB_XSUB(b.x)], 1u);
        const unsigned gen = old / nloc;
        if (old + 1u == (gen + 1u) * nloc) {
            __builtin_amdgcn_fence(__ATOMIC_RELEASE, "agent");
            asm volatile("s_waitcnt vmcnt(0)" ::: "memory");
            const unsigned og = xb_add(&bar[XB_TOP], 1u);
            const unsigned tg = og / nx;
            if (og + 1u == (tg + 1u) * nx) xb_add(&bar[XB_TOPGEN], 1u);
            else XB_SPIN(xb_ld(&bar[XB_TOPGEN]) == tg, bar);
            __builtin_amdgcn_fence(__ATOMIC_ACQUIRE, "agent");
            xb_add(&bar[XB_XGEN(b.x)], 1u);
            asm volatile("s_waitcnt vmcnt(0)" ::: "memory");
        } else {
            XB_SPIN(xb_ld(&bar[XB_XGEN(b.x)]) == gen, bar);
            __builtin_amdgcn_fence(__ATOMIC_ACQUIRE, "agent");
            asm volatile("s_waitcnt vmcnt(0)" ::: "memory");
        }
    }
    __syncthreads();
}

struct Args { const float* in[39]; const int* pos; float* out; unsigned char* ws; int ph_lo, ph_hi, variant, pad; };
enum InIdx { I_X = 0, I_NORM_MIX0 = 1, I_W_IN, I_MU, I_W0, I_WDEC, I_A0, I_WICL, I_WGAT, I_KK, I_KA, I_RK, I_GNW, I_GNB, I_CONVW, I_CONVB, I_DTB, I_ALOG, I_DSKIP, I_SSDN,
             I_WOUT, I_NORM_FFN0, I_FG, I_FU, I_FD, I_NORM_MIX1, I_WQKV, I_BQKV, I_QN, I_KN, I_SINK, I_WO, I_BO, I_NORM_FFN1, I_ROUTER, I_EG, I_EU, I_ED };

__device__ __forceinline__ void transpose_item(const float* W, int ld, int K, int k0, int n0, bf16_t* WT, int drow, LAS float* scr, int lane, const float* gk) {
    f32x4 v[8]; const int kr = lane >> 3, n4 = 4 * (lane & 7); const float* wp = W + (size_t)(k0 + kr) * ld + n0 + n4;
#pragma unroll
    for (int i = 0; i < 8; ++i) v[i] = *(const f32x4*)(wp + (size_t)(8 * i) * ld);
    if (gk) { const float* gp = gk + k0 + kr;
#pragma unroll
        for (int i = 0; i < 8; ++i) v[i] = v[i] * gp[8 * i]; }
#pragma unroll
    for (int i = 0; i < 8; ++i) { LAS float* sp = scr + (8 * i + kr) * 33 + n4; sp[0] = v[i][0]; sp[1] = v[i][1]; sp[2] = v[i][2]; sp[3] = v[i][3]; }
    asm volatile("s_waitcnt lgkmcnt(0)" ::: "memory");
    const int c = lane & 7;
#pragma unroll
    for (int j = 0; j < 4; ++j) { const int n = (lane >> 3) + 8 * j; const LAS float* s = scr + (8 * c) * 33 + n;
        u32x4 o; o.x = pk2(s[0 * 33], s[1 * 33]); o.y = pk2(s[2 * 33], s[3 * 33]); o.z = pk2(s[4 * 33], s[5 * 33]); o.w = pk2(s[6 * 33], s[7 * 33]);
        *(u32x4*)(WT + (size_t)(drow + n) * K + k0 + 8 * c) = o; }
    asm volatile("s_waitcnt lgkmcnt(0)" ::: "memory");
}
__device__ __forceinline__ int drow_of(int kind, int n0) {
    if (kind == 0) return n0;
    if (kind == 1) return 256 * (n0 >> 7) + (n0 & 127);
    if (kind == 2) return 256 * (n0 >> 7) + 128 + (n0 & 127);
    const int hd = n0 >> 6, bj = (n0 >> 5) & 1; return 256 * (hd >> 2) + 128 * bj + 32 * (hd & 3);
}
__device__ __forceinline__ bool transpose_matrix(int& it, const float* W, int ld, int K, int ncols, bf16_t* WT, int kind, LAS float* scr, int lane, const float* gk = nullptr) {
    const int nnb = ncols / 32, items = (K / 64) * nnb;
    if (it < items) { const int kb = it / nnb, nb = it % nnb; transpose_item(W, ld, K, 64 * kb, 32 * nb, WT, drow_of(kind, 32 * nb), scr, lane, gk); return true; }
    it -= items; return false;
}

__device__ __forceinline__ u32x4 conv8(const bf16_t* proj, size_t m, int tpos, int c, const float* cw, const float* cb) {
    const bf16_t* p = proj + m * NPROJ + 2304 + c; u32x4 raw[4];
#pragma unroll
    for (int k = 0; k < 4; ++k) raw[k] = *(const u32x4*)(p - (size_t)(tpos >= k ? k : 0) * NPROJ);
    float acc[8];
    { const f32x4 b0 = *(const f32x4*)(cb + c), b1 = *(const f32x4*)(cb + c + 4); acc[0] = b0[0]; acc[1] = b0[1]; acc[2] = b0[2]; acc[3] = b0[3]; acc[4] = b1[0]; acc[5] = b1[1]; acc[6] = b1[2]; acc[7] = b1[3]; }
#pragma unroll
    for (int k = 0; k < 4; ++k) { float x[8]; unpack8(raw[k], x); const float ok = tpos >= k ? 1.f : 0.f; const f32x4 w0 = *(const f32x4*)(cw + (3 - k) * 1024 + c), w1 = *(const f32x4*)(cw + (3 - k) * 1024 + c + 4);
        acc[0] += ok * w0[0] * x[0]; acc[1] += ok * w0[1] * x[1]; acc[2] += ok * w0[2] * x[2]; acc[3] += ok * w0[3] * x[3]; acc[4] += ok * w1[0] * x[4]; acc[5] += ok * w1[1] * x[5]; acc[6] += ok * w1[2] * x[6]; acc[7] += ok * w1[3] * x[7]; }
#pragma unroll
    for (int i = 0; i < 8; ++i) acc[i] = siluf_(acc[i]);
    return pack8(acc);
}
__device__ __forceinline__ u32x2 conv4(const bf16_t* proj, size_t m, int tpos, int c, const float* cw, const float* cb) {
    const bf16_t* p = proj + m * NPROJ + 2304 + c; u32x2 raw[4];
#pragma unroll
    for (int k = 0; k < 4; ++k) raw[k] = *(const u32x2*)(p - (size_t)(tpos >= k ? k : 0) * NPROJ);
    f32x4 acc = *(const f32x4*)(cb + c);
#pragma unroll
    for (int k = 0; k < 4; ++k) { const float ok = tpos >= k ? 1.f : 0.f; const f32x4 w0 = *(const f32x4*)(cw + (3 - k) * 1024 + c);
        acc[0] += ok * w0[0] * bflo(raw[k].x); acc[1] += ok * w0[1] * bfhi(raw[k].x); acc[2] += ok * w0[2] * bflo(raw[k].y); acc[3] += ok * w0[3] * bfhi(raw[k].y); }
    u32x2 o; o.x = pk2(siluf_(acc[0]), siluf_(acc[1])); o.y = pk2(siluf_(acc[2]), siluf_(acc[3])); return o;
}

#ifndef DUPM
#define DUPM 0u
#endif

#define XN ((bf16_t*)(ws + WS_XN))
#define MIX ((bf16_t*)(ws + WS_MIX))
#define PROJ ((bf16_t*)(ws + WS_PROJ))
#define GOUT ((bf16_t*)(ws + WS_GOUT))
#define XNB ((bf16_t*)(ws + WS_XNB))
#define HID ((bf16_t*)(ws + WS_HID))
#define QKV ((bf16_t*)(ws + WS_QKV))
#define ATTO ((bf16_t*)(ws + WS_ATTO))
#define AS ((bf16_t*)(ws + WS_AS))
#define HS ((bf16_t*)(ws + WS_HS))
#define SSTATE ((bf16_t*)(ws + 54 * MiB))
#define CHDEC ((float*)(ws + WS_TOPE))
#define DTSP ((float*)(ws + WS_DTSP))
#define KKR ((float*)(ws + WS_KKR))
#define ROPE ((float*)(ws + WS_ROPE))
#define SS ((float*)(ws + WS_SS))
#define TOPE ((int*)(ws + WS_TOPE))
#define RANK ((int*)(ws + WS_RANK))
#define TOPW ((float*)(ws + WS_TOPW))
#define POS ((int*)(ws + WS_POS))
#define RSTD4 ((float*)(ws + WS_RSTD4))
#define RSTDS ((float*)(ws + WS_RSTDS))
#define WDEC ((bf16_t*)(ws + WS_WDEC))
#define WICL ((bf16_t*)(ws + WS_WICL))
#define WGAT ((bf16_t*)(ws + WS_WGAT))
#define EGU ((bf16_t*)(ws + WS_EGU))
#define EDN ((bf16_t*)(ws + WS_EDN))
#define WIN ((bf16_t*)(ws + WS_WIN))
#define WOUT ((bf16_t*)(ws + WS_WOUT))
#define WGU ((bf16_t*)(ws + WS_WGU))
#define WDN ((bf16_t*)(ws + WS_WDN))
#define WQKV ((bf16_t*)(ws + WS_WQKV))
#define WO ((bf16_t*)(ws + WS_WO))
struct TDesc { const float* src; bf16_t* dst; const float* gk; int ld, K; };
__device__ __forceinline__ void tdesc(TDesc& d, int it, const float* W, int ld, int K, int ncols, bf16_t* WT, int kind, const float* gk) {
    const int nnb = ncols / 32, kb = it / nnb, nb = it % nnb;
    d.src = W + (size_t)(64 * kb) * ld + 32 * nb; d.dst = WT + (size_t)drow_of(kind, 32 * nb) * K + 64 * kb; d.gk = gk ? gk + 64 * kb : nullptr; d.ld = ld; d.K = K;
}
constexpr int CV_P0 = 1728, CV_NE = CV_P0 + 6016, CV_EGU = CV_NE + 16 * 704, CV_END = CV_EGU + 8 * 704;
__device__ __forceinline__ void conv_resolve(const float* const* in, unsigned char* ws, int id, TDesc& d) {
    if (id < 1664) { tdesc(d, id, in[I_W_IN], IN0, DM, NPROJ, (bf16_t*)(ws + WS_WIN), 0, nullptr); return; } id -= 1664;
    if (id < 16) { tdesc(d, id, in[I_WDEC], 512, 64, 512, (bf16_t*)(ws + WS_WDEC), 0, nullptr); return; } id -= 16;
    if (id < 16) { tdesc(d, id, in[I_WICL], 512, 64, 512, (bf16_t*)(ws + WS_WICL), 0, nullptr); return; } id -= 16;
    if (id < 32) { tdesc(d, id, in[I_WGAT], 512, 128, 512, (bf16_t*)(ws + WS_WGAT), 0, nullptr); return; } id -= 32;
    if (id < 512) { tdesc(d, id, in[I_WOUT], DM, DM, DM, (bf16_t*)(ws + WS_WOUT), 0, nullptr); return; } id -= 512;
    if (id < 1408) { tdesc(d, id, in[I_FG], FFN, DM, FFN, (bf16_t*)(ws + WS_WGU), 1, in[I_NORM_FFN0]); return; } id -= 1408;
    if (id < 1408) { tdesc(d, id, in[I_FU], FFN, DM, FFN, (bf16_t*)(ws + WS_WGU), 2, in[I_NORM_FFN0]); return; } id -= 1408;
    if (id < 1408) { tdesc(d, id, in[I_FD], DM, FFN, DM, (bf16_t*)(ws + WS_WDN), 0, nullptr); return; } id -= 1408;
    if (id < 768) { tdesc(d, id, in[I_WQKV], 1536, DM, 1536, (bf16_t*)(ws + WS_WQKV), 3, in[I_NORM_MIX1]); return; } id -= 768;
    if (id < 512) { tdesc(d, id, in[I_WO], DM, DM, DM, (bf16_t*)(ws + WS_WO), 0, nullptr); return; } id -= 512;
    if (id < 16 * 704) { const int e = id / 1408, r = id % 1408, up = r / 704;
        tdesc(d, r % 704, in[up ? I_EU : I_EG] + (size_t)e * DM * FE, FE, DM, FE, (bf16_t*)(ws + WS_EGU) + (size_t)e * 2 * FE * DM, 1 + up, in[I_NORM_FFN1]); return; } id -= 16 * 704;
    { const int e = id / 704; tdesc(d, id % 704, in[I_ED] + (size_t)e * FE * DM, DM, FE, DM, (bf16_t*)(ws + WS_EDN) + (size_t)e * DM * FE, 0, nullptr); }
}
__device__ __forceinline__ void conv_load(const TDesc& d, f32x4 (&v)[8], int lane) {
    const float* wp = d.src + (size_t)(lane >> 3) * d.ld + 4 * (lane & 7);
#pragma unroll
    for (int i = 0; i < 8; ++i) v[i] = *(const f32x4*)(wp + (size_t)(8 * i) * d.ld);
}
__device__ __forceinline__ void conv_finish(const TDesc& d, f32x4 (&v)[8], LAS float* scr, int lane) {
    const int kr = lane >> 3, n4 = 4 * (lane & 7);
    if (d.gk) {
#pragma unroll
        for (int i = 0; i < 8; ++i) v[i] = v[i] * d.gk[kr + 8 * i]; }
#pragma unroll
    for (int i = 0; i < 8; ++i) { LAS float* sp = scr + (8 * i + kr) * 33 + n4; sp[0] = v[i][0]; sp[1] = v[i][1]; sp[2] = v[i][2]; sp[3] = v[i][3]; }
    asm volatile("s_waitcnt lgkmcnt(0)" ::: "memory");
    const int c = lane & 7;
#pragma unroll
    for (int j = 0; j < 4; ++j) { const int n = (lane >> 3) + 8 * j; const LAS float* s = scr + (8 * c) * 33 + n;
        u32x4 o; o.x = pk2(s[0 * 33], s[1 * 33]); o.y = pk2(s[2 * 33], s[3 * 33]); o.z = pk2(s[4 * 33], s[5 * 33]); o.w = pk2(s[6 * 33], s[7 * 33]);
        *(u32x4*)(d.dst + (size_t)n * d.K + 8 * c) = o; }
    asm volatile("s_waitcnt lgkmcnt(0)" ::: "memory");
}
__device__ __forceinline__ void conv_range(const float* const* in, unsigned char* ws, int lo, int hi, int first, int stride, LAS float* scr, int lane) {
    int id = lo + first; if (id >= hi) return;
    TDesc cur; conv_resolve(in, ws, id, cur); f32x4 v[8]; conv_load(cur, v, lane);
    for (;;) {
        const int idn = id + stride; const bool hn = idn < hi; TDesc nx = cur; f32x4 w[8];
        if (hn) { conv_resolve(in, ws, idn, nx); conv_load(nx, w, lane); }
        conv_finish(cur, v, scr, lane);
        if (!hn) break;
        cur = nx; id = idn;
#pragma unroll
        for (int i = 0; i < 8; ++i) v[i] = w[i];
    }
}

__global__ void __launch_bounds__(512, 2) fwd_kernel(Args args) {
    extern __shared__ __attribute__((aligned(16))) unsigned char lds_raw[];
    LAS unsigned char* lds = (LAS unsigned char*)lds_raw;
    volatile LAS unsigned* MISC = (volatile LAS unsigned*)(lds + MISC_OFF);
    const int tid = threadIdx.x, lane = tid & 63, wave = __builtin_amdgcn_readfirstlane(tid >> 6);
    const int G = gridDim.x, bx = blockIdx.x;
    const int vcu = (G % 8 == 0) ? (bx % 8) * (G / 8) + bx / 8 : bx;
    unsigned char* ws = args.ws;
    unsigned* ctl = (unsigned*)(ws + WS_CTL);
    float* dout = args.out;
    if (tid < 32) ((LAS unsigned*)(lds + MISC_OFF))[tid] = 0u;
    __syncthreads();
    XcdBarrier bar = xcd_barrier_post(ctl + CW_BAR, MISC + 8);
    const int lo = args.ph_lo, hi = args.ph_hi;
#define IN(k) (lo <= (k) && (k) < hi)
#if DUPM
#define PHASE(k) for (int rep_ = 0; rep_ <= (int)((DUPM >> (k)) & 1u); ++rep_) if (IN(k))
#define REPBAR if (rep_) xcd_barrier(bar);
#else
#define PHASE(k) if (IN(k))
#define REPBAR
#endif
#define SEAM(k) do { if (IN(k) && IN((k) + 1)) xcd_barrier(bar); } while (0)
    const int gw = vcu * 8 + wave, NGW = G * 8;

    unsigned* CNT = ctl + CW_CNT;

    PHASE(0) { REPBAR
        conv_range(args.in, ws, 0, CV_P0, gw, NGW, (LAS float*)(lds + wave * 16384), lane);
        __syncthreads();
        LAS float* w8 = (LAS float*)lds;
        for (int r = tid; r < DM; r += 512) { const float* p = args.in[I_W_IN] + (size_t)r * IN0 + NPROJ; *(LAS f32x4*)(w8 + r * 8) = *(const f32x4*)p; *(LAS f32x4*)(w8 + r * 8 + 4) = *(const f32x4*)(p + 4); }
        __syncthreads();
        const float* gm = args.in[I_NORM_MIX0];
#pragma unroll 1
        for (int k0 = 0; k0 < MTOK / NGW; k0 += 4) {
          f32x4 vv[4][4];
#pragma unroll
          for (int q = 0; q < 4; ++q) { const f32x4* xr = (const f32x4*)(args.in[I_X] + (size_t)(gw + (k0 + q) * NGW) * DM) + lane;
#pragma unroll
              for (int j = 0; j < 4; ++j) vv[q][j] = xr[64 * j]; }
#pragma unroll
          for (int q = 0; q < 4; ++q) { const int m = gw + (k0 + q) * NGW;
            f32x4 v[4]; float s = 0.f;
#pragma unroll
            for (int j = 0; j < 4; ++j) { v[j] = vv[q][j]; s += (v[j][0] * v[j][0] + v[j][1] * v[j][1]) + (v[j][2] * v[j][2] + v[j][3] * v[j][3]); }
            const float rstd = __builtin_amdgcn_rsqf(wave_sum(s) * (1.0f / DM) + EPS);
            float d[8];
#pragma unroll
            for (int k = 0; k < 8; ++k) d[k] = 0.f;
            unsigned long long* o8 = (unsigned long long*)(XN + (size_t)m * DM) + lane;
#pragma unroll
            for (int j = 0; j < 4; ++j) { const f32x4 g4 = ((const f32x4*)gm)[64 * j + lane]; const f32x4 y = v[j] * rstd * g4;
                o8[64 * j] = (unsigned long long)pk2(y[0], y[1]) | ((unsigned long long)pk2(y[2], y[3]) << 32);
#pragma unroll
                for (int i = 0; i < 4; ++i) { const int c = 256 * j + 4 * lane + i; const f32x4 wa = *(const LAS f32x4*)(w8 + c * 8), wb = *(const LAS f32x4*)(w8 + c * 8 + 4);
                    d[0] += y[i] * wa[0]; d[1] += y[i] * wa[1]; d[2] += y[i] * wa[2]; d[3] += y[i] * wa[3]; d[4] += y[i] * wb[0]; d[5] += y[i] * wb[1]; d[6] += y[i] * wb[2]; d[7] += y[i] * wb[3]; } }
            wave_sum8(d);
            if (lane < 8) { float dv = d[0];
#pragma unroll
                for (int k = 1; k < 8; ++k) dv = (lane == k) ? d[k] : dv;
                const float z = dv + args.in[I_DTB][lane]; DTSP[(size_t)m * 8 + lane] = z > 20.f ? z : log1pf(__expf(z)); }
            if (lane >= 16 && lane < 24) { const int j = lane - 16; const float inv = expf(-(float)j * (0.125f * 13.122363377404328f)); const float ang = (float)args.pos[m] * inv;
                float sn, cs; sincosf(ang, &sn, &cs); ROPE[(size_t)m * 16 + j] = cs; ROPE[(size_t)m * 16 + 8 + j] = sn; }
          }
        }
        __syncthreads();
    }
    SEAM(0);

    PHASE(1) { REPBAR
        pg8::Gemm g{XN, WIN, MTOK, NPROJ, DM}; pg8::StaticOrder S; S.init(MTOK, NPROJ, G, bx);
        pg8::EpiBf16 E{PROJ, NPROJ};
        pg8::gemm_phase(lds, g, S, E);
        if (bx >= 64) {
            conv_range(args.in, ws, CV_P0, CV_NE + 8 * 704, (bx - 64) * 8 + wave, 192 * 8, (LAS float*)(lds + wave * 16384), lane);
        }
    }
    SEAM(1);

#define LANE_CONSTS const int r32 = lane & 31, hh = lane >> 5, trq = (lane & 15) >> 2, trc = 16 * ((lane >> 4) & 1) + 4 * (lane & 3)
#define TRF(M, P, s, blk) ({ const LAS bf16_t* p_ = (M) + (16 * (s) + 8 * hh + trq) * (P) + 32 * (blk) + trc; \
        const s16x4 lo_ = __builtin_bit_cast(s16x4, __builtin_amdgcn_ds_read_tr16_b64_v4i16((LAS s16x4*)p_)); \
        const s16x4 hi_ = __builtin_bit_cast(s16x4, __builtin_amdgcn_ds_read_tr16_b64_v4i16((LAS s16x4*)(p_ + 4 * (P)))); \
        (bf16x8){lo_[0], lo_[1], lo_[2], lo_[3], hi_[0], hi_[1], hi_[2], hi_[3]}; })
#define NATF(M, P, s, blk) (*(const LAS bf16x8*)((M) + (32 * (blk) + r32) * (P) + 16 * (s) + 8 * hh))
    PHASE(2) { REPBAR
        LANE_CONSTS;
        const float* mu = args.in[I_MU];
        LAS bf16_t* Aw = (LAS bf16_t*)lds; LAS bf16_t* Aa = (LAS bf16_t*)(lds + 9216); LAS bf16_t* Ag = (LAS bf16_t*)(lds + 18432);
        LAS float* LW = (LAS float*)(lds + 35840); LAS float* IC = LW + 4096;
        LAS bf16_t* At = (LAS bf16_t*)(lds + 68864); LAS bf16_t* Kt = At + 4608; LAS bf16_t* Bt = Kt + 4608; LAS bf16_t* Rt = Bt + 4608; LAS bf16_t* Vt = Rt + 4608;
        LAS bf16_t* Lab = (LAS bf16_t*)(lds + 35840);
        LAS bf16_t* XX = At;
        LAS bf16_t* Lak = (LAS bf16_t*)(lds + 114944); LAS bf16_t* Mrk = Lak + 4608; LAS bf16_t* Mrb = Mrk + 4608;
        LAS float* TOT = (LAS float*)(lds + 142592); LAS float* GAMC = TOT + 512;
        const int mt = (wave >> 1) & 1, nt = wave & 1, grp = wave >> 2;
        for (int unit = vcu; unit < MTOK / 64; unit += G) {
            const int m0 = unit * 64;
            {
                const int tt = tid >> 3, cg = tid & 7, m = m0 + tt; const bool hasprev = (m & (SEQ - 1)) != 0;
                const bf16_t* pc = PROJ + (size_t)m * NPROJ + 1536 + 32 * cg;
#pragma unroll 1
                for (int q = 0; q < 4; ++q) {
                    float c[8], p[8]; unpack8(*(const u32x4*)(pc + 8 * q), c);
                    if (hasprev) unpack8(*(const u32x4*)(pc - NPROJ + 8 * q), p); else { for (int i = 0; i < 8; ++i) p[i] = 0.f; }
                    float o[8];
#pragma unroll
                    for (int i = 0; i < 8; ++i) { const int col = 32 * cg + 8 * q + i; const float x = c[i] + (p[i] - c[i]) * mu[1536 + col];
                        o[i] = cg < 2 ? tanhf(x) : (cg < 4 ? x : sigmoidf_(x)); }
                    const u32x4 w = pack8(o); const int col0 = 32 * cg + 8 * q;
                    if (cg < 2) *(LAS u32x4*)(Aw + tt * 72 + col0) = w; else if (cg < 4) *(LAS u32x4*)(Aa + tt * 72 + (col0 - 64)) = w; else *(LAS u32x4*)(Ag + tt * 136 + (col0 - 128)) = w;
                }
            }
            LBAR();
#pragma unroll 1
            for (int h = 0; h < 8; ++h) {
                unsigned char* cs = (unsigned char*)dout + (size_t)(unit * 8 + h) * 24576;
                float r0v[8], k0v[8], v0v[8]; float pr = 0.f, pk = 0.f, pv = 0.f;
                {   const bf16_t* pp = PROJ + (size_t)(m0 + 8 * wave) * NPROJ + 64 * h + lane;
                    if (((m0 + 8 * wave) & (SEQ - 1)) != 0) { pr = bflo(pp[-NPROJ]); pk = bflo(pp[-NPROJ + 512]); pv = bflo(pp[-NPROJ + 1024]); }
#pragma unroll
                    for (int i = 0; i < 8; ++i) { r0v[i] = bflo(pp[(size_t)i * NPROJ]); k0v[i] = bflo(pp[(size_t)i * NPROJ + 512]); v0v[i] = bflo(pp[(size_t)i * NPROJ + 1024]); } }
                if (grp == 0) {
                    f32x16 ad, ai;
#pragma unroll
                    for (int r = 0; r < 16; ++r) { ad[r] = 0.f; ai[r] = 0.f; }
#pragma unroll
                    for (int s = 0; s < 4; ++s) {
                        const bf16x8 bd = *(const bf16x8*)(WDEC + (size_t)(64 * h + 32 * nt + r32) * 64 + 16 * s + 8 * hh), bi = *(const bf16x8*)(WICL + (size_t)(64 * h + 32 * nt + r32) * 64 + 16 * s + 8 * hh);
                        ad = __builtin_amdgcn_mfma_f32_32x32x16_bf16(NATF(Aw, 72, s, mt), bd, ad, 0, 0, 0);
                        ai = __builtin_amdgcn_mfma_f32_32x32x16_bf16(NATF(Aa, 72, s, mt), bi, ai, 0, 0, 0);
                    }
                    const int c = 32 * nt + r32; const float w0c = args.in[I_W0][64 * h + c], a0c = args.in[I_A0][64 * h + c];
                    LAS float* lwb = LW + (32 * mt + 4 * hh) * 64 + c;
#pragma unroll
                    for (int r = 0; r < 16; ++r) { lwb[crc(r) * 64] = -0.6065306597126334f * sigmoidf_(ad[r] + w0c); lwb[4096 + crc(r) * 64] = sigmoidf_(ai[r] + a0c); }
                } else {
                    f32x16 ag;
#pragma unroll
                    for (int r = 0; r < 16; ++r) ag[r] = 0.f;
#pragma unroll
                    for (int s = 0; s < 8; ++s) {
                        const bf16x8 bg = *(const bf16x8*)(WGAT + (size_t)(64 * h + 32 * nt + r32) * 128 + 16 * s + 8 * hh);
                        ag = __builtin_amdgcn_mfma_f32_32x32x16_bf16(NATF(Ag, 136, s, mt), bg, ag, 0, 0, 0);
                    }
                    bf16_t* gob = GOUT + (size_t)(m0 + 32 * mt + 4 * hh) * 512 + 64 * h + 32 * nt + r32;
#pragma unroll
                    for (int r = 0; r < 16; ++r) gob[crc(r) * 512] = (bf16_t)f2bf(ag[r]);
                }
                LBAR();
                {
                    const int c = lane, gc = 64 * h + c, t0 = 8 * wave;
                    const float mur = mu[gc], muk = mu[512 + gc], muv = mu[1024 + gc], kkc = args.in[I_KK][gc], kac = args.in[I_KA][gc], rkc = args.in[I_RK][gc];
                    float rr[8], kx[8], vv[8], an[8], bn[8], lw[8], cl[8]; float run = 0.f;
#pragma unroll
                    for (int i = 0; i < 8; ++i) {
                        const float r0 = r0v[i], k0 = k0v[i], v0 = v0v[i];
                        rr[i] = r0 + (pr - r0) * mur; const float kl = k0 + (pk - k0) * muk; vv[i] = v0 + (pv - v0) * muv; pr = r0; pk = k0; pv = v0;
                        const float ic = IC[(t0 + i) * 64 + c]; lw[i] = LW[(t0 + i) * 64 + c]; run += lw[i]; cl[i] = run;
                        const float xk = kl * kkc; const float ssq = dpp_sum63(xk * xk); const float kn = xk * __builtin_amdgcn_rsqf(ssq + 1e-12f);
                        an[i] = -kn; bn[i] = kn * ic; kx[i] = kl * (1.0f + (ic - 1.0f) * kac);
                        const float bon = dpp_sum63(rr[i] * kx[i] * rkc);
                        if (lane == 0) KKR[(size_t)(m0 + t0 + i) * 8 + h] = bon;
                    }
                    TOT[wave * 64 + c] = run;
                    LBAR();
                    float off = 0.f, totc = 0.f;
#pragma unroll
                    for (int w2 = 0; w2 < 8; ++w2) { const float tv = TOT[w2 * 64 + c]; totc += tv; off += (w2 < wave) ? tv : 0.f; }
                    if (wave == 0) GAMC[c] = __expf(totc);
#pragma unroll
                    for (int i = 0; i < 8; ++i) { const float cum = off + cl[i]; const float en = __expf(-cum), ep = __expf(cum), em = __expf(cum - lw[i]); const int o = (t0 + i) * 72 + c;
                        At[o] = (bf16_t)f2bf(an[i] * em); Kt[o] = (bf16_t)f2bf(kx[i] * en); Bt[o] = (bf16_t)f2bf(bn[i] * en); Rt[o] = (bf16_t)f2bf(rr[i] * ep); Vt[o] = (bf16_t)f2bf(vv[i]); }
                }
                LBAR();
                {
                    f32x16 pb, pk2_;
#pragma unroll
                    for (int r = 0; r < 16; ++r) { pb[r] = 0.f; pk2_[r] = 0.f; }
                    const LAS bf16_t* Aop = grp == 0 ? At : Rt;
#pragma unroll
                    for (int s = 0; s < 4; ++s) { const bf16x8 a = NATF(Aop, 72, s, mt);
                        pb = __builtin_amdgcn_mfma_f32_32x32x16_bf16(a, NATF(Bt, 72, s, nt), pb, 0, 0, 0);
                        pk2_ = __builtin_amdgcn_mfma_f32_32x32x16_bf16(a, NATF(Kt, 72, s, nt), pk2_, 0, 0, 0); }
                    const int sc = 32 * nt + r32, tb = 32 * mt + 4 * hh;
                    LAS bf16_t* o1 = (grp == 0 ? Lab : Mrb) + tb * 72 + sc; LAS bf16_t* o2 = (grp == 0 ? Lak : Mrk) + tb * 72 + sc;
#pragma unroll
                    for (int r = 0; r < 16; ++r) { const int t = tb + crc(r); const bool keep = grp == 0 ? (sc < t) : (sc <= t);
                        o1[crc(r) * 72] = (bf16_t)f2bf(keep ? pb[r] : 0.f); o2[crc(r) * 72] = (bf16_t)f2bf(keep ? pk2_[r] : 0.f); }
                }
                LBAR();
                f32x16 accA, accB;
#pragma unroll
                for (int r = 0; r < 16; ++r) { accA[r] = 0.f; accB[r] = 0.f; }
                {
                    const LAS bf16_t* Aop = grp == 0 ? Lak : Mrk;
#pragma unroll
                    for (int s = 0; s < 4; ++s) { const bf16x8 vb = TRF(Vt, 72, s, nt);
                        if (grp == 0) { accA = __builtin_amdgcn_mfma_f32_32x32x16_bf16(NATF(Aop, 72, s, mt), vb, accA, 0, 0, 0); accB = __builtin_amdgcn_mfma_f32_32x32x16_bf16(TRF(Kt, 72, s, mt), vb, accB, 0, 0, 0); }
                        else accB = __builtin_amdgcn_mfma_f32_32x32x16_bf16(NATF(Aop, 72, s, mt), vb, accB, 0, 0, 0); }
                    if (grp == 0) { LAS float* ggb = IC + (32 * mt + 4 * hh) * 65 + 32 * nt + r32;
#pragma unroll
                        for (int r = 0; r < 16; ++r) ggb[crc(r) * 65] = accA[r]; }
                }
                LBAR();
                {
                    const int n16 = lane & 15, g4 = lane >> 4;
                    f32x4 Rr[4];
                    if (wave < 4) {
#pragma unroll
                        for (int I = 0; I < 4; ++I)
#pragma unroll
                            for (int j = 0; j < 4; ++j) Rr[I][j] = bflo((unsigned)At[(16 * I + 4 * g4 + j) * 72 + 16 * wave + n16]);
                    } else { const LAS float* GG = IC;
#pragma unroll
                        for (int I = 0; I < 4; ++I)
#pragma unroll
                            for (int j = 0; j < 4; ++j) Rr[I][j] = GG[(16 * I + 4 * g4 + j) * 65 + 16 * (wave - 4) + n16];
                    }
                    LBAR();
                    const LAS bf16_t* lrow = Lab + n16 * 72 + 4 * g4;
#define LF(I, J) (*(const LAS u32x2*)(lrow + (16 * (I)) * 72 + 16 * (J)))
#define MF16(A0, A1, B0, B1, C) __builtin_amdgcn_mfma_f32_16x16x32_bf16(__builtin_bit_cast(bf16x8, (u32x4){(A0).x, (A0).y, (A1).x, (A1).y}), __builtin_bit_cast(bf16x8, (u32x4){(B0).x, (B0).y, (B1).x, (B1).y}), (C), 0, 0, 0)
                    const u32x2 zz = (u32x2){0u, 0u};
                    u32x2 Xb[4];
#pragma unroll
                    for (int I = 0; I < 4; ++I) {
                        f32x4 Z = Rr[I];
                        if (I == 1) Z = MF16(LF(1, 0), zz, Xb[0], zz, Z);
                        if (I == 2) Z = MF16(LF(2, 0), LF(2, 1), Xb[0], Xb[1], Z);
                        if (I == 3) { Z = MF16(LF(3, 0), LF(3, 1), Xb[0], Xb[1], Z); Z = MF16(LF(3, 2), zz, Xb[2], zz, Z); }
                        const u32x2 ld = LF(I, I);
                        f32x4 X = Z;
#pragma unroll
                        for (int it = 0; it < 15; ++it) { u32x2 xb; xb.x = pk2(X[0], X[1]); xb.y = pk2(X[2], X[3]); X = MF16(ld, zz, xb, zz, Z); }
                        Xb[I].x = pk2(X[0], X[1]); Xb[I].y = pk2(X[2], X[3]);
                        LAS bf16_t* xo = XX + (16 * I + 4 * g4) * 136 + 16 * wave + n16;
                        xo[0] = (bf16_t)(Xb[I].x & 0xffffu); xo[136] = (bf16_t)(Xb[I].x >> 16); xo[272] = (bf16_t)(Xb[I].y & 0xffffu); xo[408] = (bf16_t)(Xb[I].y >> 16);
                    }
#undef LF
#undef MF16
                }
                LBAR();
                {
                    f32x16 acc1;
#pragma unroll
                    for (int r = 0; r < 16; ++r) acc1[r] = 0.f;
#pragma unroll
                    for (int s = 0; s < 4; ++s) {
                        const bf16x8 a = grp == 0 ? TRF(Bt, 72, s, mt) : NATF(Mrb, 72, s, mt);
                        acc1 = __builtin_amdgcn_mfma_f32_32x32x16_bf16(a, TRF(XX, 136, s, nt), acc1, 0, 0, 0);
                        accB = __builtin_amdgcn_mfma_f32_32x32x16_bf16(a, TRF(XX + 64, 136, s, nt), accB, 0, 0, 0);
                    }
                    const int col = 32 * nt + r32, rb = 32 * mt + 4 * hh;
                    if (grp == 0) {
                        bf16_t* acb = (bf16_t*)cs + rb * 64 + col; bf16_t* dcb = (bf16_t*)(cs + 8192) + col * 64 + rb; const LAS float* gb = GAMC + rb;
#pragma unroll
                        for (int r = 0; r < 16; ++r) { const float gcv = gb[crc(r)]; acb[crc(r) * 64] = (bf16_t)f2bf(gcv * (acc1[r] + ((rb + crc(r)) == col ? 1.0f : 0.0f))); }
#pragma unroll
                        for (int rq = 0; rq < 4; ++rq) { const f32x4 g4 = *(const LAS f32x4*)(gb + 8 * rq);
                            u32x2 w; w.x = pk2(accB[4 * rq] * g4[0], accB[4 * rq + 1] * g4[1]); w.y = pk2(accB[4 * rq + 2] * g4[2], accB[4 * rq + 3] * g4[3]); *(u32x2*)(dcb + 8 * rq) = w; }
                    } else {
                        bf16_t* rpb = (bf16_t*)(cs + 16384) + rb * 64 + col; const LAS bf16_t* rtb = Rt + rb * 72 + col; bf16_t* yb = MIX + (size_t)(m0 + rb) * DM + 64 * h + col;
#pragma unroll
                        for (int r = 0; r < 16; ++r) { rpb[crc(r) * 64] = (bf16_t)f2bf(acc1[r] + bflo((unsigned)rtb[crc(r) * 72])); yb[crc(r) * DM] = (bf16_t)f2bf(accB[r]); }
                    }
                }
                LBAR();
            }
        }
    }

    SEAM(2);

    PHASE(3) { REPBAR
        LANE_CONSTS;
        if (vcu < 32) {
            const int b = vcu >> 3, h = vcu & 7;
            const unsigned char* cbase = (const unsigned char*)dout + (size_t)(b * 64 * 8 + h) * 24576;
            constexpr size_t CSTR = (size_t)8 * 24576; constexpr int SLOT = 27648;
            const bool loader = wave >= 2; const int lt = tid - 128;
            int poff[4];
#pragma unroll
            for (int k = 0; k < 4; ++k) { const int p = lt + 384 * k; poff[k] = (p >> 9) * 9216 + ((p & 511) >> 3) * 144 + (p & 7) * 16; }
            u32x4 st[4][4];
#define RB_ISSUE(set, ch) do { if (loader) { const unsigned char* g_ = cbase + (size_t)(ch) * CSTR + (size_t)lt * 16; _Pragma("unroll") for (int k = 0; k < 4; ++k) st[set][k] = *(const u32x4*)(g_ + k * 6144); } } while (0)
#define RB_WRITE(set, ch) do { if (loader) { LAS unsigned char* s_ = lds + ((ch) & 3) * SLOT; _Pragma("unroll") for (int k = 0; k < 4; ++k) *(LAS u32x4*)(s_ + poff[k]) = st[set][k]; } } while (0)
            RB_ISSUE(0, 0); RB_ISSUE(1, 1); RB_WRITE(0, 0); RB_WRITE(1, 1);
            RB_ISSUE(2, 2); RB_ISSUE(3, 3); RB_ISSUE(0, 4); RB_ISSUE(1, 5);
            LBAR();
            f32x16 H[2];
#pragma unroll
            for (int r = 0; r < 16; ++r) { H[0][r] = 0.f; H[1][r] = 0.f; }
            bf16_t* zp = (bf16_t*)((unsigned char*)dout + 48 * MiB) + (size_t)(b * SEQ + 4 * hh) * 512 + 64 * h + 32 * wave + r32;
#define RB_STEP(j, chv) do { const int ch_ = (chv); \
                if (loader) { if (ch_ + 2 < 64) RB_WRITE(((j) + 2) & 3, ch_ + 2); if (ch_ + 6 < 64) RB_ISSUE(((j) + 2) & 3, ch_ + 6); } \
                else { const LAS unsigned char* sl = lds + (ch_ & 3) * SLOT; f32x16 Hn[2], Z[2]; bf16x8 Hb[4]; \
                    _Pragma("unroll") for (int s = 0; s < 4; ++s) { const int m = s >> 1, o = 8 * (s & 1); u32x4 t; t.x = pk2(H[m][o], H[m][o + 1]); t.y = pk2(H[m][o + 2], H[m][o + 3]); t.z = pk2(H[m][o + 4], H[m][o + 5]); t.w = pk2(H[m][o + 6], H[m][o + 7]); Hb[s] = __builtin_bit_cast(bf16x8, t); } \
                    _Pragma("unroll") for (int m = 0; m < 2; ++m) { \
                        _Pragma("unroll") for (int rq = 0; rq < 4; ++rq) { const u32x2 d = *(const LAS u32x2*)(sl + 9216 + (32 * wave + r32) * 144 + (32 * m + 8 * rq + 4 * hh) * 2); \
                            Hn[m][4 * rq] = bflo(d.x); Hn[m][4 * rq + 1] = bfhi(d.x); Hn[m][4 * rq + 2] = bflo(d.y); Hn[m][4 * rq + 3] = bfhi(d.y); } \
                        _Pragma("unroll") for (int r = 0; r < 16; ++r) Z[m][r] = 0.f; } \
                    _Pragma("unroll") for (int s = 0; s < 4; ++s) \
                        _Pragma("unroll") for (int m = 0; m < 2; ++m) { const int o = (32 * m + r32) * 144 + (16 * s + 4 * hh) * 2; \
                            const u32x2 a0 = *(const LAS u32x2*)(sl + o), a1 = *(const LAS u32x2*)(sl + o + 16), q0 = *(const LAS u32x2*)(sl + 18432 + o), q1 = *(const LAS u32x2*)(sl + 18432 + o + 16); \
                            u32x4 t; t.x = a0.x; t.y = a0.y; t.z = a1.x; t.w = a1.y; Hn[m] = __builtin_amdgcn_mfma_f32_32x32x16_bf16(__builtin_bit_cast(bf16x8, t), Hb[s], Hn[m], 0, 0, 0); \
                            t.x = q0.x; t.y = q0.y; t.z = q1.x; t.w = q1.y; Z[m] = __builtin_amdgcn_mfma_f32_32x32x16_bf16(__builtin_bit_cast(bf16x8, t), Hb[s], Z[m], 0, 0, 0); } \
                    H[0] = Hn[0]; H[1] = Hn[1]; \
                    bf16_t* zq = zp + (size_t)ch_ * 64 * 512; \
                    _Pragma("unroll") for (int m = 0; m < 2; ++m) _Pragma("unroll") for (int r = 0; r < 16; ++r) zq[(32 * m + crc(r)) * 512] = (bf16_t)f2bf(Z[m][r]); } \
                LBAR(); } while (0)
            if (wave < 2 || loader) {
                for (int ch = 0; ch < 64; ch += 4) { RB_STEP(0, ch); RB_STEP(1, ch + 1); RB_STEP(2, ch + 2); RB_STEP(3, ch + 3); }
            }
#undef RB_STEP
#undef RB_ISSUE
#undef RB_WRITE
        } else {
            LAS bf16_t* Bm = (LAS bf16_t*)lds; LAS bf16_t* Xh = (LAS bf16_t*)(lds + 34816); LAS float* CUM = (LAS float*)(lds + 53248); LAS float* DTL = CUM + 512;
            for (int unit = vcu - 32; unit < 256; unit += G - 32) {
                const int g = unit & 1, c = (unit >> 1) & 31, b = unit >> 6, m0 = b * SEQ + c * 128;
#pragma unroll 1
                for (int k = 0; k < 4; ++k) { const int p = tid + 512 * k, row = p >> 4, c16 = p & 15; *(LAS u32x4*)(Bm + row * 136 + 8 * c16) = conv8(PROJ, (size_t)(m0 + row), c * 128 + row, 512 + 128 * g + 8 * c16, args.in[I_CONVW], args.in[I_CONVB]); }
                if (wave < 4) { const int h = 4 * g + wave; const float a_h = -__expf(args.in[I_ALOG][h]);
                    const float v0 = DTSP[(size_t)(m0 + 2 * lane) * 8 + h], v1 = DTSP[(size_t)(m0 + 2 * lane + 1) * 8 + h]; float s = v0 + v1;
#pragma unroll
                    for (int o = 1; o < 64; o <<= 1) { const float t = __shfl_up(s, o); if (lane >= o) s += t; }
                    const float ex = s - (v0 + v1);
                    CUM[wave * 128 + 2 * lane] = a_h * (ex + v0); CUM[wave * 128 + 2 * lane + 1] = a_h * (ex + v0 + v1); DTL[wave * 128 + 2 * lane] = v0; DTL[wave * 128 + 2 * lane + 1] = v1; }
                LBAR();
#pragma unroll 1
                for (int hq = 0; hq < 4; ++hq) { const int h = 4 * g + hq;
                    { const int s = tid >> 2, cq = 16 * (tid & 3); const float sc = DTL[hq * 128 + s] * __expf(CUM[hq * 128 + 127] - CUM[hq * 128 + s]);
#pragma unroll 1
                      for (int q = 0; q < 2; ++q) { float f[8]; unpack8(conv8(PROJ, (size_t)(m0 + s), c * 128 + s, 64 * h + cq + 8 * q, args.in[I_CONVW], args.in[I_CONVB]), f);
#pragma unroll
                          for (int i = 0; i < 8; ++i) f[i] *= sc;
                          *(LAS u32x4*)(Xh + s * 72 + cq + 8 * q) = pack8(f); } }
                    LBAR();
                    const int mt = wave >> 2, nt = wave & 3; f32x16 acc;
#pragma unroll
                    for (int r = 0; r < 16; ++r) acc[r] = 0.f;
#pragma unroll
                    for (int ks = 0; ks < 8; ++ks) acc = __builtin_amdgcn_mfma_f32_32x32x16_bf16(TRF(Xh, 72, ks, mt), TRF(Bm, 136, ks, nt), acc, 0, 0, 0);
                    bf16_t* sp = SSTATE + ((size_t)((b * 32 + c) * 8 + h)) * 8192 + (32 * mt + 4 * hh) * 128 + 32 * nt + r32;
#pragma unroll
                    for (int r = 0; r < 16; ++r) sp[crc(r) * 128] = (bf16_t)f2bf(acc[r]);
                    if (tid == 0) CHDEC[(b * 32 + c) * 8 + h] = __expf(CUM[hq * 128 + 127]);
                    LBAR();
                }
            }
            conv_range(args.in, ws, CV_NE + 8 * 704, CV_EGU, (vcu - 32) * 8 + wave, (G - 32) * 8, (LAS float*)(lds + wave * 16384), lane);
        }
    }

    SEAM(3);

    PHASE(4) { REPBAR
        const int gt = vcu * 512 + tid, bh = gt >> 12, e2 = gt & 4095, b = bh >> 3, h = bh & 7;
        unsigned* sp = (unsigned*)SSTATE + ((size_t)(b * 32 * 8 + h)) * 4096 + e2;
        unsigned vals[32];
#pragma unroll
        for (int c = 0; c < 32; ++c) vals[c] = sp[(size_t)c * 8 * 4096];
        float r0 = 0.f, r1 = 0.f;
#pragma unroll
        for (int c = 0; c < 32; ++c) { const float dec = CHDEC[(b * 32 + c) * 8 + h]; sp[(size_t)c * 8 * 4096] = pk2(r0, r1); r0 = r0 * dec + bflo(vals[c]); r1 = r1 * dec + bfhi(vals[c]); }
    }
    SEAM(4);

    PHASE(5) { REPBAR
        LANE_CONSTS;
        {
            LAS bf16_t* Cm = (LAS bf16_t*)lds; LAS bf16_t* Bm = (LAS bf16_t*)(lds + 34816); LAS bf16_t* Xh = (LAS bf16_t*)(lds + 69632); LAS bf16_t* Hp = (LAS bf16_t*)(lds + 88064);
            LAS float* CUM = (LAS float*)(lds + 105472); LAS float* DTL = CUM + 512;
            for (int unit = vcu; unit < 256; unit += G) {
                const int g = unit & 1, c = (unit >> 1) & 31, b = unit >> 6, m0 = b * SEQ + c * 128;
#pragma unroll 1
                for (int k = 0; k < 4; ++k) { const int p = tid + 512 * k, row = p >> 4, c16 = p & 15;
                    *(LAS u32x4*)(Bm + row * 136 + 8 * c16) = conv8(PROJ, (size_t)(m0 + row), c * 128 + row, 512 + 128 * g + 8 * c16, args.in[I_CONVW], args.in[I_CONVB]);
                    *(LAS u32x4*)(Cm + row * 136 + 8 * c16) = conv8(PROJ, (size_t)(m0 + row), c * 128 + row, 768 + 128 * g + 8 * c16, args.in[I_CONVW], args.in[I_CONVB]); }
                if (wave < 4) { const int h = 4 * g + wave; const float a_h = -__expf(args.in[I_ALOG][h]);
                    const float v0 = DTSP[(size_t)(m0 + 2 * lane) * 8 + h], v1 = DTSP[(size_t)(m0 + 2 * lane + 1) * 8 + h]; float s = v0 + v1;
#pragma unroll
                    for (int o = 1; o < 64; o <<= 1) { const float t = __shfl_up(s, o); if (lane >= o) s += t; }
                    const float ex = s - (v0 + v1);
                    CUM[wave * 128 + 2 * lane] = a_h * (ex + v0); CUM[wave * 128 + 2 * lane + 1] = a_h * (ex + v0 + v1); DTL[wave * 128 + 2 * lane] = v0; DTL[wave * 128 + 2 * lane + 1] = v1; }
                LBAR();
                const int mt = wave >> 1, nb = 2 * (wave & 1), nt2 = wave & 1;
                f32x16 cb[2];
#pragma unroll
                for (int r = 0; r < 16; ++r) { cb[0][r] = 0.f; cb[1][r] = 0.f; }
#pragma unroll
                for (int ks = 0; ks < 8; ++ks) { const bf16x8 a = NATF(Cm, 136, ks, mt);
                    cb[0] = __builtin_amdgcn_mfma_f32_32x32x16_bf16(a, NATF(Bm, 136, ks, nb), cb[0], 0, 0, 0); cb[1] = __builtin_amdgcn_mfma_f32_32x32x16_bf16(a, NATF(Bm, 136, ks, nb + 1), cb[1], 0, 0, 0); }
                LBAR();
                LAS bf16_t* Wt = Bm;
#pragma unroll 1
                for (int hq = 0; hq < 4; ++hq) { const int h = 4 * g + hq;
                    u32x4 ph[2];
                    { const bf16_t* hp = SSTATE + ((size_t)((b * 32 + c) * 8 + h)) * 8192;
#pragma unroll
                      for (int k = 0; k < 2; ++k) { const int p = tid + 512 * k; ph[k] = *(const u32x4*)(hp + (p >> 4) * 128 + 8 * (p & 15)); } }
#pragma unroll
                    for (int j = 0; j < 2; ++j) { const int s = 32 * (nb + j) + r32; const float cs = CUM[hq * 128 + s], ds = DTL[hq * 128 + s]; const int lb = 32 * mt + 4 * hh;
                        LAS bf16_t* wp = Wt + lb * 136 + s; const LAS float* cl = CUM + hq * 128 + lb;
#pragma unroll
                        for (int r = 0; r < 16; ++r) { const float w = (s <= lb + crc(r)) ? cb[j][r] * __expf(cl[crc(r)] - cs) * ds : 0.f; wp[crc(r) * 136] = (bf16_t)f2bf(w); } }
                    { const int s = tid >> 2, cq = 16 * (tid & 3);
#pragma unroll 1
                      for (int q = 0; q < 2; ++q) *(LAS u32x4*)(Xh + s * 72 + cq + 8 * q) = conv8(PROJ, (size_t)(m0 + s), c * 128 + s, 64 * h + cq + 8 * q, args.in[I_CONVW], args.in[I_CONVB]); }
#pragma unroll
                    for (int k = 0; k < 2; ++k) { const int p = tid + 512 * k, row = p >> 4, c16 = p & 15; *(LAS u32x4*)(Hp + row * 136 + 8 * c16) = ph[k]; }
                    LBAR();
                    f32x16 yd, yo;
#pragma unroll
                    for (int r = 0; r < 16; ++r) { yd[r] = 0.f; yo[r] = 0.f; }
#pragma unroll
                    for (int ks = 0; ks < 8; ++ks) { yd = __builtin_amdgcn_mfma_f32_32x32x16_bf16(NATF(Wt, 136, ks, mt), TRF(Xh, 72, ks, nt2), yd, 0, 0, 0);
                        yo = __builtin_amdgcn_mfma_f32_32x32x16_bf16(NATF(Cm, 136, ks, mt), NATF(Hp, 136, ks, nt2), yo, 0, 0, 0); }
                    { const LAS float* cl = CUM + hq * 128 + 32 * mt + 4 * hh; bf16_t* yb = MIX + (size_t)(m0 + 32 * mt + 4 * hh) * DM + 512 + 256 * g + 64 * hq + 32 * nt2 + r32;
#pragma unroll
                      for (int r = 0; r < 16; ++r) yb[crc(r) * DM] = (bf16_t)f2bf(yd[r] + __expf(cl[crc(r)]) * yo[r]); }
                    LBAR();
                }
                __syncthreads();
                for (int i4 = 0; i4 < 16; i4 += 4) { const int ch = 256 * g + 4 * lane; const float dsk = args.in[I_DSKIP][4 * g + (lane >> 4)]; const f32x4 nw = *(const f32x4*)(args.in[I_SSDN] + ch);
                  u32x2 xv4[4], zv4[4];
#pragma unroll
                  for (int q = 0; q < 4; ++q) { const size_t m = (size_t)(m0 + wave * 16 + i4 + q); xv4[q] = conv4(PROJ, m, c * 128 + wave * 16 + i4 + q, ch, args.in[I_CONVW], args.in[I_CONVB]); zv4[q] = *(const u32x2*)(PROJ + m * NPROJ + 1792 + ch); }
#pragma unroll
                  for (int q = 0; q < 4; ++q) { const int l = wave * 16 + i4 + q; const size_t m = (size_t)(m0 + l);
                    const u32x2 yv = *(const u32x2*)(MIX + m * DM + 512 + ch), xv = xv4[q], zv = zv4[q];
                    float v[4] = {bflo(yv.x), bfhi(yv.x), bflo(yv.y), bfhi(yv.y)}; const float xs[4] = {bflo(xv.x), bfhi(xv.x), bflo(xv.y), bfhi(xv.y)}, zz[4] = {bflo(zv.x), bfhi(zv.x), bflo(zv.y), bfhi(zv.y)};
                    float qs = 0.f;
#pragma unroll
                    for (int j = 0; j < 4; ++j) { v[j] = (v[j] + dsk * xs[j]) * siluf_(zz[j]); qs += v[j] * v[j]; }
                    qs = wave_sum(qs); const float rq = __builtin_amdgcn_rsqf(qs * (1.0f / 256.0f) + EPS);
                    u32x2 o; o.x = pk2(v[0] * rq * nw[0], v[1] * rq * nw[1]); o.y = pk2(v[2] * rq * nw[2], v[3] * rq * nw[3]); *(u32x2*)(MIX + m * DM + 512 + ch) = o; } }
                LBAR();
            }
        }
        {
            const int c0 = 8 * lane, h = lane >> 3; const float* mu = args.in[I_MU];
            float muv[8], gw_[8], gb_[8];
#pragma unroll
            for (int i = 0; i < 8; ++i) { muv[i] = mu[1024 + c0 + i]; gw_[i] = args.in[I_GNW][c0 + i]; gb_[i] = args.in[I_GNB][c0 + i]; }
#pragma unroll 1
            for (int k0 = 0; k0 < MTOK / NGW; k0 += 4) {
                u32x4 ry[4], rz[4], rv[4], rp[4], rg[4]; float bdv[4];
#pragma unroll
                for (int q = 0; q < 4; ++q) { const size_t m = (size_t)(gw + (k0 + q) * NGW); const bool hasprev = (m & (SEQ - 1)) != 0;
                    ry[q] = *(const u32x4*)(MIX + m * DM + c0); rz[q] = *(const u32x4*)((const bf16_t*)((const unsigned char*)dout + 48 * MiB) + m * 512 + c0);
                    const bf16_t* pc = PROJ + m * NPROJ + c0 + 1024; rv[q] = *(const u32x4*)pc; rp[q] = hasprev ? *(const u32x4*)(pc - NPROJ) : (u32x4){0u, 0u, 0u, 0u};
                    rg[q] = *(const u32x4*)(GOUT + m * 512 + c0); bdv[q] = KKR[m * 8 + h]; }
#pragma unroll
                for (int q = 0; q < 4; ++q) { const size_t m = (size_t)(gw + (k0 + q) * NGW);
                    float y[8], v[8], p[8], go[8];
                    unpack8(ry[q], y); unpack8(rz[q], p);
#pragma unroll
                    for (int i = 0; i < 8; ++i) y[i] += p[i];
                    unpack8(rv[q], v); unpack8(rp[q], p);
#pragma unroll
                    for (int i = 0; i < 8; ++i) v[i] += (p[i] - v[i]) * muv[i];
                    unpack8(rg[q], go);
                    float s1 = 0.f; const float bd = bdv[q];
#pragma unroll
                    for (int i = 0; i < 8; ++i) s1 += y[i];
                    s1 += __shfl_xor(s1, 1); s1 += __shfl_xor(s1, 2); s1 += __shfl_xor(s1, 4);
                    const float mean = s1 * (1.0f / 64.0f); float s2 = 0.f;
#pragma unroll
                    for (int i = 0; i < 8; ++i) { const float d = y[i] - mean; s2 += d * d; }
                    s2 += __shfl_xor(s2, 1); s2 += __shfl_xor(s2, 2); s2 += __shfl_xor(s2, 4);
                    const float rs = __builtin_amdgcn_rsqf(s2 * (1.0f / 64.0f) + 64e-5f);
                    float o[8];
#pragma unroll
                    for (int i = 0; i < 8; ++i) o[i] = ((y[i] - mean) * rs * gw_[i] + gb_[i] + bd * v[i]) * go[i];
                    *(u32x4*)(MIX + m * DM + c0) = pack8(o); }
            }
        }
    }
    SEAM(5);


    PHASE(6) { REPBAR
        pg8::Gemm g{MIX, WOUT, MTOK, DM, DM}; pg8::StaticOrder S; S.init(MTOK, DM, G, bx);
        pg8::EpiRes<false, false> E{args.in[I_X], nullptr, XNB, nullptr, SS};
        pg8::gemm_phase(lds, g, S, E);
    }
    SEAM(6);
    PHASE(7) { REPBAR
        pg8::Gemm g{XNB, WGU, MTOK, 2 * FFN, DM}; pg8::StaticOrder S; S.init(MTOK, 2 * FFN, G, bx);
        pg8::EpiSwiglu E{HID, FFN, SS, nullptr};
        pg8::gemm_phase(lds, g, S, E);
    }
    SEAM(7);
    PHASE(8) { REPBAR
        pg8::Gemm g{HID, WDN, MTOK, DM, FFN}; pg8::StaticOrder S; S.init(MTOK, DM, G, bx);
        pg8::EpiRes<true, false> E{XNB, nullptr, XNB, nullptr, SS};
        pg8::gemm_phase(lds, g, S, E);
    }
    SEAM(8);
    PHASE(9) { REPBAR
        pg8::Gemm g{XNB, WQKV, MTOK, 1536, DM}; pg8::StaticOrder S; S.init(MTOK, 1536, G, bx);
        pg8::EpiQkv E{QKV, SS, args.in[I_BQKV], args.in[I_QN], args.in[I_KN], ROPE};
        pg8::gemm_phase(lds, g, S, E);
        if (bx >= 128) {
            conv_range(args.in, ws, CV_EGU, CV_END, (bx - 128) * 8 + wave, 128 * 8, (LAS float*)(lds + wave * 16384), lane);
        }
    }
    SEAM(9);

    PHASE(10) { REPBAR
        LAS bf16_t* Kt = (LAS bf16_t*)lds; LAS bf16_t* Vt = (LAS bf16_t*)(lds + 36864);
        const int r32 = lane & 31, hh = lane >> 5;
        for (int unit = vcu; unit < BATCH * 4 * 32; unit += G) {
            const int blk = unit & 31, kvh = (unit >> 5) & 3, b = unit >> 7;
            {
                const int rowi = tid >> 1, half = tid & 1; const int tpos = (blk - 1) * 128 + rowi;
#pragma unroll
                for (int q = 0; q < 4; ++q) { u32x4 kv = (u32x4){0, 0, 0, 0}, vv = kv;
                    if (tpos >= 0) { const bf16_t* p = QKV + (size_t)(b * SEQ + tpos) * 1536 + 1024 + kvh * 64 + half * 32 + 8 * q; kv = *(const u32x4*)p; vv = *(const u32x4*)(p + 256); }
                    *(LAS u32x4*)(Kt + rowi * 72 + half * 32 + 8 * q) = kv; *(LAS u32x4*)(Vt + rowi * 72 + half * 32 + 8 * q) = vv; }
            }
            __syncthreads();
            const int gq = wave >> 1, qh = kvh * 4 + gq; const float sink = args.in[I_SINK][qh];
            for (int it = 0; it < 2; ++it) {
                const int qi = (wave & 1) * 64 + it * 32 + r32; const size_t mq = (size_t)b * SEQ + blk * 128 + qi;
                bf16x8 qr[4];
#pragma unroll
                for (int s = 0; s < 4; ++s) qr[s] = *(const bf16x8*)(QKV + mq * 1536 + qh * 64 + 16 * s + 8 * hh);
                const int a0 = (wave & 1) * 2 + it;
                f32x16 sc[5];
#pragma unroll
                for (int j = 0; j < 5; ++j) {
#pragma unroll
                    for (int r = 0; r < 16; ++r) sc[j][r] = 0.f;
#pragma unroll
                    for (int s = 0; s < 4; ++s) { const bf16x8 kf = *(const LAS bf16x8*)(Kt + (32 * (a0 + j) + r32) * 72 + 16 * s + 8 * hh); sc[j] = __builtin_amdgcn_mfma_f32_32x32x16_bf16(kf, qr[s], sc[j], 0, 0, 0); }
                }
                float mx = sink;
#pragma unroll
                for (int j = 0; j < 5; ++j)
#pragma unroll
                    for (int r = 0; r < 16; ++r) { const int kj = 32 * (a0 + j) + crow(r, hh); const bool valid = (kj > qi) && (kj <= qi + 128) && (blk > 0 || kj >= 128);
                        const float x = valid ? sc[j][r] * 0.125f : -1e30f; sc[j][r] = x; mx = fmaxf(mx, x); }
                mx = fmaxf(mx, __shfl_xor(mx, 32));
                float l = 0.f;
#pragma unroll
                for (int j = 0; j < 5; ++j)
#pragma unroll
                    for (int r = 0; r < 16; ++r) { const float p = __expf(sc[j][r] - mx); sc[j][r] = p; l += p; }
                l += __shfl_xor(l, 32); l += __expf(sink - mx);
                const float inv = 1.0f / l;
                f32x16 o[2];
#pragma unroll
                for (int dt = 0; dt < 2; ++dt)
#pragma unroll
                    for (int r = 0; r < 16; ++r) o[dt][r] = 0.f;
#pragma unroll
                for (int j = 0; j < 5; ++j)
#pragma unroll
                    for (int s2 = 0; s2 < 2; ++s2) {
                        u32x4 pw; pw.x = pk2(sc[j][8 * s2 + 0], sc[j][8 * s2 + 1]); pw.y = pk2(sc[j][8 * s2 + 2], sc[j][8 * s2 + 3]); pw.z = pk2(sc[j][8 * s2 + 4], sc[j][8 * s2 + 5]); pw.w = pk2(sc[j][8 * s2 + 6], sc[j][8 * s2 + 7]);
                        const bf16x8 pf = __builtin_bit_cast(bf16x8, pw);
                        const int key0 = 32 * (a0 + j) + 16 * s2 + 4 * hh + ((lane & 15) >> 2);
#pragma unroll
                        for (int dt = 0; dt < 2; ++dt) {
                            const LAS bf16_t* vp = Vt + key0 * 72 + 32 * dt + 16 * ((lane >> 4) & 1) + 4 * (lane & 3);
                            const s16x4 lo = __builtin_bit_cast(s16x4, __builtin_amdgcn_ds_read_tr16_b64_v4i16((LAS s16x4*)vp));
                            const s16x4 hi = __builtin_bit_cast(s16x4, __builtin_amdgcn_ds_read_tr16_b64_v4i16((LAS s16x4*)(vp + 8 * 72)));
                            const bf16x8 vf = (bf16x8){lo[0], lo[1], lo[2], lo[3], hi[0], hi[1], hi[2], hi[3]};
                            o[dt] = __builtin_amdgcn_mfma_f32_32x32x16_bf16(vf, pf, o[dt], 0, 0, 0);
                        }
                    }
                bf16_t* op = ATTO + mq * DM + qh * 64;
#pragma unroll
                for (int dt = 0; dt < 2; ++dt)
#pragma unroll
                    for (int rq = 0; rq < 4; ++rq) { u32x2 w; w.x = pk2(o[dt][4 * rq] * inv, o[dt][4 * rq + 1] * inv); w.y = pk2(o[dt][4 * rq + 2] * inv, o[dt][4 * rq + 3] * inv);
                        *(u32x2*)(op + 32 * dt + 8 * rq + 4 * hh) = w; }
            }
            __syncthreads();
        }
    }
    SEAM(10);

    PHASE(11) { REPBAR
        pg8::Gemm g{ATTO, WO, MTOK, DM, DM}; pg8::StaticOrder S; S.init(MTOK, DM, G, bx);
        pg8::EpiResRouter E{XNB, dout, args.in[I_BO], SS, (float*)(ws + WS_GOUT)  , args.in[I_NORM_FFN1], args.in[I_ROUTER]};
        pg8::gemm_phase(lds, g, S, E);
    }
    SEAM(11);

    PHASE(12) { REPBAR
        LAS unsigned* lcnt = (LAS unsigned*)lds; LAS unsigned* lbase = lcnt + 8;
        if (tid < 8) lcnt[tid] = 0u;
        __syncthreads();
        int e0 = 0, e1 = 1; unsigned r0 = 0u, r1 = 0u; const int m = vcu * 64 + tid;
        if (tid < 64) {
            const float rstd = pg8::rstd_from_ss(SS, m);
            float d[8];
#pragma unroll
            for (int k = 0; k < 8; ++k) d[k] = 0.f;
            const f32x4* lp = (const f32x4*)((const float*)(ws + WS_GOUT) + (size_t)m * 128);
#pragma unroll
            for (int q = 0; q < 16; ++q) { const f32x4 a = lp[2 * q], b2 = lp[2 * q + 1]; d[0] += a[0]; d[1] += a[1]; d[2] += a[2]; d[3] += a[3]; d[4] += b2[0]; d[5] += b2[1]; d[6] += b2[2]; d[7] += b2[3]; }
            float v0 = d[0];
#pragma unroll
            for (int k = 1; k < 8; ++k) if (d[k] > v0) { v0 = d[k]; e0 = k; }
            float v1 = -3.0e38f; e1 = -1;
#pragma unroll
            for (int k = 0; k < 8; ++k) if (k != e0 && d[k] > v1) { v1 = d[k]; e1 = k; }
            const float w0 = __builtin_amdgcn_rcpf(1.0f + __expf((v1 - v0) * rstd));
            r0 = atomicAdd((unsigned*)(lcnt + e0), 1u); r1 = atomicAdd((unsigned*)(lcnt + e1), 1u);
            TOPE[2 * m] = e0; TOPE[2 * m + 1] = e1; TOPW[2 * m] = w0; TOPW[2 * m + 1] = 1.0f - w0; RSTD4[m] = rstd;
        }
        __syncthreads();
        if (tid < 8) lbase[tid] = atomicAdd(CNT + tid, lcnt[tid]);
        __syncthreads();
        if (tid < 64) { RANK[2 * m] = (int)(lbase[e0] + r0); RANK[2 * m + 1] = (int)(lbase[e1] + r1); }
        __syncthreads();
    }
    SEAM(12);

    PHASE(13) { REPBAR
        int roff[NEXP]; { int t = 0;
#pragma unroll
            for (int e = 0; e < NEXP; ++e) { roff[e] = t; t += (int)((CNT[e] + 255u) >> 8) << 8; } }
        {
            const int myj = gw + (lane & 15) * NGW, e = TOPE[myj]; int ro = roff[0];
#pragma unroll
            for (int k = 1; k < NEXP; ++k) ro = (e == k) ? roff[k] : ro;
            const int mypos = ro + RANK[myj];
            if (lane < 16) { POS[myj] = mypos; RSTDS[mypos] = RSTD4[myj >> 1]; }
#pragma unroll
            for (int k0 = 0; k0 < 16; k0 += 4) {
                u32x4 v[4][2]; int pos[4];
#pragma unroll
                for (int q = 0; q < 4; ++q) { pos[q] = __builtin_amdgcn_readlane(mypos, k0 + q); const int m = (gw + (k0 + q) * NGW) >> 1;
                    const u32x4* sp = (const u32x4*)(XNB + (size_t)m * DM) + lane; v[q][0] = sp[0]; v[q][1] = sp[64]; }
#pragma unroll
                for (int q = 0; q < 4; ++q) { u32x4* dp = (u32x4*)(AS + (size_t)pos[q] * DM) + lane; dp[0] = v[q][0]; dp[64] = v[q][1]; }
            }
        }
    }
    SEAM(13);
    PHASE(14) { REPBAR
        pg8::Gemm g{AS, EGU, SROWS, 2 * FE, DM}; pg8::MoeOrder S; S.init(CNT, 2 * FE / 256, G, bx, (long)2 * FE * DM * 2);
        pg8::EpiSwiglu E{HS, FE, nullptr, RSTDS};
        pg8::gemm_phase(lds, g, S, E);
    }
    SEAM(14);
    PHASE(15) { REPBAR
        pg8::Gemm g{HS, EDN, SROWS, DM, FE}; pg8::MoeOrder S; S.init(CNT, DM / 256, G, bx, (long)DM * FE * 2);
        pg8::EpiBf16 E{AS, DM};
        pg8::gemm_phase(lds, g, S, E);
    }
    SEAM(15);
    PHASE(16) { REPBAR
        {
            const int mym = gw + (lane & 7) * NGW; const int q0 = POS[2 * mym], q1 = POS[2 * mym + 1]; const float u0 = TOPW[2 * mym], u1 = TOPW[2 * mym + 1];
#pragma unroll
            for (int k0 = 0; k0 < 8; k0 += 4) {
                u32x4 ya[4][2], yb[4][2]; f32x4 hv[4][4]; float w0[4], w1[4];
#pragma unroll
                for (int t = 0; t < 4; ++t) { const int p0 = __builtin_amdgcn_readlane(q0, k0 + t), p1 = __builtin_amdgcn_readlane(q1, k0 + t);
                    w0[t] = __builtin_bit_cast(float, __builtin_amdgcn_readlane(__builtin_bit_cast(int, u0), k0 + t)); w1[t] = __builtin_bit_cast(float, __builtin_amdgcn_readlane(__builtin_bit_cast(int, u1), k0 + t));
                    const u32x4* y0 = (const u32x4*)(AS + (size_t)p0 * DM) + lane; const u32x4* y1 = (const u32x4*)(AS + (size_t)p1 * DM) + lane;
                    ya[t][0] = y0[0]; ya[t][1] = y0[64]; yb[t][0] = y1[0]; yb[t][1] = y1[64];
                    const f32x4* o = (const f32x4*)(dout + (size_t)(gw + (k0 + t) * NGW) * DM);
                    hv[t][0] = o[2 * lane]; hv[t][1] = o[2 * lane + 1]; hv[t][2] = o[128 + 2 * lane]; hv[t][3] = o[128 + 2 * lane + 1]; }
#pragma unroll
                for (int t = 0; t < 4; ++t) { f32x4* o = (f32x4*)(dout + (size_t)(gw + (k0 + t) * NGW) * DM);
#pragma unroll
                    for (int q = 0; q < 2; ++q) { float a[8], c[8]; unpack8(ya[t][q], a); unpack8(yb[t][q], c); f32x4 h0 = hv[t][2 * q], h1 = hv[t][2 * q + 1];
#pragma unroll
                        for (int i = 0; i < 4; ++i) { h0[i] += w0[t] * a[i] + w1[t] * c[i]; h1[i] += w0[t] * a[4 + i] + w1[t] * c[4 + i]; }
                        o[128 * q + 2 * lane] = h0; o[128 * q + 2 * lane + 1] = h1; } }
            }
        }
    }
#undef TRF
#undef NATF
#undef IN
#undef SEAM
#undef PHASE
#undef REPBAR
}

constexpr int NPHASE = 17;
extern "C" void kernel_launch(void* const* d_in, const int* in_sizes, int n_in, void* d_out, int out_size, void* d_ws, size_t ws_size, hipStream_t stream) {
    static int grid = 0;
    if (grid == 0) {
        if (n_in != 39 || out_size != MTOK * DM || ws_size < WS_END) { fprintf(stderr, "kernel_launch: unexpected shapes n_in %d out %d ws %zu\n", n_in, out_size, ws_size); grid = -1; return; }
        int dev = 0, cus = 0;
        if (hipGetDevice(&dev) != hipSuccess || hipDeviceGetAttribute(&cus, hipDeviceAttributeMultiprocessorCount, dev) != hipSuccess) { grid = -1; return; }
        if (hipFuncSetAttribute((const void*)fwd_kernel, hipFuncAttributeMaxDynamicSharedMemorySize, LDS_BYTES) != hipSuccess) { fprintf(stderr, "kernel_launch: hipFuncSetAttribute failed\n"); grid = -1; return; }
        int per_cu = 0; (void)hipOccupancyMaxActiveBlocksPerMultiprocessor(&per_cu, (const void*)fwd_kernel, 512, LDS_BYTES); (void)hipGetLastError();
        grid = 256; if (cus != 256 || per_cu < 1) fprintf(stderr, "kernel_launch: note: cus %d per_cu %d\n", cus, per_cu);
    }
    if (grid < 0) return;
    Args a{};
    a.in[0] = (const float*)d_in[0];
    for (int i = 2; i < 39; ++i) a.in[i - 1] = (const float*)d_in[i];
    a.pos = (const int*)d_in[1]; a.out = (float*)d_out; a.ws = (unsigned char*)d_ws;
    (void)hipMemsetAsync((char*)d_ws + WS_CTL, 0, CTL_ZERO_BYTES, stream);
#ifdef PROBE_PHASE
    constexpr int pp = PROBE_PHASE; constexpr bool before = (pp == 2 || pp == 3 || pp == 5 || pp == 6 || pp == 8 || pp == 11 || pp == 12);
#ifdef PROBE_VARIANT
    a.variant = PROBE_VARIANT;
#endif
    if (before) { a.ph_lo = pp; a.ph_hi = pp + 1; hipLaunchKernelGGL(fwd_kernel, dim3(grid), dim3(512), LDS_BYTES, stream, a); (void)hipMemsetAsync((char*)d_ws + WS_CTL, 0, CTL_ZERO_BYTES, stream); }
    a.variant = 0;
#endif
    a.ph_lo = 0; a.ph_hi = NPHASE;
    hipLaunchKernelGGL(fwd_kernel, dim3(grid), dim3(512), LDS_BYTES, stream, a);
#ifdef PROBE_PHASE
    if (!before) { (void)hipMemsetAsync((char*)d_ws + WS_CTL, 0, CW_CNT * 4, stream);
#ifdef PROBE_VARIANT
        a.variant = PROBE_VARIANT;
#endif
        a.ph_lo = pp; a.ph_hi = pp + 1; hipLaunchKernelGGL(fwd_kernel, dim3(grid), dim3(512), LDS_BYTES, stream, a); }
#endif
}
```

```cpp
#include <hip/hip_runtime.h>
#include <cstdio>
#include <cstdint>

#define LAS __attribute__((address_space(3)))
#define GAS __attribute__((address_space(1)))
typedef unsigned short bf16_t;
typedef short bf16x8 __attribute__((ext_vector_type(8)));
typedef float f32x4 __attribute__((ext_vector_type(4)));
typedef float f32x2 __attribute__((ext_vector_type(2)));
typedef float f32x16 __attribute__((ext_vector_type(16)));
typedef unsigned u32x4 __attribute__((ext_vector_type(4)));
typedef unsigned u32x2 __attribute__((ext_vector_type(2)));
typedef short s16x4 __attribute__((ext_vector_type(4)));

constexpr int BATCH = 4, SEQ = 4096, DM = 1024, MTOK = BATCH * SEQ;
constexpr int IN0 = 3336, NPROJ = 3328;
constexpr int FFN = 2816, FE = 1408, NEXP = 8;
constexpr int SROWS = 2 * MTOK + NEXP * 256;
constexpr float EPS = 1e-6f;

constexpr size_t MiB = 1u << 20;
constexpr size_t WS_CTL = 0, CTL_ZERO_BYTES = 64 * 1024;
constexpr size_t WS_DTSP = 1 * MiB;
constexpr size_t WS_KKR = 1 * MiB + 512 * 1024;
constexpr size_t WS_ROPE = 2 * MiB;
constexpr size_t WS_SS = 3 * MiB;
constexpr size_t WS_TOPE = 4 * MiB;
constexpr size_t WS_RANK = 4 * MiB + 128 * 1024;
constexpr size_t WS_TOPW = 4 * MiB + 256 * 1024;
constexpr size_t WS_POS = 4 * MiB + 384 * 1024;
constexpr size_t WS_RSTD4 = 4 * MiB + 512 * 1024;
constexpr size_t WS_RSTDS = 4 * MiB + 640 * 1024;
constexpr size_t WS_WDEC = 5 * MiB;
constexpr size_t WS_WICL = 5 * MiB + 64 * 1024;
constexpr size_t WS_WGAT = 5 * MiB + 128 * 1024;
constexpr size_t WS_EGU = 6 * MiB;
constexpr size_t WS_EDN = 50 * MiB;
constexpr size_t WS_WIN = 72 * MiB;
constexpr size_t WS_WOUT = WS_WIN + (size_t)NPROJ * DM * 2;
constexpr size_t WS_WGU = WS_WOUT + 2 * MiB;
constexpr size_t WS_WDN = WS_WGU + 11 * MiB;
constexpr size_t WS_WQKV = WS_WDN + (size_t)DM * FFN * 2;
constexpr size_t WS_WO = WS_WQKV + 3 * MiB;
constexpr size_t R0 = 102 * MiB;
static_assert(WS_WO + 2 * MiB <= R0, "weights");
constexpr size_t WS_XN = R0, WS_MIX = R0;
constexpr size_t WS_PROJ = R0 + 32 * MiB;
constexpr size_t WS_GOUT = R0 + 136 * MiB;
constexpr size_t WS_XNB = R0 + 104 * MiB;
constexpr size_t WS_HID = R0;
constexpr size_t WS_QKV = R0;
constexpr size_t WS_ATTO = R0 + 48 * MiB;
constexpr size_t WS_AS = 72 * MiB;
constexpr size_t WS_HS = 140 * MiB;
constexpr size_t WS_END = 254 * MiB;
static_assert(WS_AS + (size_t)SROWS * DM * 2 <= WS_HS && WS_HS + (size_t)SROWS * FE * 2 <= WS_END && WS_GOUT + 16 * MiB <= WS_END, "map");
constexpr int CW_BAR = 4096, CW_CNT = 8192;

constexpr int LDS_BYTES = 147456, RING_BYTES = 131072, MISC_OFF = LDS_BYTES - 128;

__device__ __forceinline__ unsigned f2bf(float f) { unsigned u = __builtin_bit_cast(unsigned, f); return (u + 0x7fffu + ((u >> 16) & 1u)) >> 16; }
typedef __bf16 bf16x2_t __attribute__((ext_vector_type(2)));
__device__ __forceinline__ unsigned pk2(float lo, float hi) { const f32x2 v = {lo, hi}; const bf16x2_t b = __builtin_convertvector(v, bf16x2_t); return __builtin_bit_cast(unsigned, b); }
__device__ __forceinline__ float bflo(unsigned u) { return __builtin_bit_cast(float, u << 16); }
__device__ __forceinline__ float bfhi(unsigned u) { return __builtin_bit_cast(float, u & 0xffff0000u); }
__device__ __forceinline__ void unpack8(const u32x4 v, float* f) { f[0] = bflo(v.x); f[1] = bfhi(v.x); f[2] = bflo(v.y); f[3] = bfhi(v.y); f[4] = bflo(v.z); f[5] = bfhi(v.z); f[6] = bflo(v.w); f[7] = bfhi(v.w); }
__device__ __forceinline__ u32x4 pack8(const float* f) { u32x4 v; v.x = pk2(f[0], f[1]); v.y = pk2(f[2], f[3]); v.z = pk2(f[4], f[5]); v.w = pk2(f[6], f[7]); return v; }
__device__ __forceinline__ float sigmoidf_(float x) { return __builtin_amdgcn_rcpf(1.0f + __expf(-x)); }
__device__ __forceinline__ float siluf_(float x) { return x * __builtin_amdgcn_rcpf(1.0f + __expf(-x)); }
#define LBAR() do { asm volatile("s_waitcnt lgkmcnt(0)" ::: "memory"); __builtin_amdgcn_s_barrier(); asm volatile("" ::: "memory"); } while (0)
__device__ __forceinline__ float wave_sum(float v) {
#pragma unroll
    for (int o = 1; o < 64; o <<= 1) v += __shfl_xor(v, o);
    return v;
}
__device__ __forceinline__ float dpp_sum63(float x) {
    int v;
    v = __builtin_amdgcn_update_dpp(0, __builtin_bit_cast(int, x), 0xB1, 0xF, 0xF, false); x += __builtin_bit_cast(float, v);
    v = __builtin_amdgcn_update_dpp(0, __builtin_bit_cast(int, x), 0x4E, 0xF, 0xF, false); x += __builtin_bit_cast(float, v);
    v = __builtin_amdgcn_update_dpp(0, __builtin_bit_cast(int, x), 0x141, 0xF, 0xF, false); x += __builtin_bit_cast(float, v);
    v = __builtin_amdgcn_update_dpp(0, __builtin_bit_cast(int, x), 0x140, 0xF, 0xF, false); x += __builtin_bit_cast(float, v);
    v = __builtin_amdgcn_update_dpp(0, __builtin_bit_cast(int, x), 0x142, 0xA, 0xF, false); x += __builtin_bit_cast(float, v);
    v = __builtin_amdgcn_update_dpp(0, __builtin_bit_cast(int, x), 0x143, 0xC, 0xF, false); x += __builtin_bit_cast(float, v);
    return __builtin_bit_cast(float, __builtin_amdgcn_readlane(__builtin_bit_cast(int, x), 63));
}
__device__ __forceinline__ void wave_sum8(float (&d)[8]) {
    float e4[4], e2[2], e1;
    { const bool up = (threadIdx.x & 32) != 0;
#pragma unroll
      for (int k = 0; k < 4; ++k) { const float keep = up ? d[k + 4] : d[k], send = up ? d[k] : d[k + 4]; e4[k] = keep + __shfl_xor(send, 32); } }
    { const bool up = (threadIdx.x & 16) != 0;
#pragma unroll
      for (int k = 0; k < 2; ++k) { const float keep = up ? e4[k + 2] : e4[k], send = up ? e4[k] : e4[k + 2]; e2[k] = keep + __shfl_xor(send, 16); } }
    { const bool up = (threadIdx.x & 8) != 0; const float keep = up ? e2[1] : e2[0], send = up ? e2[0] : e2[1]; e1 = keep + __shfl_xor(send, 8); }
    e1 += __shfl_xor(e1, 4); e1 += __shfl_xor(e1, 2); e1 += __shfl_xor(e1, 1);
#pragma unroll
    for (int k = 0; k < 8; ++k) d[k] = __builtin_bit_cast(float, __builtin_amdgcn_readlane(__builtin_bit_cast(int, e1), 8 * k));
}
__device__ __forceinline__ int crow(int r, int hi) { return (r & 3) + 8 * (r >> 2) + 4 * hi; }
__device__ __forceinline__ constexpr int crc(int r) { return (r & 3) + 8 * (r >> 2); }

namespace pg8 {
constexpr int BM = 256, BK = 64, HALF = 128, HTB = HALF * BK * 2, NXCD = 8, WGM = 2;
__host__ __device__ __forceinline__ int lds_byte(int r, int c) { const int st = (r >> 4) * 2 + (c >> 5), rr = r & 15, cc = c & 31, ob = rr * 64 + cc * 2; return st * 1024 + (ob ^ (((ob >> 9) & 1) << 5)); }
__host__ __device__ __forceinline__ void stage_rc(int b, int& R, int& C) { const int st = b / 1024, sb = b % 1024, swz = sb ^ (((sb >> 9) & 1) << 5); R = (st >> 1) * 16 + swz / 64; C = (st & 1) * 32 + (swz % 64) / 2; }
__host__ __device__ __forceinline__ int perm32(int rho) { const int n = rho >> 4, i = rho & 15; return 8 * (i >> 2) + 4 * n + (i & 3); }
struct Unit { int pm, pn; long bofs; };
struct Gemm { const bf16_t* A; const bf16_t* Bt; int M, N, K; };
struct StaticOrder {
    int nM, nN, nwg, G, c;
    __device__ void init(int M, int N, int G_, int c_) { nM = M / BM; nN = N / BM; nwg = nM * nN; G = G_; c = c_; }
    __device__ bool next(int i, Unit& u) const {
        const long L = (long)i * G + c; if (L >= nwg) return false;
        int wgid = (int)L; { const int q = nwg / NXCD, r = nwg % NXCD, xcd = wgid % NXCD, off = wgid / NXCD; wgid = (xcd < r ? xcd * (q + 1) : r * (q + 1) + (xcd - r) * q) + off; }
        const int nig = WGM * nN, gid = wgid / nig, fm = gid * WGM, gsz = (nM - fm) < WGM ? (nM - fm) : WGM;
        u.pm = fm + ((wgid % nig) % gsz); u.pn = (wgid % nig) / gsz; u.bofs = 0; return true;
    }
};
struct MoeOrder {
    int toff[NEXP + 1]; int nN, G, c; long estride;
    __device__ void init(const unsigned* cnt, int nN_, int G_, int c_, long estride_) {
        nN = nN_; G = G_; c = c_; estride = estride_; int t = 0;
#pragma unroll
        for (int e = 0; e < NEXP; ++e) { toff[e] = t; t += (int)((cnt[e] + 255u) >> 8); }
        toff[NEXP] = t;
    }
    __device__ bool next(int i, Unit& u) const {
        const int nM = toff[NEXP], nwg = nM * nN; const long L = (long)i * G + c; if (L >= nwg) return false;
        int wgid = (int)L; { const int q = nwg / NXCD, r = nwg % NXCD, xcd = wgid % NXCD, off = wgid / NXCD; wgid = (xcd < r ? xcd * (q + 1) : r * (q + 1) + (xcd - r) * q) + off; }
        const int nig = WGM * nN, gid = wgid / nig, fm = gid * WGM, gsz = (nM - fm) < WGM ? (nM - fm) : WGM;
        const int pm = fm + ((wgid % nig) % gsz); u.pm = pm; u.pn = (wgid % nig) / gsz; int e = 0;
#pragma unroll
        for (int j = 1; j < NEXP; ++j) e += (pm >= toff[j]) ? 1 : 0;
        u.bofs = (long)e * estride; return true;
    }
};

template <class Epi, class Sched>
__device__ __forceinline__ void gemm_phase(LAS unsigned char* lds, const Gemm g, const Sched& S, const Epi& E) {
    constexpr bool ALIGN_EPI = true;
    const int tid = threadIdx.x, wid = __builtin_amdgcn_readfirstlane(tid >> 6), lane = tid & 63, wr = wid >> 2, wc = wid & 3, fr = lane & 15, fq = lane >> 4;
    const int K = g.K, nt = K / BK;
    unsigned voffA[2], voffB[2];
#pragma unroll
    for (int i = 0; i < 2; ++i) { int R, C; stage_rc(tid * 16 + i * 8192, R, C); const int Rb = Epi::PERM ? ((R & ~31) + perm32(R & 31)) : R;
        voffA[i] = (unsigned)(R * K + C) * 2u; voffB[i] = (unsigned)(Rb * K + C) * 2u; }
    const size_t kstep = (size_t)(BK * 2);
    const size_t hstep = (size_t)HALF * K * 2;
    const size_t tstep = 2 * hstep;
    const unsigned ldsw = (unsigned)wid * 1024u;
    const int aoff = lds_byte(wr * 64 + fr, fq * 8), boff = lds_byte(wc * 32 + fr, fq * 8);
#define PG8_SA(b, h) (((b) * 2 + (h)) * HTB)
#define PG8_SB(b, h) ((4 + (b) * 2 + (h)) * HTB)
#define PG8_STAGE(bufoff, gbase, voff) do { _Pragma("unroll") for (int _i = 0; _i < 2; ++_i) \
        __builtin_amdgcn_global_load_lds((const unsigned*)((const char*)(gbase) + (voff)[_i]), (LAS unsigned*)(lds + (bufoff) + ldsw + _i * 8192), 16, 0, 0); } while (0)
#define PG8_LDA(dst, b, h) do { _Pragma("unroll") for (int m = 0; m < 4; ++m) _Pragma("unroll") for (int k = 0; k < 2; ++k) dst[m][k] = *(const LAS bf16x8*)(lds + PG8_SA(b, h) + aoff + m * 2048 + k * 1024); } while (0)
#define PG8_LDB(dst, b, h) do { _Pragma("unroll") for (int n = 0; n < 2; ++n) _Pragma("unroll") for (int k = 0; k < 2; ++k) dst[n][k] = *(const LAS bf16x8*)(lds + PG8_SB(b, h) + boff + n * 2048 + k * 1024); } while (0)
#define PG8_MMA(ai, bj, At, Bt) do { __builtin_amdgcn_s_setprio(1); _Pragma("unroll") for (int m = 0; m < 4; ++m) _Pragma("unroll") for (int n = 0; n < 2; ++n) _Pragma("unroll") for (int k = 0; k < 2; ++k) \
        acc[ai][bj][m][n] = __builtin_amdgcn_mfma_f32_16x16x32_bf16(Bt[n][k], At[m][k], acc[ai][bj][m][n], 0, 0, 0); __builtin_amdgcn_s_setprio(0); } while (0)
#define PG8_WAIT_V(n) asm volatile("s_waitcnt vmcnt(" #n ")" ::: "memory")
#define PG8_WAIT_L(n) asm volatile("s_waitcnt lgkmcnt(" #n ")" ::: "memory")
#define PG8_BAR __builtin_amdgcn_s_barrier()
#define PG8_SCHED __builtin_amdgcn_sched_barrier(0)
    Unit cur, nxt; int ui = 0;
    if (!S.next(0, cur)) return;
    f32x4 acc[2][2][4][2];
#pragma unroll
    for (int a = 0; a < 2; ++a)
#pragma unroll
        for (int b = 0; b < 2; ++b)
#pragma unroll
            for (int m = 0; m < 4; ++m)
#pragma unroll
                for (int n = 0; n < 2; ++n) acc[a][b][m][n] = (f32x4){0.f, 0.f, 0.f, 0.f};
    bf16x8 At[4][2], B0[2][2], B1[2][2];
    const char* cA = (const char*)g.A + (size_t)cur.pm * tstep; const char* cB = (const char*)g.Bt + cur.bofs + (size_t)cur.pn * tstep;
    PG8_STAGE(PG8_SB(0, 0), cB, voffB); PG8_STAGE(PG8_SB(0, 1), cB + hstep, voffB); PG8_STAGE(PG8_SA(0, 0), cA, voffA); PG8_STAGE(PG8_SA(0, 1), cA + hstep, voffA);
    if (wr == 1) PG8_BAR;
    PG8_WAIT_V(2); PG8_BAR;
    PG8_STAGE(PG8_SB(1, 0), cB + kstep, voffB); PG8_STAGE(PG8_SA(1, 0), cA + kstep, voffA); PG8_STAGE(PG8_SB(1, 1), cB + hstep + kstep, voffB);
    PG8_WAIT_V(6); PG8_BAR;
    for (;;) {
        const bool has_next = S.next(ui + 1, nxt);
        const char* nA = has_next ? (const char*)g.A + (size_t)nxt.pm * tstep : cA; const char* nB = has_next ? (const char*)g.Bt + nxt.bofs + (size_t)nxt.pn * tstep : cB;
        for (int t = 0; t < nt; t += 2) {
            const bool last = (t == nt - 2);
            const char* a1 = cA + (size_t)(t + 1) * kstep;
            const char* a2 = last ? nA : cA + (size_t)(t + 2) * kstep; const char* b2 = last ? nB : cB + (size_t)(t + 2) * kstep;
            const char* a3 = a2 + kstep; const char* b3 = b2 + kstep;
            PG8_LDB(B0, 0, 0); PG8_LDB(B1, 0, 1); PG8_SCHED; PG8_LDA(At, 0, 0); PG8_STAGE(PG8_SA(1, 1), a1 + hstep, voffA);
            PG8_WAIT_V(8); PG8_WAIT_L(0); PG8_BAR; PG8_MMA(0, 0, At, B0); PG8_MMA(0, 1, At, B1); PG8_BAR; PG8_SCHED;
            PG8_LDA(At, 0, 1); PG8_STAGE(PG8_SB(0, 0), b2, voffB); PG8_STAGE(PG8_SB(0, 1), b2 + hstep, voffB); PG8_STAGE(PG8_SA(0, 0), a2, voffA);
            PG8_WAIT_V(8); PG8_WAIT_L(0); PG8_BAR; PG8_MMA(1, 0, At, B0); PG8_MMA(1, 1, At, B1); PG8_BAR; PG8_SCHED;
            PG8_LDB(B0, 1, 0); PG8_LDB(B1, 1, 1); PG8_SCHED; PG8_LDA(At, 1, 0); PG8_STAGE(PG8_SA(0, 1), a2 + hstep, voffA);
            PG8_WAIT_V(8); PG8_WAIT_L(0); PG8_BAR; PG8_MMA(0, 0, At, B0); PG8_MMA(0, 1, At, B1); PG8_BAR; PG8_SCHED;
            PG8_LDA(At, 1, 1); PG8_STAGE(PG8_SB(1, 0), b3, voffB); PG8_STAGE(PG8_SB(1, 1), b3 + hstep, voffB); PG8_STAGE(PG8_SA(1, 0), a3, voffA);
            PG8_WAIT_V(8); PG8_WAIT_L(0); PG8_BAR; PG8_MMA(1, 0, At, B0); PG8_MMA(1, 1, At, B1); PG8_BAR; PG8_SCHED;
        }
        if constexpr (ALIGN_EPI) { if (wr == 0) PG8_BAR; }
        if constexpr (!Epi::AFTER_DRAIN) E(acc, cur, wr, wc, fr, fq);
        if (!has_next) break;
#pragma unroll
        for (int a = 0; a < 2; ++a)
#pragma unroll
            for (int b = 0; b < 2; ++b)
#pragma unroll
                for (int m = 0; m < 4; ++m)
#pragma unroll
                    for (int n = 0; n < 2; ++n) acc[a][b][m][n] = (f32x4){0.f, 0.f, 0.f, 0.f};
        cur = nxt; cA = nA; cB = nB; ++ui;
        if constexpr (ALIGN_EPI) { if (wr == 1) PG8_BAR; }
    }
    PG8_WAIT_V(0);
    if constexpr (!ALIGN_EPI) { if (wr == 0) PG8_BAR; }
    PG8_BAR;
    if constexpr (Epi::AFTER_DRAIN) E.fused(acc, cur, wr, wc, fr, fq, lds);
#undef PG8_SA
#undef PG8_SB
#undef PG8_STAGE
#undef PG8_LDA
#undef PG8_LDB
#undef PG8_MMA
#undef PG8_WAIT_V
#undef PG8_WAIT_L
#undef PG8_BAR
#undef PG8_SCHED
}

struct EpiBf16 {
    static constexpr bool PERM = true, AFTER_DRAIN = false;
    bf16_t* O; int ldc;
    __device__ __forceinline__ void operator()(const f32x4 (&acc)[2][2][4][2], const Unit& u, int wr, int wc, int fr, int fq) const {
        const int row0 = u.pm * BM + wr * 64 + fr, col0 = u.pn * BM + wc * 32 + 8 * fq;
#pragma unroll
        for (int ai = 0; ai < 2; ++ai)
#pragma unroll
            for (int m = 0; m < 4; ++m) { bf16_t* rowp = O + (size_t)(row0 + ai * HALF + m * 16) * ldc + col0;
#pragma unroll
                for (int bj = 0; bj < 2; ++bj) { const f32x4 v0 = acc[ai][bj][m][0], v1 = acc[ai][bj][m][1];
                    u32x4 w; w.x = pk2(v0[0], v0[1]); w.y = pk2(v0[2], v0[3]); w.z = pk2(v1[0], v1[1]); w.w = pk2(v1[2], v1[3]);
                    *(u32x4*)(rowp + bj * HALF) = w; } }
    }
};
template <bool BASE_BF16, bool F32OUT> struct EpiRes {
    static constexpr bool PERM = false, AFTER_DRAIN = false;
    const void* base; float* out; bf16_t* hb; const float* bias; float* ss;
    __device__ __forceinline__ void operator()(const f32x4 (&acc)[2][2][4][2], const Unit& u, int wr, int wc, int fr, int fq) const {
        const int col0 = u.pn * BM + wc * 32 + 4 * fq;
        f32x4 bv[2][2];
#pragma unroll
        for (int bj = 0; bj < 2; ++bj)
#pragma unroll
            for (int n = 0; n < 2; ++n) bv[bj][n] = bias ? *(const f32x4*)(bias + col0 + bj * HALF + n * 16) : (f32x4){0.f, 0.f, 0.f, 0.f};
#pragma unroll
        for (int ai = 0; ai < 2; ++ai) {
            f32x4 pre[4][2][2];
#pragma unroll
            for (int m = 0; m < 4; ++m) { const size_t off = (size_t)(u.pm * BM + ai * HALF + wr * 64 + m * 16 + fr) * DM + col0;
#pragma unroll
                for (int bj = 0; bj < 2; ++bj)
#pragma unroll
                    for (int n = 0; n < 2; ++n) { const size_t o2 = off + bj * HALF + n * 16;
                        if (BASE_BF16) { const u32x2 w = *(const u32x2*)((const bf16_t*)base + o2); pre[m][bj][n] = (f32x4){bflo(w.x), bfhi(w.x), bflo(w.y), bfhi(w.y)}; } else pre[m][bj][n] = *(const f32x4*)((const float*)base + o2); } }
            asm volatile("" ::: "memory");
#pragma unroll
            for (int m = 0; m < 4; ++m) { const int row = u.pm * BM + ai * HALF + wr * 64 + m * 16 + fr; const size_t off = (size_t)row * DM + col0; float s = 0.f;
#pragma unroll
                for (int bj = 0; bj < 2; ++bj)
#pragma unroll
                    for (int n = 0; n < 2; ++n) { const size_t o2 = off + bj * HALF + n * 16;
                        const f32x4 o = pre[m][bj][n] + acc[ai][bj][m][n] + bv[bj][n];
                        if (F32OUT) *(f32x4*)(out + o2) = o;
                        s += (o[0] * o[0] + o[1] * o[1]) + (o[2] * o[2] + o[3] * o[3]);
                        u32x2 w; w.x = pk2(o[0], o[1]); w.y = pk2(o[2], o[3]); *(u32x2*)(hb + o2) = w; }
                s += __shfl_xor(s, 16); s += __shfl_xor(s, 32);
                if (fq == 0) ss[(size_t)row * 16 + u.pn * 4 + wc] = s; }
        }
    }
};
struct EpiResRouter {
    static constexpr bool PERM = false, AFTER_DRAIN = true;
    bf16_t* hb; float* out; const float* bias; float* ss; float* lp; const float* gw; const float* wr8;
    __device__ __forceinline__ void fused(const f32x4 (&acc)[2][2][4][2], const Unit& u, int wr, int wc, int fr, int fq, LAS unsigned char* lds) const {
        LAS float* GW = (LAS float*)lds;
        { const int t = threadIdx.x, c = t >> 1, hf = t & 1; const float g = gw[u.pn * BM + c]; const f32x4 w = *(const f32x4*)(wr8 + (size_t)(u.pn * BM + c) * 8 + 4 * hf); *(LAS f32x4*)(GW + c * 8 + 4 * hf) = w * g; }
        asm volatile("s_waitcnt lgkmcnt(0)" ::: "memory"); __builtin_amdgcn_s_barrier(); asm volatile("" ::: "memory");
        const int col0 = u.pn * BM + wc * 32 + 4 * fq, lc0 = wc * 32 + 4 * fq;
        f32x4 bv[2][2];
#pragma unroll
        for (int bj = 0; bj < 2; ++bj)
#pragma unroll
            for (int n = 0; n < 2; ++n) bv[bj][n] = *(const f32x4*)(bias + col0 + bj * HALF + n * 16);
#pragma unroll
        for (int ai = 0; ai < 2; ++ai) {
#pragma unroll
          for (int mh = 0; mh < 2; ++mh) {
            u32x2 pre[4][2][2];
#pragma unroll
            for (int m = 2 * mh; m < 2 * mh + 2; ++m) { const size_t off = (size_t)(u.pm * BM + ai * HALF + wr * 64 + m * 16 + fr) * DM + col0;
#pragma unroll
                for (int bj = 0; bj < 2; ++bj)
#pragma unroll
                    for (int n = 0; n < 2; ++n) pre[m][bj][n] = *(const u32x2*)(hb + off + bj * HALF + n * 16); }
            asm volatile("" ::: "memory");
#pragma unroll
            for (int m = 2 * mh; m < 2 * mh + 2; ++m) { const int row = u.pm * BM + ai * HALF + wr * 64 + m * 16 + fr; const size_t off = (size_t)row * DM + col0; float s = 0.f;
                float lg[8];
#pragma unroll
                for (int e = 0; e < 8; ++e) lg[e] = 0.f;
#pragma unroll
                for (int bj = 0; bj < 2; ++bj)
#pragma unroll
                    for (int n = 0; n < 2; ++n) { const size_t o2 = off + bj * HALF + n * 16; const u32x2 w = pre[m][bj][n];
                        const f32x4 o = (f32x4){bflo(w.x), bfhi(w.x), bflo(w.y), bfhi(w.y)} + acc[ai][bj][m][n] + bv[bj][n];
                        s += (o[0] * o[0] + o[1] * o[1]) + (o[2] * o[2] + o[3] * o[3]);
                        u32x2 wo; wo.x = pk2(o[0], o[1]); wo.y = pk2(o[2], o[3]); *(u32x2*)(hb + o2) = wo; *(f32x4*)(out + o2) = o;
#pragma unroll
                        for (int i = 0; i < 4; ++i) { const LAS float* gp = GW + (lc0 + bj * HALF + n * 16 + i) * 8; const f32x4 wa = *(const LAS f32x4*)gp, wb = *(const LAS f32x4*)(gp + 4);
                            lg[0] += o[i] * wa[0]; lg[1] += o[i] * wa[1]; lg[2] += o[i] * wa[2]; lg[3] += o[i] * wa[3]; lg[4] += o[i] * wb[0]; lg[5] += o[i] * wb[1]; lg[6] += o[i] * wb[2]; lg[7] += o[i] * wb[3]; } }
                s += __shfl_xor(s, 16); s += __shfl_xor(s, 32);
#pragma unroll
                for (int e = 0; e < 8; ++e) { lg[e] += __shfl_xor(lg[e], 16); lg[e] += __shfl_xor(lg[e], 32); }
                if (fq == 0) { ss[(size_t)row * 16 + u.pn * 4 + wc] = s; float* lpp = lp + ((size_t)row * 16 + u.pn * 4 + wc) * 8;
                    *(f32x4*)lpp = (f32x4){lg[0], lg[1], lg[2], lg[3]}; *(f32x4*)(lpp + 4) = (f32x4){lg[4], lg[5], lg[6], lg[7]}; }
                asm volatile("" ::: "memory"); }
          }
        }
    }
};
__device__ __forceinline__ float rstd_from_ss(const float* ss, int row) {
    const f32x4* p = (const f32x4*)(ss + (size_t)row * 16); const f32x4 a = p[0], b = p[1], c = p[2], d = p[3];
    const float t = ((a[0] + a[1]) + (a[2] + a[3])) + ((b[0] + b[1]) + (b[2] + b[3])) + ((c[0] + c[1]) + (c[2] + c[3])) + ((d[0] + d[1]) + (d[2] + d[3]));
    return __builtin_amdgcn_rsqf(t * (1.0f / DM) + EPS);
}
struct EpiSwiglu {
    static constexpr bool PERM = true, AFTER_DRAIN = false;
    bf16_t* O; int ldc; const float* ss; const float* rstd;
    __device__ __forceinline__ void operator()(const f32x4 (&acc)[2][2][4][2], const Unit& u, int wr, int wc, int fr, int fq) const {
        const int row0 = u.pm * BM + wr * 64 + fr, col0 = u.pn * HALF + wc * 32 + 8 * fq;
#pragma unroll
        for (int ai = 0; ai < 2; ++ai) {
            float rs[4];
#pragma unroll
            for (int m = 0; m < 4; ++m) { const int row = row0 + ai * HALF + m * 16; rs[m] = ss ? rstd_from_ss(ss, row) : rstd[row]; }
            asm volatile("" ::: "memory");
#pragma unroll
            for (int m = 0; m < 4; ++m) { const int row = row0 + ai * HALF + m * 16;
                float h[8];
#pragma unroll
                for (int n = 0; n < 2; ++n)
#pragma unroll
                    for (int i = 0; i < 4; ++i) { const float gg = acc[ai][0][m][n][i] * rs[m], uu = acc[ai][1][m][n][i] * rs[m]; h[n * 4 + i] = siluf_(gg) * uu; }
                *(u32x4*)(O + (size_t)row * ldc + col0) = pack8(h); }
        }
    }
};
struct EpiQkv {
    static constexpr bool PERM = true, AFTER_DRAIN = false;
    bf16_t* O; const float* ss; const float* bias; const float* qn; const float* kn; const float* rope;
    __device__ __forceinline__ void operator()(const f32x4 (&acc)[2][2][4][2], const Unit& u, int wr, int wc, int fr, int fq) const {
        const int hd = u.pn * 4 + wc, row0 = u.pm * BM + wr * 64 + fr; const int kind = u.pn < 4 ? 0 : (u.pn == 4 ? 1 : 2);
        const float* nw = kind == 0 ? qn : kn;
        float bv[2][8], nv[2][8];
#pragma unroll
        for (int bj = 0; bj < 2; ++bj)
#pragma unroll
            for (int j = 0; j < 8; ++j) { bv[bj][j] = bias[hd * 64 + bj * 32 + fq * 8 + j]; nv[bj][j] = nw[bj * 32 + fq * 8 + j]; }
#pragma unroll
        for (int ai = 0; ai < 2; ++ai)
#pragma unroll
            for (int m = 0; m < 4; ++m) { const int row = row0 + ai * HALF + m * 16; const float rs = rstd_from_ss(ss, row);
                float v[2][8]; float s = 0.f;
#pragma unroll
                for (int bj = 0; bj < 2; ++bj)
#pragma unroll
                    for (int n = 0; n < 2; ++n)
#pragma unroll
                        for (int i = 0; i < 4; ++i) { const float x = acc[ai][bj][m][n][i] * rs + bv[bj][n * 4 + i]; v[bj][n * 4 + i] = x; s += x * x; }
                if (kind < 2) {
                    s += __shfl_xor(s, 16); s += __shfl_xor(s, 32);
                    const float r2 = __builtin_amdgcn_rsqf(s * (1.0f / 64.0f) + EPS);
#pragma unroll
                    for (int bj = 0; bj < 2; ++bj)
#pragma unroll
                        for (int j = 0; j < 8; ++j) v[bj][j] = v[bj][j] * r2 * nv[bj][j];
                    const f32x4* rp = (const f32x4*)(rope + (size_t)row * 16);
                    const f32x4 c0 = rp[0], c1 = rp[1], s0 = rp[2], s1 = rp[3];
#pragma unroll
                    for (int j = 0; j < 8; ++j) { const float other = __shfl_xor(v[0][j], 16); const float cc = j < 4 ? c0[j] : c1[j - 4], sn = j < 4 ? s0[j] : s1[j - 4];
                        const float mine = v[0][j]; const float rot = (fq == 0) ? (mine * cc - other * sn) : (mine * cc + other * sn);
                        v[0][j] = (fq < 2) ? rot : mine; }
                }
#pragma unroll
                for (int bj = 0; bj < 2; ++bj) *(u32x4*)(O + (size_t)row * 1536 + hd * 64 + bj * 32 + fq * 8) = pack8(v[bj]);
            }
    }
};
}

#define XB_TMO      128
#define XB_XCNT(j)  (256  + 64 * (j))
#define XB_XSUB(j)  (1280 + 64 * (j))
#define XB_XGEN(j)  (2304 + 64 * (j))
#define XB_TOP      3328
#define XB_TOPGEN   3392
#define XCD_BAR_WORDS 3456
#define XB_SPIN_CAP (1u << 20)
__device__ __forceinline__ unsigned xb_ld(unsigned* p)              { return __hip_atomic_load(p, __ATOMIC_RELAXED, __HIP_MEMORY_SCOPE_AGENT); }
__device__ __forceinline__ unsigned xb_add(unsigned* p, unsigned v) { return __hip_atomic_fetch_add(p, v, __ATOMIC_RELAXED, __HIP_MEMORY_SCOPE_AGENT); }
__device__ __forceinline__ unsigned xb_xcc_id() { return (unsigned)__builtin_amdgcn_s_getreg((3 << 11) | 20) & 0xFu; }
#define XB_SPIN(cond, bar) do { unsigned _sp = 0; while (cond) { __builtin_amdgcn_s_sleep(1); \
    if ((++_sp & 255u) == 0u) { if (xb_ld(&(bar)[XB_TMO])) break; if (_sp > XB_SPIN_CAP) { atomicAdd(&(bar)[XB_TMO], 1u); break; } } } } while (0)
struct XcdBarrier { unsigned* bar; unsigned x; volatile LAS unsigned* st; };
__device__ __forceinline__ XcdBarrier xcd_barrier_post(unsigned* bar, volatile LAS unsigned* st) {
    XcdBarrier b; b.bar = bar; b.x = xb_xcc_id(); b.st = st;
    if (threadIdx.x == 0) (void)xb_add(&bar[XB_XCNT(b.x)], 1u);
    return b;
}
__device__ __forceinline__ void xcd_barrier_complete(unsigned* bar, unsigned x, unsigned& nloc, unsigned& nx) {
    const unsigned G = gridDim.x * gridDim.y * gridDim.z;
    unsigned sum, cnt, mine, sp = 0u;
    for (;;) {
        sum = 0u; cnt = 0u; mine = 0u;
#pragma unroll
        for (unsigned j = 0; j < 16; ++j) { const unsigned c = xb_ld(&bar[XB_XCNT(j)]); sum += c; cnt += (c > 0u) ? 1u : 0u; mine = (j == x) ? c : mine; }
        if (sum == G) break;
        __builtin_amdgcn_s_sleep(1);
        if ((++sp & 255u) == 0u) { if (xb_ld(&bar[XB_TMO])) break; if (sp > XB_SPIN_CAP) { atomicAdd(&bar[XB_TMO], 1u); break; } }
    }
    nloc = mine > 0u ? mine : 1u; nx = cnt > 0u ? cnt : 1u;
}
__device__ __forceinline__ void xcd_barrier(const XcdBarrier& b) {
    asm volatile("s_waitcnt vmcnt(0)" ::: "memory");
    __syncthreads();
    if (threadIdx.x == 0) {
        unsigned* bar = b.bar;
        __builtin_amdgcn_s_waitcnt(0);
        unsigned nloc = b.st[0], nx = b.st[1];
        if (nloc == 0u) { xcd_barrier_complete(bar, b.x, nloc, nx); b.st[0] = nloc; b.st[1] = nx; }
        const unsigned old = xb_add(&bar[XB_XSUB(b.x)], 1u);
        const unsigned gen = old / nloc;
        if (old + 1u == (gen + 1u) * nloc) {
            __builtin_amdgcn_fence(__ATOMIC_RELEASE, "agent");
            asm volatile("s_waitcnt vmcnt(0)" ::: "memory");
            const unsigned og = xb_add(&bar[XB_TOP], 1u);
            const unsigned tg = og / nx;
            if (og + 1u == (tg + 1u) * nx) xb_add(&bar[XB_TOPGEN], 1u);
            else XB_SPIN(xb_ld(&bar[XB_TOPGEN]) == tg, bar);
            __builtin_amdgcn_fence(__ATOMIC_ACQUIRE, "agent");
            xb_add(&bar[XB_XGEN(b.x)], 1u);
            asm volatile("s_waitcnt vmcnt(0)" ::: "memory");
        } else {
            XB_SPIN(xb_ld(&bar[XB_XGEN(b.x)]) == gen, bar);
            __builtin_amdgcn_fence(__ATOMIC_ACQUIRE, "agent");
            asm volatile("s_waitcnt vmcnt(0)" ::: "memory");
        }
    }
    __syncthreads();
}

struct Args { const float* in[39]; const int* pos; float* out; unsigned char* ws; int ph_lo, ph_hi, variant, pad; };
enum InIdx { I_X = 0, I_NORM_MIX0 = 1, I_W_IN, I_MU, I_W0, I_WDEC, I_A0, I_WICL, I_WGAT, I_KK, I_KA, I_RK, I_GNW, I_GNB, I_CONVW, I_CONVB, I_DTB, I_ALOG, I_DSKIP, I_SSDN,
             I_WOUT, I_NORM_FFN0, I_FG, I_FU, I_FD, I_NORM_MIX1, I_WQKV, I_BQKV, I_QN, I_KN, I_SINK, I_WO, I_BO, I_NORM_FFN1, I_ROUTER, I_EG, I_EU, I_ED };

__device__ __forceinline__ void transpose_item(const float* W, int ld, int K, int k0, int n0, bf16_t* WT, int drow, LAS float* scr, int lane, const float* gk) {
    f32x4 v[8]; const int kr = lane >> 3, n4 = 4 * (lane & 7); const float* wp = W + (size_t)(k0 + kr) * ld + n0 + n4;
#pragma unroll
    for (int i = 0; i < 8; ++i) v[i] = *(const f32x4*)(wp + (size_t)(8 * i) * ld);
    if (gk) { const float* gp = gk + k0 + kr;
#pragma unroll
        for (int i = 0; i < 8; ++i) v[i] = v[i] * gp[8 * i]; }
#pragma unroll
    for (int i = 0; i < 8; ++i) { LAS float* sp = scr + (8 * i + kr) * 33 + n4; sp[0] = v[i][0]; sp[1] = v[i][1]; sp[2] = v[i][2]; sp[3] = v[i][3]; }
    asm volatile("s_waitcnt lgkmcnt(0)" ::: "memory");
    const int c = lane & 7;
#pragma unroll
    for (int j = 0; j < 4; ++j) { const int n = (lane >> 3) + 8 * j; const LAS float* s = scr + (8 * c) * 33 + n;
        u32x4 o; o.x = pk2(s[0 * 33], s[1 * 33]); o.y = pk2(s[2 * 33], s[3 * 33]); o.z = pk2(s[4 * 33], s[5 * 33]); o.w = pk2(s[6 * 33], s[7 * 33]);
        *(u32x4*)(WT + (size_t)(drow + n) * K + k0 + 8 * c) = o; }
    asm volatile("s_waitcnt lgkmcnt(0)" ::: "memory");
}
__device__ __forceinline__ int drow_of(int kind, int n0) {
    if (kind == 0) return n0;
    if (kind == 1) return 256 * (n0 >> 7) + (n0 & 127);
    if (kind == 2) return 256 * (n0 >> 7) + 128 + (n0 & 127);
    const int hd = n0 >> 6, bj = (n0 >> 5) & 1; return 256 * (hd >> 2) + 128 * bj + 32 * (hd & 3);
}
__device__ __forceinline__ bool transpose_matrix(int& it, const float* W, int ld, int K, int ncols, bf16_t* WT, int kind, LAS float* scr, int lane, const float* gk = nullptr) {
    const int nnb = ncols / 32, items = (K / 64) * nnb;
    if (it < items) { const int kb = it / nnb, nb = it % nnb; transpose_item(W, ld, K, 64 * kb, 32 * nb, WT, drow_of(kind, 32 * nb), scr, lane, gk); return true; }
    it -= items; return false;
}

__device__ __forceinline__ u32x4 conv8(const bf16_t* proj, size_t m, int tpos, int c, const float* cw, const float* cb) {
    const bf16_t* p = proj + m * NPROJ + 2304 + c; u32x4 raw[4];
#pragma unroll
    for (int k = 0; k < 4; ++k) raw[k] = *(const u32x4*)(p - (size_t)(tpos >= k ? k : 0) * NPROJ);
    float acc[8];
    { const f32x4 b0 = *(const f32x4*)(cb + c), b1 = *(const f32x4*)(cb + c + 4); acc[0] = b0[0]; acc[1] = b0[1]; acc[2] = b0[2]; acc[3] = b0[3]; acc[4] = b1[0]; acc[5] = b1[1]; acc[6] = b1[2]; acc[7] = b1[3]; }
#pragma unroll
    for (int k = 0; k < 4; ++k) { float x[8]; unpack8(raw[k], x); const float ok = tpos >= k ? 1.f : 0.f; const f32x4 w0 = *(const f32x4*)(cw + (3 - k) * 1024 + c), w1 = *(const f32x4*)(cw + (3 - k) * 1024 + c + 4);
        acc[0] += ok * w0[0] * x[0]; acc[1] += ok * w0[1] * x[1]; acc[2] += ok * w0[2] * x[2]; acc[3] += ok * w0[3] * x[3]; acc[4] += ok * w1[0] * x[4]; acc[5] += ok * w1[1] * x[5]; acc[6] += ok * w1[2] * x[6]; acc[7] += ok * w1[3] * x[7]; }
#pragma unroll
    for (int i = 0; i < 8; ++i) acc[i] = siluf_(acc[i]);
    return pack8(acc);
}
__device__ __forceinline__ u32x2 conv4(const bf16_t* proj, size_t m, int tpos, int c, const float* cw, const float* cb) {
    const bf16_t* p = proj + m * NPROJ + 2304 + c; u32x2 raw[4];
#pragma unroll
    for (int k = 0; k < 4; ++k) raw[k] = *(const u32x2*)(p - (size_t)(tpos >= k ? k : 0) * NPROJ);
    f32x4 acc = *(const f32x4*)(cb + c);
#pragma unroll
    for (int k = 0; k < 4; ++k) { const float ok = tpos >= k ? 1.f : 0.f; const f32x4 w0 = *(const f32x4*)(cw + (3 - k) * 1024 + c);
        acc[0] += ok * w0[0] * bflo(raw[k].x); acc[1] += ok * w0[1] * bfhi(raw[k].x); acc[2] += ok * w0[2] * bflo(raw[k].y); acc[3] += ok * w0[3] * bfhi(raw[k].y); }
    u32x2 o; o.x = pk2(siluf_(acc[0]), siluf_(acc[1])); o.y = pk2(siluf_(acc[2]), siluf_(acc[3])); return o;
}

#ifndef DUPM
#define DUPM 0u
#endif

#define XN ((bf16_t*)(ws + WS_XN))
#define MIX ((bf16_t*)(ws + WS_MIX))
#define PROJ ((bf16_t*)(ws + WS_PROJ))
#define GOUT ((bf16_t*)(ws + WS_GOUT))
#define XNB ((bf16_t*)(ws + WS_XNB))
#define HID ((bf16_t*)(ws + WS_HID))
#define QKV ((bf16_t*)(ws + WS_QKV))
#define ATTO ((bf16_t*)(ws + WS_ATTO))
#define AS ((bf16_t*)(ws + WS_AS))
#define HS ((bf16_t*)(ws + WS_HS))
#define SSTATE ((bf16_t*)(ws + 54 * MiB))
#define CHDEC ((float*)(ws + WS_TOPE))
#define DTSP ((float*)(ws + WS_DTSP))
#define KKR ((float*)(ws + WS_KKR))
#define ROPE ((float*)(ws + WS_ROPE))
#define SS ((float*)(ws + WS_SS))
#define TOPE ((int*)(ws + WS_TOPE))
#define RANK ((int*)(ws + WS_RANK))
#define TOPW ((float*)(ws + WS_TOPW))
#define POS ((int*)(ws + WS_POS))
#define RSTD4 ((float*)(ws + WS_RSTD4))
#define RSTDS ((float*)(ws + WS_RSTDS))
#define WDEC ((bf16_t*)(ws + WS_WDEC))
#define WICL ((bf16_t*)(ws + WS_WICL))
#define WGAT ((bf16_t*)(ws + WS_WGAT))
#define EGU ((bf16_t*)(ws + WS_EGU))
#define EDN ((bf16_t*)(ws + WS_EDN))
#define WIN ((bf16_t*)(ws + WS_WIN))
#define WOUT ((bf16_t*)(ws + WS_WOUT))
#define WGU ((bf16_t*)(ws + WS_WGU))
#define WDN ((bf16_t*)(ws + WS_WDN))
#define WQKV ((bf16_t*)(ws + WS_WQKV))
#define WO ((bf16_t*)(ws + WS_WO))
struct TDesc { const float* src; bf16_t* dst; const float* gk; int ld, K; };
__device__ __forceinline__ void tdesc(TDesc& d, int it, const float* W, int ld, int K, int ncols, bf16_t* WT, int kind, const float* gk) {
    const int nnb = ncols / 32, kb = it / nnb, nb = it % nnb;
    d.src = W + (size_t)(64 * kb) * ld + 32 * nb; d.dst = WT + (size_t)drow_of(kind, 32 * nb) * K + 64 * kb; d.gk = gk ? gk + 64 * kb : nullptr; d.ld = ld; d.K = K;
}
constexpr int CV_P0 = 1728, CV_NE = CV_P0 + 6016, CV_EGU = CV_NE + 16 * 704, CV_END = CV_EGU + 8 * 704;
__device__ __forceinline__ void conv_resolve(const float* const* in, unsigned char* ws, int id, TDesc& d) {
    if (id < 1664) { tdesc(d, id, in[I_W_IN], IN0, DM, NPROJ, (bf16_t*)(ws + WS_WIN), 0, nullptr); return; } id -= 1664;
    if (id < 16) { tdesc(d, id, in[I_WDEC], 512, 64, 512, (bf16_t*)(ws + WS_WDEC), 0, nullptr); return; } id -= 16;
    if (id < 16) { tdesc(d, id, in[I_WICL], 512, 64, 512, (bf16_t*)(ws + WS_WICL), 0, nullptr); return; } id -= 16;
    if (id < 32) { tdesc(d, id, in[I_WGAT], 512, 128, 512, (bf16_t*)(ws + WS_WGAT), 0, nullptr); return; } id -= 32;
    if (id < 512) { tdesc(d, id, in[I_WOUT], DM, DM, DM, (bf16_t*)(ws + WS_WOUT), 0, nullptr); return; } id -= 512;
    if (id < 1408) { tdesc(d, id, in[I_FG], FFN, DM, FFN, (bf16_t*)(ws + WS_WGU), 1, in[I_NORM_FFN0]); return; } id -= 1408;
    if (id < 1408) { tdesc(d, id, in[I_FU], FFN, DM, FFN, (bf16_t*)(ws + WS_WGU), 2, in[I_NORM_FFN0]); return; } id -= 1408;
    if (id < 1408) { tdesc(d, id, in[I_FD], DM, FFN, DM, (bf16_t*)(ws + WS_WDN), 0, nullptr); return; } id -= 1408;
    if (id < 768) { tdesc(d, id, in[I_WQKV], 1536, DM, 1536, (bf16_t*)(ws + WS_WQKV), 3, in[I_NORM_MIX1]); return; } id -= 768;
    if (id < 512) { tdesc(d, id, in[I_WO], DM, DM, DM, (bf16_t*)(ws + WS_WO), 0, nullptr); return; } id -= 512;
    if (id < 16 * 704) { const int e = id / 1408, r = id % 1408, up = r / 704;
        tdesc(d, r % 704, in[up ? I_EU : I_EG] + (size_t)e * DM * FE, FE, DM, FE, (bf16_t*)(ws + WS_EGU) + (size_t)e * 2 * FE * DM, 1 + up, in[I_NORM_FFN1]); return; } id -= 16 * 704;
    { const int e = id / 704; tdesc(d, id % 704, in[I_ED] + (size_t)e * FE * DM, DM, FE, DM, (bf16_t*)(ws + WS_EDN) + (size_t)e * DM * FE, 0, nullptr); }
}
__device__ __forceinline__ void conv_load(const TDesc& d, f32x4 (&v)[8], int lane) {
    const float* wp = d.src + (size_t)(lane >> 3) * d.ld + 4 * (lane & 7);
#pragma unroll
    for (int i = 0; i < 8; ++i) v[i] = *(const f32x4*)(wp + (size_t)(8 * i) * d.ld);
}
__device__ __forceinline__ void conv_finish(const TDesc& d, f32x4 (&v)[8], LAS float* scr, int lane) {
    const int kr = lane >> 3, n4 = 4 * (lane & 7);
    if (d.gk) {
#pragma unroll
        for (int i = 0; i < 8; ++i) v[i] = v[i] * d.gk[kr + 8 * i]; }
#pragma unroll
    for (int i = 0; i < 8; ++i) { LAS float* sp = scr + (8 * i + kr) * 33 + n4; sp[0] = v[i][0]; sp[1] = v[i][1]; sp[2] = v[i][2]; sp[3] = v[i][3]; }
    asm volatile("s_waitcnt lgkmcnt(0)" ::: "memory");
    const int c = lane & 7;
#pragma unroll
    for (int j = 0; j < 4; ++j) { const int n = (lane >> 3) + 8 * j; const LAS float* s = scr + (8 * c) * 33 + n;
        u32x4 o; o.x = pk2(s[0 * 33], s[1 * 33]); o.y = pk2(s[2 * 33], s[3 * 33]); o.z = pk2(s[4 * 33], s[5 * 33]); o.w = pk2(s[6 * 33], s[7 * 33]);
        *(u32x4*)(d.dst + (size_t)n * d.K + 8 * c) = o; }
    asm volatile("s_waitcnt lgkmcnt(0)" ::: "memory");
}
__device__ __forceinline__ void conv_range(const float* const* in, unsigned char* ws, int lo, int hi, int first, int stride, LAS float* scr, int lane) {
    int id = lo + first; if (id >= hi) return;
    TDesc cur; conv_resolve(in, ws, id, cur); f32x4 v[8]; conv_load(cur, v, lane);
    for (;;) {
        const int idn = id + stride; const bool hn = idn < hi; TDesc nx = cur; f32x4 w[8];
        if (hn) { conv_resolve(in, ws, idn, nx); conv_load(nx, w, lane); }
        conv_finish(cur, v, scr, lane);
        if (!hn) break;
        cur = nx; id = idn;
#pragma unroll
        for (int i = 0; i < 8; ++i) v[i] = w[i];
    }
}

__global__ void __launch_bounds__(512, 2) fwd_kernel(Args args) {
    extern __shared__ __attribute__((aligned(16))) unsigned char lds_raw[];
    LAS unsigned char* lds = (LAS unsigned char*)lds_raw;
    volatile LAS unsigned* MISC = (volatile LAS unsigned*)(lds + MISC_OFF);
    const int tid = threadIdx.x, lane = tid & 63, wave = __builtin_amdgcn_readfirstlane(tid >> 6);
    const int G = gridDim.x, bx = blockIdx.x;
    const int vcu = (G % 8 == 0) ? (bx % 8) * (G / 8) + bx / 8 : bx;
    unsigned char* ws = args.ws;
    unsigned* ctl = (unsigned*)(ws + WS_CTL);
    float* dout = args.out;
    if (tid < 32) ((LAS unsigned*)(lds + MISC_OFF))[tid] = 0u;
    __syncthreads();
    XcdBarrier bar = xcd_barrier_post(ctl + CW_BAR, MISC + 8);
    const int lo = args.ph_lo, hi = args.ph_hi;
#define IN(k) (lo <= (k) && (k) < hi)
#if DUPM
#define PHASE(k) for (int rep_ = 0; rep_ <= (int)((DUPM >> (k)) & 1u); ++rep_) if (IN(k))
#define REPBAR if (rep_) xcd_barrier(bar);
#else
#define PHASE(k) if (IN(k))
#define REPBAR
#endif
#define SEAM(k) do { if (IN(k) && IN((k) + 1)) xcd_barrier(bar); } while (0)
    const int gw = vcu * 8 + wave, NGW = G * 8;

    unsigned* CNT = ctl + CW_CNT;

    PHASE(0) { REPBAR
        conv_range(args.in, ws, 0, CV_P0, gw, NGW, (LAS float*)(lds + wave * 16384), lane);
        __syncthreads();
        LAS float* w8 = (LAS float*)lds;
        for (int r = tid; r < DM; r += 512) { const float* p = args.in[I_W_IN] + (size_t)r * IN0 + NPROJ; *(LAS f32x4*)(w8 + r * 8) = *(const f32x4*)p; *(LAS f32x4*)(w8 + r * 8 + 4) = *(const f32x4*)(p + 4); }
        __syncthreads();
        const float* gm = args.in[I_NORM_MIX0];
#pragma unroll 1
        for (int k0 = 0; k0 < MTOK / NGW; k0 += 4) {
          f32x4 vv[4][4];
#pragma unroll
          for (int q = 0; q < 4; ++q) { const f32x4* xr = (const f32x4*)(args.in[I_X] + (size_t)(gw + (k0 + q) * NGW) * DM) + lane;
#pragma unroll
              for (int j = 0; j < 4; ++j) vv[q][j] = xr[64 * j]; }
#pragma unroll
          for (int q = 0; q < 4; ++q) { const int m = gw + (k0 + q) * NGW;
            f32x4 v[4]; float s = 0.f;
#pragma unroll
            for (int j = 0; j < 4; ++j) { v[j] = vv[q][j]; s += (v[j][0] * v[j][0] + v[j][1] * v[j][1]) + (v[j][2] * v[j][2] + v[j][3] * v[j][3]); }
            const float rstd = __builtin_amdgcn_rsqf(wave_sum(s) * (1.0f / DM) + EPS);
            float d[8];
#pragma unroll
            for (int k = 0; k < 8; ++k) d[k] = 0.f;
            unsigned long long* o8 = (unsigned long long*)(XN + (size_t)m * DM) + lane;
#pragma unroll
            for (int j = 0; j < 4; ++j) { const f32x4 g4 = ((const f32x4*)gm)[64 * j + lane]; const f32x4 y = v[j] * rstd * g4;
                o8[64 * j] = (unsigned long long)pk2(y[0], y[1]) | ((unsigned long long)pk2(y[2], y[3]) << 32);
#pragma unroll
                for (int i = 0; i < 4; ++i) { const int c = 256 * j + 4 * lane + i; const f32x4 wa = *(const LAS f32x4*)(w8 + c * 8), wb = *(const LAS f32x4*)(w8 + c * 8 + 4);
                    d[0] += y[i] * wa[0]; d[1] += y[i] * wa[1]; d[2] += y[i] * wa[2]; d[3] += y[i] * wa[3]; d[4] += y[i] * wb[0]; d[5] += y[i] * wb[1]; d[6] += y[i] * wb[2]; d[7] += y[i] * wb[3]; } }
            wave_sum8(d);
            if (lane < 8) { float dv = d[0];
#pragma unroll
                for (int k = 1; k < 8; ++k) dv = (lane == k) ? d[k] : dv;
                const float z = dv + args.in[I_DTB][lane]; DTSP[(size_t)m * 8 + lane] = z > 20.f ? z : log1pf(__expf(z)); }
            if (lane >= 16 && lane < 24) { const int j = lane - 16; const float inv = expf(-(float)j * (0.125f * 13.122363377404328f)); const float ang = (float)args.pos[m] * inv;
                float sn, cs; sincosf(ang, &sn, &cs); ROPE[(size_t)m * 16 + j] = cs; ROPE[(size_t)m * 16 + 8 + j] = sn; }
          }
        }
        __syncthreads();
    }
    SEAM(0);

    PHASE(1) { REPBAR
        pg8::Gemm g{XN, WIN, MTOK, NPROJ, DM}; pg8::StaticOrder S; S.init(MTOK, NPROJ, G, bx);
        pg8::EpiBf16 E{PROJ, NPROJ};
        pg8::gemm_phase(lds, g, S, E);
        if (bx >= 64) {
            conv_range(args.in, ws, CV_P0, CV_NE + 8 * 704, (bx - 64) * 8 + wave, 192 * 8, (LAS float*)(lds + wave * 16384), lane);
        }
    }
    SEAM(1);

#define LANE_CONSTS const int r32 = lane & 31, hh = lane >> 5, trq = (lane & 15) >> 2, trc = 16 * ((lane >> 4) & 1) + 4 * (lane & 3)
#define TRF(M, P, s, blk) ({ const LAS bf16_t* p_ = (M) + (16 * (s) + 8 * hh + trq) * (P) + 32 * (blk) + trc; \
        const s16x4 lo_ = __builtin_bit_cast(s16x4, __builtin_amdgcn_ds_read_tr16_b64_v4i16((LAS s16x4*)p_)); \
        const s16x4 hi_ = __builtin_bit_cast(s16x4, __builtin_amdgcn_ds_read_tr16_b64_v4i16((LAS s16x4*)(p_ + 4 * (P)))); \
        (bf16x8){lo_[0], lo_[1], lo_[2], lo_[3], hi_[0], hi_[1], hi_[2], hi_[3]}; })
#define NATF(M, P, s, blk) (*(const LAS bf16x8*)((M) + (32 * (blk) + r32) * (P) + 16 * (s) + 8 * hh))
    PHASE(2) { REPBAR
        LANE_CONSTS;
        const float* mu = args.in[I_MU];
        LAS bf16_t* Aw = (LAS bf16_t*)lds; LAS bf16_t* Aa = (LAS bf16_t*)(lds + 9216); LAS bf16_t* Ag = (LAS bf16_t*)(lds + 18432);
        LAS float* LW = (LAS float*)(lds + 35840); LAS float* IC = LW + 4096;
        LAS bf16_t* At = (LAS bf16_t*)(lds + 68864); LAS bf16_t* Kt = At + 4608; LAS bf16_t* Bt = Kt + 4608; LAS bf16_t* Rt = Bt + 4608; LAS bf16_t* Vt = Rt + 4608;
        LAS bf16_t* Lab = (LAS bf16_t*)(lds + 35840);
        LAS bf16_t* XX = At;
        LAS bf16_t* Lak = (LAS bf16_t*)(lds + 114944); LAS bf16_t* Mrk = Lak + 4608; LAS bf16_t* Mrb = Mrk + 4608;
        LAS float* TOT = (LAS float*)(lds + 142592); LAS float* GAMC = TOT + 512;
        const int mt = (wave >> 1) & 1, nt = wave & 1, grp = wave >> 2;
        for (int unit = vcu; unit < MTOK / 64; unit += G) {
            const int m0 = unit * 64;
            {
                const int tt = tid >> 3, cg = tid & 7, m = m0 + tt; const bool hasprev = (m & (SEQ - 1)) != 0;
                const bf16_t* pc = PROJ + (size_t)m * NPROJ + 1536 + 32 * cg;
#pragma unroll 1
                for (int q = 0; q < 4; ++q) {
                    float c[8], p[8]; unpack8(*(const u32x4*)(pc + 8 * q), c);
                    if (hasprev) unpack8(*(const u32x4*)(pc - NPROJ + 8 * q), p); else { for (int i = 0; i < 8; ++i) p[i] = 0.f; }
                    float o[8];
#pragma unroll
                    for (int i = 0; i < 8; ++i) { const int col = 32 * cg + 8 * q + i; const float x = c[i] + (p[i] - c[i]) * mu[1536 + col];
                        o[i] = cg < 2 ? tanhf(x) : (cg < 4 ? x : sigmoidf_(x)); }
                    const u32x4 w = pack8(o); const int col0 = 32 * cg + 8 * q;
                    if (cg < 2) *(LAS u32x4*)(Aw + tt * 72 + col0) = w; else if (cg < 4) *(LAS u32x4*)(Aa + tt * 72 + (col0 - 64)) = w; else *(LAS u32x4*)(Ag + tt * 136 + (col0 - 128)) = w;
                }
            }
            LBAR();
#pragma unroll 1
            for (int h = 0; h < 8; ++h) {
                unsigned char* cs = (unsigned char*)dout + (size_t)(unit * 8 + h) * 24576;
                float r0v[8], k0v[8], v0v[8]; float pr = 0.f, pk = 0.f, pv = 0.f;
                {   const bf16_t* pp = PROJ + (size_t)(m0 + 8 * wave) * NPROJ + 64 * h + lane;
                    if (((m0 + 8 * wave) & (SEQ - 1)) != 0) { pr = bflo(pp[-NPROJ]); pk = bflo(pp[-NPROJ + 512]); pv = bflo(pp[-NPROJ + 1024]); }
#pragma unroll
                    for (int i = 0; i < 8; ++i) { r0v[i] = bflo(pp[(size_t)i * NPROJ]); k0v[i] = bflo(pp[(size_t)i * NPROJ + 512]); v0v[i] = bflo(pp[(size_t)i * NPROJ + 1024]); } }
                if (grp == 0) {
                    f32x16 ad, ai;
#pragma unroll
                    for (int r = 0; r < 16; ++r) { ad[r] = 0.f; ai[r] = 0.f; }
#pragma unroll
                    for (int s = 0; s < 4; ++s) {
                        const bf16x8 bd = *(const bf16x8*)(WDEC + (size_t)(64 * h + 32 * nt + r32) * 64 + 16 * s + 8 * hh), bi = *(const bf16x8*)(WICL + (size_t)(64 * h + 32 * nt + r32) * 64 + 16 * s + 8 * hh);
                        ad = __builtin_amdgcn_mfma_f32_32x32x16_bf16(NATF(Aw, 72, s, mt), bd, ad, 0, 0, 0);
                        ai = __builtin_amdgcn_mfma_f32_32x32x16_bf16(NATF(Aa, 72, s, mt), bi, ai, 0, 0, 0);
                    }
                    const int c = 32 * nt + r32; const float w0c = args.in[I_W0][64 * h + c], a0c = args.in[I_A0][64 * h + c];
                    LAS float* lwb = LW + (32 * mt + 4 * hh) * 64 + c;
#pragma unroll
                    for (int r = 0; r < 16; ++r) { lwb[crc(r) * 64] = -0.6065306597126334f * sigmoidf_(ad[r] + w0c); lwb[4096 + crc(r) * 64] = sigmoidf_(ai[r] + a0c); }
                } else {
                    f32x16 ag;
#pragma unroll
                    for (int r = 0; r < 16; ++r) ag[r] = 0.f;
#pragma unroll
                    for (int s = 0; s < 8; ++s) {
                        const bf16x8 bg = *(const bf16x8*)(WGAT + (size_t)(64 * h + 32 * nt + r32) * 128 + 16 * s + 8 * hh);
                        ag = __builtin_amdgcn_mfma_f32_32x32x16_bf16(NATF(Ag, 136, s, mt), bg, ag, 0, 0, 0);
                    }
                    bf16_t* gob = GOUT + (size_t)(m0 + 32 * mt + 4 * hh) * 512 + 64 * h + 32 * nt + r32;
#pragma unroll
                    for (int r = 0; r < 16; ++r) gob[crc(r) * 512] = (bf16_t)f2bf(ag[r]);
                }
                LBAR();
                {
                    const int c = lane, gc = 64 * h + c, t0 = 8 * wave;
                    const float mur = mu[gc], muk = mu[512 + gc], muv = mu[1024 + gc], kkc = args.in[I_KK][gc], kac = args.in[I_KA][gc], rkc = args.in[I_RK][gc];
                    float rr[8], kx[8], vv[8], an[8], bn[8], lw[8], cl[8]; float run = 0.f;
#pragma unroll
                    for (int i = 0; i < 8; ++i) {
                        const float r0 = r0v[i], k0 = k0v[i], v0 = v0v[i];
                        rr[i] = r0 + (pr - r0) * mur; const float kl = k0 + (pk - k0) * muk; vv[i] = v0 + (pv - v0) * muv; pr = r0; pk = k0; pv = v0;
                        const float ic = IC[(t0 + i) * 64 + c]; lw[i] = LW[(t0 + i) * 64 + c]; run += lw[i]; cl[i] = run;
                        const float xk = kl * kkc; const float ssq = dpp_sum63(xk * xk); const float kn = xk * __builtin_amdgcn_rsqf(ssq + 1e-12f);
                        an[i] = -kn; bn[i] = kn * ic; kx[i] = kl * (1.0f + (ic - 1.0f) * kac);
                        const float bon = dpp_sum63(rr[i] * kx[i] * rkc);
                        if (lane == 0) KKR[(size_t)(m0 + t0 + i) * 8 + h] = bon;
                    }
                    TOT[wave * 64 + c] = run;
                    LBAR();
                    float off = 0.f, totc = 0.f;
#pragma unroll
                    for (int w2 = 0; w2 < 8; ++w2) { const float tv = TOT[w2 * 64 + c]; totc += tv; off += (w2 < wave) ? tv : 0.f; }
                    if (wave == 0) GAMC[c] = __expf(totc);
#pragma unroll
                    for (int i = 0; i < 8; ++i) { const float cum = off + cl[i]; const float en = __expf(-cum), ep = __expf(cum), em = __expf(cum - lw[i]); const int o = (t0 + i) * 72 + c;
                        At[o] = (bf16_t)f2bf(an[i] * em); Kt[o] = (bf16_t)f2bf(kx[i] * en); Bt[o] = (bf16_t)f2bf(bn[i] * en); Rt[o] = (bf16_t)f2bf(rr[i] * ep); Vt[o] = (bf16_t)f2bf(vv[i]); }
                }
                LBAR();
                {
                    f32x16 pb, pk2_;
#pragma unroll
                    for (int r = 0; r < 16; ++r) { pb[r] = 0.f; pk2_[r] = 0.f; }
                    const LAS bf16_t* Aop = grp == 0 ? At : Rt;
#pragma unroll
                    for (int s = 0; s < 4; ++s) { const bf16x8 a = NATF(Aop, 72, s, mt);
                        pb = __builtin_amdgcn_mfma_f32_32x32x16_bf16(a, NATF(Bt, 72, s, nt), pb, 0, 0, 0);
                        pk2_ = __builtin_amdgcn_mfma_f32_32x32x16_bf16(a, NATF(Kt, 72, s, nt), pk2_, 0, 0, 0); }
                    const int sc = 32 * nt + r32, tb = 32 * mt + 4 * hh;
                    LAS bf16_t* o1 = (grp == 0 ? Lab : Mrb) + tb * 72 + sc; LAS bf16_t* o2 = (grp == 0 ? Lak : Mrk) + tb * 72 + sc;
#pragma unroll
                    for (int r = 0; r < 16; ++r) { const int t = tb + crc(r); const bool keep = grp == 0 ? (sc < t) : (sc <= t);
                        o1[crc(r) * 72] = (bf16_t)f2bf(keep ? pb[r] : 0.f); o2[crc(r) * 72] = (bf16_t)f2bf(keep ? pk2_[r] : 0.f); }
                }
                LBAR();
                f32x16 accA, accB;
#pragma unroll
                for (int r = 0; r < 16; ++r) { accA[r] = 0.f; accB[r] = 0.f; }
                {
                    const LAS bf16_t* Aop = grp == 0 ? Lak : Mrk;
#pragma unroll
                    for (int s = 0; s < 4; ++s) { const bf16x8 vb = TRF(Vt, 72, s, nt);
                        if (grp == 0) { accA = __builtin_amdgcn_mfma_f32_32x32x16_bf16(NATF(Aop, 72, s, mt), vb, accA, 0, 0, 0); accB = __builtin_amdgcn_mfma_f32_32x32x16_bf16(TRF(Kt, 72, s, mt), vb, accB, 0, 0, 0); }
                        else accB = __builtin_amdgcn_mfma_f32_32x32x16_bf16(NATF(Aop, 72, s, mt), vb, accB, 0, 0, 0); }
                    if (grp == 0) { LAS float* ggb = IC + (32 * mt + 4 * hh) * 65 + 32 * nt + r32;
#pragma unroll
                        for (int r = 0; r < 16; ++r) ggb[crc(r) * 65] = accA[r]; }
                }
                LBAR();
                {
                    const int n16 = lane & 15, g4 = lane >> 4;
                    f32x4 Rr[4];
                    if (wave < 4) {
#pragma unroll
                        for (int I = 0; I < 4; ++I)
#pragma unroll
                            for (int j = 0; j < 4; ++j) Rr[I][j] = bflo((unsigned)At[(16 * I + 4 * g4 + j) * 72 + 16 * wave + n16]);
                    } else { const LAS float* GG = IC;
#pragma unroll
                        for (int I = 0; I < 4; ++I)
#pragma unroll
                            for (int j = 0; j < 4; ++j) Rr[I][j] = GG[(16 * I + 4 * g4 + j) * 65 + 16 * (wave - 4) + n16];
                    }
                    LBAR();
                    const LAS bf16_t* lrow = Lab + n16 * 72 + 4 * g4;
#define LF(I, J) (*(const LAS u32x2*)(lrow + (16 * (I)) * 72 + 16 * (J)))
#define MF16(A0, A1, B0, B1, C) __builtin_amdgcn_mfma_f32_16x16x32_bf16(__builtin_bit_cast(bf16x8, (u32x4){(A0).x, (A0).y, (A1).x, (A1).y}), __builtin_bit_cast(bf16x8, (u32x4){(B0).x, (B0).y, (B1).x, (B1).y}), (C), 0, 0, 0)
                    const u32x2 zz = (u32x2){0u, 0u};
                    u32x2 Xb[4];
#pragma unroll
                    for (int I = 0; I < 4; ++I) {
                        f32x4 Z = Rr[I];
                        if (I == 1) Z = MF16(LF(1, 0), zz, Xb[0], zz, Z);
                        if (I == 2) Z = MF16(LF(2, 0), LF(2, 1), Xb[0], Xb[1], Z);
                        if (I == 3) { Z = MF16(LF(3, 0), LF(3, 1), Xb[0], Xb[1], Z); Z = MF16(LF(3, 2), zz, Xb[2], zz, Z); }
                        const u32x2 ld = LF(I, I);
                        f32x4 X = Z;
#pragma unroll
                        for (int it = 0; it < 15; ++it) { u32x2 xb; xb.x = pk2(X[0], X[1]); xb.y = pk2(X[2], X[3]); X = MF16(ld, zz, xb, zz, Z); }
                        Xb[I].x = pk2(X[0], X[1]); Xb[I].y = pk2(X[2], X[3]);
                        LAS bf16_t* xo = XX + (16 * I + 4 * g4) * 136 + 16 * wave + n16;
                        xo[0] = (bf16_t)(Xb[I].x & 0xffffu); xo[136] = (bf16_t)(Xb[I].x >> 16); xo[272] = (bf16_t)(Xb[I].y & 0xffffu); xo[408] = (bf16_t)(Xb[I].y >> 16);
                    }
#undef LF
#undef MF16
                }
                LBAR();
                {
                    f32x16 acc1;
#pragma unroll
                    for (int r = 0; r < 16; ++r) acc1[r] = 0.f;
#pragma unroll
                    for (int s = 0; s < 4; ++s) {
                        const bf16x8 a = grp == 0 ? TRF(Bt, 72, s, mt) : NATF(Mrb, 72, s, mt);
                        acc1 = __builtin_amdgcn_mfma_f32_32x32x16_bf16(a, TRF(XX, 136, s, nt), acc1, 0, 0, 0);
                        accB = __builtin_amdgcn_mfma_f32_32x32x16_bf16(a, TRF(XX + 64, 136, s, nt), accB, 0, 0, 0);
                    }
                    const int col = 32 * nt + r32, rb = 32 * mt + 4 * hh;
                    if (grp == 0) {
                        bf16_t* acb = (bf16_t*)cs + rb * 64 + col; bf16_t* dcb = (bf16_t*)(cs + 8192) + col * 64 + rb; const LAS float* gb = GAMC + rb;
#pragma unroll
                        for (int r = 0; r < 16; ++r) { const float gcv = gb[crc(r)]; acb[crc(r) * 64] = (bf16_t)f2bf(gcv * (acc1[r] + ((rb + crc(r)) == col ? 1.0f : 0.0f))); }
#pragma unroll
                        for (int rq = 0; rq < 4; ++rq) { const f32x4 g4 = *(const LAS f32x4*)(gb + 8 * rq);
                            u32x2 w; w.x = pk2(accB[4 * rq] * g4[0], accB[4 * rq + 1] * g4[1]); w.y = pk2(accB[4 * rq + 2] * g4[2], accB[4 * rq + 3] * g4[3]); *(u32x2*)(dcb + 8 * rq) = w; }
                    } else {
                        bf16_t* rpb = (bf16_t*)(cs + 16384) + rb * 64 + col; const LAS bf16_t* rtb = Rt + rb * 72 + col; bf16_t* yb = MIX + (size_t)(m0 + rb) * DM + 64 * h + col;
#pragma unroll
                        for (int r = 0; r < 16; ++r) { rpb[crc(r) * 64] = (bf16_t)f2bf(acc1[r] + bflo((unsigned)rtb[crc(r) * 72])); yb[crc(r) * DM] = (bf16_t)f2bf(accB[r]); }
                    }
                }
                LBAR();
            }
        }
    }

    SEAM(2);

    PHASE(3) { REPBAR
        LANE_CONSTS;
        if (vcu < 32) {
            const int b = vcu >> 3, h = vcu & 7;
            const unsigned char* cbase = (const unsigned char*)dout + (size_t)(b * 64 * 8 + h) * 24576;
            constexpr size_t CSTR = (size_t)8 * 24576; constexpr int SLOT = 27648;
            const bool loader = wave >= 2; const int lt = tid - 128;
            int poff[4];
#pragma unroll
            for (int k = 0; k < 4; ++k) { const int p = lt + 384 * k; poff[k] = (p >> 9) * 9216 + ((p & 511) >> 3) * 144 + (p & 7) * 16; }
            u32x4 st[4][4];
#define RB_ISSUE(set, ch) do { if (loader) { const unsigned char* g_ = cbase + (size_t)(ch) * CSTR + (size_t)lt * 16; _Pragma("unroll") for (int k = 0; k < 4; ++k) st[set][k] = *(const u32x4*)(g_ + k * 6144); } } while (0)
#define RB_WRITE(set, ch) do { if (loader) { LAS unsigned char* s_ = lds + ((ch) & 3) * SLOT; _Pragma("unroll") for (int k = 0; k < 4; ++k) *(LAS u32x4*)(s_ + poff[k]) = st[set][k]; } } while (0)
            RB_ISSUE(0, 0); RB_ISSUE(1, 1); RB_WRITE(0, 0); RB_WRITE(1, 1);
            RB_ISSUE(2, 2); RB_ISSUE(3, 3); RB_ISSUE(0, 4); RB_ISSUE(1, 5);
            LBAR();
            f32x16 H[2];
#pragma unroll
            for (int r = 0; r < 16; ++r) { H[0][r] = 0.f; H[1][r] = 0.f; }
            bf16_t* zp = (bf16_t*)((unsigned char*)dout + 48 * MiB) + (size_t)(b * SEQ + 4 * hh) * 512 + 64 * h + 32 * wave + r32;
#define RB_STEP(j, chv) do { const int ch_ = (chv); \
                if (loader) { if (ch_ + 2 < 64) RB_WRITE(((j) + 2) & 3, ch_ + 2); if (ch_ + 6 < 64) RB_ISSUE(((j) + 2) & 3, ch_ + 6); } \
                else { const LAS unsigned char* sl = lds + (ch_ & 3) * SLOT; f32x16 Hn[2], Z[2]; bf16x8 Hb[4]; \
                    _Pragma("unroll") for (int s = 0; s < 4; ++s) { const int m = s >> 1, o = 8 * (s & 1); u32x4 t; t.x = pk2(H[m][o], H[m][o + 1]); t.y = pk2(H[m][o + 2], H[m][o + 3]); t.z = pk2(H[m][o + 4], H[m][o + 5]); t.w = pk2(H[m][o + 6], H[m][o + 7]); Hb[s] = __builtin_bit_cast(bf16x8, t); } \
                    _Pragma("unroll") for (int m = 0; m < 2; ++m) { \
                        _Pragma("unroll") for (int rq = 0; rq < 4; ++rq) { const u32x2 d = *(const LAS u32x2*)(sl + 9216 + (32 * wave + r32) * 144 + (32 * m + 8 * rq + 4 * hh) * 2); \
                            Hn[m][4 * rq] = bflo(d.x); Hn[m][4 * rq + 1] = bfhi(d.x); Hn[m][4 * rq + 2] = bflo(d.y); Hn[m][4 * rq + 3] = bfhi(d.y); } \
                        _Pragma("unroll") for (int r = 0; r < 16; ++r) Z[m][r] = 0.f; } \
                    _Pragma("unroll") for (int s = 0; s < 4; ++s) \
                        _Pragma("unroll") for (int m = 0; m < 2; ++m) { const int o = (32 * m + r32) * 144 + (16 * s + 4 * hh) * 2; \
                            const u32x2 a0 = *(const LAS u32x2*)(sl + o), a1 = *(const LAS u32x2*)(sl + o + 16), q0 = *(const LAS u32x2*)(sl + 18432 + o), q1 = *(const LAS u32x2*)(sl + 18432 + o + 16); \
                            u32x4 t; t.x = a0.x; t.y = a0.y; t.z = a1.x; t.w = a1.y; Hn[m] = __builtin_amdgcn_mfma_f32_32x32x16_bf16(__builtin_bit_cast(bf16x8, t), Hb[s], Hn[m], 0, 0, 0); \
                            t.x = q0.x; t.y = q0.y; t.z = q1.x; t.w = q1.y; Z[m] = __builtin_amdgcn_mfma_f32_32x32x16_bf16(__builtin_bit_cast(bf16x8, t), Hb[s], Z[m], 0, 0, 0); } \
                    H[0] = Hn[0]; H[1] = Hn[1]; \
                    bf16_t* zq = zp + (size_t)ch_ * 64 * 512; \
                    _Pragma("unroll") for (int m = 0; m < 2; ++m) _Pragma("unroll") for (int r = 0; r < 16; ++r) zq[(32 * m + crc(r)) * 512] = (bf16_t)f2bf(Z[m][r]); } \
                LBAR(); } while (0)
            if (wave < 2 || loader) {
                for (int ch = 0; ch < 64; ch += 4) { RB_STEP(0, ch); RB_STEP(1, ch + 1); RB_STEP(2, ch + 2); RB_STEP(3, ch + 3); }
            }
#undef RB_STEP
#undef RB_ISSUE
#undef RB_WRITE
        } else {
            LAS bf16_t* Bm = (LAS bf16_t*)lds; LAS bf16_t* Xh = (LAS bf16_t*)(lds + 34816); LAS float* CUM = (LAS float*)(lds + 53248); LAS float* DTL = CUM + 512;
            for (int unit = vcu - 32; unit < 256; unit += G - 32) {
                const int g = unit & 1, c = (unit >> 1) & 31, b = unit >> 6, m0 = b * SEQ + c * 128;
#pragma unroll 1
                for (int k = 0; k < 4; ++k) { const int p = tid + 512 * k, row = p >> 4, c16 = p & 15; *(LAS u32x4*)(Bm + row * 136 + 8 * c16) = conv8(PROJ, (size_t)(m0 + row), c * 128 + row, 512 + 128 * g + 8 * c16, args.in[I_CONVW], args.in[I_CONVB]); }
                if (wave < 4) { const int h = 4 * g + wave; const float a_h = -__expf(args.in[I_ALOG][h]);
                    const float v0 = DTSP[(size_t)(m0 + 2 * lane) * 8 + h], v1 = DTSP[(size_t)(m0 + 2 * lane + 1) * 8 + h]; float s = v0 + v1;
#pragma unroll
                    for (int o = 1; o < 64; o <<= 1) { const float t = __shfl_up(s, o); if (lane >= o) s += t; }
                    const float ex = s - (v0 + v1);
                    CUM[wave * 128 + 2 * lane] = a_h * (ex + v0); CUM[wave * 128 + 2 * lane + 1] = a_h * (ex + v0 + v1); DTL[wave * 128 + 2 * lane] = v0; DTL[wave * 128 + 2 * lane + 1] = v1; }
                LBAR();
#pragma unroll 1
                for (int hq = 0; hq < 4; ++hq) { const int h = 4 * g + hq;
                    { const int s = tid >> 2, cq = 16 * (tid & 3); const float sc = DTL[hq * 128 + s] * __expf(CUM[hq * 128 + 127] - CUM[hq * 128 + s]);
#pragma unroll 1
                      for (int q = 0; q < 2; ++q) { float f[8]; unpack8(conv8(PROJ, (size_t)(m0 + s), c * 128 + s, 64 * h + cq + 8 * q, args.in[I_CONVW], args.in[I_CONVB]), f);
#pragma unroll
                          for (int i = 0; i < 8; ++i) f[i] *= sc;
                          *(LAS u32x4*)(Xh + s * 72 + cq + 8 * q) = pack8(f); } }
                    LBAR();
                    const int mt = wave >> 2, nt = wave & 3; f32x16 acc;
#pragma unroll
                    for (int r = 0; r < 16; ++r) acc[r] = 0.f;
#pragma unroll
                    for (int ks = 0; ks < 8; ++ks) acc = __builtin_amdgcn_mfma_f32_32x32x16_bf16(TRF(Xh, 72, ks, mt), TRF(Bm, 136, ks, nt), acc, 0, 0, 0);
                    bf16_t* sp = SSTATE + ((size_t)((b * 32 + c) * 8 + h)) * 8192 + (32 * mt + 4 * hh) * 128 + 32 * nt + r32;
#pragma unroll
                    for (int r = 0; r < 16; ++r) sp[crc(r) * 128] = (bf16_t)f2bf(acc[r]);
                    if (tid == 0) CHDEC[(b * 32 + c) * 8 + h] = __expf(CUM[hq * 128 + 127]);
                    LBAR();
                }
            }
            conv_range(args.in, ws, CV_NE + 8 * 704, CV_EGU, (vcu - 32) * 8 + wave, (G - 32) * 8, (LAS float*)(lds + wave * 16384), lane);
        }
    }

    SEAM(3);

    PHASE(4) { REPBAR
        const int gt = vcu * 512 + tid, bh = gt >> 12, e2 = gt & 4095, b = bh >> 3, h = bh & 7;
        unsigned* sp = (unsigned*)SSTATE + ((size_t)(b * 32 * 8 + h)) * 4096 + e2;
        unsigned vals[32];
#pragma unroll
        for (int c = 0; c < 32; ++c) vals[c] = sp[(size_t)c * 8 * 4096];
        float r0 = 0.f, r1 = 0.f;
#pragma unroll
        for (int c = 0; c < 32; ++c) { const float dec = CHDEC[(b * 32 + c) * 8 + h]; sp[(size_t)c * 8 * 4096] = pk2(r0, r1); r0 = r0 * dec + bflo(vals[c]); r1 = r1 * dec + bfhi(vals[c]); }
    }
    SEAM(4);

    PHASE(5) { REPBAR
        LANE_CONSTS;
        {
            LAS bf16_t* Cm = (LAS bf16_t*)lds; LAS bf16_t* Bm = (LAS bf16_t*)(lds + 34816); LAS bf16_t* Xh = (LAS bf16_t*)(lds + 69632); LAS bf16_t* Hp = (LAS bf16_t*)(lds + 88064);
            LAS float* CUM = (LAS float*)(lds + 105472); LAS float* DTL = CUM + 512;
            for (int unit = vcu; unit < 256; unit += G) {
                const int g = unit & 1, c = (unit >> 1) & 31, b = unit >> 6, m0 = b * SEQ + c * 128;
#pragma unroll 1
                for (int k = 0; k < 4; ++k) { const int p = tid + 512 * k, row = p >> 4, c16 = p & 15;
                    *(LAS u32x4*)(Bm + row * 136 + 8 * c16) = conv8(PROJ, (size_t)(m0 + row), c * 128 + row, 512 + 128 * g + 8 * c16, args.in[I_CONVW], args.in[I_CONVB]);
                    *(LAS u32x4*)(Cm + row * 136 + 8 * c16) = conv8(PROJ, (size_t)(m0 + row), c * 128 + row, 768 + 128 * g + 8 * c16, args.in[I_CONVW], args.in[I_CONVB]); }
                if (wave < 4) { const int h = 4 * g + wave; const float a_h = -__expf(args.in[I_ALOG][h]);
                    const float v0 = DTSP[(size_t)(m0 + 2 * lane) * 8 + h], v1 = DTSP[(size_t)(m0 + 2 * lane + 1) * 8 + h]; float s = v0 + v1;
#pragma unroll
                    for (int o = 1; o < 64; o <<= 1) { const float t = __shfl_up(s, o); if (lane >= o) s += t; }
                    const float ex = s - (v0 + v1);
                    CUM[wave * 128 + 2 * lane] = a_h * (ex + v0); CUM[wave * 128 + 2 * lane + 1] = a_h * (ex + v0 + v1); DTL[wave * 128 + 2 * lane] = v0; DTL[wave * 128 + 2 * lane + 1] = v1; }
                LBAR();
                const int mt = wave >> 1, nb = 2 * (wave & 1), nt2 = wave & 1;
                f32x16 cb[2];
#pragma unroll
                for (int r = 0; r < 16; ++r) { cb[0][r] = 0.f; cb[1][r] = 0.f; }
#pragma unroll
                for (int ks = 0; ks < 8; ++ks) { const bf16x8 a = NATF(Cm, 136, ks, mt);
                    cb[0] = __builtin_amdgcn_mfma_f32_32x32x16_bf16(a, NATF(Bm, 136, ks, nb), cb[0], 0, 0, 0); cb[1] = __builtin_amdgcn_mfma_f32_32x32x16_bf16(a, NATF(Bm, 136, ks, nb + 1), cb[1], 0, 0, 0); }
                LBAR();
                LAS bf16_t* Wt = Bm;
#pragma unroll 1
                for (int hq = 0; hq < 4; ++hq) { const int h = 4 * g + hq;
                    u32x4 ph[2];
                    { const bf16_t* hp = SSTATE + ((size_t)((b * 32 + c) * 8 + h)) * 8192;
#pragma unroll
                      for (int k = 0; k < 2; ++k) { const int p = tid + 512 * k; ph[k] = *(const u32x4*)(hp + (p >> 4) * 128 + 8 * (p & 15)); } }
#pragma unroll
                    for (int j = 0; j < 2; ++j) { const int s = 32 * (nb + j) + r32; const float cs = CUM[hq * 128 + s], ds = DTL[hq * 128 + s]; const int lb = 32 * mt + 4 * hh;
                        LAS bf16_t* wp = Wt + lb * 136 + s; const LAS float* cl = CUM + hq * 128 + lb;
#pragma unroll
                        for (int r = 0; r < 16; ++r) { const float w = (s <= lb + crc(r)) ? cb[j][r] * __expf(cl[crc(r)] - cs) * ds : 0.f; wp[crc(r) * 136] = (bf16_t)f2bf(w); } }
                    { const int s = tid >> 2, cq = 16 * (tid & 3);
#pragma unroll 1
                      for (int q = 0; q < 2; ++q) *(LAS u32x4*)(Xh + s * 72 + cq + 8 * q) = conv8(PROJ, (size_t)(m0 + s), c * 128 + s, 64 * h + cq + 8 * q, args.in[I_CONVW], args.in[I_CONVB]); }
#pragma unroll
                    for (int k = 0; k < 2; ++k) { const int p = tid + 512 * k, row = p >> 4, c16 = p & 15; *(LAS u32x4*)(Hp + row * 136 + 8 * c16) = ph[k]; }
                    LBAR();
                    f32x16 yd, yo;
#pragma unroll
                    for (int r = 0; r < 16; ++r) { yd[r] = 0.f; yo[r] = 0.f; }
#pragma unroll
                    for (int ks = 0; ks < 8; ++ks) { yd = __builtin_amdgcn_mfma_f32_32x32x16_bf16(NATF(Wt, 136, ks, mt), TRF(Xh, 72, ks, nt2), yd, 0, 0, 0);
                        yo = __builtin_amdgcn_mfma_f32_32x32x16_bf16(NATF(Cm, 136, ks, mt), NATF(Hp, 136, ks, nt2), yo, 0, 0, 0); }
                    { const LAS float* cl = CUM + hq * 128 + 32 * mt + 4 * hh; bf16_t* yb = MIX + (size_t)(m0 + 32 * mt + 4 * hh) * DM + 512 + 256 * g + 64 * hq + 32 * nt2 + r32;
#pragma unroll
                      for (int r = 0; r < 16; ++r) yb[crc(r) * DM] = (bf16_t)f2bf(yd[r] + __expf(cl[crc(r)]) * yo[r]); }
                    LBAR();
                }
                __syncthreads();
                for (int i4 = 0; i4 < 16; i4 += 4) { const int ch = 256 * g + 4 * lane; const float dsk = args.in[I_DSKIP][4 * g + (lane >> 4)]; const f32x4 nw = *(const f32x4*)(args.in[I_SSDN] + ch);
                  u32x2 xv4[4], zv4[4];
#pragma unroll
                  for (int q = 0; q < 4; ++q) { const size_t m = (size_t)(m0 + wave * 16 + i4 + q); xv4[q] = conv4(PROJ, m, c * 128 + wave * 16 + i4 + q, ch, args.in[I_CONVW], args.in[I_CONVB]); zv4[q] = *(const u32x2*)(PROJ + m * NPROJ + 1792 + ch); }
#pragma unroll
                  for (int q = 0; q < 4; ++q) { const int l = wave * 16 + i4 + q; const size_t m = (size_t)(m0 + l);
                    const u32x2 yv = *(const u32x2*)(MIX + m * DM + 512 + ch), xv = xv4[q], zv = zv4[q];
                    float v[4] = {bflo(yv.x), bfhi(yv.x), bflo(yv.y), bfhi(yv.y)}; const float xs[4] = {bflo(xv.x), bfhi(xv.x), bflo(xv.y), bfhi(xv.y)}, zz[4] = {bflo(zv.x), bfhi(zv.x), bflo(zv.y), bfhi(zv.y)};
                    float qs = 0.f;
#pragma unroll
                    for (int j = 0; j < 4; ++j) { v[j] = (v[j] + dsk * xs[j]) * siluf_(zz[j]); qs += v[j] * v[j]; }
                    qs = wave_sum(qs); const float rq = __builtin_amdgcn_rsqf(qs * (1.0f / 256.0f) + EPS);
                    u32x2 o; o.x = pk2(v[0] * rq * nw[0], v[1] * rq * nw[1]); o.y = pk2(v[2] * rq * nw[2], v[3] * rq * nw[3]); *(u32x2*)(MIX + m * DM + 512 + ch) = o; } }
                LBAR();
            }
        }
        {
            const int c0 = 8 * lane, h = lane >> 3; const float* mu = args.in[I_MU];
            float muv[8], gw_[8], gb_[8];
#pragma unroll
            for (int i = 0; i < 8; ++i) { muv[i] = mu[1024 + c0 + i]; gw_[i] = args.in[I_GNW][c0 + i]; gb_[i] = args.in[I_GNB][c0 + i]; }
#pragma unroll 1
            for (int k0 = 0; k0 < MTOK / NGW; k0 += 4) {
                u32x4 ry[4], rz[4], rv[4], rp[4], rg[4]; float bdv[4];
#pragma unroll
                for (int q = 0; q < 4; ++q) { const size_t m = (size_t)(gw + (k0 + q) * NGW); const bool hasprev = (m & (SEQ - 1)) != 0;
                    ry[q] = *(const u32x4*)(MIX + m * DM + c0); rz[q] = *(const u32x4*)((const bf16_t*)((const unsigned char*)dout + 48 * MiB) + m * 512 + c0);
                    const bf16_t* pc = PROJ + m * NPROJ + c0 + 1024; rv[q] = *(const u32x4*)pc; rp[q] = hasprev ? *(const u32x4*)(pc - NPROJ) : (u32x4){0u, 0u, 0u, 0u};
                    rg[q] = *(const u32x4*)(GOUT + m * 512 + c0); bdv[q] = KKR[m * 8 + h]; }
#pragma unroll
                for (int q = 0; q < 4; ++q) { const size_t m = (size_t)(gw + (k0 + q) * NGW);
                    float y[8], v[8], p[8], go[8];
                    unpack8(ry[q], y); unpack8(rz[q], p);
#pragma unroll
                    for (int i = 0; i < 8; ++i) y[i] += p[i];
                    unpack8(rv[q], v); unpack8(rp[q], p);
#pragma unroll
                    for (int i = 0; i < 8; ++i) v[i] += (p[i] - v[i]) * muv[i];
                    unpack8(rg[q], go);
                    float s1 = 0.f; const float bd = bdv[q];
#pragma unroll
                    for (int i = 0; i < 8; ++i) s1 += y[i];
                    s1 += __shfl_xor(s1, 1); s1 += __shfl_xor(s1, 2); s1 += __shfl_xor(s1, 4);
                    const float mean = s1 * (1.0f / 64.0f); float s2 = 0.f;
#pragma unroll
                    for (int i = 0; i < 8; ++i) { const float d = y[i] - mean; s2 += d * d; }
                    s2 += __shfl_xor(s2, 1); s2 += __shfl_xor(s2, 2); s2 += __shfl_xor(s2, 4);
                    const float rs = __builtin_amdgcn_rsqf(s2 * (1.0f / 64.0f) + 64e-5f);
                    float o[8];
#pragma unroll
                    for (int i = 0; i < 8; ++i) o[i] = ((y[i] - mean) * rs * gw_[i] + gb_[i] + bd * v[i]) * go[i];
                    *(u32x4*)(MIX + m * DM + c0) = pack8(o); }
            }
        }
    }
    SEAM(5);


    PHASE(6) { REPBAR
        pg8::Gemm g{MIX, WOUT, MTOK, DM, DM}; pg8::StaticOrder S; S.init(MTOK, DM, G, bx);
        pg8::EpiRes<false, false> E{args.in[I_X], nullptr, XNB, nullptr, SS};
        pg8::gemm_phase(lds, g, S, E);
    }
    SEAM(6);
    PHASE(7) { REPBAR
        pg8::Gemm g{XNB, WGU, MTOK, 2 * FFN, DM}; pg8::StaticOrder S; S.init(MTOK, 2 * FFN, G, bx);
        pg8::EpiSwiglu E{HID, FFN, SS, nullptr};
        pg8::gemm_phase(lds, g, S, E);
    }
    SEAM(7);
    PHASE(8) { REPBAR
        pg8::Gemm g{HID, WDN, MTOK, DM, FFN}; pg8::StaticOrder S; S.init(MTOK, DM, G, bx);
        pg8::EpiRes<true, false> E{XNB, nullptr, XNB, nullptr, SS};
        pg8::gemm_phase(lds, g, S, E);
    }
    SEAM(8);
    PHASE(9) { REPBAR
        pg8::Gemm g{XNB, WQKV, MTOK, 1536, DM}; pg8::StaticOrder S; S.init(MTOK, 1536, G, bx);
        pg8::EpiQkv E{QKV, SS, args.in[I_BQKV], args.in[I_QN], args.in[I_KN], ROPE};
        pg8::gemm_phase(lds, g, S, E);
        if (bx >= 128) {
            conv_range(args.in, ws, CV_EGU, CV_END, (bx - 128) * 8 + wave, 128 * 8, (LAS float*)(lds + wave * 16384), lane);
        }
    }
    SEAM(9);

    PHASE(10) { REPBAR
        LAS bf16_t* Kt = (LAS bf16_t*)lds; LAS bf16_t* Vt = (LAS bf16_t*)(lds + 36864);
        const int r32 = lane & 31, hh = lane >> 5;
        for (int unit = vcu; unit < BATCH * 4 * 32; unit += G) {
            const int blk = unit & 31, kvh = (unit >> 5) & 3, b = unit >> 7;
            {
                const int rowi = tid >> 1, half = tid & 1; const int tpos = (blk - 1) * 128 + rowi;
#pragma unroll
                for (int q = 0; q < 4; ++q) { u32x4 kv = (u32x4){0, 0, 0, 0}, vv = kv;
                    if (tpos >= 0) { const bf16_t* p = QKV + (size_t)(b * SEQ + tpos) * 1536 + 1024 + kvh * 64 + half * 32 + 8 * q; kv = *(const u32x4*)p; vv = *(const u32x4*)(p + 256); }
                    *(LAS u32x4*)(Kt + rowi * 72 + half * 32 + 8 * q) = kv; *(LAS u32x4*)(Vt + rowi * 72 + half * 32 + 8 * q) = vv; }
            }
            __syncthreads();
            const int gq = wave >> 1, qh = kvh * 4 + gq; const float sink = args.in[I_SINK][qh];
            for (int it = 0; it < 2; ++it) {
                const int qi = (wave & 1) * 64 + it * 32 + r32; const size_t mq = (size_t)b * SEQ + blk * 128 + qi;
                bf16x8 qr[4];
#pragma unroll
                for (int s = 0; s < 4; ++s) qr[s] = *(const bf16x8*)(QKV + mq * 1536 + qh * 64 + 16 * s + 8 * hh);
                const int a0 = (wave & 1) * 2 + it;
                f32x16 sc[5];
#pragma unroll
                for (int j = 0; j < 5; ++j) {
#pragma unroll
                    for (int r = 0; r < 16; ++r) sc[j][r] = 0.f;
#pragma unroll
                    for (int s = 0; s < 4; ++s) { const bf16x8 kf = *(const LAS bf16x8*)(Kt + (32 * (a0 + j) + r32) * 72 + 16 * s + 8 * hh); sc[j] = __builtin_amdgcn_mfma_f32_32x32x16_bf16(kf, qr[s], sc[j], 0, 0, 0); }
                }
                float mx = sink;
#pragma unroll
                for (int j = 0; j < 5; ++j)
#pragma unroll
                    for (int r = 0; r < 16; ++r) { const int kj = 32 * (a0 + j) + crow(r, hh); const bool valid = (kj > qi) && (kj <= qi + 128) && (blk > 0 || kj >= 128);
                        const float x = valid ? sc[j][r] * 0.125f : -1e30f; sc[j][r] = x; mx = fmaxf(mx, x); }
                mx = fmaxf(mx, __shfl_xor(mx, 32));
                float l = 0.f;
#pragma unroll
                for (int j = 0; j < 5; ++j)
#pragma unroll
                    for (int r = 0; r < 16; ++r) { const float p = __expf(sc[j][r] - mx); sc[j][r] = p; l += p; }
                l += __shfl_xor(l, 32); l += __expf(sink - mx);
                const float inv = 1.0f / l;
                f32x16 o[2];
#pragma unroll
                for (int dt = 0; dt < 2; ++dt)
#pragma unroll
                    for (int r = 0; r < 16; ++r) o[dt][r] = 0.f;
#pragma unroll
                for (int j = 0; j < 5; ++j)
#pragma unroll
                    for (int s2 = 0; s2 < 2; ++s2) {
                        u32x4 pw; pw.x = pk2(sc[j][8 * s2 + 0], sc[j][8 * s2 + 1]); pw.y = pk2(sc[j][8 * s2 + 2], sc[j][8 * s2 + 3]); pw.z = pk2(sc[j][8 * s2 + 4], sc[j][8 * s2 + 5]); pw.w = pk2(sc[j][8 * s2 + 6], sc[j][8 * s2 + 7]);
                        const bf16x8 pf = __builtin_bit_cast(bf16x8, pw);
                        const int key0 = 32 * (a0 + j) + 16 * s2 + 4 * hh + ((lane & 15) >> 2);
#pragma unroll
                        for (int dt = 0; dt < 2; ++dt) {
                            const LAS bf16_t* vp = Vt + key0 * 72 + 32 * dt + 16 * ((lane >> 4) & 1) + 4 * (lane & 3);
                            const s16x4 lo = __builtin_bit_cast(s16x4, __builtin_amdgcn_ds_read_tr16_b64_v4i16((LAS s16x4*)vp));
                            const s16x4 hi = __builtin_bit_cast(s16x4, __builtin_amdgcn_ds_read_tr16_b64_v4i16((LAS s16x4*)(vp + 8 * 72)));
                            const bf16x8 vf = (bf16x8){lo[0], lo[1], lo[2], lo[3], hi[0], hi[1], hi[2], hi[3]};
                            o[dt] = __builtin_amdgcn_mfma_f32_32x32x16_bf16(vf, pf, o[dt], 0, 0, 0);
                        }
                    }
                bf16_t* op = ATTO + mq * DM + qh * 64;
#pragma unroll
                for (int dt = 0; dt < 2; ++dt)
#pragma unroll
                    for (int rq = 0; rq < 4; ++rq) { u32x2 w; w.x = pk2(o[dt][4 * rq] * inv, o[dt][4 * rq + 1] * inv); w.y = pk2(o[dt][4 * rq + 2] * inv, o[dt][4 * rq + 3] * inv);
                        *(u32x2*)(op + 32 * dt + 8 * rq + 4 * hh) = w; }
            }
            __syncthreads();
        }
    }
    SEAM(10);

    PHASE(11) { REPBAR
        pg8::Gemm g{ATTO, WO, MTOK, DM, DM}; pg8::StaticOrder S; S.init(MTOK, DM, G, bx);
        pg8::EpiResRouter E{XNB, dout, args.in[I_BO], SS, (float*)(ws + WS_GOUT)  , args.in[I_NORM_FFN1], args.in[I_ROUTER]};
        pg8::gemm_phase(lds, g, S, E);
    }
    SEAM(11);

    PHASE(12) { REPBAR
        LAS unsigned* lcnt = (LAS unsigned*)lds; LAS unsigned* lbase = lcnt + 8;
        if (tid < 8) lcnt[tid] = 0u;
        __syncthreads();
        int e0 = 0, e1 = 1; unsigned r0 = 0u, r1 = 0u; const int m = vcu * 64 + tid;
        if (tid < 64) {
            const float rstd = pg8::rstd_from_ss(SS, m);
            float d[8];
#pragma unroll
            for (int k = 0; k < 8; ++k) d[k] = 0.f;
            const f32x4* lp = (const f32x4*)((const float*)(ws + WS_GOUT) + (size_t)m * 128);
#pragma unroll
            for (int q = 0; q < 16; ++q) { const f32x4 a = lp[2 * q], b2 = lp[2 * q + 1]; d[0] += a[0]; d[1] += a[1]; d[2] += a[2]; d[3] += a[3]; d[4] += b2[0]; d[5] += b2[1]; d[6] += b2[2]; d[7] += b2[3]; }
            float v0 = d[0];
#pragma unroll
            for (int k = 1; k < 8; ++k) if (d[k] > v0) { v0 = d[k]; e0 = k; }
            float v1 = -3.0e38f; e1 = -1;
#pragma unroll
            for (int k = 0; k < 8; ++k) if (k != e0 && d[k] > v1) { v1 = d[k]; e1 = k; }
            const float w0 = __builtin_amdgcn_rcpf(1.0f + __expf((v1 - v0) * rstd));
            r0 = atomicAdd((unsigned*)(lcnt + e0), 1u); r1 = atomicAdd((unsigned*)(lcnt + e1), 1u);
            TOPE[2 * m] = e0; TOPE[2 * m + 1] = e1; TOPW[2 * m] = w0; TOPW[2 * m + 1] = 1.0f - w0; RSTD4[m] = rstd;
        }
        __syncthreads();
        if (tid < 8) lbase[tid] = atomicAdd(CNT + tid, lcnt[tid]);
        __syncthreads();
        if (tid < 64) { RANK[2 * m] = (int)(lbase[e0] + r0); RANK[2 * m + 1] = (int)(lbase[e1] + r1); }
        __syncthreads();
    }
    SEAM(12);

    PHASE(13) { REPBAR
        int roff[NEXP]; { int t = 0;
#pragma unroll
            for (int e = 0; e < NEXP; ++e) { roff[e] = t; t += (int)((CNT[e] + 255u) >> 8) << 8; } }
        {
            const int myj = gw + (lane & 15) * NGW, e = TOPE[myj]; int ro = roff[0];
#pragma unroll
            for (int k = 1; k < NEXP; ++k) ro = (e == k) ? roff[k] : ro;
            const int mypos = ro + RANK[myj];
            if (lane < 16) { POS[myj] = mypos; RSTDS[mypos] = RSTD4[myj >> 1]; }
#pragma unroll
            for (int k0 = 0; k0 < 16; k0 += 4) {
                u32x4 v[4][2]; int pos[4];
#pragma unroll
                for (int q = 0; q < 4; ++q) { pos[q] = __builtin_amdgcn_readlane(mypos, k0 + q); const int m = (gw + (k0 + q) * NGW) >> 1;
                    const u32x4* sp = (const u32x4*)(XNB + (size_t)m * DM) + lane; v[q][0] = sp[0]; v[q][1] = sp[64]; }
#pragma unroll
                for (int q = 0; q < 4; ++q) { u32x4* dp = (u32x4*)(AS + (size_t)pos[q] * DM) + lane; dp[0] = v[q][0]; dp[64] = v[q][1]; }
            }
        }
    }
    SEAM(13);
    PHASE(14) { REPBAR
        pg8::Gemm g{AS, EGU, SROWS, 2 * FE, DM}; pg8::MoeOrder S; S.init(CNT, 2 * FE / 256, G, bx, (long)2 * FE * DM * 2);
        pg8::EpiSwiglu E{HS, FE, nullptr, RSTDS};
        pg8::gemm_phase(lds, g, S, E);
    }
    SEAM(14);
    PHASE(15) { REPBAR
        pg8::Gemm g{HS, EDN, SROWS, DM, FE}; pg8::MoeOrder S; S.init(CNT, DM / 256, G, bx, (long)DM * FE * 2);
        pg8::EpiBf16 E{AS, DM};
        pg8::gemm_phase(lds, g, S, E);
    }
    SEAM(15);
    PHASE(16) { REPBAR
        {
            const int mym = gw + (lane & 7) * NGW; const int q0 = POS[2 * mym], q1 = POS[2 * mym + 1]; const float u0 = TOPW[2 * mym], u1 = TOPW[2 * mym + 1];
#pragma unroll
            for (int k0 = 0; k0 < 8; k0 += 4) {
                u32x4 ya[4][2], yb[4][2]; f32x4 hv[4][4]; float w0[4], w1[4];
#pragma unroll
                for (int t = 0; t < 4; ++t) { const int p0 = __builtin_amdgcn_readlane(q0, k0 + t), p1 = __builtin_amdgcn_readlane(q1, k0 + t);
                    w0[t] = __builtin_bit_cast(float, __builtin_amdgcn_readlane(__builtin_bit_cast(int, u0), k0 + t)); w1[t] = __builtin_bit_cast(float, __builtin_amdgcn_readlane(__builtin_bit_cast(int, u1), k0 + t));
                    const u32x4* y0 = (const u32x4*)(AS + (size_t)p0 * DM) + lane; const u32x4* y1 = (const u32x4*)(AS + (size_t)p1 * DM) + lane;
                    ya[t][0] = y0[0]; ya[t][1] = y0[64]; yb[t][0] = y1[0]; yb[t][1] = y1[64];
                    const f32x4* o = (const f32x4*)(dout + (size_t)(gw + (k0 + t) * NGW) * DM);
                    hv[t][0] = o[2 * lane]; hv[t][1] = o[2 * lane + 1]; hv[t][2] = o[128 + 2 * lane]; hv[t][3] = o[128 + 2 * lane + 1]; }
#pragma unroll
                for (int t = 0; t < 4; ++t) { f32x4* o = (f32x4*)(dout + (size_t)(gw + (k0 + t) * NGW) * DM);
#pragma unroll
                    for (int q = 0; q < 2; ++q) { float a[8], c[8]; unpack8(ya[t][q], a); unpack8(yb[t][q], c); f32x4 h0 = hv[t][2 * q], h1 = hv[t][2 * q + 1];
#pragma unroll
                        for (int i = 0; i < 4; ++i) { h0[i] += w0[t] * a[i] + w1[t] * c[i]; h1[i] += w0[t] * a[4 + i] + w1[t] * c[4 + i]; }
                        o[128 * q + 2 * lane] = h0; o[128 * q + 2 * lane + 1] = h1; } }
            }
        }
    }
#undef TRF
#undef NATF
#undef IN
#undef SEAM
#undef PHASE
#undef REPBAR
}

constexpr int NPHASE = 17;
extern "C" void kernel_launch(void* const* d_in, const int* in_sizes, int n_in, void* d_out, int out_size, void* d_ws, size_t ws_size, hipStream_t stream) {
    static int grid = 0;
    if (grid == 0) {
        if (n_in != 39 || out_size != MTOK * DM || ws_size < WS_END) { fprintf(stderr, "kernel_launch: unexpected shapes n_in %d out %d ws %zu\n", n_in, out_size, ws_size); grid = -1; return; }
        int dev = 0, cus = 0;
        if (hipGetDevice(&dev) != hipSuccess || hipDeviceGetAttribute(&cus, hipDeviceAttributeMultiprocessorCount, dev) != hipSuccess) { grid = -1; return; }
        if (hipFuncSetAttribute((const void*)fwd_kernel, hipFuncAttributeMaxDynamicSharedMemorySize, LDS_BYTES) != hipSuccess) { fprintf(stderr, "kernel_launch: hipFuncSetAttribute failed\n"); grid = -1; return; }
        int per_cu = 0; (void)hipOccupancyMaxActiveBlocksPerMultiprocessor(&per_cu, (const void*)fwd_kernel, 512, LDS_BYTES); (void)hipGetLastError();
        grid = 256; if (cus != 256 || per_cu < 1) fprintf(stderr, "kernel_launch: note: cus %d per_cu %d\n", cus, per_cu);
    }
    if (grid < 0) return;
    Args a{};
    a.in[0] = (const float*)d_in[0];
    for (int i = 2; i < 39; ++i) a.in[i - 1] = (const float*)d_in[i];
    a.pos = (const int*)d_in[1]; a.out = (float*)d_out; a.ws = (unsigned char*)d_ws;
    (void)hipMemsetAsync((char*)d_ws + WS_CTL, 0, CTL_ZERO_BYTES, stream);
#ifdef PROBE_PHASE
    constexpr int pp = PROBE_PHASE; constexpr bool before = (pp == 2 || pp == 3 || pp == 5 || pp == 6 || pp == 8 || pp == 11 || pp == 12);
#ifdef PROBE_VARIANT
    a.variant = PROBE_VARIANT;
#endif
    if (before) { a.ph_lo = pp; a.ph_hi = pp + 1; hipLaunchKernelGGL(fwd_kernel, dim3(grid), dim3(512), LDS_BYTES, stream, a); (void)hipMemsetAsync((char*)d_ws + WS_CTL, 0, CTL_ZERO_BYTES, stream); }
    a.variant = 0;
#endif
    a.ph_lo = 0; a.ph_hi = NPHASE;
    hipLaunchKernelGGL(fwd_kernel, dim3(grid), dim3(512), LDS_BYTES, stream, a);
#ifdef PROBE_PHASE
    if (!before) { (void)hipMemsetAsync((char*)d_ws + WS_CTL, 0, CW_CNT * 4, stream);
#ifdef PROBE_VARIANT
        a.variant = PROBE_VARIANT;
#endif
        a.ph_lo = pp; a.ph_hi = pp + 1; hipLaunchKernelGGL(fwd_kernel, dim3(grid), dim3(512), LDS_BYTES, stream, a); }
#endif
}
```

```cpp
#include <hip/hip_runtime.h>
#include <cstdio>
#include <cstdint>

#define LAS __attribute__((address_space(3)))
#define GAS __attribute__((address_space(1)))
typedef unsigned short bf16_t;
typedef short bf16x8 __attribute__((ext_vector_type(8)));
typedef float f32x4 __attribute__((ext_vector_type(4)));
typedef float f32x2 __attribute__((ext_vector_type(2)));
typedef float f32x16 __attribute__((ext_vector_type(16)));
typedef unsigned u32x4 __attribute__((ext_vector_type(4)));
typedef unsigned u32x2 __attribute__((ext_vector_type(2)));
typedef short s16x4 __attribute__((ext_vector_type(4)));

constexpr int BATCH = 4, SEQ = 4096, DM = 1024, MTOK = BATCH * SEQ;
constexpr int IN0 = 3336, NPROJ = 3328;
constexpr int FFN = 2816, FE = 1408, NEXP = 8;
constexpr int SROWS = 2 * MTOK + NEXP * 256;
constexpr float EPS = 1e-6f;

constexpr size_t MiB = 1u << 20;
constexpr size_t WS_CTL = 0, CTL_ZERO_BYTES = 64 * 1024;
constexpr size_t WS_DTSP = 1 * MiB;
constexpr size_t WS_KKR = 1 * MiB + 512 * 1024;
constexpr size_t WS_ROPE = 2 * MiB;
constexpr size_t WS_SS = 3 * MiB;
constexpr size_t WS_TOPE = 4 * MiB;
constexpr size_t WS_RANK = 4 * MiB + 128 * 1024;
constexpr size_t WS_TOPW = 4 * MiB + 256 * 1024;
constexpr size_t WS_POS = 4 * MiB + 384 * 1024;
constexpr size_t WS_RSTD4 = 4 * MiB + 512 * 1024;
constexpr size_t WS_RSTDS = 4 * MiB + 640 * 1024;
constexpr size_t WS_WDEC = 5 * MiB;
constexpr size_t WS_WICL = 5 * MiB + 64 * 1024;
constexpr size_t WS_WGAT = 5 * MiB + 128 * 1024;
constexpr size_t WS_EGU = 6 * MiB;
constexpr size_t WS_EDN = 50 * MiB;
constexpr size_t WS_WIN = 72 * MiB;
constexpr size_t WS_WOUT = WS_WIN + (size_t)NPROJ * DM * 2;
constexpr size_t WS_WGU = WS_WOUT + 2 * MiB;
constexpr size_t WS_WDN = WS_WGU + 11 * MiB;
constexpr size_t WS_WQKV = WS_WDN + (size_t)DM * FFN * 2;
constexpr size_t WS_WO = WS_WQKV + 3 * MiB;
constexpr size_t R0 = 102 * MiB;
static_assert(WS_WO + 2 * MiB <= R0, "weights");
constexpr size_t WS_XN = R0, WS_MIX = R0;
constexpr size_t WS_PROJ = R0 + 32 * MiB;
constexpr size_t WS_GOUT = R0 + 136 * MiB;
constexpr size_t WS_XNB = R0 + 104 * MiB;
constexpr size_t WS_HID = R0;
constexpr size_t WS_QKV = R0;
constexpr size_t WS_ATTO = R0 + 48 * MiB;
constexpr size_t WS_AS = 72 * MiB;
constexpr size_t WS_HS = 140 * MiB;
constexpr size_t WS_END = 254 * MiB;
static_assert(WS_AS + (size_t)SROWS * DM * 2 <= WS_HS && WS_HS + (size_t)SROWS * FE * 2 <= WS_END && WS_GOUT + 16 * MiB <= WS_END, "map");
constexpr int CW_BAR = 4096, CW_CNT = 8192;

constexpr int LDS_BYTES = 147456, RING_BYTES = 131072, MISC_OFF = LDS_BYTES - 128;

__device__ __forceinline__ unsigned f2bf(float f) { unsigned u = __builtin_bit_cast(unsigned, f); return (u + 0x7fffu + ((u >> 16) & 1u)) >> 16; }
typedef __bf16 bf16x2_t __attribute__((ext_vector_type(2)));
__device__ __forceinline__ unsigned pk2(float lo, float hi) { const f32x2 v = {lo, hi}; const bf16x2_t b = __builtin_convertvector(v, bf16x2_t); return __builtin_bit_cast(unsigned, b); }
__device__ __forceinline__ float bflo(unsigned u) { return __builtin_bit_cast(float, u << 16); }
__device__ __forceinline__ float bfhi(unsigned u) { return __builtin_bit_cast(float, u & 0xffff0000u); }
__device__ __forceinline__ void unpack8(const u32x4 v, float* f) { f[0] = bflo(v.x); f[1] = bfhi(v.x); f[2] = bflo(v.y); f[3] = bfhi(v.y); f[4] = bflo(v.z); f[5] = bfhi(v.z); f[6] = bflo(v.w); f[7] = bfhi(v.w); }
__device__ __forceinline__ u32x4 pack8(const float* f) { u32x4 v; v.x = pk2(f[0], f[1]); v.y = pk2(f[2], f[3]); v.z = pk2(f[4], f[5]); v.w = pk2(f[6], f[7]); return v; }
__device__ __forceinline__ float sigmoidf_(float x) { return __builtin_amdgcn_rcpf(1.0f + __expf(-x)); }
__device__ __forceinline__ float siluf_(float x) { return x * __builtin_amdgcn_rcpf(1.0f + __expf(-x)); }
#define LBAR() do { asm volatile("s_waitcnt lgkmcnt(0)" ::: "memory"); __builtin_amdgcn_s_barrier(); asm volatile("" ::: "memory"); } while (0)
__device__ __forceinline__ float wave_sum(float v) {
#pragma unroll
    for (int o = 1; o < 64; o <<= 1) v += __shfl_xor(v, o);
    return v;
}
__device__ __forceinline__ float dpp_sum63(float x) {
    int v;
    v = __builtin_amdgcn_update_dpp(0, __builtin_bit_cast(int, x), 0xB1, 0xF, 0xF, false); x += __builtin_bit_cast(float, v);
    v = __builtin_amdgcn_update_dpp(0, __builtin_bit_cast(int, x), 0x4E, 0xF, 0xF, false); x += __builtin_bit_cast(float, v);
    v = __builtin_amdgcn_update_dpp(0, __builtin_bit_cast(int, x), 0x141, 0xF, 0xF, false); x += __builtin_bit_cast(float, v);
    v = __builtin_amdgcn_update_dpp(0, __builtin_bit_cast(int, x), 0x140, 0xF, 0xF, false); x += __builtin_bit_cast(float, v);
    v = __builtin_amdgcn_update_dpp(0, __builtin_bit_cast(int, x), 0x142, 0xA, 0xF, false); x += __builtin_bit_cast(float, v);
    v = __builtin_amdgcn_update_dpp(0, __builtin_bit_cast(int, x), 0x143, 0xC, 0xF, false); x += __builtin_bit_cast(float, v);
    return __builtin_bit_cast(float, __builtin_amdgcn_readlane(__builtin_bit_cast(int, x), 63));
}
__device__ __forceinline__ void wave_sum8(float (&d)[8]) {
    float e4[4], e2[2], e1;
    { const bool up = (threadIdx.x & 32) != 0;
#pragma unroll
      for (int k = 0; k < 4; ++k) { const float keep = up ? d[k + 4] : d[k], send = up ? d[k] : d[k + 4]; e4[k] = keep + __shfl_xor(send, 32); } }
    { const bool up = (threadIdx.x & 16) != 0;
#pragma unroll
      for (int k = 0; k < 2; ++k) { const float keep = up ? e4[k + 2] : e4[k], send = up ? e4[k] : e4[k + 2]; e2[k] = keep + __shfl_xor(send, 16); } }
    { const bool up = (threadIdx.x & 8) != 0; const float keep = up ? e2[1] : e2[0], send = up ? e2[0] : e2[1]; e1 = keep + __shfl_xor(send, 8); }
    e1 += __shfl_xor(e1, 4); e1 += __shfl_xor(e1, 2); e1 += __shfl_xor(e1, 1);
#pragma unroll
    for (int k = 0; k < 8; ++k) d[k] = __builtin_bit_cast(float, __builtin_amdgcn_readlane(__builtin_bit_cast(int, e1), 8 * k));
}
__device__ __forceinline__ int crow(int r, int hi) { return (r & 3) + 8 * (r >> 2) + 4 * hi; }
__device__ __forceinline__ constexpr int crc(int r) { return (r & 3) + 8 * (r >> 2); }

namespace pg8 {
constexpr int BM = 256, BK = 64, HALF = 128, HTB = HALF * BK * 2, NXCD = 8, WGM = 2;
__host__ __device__ __forceinline__ int lds_byte(int r, int c) { const int st = (r >> 4) * 2 + (c >> 5), rr = r & 15, cc = c & 31, ob = rr * 64 + cc * 2; return st * 1024 + (ob ^ (((ob >> 9) & 1) << 5)); }
__host__ __device__ __forceinline__ void stage_rc(int b, int& R, int& C) { const int st = b / 1024, sb = b % 1024, swz = sb ^ (((sb >> 9) & 1) << 5); R = (st >> 1) * 16 + swz / 64; C = (st & 1) * 32 + (swz % 64) / 2; }
__host__ __device__ __forceinline__ int perm32(int rho) { const int n = rho >> 4, i = rho & 15; return 8 * (i >> 2) + 4 * n + (i & 3); }
struct Unit { int pm, pn; long bofs; int slot; };
struct Gemm { const bf16_t* A; const bf16_t* Bt; int M, N, K; };
struct StaticOrder {
    int nM, nN, nwg, G, c;
    __device__ __forceinline__ void init(int M, int N, int G_, int c_) { nM = M / BM; nN = N / BM; nwg = nM * nN; G = G_; c = c_; }
    __device__ __forceinline__ bool next(int i, Unit& u) const {
        const long L = (long)i * G + c; if (L >= nwg) return false;
        int wgid = (int)L; { const int q = nwg / NXCD, r = nwg % NXCD, xcd = wgid % NXCD, off = wgid / NXCD; wgid = (xcd < r ? xcd * (q + 1) : r * (q + 1) + (xcd - r) * q) + off; }
        const int nig = WGM * nN, gid = wgid / nig, fm = gid * WGM, gsz = (nM - fm) < WGM ? (nM - fm) : WGM;
        u.pm = fm + ((wgid % nig) % gsz); u.pn = (wgid % nig) / gsz; u.bofs = 0; u.slot = i; return true;
    }
};
struct MoeOrder {
    int toff[NEXP + 1]; int nN, G, c; long estride;
    __device__ __forceinline__ void init(const unsigned* cnt, int nN_, int G_, int c_, long estride_) {
        nN = nN_; G = G_; c = c_; estride = estride_; int t = 0;
#pragma unroll
        for (int e = 0; e < NEXP; ++e) { toff[e] = t; t += (int)((cnt[e] + 255u) >> 8); }
        toff[NEXP] = t;
    }
    __device__ __forceinline__ bool next(int i, Unit& u) const {
        const int nM = toff[NEXP], nwg = nM * nN; const long L = (long)i * G + c; if (L >= nwg) return false;
        int wgid = (int)L; { const int q = nwg / NXCD, r = nwg % NXCD, xcd = wgid % NXCD, off = wgid / NXCD; wgid = (xcd < r ? xcd * (q + 1) : r * (q + 1) + (xcd - r) * q) + off; }
        const int nig = WGM * nN, gid = wgid / nig, fm = gid * WGM, gsz = (nM - fm) < WGM ? (nM - fm) : WGM;
        const int pm = fm + ((wgid % nig) % gsz); u.pm = pm; u.pn = (wgid % nig) / gsz; u.slot = i; int e = 0;
#pragma unroll
        for (int j = 1; j < NEXP; ++j) e += (pm >= toff[j]) ? 1 : 0;
        u.bofs = (long)e * estride; return true;
    }
};

template <class Epi, class Sched>
__device__ __forceinline__ void gemm_phase(LAS unsigned char* lds, const Gemm g, const Sched& S, const Epi& E) {
    constexpr bool ALIGN_EPI = true;
    const int tid = threadIdx.x, wid = __builtin_amdgcn_readfirstlane(tid >> 6), lane = tid & 63, wr = wid >> 2, wc = wid & 3, fr = lane & 15, fq = lane >> 4;
    const int K = g.K, nt = K / BK;
    unsigned voffA[2], voffB[2];
#pragma unroll
    for (int i = 0; i < 2; ++i) { int R, C; stage_rc(tid * 16 + i * 8192, R, C); const int Rb = Epi::PERM ? ((R & ~31) + perm32(R & 31)) : R;
        voffA[i] = (unsigned)(R * K + C) * 2u; voffB[i] = (unsigned)(Rb * K + C) * 2u; }
    const size_t kstep = (size_t)(BK * 2);
    const size_t hstep = (size_t)HALF * K * 2;
    const size_t tstep = 2 * hstep;
    const unsigned ldsw = (unsigned)wid * 1024u;
    const int aoff = lds_byte(wr * 64 + fr, fq * 8), boff = lds_byte(wc * 32 + fr, fq * 8);
#define PG8_SA(b, h) (((b) * 2 + (h)) * HTB)
#define PG8_SB(b, h) ((4 + (b) * 2 + (h)) * HTB)
#define PG8_STAGE(bufoff, gbase, voff) do { _Pragma("unroll") for (int _i = 0; _i < 2; ++_i) \
        __builtin_amdgcn_global_load_lds((const unsigned*)((const char*)(gbase) + (voff)[_i]), (LAS unsigned*)(lds + (bufoff) + ldsw + _i * 8192), 16, 0, 0); } while (0)
#define PG8_LDA(dst, b, h) do { _Pragma("unroll") for (int m = 0; m < 4; ++m) _Pragma("unroll") for (int k = 0; k < 2; ++k) dst[m][k] = *(const LAS bf16x8*)(lds + PG8_SA(b, h) + aoff + m * 2048 + k * 1024); } while (0)
#define PG8_LDB(dst, b, h) do { _Pragma("unroll") for (int n = 0; n < 2; ++n) _Pragma("unroll") for (int k = 0; k < 2; ++k) dst[n][k] = *(const LAS bf16x8*)(lds + PG8_SB(b, h) + boff + n * 2048 + k * 1024); } while (0)
#define PG8_MMA(ai, bj, At, Bt) do { __builtin_amdgcn_s_setprio(1); _Pragma("unroll") for (int m = 0; m < 4; ++m) _Pragma("unroll") for (int n = 0; n < 2; ++n) _Pragma("unroll") for (int k = 0; k < 2; ++k) \
        acc[ai][bj][m][n] = __builtin_amdgcn_mfma_f32_16x16x32_bf16(Bt[n][k], At[m][k], acc[ai][bj][m][n], 0, 0, 0); __builtin_amdgcn_s_setprio(0); } while (0)
#define PG8_WAIT_V(n) asm volatile("s_waitcnt vmcnt(" #n ")" ::: "memory")
#define PG8_WAIT_L(n) asm volatile("s_waitcnt lgkmcnt(" #n ")" ::: "memory")
#define PG8_BAR __builtin_amdgcn_s_barrier()
#define PG8_SCHED __builtin_amdgcn_sched_barrier(0)
    Unit cur, nxt; int ui = 0;
    if (!S.next(0, cur)) return;
    f32x4 acc[2][2][4][2];
#pragma unroll
    for (int a = 0; a < 2; ++a)
#pragma unroll
        for (int b = 0; b < 2; ++b)
#pragma unroll
            for (int m = 0; m < 4; ++m)
#pragma unroll
                for (int n = 0; n < 2; ++n) acc[a][b][m][n] = (f32x4){0.f, 0.f, 0.f, 0.f};
    bf16x8 At[4][2], B0[2][2], B1[2][2];
    const char* cA = (const char*)g.A + (size_t)cur.pm * tstep; const char* cB = (const char*)g.Bt + cur.bofs + (size_t)cur.pn * tstep;
    PG8_STAGE(PG8_SB(0, 0), cB, voffB); PG8_STAGE(PG8_SB(0, 1), cB + hstep, voffB); PG8_STAGE(PG8_SA(0, 0), cA, voffA); PG8_STAGE(PG8_SA(0, 1), cA + hstep, voffA);
    if (wr == 1) PG8_BAR;
    PG8_WAIT_V(2); PG8_BAR;
    PG8_STAGE(PG8_SB(1, 0), cB + kstep, voffB); PG8_STAGE(PG8_SA(1, 0), cA + kstep, voffA); PG8_STAGE(PG8_SB(1, 1), cB + hstep + kstep, voffB);
    PG8_WAIT_V(6); PG8_BAR;
    for (;;) {
        const bool has_next = S.next(ui + 1, nxt);
        const char* nA = has_next ? (const char*)g.A + (size_t)nxt.pm * tstep : cA; const char* nB = has_next ? (const char*)g.Bt + nxt.bofs + (size_t)nxt.pn * tstep : cB;
        for (int t = 0; t < nt; t += 2) {
            const bool last = (t == nt - 2);
            const char* a1 = cA + (size_t)(t + 1) * kstep;
            const char* a2 = last ? nA : cA + (size_t)(t + 2) * kstep; const char* b2 = last ? nB : cB + (size_t)(t + 2) * kstep;
            const char* a3 = a2 + kstep; const char* b3 = b2 + kstep;
            PG8_LDB(B0, 0, 0); PG8_LDB(B1, 0, 1); PG8_SCHED; PG8_LDA(At, 0, 0); PG8_STAGE(PG8_SA(1, 1), a1 + hstep, voffA);
            PG8_WAIT_V(8); PG8_WAIT_L(0); PG8_BAR; PG8_MMA(0, 0, At, B0); PG8_MMA(0, 1, At, B1); PG8_BAR; PG8_SCHED;
            PG8_LDA(At, 0, 1); PG8_STAGE(PG8_SB(0, 0), b2, voffB); PG8_STAGE(PG8_SB(0, 1), b2 + hstep, voffB); PG8_STAGE(PG8_SA(0, 0), a2, voffA);
            PG8_WAIT_V(8); PG8_WAIT_L(0); PG8_BAR; PG8_MMA(1, 0, At, B0); PG8_MMA(1, 1, At, B1); PG8_BAR; PG8_SCHED;
            PG8_LDB(B0, 1, 0); PG8_LDB(B1, 1, 1); PG8_SCHED; PG8_LDA(At, 1, 0); PG8_STAGE(PG8_SA(0, 1), a2 + hstep, voffA);
            PG8_WAIT_V(8); PG8_WAIT_L(0); PG8_BAR; PG8_MMA(0, 0, At, B0); PG8_MMA(0, 1, At, B1); PG8_BAR; PG8_SCHED;
            PG8_LDA(At, 1, 1); PG8_STAGE(PG8_SB(1, 0), b3, voffB); PG8_STAGE(PG8_SB(1, 1), b3 + hstep, voffB); PG8_STAGE(PG8_SA(1, 0), a3, voffA);
            PG8_WAIT_V(8); PG8_WAIT_L(0); PG8_BAR; PG8_MMA(1, 0, At, B0); PG8_MMA(1, 1, At, B1); PG8_BAR; PG8_SCHED;
        }
        if constexpr (ALIGN_EPI) { if (wr == 0) PG8_BAR; }
        if constexpr (!Epi::AFTER_DRAIN) E(acc, cur, wr, wc, fr, fq);
        if (!has_next) break;
#pragma unroll
        for (int a = 0; a < 2; ++a)
#pragma unroll
            for (int b = 0; b < 2; ++b)
#pragma unroll
                for (int m = 0; m < 4; ++m)
#pragma unroll
                    for (int n = 0; n < 2; ++n) acc[a][b][m][n] = (f32x4){0.f, 0.f, 0.f, 0.f};
        cur = nxt; cA = nA; cB = nB; ++ui;
        if constexpr (ALIGN_EPI) { if (wr == 1) PG8_BAR; }
    }
    PG8_WAIT_V(0);
    if constexpr (!ALIGN_EPI) { if (wr == 0) PG8_BAR; }
    PG8_BAR;
    if constexpr (Epi::AFTER_DRAIN) E.fused(acc, cur, wr, wc, fr, fq, lds);
#undef PG8_SA
#undef PG8_SB
#undef PG8_STAGE
#undef PG8_LDA
#undef PG8_LDB
#undef PG8_MMA
#undef PG8_WAIT_V
#undef PG8_WAIT_L
#undef PG8_BAR
#undef PG8_SCHED
}

struct EpiBf16 {
    static constexpr bool PERM = true, AFTER_DRAIN = false;
    bf16_t* O; int ldc;
    __device__ __forceinline__ void operator()(const f32x4 (&acc)[2][2][4][2], const Unit& u, int wr, int wc, int fr, int fq) const {
        const int row0 = u.pm * BM + wr * 64 + fr, col0 = u.pn * BM + wc * 32 + 8 * fq;
#pragma unroll
        for (int ai = 0; ai < 2; ++ai)
#pragma unroll
            for (int m = 0; m < 4; ++m) { bf16_t* rowp = O + (size_t)(row0 + ai * HALF + m * 16) * ldc + col0;
#pragma unroll
                for (int bj = 0; bj < 2; ++bj) { const f32x4 v0 = acc[ai][bj][m][0], v1 = acc[ai][bj][m][1];
                    u32x4 w; w.x = pk2(v0[0], v0[1]); w.y = pk2(v0[2], v0[3]); w.z = pk2(v1[0], v1[1]); w.w = pk2(v1[2], v1[3]);
                    *(u32x4*)(rowp + bj * HALF) = w; } }
    }
};
template <bool BASE_BF16, bool F32OUT> struct EpiRes {
    static constexpr bool PERM = false, AFTER_DRAIN = false;
    const void* base; float* out; bf16_t* hb; const float* bias; float* ss;
    __device__ __forceinline__ void operator()(const f32x4 (&acc)[2][2][4][2], const Unit& u, int wr, int wc, int fr, int fq) const {
        const int col0 = u.pn * BM + wc * 32 + 4 * fq;
        f32x4 bv[2][2];
#pragma unroll
        for (int bj = 0; bj < 2; ++bj)
#pragma unroll
            for (int n = 0; n < 2; ++n) bv[bj][n] = bias ? *(const f32x4*)(bias + col0 + bj * HALF + n * 16) : (f32x4){0.f, 0.f, 0.f, 0.f};
#pragma unroll
        for (int ai = 0; ai < 2; ++ai) {
            f32x4 pre[4][2][2];
#pragma unroll
            for (int m = 0; m < 4; ++m) { const size_t off = (size_t)(u.pm * BM + ai * HALF + wr * 64 + m * 16 + fr) * DM + col0;
#pragma unroll
                for (int bj = 0; bj < 2; ++bj)
#pragma unroll
                    for (int n = 0; n < 2; ++n) { const size_t o2 = off + bj * HALF + n * 16;
                        if (BASE_BF16) { const u32x2 w = *(const u32x2*)((const bf16_t*)base + o2); pre[m][bj][n] = (f32x4){bflo(w.x), bfhi(w.x), bflo(w.y), bfhi(w.y)}; } else pre[m][bj][n] = *(const f32x4*)((const float*)base + o2); } }
            asm volatile("" ::: "memory");
#pragma unroll
            for (int m = 0; m < 4; ++m) { const int row = u.pm * BM + ai * HALF + wr * 64 + m * 16 + fr; const size_t off = (size_t)row * DM + col0; float s = 0.f;
#pragma unroll
                for (int bj = 0; bj < 2; ++bj)
#pragma unroll
                    for (int n = 0; n < 2; ++n) { const size_t o2 = off + bj * HALF + n * 16;
                        const f32x4 o = pre[m][bj][n] + acc[ai][bj][m][n] + bv[bj][n];
                        if (F32OUT) *(f32x4*)(out + o2) = o;
                        s += (o[0] * o[0] + o[1] * o[1]) + (o[2] * o[2] + o[3] * o[3]);
                        u32x2 w; w.x = pk2(o[0], o[1]); w.y = pk2(o[2], o[3]); *(u32x2*)(hb + o2) = w; }
                s += __shfl_xor(s, 16); s += __shfl_xor(s, 32);
                if (fq == 0) ss[(size_t)row * 16 + u.pn * 4 + wc] = s; }
        }
    }
};
struct EpiResRouter {
    static constexpr bool PERM = false, AFTER_DRAIN = true;
    bf16_t* hb; float* out; const float* bias; float* ss; float* lp; const float* gw; const float* wr8;
    __device__ __forceinline__ void fused(const f32x4 (&acc)[2][2][4][2], const Unit& u, int wr, int wc, int fr, int fq, LAS unsigned char* lds) const {
        LAS float* GW = (LAS float*)lds;
        { const int t = threadIdx.x, c = t >> 1, hf = t & 1; const float g = gw[u.pn * BM + c]; const f32x4 w = *(const f32x4*)(wr8 + (size_t)(u.pn * BM + c) * 8 + 4 * hf); *(LAS f32x4*)(GW + c * 8 + 4 * hf) = w * g; }
        asm volatile("s_waitcnt lgkmcnt(0)" ::: "memory"); __builtin_amdgcn_s_barrier(); asm volatile("" ::: "memory");
        const int col0 = u.pn * BM + wc * 32 + 4 * fq, lc0 = wc * 32 + 4 * fq;
        f32x4 bv[2][2];
#pragma unroll
        for (int bj = 0; bj < 2; ++bj)
#pragma unroll
            for (int n = 0; n < 2; ++n) bv[bj][n] = *(const f32x4*)(bias + col0 + bj * HALF + n * 16);
#pragma unroll
        for (int ai = 0; ai < 2; ++ai) {
#pragma unroll
          for (int mh = 0; mh < 2; ++mh) {
            u32x2 pre[4][2][2];
#pragma unroll
            for (int m = 2 * mh; m < 2 * mh + 2; ++m) { const size_t off = (size_t)(u.pm * BM + ai * HALF + wr * 64 + m * 16 + fr) * DM + col0;
#pragma unroll
                for (int bj = 0; bj < 2; ++bj)
#pragma unroll
                    for (int n = 0; n < 2; ++n) pre[m][bj][n] = *(const u32x2*)(hb + off + bj * HALF + n * 16); }
            asm volatile("" ::: "memory");
#pragma unroll
            for (int m = 2 * mh; m < 2 * mh + 2; ++m) { const int row = u.pm * BM + ai * HALF + wr * 64 + m * 16 + fr; const size_t off = (size_t)row * DM + col0; float s = 0.f;
                float lg[8];
#pragma unroll
                for (int e = 0; e < 8; ++e) lg[e] = 0.f;
#pragma unroll
                for (int bj = 0; bj < 2; ++bj)
#pragma unroll
                    for (int n = 0; n < 2; ++n) { const size_t o2 = off + bj * HALF + n * 16; const u32x2 w = pre[m][bj][n];
                        const f32x4 o = (f32x4){bflo(w.x), bfhi(w.x), bflo(w.y), bfhi(w.y)} + acc[ai][bj][m][n] + bv[bj][n];
                        s += (o[0] * o[0] + o[1] * o[1]) + (o[2] * o[2] + o[3] * o[3]);
                        u32x2 wo; wo.x = pk2(o[0], o[1]); wo.y = pk2(o[2], o[3]); *(u32x2*)(hb + o2) = wo; *(f32x4*)(out + o2) = o;
#pragma unroll
                        for (int i = 0; i < 4; ++i) { const LAS float* gp = GW + (lc0 + bj * HALF + n * 16 + i) * 8; const f32x4 wa = *(const LAS f32x4*)gp, wb = *(const LAS f32x4*)(gp + 4);
                            lg[0] += o[i] * wa[0]; lg[1] += o[i] * wa[1]; lg[2] += o[i] * wa[2]; lg[3] += o[i] * wa[3]; lg[4] += o[i] * wb[0]; lg[5] += o[i] * wb[1]; lg[6] += o[i] * wb[2]; lg[7] += o[i] * wb[3]; } }
                s += __shfl_xor(s, 16); s += __shfl_xor(s, 32);
#pragma unroll
                for (int e = 0; e < 8; ++e) { lg[e] += __shfl_xor(lg[e], 16); lg[e] += __shfl_xor(lg[e], 32); }
                if (fq == 0) { ss[(size_t)row * 16 + u.pn * 4 + wc] = s; float* lpp = lp + ((size_t)row * 16 + u.pn * 4 + wc) * 8;
                    *(f32x4*)lpp = (f32x4){lg[0], lg[1], lg[2], lg[3]}; *(f32x4*)(lpp + 4) = (f32x4){lg[4], lg[5], lg[6], lg[7]}; }
                asm volatile("" ::: "memory"); }
          }
        }
    }
};
__device__ __forceinline__ float rstd_from_ss(const float* ss, int row) {
    const f32x4* p = (const f32x4*)(ss + (size_t)row * 16); const f32x4 a = p[0], b = p[1], c = p[2], d = p[3];
    const float t = ((a[0] + a[1]) + (a[2] + a[3])) + ((b[0] + b[1]) + (b[2] + b[3])) + ((c[0] + c[1]) + (c[2] + c[3])) + ((d[0] + d[1]) + (d[2] + d[3]));
    return __builtin_amdgcn_rsqf(t * (1.0f / DM) + EPS);
}
struct EpiSwiglu {
    static constexpr bool PERM = true, AFTER_DRAIN = false;
    bf16_t* O; int ldc; const LAS float* rsl; const float* rstd;
    __device__ __forceinline__ void operator()(const f32x4 (&acc)[2][2][4][2], const Unit& u, int wr, int wc, int fr, int fq) const {
        const int row0 = u.pm * BM + wr * 64 + fr, col0 = u.pn * HALF + wc * 32 + 8 * fq;
#pragma unroll
        for (int ai = 0; ai < 2; ++ai) {
            float rs[4];
#pragma unroll
            for (int m = 0; m < 4; ++m) { const int row = row0 + ai * HALF + m * 16; rs[m] = rsl ? rsl[256 * u.slot + wr * 64 + fr + ai * HALF + m * 16] : rstd[row]; }
            asm volatile("" ::: "memory");
#pragma unroll
            for (int m = 0; m < 4; ++m) { const int row = row0 + ai * HALF + m * 16;
                float h[8];
#pragma unroll
                for (int n = 0; n < 2; ++n)
#pragma unroll
                    for (int i = 0; i < 4; ++i) { const float gg = acc[ai][0][m][n][i] * rs[m], uu = acc[ai][1][m][n][i] * rs[m]; h[n * 4 + i] = siluf_(gg) * uu; }
                *(u32x4*)(O + (size_t)row * ldc + col0) = pack8(h); }
        }
    }
};
struct EpiQkv {
    static constexpr bool PERM = true, AFTER_DRAIN = false;
    bf16_t* O; const LAS float* rsl; const float* bias; const float* qn; const float* kn; const float* rope;
    __device__ __forceinline__ void operator()(const f32x4 (&acc)[2][2][4][2], const Unit& u, int wr, int wc, int fr, int fq) const {
        const int hd = u.pn * 4 + wc, row0 = u.pm * BM + wr * 64 + fr; const int kind = u.pn < 4 ? 0 : (u.pn == 4 ? 1 : 2);
        const float* nw = kind == 0 ? qn : kn;
        float bv[2][8], nv[2][8];
#pragma unroll
        for (int bj = 0; bj < 2; ++bj)
#pragma unroll
            for (int j = 0; j < 8; ++j) { bv[bj][j] = bias[hd * 64 + bj * 32 + fq * 8 + j]; nv[bj][j] = nw[bj * 32 + fq * 8 + j]; }
#pragma unroll
        for (int ai = 0; ai < 2; ++ai)
#pragma unroll
            for (int m = 0; m < 4; ++m) { const int row = row0 + ai * HALF + m * 16; const float rs = rsl[256 * u.slot + wr * 64 + fr + ai * HALF + m * 16];
                float v[2][8]; float s = 0.f;
#pragma unroll
                for (int bj = 0; bj < 2; ++bj)
#pragma unroll
                    for (int n = 0; n < 2; ++n)
#pragma unroll
                        for (int i = 0; i < 4; ++i) { const float x = acc[ai][bj][m][n][i] * rs + bv[bj][n * 4 + i]; v[bj][n * 4 + i] = x; s += x * x; }
                if (kind < 2) {
                    s += __shfl_xor(s, 16); s += __shfl_xor(s, 32);
                    const float r2 = __builtin_amdgcn_rsqf(s * (1.0f / 64.0f) + EPS);
#pragma unroll
                    for (int bj = 0; bj < 2; ++bj)
#pragma unroll
                        for (int j = 0; j < 8; ++j) v[bj][j] = v[bj][j] * r2 * nv[bj][j];
                    const f32x4* rp = (const f32x4*)(rope + (size_t)row * 16);
                    const f32x4 c0 = rp[0], c1 = rp[1], s0 = rp[2], s1 = rp[3];
#pragma unroll
                    for (int j = 0; j < 8; ++j) { const float other = __shfl_xor(v[0][j], 16); const float cc = j < 4 ? c0[j] : c1[j - 4], sn = j < 4 ? s0[j] : s1[j - 4];
                        const float mine = v[0][j]; const float rot = (fq == 0) ? (mine * cc - other * sn) : (mine * cc + other * sn);
                        v[0][j] = (fq < 2) ? rot : mine; }
                }
#pragma unroll
                for (int bj = 0; bj < 2; ++bj) *(u32x4*)(O + (size_t)row * 1536 + hd * 64 + bj * 32 + fq * 8) = pack8(v[bj]);
            }
    }
};
}

#define XB_TMO      128
#define XB_XCNT(j)  (256  + 64 * (j))
#define XB_XSUB(j)  (1280 + 64 * (j))
#define XB_XGEN(j)  (2304 + 64 * (j))
#define XB_TOP      3328
#define XB_TOPGEN   3392
#define XCD_BAR_WORDS 3456
#define XB_SPIN_CAP (1u << 20)
__device__ __forceinline__ unsigned xb_ld(unsigned* p)              { return __hip_atomic_load(p, __ATOMIC_RELAXED, __HIP_MEMORY_SCOPE_AGENT); }
__device__ __forceinline__ unsigned xb_add(unsigned* p, unsigned v) { return __hip_atomic_fetch_add(p, v, __ATOMIC_RELAXED, __HIP_MEMORY_SCOPE_AGENT); }
__device__ __forceinline__ unsigned xb_xcc_id() { return (unsigned)__builtin_amdgcn_s_getreg((3 << 11) | 20) & 0xFu; }
#define XB_SPIN(cond, bar) do { unsigned _sp = 0; while (cond) { __builtin_amdgcn_s_sleep(1); \
    if ((++_sp & 255u) == 0u) { if (xb_ld(&(bar)[XB_TMO])) break; if (_sp > XB_SPIN_CAP) { atomicAdd(&(bar)[XB_TMO], 1u); break; } } } } while (0)
struct XcdBarrier { unsigned* bar; unsigned x; volatile LAS unsigned* st; };
__device__ __forceinline__ XcdBarrier xcd_barrier_post(unsigned* bar, volatile LAS unsigned* st) {
    XcdBarrier b; b.bar = bar; b.x = xb_xcc_id(); b.st = st;
    if (threadIdx.x == 0) (void)xb_add(&bar[XB_XCNT(b.x)], 1u);
    return b;
}
__device__ __forceinline__ void xcd_barrier_complete(unsigned* bar, unsigned x, unsigned& nloc, unsigned& nx) {
    const unsigned G = gridDim.x * gridDim.y * gridDim.z;
    unsigned sum, cnt, mine, sp = 0u;
    for (;;) {
        sum = 0u; cnt = 0u; mine = 0u;
#pragma unroll
        for (unsigned j = 0; j < 16; ++j) { const unsigned c = xb_ld(&bar[XB_XCNT(j)]); sum += c; cnt += (c > 0u) ? 1u : 0u; mine = (j == x) ? c : mine; }
        if (sum == G) break;
        __builtin_amdgcn_s_sleep(1);
        if ((++sp & 255u) == 0u) { if (xb_ld(&bar[XB_TMO])) break; if (sp > XB_SPIN_CAP) { atomicAdd(&bar[XB_TMO], 1u); break; } }
    }
    nloc = mine > 0u ? mine : 1u; nx = cnt > 0u ? cnt : 1u;
}
__device__ __forceinline__ void xcd_barrier(const XcdBarrier& b) {
    asm volatile("s_waitcnt vmcnt(0)" ::: "memory");
    __syncthreads();
    if (threadIdx.x == 0) {
        unsigned* bar = b.bar;
        __builtin_amdgcn_s_waitcnt(0);
        unsigned nloc = b.st[0], nx = b.st[1];
        if (nloc == 0u) { xcd_barrier_complete(bar, b.x, nloc, nx); b.st[0] = nloc; b.st[1] = nx; }
        const unsigned old = xb_add(&bar[XB_XSUB(b.x)], 1u);
        const unsigned gen = old / nloc;
        if (old + 1u == (gen + 1u) * nloc) {
            __builtin_amdgcn_fence(__ATOMIC_RELEASE, "agent");
            asm volatile("s_waitcnt vmcnt(0)" ::: "memory");
            const unsigned og = xb_add(&bar[XB_TOP], 1u);
            const unsigned tg = og / nx;
            if (og + 1u == (tg + 1u) * nx) xb_add(&bar[XB_TOPGEN], 1u);
            else XB_SPIN(xb_ld(&bar[XB_TOPGEN]) == tg, bar);
            __builtin_amdgcn_fence(__ATOMIC_ACQUIRE, "agent");
            xb_add(&bar[XB_XGEN(b.x)], 1u);
            asm volatile("s_waitcnt vmcnt(0)" ::: "memory");
        } else {
            XB_SPIN(xb_ld(&bar[XB_XGEN(b.x)]) == gen, bar);
            __builtin_amdgcn_fence(__ATOMIC_ACQUIRE, "agent");
            asm volatile("s_waitcnt vmcnt(0)" ::: "memory");
        }
    }
    __syncthreads();
}

struct Args { const float* in[39]; const int* pos; float* out; unsigned char* ws; int ph_lo, ph_hi, variant, pad; };
enum InIdx { I_X = 0, I_NORM_MIX0 = 1, I_W_IN, I_MU, I_W0, I_WDEC, I_A0, I_WICL, I_WGAT, I_KK, I_KA, I_RK, I_GNW, I_GNB, I_CONVW, I_CONVB, I_DTB, I_ALOG, I_DSKIP, I_SSDN,
             I_WOUT, I_NORM_FFN0, I_FG, I_FU, I_FD, I_NORM_MIX1, I_WQKV, I_BQKV, I_QN, I_KN, I_SINK, I_WO, I_BO, I_NORM_FFN1, I_ROUTER, I_EG, I_EU, I_ED };

__device__ __forceinline__ void transpose_item(const float* W, int ld, int K, int k0, int n0, bf16_t* WT, int drow, LAS float* scr, int lane, const float* gk) {
    f32x4 v[8]; const int kr = lane >> 3, n4 = 4 * (lane & 7); const float* wp = W + (size_t)(k0 + kr) * ld + n0 + n4;
#pragma unroll
    for (int i = 0; i < 8; ++i) v[i] = *(const f32x4*)(wp + (size_t)(8 * i) * ld);
    if (gk) { const float* gp = gk + k0 + kr;
#pragma unroll
        for (int i = 0; i < 8; ++i) v[i] = v[i] * gp[8 * i]; }
#pragma unroll
    for (int i = 0; i < 8; ++i) { LAS float* sp = scr + (8 * i + kr) * 33 + n4; sp[0] = v[i][0]; sp[1] = v[i][1]; sp[2] = v[i][2]; sp[3] = v[i][3]; }
    asm volatile("s_waitcnt lgkmcnt(0)" ::: "memory");
    const int c = lane & 7;
#pragma unroll
    for (int j = 0; j < 4; ++j) { const int n = (lane >> 3) + 8 * j; const LAS float* s = scr + (8 * c) * 33 + n;
        u32x4 o; o.x = pk2(s[0 * 33], s[1 * 33]); o.y = pk2(s[2 * 33], s[3 * 33]); o.z = pk2(s[4 * 33], s[5 * 33]); o.w = pk2(s[6 * 33], s[7 * 33]);
        *(u32x4*)(WT + (size_t)(drow + n) * K + k0 + 8 * c) = o; }
    asm volatile("s_waitcnt lgkmcnt(0)" ::: "memory");
}
__device__ __forceinline__ int drow_of(int kind, int n0) {
    if (kind == 0) return n0;
    if (kind == 1) return 256 * (n0 >> 7) + (n0 & 127);
    if (kind == 2) return 256 * (n0 >> 7) + 128 + (n0 & 127);
    const int hd = n0 >> 6, bj = (n0 >> 5) & 1; return 256 * (hd >> 2) + 128 * bj + 32 * (hd & 3);
}
__device__ __forceinline__ bool transpose_matrix(int& it, const float* W, int ld, int K, int ncols, bf16_t* WT, int kind, LAS float* scr, int lane, const float* gk = nullptr) {
    const int nnb = ncols / 32, items = (K / 64) * nnb;
    if (it < items) { const int kb = it / nnb, nb = it % nnb; transpose_item(W, ld, K, 64 * kb, 32 * nb, WT, drow_of(kind, 32 * nb), scr, lane, gk); return true; }
    it -= items; return false;
}

__device__ __forceinline__ u32x4 conv8(const bf16_t* proj, size_t m, int tpos, int c, const float* cw, const float* cb) {
    const bf16_t* p = proj + m * NPROJ + 2304 + c; u32x4 raw[4];
#pragma unroll
    for (int k = 0; k < 4; ++k) raw[k] = *(const u32x4*)(p - (size_t)(tpos >= k ? k : 0) * NPROJ);
    float acc[8];
    { const f32x4 b0 = *(const f32x4*)(cb + c), b1 = *(const f32x4*)(cb + c + 4); acc[0] = b0[0]; acc[1] = b0[1]; acc[2] = b0[2]; acc[3] = b0[3]; acc[4] = b1[0]; acc[5] = b1[1]; acc[6] = b1[2]; acc[7] = b1[3]; }
#pragma unroll
    for (int k = 0; k < 4; ++k) { float x[8]; unpack8(raw[k], x); const float ok = tpos >= k ? 1.f : 0.f; const f32x4 w0 = *(const f32x4*)(cw + (3 - k) * 1024 + c), w1 = *(const f32x4*)(cw + (3 - k) * 1024 + c + 4);
        acc[0] += ok * w0[0] * x[0]; acc[1] += ok * w0[1] * x[1]; acc[2] += ok * w0[2] * x[2]; acc[3] += ok * w0[3] * x[3]; acc[4] += ok * w1[0] * x[4]; acc[5] += ok * w1[1] * x[5]; acc[6] += ok * w1[2] * x[6]; acc[7] += ok * w1[3] * x[7]; }
#pragma unroll
    for (int i = 0; i < 8; ++i) acc[i] = siluf_(acc[i]);
    return pack8(acc);
}
__device__ __forceinline__ u32x2 conv4(const bf16_t* proj, size_t m, int tpos, int c, const float* cw, const float* cb) {
    const bf16_t* p = proj + m * NPROJ + 2304 + c; u32x2 raw[4];
#pragma unroll
    for (int k = 0; k < 4; ++k) raw[k] = *(const u32x2*)(p - (size_t)(tpos >= k ? k : 0) * NPROJ);
    f32x4 acc = *(const f32x4*)(cb + c);
#pragma unroll
    for (int k = 0; k < 4; ++k) { const float ok = tpos >= k ? 1.f : 0.f; const f32x4 w0 = *(const f32x4*)(cw + (3 - k) * 1024 + c);
        acc[0] += ok * w0[0] * bflo(raw[k].x); acc[1] += ok * w0[1] * bfhi(raw[k].x); acc[2] += ok * w0[2] * bflo(raw[k].y); acc[3] += ok * w0[3] * bfhi(raw[k].y); }
    u32x2 o; o.x = pk2(siluf_(acc[0]), siluf_(acc[1])); o.y = pk2(siluf_(acc[2]), siluf_(acc[3])); return o;
}

#ifndef DUPM
#define DUPM 0u
#endif

#define XN ((bf16_t*)(ws + WS_XN))
#define MIX ((bf16_t*)(ws + WS_MIX))
#define PROJ ((bf16_t*)(ws + WS_PROJ))
#define GOUT ((bf16_t*)(ws + WS_GOUT))
#define XNB ((bf16_t*)(ws + WS_XNB))
#define HID ((bf16_t*)(ws + WS_HID))
#define QKV ((bf16_t*)(ws + WS_QKV))
#define ATTO ((bf16_t*)(ws + WS_ATTO))
#define AS ((bf16_t*)(ws + WS_AS))
#define HS ((bf16_t*)(ws + WS_HS))
#define SSTATE ((bf16_t*)(ws + 54 * MiB))
#define CHDEC ((float*)(ws + WS_TOPE))
#define DTSP ((float*)(ws + WS_DTSP))
#define KKR ((float*)(ws + WS_KKR))
#define ROPE ((float*)(ws + WS_ROPE))
#define SS ((float*)(ws + WS_SS))
#define TOPE ((int*)(ws + WS_TOPE))
#define RANK ((int*)(ws + WS_RANK))
#define TOPW ((float*)(ws + WS_TOPW))
#define POS ((int*)(ws + WS_POS))
#define RSTD4 ((float*)(ws + WS_RSTD4))
#define RSTDS ((float*)(ws + WS_RSTDS))
#define WDEC ((bf16_t*)(ws + WS_WDEC))
#define WICL ((bf16_t*)(ws + WS_WICL))
#define WGAT ((bf16_t*)(ws + WS_WGAT))
#define EGU ((bf16_t*)(ws + WS_EGU))
#define EDN ((bf16_t*)(ws + WS_EDN))
#define WIN ((bf16_t*)(ws + WS_WIN))
#define WOUT ((bf16_t*)(ws + WS_WOUT))
#define WGU ((bf16_t*)(ws + WS_WGU))
#define WDN ((bf16_t*)(ws + WS_WDN))
#define WQKV ((bf16_t*)(ws + WS_WQKV))
#define WO ((bf16_t*)(ws + WS_WO))
struct TDesc { const float* src; bf16_t* dst; const float* gk; int ld, K; };
__device__ __forceinline__ void tdesc(TDesc& d, int it, const float* W, int ld, int K, int ncols, bf16_t* WT, int kind, const float* gk) {
    const int nnb = ncols / 32, kb = it / nnb, nb = it % nnb;
    d.src = W + (size_t)(64 * kb) * ld + 32 * nb; d.dst = WT + (size_t)drow_of(kind, 32 * nb) * K + 64 * kb; d.gk = gk ? gk + 64 * kb : nullptr; d.ld = ld; d.K = K;
}
constexpr int CV_P0 = 1728, CV_NE = CV_P0 + 6016, CV_EGU = CV_NE + 16 * 704, CV_END = CV_EGU + 8 * 704;
__device__ __forceinline__ void conv_resolve(const float* const* in, unsigned char* ws, int id, TDesc& d) {
    if (id < 1664) { tdesc(d, id, in[I_W_IN], IN0, DM, NPROJ, (bf16_t*)(ws + WS_WIN), 0, nullptr); return; } id -= 1664;
    if (id < 16) { tdesc(d, id, in[I_WDEC], 512, 64, 512, (bf16_t*)(ws + WS_WDEC), 0, nullptr); return; } id -= 16;
    if (id < 16) { tdesc(d, id, in[I_WICL], 512, 64, 512, (bf16_t*)(ws + WS_WICL), 0, nullptr); return; } id -= 16;
    if (id < 32) { tdesc(d, id, in[I_WGAT], 512, 128, 512, (bf16_t*)(ws + WS_WGAT), 0, nullptr); return; } id -= 32;
    if (id < 512) { tdesc(d, id, in[I_WOUT], DM, DM, DM, (bf16_t*)(ws + WS_WOUT), 0, nullptr); return; } id -= 512;
    if (id < 1408) { tdesc(d, id, in[I_FG], FFN, DM, FFN, (bf16_t*)(ws + WS_WGU), 1, in[I_NORM_FFN0]); return; } id -= 1408;
    if (id < 1408) { tdesc(d, id, in[I_FU], FFN, DM, FFN, (bf16_t*)(ws + WS_WGU), 2, in[I_NORM_FFN0]); return; } id -= 1408;
    if (id < 1408) { tdesc(d, id, in[I_FD], DM, FFN, DM, (bf16_t*)(ws + WS_WDN), 0, nullptr); return; } id -= 1408;
    if (id < 768) { tdesc(d, id, in[I_WQKV], 1536, DM, 1536, (bf16_t*)(ws + WS_WQKV), 3, in[I_NORM_MIX1]); return; } id -= 768;
    if (id < 512) { tdesc(d, id, in[I_WO], DM, DM, DM, (bf16_t*)(ws + WS_WO), 0, nullptr); return; } id -= 512;
    if (id < 16 * 704) { const int e = id / 1408, r = id % 1408, up = r / 704;
        tdesc(d, r % 704, in[up ? I_EU : I_EG] + (size_t)e * DM * FE, FE, DM, FE, (bf16_t*)(ws + WS_EGU) + (size_t)e * 2 * FE * DM, 1 + up, in[I_NORM_FFN1]); return; } id -= 16 * 704;
    { const int e = id / 704; tdesc(d, id % 704, in[I_ED] + (size_t)e * FE * DM, DM, FE, DM, (bf16_t*)(ws + WS_EDN) + (size_t)e * DM * FE, 0, nullptr); }
}
__device__ __forceinline__ void conv_load(const TDesc& d, f32x4 (&v)[8], int lane) {
    const float* wp = d.src + (size_t)(lane >> 3) * d.ld + 4 * (lane & 7);
#pragma unroll
    for (int i = 0; i < 8; ++i) v[i] = *(const f32x4*)(wp + (size_t)(8 * i) * d.ld);
}
__device__ __forceinline__ void conv_finish(const TDesc& d, f32x4 (&v)[8], LAS float* scr, int lane) {
    const int kr = lane >> 3, n4 = 4 * (lane & 7);
    if (d.gk) {
#pragma unroll
        for (int i = 0; i < 8; ++i) v[i] = v[i] * d.gk[kr + 8 * i]; }
#pragma unroll
    for (int i = 0; i < 8; ++i) { LAS float* sp = scr + (8 * i + kr) * 33 + n4; sp[0] = v[i][0]; sp[1] = v[i][1]; sp[2] = v[i][2]; sp[3] = v[i][3]; }
    asm volatile("s_waitcnt lgkmcnt(0)" ::: "memory");
    const int c = lane & 7;
#pragma unroll
    for (int j = 0; j < 4; ++j) { const int n = (lane >> 3) + 8 * j; const LAS float* s = scr + (8 * c) * 33 + n;
        u32x4 o; o.x = pk2(s[0 * 33], s[1 * 33]); o.y = pk2(s[2 * 33], s[3 * 33]); o.z = pk2(s[4 * 33], s[5 * 33]); o.w = pk2(s[6 * 33], s[7 * 33]);
        *(u32x4*)(d.dst + (size_t)n * d.K + 8 * c) = o; }
    asm volatile("s_waitcnt lgkmcnt(0)" ::: "memory");
}
__device__ __forceinline__ void conv_range(const float* const* in, unsigned char* ws, int lo, int hi, int first, int stride, LAS float* scr, int lane) {
    int id = lo + first; if (id >= hi) return;
    TDesc cur; conv_resolve(in, ws, id, cur); f32x4 v[8]; conv_load(cur, v, lane);
    for (;;) {
        const int idn = id + stride; const bool hn = idn < hi; TDesc nx = cur; f32x4 w[8];
        if (hn) { conv_resolve(in, ws, idn, nx); conv_load(nx, w, lane); }
        conv_finish(cur, v, scr, lane);
        if (!hn) break;
        cur = nx; id = idn;
#pragma unroll
        for (int i = 0; i < 8; ++i) v[i] = w[i];
    }
}

__global__ void __launch_bounds__(512, 2) fwd_kernel(Args args) {
    extern __shared__ __attribute__((aligned(16))) unsigned char lds_raw[];
    LAS unsigned char* lds = (LAS unsigned char*)lds_raw;
    volatile LAS unsigned* MISC = (volatile LAS unsigned*)(lds + MISC_OFF);
    const int tid = threadIdx.x, lane = tid & 63, wave = __builtin_amdgcn_readfirstlane(tid >> 6);
    const int G = gridDim.x, bx = blockIdx.x;
    const int vcu = (G % 8 == 0) ? (bx % 8) * (G / 8) + bx / 8 : bx;
    unsigned char* ws = args.ws;
    unsigned* ctl = (unsigned*)(ws + WS_CTL);
    float* dout = args.out;
    if (tid < 32) ((LAS unsigned*)(lds + MISC_OFF))[tid] = 0u;
    __syncthreads();
    XcdBarrier bar = xcd_barrier_post(ctl + CW_BAR, MISC + 8);
    const int lo = args.ph_lo, hi = args.ph_hi;
#define IN(k) (lo <= (k) && (k) < hi)
#if DUPM
#define PHASE(k) for (int rep_ = 0; rep_ <= (int)((DUPM >> (k)) & 1u); ++rep_) if (IN(k))
#define REPBAR if (rep_) xcd_barrier(bar);
#else
#define PHASE(k) if (IN(k))
#define REPBAR
#endif
#define SEAM(k) do { if (IN(k) && IN((k) + 1)) xcd_barrier(bar); } while (0)
    const int gw = vcu * 8 + wave, NGW = G * 8;

    unsigned* CNT = ctl + CW_CNT;

    PHASE(0) { REPBAR
        conv_range(args.in, ws, 0, CV_P0, gw, NGW, (LAS float*)(lds + wave * 16384), lane);
        __syncthreads();
        LAS float* w8 = (LAS float*)lds;
        for (int r = tid; r < DM; r += 512) { const float* p = args.in[I_W_IN] + (size_t)r * IN0 + NPROJ; *(LAS f32x4*)(w8 + r * 8) = *(const f32x4*)p; *(LAS f32x4*)(w8 + r * 8 + 4) = *(const f32x4*)(p + 4); }
        __syncthreads();
        const float* gm = args.in[I_NORM_MIX0];
#pragma unroll 1
        for (int k0 = 0; k0 < MTOK / NGW; k0 += 4) {
          f32x4 vv[4][4];
#pragma unroll
          for (int q = 0; q < 4; ++q) { const f32x4* xr = (const f32x4*)(args.in[I_X] + (size_t)(gw + (k0 + q) * NGW) * DM) + lane;
#pragma unroll
              for (int j = 0; j < 4; ++j) vv[q][j] = xr[64 * j]; }
#pragma unroll
          for (int q = 0; q < 4; ++q) { const int m = gw + (k0 + q) * NGW;
            f32x4 v[4]; float s = 0.f;
#pragma unroll
            for (int j = 0; j < 4; ++j) { v[j] = vv[q][j]; s += (v[j][0] * v[j][0] + v[j][1] * v[j][1]) + (v[j][2] * v[j][2] + v[j][3] * v[j][3]); }
            const float rstd = __builtin_amdgcn_rsqf(wave_sum(s) * (1.0f / DM) + EPS);
            float d[8];
#pragma unroll
            for (int k = 0; k < 8; ++k) d[k] = 0.f;
            unsigned long long* o8 = (unsigned long long*)(XN + (size_t)m * DM) + lane;
#pragma unroll
            for (int j = 0; j < 4; ++j) { const f32x4 g4 = ((const f32x4*)gm)[64 * j + lane]; const f32x4 y = v[j] * rstd * g4;
                o8[64 * j] = (unsigned long long)pk2(y[0], y[1]) | ((unsigned long long)pk2(y[2], y[3]) << 32);
#pragma unroll
                for (int i = 0; i < 4; ++i) { const int c = 256 * j + 4 * lane + i; const f32x4 wa = *(const LAS f32x4*)(w8 + c * 8), wb = *(const LAS f32x4*)(w8 + c * 8 + 4);
                    d[0] += y[i] * wa[0]; d[1] += y[i] * wa[1]; d[2] += y[i] * wa[2]; d[3] += y[i] * wa[3]; d[4] += y[i] * wb[0]; d[5] += y[i] * wb[1]; d[6] += y[i] * wb[2]; d[7] += y[i] * wb[3]; } }
            wave_sum8(d);
            if (lane < 8) { float dv = d[0];
#pragma unroll
                for (int k = 1; k < 8; ++k) dv = (lane == k) ? d[k] : dv;
                const float z = dv + args.in[I_DTB][lane]; DTSP[(size_t)m * 8 + lane] = z > 20.f ? z : log1pf(__expf(z)); }
            if (lane >= 16 && lane < 24) { const int j = lane - 16; const float inv = expf(-(float)j * (0.125f * 13.122363377404328f)); const float ang = (float)args.pos[m] * inv;
                float sn, cs; sincosf(ang, &sn, &cs); ROPE[(size_t)m * 16 + j] = cs; ROPE[(size_t)m * 16 + 8 + j] = sn; }
          }
        }
        __syncthreads();
    }
    SEAM(0);

    PHASE(1) { REPBAR
        pg8::Gemm g{XN, WIN, MTOK, NPROJ, DM}; pg8::StaticOrder S; S.init(MTOK, NPROJ, G, bx);
        pg8::EpiBf16 E{PROJ, NPROJ};
        pg8::gemm_phase(lds, g, S, E);
        if (bx >= 64) {
            conv_range(args.in, ws, CV_P0, CV_NE + 8 * 704, (bx - 64) * 8 + wave, 192 * 8, (LAS float*)(lds + wave * 16384), lane);
        }
    }
    SEAM(1);

#define LANE_CONSTS const int r32 = lane & 31, hh = lane >> 5, trq = (lane & 15) >> 2, trc = 16 * ((lane >> 4) & 1) + 4 * (lane & 3)
#define TRF(M, P, s, blk) ({ const LAS bf16_t* p_ = (M) + (16 * (s) + 8 * hh + trq) * (P) + 32 * (blk) + trc; \
        const s16x4 lo_ = __builtin_bit_cast(s16x4, __builtin_amdgcn_ds_read_tr16_b64_v4i16((LAS s16x4*)p_)); \
        const s16x4 hi_ = __builtin_bit_cast(s16x4, __builtin_amdgcn_ds_read_tr16_b64_v4i16((LAS s16x4*)(p_ + 4 * (P)))); \
        (bf16x8){lo_[0], lo_[1], lo_[2], lo_[3], hi_[0], hi_[1], hi_[2], hi_[3]}; })
#define NATF(M, P, s, blk) (*(const LAS bf16x8*)((M) + (32 * (blk) + r32) * (P) + 16 * (s) + 8 * hh))
    PHASE(2) { REPBAR
        LANE_CONSTS;
        const float* mu = args.in[I_MU];
        LAS bf16_t* Aw = (LAS bf16_t*)lds; LAS bf16_t* Aa = (LAS bf16_t*)(lds + 9216); LAS bf16_t* Ag = (LAS bf16_t*)(lds + 18432);
        LAS float* LW = (LAS float*)(lds + 35840); LAS float* IC = LW + 4096;
        LAS bf16_t* At = (LAS bf16_t*)(lds + 68864); LAS bf16_t* Kt = At + 4608; LAS bf16_t* Bt = Kt + 4608; LAS bf16_t* Rt = Bt + 4608; LAS bf16_t* Vt = Rt + 4608;
        LAS bf16_t* Lab = (LAS bf16_t*)(lds + 35840);
        LAS bf16_t* XX = At;
        LAS bf16_t* Lak = (LAS bf16_t*)(lds + 114944); LAS bf16_t* Mrk = Lak + 4608; LAS bf16_t* Mrb = Mrk + 4608;
        LAS float* TOT = (LAS float*)(lds + 142592); LAS float* GAMC = TOT + 512;
        const int mt = (wave >> 1) & 1, nt = wave & 1, grp = wave >> 2;
        for (int unit = vcu; unit < MTOK / 64; unit += G) {
            const int m0 = unit * 64;
            {
                const int tt = tid >> 3, cg = tid & 7, m = m0 + tt; const bool hasprev = (m & (SEQ - 1)) != 0;
                const bf16_t* pc = PROJ + (size_t)m * NPROJ + 1536 + 32 * cg;
#pragma unroll 1
                for (int q = 0; q < 4; ++q) {
                    float c[8], p[8]; unpack8(*(const u32x4*)(pc + 8 * q), c);
                    if (hasprev) unpack8(*(const u32x4*)(pc - NPROJ + 8 * q), p); else { for (int i = 0; i < 8; ++i) p[i] = 0.f; }
                    float o[8];
#pragma unroll
                    for (int i = 0; i < 8; ++i) { const int col = 32 * cg + 8 * q + i; const float x = c[i] + (p[i] - c[i]) * mu[1536 + col];
                        o[i] = cg < 2 ? tanhf(x) : (cg < 4 ? x : sigmoidf_(x)); }
                    const u32x4 w = pack8(o); const int col0 = 32 * cg + 8 * q;
                    if (cg < 2) *(LAS u32x4*)(Aw + tt * 72 + col0) = w; else if (cg < 4) *(LAS u32x4*)(Aa + tt * 72 + (col0 - 64)) = w; else *(LAS u32x4*)(Ag + tt * 136 + (col0 - 128)) = w;
                }
            }
            LBAR();
#pragma unroll 1
            for (int h = 0; h < 8; ++h) {
                unsigned char* cs = (unsigned char*)dout + (size_t)(unit * 8 + h) * 24576;
                float r0v[8], k0v[8], v0v[8]; float pr = 0.f, pk = 0.f, pv = 0.f;
                {   const bf16_t* pp = PROJ + (size_t)(m0 + 8 * wave) * NPROJ + 64 * h + lane;
                    if (((m0 + 8 * wave) & (SEQ - 1)) != 0) { pr = bflo(pp[-NPROJ]); pk = bflo(pp[-NPROJ + 512]); pv = bflo(pp[-NPROJ + 1024]); }
#pragma unroll
                    for (int i = 0; i < 8; ++i) { r0v[i] = bflo(pp[(size_t)i * NPROJ]); k0v[i] = bflo(pp[(size_t)i * NPROJ + 512]); v0v[i] = bflo(pp[(size_t)i * NPROJ + 1024]); } }
                if (grp == 0) {
                    f32x16 ad, ai;
#pragma unroll
                    for (int r = 0; r < 16; ++r) { ad[r] = 0.f; ai[r] = 0.f; }
#pragma unroll
                    for (int s = 0; s < 4; ++s) {
                        const bf16x8 bd = *(const bf16x8*)(WDEC + (size_t)(64 * h + 32 * nt + r32) * 64 + 16 * s + 8 * hh), bi = *(const bf16x8*)(WICL + (size_t)(64 * h + 32 * nt + r32) * 64 + 16 * s + 8 * hh);
                        ad = __builtin_amdgcn_mfma_f32_32x32x16_bf16(NATF(Aw, 72, s, mt), bd, ad, 0, 0, 0);
                        ai = __builtin_amdgcn_mfma_f32_32x32x16_bf16(NATF(Aa, 72, s, mt), bi, ai, 0, 0, 0);
                    }
                    const int c = 32 * nt + r32; const float w0c = args.in[I_W0][64 * h + c], a0c = args.in[I_A0][64 * h + c];
                    LAS float* lwb = LW + (32 * mt + 4 * hh) * 64 + c;
#pragma unroll
                    for (int r = 0; r < 16; ++r) { lwb[crc(r) * 64] = -0.6065306597126334f * sigmoidf_(ad[r] + w0c); lwb[4096 + crc(r) * 64] = sigmoidf_(ai[r] + a0c); }
                } else {
                    f32x16 ag;
#pragma unroll
                    for (int r = 0; r < 16; ++r) ag[r] = 0.f;
#pragma unroll
                    for (int s = 0; s < 8; ++s) {
                        const bf16x8 bg = *(const bf16x8*)(WGAT + (size_t)(64 * h + 32 * nt + r32) * 128 + 16 * s + 8 * hh);
                        ag = __builtin_amdgcn_mfma_f32_32x32x16_bf16(NATF(Ag, 136, s, mt), bg, ag, 0, 0, 0);
                    }
                    bf16_t* gob = GOUT + (size_t)(m0 + 32 * mt + 4 * hh) * 512 + 64 * h + 32 * nt + r32;
#pragma unroll
                    for (int r = 0; r < 16; ++r) gob[crc(r) * 512] = (bf16_t)f2bf(ag[r]);
                }
                LBAR();
                {
                    const int c = lane, gc = 64 * h + c, t0 = 8 * wave;
                    const float mur = mu[gc], muk = mu[512 + gc], muv = mu[1024 + gc], kkc = args.in[I_KK][gc], kac = args.in[I_KA][gc], rkc = args.in[I_RK][gc];
                    float rr[8], kx[8], vv[8], an[8], bn[8], lw[8], cl[8]; float run = 0.f;
#pragma unroll
                    for (int i = 0; i < 8; ++i) {
                        const float r0 = r0v[i], k0 = k0v[i], v0 = v0v[i];
                        rr[i] = r0 + (pr - r0) * mur; const float kl = k0 + (pk - k0) * muk; vv[i] = v0 + (pv - v0) * muv; pr = r0; pk = k0; pv = v0;
                        const float ic = IC[(t0 + i) * 64 + c]; lw[i] = LW[(t0 + i) * 64 + c]; run += lw[i]; cl[i] = run;
                        const float xk = kl * kkc; const float ssq = dpp_sum63(xk * xk); const float kn = xk * __builtin_amdgcn_rsqf(ssq + 1e-12f);
                        an[i] = -kn; bn[i] = kn * ic; kx[i] = kl * (1.0f + (ic - 1.0f) * kac);
                        const float bon = dpp_sum63(rr[i] * kx[i] * rkc);
                        if (lane == 0) KKR[(size_t)(m0 + t0 + i) * 8 + h] = bon;
                    }
                    TOT[wave * 64 + c] = run;
                    LBAR();
                    float off = 0.f, totc = 0.f;
#pragma unroll
                    for (int w2 = 0; w2 < 8; ++w2) { const float tv = TOT[w2 * 64 + c]; totc += tv; off += (w2 < wave) ? tv : 0.f; }
                    if (wave == 0) GAMC[c] = __expf(totc);
#pragma unroll
                    for (int i = 0; i < 8; ++i) { const float cum = off + cl[i]; const float en = __expf(-cum), ep = __expf(cum), em = __expf(cum - lw[i]); const int o = (t0 + i) * 72 + c;
                        At[o] = (bf16_t)f2bf(an[i] * em); Kt[o] = (bf16_t)f2bf(kx[i] * en); Bt[o] = (bf16_t)f2bf(bn[i] * en); Rt[o] = (bf16_t)f2bf(rr[i] * ep); Vt[o] = (bf16_t)f2bf(vv[i]); }
                }
                LBAR();
                {
                    f32x16 pb, pk2_;
#pragma unroll
                    for (int r = 0; r < 16; ++r) { pb[r] = 0.f; pk2_[r] = 0.f; }
                    const LAS bf16_t* Aop = grp == 0 ? At : Rt;
#pragma unroll
                    for (int s = 0; s < 4; ++s) { const bf16x8 a = NATF(Aop, 72, s, mt);
                        pb = __builtin_amdgcn_mfma_f32_32x32x16_bf16(a, NATF(Bt, 72, s, nt), pb, 0, 0, 0);
                        pk2_ = __builtin_amdgcn_mfma_f32_32x32x16_bf16(a, NATF(Kt, 72, s, nt), pk2_, 0, 0, 0); }
                    const int sc = 32 * nt + r32, tb = 32 * mt + 4 * hh;
                    LAS bf16_t* o1 = (grp == 0 ? Lab : Mrb) + tb * 72 + sc; LAS bf16_t* o2 = (grp == 0 ? Lak : Mrk) + tb * 72 + sc;
#pragma unroll
                    for (int r = 0; r < 16; ++r) { const int t = tb + crc(r); const bool keep = grp == 0 ? (sc < t) : (sc <= t);
                        o1[crc(r) * 72] = (bf16_t)f2bf(keep ? pb[r] : 0.f); o2[crc(r) * 72] = (bf16_t)f2bf(keep ? pk2_[r] : 0.f); }
                }
                LBAR();
                f32x16 accA, accB;
#pragma unroll
                for (int r = 0; r < 16; ++r) { accA[r] = 0.f; accB[r] = 0.f; }
                {
                    const LAS bf16_t* Aop = grp == 0 ? Lak : Mrk;
#pragma unroll
                    for (int s = 0; s < 4; ++s) { const bf16x8 vb = TRF(Vt, 72, s, nt);
                        if (grp == 0) { accA = __builtin_amdgcn_mfma_f32_32x32x16_bf16(NATF(Aop, 72, s, mt), vb, accA, 0, 0, 0); accB = __builtin_amdgcn_mfma_f32_32x32x16_bf16(TRF(Kt, 72, s, mt), vb, accB, 0, 0, 0); }
                        else accB = __builtin_amdgcn_mfma_f32_32x32x16_bf16(NATF(Aop, 72, s, mt), vb, accB, 0, 0, 0); }
                    if (grp == 0) { LAS float* ggb = IC + (32 * mt + 4 * hh) * 65 + 32 * nt + r32;
#pragma unroll
                        for (int r = 0; r < 16; ++r) ggb[crc(r) * 65] = accA[r]; }
                }
                LBAR();
                {
                    const int n16 = lane & 15, g4 = lane >> 4;
                    f32x4 Rr[4];
                    if (wave < 4) {
#pragma unroll
                        for (int I = 0; I < 4; ++I)
#pragma unroll
                            for (int j = 0; j < 4; ++j) Rr[I][j] = bflo((unsigned)At[(16 * I + 4 * g4 + j) * 72 + 16 * wave + n16]);
                    } else { const LAS float* GG = IC;
#pragma unroll
                        for (int I = 0; I < 4; ++I)
#pragma unroll
                            for (int j = 0; j < 4; ++j) Rr[I][j] = GG[(16 * I + 4 * g4 + j) * 65 + 16 * (wave - 4) + n16];
                    }
                    LBAR();
                    const LAS bf16_t* lrow = Lab + n16 * 72 + 4 * g4;
#define LF(I, J) (*(const LAS u32x2*)(lrow + (16 * (I)) * 72 + 16 * (J)))
#define MF16(A0, A1, B0, B1, C) __builtin_amdgcn_mfma_f32_16x16x32_bf16(__builtin_bit_cast(bf16x8, (u32x4){(A0).x, (A0).y, (A1).x, (A1).y}), __builtin_bit_cast(bf16x8, (u32x4){(B0).x, (B0).y, (B1).x, (B1).y}), (C), 0, 0, 0)
                    const u32x2 zz = (u32x2){0u, 0u};
                    u32x2 Xb[4];
#pragma unroll
                    for (int I = 0; I < 4; ++I) {
                        f32x4 Z = Rr[I];
                        if (I == 1) Z = MF16(LF(1, 0), zz, Xb[0], zz, Z);
                        if (I == 2) Z = MF16(LF(2, 0), LF(2, 1), Xb[0], Xb[1], Z);
                        if (I == 3) { Z = MF16(LF(3, 0), LF(3, 1), Xb[0], Xb[1], Z); Z = MF16(LF(3, 2), zz, Xb[2], zz, Z); }
                        const u32x2 ld = LF(I, I);
                        f32x4 X = Z;
#pragma unroll
                        for (int it = 0; it < 15; ++it) { u32x2 xb; xb.x = pk2(X[0], X[1]); xb.y = pk2(X[2], X[3]); X = MF16(ld, zz, xb, zz, Z); }
                        Xb[I].x = pk2(X[0], X[1]); Xb[I].y = pk2(X[2], X[3]);
                        LAS bf16_t* xo = XX + (16 * I + 4 * g4) * 136 + 16 * wave + n16;
                        xo[0] = (bf16_t)(Xb[I].x & 0xffffu); xo[136] = (bf16_t)(Xb[I].x >> 16); xo[272] = (bf16_t)(Xb[I].y & 0xffffu); xo[408] = (bf16_t)(Xb[I].y >> 16);
                    }
#undef LF
#undef MF16
                }
                LBAR();
                {
                    f32x16 acc1;
#pragma unroll
                    for (int r = 0; r < 16; ++r) acc1[r] = 0.f;
#pragma unroll
                    for (int s = 0; s < 4; ++s) {
                        const bf16x8 a = grp == 0 ? TRF(Bt, 72, s, mt) : NATF(Mrb, 72, s, mt);
                        acc1 = __builtin_amdgcn_mfma_f32_32x32x16_bf16(a, TRF(XX, 136, s, nt), acc1, 0, 0, 0);
                        accB = __builtin_amdgcn_mfma_f32_32x32x16_bf16(a, TRF(XX + 64, 136, s, nt), accB, 0, 0, 0);
                    }
                    const int col = 32 * nt + r32, rb = 32 * mt + 4 * hh;
                    if (grp == 0) {
                        bf16_t* acb = (bf16_t*)cs + rb * 64 + col; bf16_t* dcb = (bf16_t*)(cs + 8192) + col * 64 + rb; const LAS float* gb = GAMC + rb;
#pragma unroll
                        for (int r = 0; r < 16; ++r) { const float gcv = gb[crc(r)]; acb[crc(r) * 64] = (bf16_t)f2bf(gcv * (acc1[r] + ((rb + crc(r)) == col ? 1.0f : 0.0f))); }
#pragma unroll
                        for (int rq = 0; rq < 4; ++rq) { const f32x4 g4 = *(const LAS f32x4*)(gb + 8 * rq);
                            u32x2 w; w.x = pk2(accB[4 * rq] * g4[0], accB[4 * rq + 1] * g4[1]); w.y = pk2(accB[4 * rq + 2] * g4[2], accB[4 * rq + 3] * g4[3]); *(u32x2*)(dcb + 8 * rq) = w; }
                    } else {
                        bf16_t* rpb = (bf16_t*)(cs + 16384) + rb * 64 + col; const LAS bf16_t* rtb = Rt + rb * 72 + col; bf16_t* yb = MIX + (size_t)(m0 + rb) * DM + 64 * h + col;
#pragma unroll
                        for (int r = 0; r < 16; ++r) { rpb[crc(r) * 64] = (bf16_t)f2bf(acc1[r] + bflo((unsigned)rtb[crc(r) * 72])); yb[crc(r) * DM] = (bf16_t)f2bf(accB[r]); }
                    }
                }
                LBAR();
            }
        }
    }

    SEAM(2);

    PHASE(3) { REPBAR
        LANE_CONSTS;
        if (vcu < 32) {
            const int b = vcu >> 3, h = vcu & 7;
            const unsigned char* cbase = (const unsigned char*)dout + (size_t)(b * 64 * 8 + h) * 24576;
            constexpr size_t CSTR = (size_t)8 * 24576; constexpr int SLOT = 27648;
            const bool loader = wave >= 2; const int lt = tid - 128;
            int poff[4];
#pragma unroll
            for (int k = 0; k < 4; ++k) { const int p = lt + 384 * k; poff[k] = (p >> 9) * 9216 + ((p & 511) >> 3) * 144 + (p & 7) * 16; }
            u32x4 st[4][4];
#define RB_ISSUE(set, ch) do { if (loader) { const unsigned char* g_ = cbase + (size_t)(ch) * CSTR + (size_t)lt * 16; _Pragma("unroll") for (int k = 0; k < 4; ++k) st[set][k] = *(const u32x4*)(g_ + k * 6144); } } while (0)
#define RB_WRITE(set, ch) do { if (loader) { LAS unsigned char* s_ = lds + ((ch) & 3) * SLOT; _Pragma("unroll") for (int k = 0; k < 4; ++k) *(LAS u32x4*)(s_ + poff[k]) = st[set][k]; } } while (0)
            RB_ISSUE(0, 0); RB_ISSUE(1, 1); RB_WRITE(0, 0); RB_WRITE(1, 1);
            RB_ISSUE(2, 2); RB_ISSUE(3, 3); RB_ISSUE(0, 4); RB_ISSUE(1, 5);
            LBAR();
            f32x16 H[2];
#pragma unroll
            for (int r = 0; r < 16; ++r) { H[0][r] = 0.f; H[1][r] = 0.f; }
            bf16_t* zp = (bf16_t*)((unsigned char*)dout + 48 * MiB) + (size_t)(b * SEQ + 4 * hh) * 512 + 64 * h + 32 * wave + r32;
#define RB_STEP(j, chv) do { const int ch_ = (chv); \
                if (loader) { if (ch_ + 2 < 64) RB_WRITE(((j) + 2) & 3, ch_ + 2); if (ch_ + 6 < 64) RB_ISSUE(((j) + 2) & 3, ch_ + 6); } \
                else { const LAS unsigned char* sl = lds + (ch_ & 3) * SLOT; f32x16 Hn[2], Z[2]; bf16x8 Hb[4]; \
                    _Pragma("unroll") for (int s = 0; s < 4; ++s) { const int m = s >> 1, o = 8 * (s & 1); u32x4 t; t.x = pk2(H[m][o], H[m][o + 1]); t.y = pk2(H[m][o + 2], H[m][o + 3]); t.z = pk2(H[m][o + 4], H[m][o + 5]); t.w = pk2(H[m][o + 6], H[m][o + 7]); Hb[s] = __builtin_bit_cast(bf16x8, t); } \
                    _Pragma("unroll") for (int m = 0; m < 2; ++m) { \
                        _Pragma("unroll") for (int rq = 0; rq < 4; ++rq) { const u32x2 d = *(const LAS u32x2*)(sl + 9216 + (32 * wave + r32) * 144 + (32 * m + 8 * rq + 4 * hh) * 2); \
                            Hn[m][4 * rq] = bflo(d.x); Hn[m][4 * rq + 1] = bfhi(d.x); Hn[m][4 * rq + 2] = bflo(d.y); Hn[m][4 * rq + 3] = bfhi(d.y); } \
                        _Pragma("unroll") for (int r = 0; r < 16; ++r) Z[m][r] = 0.f; } \
                    _Pragma("unroll") for (int s = 0; s < 4; ++s) \
                        _Pragma("unroll") for (int m = 0; m < 2; ++m) { const int o = (32 * m + r32) * 144 + (16 * s + 4 * hh) * 2; \
                            const u32x2 a0 = *(const LAS u32x2*)(sl + o), a1 = *(const LAS u32x2*)(sl + o + 16), q0 = *(const LAS u32x2*)(sl + 18432 + o), q1 = *(const LAS u32x2*)(sl + 18432 + o + 16); \
                            u32x4 t; t.x = a0.x; t.y = a0.y; t.z = a1.x; t.w = a1.y; Hn[m] = __builtin_amdgcn_mfma_f32_32x32x16_bf16(__builtin_bit_cast(bf16x8, t), Hb[s], Hn[m], 0, 0, 0); \
                            t.x = q0.x; t.y = q0.y; t.z = q1.x; t.w = q1.y; Z[m] = __builtin_amdgcn_mfma_f32_32x32x16_bf16(__builtin_bit_cast(bf16x8, t), Hb[s], Z[m], 0, 0, 0); } \
                    H[0] = Hn[0]; H[1] = Hn[1]; \
                    bf16_t* zq = zp + (size_t)ch_ * 64 * 512; \
                    _Pragma("unroll") for (int m = 0; m < 2; ++m) _Pragma("unroll") for (int r = 0; r < 16; ++r) zq[(32 * m + crc(r)) * 512] = (bf16_t)f2bf(Z[m][r]); } \
                LBAR(); } while (0)
            if (wave < 2 || loader) {
                for (int ch = 0; ch < 64; ch += 4) { RB_STEP(0, ch); RB_STEP(1, ch + 1); RB_STEP(2, ch + 2); RB_STEP(3, ch + 3); }
            }
#undef RB_STEP
#undef RB_ISSUE
#undef RB_WRITE
        } else {
            LAS bf16_t* Bm = (LAS bf16_t*)lds; LAS bf16_t* Xh = (LAS bf16_t*)(lds + 34816); LAS float* CUM = (LAS float*)(lds + 53248); LAS float* DTL = CUM + 512;
            for (int unit = vcu - 32; unit < 256; unit += G - 32) {
                const int g = unit & 1, c = (unit >> 1) & 31, b = unit >> 6, m0 = b * SEQ + c * 128;
#pragma unroll 1
                for (int k = 0; k < 4; ++k) { const int p = tid + 512 * k, row = p >> 4, c16 = p & 15; *(LAS u32x4*)(Bm + row * 136 + 8 * c16) = conv8(PROJ, (size_t)(m0 + row), c * 128 + row, 512 + 128 * g + 8 * c16, args.in[I_CONVW], args.in[I_CONVB]); }
                if (wave < 4) { const int h = 4 * g + wave; const float a_h = -__expf(args.in[I_ALOG][h]);
                    const float v0 = DTSP[(size_t)(m0 + 2 * lane) * 8 + h], v1 = DTSP[(size_t)(m0 + 2 * lane + 1) * 8 + h]; float s = v0 + v1;
#pragma unroll
                    for (int o = 1; o < 64; o <<= 1) { const float t = __shfl_up(s, o); if (lane >= o) s += t; }
                    const float ex = s - (v0 + v1);
                    CUM[wave * 128 + 2 * lane] = a_h * (ex + v0); CUM[wave * 128 + 2 * lane + 1] = a_h * (ex + v0 + v1); DTL[wave * 128 + 2 * lane] = v0; DTL[wave * 128 + 2 * lane + 1] = v1; }
                LBAR();
#pragma unroll 1
                for (int hq = 0; hq < 4; ++hq) { const int h = 4 * g + hq;
                    { const int s = tid >> 2, cq = 16 * (tid & 3); const float sc = DTL[hq * 128 + s] * __expf(CUM[hq * 128 + 127] - CUM[hq * 128 + s]);
#pragma unroll 1
                      for (int q = 0; q < 2; ++q) { float f[8]; unpack8(conv8(PROJ, (size_t)(m0 + s), c * 128 + s, 64 * h + cq + 8 * q, args.in[I_CONVW], args.in[I_CONVB]), f);
#pragma unroll
                          for (int i = 0; i < 8; ++i) f[i] *= sc;
                          *(LAS u32x4*)(Xh + s * 72 + cq + 8 * q) = pack8(f); } }
                    LBAR();
                    const int mt = wave >> 2, nt = wave & 3; f32x16 acc;
#pragma unroll
                    for (int r = 0; r < 16; ++r) acc[r] = 0.f;
#pragma unroll
                    for (int ks = 0; ks < 8; ++ks) acc = __builtin_amdgcn_mfma_f32_32x32x16_bf16(TRF(Xh, 72, ks, mt), TRF(Bm, 136, ks, nt), acc, 0, 0, 0);
                    bf16_t* sp = SSTATE + ((size_t)((b * 32 + c) * 8 + h)) * 8192 + (32 * mt + 4 * hh) * 128 + 32 * nt + r32;
#pragma unroll
                    for (int r = 0; r < 16; ++r) sp[crc(r) * 128] = (bf16_t)f2bf(acc[r]);
                    if (tid == 0) CHDEC[(b * 32 + c) * 8 + h] = __expf(CUM[hq * 128 + 127]);
                    LBAR();
                }
            }
            conv_range(args.in, ws, CV_NE + 8 * 704, CV_EGU, (vcu - 32) * 8 + wave, (G - 32) * 8, (LAS float*)(lds + wave * 16384), lane);
        }
    }

    SEAM(3);

    PHASE(4) { REPBAR
        const int gt = vcu * 512 + tid, bh = gt >> 12, e2 = gt & 4095, b = bh >> 3, h = bh & 7;
        unsigned* sp = (unsigned*)SSTATE + ((size_t)(b * 32 * 8 + h)) * 4096 + e2;
        unsigned vals[32];
#pragma unroll
        for (int c = 0; c < 32; ++c) vals[c] = sp[(size_t)c * 8 * 4096];
        float r0 = 0.f, r1 = 0.f;
#pragma unroll
        for (int c = 0; c < 32; ++c) { const float dec = CHDEC[(b * 32 + c) * 8 + h]; sp[(size_t)c * 8 * 4096] = pk2(r0, r1); r0 = r0 * dec + bflo(vals[c]); r1 = r1 * dec + bfhi(vals[c]); }
    }
    SEAM(4);

    PHASE(5) { REPBAR
        LANE_CONSTS;
        {
            LAS bf16_t* Cm = (LAS bf16_t*)lds; LAS bf16_t* Bm = (LAS bf16_t*)(lds + 34816); LAS bf16_t* Xh = (LAS bf16_t*)(lds + 69632); LAS bf16_t* Hp = (LAS bf16_t*)(lds + 88064);
            LAS float* CUM = (LAS float*)(lds + 105472); LAS float* DTL = CUM + 512;
            for (int unit = vcu; unit < 256; unit += G) {
                const int g = unit & 1, c = (unit >> 1) & 31, b = unit >> 6, m0 = b * SEQ + c * 128;
#pragma unroll 1
                for (int k = 0; k < 4; ++k) { const int p = tid + 512 * k, row = p >> 4, c16 = p & 15;
                    *(LAS u32x4*)(Bm + row * 136 + 8 * c16) = conv8(PROJ, (size_t)(m0 + row), c * 128 + row, 512 + 128 * g + 8 * c16, args.in[I_CONVW], args.in[I_CONVB]);
                    *(LAS u32x4*)(Cm + row * 136 + 8 * c16) = conv8(PROJ, (size_t)(m0 + row), c * 128 + row, 768 + 128 * g + 8 * c16, args.in[I_CONVW], args.in[I_CONVB]); }
                if (wave < 4) { const int h = 4 * g + wave; const float a_h = -__expf(args.in[I_ALOG][h]);
                    const float v0 = DTSP[(size_t)(m0 + 2 * lane) * 8 + h], v1 = DTSP[(size_t)(m0 + 2 * lane + 1) * 8 + h]; float s = v0 + v1;
#pragma unroll
                    for (int o = 1; o < 64; o <<= 1) { const float t = __shfl_up(s, o); if (lane >= o) s += t; }
                    const float ex = s - (v0 + v1);
                    CUM[wave * 128 + 2 * lane] = a_h * (ex + v0); CUM[wave * 128 + 2 * lane + 1] = a_h * (ex + v0 + v1); DTL[wave * 128 + 2 * lane] = v0; DTL[wave * 128 + 2 * lane + 1] = v1; }
                LBAR();
                const int mt = wave >> 1, nb = 2 * (wave & 1), nt2 = wave & 1;
                f32x16 cb[2];
#pragma unroll
                for (int r = 0; r < 16; ++r) { cb[0][r] = 0.f; cb[1][r] = 0.f; }
#pragma unroll
                for (int ks = 0; ks < 8; ++ks) { const bf16x8 a = NATF(Cm, 136, ks, mt);
                    cb[0] = __builtin_amdgcn_mfma_f32_32x32x16_bf16(a, NATF(Bm, 136, ks, nb), cb[0], 0, 0, 0); cb[1] = __builtin_amdgcn_mfma_f32_32x32x16_bf16(a, NATF(Bm, 136, ks, nb + 1), cb[1], 0, 0, 0); }
                LBAR();
                LAS bf16_t* Wt = Bm;
#pragma unroll 1
                for (int hq = 0; hq < 4; ++hq) { const int h = 4 * g + hq;
                    u32x4 ph[2];
                    { const bf16_t* hp = SSTATE + ((size_t)((b * 32 + c) * 8 + h)) * 8192;
#pragma unroll
                      for (int k = 0; k < 2; ++k) { const int p = tid + 512 * k; ph[k] = *(const u32x4*)(hp + (p >> 4) * 128 + 8 * (p & 15)); } }
#pragma unroll
                    for (int j = 0; j < 2; ++j) { const int s = 32 * (nb + j) + r32; const float cs = CUM[hq * 128 + s], ds = DTL[hq * 128 + s]; const int lb = 32 * mt + 4 * hh;
                        LAS bf16_t* wp = Wt + lb * 136 + s; const LAS float* cl = CUM + hq * 128 + lb;
#pragma unroll
                        for (int r = 0; r < 16; ++r) { const float w = (s <= lb + crc(r)) ? cb[j][r] * __expf(cl[crc(r)] - cs) * ds : 0.f; wp[crc(r) * 136] = (bf16_t)f2bf(w); } }
                    { const int s = tid >> 2, cq = 16 * (tid & 3);
#pragma unroll 1
                      for (int q = 0; q < 2; ++q) *(LAS u32x4*)(Xh + s * 72 + cq + 8 * q) = conv8(PROJ, (size_t)(m0 + s), c * 128 + s, 64 * h + cq + 8 * q, args.in[I_CONVW], args.in[I_CONVB]); }
#pragma unroll
                    for (int k = 0; k < 2; ++k) { const int p = tid + 512 * k, row = p >> 4, c16 = p & 15; *(LAS u32x4*)(Hp + row * 136 + 8 * c16) = ph[k]; }
                    LBAR();
                    f32x16 yd, yo;
#pragma unroll
                    for (int r = 0; r < 16; ++r) { yd[r] = 0.f; yo[r] = 0.f; }
#pragma unroll
                    for (int ks = 0; ks < 8; ++ks) { yd = __builtin_amdgcn_mfma_f32_32x32x16_bf16(NATF(Wt, 136, ks, mt), TRF(Xh, 72, ks, nt2), yd, 0, 0, 0);
                        yo = __builtin_amdgcn_mfma_f32_32x32x16_bf16(NATF(Cm, 136, ks, mt), NATF(Hp, 136, ks, nt2), yo, 0, 0, 0); }
                    { const LAS float* cl = CUM + hq * 128 + 32 * mt + 4 * hh; bf16_t* yb = MIX + (size_t)(m0 + 32 * mt + 4 * hh) * DM + 512 + 256 * g + 64 * hq + 32 * nt2 + r32;
#pragma unroll
                      for (int r = 0; r < 16; ++r) yb[crc(r) * DM] = (bf16_t)f2bf(yd[r] + __expf(cl[crc(r)]) * yo[r]); }
                    LBAR();
                }
                __syncthreads();
                for (int i4 = 0; i4 < 16; i4 += 4) { const int ch = 256 * g + 4 * lane; const float dsk = args.in[I_DSKIP][4 * g + (lane >> 4)]; const f32x4 nw = *(const f32x4*)(args.in[I_SSDN] + ch);
                  u32x2 xv4[4], zv4[4];
#pragma unroll
                  for (int q = 0; q < 4; ++q) { const size_t m = (size_t)(m0 + wave * 16 + i4 + q); xv4[q] = conv4(PROJ, m, c * 128 + wave * 16 + i4 + q, ch, args.in[I_CONVW], args.in[I_CONVB]); zv4[q] = *(const u32x2*)(PROJ + m * NPROJ + 1792 + ch); }
#pragma unroll
                  for (int q = 0; q < 4; ++q) { const int l = wave * 16 + i4 + q; const size_t m = (size_t)(m0 + l);
                    const u32x2 yv = *(const u32x2*)(MIX + m * DM + 512 + ch), xv = xv4[q], zv = zv4[q];
                    float v[4] = {bflo(yv.x), bfhi(yv.x), bflo(yv.y), bfhi(yv.y)}; const float xs[4] = {bflo(xv.x), bfhi(xv.x), bflo(xv.y), bfhi(xv.y)}, zz[4] = {bflo(zv.x), bfhi(zv.x), bflo(zv.y), bfhi(zv.y)};
                    float qs = 0.f;
#pragma unroll
                    for (int j = 0; j < 4; ++j) { v[j] = (v[j] + dsk * xs[j]) * siluf_(zz[j]); qs += v[j] * v[j]; }
                    qs = wave_sum(qs); const float rq = __builtin_amdgcn_rsqf(qs * (1.0f / 256.0f) + EPS);
                    u32x2 o; o.x = pk2(v[0] * rq * nw[0], v[1] * rq * nw[1]); o.y = pk2(v[2] * rq * nw[2], v[3] * rq * nw[3]); *(u32x2*)(MIX + m * DM + 512 + ch) = o; } }
                LBAR();
            }
        }
        {
            const int c0 = 8 * lane, h = lane >> 3; const float* mu = args.in[I_MU];
            float muv[8], gw_[8], gb_[8];
#pragma unroll
            for (int i = 0; i < 8; ++i) { muv[i] = mu[1024 + c0 + i]; gw_[i] = args.in[I_GNW][c0 + i]; gb_[i] = args.in[I_GNB][c0 + i]; }
#pragma unroll 1
            for (int k0 = 0; k0 < MTOK / NGW; k0 += 4) {
                u32x4 ry[4], rz[4], rv[4], rp[4], rg[4]; float bdv[4];
#pragma unroll
                for (int q = 0; q < 4; ++q) { const size_t m = (size_t)(gw + (k0 + q) * NGW); const bool hasprev = (m & (SEQ - 1)) != 0;
                    ry[q] = *(const u32x4*)(MIX + m * DM + c0); rz[q] = *(const u32x4*)((const bf16_t*)((const unsigned char*)dout + 48 * MiB) + m * 512 + c0);
                    const bf16_t* pc = PROJ + m * NPROJ + c0 + 1024; rv[q] = *(const u32x4*)pc; rp[q] = hasprev ? *(const u32x4*)(pc - NPROJ) : (u32x4){0u, 0u, 0u, 0u};
                    rg[q] = *(const u32x4*)(GOUT + m * 512 + c0); bdv[q] = KKR[m * 8 + h]; }
#pragma unroll
                for (int q = 0; q < 4; ++q) { const size_t m = (size_t)(gw + (k0 + q) * NGW);
                    float y[8], v[8], p[8], go[8];
                    unpack8(ry[q], y); unpack8(rz[q], p);
#pragma unroll
                    for (int i = 0; i < 8; ++i) y[i] += p[i];
                    unpack8(rv[q], v); unpack8(rp[q], p);
#pragma unroll
                    for (int i = 0; i < 8; ++i) v[i] += (p[i] - v[i]) * muv[i];
                    unpack8(rg[q], go);
                    float s1 = 0.f; const float bd = bdv[q];
#pragma unroll
                    for (int i = 0; i < 8; ++i) s1 += y[i];
                    s1 += __shfl_xor(s1, 1); s1 += __shfl_xor(s1, 2); s1 += __shfl_xor(s1, 4);
                    const float mean = s1 * (1.0f / 64.0f); float s2 = 0.f;
#pragma unroll
                    for (int i = 0; i < 8; ++i) { const float d = y[i] - mean; s2 += d * d; }
                    s2 += __shfl_xor(s2, 1); s2 += __shfl_xor(s2, 2); s2 += __shfl_xor(s2, 4);
                    const float rs = __builtin_amdgcn_rsqf(s2 * (1.0f / 64.0f) + 64e-5f);
                    float o[8];
#pragma unroll
                    for (int i = 0; i < 8; ++i) o[i] = ((y[i] - mean) * rs * gw_[i] + gb_[i] + bd * v[i]) * go[i];
                    *(u32x4*)(MIX + m * DM + c0) = pack8(o); }
            }
        }
    }
    SEAM(5);


    PHASE(6) { REPBAR
        pg8::Gemm g{MIX, WOUT, MTOK, DM, DM}; pg8::StaticOrder S; S.init(MTOK, DM, G, bx);
        pg8::EpiRes<false, false> E{args.in[I_X], nullptr, XNB, nullptr, SS};
        pg8::gemm_phase(lds, g, S, E);
    }
    SEAM(6);
    PHASE(7) { REPBAR
        pg8::Gemm g{XNB, WGU, MTOK, 2 * FFN, DM}; pg8::StaticOrder S; S.init(MTOK, 2 * FFN, G, bx);
        LAS float* rsl = (LAS float*)(lds + RING_BYTES);
        { pg8::Unit u; for (int i = 0; S.next(i, u); ++i) if (tid < 256) rsl[256 * i + tid] = pg8::rstd_from_ss(SS, u.pm * 256 + tid); }
        __syncthreads();
        pg8::EpiSwiglu E{HID, FFN, rsl, nullptr};
        pg8::gemm_phase(lds, g, S, E);
    }
    SEAM(7);
    PHASE(8) { REPBAR
        pg8::Gemm g{HID, WDN, MTOK, DM, FFN}; pg8::StaticOrder S; S.init(MTOK, DM, G, bx);
        pg8::EpiRes<true, false> E{XNB, nullptr, XNB, nullptr, SS};
        pg8::gemm_phase(lds, g, S, E);
    }
    SEAM(8);
    PHASE(9) { REPBAR
        pg8::Gemm g{XNB, WQKV, MTOK, 1536, DM}; pg8::StaticOrder S; S.init(MTOK, 1536, G, bx);
        LAS float* rsl = (LAS float*)(lds + RING_BYTES);
        { pg8::Unit u; for (int i = 0; S.next(i, u); ++i) if (tid < 256) rsl[256 * i + tid] = pg8::rstd_from_ss(SS, u.pm * 256 + tid); }
        __syncthreads();
        pg8::EpiQkv E{QKV, rsl, args.in[I_BQKV], args.in[I_QN], args.in[I_KN], ROPE};
        pg8::gemm_phase(lds, g, S, E);
        if (bx >= 128) {
            conv_range(args.in, ws, CV_EGU, CV_END, (bx - 128) * 8 + wave, 128 * 8, (LAS float*)(lds + wave * 16384), lane);
        }
    }
    SEAM(9);

    PHASE(10) { REPBAR
        LAS bf16_t* Kt = (LAS bf16_t*)lds; LAS bf16_t* Vt = (LAS bf16_t*)(lds + 36864);
        const int r32 = lane & 31, hh = lane >> 5;
        for (int unit = vcu; unit < BATCH * 4 * 32; unit += G) {
            const int blk = unit & 31, kvh = (unit >> 5) & 3, b = unit >> 7;
            {
                const int rowi = tid >> 1, half = tid & 1; const int tpos = (blk - 1) * 128 + rowi;
#pragma unroll
                for (int q = 0; q < 4; ++q) { u32x4 kv = (u32x4){0, 0, 0, 0}, vv = kv;
                    if (tpos >= 0) { const bf16_t* p = QKV + (size_t)(b * SEQ + tpos) * 1536 + 1024 + kvh * 64 + half * 32 + 8 * q; kv = *(const u32x4*)p; vv = *(const u32x4*)(p + 256); }
                    *(LAS u32x4*)(Kt + rowi * 72 + half * 32 + 8 * q) = kv; *(LAS u32x4*)(Vt + rowi * 72 + half * 32 + 8 * q) = vv; }
            }
            __syncthreads();
            const int gq = wave >> 1, qh = kvh * 4 + gq; const float sink = args.in[I_SINK][qh];
            for (int it = 0; it < 2; ++it) {
                const int qi = (wave & 1) * 64 + it * 32 + r32; const size_t mq = (size_t)b * SEQ + blk * 128 + qi;
                bf16x8 qr[4];
#pragma unroll
                for (int s = 0; s < 4; ++s) qr[s] = *(const bf16x8*)(QKV + mq * 1536 + qh * 64 + 16 * s + 8 * hh);
                const int a0 = (wave & 1) * 2 + it;
                f32x16 sc[5];
#pragma unroll
                for (int j = 0; j < 5; ++j) {
#pragma unroll
                    for (int r = 0; r < 16; ++r) sc[j][r] = 0.f;
#pragma unroll
                    for (int s = 0; s < 4; ++s) { const bf16x8 kf = *(const LAS bf16x8*)(Kt + (32 * (a0 + j) + r32) * 72 + 16 * s + 8 * hh); sc[j] = __builtin_amdgcn_mfma_f32_32x32x16_bf16(kf, qr[s], sc[j], 0, 0, 0); }
                }
                float mx = sink;
#pragma unroll
                for (int j = 0; j < 5; ++j)
#pragma unroll
                    for (int r = 0; r < 16; ++r) { const int kj = 32 * (a0 + j) + crow(r, hh); const bool valid = (kj > qi) && (kj <= qi + 128) && (blk > 0 || kj >= 128);
                        const float x = valid ? sc[j][r] * 0.125f : -1e30f; sc[j][r] = x; mx = fmaxf(mx, x); }
                mx = fmaxf(mx, __shfl_xor(mx, 32));
                float l = 0.f;
#pragma unroll
                for (int j = 0; j < 5; ++j)
#pragma unroll
                    for (int r = 0; r < 16; ++r) { const float p = __expf(sc[j][r] - mx); sc[j][r] = p; l += p; }
                l += __shfl_xor(l, 32); l += __expf(sink - mx);
                const float inv = 1.0f / l;
                f32x16 o[2];
#pragma unroll
                for (int dt = 0; dt < 2; ++dt)
#pragma unroll
                    for (int r = 0; r < 16; ++r) o[dt][r] = 0.f;
#pragma unroll
                for (int j = 0; j < 5; ++j)
#pragma unroll
                    for (int s2 = 0; s2 < 2; ++s2) {
                        u32x4 pw; pw.x = pk2(sc[j][8 * s2 + 0], sc[j][8 * s2 + 1]); pw.y = pk2(sc[j][8 * s2 + 2], sc[j][8 * s2 + 3]); pw.z = pk2(sc[j][8 * s2 + 4], sc[j][8 * s2 + 5]); pw.w = pk2(sc[j][8 * s2 + 6], sc[j][8 * s2 + 7]);
                        const bf16x8 pf = __builtin_bit_cast(bf16x8, pw);
                        const int key0 = 32 * (a0 + j) + 16 * s2 + 4 * hh + ((lane & 15) >> 2);
#pragma unroll
                        for (int dt = 0; dt < 2; ++dt) {
                            const LAS bf16_t* vp = Vt + key0 * 72 + 32 * dt + 16 * ((lane >> 4) & 1) + 4 * (lane & 3);
                            const s16x4 lo = __builtin_bit_cast(s16x4, __builtin_amdgcn_ds_read_tr16_b64_v4i16((LAS s16x4*)vp));
                            const s16x4 hi = __builtin_bit_cast(s16x4, __builtin_amdgcn_ds_read_tr16_b64_v4i16((LAS s16x4*)(vp + 8 * 72)));
                            const bf16x8 vf = (bf16x8){lo[0], lo[1], lo[2], lo[3], hi[0], hi[1], hi[2], hi[3]};
                            o[dt] = __builtin_amdgcn_mfma_f32_32x32x16_bf16(vf, pf, o[dt], 0, 0, 0);
                        }
                    }
                bf16_t* op = ATTO + mq * DM + qh * 64;
#pragma unroll
                for (int dt = 0; dt < 2; ++dt)
#pragma unroll
                    for (int rq = 0; rq < 4; ++rq) { u32x2 w; w.x = pk2(o[dt][4 * rq] * inv, o[dt][4 * rq + 1] * inv); w.y = pk2(o[dt][4 * rq + 2] * inv, o[dt][4 * rq + 3] * inv);
                        *(u32x2*)(op + 32 * dt + 8 * rq + 4 * hh) = w; }
            }
            __syncthreads();
        }
    }
    SEAM(10);

    PHASE(11) { REPBAR
        pg8::Gemm g{ATTO, WO, MTOK, DM, DM}; pg8::StaticOrder S; S.init(MTOK, DM, G, bx);
        pg8::EpiResRouter E{XNB, dout, args.in[I_BO], SS, (float*)(ws + WS_GOUT)  , args.in[I_NORM_FFN1], args.in[I_ROUTER]};
        pg8::gemm_phase(lds, g, S, E);
    }
    SEAM(11);

    PHASE(12) { REPBAR
        LAS unsigned* lcnt = (LAS unsigned*)lds; LAS unsigned* lbase = lcnt + 8;
        if (tid < 8) lcnt[tid] = 0u;
        __syncthreads();
        int e0 = 0, e1 = 1; unsigned r0 = 0u, r1 = 0u; const int m = vcu * 64 + tid;
        if (tid < 64) {
            const float rstd = pg8::rstd_from_ss(SS, m);
            float d[8];
#pragma unroll
            for (int k = 0; k < 8; ++k) d[k] = 0.f;
            const f32x4* lp = (const f32x4*)((const float*)(ws + WS_GOUT) + (size_t)m * 128);
#pragma unroll
            for (int q = 0; q < 16; ++q) { const f32x4 a = lp[2 * q], b2 = lp[2 * q + 1]; d[0] += a[0]; d[1] += a[1]; d[2] += a[2]; d[3] += a[3]; d[4] += b2[0]; d[5] += b2[1]; d[6] += b2[2]; d[7] += b2[3]; }
            float v0 = d[0];
#pragma unroll
            for (int k = 1; k < 8; ++k) if (d[k] > v0) { v0 = d[k]; e0 = k; }
            float v1 = -3.0e38f; e1 = -1;
#pragma unroll
            for (int k = 0; k < 8; ++k) if (k != e0 && d[k] > v1) { v1 = d[k]; e1 = k; }
            const float w0 = __builtin_amdgcn_rcpf(1.0f + __expf((v1 - v0) * rstd));
            r0 = atomicAdd((unsigned*)(lcnt + e0), 1u); r1 = atomicAdd((unsigned*)(lcnt + e1), 1u);
            TOPE[2 * m] = e0; TOPE[2 * m + 1] = e1; TOPW[2 * m] = w0; TOPW[2 * m + 1] = 1.0f - w0; RSTD4[m] = rstd;
        }
        __syncthreads();
        if (tid < 8) lbase[tid] = atomicAdd(CNT + tid, lcnt[tid]);
        __syncthreads();
        if (tid < 64) { RANK[2 * m] = (int)(lbase[e0] + r0); RANK[2 * m + 1] = (int)(lbase[e1] + r1); }
        __syncthreads();
    }
    SEAM(12);

    PHASE(13) { REPBAR
        int roff[NEXP]; { int t = 0;
#pragma unroll
            for (int e = 0; e < NEXP; ++e) { roff[e] = t; t += (int)((CNT[e] + 255u) >> 8) << 8; } }
        {
            const int myj = gw + (lane & 15) * NGW, e = TOPE[myj]; int ro = roff[0];
#pragma unroll
            for (int k = 1; k < NEXP; ++k) ro = (e == k) ? roff[k] : ro;
            const int mypos = ro + RANK[myj];
            if (lane < 16) { POS[myj] = mypos; RSTDS[mypos] = RSTD4[myj >> 1]; }
#pragma unroll
            for (int k0 = 0; k0 < 16; k0 += 4) {
                u32x4 v[4][2]; int pos[4];
#pragma unroll
                for (int q = 0; q < 4; ++q) { pos[q] = __builtin_amdgcn_readlane(mypos, k0 + q); const int m = (gw + (k0 + q) * NGW) >> 1;
                    const u32x4* sp = (const u32x4*)(XNB + (size_t)m * DM) + lane; v[q][0] = sp[0]; v[q][1] = sp[64]; }
#pragma unroll
                for (int q = 0; q < 4; ++q) { u32x4* dp = (u32x4*)(AS + (size_t)pos[q] * DM) + lane; dp[0] = v[q][0]; dp[64] = v[q][1]; }
            }
        }
    }
    SEAM(13);
    PHASE(14) { REPBAR
        pg8::Gemm g{AS, EGU, SROWS, 2 * FE, DM}; pg8::MoeOrder S; S.init(CNT, 2 * FE / 256, G, bx, (long)2 * FE * DM * 2);
        pg8::EpiSwiglu E{HS, FE, (const LAS float*)nullptr, RSTDS};
        pg8::gemm_phase(lds, g, S, E);
    }
    SEAM(14);
    PHASE(15) { REPBAR
        pg8::Gemm g{HS, EDN, SROWS, DM, FE}; pg8::MoeOrder S; S.init(CNT, DM / 256, G, bx, (long)DM * FE * 2);
        pg8::EpiBf16 E{AS, DM};
        pg8::gemm_phase(lds, g, S, E);
    }
    SEAM(15);
    PHASE(16) { REPBAR
        {
            const int mym = gw + (lane & 7) * NGW; const int q0 = POS[2 * mym], q1 = POS[2 * mym + 1]; const float u0 = TOPW[2 * mym], u1 = TOPW[2 * mym + 1];
#pragma unroll
            for (int k0 = 0; k0 < 8; k0 += 4) {
                u32x4 ya[4][2], yb[4][2]; f32x4 hv[4][4]; float w0[4], w1[4];
#pragma unroll
                for (int t = 0; t < 4; ++t) { const int p0 = __builtin_amdgcn_readlane(q0, k0 + t), p1 = __builtin_amdgcn_readlane(q1, k0 + t);
                    w0[t] = __builtin_bit_cast(float, __builtin_amdgcn_readlane(__builtin_bit_cast(int, u0), k0 + t)); w1[t] = __builtin_bit_cast(float, __builtin_amdgcn_readlane(__builtin_bit_cast(int, u1), k0 + t));
                    const u32x4* y0 = (const u32x4*)(AS + (size_t)p0 * DM) + lane; const u32x4* y1 = (const u32x4*)(AS + (size_t)p1 * DM) + lane;
                    ya[t][0] = y0[0]; ya[t][1] = y0[64]; yb[t][0] = y1[0]; yb[t][1] = y1[64];
                    const f32x4* o = (const f32x4*)(dout + (size_t)(gw + (k0 + t) * NGW) * DM);
                    hv[t][0] = o[2 * lane]; hv[t][1] = o[2 * lane + 1]; hv[t][2] = o[128 + 2 * lane]; hv[t][3] = o[128 + 2 * lane + 1]; }
#pragma unroll
                for (int t = 0; t < 4; ++t) { f32x4* o = (f32x4*)(dout + (size_t)(gw + (k0 + t) * NGW) * DM);
#pragma unroll
                    for (int q = 0; q < 2; ++q) { float a[8], c[8]; unpack8(ya[t][q], a); unpack8(yb[t][q], c); f32x4 h0 = hv[t][2 * q], h1 = hv[t][2 * q + 1];
#pragma unroll
                        for (int i = 0; i < 4; ++i) { h0[i] += w0[t] * a[i] + w1[t] * c[i]; h1[i] += w0[t] * a[4 + i] + w1[t] * c[4 + i]; }
                        o[128 * q + 2 * lane] = h0; o[128 * q + 2 * lane + 1] = h1; } }
            }
        }
    }
#undef TRF
#undef NATF
#undef IN
#undef SEAM
#undef PHASE
#undef REPBAR
}

constexpr int NPHASE = 17;
extern "C" void kernel_launch(void* const* d_in, const int* in_sizes, int n_in, void* d_out, int out_size, void* d_ws, size_t ws_size, hipStream_t stream) {
    static int grid = 0;
    if (grid == 0) {
        if (n_in != 39 || out_size != MTOK * DM || ws_size < WS_END) { fprintf(stderr, "kernel_launch: unexpected shapes n_in %d out %d ws %zu\n", n_in, out_size, ws_size); grid = -1; return; }
        int dev = 0, cus = 0;
        if (hipGetDevice(&dev) != hipSuccess || hipDeviceGetAttribute(&cus, hipDeviceAttributeMultiprocessorCount, dev) != hipSuccess) { grid = -1; return; }
        if (hipFuncSetAttribute((const void*)fwd_kernel, hipFuncAttributeMaxDynamicSharedMemorySize, LDS_BYTES) != hipSuccess) { fprintf(stderr, "kernel_launch: hipFuncSetAttribute failed\n"); grid = -1; return; }
        int per_cu = 0; (void)hipOccupancyMaxActiveBlocksPerMultiprocessor(&per_cu, (const void*)fwd_kernel, 512, LDS_BYTES); (void)hipGetLastError();
        grid = 256; if (cus != 256 || per_cu < 1) fprintf(stderr, "kernel_launch: note: cus %d per_cu %d\n", cus, per_cu);
    }
    if (grid < 0) return;
    Args a{};
    a.in[0] = (const float*)d_in[0];
    for (int i = 2; i < 39; ++i) a.in[i - 1] = (const float*)d_in[i];
    a.pos = (const int*)d_in[1]; a.out = (float*)d_out; a.ws = (unsigned char*)d_ws;
    (void)hipMemsetAsync((char*)d_ws + WS_CTL, 0, CTL_ZERO_BYTES, stream);
#ifdef PROBE_PHASE
    constexpr int pp = PROBE_PHASE; constexpr bool before = (pp == 2 || pp == 3 || pp == 5 || pp == 6 || pp == 8 || pp == 11 || pp == 12);
#ifdef PROBE_VARIANT
    a.variant = PROBE_VARIANT;
#endif
    if (before) { a.ph_lo = pp; a.ph_hi = pp + 1; hipLaunchKernelGGL(fwd_kernel, dim3(grid), dim3(512), LDS_BYTES, stream, a); (void)hipMemsetAsync((char*)d_ws + WS_CTL, 0, CTL_ZERO_BYTES, stream); }
    a.variant = 0;
#endif
    a.ph_lo = 0; a.ph_hi = NPHASE;
    hipLaunchKernelGGL(fwd_kernel, dim3(grid), dim3(512), LDS_BYTES, stream, a);
#ifdef PROBE_PHASE
    if (!before) { (void)hipMemsetAsync((char*)d_ws + WS_CTL, 0, CW_CNT * 4, stream);
#ifdef PROBE_VARIANT
        a.variant = PROBE_VARIANT;
#endif
        a.ph_lo = pp; a.ph_hi = pp + 1; hipLaunchKernelGGL(fwd_kernel, dim3(grid), dim3(512), LDS_BYTES, stream, a); }
#endif
}
```

```cpp
#include <hip/hip_runtime.h>
#include <cstdio>
#include <cstdint>

#define LAS __attribute__((address_space(3)))
#define GAS __attribute__((address_space(1)))
typedef unsigned short bf16_t;
typedef short bf16x8 __attribute__((ext_vector_type(8)));
typedef float f32x4 __attribute__((ext_vector_type(4)));
typedef float f32x2 __attribute__((ext_vector_type(2)));
typedef float f32x16 __attribute__((ext_vector_type(16)));
typedef unsigned u32x4 __attribute__((ext_vector_type(4)));
typedef unsigned u32x2 __attribute__((ext_vector_type(2)));
typedef short s16x4 __attribute__((ext_vector_type(4)));

constexpr int BATCH = 4, SEQ = 4096, DM = 1024, MTOK = BATCH * SEQ;
constexpr int IN0 = 3336, NPROJ = 3328;
constexpr int FFN = 2816, FE = 1408, NEXP = 8;
constexpr int SROWS = 2 * MTOK + NEXP * 256;
constexpr float EPS = 1e-6f;

constexpr size_t MiB = 1u << 20;
constexpr size_t WS_CTL = 0, CTL_ZERO_BYTES = 64 * 1024;
constexpr size_t WS_DTSP = 1 * MiB;
constexpr size_t WS_KKR = 1 * MiB + 512 * 1024;
constexpr size_t WS_ROPE = 2 * MiB;
constexpr size_t WS_SS = 3 * MiB;
constexpr size_t WS_TOPE = 4 * MiB;
constexpr size_t WS_RANK = 4 * MiB + 128 * 1024;
constexpr size_t WS_TOPW = 4 * MiB + 256 * 1024;
constexpr size_t WS_POS = 4 * MiB + 384 * 1024;
constexpr size_t WS_RSTD4 = 4 * MiB + 512 * 1024;
constexpr size_t WS_RSTDS = 4 * MiB + 640 * 1024;
constexpr size_t WS_WDEC = 5 * MiB;
constexpr size_t WS_WICL = 5 * MiB + 64 * 1024;
constexpr size_t WS_WGAT = 5 * MiB + 128 * 1024;
constexpr size_t WS_EGU = 6 * MiB;
constexpr size_t WS_H3B = 50 * MiB;
constexpr size_t WS_WIN = 72 * MiB;
constexpr size_t WS_WOUT = WS_WIN + (size_t)NPROJ * DM * 2;
constexpr size_t WS_WGU = WS_WOUT + 2 * MiB;
constexpr size_t WS_WDN = WS_WGU + 11 * MiB;
constexpr size_t WS_WQKV = WS_WDN + (size_t)DM * FFN * 2;
constexpr size_t WS_WO = WS_WQKV + 3 * MiB;
constexpr size_t R0 = 102 * MiB;
static_assert(WS_WO + 2 * MiB <= R0, "weights");
constexpr size_t WS_XN = R0, WS_MIX = R0;
constexpr size_t WS_PROJ = R0 + 32 * MiB;
constexpr size_t WS_GOUT = R0 + 136 * MiB;
constexpr size_t WS_XNB = R0 + 104 * MiB;
constexpr size_t WS_HID = R0;
constexpr size_t WS_QKV = R0;
constexpr size_t WS_ATTO = R0 + 48 * MiB;
constexpr size_t WS_AS = 82 * MiB;
constexpr size_t WS_HS = 150 * MiB;
constexpr size_t WS_END = 254 * MiB;
static_assert(WS_H3B + 32 * MiB <= WS_AS && WS_AS + (size_t)SROWS * DM * 2 <= WS_HS && WS_HS + (size_t)SROWS * FE * 2 <= WS_END && WS_GOUT + 16 * MiB <= WS_END, "map");
constexpr int CW_BAR = 4096, CW_CNT = 8192, CW_BAR2 = 10240;

constexpr int LDS_BYTES = 147456, RING_BYTES = 131072, MISC_OFF = LDS_BYTES - 128;

typedef __bf16 bf16x2_t __attribute__((ext_vector_type(2)));
__device__ __forceinline__ unsigned pk2(float lo, float hi) { const f32x2 v = {lo, hi}; const bf16x2_t b = __builtin_convertvector(v, bf16x2_t); return __builtin_bit_cast(unsigned, b); }
__device__ __forceinline__ unsigned f2bf(float f) { return pk2(f, 0.f); }
__device__ __forceinline__ float bflo(unsigned u) { return __builtin_bit_cast(float, u << 16); }
__device__ __forceinline__ float bfhi(unsigned u) { return __builtin_bit_cast(float, u & 0xffff0000u); }
__device__ __forceinline__ void unpack8(const u32x4 v, float* f) { f[0] = bflo(v.x); f[1] = bfhi(v.x); f[2] = bflo(v.y); f[3] = bfhi(v.y); f[4] = bflo(v.z); f[5] = bfhi(v.z); f[6] = bflo(v.w); f[7] = bfhi(v.w); }
__device__ __forceinline__ u32x4 pack8(const float* f) { u32x4 v; v.x = pk2(f[0], f[1]); v.y = pk2(f[2], f[3]); v.z = pk2(f[4], f[5]); v.w = pk2(f[6], f[7]); return v; }
__device__ __forceinline__ float sigmoidf_(float x) { return __builtin_amdgcn_rcpf(1.0f + __expf(-x)); }
__device__ __forceinline__ float siluf_(float x) { return x * __builtin_amdgcn_rcpf(1.0f + __expf(-x)); }
#define LBAR() do { asm volatile("s_waitcnt lgkmcnt(0)" ::: "memory"); __builtin_amdgcn_s_barrier(); asm volatile("" ::: "memory"); } while (0)
__device__ __forceinline__ float wave_sum(float v) {
#pragma unroll
    for (int o = 1; o < 64; o <<= 1) v += __shfl_xor(v, o);
    return v;
}
__device__ __forceinline__ float dpp_sum63(float x) {
    int v;
    v = __builtin_amdgcn_update_dpp(0, __builtin_bit_cast(int, x), 0xB1, 0xF, 0xF, false); x += __builtin_bit_cast(float, v);
    v = __builtin_amdgcn_update_dpp(0, __builtin_bit_cast(int, x), 0x4E, 0xF, 0xF, false); x += __builtin_bit_cast(float, v);
    v = __builtin_amdgcn_update_dpp(0, __builtin_bit_cast(int, x), 0x141, 0xF, 0xF, false); x += __builtin_bit_cast(float, v);
    v = __builtin_amdgcn_update_dpp(0, __builtin_bit_cast(int, x), 0x140, 0xF, 0xF, false); x += __builtin_bit_cast(float, v);
    v = __builtin_amdgcn_update_dpp(0, __builtin_bit_cast(int, x), 0x142, 0xA, 0xF, false); x += __builtin_bit_cast(float, v);
    v = __builtin_amdgcn_update_dpp(0, __builtin_bit_cast(int, x), 0x143, 0xC, 0xF, false); x += __builtin_bit_cast(float, v);
    return __builtin_bit_cast(float, __builtin_amdgcn_readlane(__builtin_bit_cast(int, x), 63));
}
__device__ __forceinline__ void wave_sum8(float (&d)[8]) {
    float e4[4], e2[2], e1;
    { const bool up = (threadIdx.x & 32) != 0;
#pragma unroll
      for (int k = 0; k < 4; ++k) { const float keep = up ? d[k + 4] : d[k], send = up ? d[k] : d[k + 4]; e4[k] = keep + __shfl_xor(send, 32); } }
    { const bool up = (threadIdx.x & 16) != 0;
#pragma unroll
      for (int k = 0; k < 2; ++k) { const float keep = up ? e4[k + 2] : e4[k], send = up ? e4[k] : e4[k + 2]; e2[k] = keep + __shfl_xor(send, 16); } }
    { const bool up = (threadIdx.x & 8) != 0; const float keep = up ? e2[1] : e2[0], send = up ? e2[0] : e2[1]; e1 = keep + __shfl_xor(send, 8); }
    e1 += __shfl_xor(e1, 4); e1 += __shfl_xor(e1, 2); e1 += __shfl_xor(e1, 1);
#pragma unroll
    for (int k = 0; k < 8; ++k) d[k] = __builtin_bit_cast(float, __builtin_amdgcn_readlane(__builtin_bit_cast(int, e1), 8 * k));
}
__device__ __forceinline__ int crow(int r, int hi) { return (r & 3) + 8 * (r >> 2) + 4 * hi; }
__device__ __forceinline__ constexpr int crc(int r) { return (r & 3) + 8 * (r >> 2); }
template <bool PERMK> __device__ __forceinline__ void tile_store_bf16(LAS bf16_t* stg, const f32x16& acc, bf16_t* g, size_t pitch, int lane) {
    const int c = lane & 31, hi = lane >> 5; const int cs = PERMK ? ((c & ~15) | (((c >> 2) & 1) << 3) | (((c >> 3) & 1) << 2) | (c & 3)) : c;
    LAS bf16_t* w = stg + (4 * hi) * 40 + cs;
#pragma unroll
    for (int r = 0; r < 16; r += 2) { const unsigned p = pk2(acc[r], acc[r + 1]); w[crc(r) * 40] = (bf16_t)(p & 0xffffu); w[crc(r + 1) * 40] = (bf16_t)(p >> 16); }
#pragma unroll
    for (int k = 0; k < 2; ++k) { const int pc = lane + 64 * k, row = pc >> 2, c4 = pc & 3; *(u32x4*)(g + (size_t)row * pitch + 8 * c4) = *(const LAS u32x4*)(stg + row * 40 + 8 * c4); }
    asm volatile("s_waitcnt lgkmcnt(0)" ::: "memory");
}

namespace pg8 {
constexpr int BM = 256, BK = 64, HALF = 128, HTB = HALF * BK * 2, NXCD = 8, WGM = 2;
__host__ __device__ __forceinline__ int lds_byte(int r, int c) { const int st = (r >> 4) * 2 + (c >> 5), rr = r & 15, cc = c & 31, ob = rr * 64 + cc * 2; return st * 1024 + (ob ^ (((ob >> 9) & 1) << 5)); }
__host__ __device__ __forceinline__ void stage_rc(int b, int& R, int& C) { const int st = b / 1024, sb = b % 1024, swz = sb ^ (((sb >> 9) & 1) << 5); R = (st >> 1) * 16 + swz / 64; C = (st & 1) * 32 + (swz % 64) / 2; }
__host__ __device__ __forceinline__ int perm32(int rho) { const int n = rho >> 4, i = rho & 15; return 8 * (i >> 2) + 4 * n + (i & 3); }
struct Unit { int pm, pn; long bofs; int slot; };
struct Gemm { const bf16_t* A; const bf16_t* Bt; int M, N, K; };
struct StaticOrder {
    static constexpr bool GATHER = false;
    int nM, nN, nwg, G, c;
    __device__ __forceinline__ void init(int M, int N, int G_, int c_) { nM = M / BM; nN = N / BM; nwg = nM * nN; G = G_; c = c_; }
    __device__ __forceinline__ bool next(int i, Unit& u) const {
        const long L = (long)i * G + c; if (L >= nwg) return false;
        int wgid = (int)L; { const int q = nwg / NXCD, r = nwg % NXCD, xcd = wgid % NXCD, off = wgid / NXCD; wgid = (xcd < r ? xcd * (q + 1) : r * (q + 1) + (xcd - r) * q) + off; }
        const int nig = WGM * nN, gid = wgid / nig, fm = gid * WGM, gsz = (nM - fm) < WGM ? (nM - fm) : WGM;
        u.pm = fm + ((wgid % nig) % gsz); u.pn = (wgid % nig) / gsz; u.bofs = 0; u.slot = i; return true;
    }
};
struct MoeOrder {
    static constexpr bool GATHER = false;
    int toff[NEXP + 1]; int nN, G, c; long estride;
    __device__ __forceinline__ void init(const unsigned* cnt, int nN_, int G_, int c_, long estride_) {
        nN = nN_; G = G_; c = c_; estride = estride_; int t = 0;
#pragma unroll
        for (int e = 0; e < NEXP; ++e) { toff[e] = t; t += (int)((cnt[e] + 255u) >> 8); }
        toff[NEXP] = t;
    }
    __device__ __forceinline__ bool next(int i, Unit& u) const {
        const int nM = toff[NEXP], nwg = nM * nN; const long L = (long)i * G + c; if (L >= nwg) return false;
        int wgid = (int)L; { const int q = nwg / NXCD, r = nwg % NXCD, xcd = wgid % NXCD, off = wgid / NXCD; wgid = (xcd < r ? xcd * (q + 1) : r * (q + 1) + (xcd - r) * q) + off; }
        const int nig = WGM * nN, gid = wgid / nig, fm = gid * WGM, gsz = (nM - fm) < WGM ? (nM - fm) : WGM;
        const int pm = fm + ((wgid % nig) % gsz); u.pm = pm; u.pn = (wgid % nig) / gsz; u.slot = i; int e = 0;
#pragma unroll
        for (int j = 1; j < NEXP; ++j) e += (pm >= toff[j]) ? 1 : 0;
        u.bofs = (long)e * estride; return true;
    }
};

struct MoeOrderG : MoeOrder { static constexpr bool GATHER = true; const LAS unsigned* gat; };

template <class Epi, class Sched>
__device__ __forceinline__ void gemm_phase(LAS unsigned char* lds, const Gemm g, const Sched& S, const Epi& E) {
    constexpr bool ALIGN_EPI = true;
    const int tid = threadIdx.x, wid = __builtin_amdgcn_readfirstlane(tid >> 6), lane = tid & 63, wr = wid >> 2, wc = wid & 3, fr = lane & 15, fq = lane >> 4;
    const int K = g.K, nt = K / BK;
    constexpr bool GA = Sched::GATHER;
    unsigned voffA[2], voffB[2], vgA[2][2];
#pragma unroll
    for (int i = 0; i < 2; ++i) { int R, C; stage_rc(tid * 16 + i * 8192, R, C); const int Rb = Epi::PERM ? ((R & ~31) + perm32(R & 31)) : R;
        voffA[i] = GA ? (unsigned)((R << 8) | (C * 2)) : (unsigned)(R * K + C) * 2u; voffB[i] = (unsigned)(Rb * K + C) * 2u; }
#define PG8_GLOAD(slot) do { if constexpr (GA) { _Pragma("unroll") for (int _h = 0; _h < 2; ++_h) _Pragma("unroll") for (int _i = 0; _i < 2; ++_i) \
        vgA[_h][_i] = S.gat[(slot) * 256 + _h * HALF + (int)(voffA[_i] >> 8)] + (voffA[_i] & 255u); } } while (0)
#define PG8_STAGE_A(bufoff, gbase, h) do { if constexpr (GA) { _Pragma("unroll") for (int _i = 0; _i < 2; ++_i) \
        __builtin_amdgcn_global_load_lds((const unsigned*)((const char*)(gbase) + vgA[h][_i]), (LAS unsigned*)(lds + (bufoff) + ldsw + _i * 8192), 16, 0, 0); } \
        else { PG8_STAGE(bufoff, (gbase) + (h) * hstep, voffA); } } while (0)
    const size_t kstep = (size_t)(BK * 2);
    const size_t hstep = (size_t)HALF * K * 2;
    const size_t tstep = 2 * hstep;
    const unsigned ldsw = (unsigned)wid * 1024u;
    const int aoff = lds_byte(wr * 64 + fr, fq * 8), boff = lds_byte(wc * 32 + fr, fq * 8);
#define PG8_SA(b, h) (((b) * 2 + (h)) * HTB)
#define PG8_SB(b, h) ((4 + (b) * 2 + (h)) * HTB)
#define PG8_STAGE(bufoff, gbase, voff) do { _Pragma("unroll") for (int _i = 0; _i < 2; ++_i) \
        __builtin_amdgcn_global_load_lds((const unsigned*)((const char*)(gbase) + (voff)[_i]), (LAS unsigned*)(lds + (bufoff) + ldsw + _i * 8192), 16, 0, 0); } while (0)
#define PG8_LDA(dst, b, h) do { _Pragma("unroll") for (int m = 0; m < 4; ++m) _Pragma("unroll") for (int k = 0; k < 2; ++k) dst[m][k] = *(const LAS bf16x8*)(lds + PG8_SA(b, h) + aoff + m * 2048 + k * 1024); } while (0)
#define PG8_LDB(dst, b, h) do { _Pragma("unroll") for (int n = 0; n < 2; ++n) _Pragma("unroll") for (int k = 0; k < 2; ++k) dst[n][k] = *(const LAS bf16x8*)(lds + PG8_SB(b, h) + boff + n * 2048 + k * 1024); } while (0)
#define PG8_MMA(ai, bj, At, Bt) do { __builtin_amdgcn_s_setprio(1); _Pragma("unroll") for (int m = 0; m < 4; ++m) _Pragma("unroll") for (int n = 0; n < 2; ++n) _Pragma("unroll") for (int k = 0; k < 2; ++k) \
        acc[ai][bj][m][n] = __builtin_amdgcn_mfma_f32_16x16x32_bf16(Bt[n][k], At[m][k], acc[ai][bj][m][n], 0, 0, 0); __builtin_amdgcn_s_setprio(0); } while (0)
#define PG8_WAIT_V(n) asm volatile("s_waitcnt vmcnt(" #n ")" ::: "memory")
#define PG8_WAIT_L(n) asm volatile("s_waitcnt lgkmcnt(" #n ")" ::: "memory")
#define PG8_BAR __builtin_amdgcn_s_barrier()
#define PG8_SCHED __builtin_amdgcn_sched_barrier(0)
    Unit cur, nxt; int ui = 0;
    if (!S.next(0, cur)) return;
    f32x4 acc[2][2][4][2];
#pragma unroll
    for (int a = 0; a < 2; ++a)
#pragma unroll
        for (int b = 0; b < 2; ++b)
#pragma unroll
            for (int m = 0; m < 4; ++m)
#pragma unroll
                for (int n = 0; n < 2; ++n) acc[a][b][m][n] = (f32x4){0.f, 0.f, 0.f, 0.f};
    bf16x8 At[4][2], B0[2][2], B1[2][2];
    const char* cA = (const char*)g.A + (GA ? (size_t)0 : (size_t)cur.pm * tstep); const char* cB = (const char*)g.Bt + cur.bofs + (size_t)cur.pn * tstep;
    PG8_GLOAD(0);
    PG8_STAGE(PG8_SB(0, 0), cB, voffB); PG8_STAGE(PG8_SB(0, 1), cB + hstep, voffB); PG8_STAGE_A(PG8_SA(0, 0), cA, 0); PG8_STAGE_A(PG8_SA(0, 1), cA, 1);
    if (wr == 1) PG8_BAR;
    PG8_WAIT_V(2); PG8_BAR;
    PG8_STAGE(PG8_SB(1, 0), cB + kstep, voffB); PG8_STAGE_A(PG8_SA(1, 0), cA + kstep, 0); PG8_STAGE(PG8_SB(1, 1), cB + hstep + kstep, voffB);
    PG8_WAIT_V(6); PG8_BAR;
    for (;;) {
        const bool has_next = S.next(ui + 1, nxt);
        const char* nA = (has_next && !GA) ? (const char*)g.A + (size_t)nxt.pm * tstep : cA; const char* nB = has_next ? (const char*)g.Bt + nxt.bofs + (size_t)nxt.pn * tstep : cB;
        for (int t = 0; t < nt; t += 2) {
            const bool last = (t == nt - 2);
            const char* a1 = cA + (size_t)(t + 1) * kstep;
            const char* a2 = last ? nA : cA + (size_t)(t + 2) * kstep; const char* b2 = last ? nB : cB + (size_t)(t + 2) * kstep;
            const char* a3 = a2 + kstep; const char* b3 = b2 + kstep;
            PG8_LDB(B0, 0, 0); PG8_LDB(B1, 0, 1); PG8_SCHED; PG8_LDA(At, 0, 0); PG8_STAGE_A(PG8_SA(1, 1), a1, 1);
            if constexpr (GA) { if (last && has_next) PG8_GLOAD(ui + 1); }
            PG8_WAIT_V(8); PG8_WAIT_L(0); PG8_BAR; PG8_MMA(0, 0, At, B0); PG8_MMA(0, 1, At, B1); PG8_BAR; PG8_SCHED;
            PG8_LDA(At, 0, 1); PG8_STAGE(PG8_SB(0, 0), b2, voffB); PG8_STAGE(PG8_SB(0, 1), b2 + hstep, voffB); PG8_STAGE_A(PG8_SA(0, 0), a2, 0);
            PG8_WAIT_V(8); PG8_WAIT_L(0); PG8_BAR; PG8_MMA(1, 0, At, B0); PG8_MMA(1, 1, At, B1); PG8_BAR; PG8_SCHED;
            PG8_LDB(B0, 1, 0); PG8_LDB(B1, 1, 1); PG8_SCHED; PG8_LDA(At, 1, 0); PG8_STAGE_A(PG8_SA(0, 1), a2, 1);
            PG8_WAIT_V(8); PG8_WAIT_L(0); PG8_BAR; PG8_MMA(0, 0, At, B0); PG8_MMA(0, 1, At, B1); PG8_BAR; PG8_SCHED;
            PG8_LDA(At, 1, 1); PG8_STAGE(PG8_SB(1, 0), b3, voffB); PG8_STAGE(PG8_SB(1, 1), b3 + hstep, voffB); PG8_STAGE_A(PG8_SA(1, 0), a3, 0);
            PG8_WAIT_V(8); PG8_WAIT_L(0); PG8_BAR; PG8_MMA(1, 0, At, B0); PG8_MMA(1, 1, At, B1); PG8_BAR; PG8_SCHED;
        }
        if constexpr (ALIGN_EPI) { if (wr == 0) PG8_BAR; }
        if constexpr (!Epi::AFTER_DRAIN) E(acc, cur, wr, wc, fr, fq);
        if (!has_next) break;
#pragma unroll
        for (int a = 0; a < 2; ++a)
#pragma unroll
            for (int b = 0; b < 2; ++b)
#pragma unroll
                for (int m = 0; m < 4; ++m)
#pragma unroll
                    for (int n = 0; n < 2; ++n) acc[a][b][m][n] = (f32x4){0.f, 0.f, 0.f, 0.f};
        cur = nxt; cA = nA; cB = nB; ++ui;
        if constexpr (ALIGN_EPI) { if (wr == 1) PG8_BAR; }
    }
    PG8_WAIT_V(0);
    if constexpr (!ALIGN_EPI) { if (wr == 0) PG8_BAR; }
    PG8_BAR;
    if constexpr (Epi::AFTER_DRAIN) E.fused(acc, cur, wr, wc, fr, fq, lds);
#undef PG8_SA
#undef PG8_SB
#undef PG8_STAGE
#undef PG8_STAGE_A
#undef PG8_GLOAD
#undef PG8_LDA
#undef PG8_LDB
#undef PG8_MMA
#undef PG8_WAIT_V
#undef PG8_WAIT_L
#undef PG8_BAR
#undef PG8_SCHED
}

struct EpiBf16 {
    static constexpr bool PERM = true, AFTER_DRAIN = false;
    bf16_t* O; int ldc;
    __device__ __forceinline__ void operator()(const f32x4 (&acc)[2][2][4][2], const Unit& u, int wr, int wc, int fr, int fq) const {
        const int row0 = u.pm * BM + wr * 64 + fr, col0 = u.pn * BM + wc * 32 + 8 * fq;
#pragma unroll
        for (int ai = 0; ai < 2; ++ai)
#pragma unroll
            for (int m = 0; m < 4; ++m) { bf16_t* rowp = O + (size_t)(row0 + ai * HALF + m * 16) * ldc + col0;
#pragma unroll
                for (int bj = 0; bj < 2; ++bj) { const f32x4 v0 = acc[ai][bj][m][0], v1 = acc[ai][bj][m][1];
                    u32x4 w; w.x = pk2(v0[0], v0[1]); w.y = pk2(v0[2], v0[3]); w.z = pk2(v1[0], v1[1]); w.w = pk2(v1[2], v1[3]);
                    *(u32x4*)(rowp + bj * HALF) = w; } }
    }
};
template <bool BASE_BF16, bool F32OUT> struct EpiRes {
    static constexpr bool PERM = true, AFTER_DRAIN = false;
    const void* base; float* out; bf16_t* hb; const float* bias; float* ss;
    __device__ __forceinline__ void operator()(const f32x4 (&acc)[2][2][4][2], const Unit& u, int wr, int wc, int fr, int fq) const {
        const int col0 = u.pn * BM + wc * 32 + 8 * fq;
        f32x4 bv[2][2];
#pragma unroll
        for (int bj = 0; bj < 2; ++bj)
#pragma unroll
            for (int n = 0; n < 2; ++n) bv[bj][n] = bias ? *(const f32x4*)(bias + col0 + bj * HALF + n * 4) : (f32x4){0.f, 0.f, 0.f, 0.f};
#pragma unroll
        for (int ai = 0; ai < 2; ++ai) {
            f32x4 pre[4][2][2];
#pragma unroll
            for (int m = 0; m < 4; ++m) { const size_t off = (size_t)(u.pm * BM + ai * HALF + wr * 64 + m * 16 + fr) * DM + col0;
#pragma unroll
                for (int bj = 0; bj < 2; ++bj) { const size_t o2 = off + bj * HALF;
                    if (BASE_BF16) { const u32x4 w = *(const u32x4*)((const bf16_t*)base + o2); pre[m][bj][0] = (f32x4){bflo(w.x), bfhi(w.x), bflo(w.y), bfhi(w.y)}; pre[m][bj][1] = (f32x4){bflo(w.z), bfhi(w.z), bflo(w.w), bfhi(w.w)}; }
                    else { pre[m][bj][0] = __builtin_nontemporal_load((const f32x4*)((const float*)base + o2)); pre[m][bj][1] = __builtin_nontemporal_load((const f32x4*)((const float*)base + o2 + 4)); } } }
            asm volatile("" ::: "memory");
#pragma unroll
            for (int m = 0; m < 4; ++m) { const int row = u.pm * BM + ai * HALF + wr * 64 + m * 16 + fr; const size_t off = (size_t)row * DM + col0; float s = 0.f;
#pragma unroll
                for (int bj = 0; bj < 2; ++bj) { const size_t o2 = off + bj * HALF;
                    const f32x4 o0 = pre[m][bj][0] + acc[ai][bj][m][0] + bv[bj][0], o1 = pre[m][bj][1] + acc[ai][bj][m][1] + bv[bj][1];
                    if (F32OUT) { *(f32x4*)(out + o2) = o0; *(f32x4*)(out + o2 + 4) = o1; }
                    s += ((o0[0] * o0[0] + o0[1] * o0[1]) + (o0[2] * o0[2] + o0[3] * o0[3])) + ((o1[0] * o1[0] + o1[1] * o1[1]) + (o1[2] * o1[2] + o1[3] * o1[3]));
                    u32x4 w; w.x = pk2(o0[0], o0[1]); w.y = pk2(o0[2], o0[3]); w.z = pk2(o1[0], o1[1]); w.w = pk2(o1[2], o1[3]); *(u32x4*)(hb + o2) = w; }
                s += __shfl_xor(s, 16); s += __shfl_xor(s, 32);
                if (fq == 0) ss[(size_t)row * 16 + u.pn * 4 + wc] = s; }
        }
    }
};
struct EpiResRouter {
    static constexpr bool PERM = true, AFTER_DRAIN = true;
    const bf16_t* hbase; bf16_t* hb; const float* bias; float* ss; float* lp; const float* gw; const float* wr8; const LAS float* gwl;
    __device__ __forceinline__ void fused(const f32x4 (&acc)[2][2][4][2], const Unit& u, int wr, int wc, int fr, int fq, LAS unsigned char* lds) const {
        const LAS float* GW = gwl;
        const int col0 = u.pn * BM + wc * 32 + 8 * fq, lc0 = wc * 32 + 8 * fq;
        f32x4 bv[2][2];
#pragma unroll
        for (int bj = 0; bj < 2; ++bj)
#pragma unroll
            for (int n = 0; n < 2; ++n) bv[bj][n] = *(const f32x4*)(bias + col0 + bj * HALF + n * 4);
#pragma unroll
        for (int ai = 0; ai < 2; ++ai) {
#pragma unroll
          for (int mh = 0; mh < 2; ++mh) {
            u32x4 pre[4][2];
#pragma unroll
            for (int m = 2 * mh; m < 2 * mh + 2; ++m) { const size_t off = (size_t)(u.pm * BM + ai * HALF + wr * 64 + m * 16 + fr) * DM + col0;
#pragma unroll
                for (int bj = 0; bj < 2; ++bj) pre[m][bj] = *(const u32x4*)(hbase + off + bj * HALF); }
            asm volatile("" ::: "memory");
#pragma unroll
            for (int m = 2 * mh; m < 2 * mh + 2; ++m) { const int row = u.pm * BM + ai * HALF + wr * 64 + m * 16 + fr; const size_t off = (size_t)row * DM + col0; float s = 0.f;
                float lg[8];
#pragma unroll
                for (int e = 0; e < 8; ++e) lg[e] = 0.f;
#pragma unroll
                for (int bj = 0; bj < 2; ++bj) { const u32x4 w = pre[m][bj]; u32x4 wo;
#pragma unroll
                    for (int n = 0; n < 2; ++n) {
                        const f32x4 o = (n == 0 ? (f32x4){bflo(w.x), bfhi(w.x), bflo(w.y), bfhi(w.y)} : (f32x4){bflo(w.z), bfhi(w.z), bflo(w.w), bfhi(w.w)}) + acc[ai][bj][m][n] + bv[bj][n];
                        s += (o[0] * o[0] + o[1] * o[1]) + (o[2] * o[2] + o[3] * o[3]);
                        if (n == 0) { wo.x = pk2(o[0], o[1]); wo.y = pk2(o[2], o[3]); } else { wo.z = pk2(o[0], o[1]); wo.w = pk2(o[2], o[3]); }
#pragma unroll
                        for (int i = 0; i < 4; ++i) { const LAS float* gp = GW + (lc0 + bj * HALF + n * 4 + i) * 8; const f32x4 wa = *(const LAS f32x4*)gp, wb = *(const LAS f32x4*)(gp + 4);
                            lg[0] += o[i] * wa[0]; lg[1] += o[i] * wa[1]; lg[2] += o[i] * wa[2]; lg[3] += o[i] * wa[3]; lg[4] += o[i] * wb[0]; lg[5] += o[i] * wb[1]; lg[6] += o[i] * wb[2]; lg[7] += o[i] * wb[3]; } }
                    *(u32x4*)(hb + off + bj * HALF) = wo; }
                s += __shfl_xor(s, 16); s += __shfl_xor(s, 32);
#pragma unroll
                for (int e = 0; e < 8; ++e) { lg[e] += __shfl_xor(lg[e], 16); lg[e] += __shfl_xor(lg[e], 32); }
                if (fq == 0) { ss[(size_t)row * 16 + u.pn * 4 + wc] = s; float* lpp = lp + ((size_t)row * 16 + u.pn * 4 + wc) * 8;
                    *(f32x4*)lpp = (f32x4){lg[0], lg[1], lg[2], lg[3]}; *(f32x4*)(lpp + 4) = (f32x4){lg[4], lg[5], lg[6], lg[7]}; }
                asm volatile("" ::: "memory"); }
          }
        }
    }
};
__device__ __forceinline__ float rstd_from_ss(const float* ss, int row) {
    const f32x4* p = (const f32x4*)(ss + (size_t)row * 16); const f32x4 a = p[0], b = p[1], c = p[2], d = p[3];
    const float t = ((a[0] + a[1]) + (a[2] + a[3])) + ((b[0] + b[1]) + (b[2] + b[3])) + ((c[0] + c[1]) + (c[2] + c[3])) + ((d[0] + d[1]) + (d[2] + d[3]));
    return __builtin_amdgcn_rsqf(t * (1.0f / DM) + EPS);
}
struct EpiSwiglu {
    static constexpr bool PERM = true, AFTER_DRAIN = false;
    bf16_t* O; int ldc; const LAS float* rsl; const float* rstd;
    __device__ __forceinline__ void operator()(const f32x4 (&acc)[2][2][4][2], const Unit& u, int wr, int wc, int fr, int fq) const {
        const int row0 = u.pm * BM + wr * 64 + fr, col0 = u.pn * HALF + wc * 32 + 8 * fq;
#pragma unroll
        for (int ai = 0; ai < 2; ++ai) {
            float rs[4];
#pragma unroll
            for (int m = 0; m < 4; ++m) { const int row = row0 + ai * HALF + m * 16; rs[m] = rsl ? rsl[256 * u.slot + wr * 64 + fr + ai * HALF + m * 16] : rstd[row]; }
            asm volatile("" ::: "memory");
#pragma unroll
            for (int m = 0; m < 4; ++m) { const int row = row0 + ai * HALF + m * 16;
                float h[8];
#pragma unroll
                for (int n = 0; n < 2; ++n)
#pragma unroll
                    for (int i = 0; i < 4; ++i) { const float gg = acc[ai][0][m][n][i] * rs[m], uu = acc[ai][1][m][n][i] * rs[m]; h[n * 4 + i] = siluf_(gg) * uu; }
                *(u32x4*)(O + (size_t)row * ldc + col0) = pack8(h); }
        }
    }
};
struct EpiQkv {
    static constexpr bool PERM = true, AFTER_DRAIN = false;
    bf16_t* O; const LAS float* rsl; const float* bias; const float* qn; const float* kn; const float* rope;
    __device__ __forceinline__ void operator()(const f32x4 (&acc)[2][2][4][2], const Unit& u, int wr, int wc, int fr, int fq) const {
        const int hd = u.pn * 4 + wc, row0 = u.pm * BM + wr * 64 + fr; const int kind = u.pn < 4 ? 0 : (u.pn == 4 ? 1 : 2);
        const float* nw = kind == 0 ? qn : kn;
        float bv[2][8], nv[2][8];
#pragma unroll
        for (int bj = 0; bj < 2; ++bj)
#pragma unroll
            for (int j = 0; j < 8; ++j) { bv[bj][j] = bias[hd * 64 + bj * 32 + fq * 8 + j]; nv[bj][j] = nw[bj * 32 + fq * 8 + j]; }
#pragma unroll
        for (int ai = 0; ai < 2; ++ai)
#pragma unroll
            for (int m = 0; m < 4; ++m) { const int row = row0 + ai * HALF + m * 16; const float rs = rsl[256 * u.slot + wr * 64 + fr + ai * HALF + m * 16];
                float v[2][8]; float s = 0.f;
#pragma unroll
                for (int bj = 0; bj < 2; ++bj)
#pragma unroll
                    for (int n = 0; n < 2; ++n)
#pragma unroll
                        for (int i = 0; i < 4; ++i) { const float x = acc[ai][bj][m][n][i] * rs + bv[bj][n * 4 + i]; v[bj][n * 4 + i] = x; s += x * x; }
                if (kind < 2) {
                    s += __shfl_xor(s, 16); s += __shfl_xor(s, 32);
                    const float r2 = __builtin_amdgcn_rsqf(s * (1.0f / 64.0f) + EPS);
#pragma unroll
                    for (int bj = 0; bj < 2; ++bj)
#pragma unroll
                        for (int j = 0; j < 8; ++j) v[bj][j] = v[bj][j] * r2 * nv[bj][j];
                    const f32x4* rp = (const f32x4*)(rope + (size_t)row * 16);
                    const f32x4 c0 = rp[0], c1 = rp[1], s0 = rp[2], s1 = rp[3];
#pragma unroll
                    for (int j = 0; j < 8; ++j) { const float other = __shfl_xor(v[0][j], 16); const float cc = j < 4 ? c0[j] : c1[j - 4], sn = j < 4 ? s0[j] : s1[j - 4];
                        const float mine = v[0][j]; const float rot = (fq == 0) ? (mine * cc - other * sn) : (mine * cc + other * sn);
                        v[0][j] = (fq < 2) ? rot : mine; }
                }
#pragma unroll
                for (int bj = 0; bj < 2; ++bj) *(u32x4*)(O + (size_t)row * 1536 + hd * 64 + bj * 32 + fq * 8) = pack8(v[bj]);
            }
    }
};
}

#define XB_TMO      128
#define XB_XCNT(j)  (256  + 64 * (j))
#define XB_XSUB(j)  (1280 + 64 * (j))
#define XB_XGEN(j)  (2304 + 64 * (j))
#define XB_TOP      3328
#define XB_TOPGEN   3392
#define XCD_BAR_WORDS 3456
#define XB_SPIN_CAP (1u << 20)
__device__ __forceinline__ unsigned xb_ld(unsigned* p)              { return __hip_atomic_load(p, __ATOMIC_RELAXED, __HIP_MEMORY_SCOPE_AGENT); }
__device__ __forceinline__ unsigned xb_add(unsigned* p, unsigned v) { return __hip_atomic_fetch_add(p, v, __ATOMIC_RELAXED, __HIP_MEMORY_SCOPE_AGENT); }
__device__ __forceinline__ unsigned xb_xcc_id() { return (unsigned)__builtin_amdgcn_s_getreg((3 << 11) | 20) & 0xFu; }
#define XB_SPIN(cond, bar) do { unsigned _sp = 0; while (cond) { __builtin_amdgcn_s_sleep(1); \
    if ((++_sp & 255u) == 0u) { if (xb_ld(&(bar)[XB_TMO])) break; if (_sp > XB_SPIN_CAP) { atomicAdd(&(bar)[XB_TMO], 1u); break; } } } } while (0)
struct XcdBarrier { unsigned* bar; unsigned x; volatile LAS unsigned* st; unsigned nexp; };
__device__ __forceinline__ XcdBarrier xcd_barrier_post(unsigned* bar, volatile LAS unsigned* st, unsigned nexp, bool member) {
    XcdBarrier b; b.bar = bar; b.x = xb_xcc_id(); b.st = st; b.nexp = nexp;
    if (member && threadIdx.x == 0) (void)xb_add(&bar[XB_XCNT(b.x)], 1u);
    return b;
}
__device__ __forceinline__ void xcd_barrier_complete(unsigned* bar, unsigned x, unsigned G, unsigned& nloc, unsigned& nx) {
    unsigned sum, cnt, mine, sp = 0u;
    for (;;) {
        sum = 0u; cnt = 0u; mine = 0u;
#pragma unroll
        for (unsigned j = 0; j < 16; ++j) { const unsigned c = xb_ld(&bar[XB_XCNT(j)]); sum += c; cnt += (c > 0u) ? 1u : 0u; mine = (j == x) ? c : mine; }
        if (sum == G) break;
        __builtin_amdgcn_s_sleep(1);
        if ((++sp & 255u) == 0u) { if (xb_ld(&bar[XB_TMO])) break; if (sp > XB_SPIN_CAP) { atomicAdd(&bar[XB_TMO], 1u); break; } }
    }
    nloc = mine > 0u ? mine : 1u; nx = cnt > 0u ? cnt : 1u;
}
__device__ __forceinline__ void xcd_barrier(const XcdBarrier& b) {
    asm volatile("s_waitcnt vmcnt(0)" ::: "memory");
    __syncthreads();
    if (threadIdx.x == 0) {
        unsigned* bar = b.bar;
        __builtin_amdgcn_s_waitcnt(0);
        unsigned nloc = b.st[0], nx = b.st[1];
        if (nloc == 0u) { xcd_barrier_complete(bar, b.x, b.nexp, nloc, nx); b.st[0] = nloc; b.st[1] = nx; }
        const unsigned old = xb_add(&bar[XB_XSUB(b.x)], 1u);
        const unsigned gen = old / nloc;
        if (old + 1u == (gen + 1u) * nloc) {
            __builtin_amdgcn_fence(__ATOMIC_RELEASE, "agent");
            asm volatile("s_waitcnt vmcnt(0)" ::: "memory");
            const unsigned og = xb_add(&bar[XB_TOP], 1u);
            const unsigned tg = og / nx;
            if (og + 1u == (tg + 1u) * nx) xb_add(&bar[XB_TOPGEN], 1u);
            else XB_SPIN(xb_ld(&bar[XB_TOPGEN]) == tg, bar);
            __builtin_amdgcn_fence(__ATOMIC_ACQUIRE, "agent");
            xb_add(&bar[XB_XGEN(b.x)], 1u);
            asm volatile("s_waitcnt vmcnt(0)" ::: "memory");
        } else {
            XB_SPIN(xb_ld(&bar[XB_XGEN(b.x)]) == gen, bar);
            __builtin_amdgcn_fence(__ATOMIC_ACQUIRE, "agent");
            asm volatile("s_waitcnt vmcnt(0)" ::: "memory");
        }
    }
    __syncthreads();
}

struct Args { const float* in[39]; const int* pos; float* out; unsigned char* ws; int ph_lo, ph_hi, variant, pad; };
enum InIdx { I_X = 0, I_NORM_MIX0 = 1, I_W_IN, I_MU, I_W0, I_WDEC, I_A0, I_WICL, I_WGAT, I_KK, I_KA, I_RK, I_GNW, I_GNB, I_CONVW, I_CONVB, I_DTB, I_ALOG, I_DSKIP, I_SSDN,
             I_WOUT, I_NORM_FFN0, I_FG, I_FU, I_FD, I_NORM_MIX1, I_WQKV, I_BQKV, I_QN, I_KN, I_SINK, I_WO, I_BO, I_NORM_FFN1, I_ROUTER, I_EG, I_EU, I_ED };

__device__ __forceinline__ void transpose_item(const float* W, int ld, int K, int k0, int n0, bf16_t* WT, int drow, LAS float* scr, int lane, const float* gk) {
    f32x4 v[8]; const int kr = lane >> 3, n4 = 4 * (lane & 7); const float* wp = W + (size_t)(k0 + kr) * ld + n0 + n4;
#pragma unroll
    for (int i = 0; i < 8; ++i) v[i] = *(const f32x4*)(wp + (size_t)(8 * i) * ld);
    if (gk) { const float* gp = gk + k0 + kr;
#pragma unroll
        for (int i = 0; i < 8; ++i) v[i] = v[i] * gp[8 * i]; }
#pragma unroll
    for (int i = 0; i < 8; ++i) { LAS float* sp = scr + (8 * i + kr) * 33 + n4; sp[0] = v[i][0]; sp[1] = v[i][1]; sp[2] = v[i][2]; sp[3] = v[i][3]; }
    asm volatile("s_waitcnt lgkmcnt(0)" ::: "memory");
    const int c = lane & 7;
#pragma unroll
    for (int j = 0; j < 4; ++j) { const int n = (lane >> 3) + 8 * j; const LAS float* s = scr + (8 * c) * 33 + n;
        u32x4 o; o.x = pk2(s[0 * 33], s[1 * 33]); o.y = pk2(s[2 * 33], s[3 * 33]); o.z = pk2(s[4 * 33], s[5 * 33]); o.w = pk2(s[6 * 33], s[7 * 33]);
        *(u32x4*)(WT + (size_t)(drow + n) * K + k0 + 8 * c) = o; }
    asm volatile("s_waitcnt lgkmcnt(0)" ::: "memory");
}
__device__ __forceinline__ int drow_of(int kind, int n0) {
    if (kind == 0) return n0;
    if (kind == 1) return 256 * (n0 >> 7) + (n0 & 127);
    if (kind == 2) return 256 * (n0 >> 7) + 128 + (n0 & 127);
    const int hd = n0 >> 6, bj = (n0 >> 5) & 1; return 256 * (hd >> 2) + 128 * bj + 32 * (hd & 3);
}
__device__ __forceinline__ bool transpose_matrix(int& it, const float* W, int ld, int K, int ncols, bf16_t* WT, int kind, LAS float* scr, int lane, const float* gk = nullptr) {
    const int nnb = ncols / 32, items = (K / 64) * nnb;
    if (it < items) { const int kb = it / nnb, nb = it % nnb; transpose_item(W, ld, K, 64 * kb, 32 * nb, WT, drow_of(kind, 32 * nb), scr, lane, gk); return true; }
    it -= items; return false;
}

__device__ __forceinline__ u32x4 conv8(const bf16_t* proj, size_t m, int tpos, int c, const float* cw, const float* cb) {
    const bf16_t* p = proj + m * NPROJ + 2304 + c; u32x4 raw[4];
#pragma unroll
    for (int k = 0; k < 4; ++k) raw[k] = *(const u32x4*)(p - (size_t)(tpos >= k ? k : 0) * NPROJ);
    float acc[8];
    { const f32x4 b0 = *(const f32x4*)(cb + c), b1 = *(const f32x4*)(cb + c + 4); acc[0] = b0[0]; acc[1] = b0[1]; acc[2] = b0[2]; acc[3] = b0[3]; acc[4] = b1[0]; acc[5] = b1[1]; acc[6] = b1[2]; acc[7] = b1[3]; }
#pragma unroll
    for (int k = 0; k < 4; ++k) { float x[8]; unpack8(raw[k], x); const float ok = tpos >= k ? 1.f : 0.f; const f32x4 w0 = *(const f32x4*)(cw + (3 - k) * 1024 + c), w1 = *(const f32x4*)(cw + (3 - k) * 1024 + c + 4);
        acc[0] += ok * w0[0] * x[0]; acc[1] += ok * w0[1] * x[1]; acc[2] += ok * w0[2] * x[2]; acc[3] += ok * w0[3] * x[3]; acc[4] += ok * w1[0] * x[4]; acc[5] += ok * w1[1] * x[5]; acc[6] += ok * w1[2] * x[6]; acc[7] += ok * w1[3] * x[7]; }
#pragma unroll
    for (int i = 0; i < 8; ++i) acc[i] = siluf_(acc[i]);
    return pack8(acc);
}
__device__ __forceinline__ void conv8_fetch(u32x4 (&raw)[4], const bf16_t* proj, size_t m, int tpos, int c) {
    const bf16_t* p = proj + m * NPROJ + 2304 + c;
#pragma unroll
    for (int k = 0; k < 4; ++k) raw[k] = *(const u32x4*)(p - (size_t)(tpos >= k ? k : 0) * NPROJ);
}
__device__ __forceinline__ u32x4 conv8_apply(const u32x4 (&raw)[4], int tpos, int c, const float* cw, const float* cb) {
    float acc[8];
    { const f32x4 b0 = *(const f32x4*)(cb + c), b1 = *(const f32x4*)(cb + c + 4); acc[0] = b0[0]; acc[1] = b0[1]; acc[2] = b0[2]; acc[3] = b0[3]; acc[4] = b1[0]; acc[5] = b1[1]; acc[6] = b1[2]; acc[7] = b1[3]; }
#pragma unroll
    for (int k = 0; k < 4; ++k) { float x[8]; unpack8(raw[k], x); const float ok = tpos >= k ? 1.f : 0.f; const f32x4 w0 = *(const f32x4*)(cw + (3 - k) * 1024 + c), w1 = *(const f32x4*)(cw + (3 - k) * 1024 + c + 4);
        acc[0] += ok * w0[0] * x[0]; acc[1] += ok * w0[1] * x[1]; acc[2] += ok * w0[2] * x[2]; acc[3] += ok * w0[3] * x[3]; acc[4] += ok * w1[0] * x[4]; acc[5] += ok * w1[1] * x[5]; acc[6] += ok * w1[2] * x[6]; acc[7] += ok * w1[3] * x[7]; }
#pragma unroll
    for (int i = 0; i < 8; ++i) acc[i] = siluf_(acc[i]);
    return pack8(acc);
}
__device__ __forceinline__ u32x2 conv4(const bf16_t* proj, size_t m, int tpos, int c, const float* cw, const float* cb) {
    const bf16_t* p = proj + m * NPROJ + 2304 + c; u32x2 raw[4];
#pragma unroll
    for (int k = 0; k < 4; ++k) raw[k] = *(const u32x2*)(p - (size_t)(tpos >= k ? k : 0) * NPROJ);
    f32x4 acc = *(const f32x4*)(cb + c);
#pragma unroll
    for (int k = 0; k < 4; ++k) { const float ok = tpos >= k ? 1.f : 0.f; const f32x4 w0 = *(const f32x4*)(cw + (3 - k) * 1024 + c);
        acc[0] += ok * w0[0] * bflo(raw[k].x); acc[1] += ok * w0[1] * bfhi(raw[k].x); acc[2] += ok * w0[2] * bflo(raw[k].y); acc[3] += ok * w0[3] * bfhi(raw[k].y); }
    u32x2 o; o.x = pk2(siluf_(acc[0]), siluf_(acc[1])); o.y = pk2(siluf_(acc[2]), siluf_(acc[3])); return o;
}

#ifndef DUPM
#define DUPM 0u
#endif

#define XN ((bf16_t*)(ws + WS_XN))
#define MIX ((bf16_t*)(ws + WS_MIX))
#define PROJ ((bf16_t*)(ws + WS_PROJ))
#define GOUT ((bf16_t*)(ws + WS_GOUT))
#define XNB ((bf16_t*)(ws + WS_XNB))
#define HID ((bf16_t*)(ws + WS_HID))
#define QKV ((bf16_t*)(ws + WS_QKV))
#define ATTO ((bf16_t*)(ws + WS_ATTO))
#define AS ((bf16_t*)(ws + WS_AS))
#define HS ((bf16_t*)(ws + WS_HS))
#define SSTATE ((bf16_t*)(ws + 54 * MiB))
#define CHDEC ((float*)(ws + WS_TOPE))
#define DTSP ((float*)(ws + WS_DTSP))
#define KKR ((float*)(ws + WS_KKR))
#define ROPE ((float*)(ws + WS_ROPE))
#define SS ((float*)(ws + WS_SS))
#define TOPE ((int*)(ws + WS_TOPE))
#define RANK ((int*)(ws + WS_RANK))
#define TOPW ((float*)(ws + WS_TOPW))
#define POS ((int*)(ws + WS_POS))
#define RSTD4 ((float*)(ws + WS_RSTD4))
#define RSTDS ((float*)(ws + WS_RSTDS))
#define SRCE ((int*)(ws + WS_KKR))
#define WDEC ((bf16_t*)(ws + WS_WDEC))
#define WICL ((bf16_t*)(ws + WS_WICL))
#define WGAT ((bf16_t*)(ws + WS_WGAT))
#define EGU ((bf16_t*)(ws + WS_EGU))
#define EDN ((bf16_t*)dout)
#define H3B ((bf16_t*)(ws + WS_H3B))
#define WIN ((bf16_t*)(ws + WS_WIN))
#define WOUT ((bf16_t*)(ws + WS_WOUT))
#define WGU ((bf16_t*)(ws + WS_WGU))
#define WDN ((bf16_t*)(ws + WS_WDN))
#define WQKV ((bf16_t*)(ws + WS_WQKV))
#define WO ((bf16_t*)(ws + WS_WO))
struct TDesc { const float* src; bf16_t* dst; const float* gk; int ld, K; };
__device__ __forceinline__ void tdesc(TDesc& d, int it, const float* W, int ld, int K, int ncols, bf16_t* WT, int kind, const float* gk) {
    const int nnb = ncols / 32, kb = it / nnb, nb = it % nnb;
    d.src = W + (size_t)(64 * kb) * ld + 32 * nb; d.dst = WT + (size_t)drow_of(kind, 32 * nb) * K + 64 * kb; d.gk = gk ? gk + 64 * kb : nullptr; d.ld = ld; d.K = K;
}
constexpr int CV_P0 = 1728, CV_NE = CV_P0 + 6016, CV_EGU = CV_NE + 16 * 704, CV_END = CV_EGU + 8 * 704;
__device__ __forceinline__ void conv_resolve(const float* const* in, unsigned char* ws, bf16_t* edn, int id, TDesc& d) {
    if (id < 1664) { tdesc(d, id, in[I_W_IN], IN0, DM, NPROJ, (bf16_t*)(ws + WS_WIN), 0, nullptr); return; } id -= 1664;
    if (id < 16) { tdesc(d, id, in[I_WDEC], 512, 64, 512, (bf16_t*)(ws + WS_WDEC), 0, nullptr); return; } id -= 16;
    if (id < 16) { tdesc(d, id, in[I_WICL], 512, 64, 512, (bf16_t*)(ws + WS_WICL), 0, nullptr); return; } id -= 16;
    if (id < 32) { tdesc(d, id, in[I_WGAT], 512, 128, 512, (bf16_t*)(ws + WS_WGAT), 0, nullptr); return; } id -= 32;
    if (id < 512) { tdesc(d, id, in[I_WOUT], DM, DM, DM, (bf16_t*)(ws + WS_WOUT), 0, nullptr); return; } id -= 512;
    if (id < 1408) { tdesc(d, id, in[I_FG], FFN, DM, FFN, (bf16_t*)(ws + WS_WGU), 1, in[I_NORM_FFN0]); return; } id -= 1408;
    if (id < 1408) { tdesc(d, id, in[I_FU], FFN, DM, FFN, (bf16_t*)(ws + WS_WGU), 2, in[I_NORM_FFN0]); return; } id -= 1408;
    if (id < 1408) { tdesc(d, id, in[I_FD], DM, FFN, DM, (bf16_t*)(ws + WS_WDN), 0, nullptr); return; } id -= 1408;
    if (id < 768) { tdesc(d, id, in[I_WQKV], 1536, DM, 1536, (bf16_t*)(ws + WS_WQKV), 3, in[I_NORM_MIX1]); return; } id -= 768;
    if (id < 512) { tdesc(d, id, in[I_WO], DM, DM, DM, (bf16_t*)(ws + WS_WO), 0, nullptr); return; } id -= 512;
    if (id < 16 * 704) { const int e = id / 1408, r = id % 1408, up = r / 704;
        tdesc(d, r % 704, in[up ? I_EU : I_EG] + (size_t)e * DM * FE, FE, DM, FE, (bf16_t*)(ws + WS_EGU) + (size_t)e * 2 * FE * DM, 1 + up, in[I_NORM_FFN1]); return; } id -= 16 * 704;
    { const int e = id / 704; tdesc(d, id % 704, in[I_ED] + (size_t)e * FE * DM, DM, FE, DM, edn + (size_t)e * DM * FE, 0, nullptr); }
}
__device__ __forceinline__ void conv_load(const TDesc& d, f32x4 (&v)[8], int lane) {
    const float* wp = d.src + (size_t)(lane >> 3) * d.ld + 4 * (lane & 7);
#pragma unroll
    for (int i = 0; i < 8; ++i) v[i] = __builtin_nontemporal_load((const f32x4*)(wp + (size_t)(8 * i) * d.ld));
}
__device__ __forceinline__ void conv_finish(const TDesc& d, f32x4 (&v)[8], LAS float* scr, int lane) {
    const int kr = lane >> 3, n4 = 4 * (lane & 7);
    if (d.gk) {
#pragma unroll
        for (int i = 0; i < 8; ++i) v[i] = v[i] * d.gk[kr + 8 * i]; }
#pragma unroll
    for (int i = 0; i < 8; ++i) { LAS float* sp = scr + (8 * i + kr) * 33 + n4; sp[0] = v[i][0]; sp[1] = v[i][1]; sp[2] = v[i][2]; sp[3] = v[i][3]; }
    asm volatile("s_waitcnt lgkmcnt(0)" ::: "memory");
    const int c = lane & 7;
#pragma unroll
    for (int j = 0; j < 4; ++j) { const int n = (lane >> 3) + 8 * j; const LAS float* s = scr + (8 * c) * 33 + n;
        u32x4 o; o.x = pk2(s[0 * 33], s[1 * 33]); o.y = pk2(s[2 * 33], s[3 * 33]); o.z = pk2(s[4 * 33], s[5 * 33]); o.w = pk2(s[6 * 33], s[7 * 33]);
        *(u32x4*)(d.dst + (size_t)n * d.K + 8 * c) = o; }
    asm volatile("s_waitcnt lgkmcnt(0)" ::: "memory");
}
__device__ __forceinline__ void conv_range(const float* const* in, unsigned char* ws, bf16_t* edn, int lo, int hi, int first, int stride, LAS float* scr, int lane) {
    int id = lo + first; if (id >= hi) return;
    TDesc d0, d1, d2; f32x4 v0[8], v1[8], v2[8];
    conv_resolve(in, ws, edn, id, d0); conv_load(d0, v0, lane); d1 = d0; d2 = d0;
    bool h1 = id + stride < hi;
    if (h1) { conv_resolve(in, ws, edn, id + stride, d1); conv_load(d1, v1, lane); }
    for (;;) {
        const bool h2 = h1 && (id + 2 * stride < hi);
        if (h2) { conv_resolve(in, ws, edn, id + 2 * stride, d2); conv_load(d2, v2, lane); }
        conv_finish(d0, v0, scr, lane);
        if (!h1) break;
        d0 = d1; d1 = d2; h1 = h2; id += stride;
#pragma unroll
        for (int i = 0; i < 8; ++i) { v0[i] = v1[i]; v1[i] = v2[i]; }
    }
}

__global__ void __launch_bounds__(512, 2) fwd_kernel(Args args) {
    extern __shared__ __attribute__((aligned(16))) unsigned char lds_raw[];
    LAS unsigned char* lds = (LAS unsigned char*)lds_raw;
    volatile LAS unsigned* MISC = (volatile LAS unsigned*)(lds + MISC_OFF);
    const int tid = threadIdx.x, lane = tid & 63, wave = __builtin_amdgcn_readfirstlane(tid >> 6);
    const int G = gridDim.x, bx = blockIdx.x;
    const int vcu = (G % 8 == 0) ? (bx % 8) * (G / 8) + bx / 8 : bx;
    unsigned char* ws = args.ws;
    unsigned* ctl = (unsigned*)(ws + WS_CTL);
    float* dout = args.out;
    if (tid < 32) ((LAS unsigned*)(lds + MISC_OFF))[tid] = 0u;
    __syncthreads();
    XcdBarrier bar = xcd_barrier_post(ctl + CW_BAR, MISC + 8, (unsigned)G, true);
    XcdBarrier bar2 = xcd_barrier_post(ctl + CW_BAR2, MISC + 16, (unsigned)(G - 32), bx >= 32);
    const int lo = args.ph_lo, hi = args.ph_hi;
#define IN(k) (lo <= (k) && (k) < hi)
#if DUPM
#define PHASE(k) for (int rep_ = 0; rep_ <= (int)((DUPM >> (k)) & 1u); ++rep_) if (IN(k))
#define REPBAR if (rep_) xcd_barrier(bar);
#else
#define PHASE(k) if (IN(k))
#define REPBAR
#endif
#define SEAM(k) do { if (IN(k) && IN((k) + 1)) xcd_barrier(bar); } while (0)
    const int gw = vcu * 8 + wave, NGW = G * 8;

    unsigned* CNT = ctl + CW_CNT;

    PHASE(0) { REPBAR
        conv_range(args.in, ws, (bf16_t*)args.out, 0, CV_P0, gw, NGW, (LAS float*)(lds + wave * 16384), lane);
        __syncthreads();
        LAS float* w8 = (LAS float*)lds;
        for (int r = tid; r < DM; r += 512) { const float* p = args.in[I_W_IN] + (size_t)r * IN0 + NPROJ; *(LAS f32x4*)(w8 + r * 8) = *(const f32x4*)p; *(LAS f32x4*)(w8 + r * 8 + 4) = *(const f32x4*)(p + 4); }
        __syncthreads();
        const float* gm = args.in[I_NORM_MIX0];
        f32x4 wreg[16][2], g4r[4];
#pragma unroll
        for (int j = 0; j < 4; ++j) { g4r[j] = ((const f32x4*)gm)[64 * j + lane];
#pragma unroll
            for (int i = 0; i < 4; ++i) { const int c = 256 * j + 4 * lane + i; wreg[4 * j + i][0] = *(const LAS f32x4*)(w8 + c * 8); wreg[4 * j + i][1] = *(const LAS f32x4*)(w8 + c * 8 + 4); } }
#pragma unroll 1
        for (int k0 = 0; k0 < MTOK / NGW; k0 += 4) {
          f32x4 vv[4][4];
#pragma unroll
          for (int q = 0; q < 4; ++q) { const f32x4* xr = (const f32x4*)(args.in[I_X] + (size_t)(gw + (k0 + q) * NGW) * DM) + lane;
#pragma unroll
              for (int j = 0; j < 4; ++j) vv[q][j] = __builtin_nontemporal_load(xr + 64 * j); }
#pragma unroll
          for (int q = 0; q < 4; ++q) { const int m = gw + (k0 + q) * NGW;
            f32x4 v[4]; float s = 0.f;
#pragma unroll
            for (int j = 0; j < 4; ++j) { v[j] = vv[q][j]; s += (v[j][0] * v[j][0] + v[j][1] * v[j][1]) + (v[j][2] * v[j][2] + v[j][3] * v[j][3]); }
            const float rstd = __builtin_amdgcn_rsqf(wave_sum(s) * (1.0f / DM) + EPS);
            float d[8];
#pragma unroll
            for (int k = 0; k < 8; ++k) d[k] = 0.f;
            unsigned long long* o8 = (unsigned long long*)(XN + (size_t)m * DM) + lane;
#pragma unroll
            for (int j = 0; j < 4; ++j) { const f32x4 g4 = g4r[j]; const f32x4 y = v[j] * rstd * g4;
                o8[64 * j] = (unsigned long long)pk2(y[0], y[1]) | ((unsigned long long)pk2(y[2], y[3]) << 32);
#pragma unroll
                for (int i = 0; i < 4; ++i) { const f32x4 wa = wreg[4 * j + i][0], wb = wreg[4 * j + i][1];
                    d[0] += y[i] * wa[0]; d[1] += y[i] * wa[1]; d[2] += y[i] * wa[2]; d[3] += y[i] * wa[3]; d[4] += y[i] * wb[0]; d[5] += y[i] * wb[1]; d[6] += y[i] * wb[2]; d[7] += y[i] * wb[3]; } }
            wave_sum8(d);
            if (lane < 8) { float dv = d[0];
#pragma unroll
                for (int k = 1; k < 8; ++k) dv = (lane == k) ? d[k] : dv;
                const float z = dv + args.in[I_DTB][lane]; DTSP[(size_t)m * 8 + lane] = z > 20.f ? z : log1pf(__expf(z)); }
            if (lane >= 16 && lane < 24) { const int j = lane - 16; const float inv = expf(-(float)j * (0.125f * 13.122363377404328f)); const float ang = (float)args.pos[m] * inv;
                float sn, cs; sincosf(ang, &sn, &cs); ROPE[(size_t)m * 16 + j] = cs; ROPE[(size_t)m * 16 + 8 + j] = sn; }
          }
        }
        __syncthreads();
    }
    SEAM(0);

    PHASE(1) { REPBAR
        pg8::Gemm g{XN, WIN, MTOK, NPROJ, DM}; pg8::StaticOrder S; S.init(MTOK, NPROJ, G, bx);
        pg8::EpiBf16 E{PROJ, NPROJ};
        pg8::gemm_phase(lds, g, S, E);
        if (bx >= 64) {
            conv_range(args.in, ws, (bf16_t*)args.out, CV_P0, CV_NE, (bx - 64) * 8 + wave, 192 * 8, (LAS float*)(lds + wave * 16384), lane);
            conv_range(args.in, ws, (bf16_t*)args.out, CV_NE + 4 * 704, CV_NE + 8 * 704, (bx - 64) * 8 + wave, 192 * 8, (LAS float*)(lds + wave * 16384), lane);
        }
    }
    SEAM(1);

#define LANE_CONSTS const int r32 = lane & 31, hh = lane >> 5, trq = (lane & 15) >> 2, trc = 16 * ((lane >> 4) & 1) + 4 * (lane & 3)
#define TRF(M, P, s, blk) ({ const LAS bf16_t* p_ = (M) + (16 * (s) + 8 * hh + trq) * (P) + 32 * (blk) + trc; \
        const s16x4 lo_ = __builtin_bit_cast(s16x4, __builtin_amdgcn_ds_read_tr16_b64_v4i16((LAS s16x4*)p_)); \
        const s16x4 hi_ = __builtin_bit_cast(s16x4, __builtin_amdgcn_ds_read_tr16_b64_v4i16((LAS s16x4*)(p_ + 4 * (P)))); \
        (bf16x8){lo_[0], lo_[1], lo_[2], lo_[3], hi_[0], hi_[1], hi_[2], hi_[3]}; })
#define NATF(M, P, s, blk) (*(const LAS bf16x8*)((M) + (32 * (blk) + r32) * (P) + 16 * (s) + 8 * hh))
    PHASE(2) { REPBAR
        LANE_CONSTS;
        const float* mu = args.in[I_MU];
        LAS bf16_t* Aw = (LAS bf16_t*)lds; LAS bf16_t* Aa = (LAS bf16_t*)(lds + 9216); LAS bf16_t* Ag = (LAS bf16_t*)(lds + 18432);
        LAS float* LW = (LAS float*)(lds + 35840); LAS float* IC = LW + 4096;
        LAS bf16_t* At = (LAS bf16_t*)(lds + 68864); LAS bf16_t* Kt = At + 4608; LAS bf16_t* Bt = Kt + 4608; LAS bf16_t* Rt = Bt + 4608; LAS bf16_t* Vt = Rt + 4608;
        LAS bf16_t* Lab = (LAS bf16_t*)(lds + 35840);
        LAS bf16_t* XX = At;
        LAS bf16_t* Lak = (LAS bf16_t*)(lds + 114944); LAS bf16_t* Mrk = Lak + 4608; LAS bf16_t* Mrb = Mrk + 4608;
        LAS float* TOT = (LAS float*)(lds + 142592); LAS float* GAMC = TOT + 512;
        const int mt = (wave >> 1) & 1, nt = wave & 1, grp = wave >> 2;
        for (int unit = vcu; unit < MTOK / 64; unit += G) {
            const int m0 = unit * 64;
            {
                const int tt = tid >> 3, cg = tid & 7, m = m0 + tt; const bool hasprev = (m & (SEQ - 1)) != 0;
                const bf16_t* pc = PROJ + (size_t)m * NPROJ + 1536 + 32 * cg;
#pragma unroll 1
                for (int q = 0; q < 4; ++q) {
                    float c[8], p[8]; unpack8(*(const u32x4*)(pc + 8 * q), c);
                    if (hasprev) unpack8(*(const u32x4*)(pc - NPROJ + 8 * q), p); else { for (int i = 0; i < 8; ++i) p[i] = 0.f; }
                    float o[8];
#pragma unroll
                    for (int i = 0; i < 8; ++i) { const int col = 32 * cg + 8 * q + i; const float x = c[i] + (p[i] - c[i]) * mu[1536 + col];
                        o[i] = cg < 2 ? tanhf(x) : (cg < 4 ? x : sigmoidf_(x)); }
                    const u32x4 w = pack8(o); const int col0 = 32 * cg + 8 * q;
                    if (cg < 2) *(LAS u32x4*)(Aw + tt * 72 + col0) = w; else if (cg < 4) *(LAS u32x4*)(Aa + tt * 72 + (col0 - 64)) = w; else *(LAS u32x4*)(Ag + tt * 136 + (col0 - 128)) = w;
                }
            }
            LBAR();
            bf16x8 lw8[8]; float w0c, a0c;
#define LORA_LOAD(hn) do { if (grp == 0) { _Pragma("unroll") for (int s = 0; s < 4; ++s) { lw8[2 * s] = *(const bf16x8*)(WDEC + (size_t)(64 * (hn) + 32 * nt + r32) * 64 + 16 * s + 8 * hh); \
                lw8[2 * s + 1] = *(const bf16x8*)(WICL + (size_t)(64 * (hn) + 32 * nt + r32) * 64 + 16 * s + 8 * hh); } } \
            else { _Pragma("unroll") for (int s = 0; s < 8; ++s) lw8[s] = *(const bf16x8*)(WGAT + (size_t)(64 * (hn) + 32 * nt + r32) * 128 + 16 * s + 8 * hh); } \
            w0c = args.in[I_W0][64 * (hn) + 32 * nt + r32]; a0c = args.in[I_A0][64 * (hn) + 32 * nt + r32]; } while (0)
#pragma unroll 1
            for (int h = 0; h < 8; ++h) {
                LORA_LOAD(h);
                unsigned char* cs = (unsigned char*)dout + (size_t)(((unit >> 6) * 8 + h) * 64 + (unit & 63)) * 24576;
                float r0v[8], k0v[8], v0v[8]; float pr = 0.f, pk = 0.f, pv = 0.f;
                const float mur = mu[64 * h + lane], muk = mu[512 + 64 * h + lane], muv = mu[1024 + 64 * h + lane], kkc = args.in[I_KK][64 * h + lane], kac = args.in[I_KA][64 * h + lane], rkc = args.in[I_RK][64 * h + lane];
                {   const bf16_t* pp = PROJ + (size_t)(m0 + 8 * wave) * NPROJ + 64 * h + lane;
                    if (((m0 + 8 * wave) & (SEQ - 1)) != 0) { pr = bflo(__builtin_nontemporal_load(pp - NPROJ)); pk = bflo(__builtin_nontemporal_load(pp - NPROJ + 512)); pv = bflo(__builtin_nontemporal_load(pp - NPROJ + 1024)); }
#pragma unroll
                    for (int i = 0; i < 8; ++i) { r0v[i] = bflo(__builtin_nontemporal_load(pp + (size_t)i * NPROJ)); k0v[i] = bflo(__builtin_nontemporal_load(pp + (size_t)i * NPROJ + 512)); v0v[i] = bflo(__builtin_nontemporal_load(pp + (size_t)i * NPROJ + 1024)); } }
                if (grp == 0) {
                    f32x16 ad, ai;
#pragma unroll
                    for (int r = 0; r < 16; ++r) { ad[r] = 0.f; ai[r] = 0.f; }
#pragma unroll
                    for (int s = 0; s < 4; ++s) {
                        const bf16x8 bd = lw8[2 * s], bi = lw8[2 * s + 1];
                        ad = __builtin_amdgcn_mfma_f32_32x32x16_bf16(NATF(Aw, 72, s, mt), bd, ad, 0, 0, 0);
                        ai = __builtin_amdgcn_mfma_f32_32x32x16_bf16(NATF(Aa, 72, s, mt), bi, ai, 0, 0, 0);
                    }
                    const int c = 32 * nt + r32;
                    LAS float* lwb = LW + (32 * mt + 4 * hh) * 64 + c;
#pragma unroll
                    for (int r = 0; r < 16; ++r) { lwb[crc(r) * 64] = -0.6065306597126334f * sigmoidf_(ad[r] + w0c); lwb[4096 + crc(r) * 64] = sigmoidf_(ai[r] + a0c); }
                } else {
                    f32x16 ag;
#pragma unroll
                    for (int r = 0; r < 16; ++r) ag[r] = 0.f;
#pragma unroll
                    for (int s = 0; s < 8; ++s) {
                        const bf16x8 bg = lw8[s];
                        ag = __builtin_amdgcn_mfma_f32_32x32x16_bf16(NATF(Ag, 136, s, mt), bg, ag, 0, 0, 0);
                    }
                    tile_store_bf16<false>(Rt + (wave - 4) * 1280, ag, GOUT + (size_t)(m0 + 32 * mt) * 512 + 64 * h + 32 * nt, 512, lane);
                }
                LBAR();
                {
                    const int c = lane, gc = 64 * h + c, t0 = 8 * wave;
                    float rr[8], kx[8], vv[8], an[8], bn[8], lw[8], cl[8]; float run = 0.f;
#pragma unroll
                    for (int i = 0; i < 8; ++i) {
                        const float r0 = r0v[i], k0 = k0v[i], v0 = v0v[i];
                        rr[i] = r0 + (pr - r0) * mur; const float kl = k0 + (pk - k0) * muk; vv[i] = v0 + (pv - v0) * muv; pr = r0; pk = k0; pv = v0;
                        const float ic = IC[(t0 + i) * 64 + c]; lw[i] = LW[(t0 + i) * 64 + c]; run += lw[i]; cl[i] = run;
                        const float xk = kl * kkc; const float ssq = dpp_sum63(xk * xk); const float kn = xk * __builtin_amdgcn_rsqf(ssq + 1e-12f);
                        an[i] = -kn; bn[i] = kn * ic; kx[i] = kl * (1.0f + (ic - 1.0f) * kac);
                        const float bon = dpp_sum63(rr[i] * kx[i] * rkc);
                        if (lane == 0) KKR[(size_t)(m0 + t0 + i) * 8 + h] = bon;
                    }
                    TOT[wave * 64 + c] = run;
                    LBAR();
                    float off = 0.f, totc = 0.f;
#pragma unroll
                    for (int w2 = 0; w2 < 8; ++w2) { const float tv = TOT[w2 * 64 + c]; totc += tv; off += (w2 < wave) ? tv : 0.f; }
                    if (wave == 0) GAMC[c] = __expf(totc);
#pragma unroll
                    for (int i = 0; i < 8; ++i) { const float cum = off + cl[i]; const float en = __expf(-cum), ep = __expf(cum), em = __expf(cum - lw[i]); const int o = (t0 + i) * 72 + c;
                        At[o] = (bf16_t)f2bf(an[i] * em); Kt[o] = (bf16_t)f2bf(kx[i] * en); Bt[o] = (bf16_t)f2bf(bn[i] * en); Rt[o] = (bf16_t)f2bf(rr[i] * ep); Vt[o] = (bf16_t)f2bf(vv[i]); }
                }
                LBAR();
                {
                    f32x16 pb, pk2_;
#pragma unroll
                    for (int r = 0; r < 16; ++r) { pb[r] = 0.f; pk2_[r] = 0.f; }
                    const LAS bf16_t* Aop = grp == 0 ? At : Rt;
#pragma unroll
                    for (int s = 0; s < 4; ++s) { const bf16x8 a = NATF(Aop, 72, s, mt);
                        pb = __builtin_amdgcn_mfma_f32_32x32x16_bf16(a, NATF(Bt, 72, s, nt), pb, 0, 0, 0);
                        pk2_ = __builtin_amdgcn_mfma_f32_32x32x16_bf16(a, NATF(Kt, 72, s, nt), pk2_, 0, 0, 0); }
                    const int sc = 32 * nt + r32, tb = 32 * mt + 4 * hh;
                    LAS bf16_t* o1 = (grp == 0 ? Lab : Mrb) + tb * 72 + sc; LAS bf16_t* o2 = (grp == 0 ? Lak : Mrk) + tb * 72 + sc;
#pragma unroll
                    for (int r = 0; r < 16; ++r) { const int t = tb + crc(r); const bool keep = grp == 0 ? (sc < t) : (sc <= t);
                        o1[crc(r) * 72] = (bf16_t)f2bf(keep ? pb[r] : 0.f); o2[crc(r) * 72] = (bf16_t)f2bf(keep ? pk2_[r] : 0.f); }
                }
                LBAR();
                f32x16 accA, accB;
#pragma unroll
                for (int r = 0; r < 16; ++r) { accA[r] = 0.f; accB[r] = 0.f; }
                {
                    const LAS bf16_t* Aop = grp == 0 ? Lak : Mrk;
#pragma unroll
                    for (int s = 0; s < 4; ++s) { const bf16x8 vb = TRF(Vt, 72, s, nt);
                        if (grp == 0) { accA = __builtin_amdgcn_mfma_f32_32x32x16_bf16(NATF(Aop, 72, s, mt), vb, accA, 0, 0, 0); accB = __builtin_amdgcn_mfma_f32_32x32x16_bf16(TRF(Kt, 72, s, mt), vb, accB, 0, 0, 0); }
                        else accB = __builtin_amdgcn_mfma_f32_32x32x16_bf16(NATF(Aop, 72, s, mt), vb, accB, 0, 0, 0); }
                    if (grp == 0) { LAS float* ggb = IC + (32 * mt + 4 * hh) * 65 + 32 * nt + r32;
#pragma unroll
                        for (int r = 0; r < 16; ++r) ggb[crc(r) * 65] = accA[r]; }
                }
                LBAR();
                {
                    const int n16 = lane & 15, g4 = lane >> 4;
                    f32x4 Rr[4];
                    if (wave < 4) {
#pragma unroll
                        for (int I = 0; I < 4; ++I)
#pragma unroll
                            for (int j = 0; j < 4; ++j) Rr[I][j] = bflo((unsigned)At[(16 * I + 4 * g4 + j) * 72 + 16 * wave + n16]);
                    } else { const LAS float* GG = IC;
#pragma unroll
                        for (int I = 0; I < 4; ++I)
#pragma unroll
                            for (int j = 0; j < 4; ++j) Rr[I][j] = GG[(16 * I + 4 * g4 + j) * 65 + 16 * (wave - 4) + n16];
                    }
#define MF16(A0, A1, B0, B1, C) __builtin_amdgcn_mfma_f32_16x16x32_bf16(__builtin_bit_cast(bf16x8, (u32x4){(A0).x, (A0).y, (A1).x, (A1).y}), __builtin_bit_cast(bf16x8, (u32x4){(B0).x, (B0).y, (B1).x, (B1).y}), (C), 0, 0, 0)
                    const u32x2 zz = (u32x2){0u, 0u};
                    LAS bf16_t* L2B = (LAS bf16_t*)TOT; LAS bf16_t* L4B = (LAS bf16_t*)(lds + 144896);
                    if (wave < 4) { const LAS bf16_t* lb = Lab + (16 * wave) * 72 + 16 * wave; const f32x4 z4 = (f32x4){0.f, 0.f, 0.f, 0.f};
                        const u32x2 la = *(const LAS u32x2*)(lb + n16 * 72 + 4 * g4);
                        u32x2 lq; lq.x = (unsigned)lb[(4 * g4) * 72 + n16] | ((unsigned)lb[(4 * g4 + 1) * 72 + n16] << 16); lq.y = (unsigned)lb[(4 * g4 + 2) * 72 + n16] | ((unsigned)lb[(4 * g4 + 3) * 72 + n16] << 16);
                        const f32x4 P2 = MF16(la, zz, lq, zz, z4);
                        u32x2 p2q; p2q.x = pk2(P2[0], P2[1]); p2q.y = pk2(P2[2], P2[3]);
                        LAS bf16_t* w2 = L2B + wave * 256 + (4 * g4) * 16 + n16;
                        w2[0] = (bf16_t)(p2q.x & 0xffffu); w2[16] = (bf16_t)(p2q.x >> 16); w2[32] = (bf16_t)(p2q.y & 0xffffu); w2[48] = (bf16_t)(p2q.y >> 16);
                        asm volatile("s_waitcnt lgkmcnt(0)" ::: "memory");
                        const u32x2 l2a = *(const LAS u32x2*)(L2B + wave * 256 + n16 * 16 + 4 * g4);
                        const f32x4 P4 = MF16(l2a, zz, p2q, zz, z4);
                        const unsigned q0 = pk2(P4[0], P4[1]), q1 = pk2(P4[2], P4[3]);
                        LAS bf16_t* w4 = L4B + wave * 256 + (4 * g4) * 16 + n16;
                        w4[0] = (bf16_t)(q0 & 0xffffu); w4[16] = (bf16_t)(q0 >> 16); w4[32] = (bf16_t)(q1 & 0xffffu); w4[48] = (bf16_t)(q1 >> 16); }
                    LBAR();
                    const LAS bf16_t* lrow = Lab + n16 * 72 + 4 * g4;
#define LF(I, J) (*(const LAS u32x2*)(lrow + (16 * (I)) * 72 + 16 * (J)))
                    u32x2 Xb[4];
#pragma unroll
                    for (int I = 0; I < 4; ++I) {
                        f32x4 Z = Rr[I];
                        if (I == 1) Z = MF16(LF(1, 0), zz, Xb[0], zz, Z);
                        if (I == 2) Z = MF16(LF(2, 0), LF(2, 1), Xb[0], Xb[1], Z);
                        if (I == 3) { Z = MF16(LF(3, 0), LF(3, 1), Xb[0], Xb[1], Z); Z = MF16(LF(3, 2), zz, Xb[2], zz, Z); }
                        const u32x2 ld = LF(I, I), l2 = *(const LAS u32x2*)(L2B + I * 256 + n16 * 16 + 4 * g4), l4 = *(const LAS u32x2*)(L4B + I * 256 + n16 * 16 + 4 * g4);
                        u32x2 xb; xb.x = pk2(Z[0], Z[1]); xb.y = pk2(Z[2], Z[3]);
                        const f32x4 W = MF16(ld, zz, xb, zz, Z);
                        xb.x = pk2(W[0], W[1]); xb.y = pk2(W[2], W[3]);
                        const f32x4 V = MF16(l2, zz, xb, zz, W);
                        f32x4 X = V;
#pragma unroll
                        for (int it = 0; it < 3; ++it) { xb.x = pk2(X[0], X[1]); xb.y = pk2(X[2], X[3]); X = MF16(l4, zz, xb, zz, V); }
                        Xb[I].x = pk2(X[0], X[1]); Xb[I].y = pk2(X[2], X[3]);
                        LAS bf16_t* xo = XX + (16 * I + 4 * g4) * 136 + 16 * wave + n16;
                        xo[0] = (bf16_t)(Xb[I].x & 0xffffu); xo[136] = (bf16_t)(Xb[I].x >> 16); xo[272] = (bf16_t)(Xb[I].y & 0xffffu); xo[408] = (bf16_t)(Xb[I].y >> 16);
                    }
#undef LF
#undef MF16
                }
                LBAR();
                {
                    f32x16 acc1;
#pragma unroll
                    for (int r = 0; r < 16; ++r) acc1[r] = 0.f;
#pragma unroll
                    for (int s = 0; s < 4; ++s) {
                        const bf16x8 a = grp == 0 ? TRF(Bt, 72, s, mt) : NATF(Mrb, 72, s, mt);
                        acc1 = __builtin_amdgcn_mfma_f32_32x32x16_bf16(a, TRF(XX, 136, s, nt), acc1, 0, 0, 0);
                        accB = __builtin_amdgcn_mfma_f32_32x32x16_bf16(a, TRF(XX + 64, 136, s, nt), accB, 0, 0, 0);
                    }
                    const int col = 32 * nt + r32, rb = 32 * mt + 4 * hh;
                    const int colp = (col & ~15) | (((col >> 2) & 1) << 3) | (((col >> 3) & 1) << 2) | (col & 3);
                    if (grp == 0) {
                        bf16_t* acb = (bf16_t*)cs + rb * 64 + colp; bf16_t* dcb = (bf16_t*)(cs + 8192) + col * 64 + rb; const LAS float* gb = GAMC + rb;
#pragma unroll
                        for (int r = 0; r < 16; ++r) { const float gcv = gb[crc(r)]; acc1[r] = gcv * (acc1[r] + ((rb + crc(r)) == col ? 1.0f : 0.0f)); }
                        tile_store_bf16<true>(Lak + wave * 1280, acc1, (bf16_t*)cs + (32 * mt) * 64 + 32 * nt, 64, lane);
#pragma unroll
                        for (int rq = 0; rq < 4; ++rq) { const f32x4 g4 = *(const LAS f32x4*)(gb + 8 * rq);
                            u32x2 w; w.x = pk2(accB[4 * rq] * g4[0], accB[4 * rq + 1] * g4[1]); w.y = pk2(accB[4 * rq + 2] * g4[2], accB[4 * rq + 3] * g4[3]); *(u32x2*)(dcb + 8 * rq) = w; }
                    } else {
                        bf16_t* rpb = (bf16_t*)(cs + 16384) + rb * 64 + colp; const LAS bf16_t* rtb = Rt + rb * 72 + col; bf16_t* yb = MIX + (size_t)(m0 + rb) * DM + 64 * h + col;
#pragma unroll
                        for (int r = 0; r < 16; ++r) acc1[r] += bflo((unsigned)rtb[crc(r) * 72]);
                        LAS bf16_t* stg = (LAS bf16_t*)(IC) + (wave - 4) * 1280;
                        tile_store_bf16<true>(stg, acc1, (bf16_t*)(cs + 16384) + (32 * mt) * 64 + 32 * nt, 64, lane);
                        tile_store_bf16<false>(stg, accB, MIX + (size_t)(m0 + 32 * mt) * DM + 64 * h + 32 * nt, DM, lane);
                    }
                }
                LBAR();
            }
        }
    }

#undef LORA_LOAD
    SEAM(2);

    PHASE(3) { REPBAR
        LANE_CONSTS;
        if (bx < 32) {
            const int b = bx >> 3, h = bx & 7;
            const unsigned char* cbase = (const unsigned char*)dout + (size_t)((b * 8 + h) * 64) * 24576;
            constexpr size_t CSTR = (size_t)24576; constexpr int SLOT = 27648;
            const bool loader = wave >= 2 && wave < 6, storer = wave >= 6; const int lw = wave - 2;
            const int nblk = lw < 3 ? 7 : 6; constexpr int ZS0 = 4 * 27648;
            unsigned soff[7];
#pragma unroll
            for (int k = 0; k < 7; ++k) { const int o = 1024 * (lw + 4 * k) + 16 * lane, arr = o / 9216, rr = (o % 9216) / 144, cb = (o % 9216) % 144; soff[k] = (unsigned)(arr * 8192 + rr * 128 + (cb < 128 ? cb : 0)); }
#define RB_DMA(ch) do { if (loader) { const unsigned char* g_ = cbase + (size_t)(ch) * CSTR; LAS unsigned char* s_ = lds + ((ch) & 3) * SLOT + 1024 * lw; \
                _Pragma("unroll") for (int k = 0; k < 7; ++k) if (k < nblk) __builtin_amdgcn_global_load_lds((const unsigned*)(g_ + soff[k]), (LAS unsigned*)(s_ + 4096 * k), 16, 0, 2  ); } } while (0)
#define RB_WAIT2() do { if (loader) { if (nblk == 7) asm volatile("s_waitcnt vmcnt(14)" ::: "memory"); else asm volatile("s_waitcnt vmcnt(12)" ::: "memory"); } } while (0)
#define RB_WAIT1() do { if (loader) { if (nblk == 7) asm volatile("s_waitcnt vmcnt(7)" ::: "memory"); else asm volatile("s_waitcnt vmcnt(6)" ::: "memory"); } } while (0)
#define RB_WAIT0() do { if (loader) asm volatile("s_waitcnt vmcnt(0)" ::: "memory"); } while (0)
            bf16_t* zg = (bf16_t*)((unsigned char*)dout + 48 * MiB) + (size_t)(b * SEQ) * 512 + 64 * h;
#define RB_ZOUT(chz) do { const LAS unsigned char* zs_ = lds + ZS0 + ((chz) & 1) * 9216; const int st_ = tid - 384; _Pragma("unroll") for (int k = 0; k < 4; ++k) { const int p = st_ + 128 * k, row = p >> 3, c8 = p & 7; \
                __builtin_nontemporal_store(*(const LAS u32x4*)(zs_ + row * 144 + c8 * 16), (u32x4*)(zg + (size_t)((chz) * 64 + row) * 512 + 8 * c8)); } } while (0)
            RB_DMA(0); RB_DMA(1); RB_DMA(2); RB_WAIT2();
            LBAR();
            f32x16 H[2];
#pragma unroll
            for (int r = 0; r < 16; ++r) { H[0][r] = 0.f; H[1][r] = 0.f; }
            f32x16 Zp[2];
#pragma unroll
            for (int r = 0; r < 16; ++r) { Zp[0][r] = 0.f; Zp[1][r] = 0.f; }
#define RB_ZSTAGE(chz) do { LAS bf16_t* zq = (LAS bf16_t*)(lds + ZS0 + ((chz) & 1) * 9216) + r32 * 72 + 32 * wave + 4 * hh; \
                _Pragma("unroll") for (int m = 0; m < 2; ++m) _Pragma("unroll") for (int rq = 0; rq < 4; ++rq) { u32x2 w; w.x = pk2(Zp[m][4 * rq], Zp[m][4 * rq + 1]); w.y = pk2(Zp[m][4 * rq + 2], Zp[m][4 * rq + 3]); \
                    *(LAS u32x2*)(zq + (32 * m) * 72 + 8 * rq) = w; } } while (0)
#define RB_STEP(j, chv) do { const int ch_ = (chv); \
                if (loader) { if (ch_ + 3 < 64) { RB_DMA(ch_ + 3); RB_WAIT2(); } else if (ch_ + 2 < 64) { RB_WAIT1(); } else { RB_WAIT0(); } }     \
                else if (storer) { if (ch_ > 1) RB_ZOUT(ch_ - 2); } \
                else { const LAS unsigned char* sl = lds + (ch_ & 3) * SLOT; f32x16 Hn[2], Z[2]; bf16x8 Hb[4]; u32x2 dd[2][4]; bf16x8 fa[2][4], fr[2][4]; \
                    _Pragma("unroll") for (int m = 0; m < 2; ++m) _Pragma("unroll") for (int rq = 0; rq < 4; ++rq) dd[m][rq] = *(const LAS u32x2*)(sl + 9216 + (32 * wave + r32) * 144 + (32 * m + 8 * rq + 4 * hh) * 2); \
                    _Pragma("unroll") for (int s = 0; s < 4; ++s) \
                        _Pragma("unroll") for (int m = 0; m < 2; ++m) { const int o = (32 * m + r32) * 144 + (16 * s + 8 * hh) * 2; fa[m][s] = *(const LAS bf16x8*)(sl + o); fr[m][s] = *(const LAS bf16x8*)(sl + 18432 + o); } \
                    __builtin_amdgcn_sched_barrier(0); \
                    _Pragma("unroll") for (int s = 0; s < 4; ++s) { const int m = s >> 1, o = 8 * (s & 1); u32x4 t; t.x = pk2(H[m][o], H[m][o + 1]); t.y = pk2(H[m][o + 2], H[m][o + 3]); t.z = pk2(H[m][o + 4], H[m][o + 5]); t.w = pk2(H[m][o + 6], H[m][o + 7]); Hb[s] = __builtin_bit_cast(bf16x8, t); } \
                    if (ch_ > 0) RB_ZSTAGE(ch_ - 1); \
                    __builtin_amdgcn_sched_barrier(0); \
                    asm volatile("s_waitcnt lgkmcnt(0)" ::: "memory"); __builtin_amdgcn_sched_barrier(0); \
                    _Pragma("unroll") for (int m = 0; m < 2; ++m) { \
                        _Pragma("unroll") for (int rq = 0; rq < 4; ++rq) { const u32x2 d = dd[m][rq]; Hn[m][4 * rq] = bflo(d.x); Hn[m][4 * rq + 1] = bfhi(d.x); Hn[m][4 * rq + 2] = bflo(d.y); Hn[m][4 * rq + 3] = bfhi(d.y); } \
                        _Pragma("unroll") for (int r = 0; r < 16; ++r) Z[m][r] = 0.f; } \
                    _Pragma("unroll") for (int s = 0; s < 4; ++s) \
                        _Pragma("unroll") for (int m = 0; m < 2; ++m) { \
                            Hn[m] = __builtin_amdgcn_mfma_f32_32x32x16_bf16(fa[m][s], Hb[s], Hn[m], 0, 0, 0);                \
                            Z[m] = __builtin_amdgcn_mfma_f32_32x32x16_bf16(Hb[s], fr[m][s], Z[m], 0, 0, 0); }               \
                    H[0] = Hn[0]; H[1] = Hn[1]; Zp[0] = Z[0]; Zp[1] = Z[1]; } \
                LBAR(); } while (0)
            for (int ch = 0; ch < 64; ch += 4) { RB_STEP(0, ch); RB_STEP(1, ch + 1); RB_STEP(2, ch + 2); RB_STEP(3, ch + 3); }
            if (storer) RB_ZOUT(62); else if (!loader) RB_ZSTAGE(63);
            LBAR();
            if (storer) RB_ZOUT(63);
#undef RB_ZSTAGE
#undef RB_STEP
#undef RB_DMA
#undef RB_WAIT2
#undef RB_WAIT1
#undef RB_WAIT0
#undef RB_ZOUT
        } else {
            LAS bf16_t* Bm = (LAS bf16_t*)lds; LAS bf16_t* Xh = (LAS bf16_t*)(lds + 34816); LAS float* CUM = (LAS float*)(lds + 53248); LAS float* DTL = CUM + 512;
            const int su = bx - 32, nsu = G - 32;
#pragma unroll 1
            for (int it = 0; it < 2; ++it) {
                int unit, hq0, hq1;
                if (nsu != 224) { if (it) break; unit = -1; hq0 = 0; hq1 = 4; }
                else if (it == 0) { unit = su; hq0 = 0; hq1 = 4; }
                else { if (su >= 128) break; unit = 224 + (su >> 2); hq0 = su & 3; hq1 = hq0 + 1; }
              for (int unit2 = (nsu != 224 ? su : unit); unit2 < (nsu != 224 ? 256 : unit + 1); unit2 += nsu) { unit = unit2;
                const int g = unit & 1, c = (unit >> 1) & 31, b = unit >> 6, m0 = b * SEQ + c * 128;
#pragma unroll 1
                for (int k = 0; k < 4; ++k) { const int p = tid + 512 * k, row = p >> 4, c16 = p & 15; *(LAS u32x4*)(Bm + row * 136 + 8 * c16) = conv8(PROJ, (size_t)(m0 + row), c * 128 + row, 512 + 128 * g + 8 * c16, args.in[I_CONVW], args.in[I_CONVB]); }
                if (wave < 4) { const int h = 4 * g + wave; const float a_h = -__expf(args.in[I_ALOG][h]);
                    const float v0 = DTSP[(size_t)(m0 + 2 * lane) * 8 + h], v1 = DTSP[(size_t)(m0 + 2 * lane + 1) * 8 + h]; float s = v0 + v1;
#pragma unroll
                    for (int o = 1; o < 64; o <<= 1) { const float t = __shfl_up(s, o); if (lane >= o) s += t; }
                    const float ex = s - (v0 + v1);
                    CUM[wave * 128 + 2 * lane] = a_h * (ex + v0); CUM[wave * 128 + 2 * lane + 1] = a_h * (ex + v0 + v1); DTL[wave * 128 + 2 * lane] = v0; DTL[wave * 128 + 2 * lane + 1] = v1; }
                LBAR();
#pragma unroll 1
                for (int hq = hq0; hq < hq1; ++hq) { const int h = 4 * g + hq;
                    { const int s = tid >> 2, cq = 16 * (tid & 3); const float sc = DTL[hq * 128 + s] * __expf(CUM[hq * 128 + 127] - CUM[hq * 128 + s]);
#pragma unroll 1
                      for (int q = 0; q < 2; ++q) { float f[8]; unpack8(conv8(PROJ, (size_t)(m0 + s), c * 128 + s, 64 * h + cq + 8 * q, args.in[I_CONVW], args.in[I_CONVB]), f);
#pragma unroll
                          for (int i = 0; i < 8; ++i) f[i] *= sc;
                          *(LAS u32x4*)(Xh + s * 72 + cq + 8 * q) = pack8(f); } }
                    LBAR();
                    const int mt = wave >> 2, nt = wave & 3; f32x16 acc;
#pragma unroll
                    for (int r = 0; r < 16; ++r) acc[r] = 0.f;
#pragma unroll
                    for (int ks = 0; ks < 8; ++ks) acc = __builtin_amdgcn_mfma_f32_32x32x16_bf16(TRF(Xh, 72, ks, mt), TRF(Bm, 136, ks, nt), acc, 0, 0, 0);
                    bf16_t* sp = SSTATE + ((size_t)((b * 32 + c) * 8 + h)) * 8192 + (32 * mt + 4 * hh) * 128 + 32 * nt + r32;
#pragma unroll
                    for (int r = 0; r < 16; ++r) sp[crc(r) * 128] = (bf16_t)f2bf(acc[r]);
                    if (tid == 0) CHDEC[(b * 32 + c) * 8 + h] = __expf(CUM[hq * 128 + 127]);
                    LBAR();
                }
              }
            }
        }
        __syncthreads();
        if (bx >= 32) {
            xcd_barrier(bar2);
            for (int gt = (bx - 32) * 512 + tid; gt < 32 * 4096; gt += (G - 32) * 512) {
                const int bh = gt >> 12, e2 = gt & 4095, b = bh >> 3, h = bh & 7;
                unsigned* sp = (unsigned*)SSTATE + ((size_t)(b * 32 * 8 + h)) * 4096 + e2;
                unsigned vals[32];
#pragma unroll
                for (int c = 0; c < 32; ++c) vals[c] = sp[(size_t)c * 8 * 4096];
                float r0 = 0.f, r1 = 0.f;
#pragma unroll
                for (int c = 0; c < 32; ++c) { const float dec = CHDEC[(b * 32 + c) * 8 + h]; sp[(size_t)c * 8 * 4096] = pk2(r0, r1); r0 = r0 * dec + bflo(vals[c]); r1 = r1 * dec + bfhi(vals[c]); }
            }
        }
    }

    SEAM(3);


    PHASE(5) { REPBAR
        LANE_CONSTS;
        u32x4 ry[2], rz[2], rv[2], rp[2], rg[2]; float bdv[2];
#define POST_LOAD(k0) do { const int c0 = 8 * lane; _Pragma("unroll") for (int q = 0; q < 2; ++q) { const size_t m = (size_t)(gw + ((k0) + q) * NGW); const bool hasprev = (m & (SEQ - 1)) != 0; \
            ry[q] = __builtin_nontemporal_load((const u32x4*)(MIX + m * DM + c0)); rz[q] = __builtin_nontemporal_load((const u32x4*)((const bf16_t*)((const unsigned char*)dout + 48 * MiB) + m * 512 + c0)); \
            const bf16_t* pc = PROJ + m * NPROJ + c0 + 1024; rv[q] = __builtin_nontemporal_load((const u32x4*)pc); rp[q] = hasprev ? __builtin_nontemporal_load((const u32x4*)(pc - NPROJ)) : (u32x4){0u, 0u, 0u, 0u}; \
            rg[q] = __builtin_nontemporal_load((const u32x4*)(GOUT + m * 512 + c0)); bdv[q] = KKR[m * 8 + (lane >> 3)]; } } while (0)
#define POST_FIN(k0) do { const int c0 = 8 * lane; float muv[8], gw_[8], gb_[8]; \
            _Pragma("unroll") for (int i = 0; i < 8; ++i) { muv[i] = args.in[I_MU][1024 + c0 + i]; gw_[i] = args.in[I_GNW][c0 + i]; gb_[i] = args.in[I_GNB][c0 + i]; } \
            _Pragma("unroll") for (int q = 0; q < 2; ++q) { const size_t m = (size_t)(gw + ((k0) + q) * NGW); float y[8], v[8], p[8], go[8]; \
                unpack8(ry[q], y); unpack8(rz[q], p); \
                _Pragma("unroll") for (int i = 0; i < 8; ++i) y[i] += p[i]; \
                unpack8(rv[q], v); unpack8(rp[q], p); \
                _Pragma("unroll") for (int i = 0; i < 8; ++i) v[i] += (p[i] - v[i]) * muv[i]; \
                unpack8(rg[q], go); float s1 = 0.f; const float bd = bdv[q]; \
                _Pragma("unroll") for (int i = 0; i < 8; ++i) s1 += y[i]; \
                s1 += __shfl_xor(s1, 1); s1 += __shfl_xor(s1, 2); s1 += __shfl_xor(s1, 4); const float mean = s1 * (1.0f / 64.0f); float s2 = 0.f; \
                _Pragma("unroll") for (int i = 0; i < 8; ++i) { const float d = y[i] - mean; s2 += d * d; } \
                s2 += __shfl_xor(s2, 1); s2 += __shfl_xor(s2, 2); s2 += __shfl_xor(s2, 4); const float rs = __builtin_amdgcn_rsqf(s2 * (1.0f / 64.0f) + 64e-5f); float o[8]; \
                _Pragma("unroll") for (int i = 0; i < 8; ++i) o[i] = ((y[i] - mean) * rs * gw_[i] + gb_[i] + bd * v[i]) * go[i]; \
                *(u32x4*)(MIX + m * DM + c0) = pack8(o); } } while (0)
        {
            LAS bf16_t* Cm = (LAS bf16_t*)lds; LAS bf16_t* Bm = (LAS bf16_t*)(lds + 34816); LAS bf16_t* Xh = (LAS bf16_t*)(lds + 69632); LAS bf16_t* Hp = (LAS bf16_t*)(lds + 88064);
            LAS float* CUM = (LAS float*)(lds + 105472); LAS float* DTL = CUM + 512;
            for (int unit = vcu; unit < 256; unit += G) {
                const int g = unit & 1, c = (unit >> 1) & 31, b = unit >> 6, m0 = b * SEQ + c * 128;
#pragma unroll 1
                for (int k = 0; k < 4; ++k) { const int p = tid + 512 * k, row = p >> 4, c16 = p & 15;
                    *(LAS u32x4*)(Bm + row * 136 + 8 * c16) = conv8(PROJ, (size_t)(m0 + row), c * 128 + row, 512 + 128 * g + 8 * c16, args.in[I_CONVW], args.in[I_CONVB]);
                    *(LAS u32x4*)(Cm + row * 136 + 8 * c16) = conv8(PROJ, (size_t)(m0 + row), c * 128 + row, 768 + 128 * g + 8 * c16, args.in[I_CONVW], args.in[I_CONVB]); }
                if (wave < 4) { const int h = 4 * g + wave; const float a_h = -__expf(args.in[I_ALOG][h]);
                    const float v0 = DTSP[(size_t)(m0 + 2 * lane) * 8 + h], v1 = DTSP[(size_t)(m0 + 2 * lane + 1) * 8 + h]; float s = v0 + v1;
#pragma unroll
                    for (int o = 1; o < 64; o <<= 1) { const float t = __shfl_up(s, o); if (lane >= o) s += t; }
                    const float ex = s - (v0 + v1);
                    CUM[wave * 128 + 2 * lane] = a_h * (ex + v0); CUM[wave * 128 + 2 * lane + 1] = a_h * (ex + v0 + v1); DTL[wave * 128 + 2 * lane] = v0; DTL[wave * 128 + 2 * lane + 1] = v1; }
                LBAR();
                const int mt = wave >> 1, nb = 2 * (wave & 1), nt2 = wave & 1;
                f32x16 cb[2];
#pragma unroll
                for (int r = 0; r < 16; ++r) { cb[0][r] = 0.f; cb[1][r] = 0.f; }
#pragma unroll
                for (int ks = 0; ks < 8; ++ks) { const bf16x8 a = NATF(Cm, 136, ks, mt);
                    cb[0] = __builtin_amdgcn_mfma_f32_32x32x16_bf16(a, NATF(Bm, 136, ks, nb), cb[0], 0, 0, 0); cb[1] = __builtin_amdgcn_mfma_f32_32x32x16_bf16(a, NATF(Bm, 136, ks, nb + 1), cb[1], 0, 0, 0); }
                LBAR();
                LAS bf16_t* Wt = Bm;
#pragma unroll 1
                for (int hq = 0; hq < 4; ++hq) { const int h = 4 * g + hq;
                    if (unit == vcu) POST_LOAD(2 * hq);
                    u32x4 ph[2];
                    { const bf16_t* hp = SSTATE + ((size_t)((b * 32 + c) * 8 + h)) * 8192;
#pragma unroll
                      for (int k = 0; k < 2; ++k) { const int p = tid + 512 * k; ph[k] = *(const u32x4*)(hp + (p >> 4) * 128 + 8 * (p & 15)); } }
#pragma unroll
                    for (int j = 0; j < 2; ++j) { const int s = 32 * (nb + j) + r32; const float cs = CUM[hq * 128 + s], ds = DTL[hq * 128 + s]; const int lb = 32 * mt + 4 * hh;
                        LAS bf16_t* wp = Wt + lb * 136 + s; const LAS float* cl = CUM + hq * 128 + lb;
#pragma unroll
                        for (int r = 0; r < 16; ++r) { const float w = (s <= lb + crc(r)) ? cb[j][r] * __expf(cl[crc(r)] - cs) * ds : 0.f; wp[crc(r) * 136] = (bf16_t)f2bf(w); } }
                    { const int s = tid >> 2, cq = 16 * (tid & 3);
                      u32x4 ra[4], rb2[4]; conv8_fetch(ra, PROJ, (size_t)(m0 + s), c * 128 + s, 64 * h + cq); conv8_fetch(rb2, PROJ, (size_t)(m0 + s), c * 128 + s, 64 * h + cq + 8);
                      asm volatile("" ::: "memory");
                      *(LAS u32x4*)(Xh + s * 72 + cq) = conv8_apply(ra, c * 128 + s, 64 * h + cq, args.in[I_CONVW], args.in[I_CONVB]);
                      asm volatile("" ::: "memory");
                      *(LAS u32x4*)(Xh + s * 72 + cq + 8) = conv8_apply(rb2, c * 128 + s, 64 * h + cq + 8, args.in[I_CONVW], args.in[I_CONVB]); }
#pragma unroll
                    for (int k = 0; k < 2; ++k) { const int p = tid + 512 * k, row = p >> 4, c16 = p & 15; *(LAS u32x4*)(Hp + row * 136 + 8 * c16) = ph[k]; }
                    LBAR();
                    f32x16 yd, yo;
#pragma unroll
                    for (int r = 0; r < 16; ++r) { yd[r] = 0.f; yo[r] = 0.f; }
#pragma unroll
                    for (int ks = 0; ks < 8; ++ks) { yd = __builtin_amdgcn_mfma_f32_32x32x16_bf16(NATF(Wt, 136, ks, mt), TRF(Xh, 72, ks, nt2), yd, 0, 0, 0);
                        yo = __builtin_amdgcn_mfma_f32_32x32x16_bf16(NATF(Cm, 136, ks, mt), NATF(Hp, 136, ks, nt2), yo, 0, 0, 0); }
                    { const LAS float* cl = CUM + hq * 128 + 32 * mt + 4 * hh;
#pragma unroll
                      for (int r = 0; r < 16; ++r) yd[r] += __expf(cl[crc(r)]) * yo[r];
                      tile_store_bf16<false>((LAS bf16_t*)(lds + 110592) + wave * 1280, yd, MIX + (size_t)(m0 + 32 * mt) * DM + 512 + 256 * g + 64 * hq + 32 * nt2, DM, lane); }
                    if (unit == vcu) POST_FIN(2 * hq);
                    LBAR();
                }
                __syncthreads();
                for (int i4 = 0; i4 < 16; i4 += 4) { const int ch = 256 * g + 4 * lane; const float dsk = args.in[I_DSKIP][4 * g + (lane >> 4)]; const f32x4 nw = *(const f32x4*)(args.in[I_SSDN] + ch);
                  u32x2 xv4[4], zv4[4];
#pragma unroll
                  for (int q = 0; q < 4; ++q) { const size_t m = (size_t)(m0 + wave * 16 + i4 + q); xv4[q] = conv4(PROJ, m, c * 128 + wave * 16 + i4 + q, ch, args.in[I_CONVW], args.in[I_CONVB]); zv4[q] = *(const u32x2*)(PROJ + m * NPROJ + 1792 + ch); }
#pragma unroll
                  for (int q = 0; q < 4; ++q) { const int l = wave * 16 + i4 + q; const size_t m = (size_t)(m0 + l);
                    const u32x2 yv = *(const u32x2*)(MIX + m * DM + 512 + ch), xv = xv4[q], zv = zv4[q];
                    float v[4] = {bflo(yv.x), bfhi(yv.x), bflo(yv.y), bfhi(yv.y)}; const float xs[4] = {bflo(xv.x), bfhi(xv.x), bflo(xv.y), bfhi(xv.y)}, zz[4] = {bflo(zv.x), bfhi(zv.x), bflo(zv.y), bfhi(zv.y)};
                    float qs = 0.f;
#pragma unroll
                    for (int j = 0; j < 4; ++j) { v[j] = (v[j] + dsk * xs[j]) * siluf_(zz[j]); qs += v[j] * v[j]; }
                    qs = wave_sum(qs); const float rq = __builtin_amdgcn_rsqf(qs * (1.0f / 256.0f) + EPS);
                    u32x2 o; o.x = pk2(v[0] * rq * nw[0], v[1] * rq * nw[1]); o.y = pk2(v[2] * rq * nw[2], v[3] * rq * nw[3]); *(u32x2*)(MIX + m * DM + 512 + ch) = o; } }
                LBAR();
            }
        }
    }
#undef POST_LOAD
#undef POST_FIN
    SEAM(5);


    PHASE(6) { REPBAR
        pg8::Gemm g{MIX, WOUT, MTOK, DM, DM}; pg8::StaticOrder S; S.init(MTOK, DM, G, bx);
        pg8::EpiRes<false, false> E{args.in[I_X], nullptr, XNB, nullptr, SS};
        pg8::gemm_phase(lds, g, S, E);
    }
    SEAM(6);
    PHASE(7) { REPBAR
        pg8::Gemm g{XNB, WGU, MTOK, 2 * FFN, DM}; pg8::StaticOrder S; S.init(MTOK, 2 * FFN, G, bx);
        LAS float* rsl = (LAS float*)(lds + RING_BYTES);
#pragma unroll
        for (int i = 0; i < 3; ++i) { const int idx = tid + 512 * i, slot = idx >> 8; pg8::Unit u; u.pm = 0; const bool has = S.next(slot, u); rsl[idx] = has ? pg8::rstd_from_ss(SS, u.pm * 256 + (idx & 255)) : 0.f; }
        __syncthreads();
        pg8::EpiSwiglu E{HID, FFN, rsl, nullptr};
        pg8::gemm_phase(lds, g, S, E);
        if (bx >= 128) conv_range(args.in, ws, (bf16_t*)args.out, CV_NE + 8 * 704, CV_EGU, (bx - 128) * 8 + wave, 128 * 8, (LAS float*)(lds + wave * 16384), lane);
    }
    SEAM(7);
    PHASE(8) { REPBAR
        pg8::Gemm g{HID, WDN, MTOK, DM, FFN}; pg8::StaticOrder S; S.init(MTOK, DM, G, bx);
        pg8::EpiRes<true, false> E{XNB, nullptr, XNB, nullptr, SS};
        pg8::gemm_phase(lds, g, S, E);
    }
    SEAM(8);
    PHASE(9) { REPBAR
        pg8::Gemm g{XNB, WQKV, MTOK, 1536, DM}; pg8::StaticOrder S; S.init(MTOK, 1536, G, bx);
        LAS float* rsl = (LAS float*)(lds + RING_BYTES);
        { const int slot = tid >> 8; pg8::Unit u; u.pm = 0; const bool has = S.next(slot, u); rsl[tid] = has ? pg8::rstd_from_ss(SS, u.pm * 256 + (tid & 255)) : 0.f; }
        __syncthreads();
        pg8::EpiQkv E{QKV, rsl, args.in[I_BQKV], args.in[I_QN], args.in[I_KN], ROPE};
        pg8::gemm_phase(lds, g, S, E);
        if (bx >= 128) {
            conv_range(args.in, ws, (bf16_t*)args.out, CV_EGU, CV_END, (bx - 128) * 8 + wave, 128 * 8, (LAS float*)(lds + wave * 16384), lane);
            conv_range(args.in, ws, (bf16_t*)args.out, CV_NE, CV_NE + 4 * 704, (bx - 128) * 8 + wave, 128 * 8, (LAS float*)(lds + wave * 16384), lane);
        }
    }
    SEAM(9);

    PHASE(10) { REPBAR
        LAS bf16_t* Kt = (LAS bf16_t*)lds; LAS bf16_t* Vt = (LAS bf16_t*)(lds + 36864);
        const int r32 = lane & 31, hh = lane >> 5;
        for (int unit = vcu; unit < BATCH * 4 * 32; unit += G) {
            const int blk = unit & 31, kvh = (unit >> 5) & 3, b = unit >> 7;
            {
                const int rowi = tid >> 1, half = tid & 1; const int tpos = (blk - 1) * 128 + rowi;
#pragma unroll
                for (int q = 0; q < 4; ++q) { u32x4 kv = (u32x4){0, 0, 0, 0}, vv = kv;
                    if (tpos >= 0) { const bf16_t* p = QKV + (size_t)(b * SEQ + tpos) * 1536 + 1024 + kvh * 64 + half * 32 + 8 * q; kv = *(const u32x4*)p; vv = *(const u32x4*)(p + 256); }
                    *(LAS u32x4*)(Kt + rowi * 72 + half * 32 + 8 * q) = kv; *(LAS u32x4*)(Vt + rowi * 72 + half * 32 + 8 * q) = vv; }
            }
            __syncthreads();
            const int gq = wave >> 1, qh = kvh * 4 + gq; const float sink = args.in[I_SINK][qh];
            for (int it = 0; it < 2; ++it) {
                const int qi = (wave & 1) * 64 + it * 32 + r32; const size_t mq = (size_t)b * SEQ + blk * 128 + qi;
                bf16x8 qr[4];
#pragma unroll
                for (int s = 0; s < 4; ++s) qr[s] = __builtin_nontemporal_load((const bf16x8*)(QKV + mq * 1536 + qh * 64 + 16 * s + 8 * hh));
                const int a0 = (wave & 1) * 2 + it;
                f32x16 sc[5];
#pragma unroll
                for (int j = 0; j < 5; ++j) {
#pragma unroll
                    for (int r = 0; r < 16; ++r) sc[j][r] = 0.f;
#pragma unroll
                    for (int s = 0; s < 4; ++s) { const bf16x8 kf = *(const LAS bf16x8*)(Kt + (32 * (a0 + j) + r32) * 72 + 16 * s + 8 * hh); sc[j] = __builtin_amdgcn_mfma_f32_32x32x16_bf16(kf, qr[s], sc[j], 0, 0, 0); }
                }
                float mx = sink;
#pragma unroll
                for (int j = 0; j < 5; ++j)
#pragma unroll
                    for (int r = 0; r < 16; ++r) { const int kj = 32 * (a0 + j) + crow(r, hh); const bool valid = (kj > qi) && (kj <= qi + 128) && (blk > 0 || kj >= 128);
                        const float x = valid ? sc[j][r] * 0.125f : -1e30f; sc[j][r] = x; mx = fmaxf(mx, x); }
                mx = fmaxf(mx, __shfl_xor(mx, 32));
                float l = 0.f;
#pragma unroll
                for (int j = 0; j < 5; ++j)
#pragma unroll
                    for (int r = 0; r < 16; ++r) { const float p = __expf(sc[j][r] - mx); sc[j][r] = p; l += p; }
                l += __shfl_xor(l, 32); l += __expf(sink - mx);
                const float inv = 1.0f / l;
                f32x16 o[2];
#pragma unroll
                for (int dt = 0; dt < 2; ++dt)
#pragma unroll
                    for (int r = 0; r < 16; ++r) o[dt][r] = 0.f;
#pragma unroll
                for (int j = 0; j < 5; ++j)
#pragma unroll
                    for (int s2 = 0; s2 < 2; ++s2) {
                        u32x4 pw; pw.x = pk2(sc[j][8 * s2 + 0], sc[j][8 * s2 + 1]); pw.y = pk2(sc[j][8 * s2 + 2], sc[j][8 * s2 + 3]); pw.z = pk2(sc[j][8 * s2 + 4], sc[j][8 * s2 + 5]); pw.w = pk2(sc[j][8 * s2 + 6], sc[j][8 * s2 + 7]);
                        const bf16x8 pf = __builtin_bit_cast(bf16x8, pw);
                        const int key0 = 32 * (a0 + j) + 16 * s2 + 4 * hh + ((lane & 15) >> 2);
#pragma unroll
                        for (int dt = 0; dt < 2; ++dt) {
                            const LAS bf16_t* vp = Vt + key0 * 72 + 32 * dt + 16 * ((lane >> 4) & 1) + 4 * (lane & 3);
                            const s16x4 lo = __builtin_bit_cast(s16x4, __builtin_amdgcn_ds_read_tr16_b64_v4i16((LAS s16x4*)vp));
                            const s16x4 hi = __builtin_bit_cast(s16x4, __builtin_amdgcn_ds_read_tr16_b64_v4i16((LAS s16x4*)(vp + 8 * 72)));
                            const bf16x8 vf = (bf16x8){lo[0], lo[1], lo[2], lo[3], hi[0], hi[1], hi[2], hi[3]};
                            o[dt] = __builtin_amdgcn_mfma_f32_32x32x16_bf16(vf, pf, o[dt], 0, 0, 0);
                        }
                    }
                bf16_t* op = ATTO + mq * DM + qh * 64;
#pragma unroll
                for (int dt = 0; dt < 2; ++dt)
#pragma unroll
                    for (int rq = 0; rq < 4; ++rq) { u32x2 w; w.x = pk2(o[dt][4 * rq] * inv, o[dt][4 * rq + 1] * inv); w.y = pk2(o[dt][4 * rq + 2] * inv, o[dt][4 * rq + 3] * inv);
                        *(u32x2*)(op + 32 * dt + 8 * rq + 4 * hh) = w; }
            }
            __syncthreads();
        }
    }
    SEAM(10);

    PHASE(11) { REPBAR
        pg8::Gemm g{ATTO, WO, MTOK, DM, DM}; pg8::StaticOrder S; S.init(MTOK, DM, G, bx);
        LAS float* GWL = (LAS float*)(lds + RING_BYTES);
        { pg8::Unit u0; u0.pn = 0; (void)S.next(0, u0); const int c = tid >> 1, hf = tid & 1; const float gg = args.in[I_NORM_FFN1][u0.pn * 256 + c];
          const f32x4 w = *(const f32x4*)(args.in[I_ROUTER] + (size_t)(u0.pn * 256 + c) * 8 + 4 * hf); *(LAS f32x4*)(GWL + c * 8 + 4 * hf) = w * gg; }
        __syncthreads();
        pg8::EpiResRouter E{XNB, H3B, args.in[I_BO], SS, (float*)(ws + WS_GOUT)  , args.in[I_NORM_FFN1], args.in[I_ROUTER], GWL};
        pg8::gemm_phase(lds, g, S, E);
    }
    SEAM(11);

    PHASE(12) { REPBAR
        LAS unsigned* lcnt = (LAS unsigned*)lds; LAS unsigned* lbase = lcnt + 8;
        if (tid < 8) lcnt[tid] = 0u;
        __syncthreads();
        const int m = vcu * 64 + (tid >> 3), p8 = tid & 7;
        int e0 = 0, e1 = 1; unsigned r0 = 0u, r1 = 0u;
        {
            const f32x4* lp = (const f32x4*)((const float*)(ws + WS_GOUT) + (size_t)m * 128) + 4 * p8;
            const f32x4 a0 = __builtin_nontemporal_load(lp), a1 = __builtin_nontemporal_load(lp + 1), b0 = __builtin_nontemporal_load(lp + 2), b1 = __builtin_nontemporal_load(lp + 3);
            const f32x2 sq = *(const f32x2*)(SS + (size_t)m * 16 + 2 * p8);
            float d[8] = {a0[0] + b0[0], a0[1] + b0[1], a0[2] + b0[2], a0[3] + b0[3], a1[0] + b1[0], a1[1] + b1[1], a1[2] + b1[2], a1[3] + b1[3]}; float t = sq[0] + sq[1];
#pragma unroll
            for (int o = 1; o < 8; o <<= 1) { t += __shfl_xor(t, o);
#pragma unroll
                for (int k = 0; k < 8; ++k) d[k] += __shfl_xor(d[k], o); }
            if (p8 == 0) {
                const float rstd = __builtin_amdgcn_rsqf(t * (1.0f / DM) + EPS);
                float v0 = d[0];
#pragma unroll
                for (int k = 1; k < 8; ++k) if (d[k] > v0) { v0 = d[k]; e0 = k; }
                float v1 = -3.0e38f; e1 = -1;
#pragma unroll
                for (int k = 0; k < 8; ++k) if (k != e0 && d[k] > v1) { v1 = d[k]; e1 = k; }
                const float w0 = __builtin_amdgcn_rcpf(1.0f + __expf((v1 - v0) * rstd));
                r0 = atomicAdd((unsigned*)(lcnt + e0), 1u); r1 = atomicAdd((unsigned*)(lcnt + e1), 1u);
                TOPW[2 * m] = w0; TOPW[2 * m + 1] = 1.0f - w0; RSTD4[m] = rstd;
            }
        }
        __syncthreads();
        if (tid < 8) lbase[tid] = atomicAdd(CNT + tid, lcnt[tid]);
        __syncthreads();
        if (p8 == 0) { const int k0 = (int)(lbase[e0] + r0), k1 = (int)(lbase[e1] + r1);
            RANK[2 * m] = k0 | (e0 << 20); RANK[2 * m + 1] = k1 | (e1 << 20);
            SRCE[e0 * MTOK + k0] = m; SRCE[e1 * MTOK + k1] = m; }
        __syncthreads();
    }
    SEAM(12);

    PHASE(14) { REPBAR
        pg8::Gemm g{H3B, EGU, SROWS, 2 * FE, DM}; pg8::MoeOrderG S; S.init(CNT, 2 * FE / 256, G, bx, (long)2 * FE * DM * 2);
        LAS int* gsrc = (LAS int*)(lds + RING_BYTES); LAS float* rsl = (LAS float*)(lds + RING_BYTES + 6144);
#pragma unroll
        for (int i = 0; i < 3; ++i) { const int idx = tid + 512 * i, slot = idx >> 8, r = idx & 255; pg8::Unit u; u.pm = 0; const bool has = S.next(slot, u);
            int e = 0;
#pragma unroll
            for (int j = 1; j < NEXP; ++j) e += (u.pm >= S.toff[j]) ? 1 : 0;
            int te = 0; unsigned ce = CNT[0];
#pragma unroll
            for (int j = 1; j < NEXP; ++j) { te = (e == j) ? S.toff[j] : te; ce = (e == j) ? CNT[j] : ce; }
            const int rk = (u.pm - te) * 256 + r; const bool ok = has && rk < (int)ce;
            const int tok = ok ? SRCE[e * MTOK + rk] : 0;
            rsl[idx] = ok ? RSTD4[tok] : 0.f; gsrc[idx] = tok * (DM * 2); }
        __syncthreads();
        S.gat = (const LAS unsigned*)gsrc;
        pg8::EpiSwiglu E{HS, FE, rsl, nullptr};
        pg8::gemm_phase(lds, g, S, E);
    }
    SEAM(14);
    PHASE(15) { REPBAR
        pg8::Gemm g{HS, EDN, SROWS, DM, FE}; pg8::MoeOrder S; S.init(CNT, DM / 256, G, bx, (long)DM * FE * 2);
        pg8::EpiBf16 E{AS, DM};
        pg8::gemm_phase(lds, g, S, E);
    }
    SEAM(15);
    PHASE(16) { REPBAR
        int tl16 = threadIdx.x; asm volatile("" : "+v"(tl16)); const int lane = tl16 & 63;
        {
            int roff[NEXP]; { int t = 0;
#pragma unroll
                for (int e = 0; e < NEXP; ++e) { roff[e] = t; t += (int)((CNT[e] + 255u) >> 8) << 8; } }
            const int mym = gw + (lane & 7) * NGW; const int w0 = RANK[2 * mym], w1 = RANK[2 * mym + 1], e0 = w0 >> 20, e1 = w1 >> 20; int q0 = roff[0], q1 = roff[0];
#pragma unroll
            for (int k = 1; k < NEXP; ++k) { q0 = (e0 == k) ? roff[k] : q0; q1 = (e1 == k) ? roff[k] : q1; }
            q0 += w0 & 0xfffff; q1 += w1 & 0xfffff; const float u0 = TOPW[2 * mym], u1 = TOPW[2 * mym + 1];
#pragma unroll
            for (int k0 = 0; k0 < 8; k0 += 4) {
                u32x4 ya[4][2], yb[4][2], hv[4][2]; float w0[4], w1[4];
#pragma unroll
                for (int t = 0; t < 4; ++t) { const int p0 = __builtin_amdgcn_readlane(q0, k0 + t), p1 = __builtin_amdgcn_readlane(q1, k0 + t);
                    w0[t] = __builtin_bit_cast(float, __builtin_amdgcn_readlane(__builtin_bit_cast(int, u0), k0 + t)); w1[t] = __builtin_bit_cast(float, __builtin_amdgcn_readlane(__builtin_bit_cast(int, u1), k0 + t));
                    const u32x4* y0 = (const u32x4*)(AS + (size_t)p0 * DM) + lane; const u32x4* y1 = (const u32x4*)(AS + (size_t)p1 * DM) + lane;
                    ya[t][0] = __builtin_nontemporal_load(y0); ya[t][1] = __builtin_nontemporal_load(y0 + 64); yb[t][0] = __builtin_nontemporal_load(y1); yb[t][1] = __builtin_nontemporal_load(y1 + 64);
                    const u32x4* hp = (const u32x4*)(H3B + (size_t)(gw + (k0 + t) * NGW) * DM) + lane;
                    hv[t][0] = __builtin_nontemporal_load(hp); hv[t][1] = __builtin_nontemporal_load(hp + 64); }
#pragma unroll
                for (int t = 0; t < 4; ++t) { f32x4* o = (f32x4*)(dout + (size_t)(gw + (k0 + t) * NGW) * DM);
#pragma unroll
                    for (int q = 0; q < 2; ++q) { float a[8], c[8], hh[8]; unpack8(ya[t][q], a); unpack8(yb[t][q], c); unpack8(hv[t][q], hh); f32x4 h0 = (f32x4){hh[0], hh[1], hh[2], hh[3]}, h1 = (f32x4){hh[4], hh[5], hh[6], hh[7]};
#pragma unroll
                        for (int i = 0; i < 4; ++i) { h0[i] += w0[t] * a[i] + w1[t] * c[i]; h1[i] += w0[t] * a[4 + i] + w1[t] * c[4 + i]; }
                        __builtin_nontemporal_store(h0, o + 128 * q + 2 * lane); __builtin_nontemporal_store(h1, o + 128 * q + 2 * lane + 1); } }
            }
        }
    }
#undef TRF
#undef NATF
#undef IN
#undef SEAM
#undef PHASE
#undef REPBAR
}

constexpr int NPHASE = 17;
extern "C" void kernel_launch(void* const* d_in, const int* in_sizes, int n_in, void* d_out, int out_size, void* d_ws, size_t ws_size, hipStream_t stream) {
    static int grid = 0;
    if (grid == 0) {
        if (n_in != 39 || out_size != MTOK * DM || ws_size < WS_END) { fprintf(stderr, "kernel_launch: unexpected shapes n_in %d out %d ws %zu\n", n_in, out_size, ws_size); grid = -1; return; }
        int dev = 0, cus = 0;
        if (hipGetDevice(&dev) != hipSuccess || hipDeviceGetAttribute(&cus, hipDeviceAttributeMultiprocessorCount, dev) != hipSuccess) { grid = -1; return; }
        if (hipFuncSetAttribute((const void*)fwd_kernel, hipFuncAttributeMaxDynamicSharedMemorySize, LDS_BYTES) != hipSuccess) { fprintf(stderr, "kernel_launch: hipFuncSetAttribute failed\n"); grid = -1; return; }
        int per_cu = 0; (void)hipOccupancyMaxActiveBlocksPerMultiprocessor(&per_cu, (const void*)fwd_kernel, 512, LDS_BYTES); (void)hipGetLastError();
        grid = 256; if (cus != 256 || per_cu < 1) fprintf(stderr, "kernel_launch: note: cus %d per_cu %d\n", cus, per_cu);
    }
    if (grid < 0) return;
    Args a{};
    a.in[0] = (const float*)d_in[0];
    for (int i = 2; i < 39; ++i) a.in[i - 1] = (const float*)d_in[i];
    a.pos = (const int*)d_in[1]; a.out = (float*)d_out; a.ws = (unsigned char*)d_ws;
    (void)hipMemsetAsync((char*)d_ws + WS_CTL, 0, CTL_ZERO_BYTES, stream);
#ifdef PROBE_PHASE
    constexpr int pp = PROBE_PHASE; constexpr bool before = (pp == 2 || pp == 3 || pp == 5 || pp == 6 || pp == 8 || pp == 11 || pp == 12);
#ifdef PROBE_VARIANT
    a.variant = PROBE_VARIANT;
#endif
    if (before) { a.ph_lo = pp; a.ph_hi = pp + 1; hipLaunchKernelGGL(fwd_kernel, dim3(grid), dim3(512), LDS_BYTES, stream, a); (void)hipMemsetAsync((char*)d_ws + WS_CTL, 0, CTL_ZERO_BYTES, stream); }
    a.variant = 0;
#endif
    a.ph_lo = 0; a.ph_hi = NPHASE;
    hipLaunchKernelGGL(fwd_kernel, dim3(grid), dim3(512), LDS_BYTES, stream, a);
#ifdef PROBE_PHASE
    if (!before) { (void)hipMemsetAsync((char*)d_ws + WS_CTL, 0, CW_CNT * 4, stream);
#ifdef PROBE_VARIANT
        a.variant = PROBE_VARIANT;
#endif
        a.ph_lo = pp; a.ph_hi = pp + 1; hipLaunchKernelGGL(fwd_kernel, dim3(grid), dim3(512), LDS_BYTES, stream, a); }
#endif
}
```
